# Optimizing an MI355X kernel written in HIP

```python
import jax, jax.numpy as jnp
from jax import lax
import numpy as np

D_MODEL = 1024
BATCH = 1
SEQ = 16384
DEPTH = 2
DEC_BATCH = 128
DEC_SEQ = 1
PAST_LEN = 16384
PAGE_SIZE = 128

N_EVEN = (DEPTH + 1) // 2
N_ODD = DEPTH // 2
GLA_HEADS = 4
GLA_DK = 64
GLA_DV = 128
GLA_RANK = 16
GLA_TAU = 16.0
GLA_CHUNK = 64
SWA_HEADS = 8
SWA_KV_HEADS = 2
SWA_GROUP = SWA_HEADS // SWA_KV_HEADS
SWA_HD = 64
WINDOW = 128
SWA_BLOCK = 128
POOL_WINDOWS = (2, 4, 8, 16)
POOL_GROUPS = len(POOL_WINDOWS)
POOL_GC = D_MODEL // POOL_GROUPS
POOL_BUF = max(POOL_WINDOWS) - 1
D_FF = 2816
CONV_W = 3
PLE_DIM = 256
EPS = 1e-6

A_QK = GLA_HEADS * GLA_DK
A_V = GLA_HEADS * GLA_DV
B_Q = SWA_HEADS * SWA_HD
B_KV = SWA_KV_HEADS * SWA_HD
IN_SIZES = (A_QK, A_QK, A_V, GLA_RANK, A_V, B_Q, B_KV, B_KV)
IN_SPLITS = tuple(int(s) for s in np.cumsum(IN_SIZES)[:-1])
IN_COLS = sum(IN_SIZES)
MIX_WIDTH = A_V + B_Q

kernel_name = 'hybrid_gla_swa_pool_convffn_step'


def rmsnorm(x, g):
    xf = x.astype(jnp.float32)
    y = xf * lax.rsqrt(jnp.mean(xf * xf, axis=-1, keepdims=True) + EPS) * g.astype(jnp.float32)
    return y.astype(x.dtype)


def alibi_slopes():
    return 2.0 ** (-8.0 * jnp.arange(1, SWA_HEADS + 1, dtype=jnp.float32) / SWA_HEADS)


def gla_chunked(q, k, v, log_a, s0):
    B, T = q.shape[:2]
    c = min(GLA_CHUNK, T)
    nc = -(-T // c)
    pad = nc * c - T

    def blocks(a):
        a = jnp.pad(a.astype(jnp.float32), ((0, 0), (0, pad), (0, 0), (0, 0)))
        return a.reshape(B, nc, c, a.shape[2], a.shape[3]).transpose(1, 0, 3, 2, 4)

    tril = jnp.tril(jnp.ones((c, c), bool))

    def step(s, xs):
        qc, kc, vc, gc = xs
        b = jnp.cumsum(gc, axis=2)
        diff = jnp.where(tril[:, :, None], b[:, :, :, None, :] - b[:, :, None, :, :], -jnp.inf)
        att = jnp.einsum('bhid,bhjd,bhijd->bhij', qc, kc, jnp.exp(diff))
        o = jnp.einsum('bhij,bhjv->bhiv', att, vc) + jnp.einsum('bhid,bhdv->bhiv', qc * jnp.exp(b), s)
        b_last = b[:, :, -1:, :]
        s = jnp.exp(b_last[:, :, 0, :])[..., None] * s + jnp.einsum('bhjd,bhjv->bhdv', kc * jnp.exp(b_last - b), vc)
        return s, o

    s, o = lax.scan(step, s0.astype(jnp.float32), (blocks(q), blocks(k), blocks(v), blocks(log_a)))
    o = o.transpose(1, 0, 3, 2, 4).reshape(B, nc * c, q.shape[2], v.shape[-1])[:, :T]
    return o, s


def swa_attention(q, k, v, buf_k, buf_v, sinks, pos0):
    B, T = q.shape[:2]
    c = min(SWA_BLOCK, T)
    nb = -(-T // c)
    pad = nb * c - T
    ke = jnp.concatenate([buf_k.astype(k.dtype), k], axis=1)
    ve = jnp.concatenate([buf_v.astype(v.dtype), v], axis=1)
    new_k, new_v = ke[:, -WINDOW:], ve[:, -WINDOW:]
    padw = ((0, 0), (0, pad), (0, 0), (0, 0))
    qb = jnp.pad(q, padw).reshape(B, nb, c, SWA_KV_HEADS, SWA_GROUP, SWA_HD)
    ke, ve = jnp.pad(ke, padw), jnp.pad(ve, padw)
    idx = jnp.arange(nb)[:, None] * c + jnp.arange(WINDOW + c)[None, :]
    kb, vb = ke[:, idx], ve[:, idx]
    q_pos = pos0 + jnp.arange(nb * c).reshape(nb, c)
    k_pos = pos0 - WINDOW + idx
    dist = q_pos[:, :, None] - k_pos[:, None, :]
    valid = (dist >= 0) & (dist < WINDOW) & (k_pos[:, None, :] >= 0)
    slopes = alibi_slopes().reshape(SWA_KV_HEADS, SWA_GROUP, 1, 1)
    logits = jnp.einsum('bnqkgd,bnskd->bnkgqs', qb, kb).astype(jnp.float32) * SWA_HD ** -0.5
    logits = logits - slopes * dist[:, None, None].astype(jnp.float32)
    logits = jnp.where(valid[:, None, None], logits, -jnp.inf)
    sink = jnp.broadcast_to(sinks.astype(jnp.float32).reshape(SWA_KV_HEADS, SWA_GROUP, 1, 1), logits.shape[:-1] + (1,))
    probs = jax.nn.softmax(jnp.concatenate([logits, sink], axis=-1), axis=-1)[..., :-1]
    out = jnp.einsum('bnkgqs,bnskd->bnqkgd', probs.astype(v.dtype), vb)
    out = out.reshape(B, nb * c, SWA_HEADS, SWA_HD)[:, :T]
    return out, new_k, new_v


def mixer_ab(xn, st_gla, buf_k, buf_v, pos0, w_in, w_alpha, b_alpha, out_norm, q_norm, k_norm, sinks, w_out):
    B, T, _ = xn.shape
    qa, ka, va, lra, ra, qb, kb, vb = jnp.split(xn @ w_in, IN_SPLITS, axis=-1)
    q = qa.reshape(B, T, GLA_HEADS, GLA_DK) * GLA_DK ** -0.5
    k = ka.reshape(B, T, GLA_HEADS, GLA_DK)
    v = va.reshape(B, T, GLA_HEADS, GLA_DV)
    log_a = jax.nn.log_sigmoid((lra @ w_alpha + b_alpha).astype(jnp.float32)) / GLA_TAU
    log_a = log_a.reshape(B, T, GLA_HEADS, GLA_DK)
    o_a, st_new = gla_chunked(q, k, v, log_a, st_gla)
    o_a = rmsnorm(o_a.astype(xn.dtype), out_norm).reshape(B, T, A_V) * jax.nn.silu(ra)
    qb = rmsnorm(qb.reshape(B, T, SWA_HEADS, SWA_HD), q_norm)
    kb = rmsnorm(kb.reshape(B, T, SWA_KV_HEADS, SWA_HD), k_norm)
    vb = vb.reshape(B, T, SWA_KV_HEADS, SWA_HD)
    o_b, new_k, new_v = swa_attention(qb, kb, vb, buf_k, buf_v, sinks, pos0)
    y = jnp.concatenate([o_a, o_b.reshape(B, T, B_Q)], axis=-1) @ w_out
    return y, st_new.astype(st_gla.dtype), new_k, new_v


def pool_mixer(xn, buf, pos0, w_pool, scale):
    B, T, D = xn.shape
    xe = jnp.concatenate([buf.astype(xn.dtype), xn], axis=1)
    cs = jnp.concatenate([jnp.zeros((B, 1, D), jnp.float32), jnp.cumsum(xe.astype(jnp.float32), axis=1)], axis=1)
    pos = pos0 + jnp.arange(T)
    L = POOL_BUF
    groups = []
    for g, w in enumerate(POOL_WINDOWS):
        sl = slice(g * POOL_GC, (g + 1) * POOL_GC)
        s = cs[:, L + 1:L + 1 + T, sl] - cs[:, L + 1 - w:L + 1 - w + T, sl]
        cnt = jnp.minimum(pos + 1, w).astype(jnp.float32)[:, None]
        groups.append(s / cnt)
    d = jnp.concatenate(groups, axis=-1) - xn.astype(jnp.float32)
    y = jnp.einsum('btgc,gcd->btgd', d.reshape(B, T, POOL_GROUPS, POOL_GC), w_pool).reshape(B, T, D) * scale
    return y.astype(xn.dtype), xe[:, -L:]


def conv_ffn(h, buf, norm, w_in, conv_w, conv_b, w_out):
    xn = rmsnorm(h, norm)
    a, v = jnp.split(xn @ w_in, 2, axis=-1)
    T = a.shape[1]
    ae = jnp.concatenate([buf.astype(a.dtype), a], axis=1)
    ac = conv_b
    for j in range(CONV_W):
        ac = ac + conv_w[j] * ae[:, j:j + T]
    y = (jax.nn.gelu(ac, approximate=False) * v) @ w_out
    return y, ae[:, -(CONV_W - 1):]


def trunk(x, p, st_gla, c_k, c_v, st_pool, st_conv, pos0,
          mix_norm_even, w_in_even, gla_w_alpha, gla_b_alpha, gla_out_norm, swa_q_norm, swa_k_norm, swa_sinks, w_out_even,
          mix_norm_odd, pool_w, pool_scale,
          ffn_norm, ffn_w_in, ffn_conv_w, ffn_conv_b, ffn_w_out,
          ple_norm, ple_w_proj, ple_w_gate):
    h = x
    gla_l, k_l, v_l, pool_l, conv_l = [], [], [], [], []
    for i in range(DEPTH):
        j = i // 2
        if i % 2 == 0:
            y, s, nk, nv = mixer_ab(rmsnorm(h, mix_norm_even[j]), st_gla[j], c_k[j], c_v[j], pos0,
                                    w_in_even[j], gla_w_alpha[j], gla_b_alpha[j], gla_out_norm[j],
                                    swa_q_norm[j], swa_k_norm[j], swa_sinks[j], w_out_even[j])
            gla_l.append(s)
            k_l.append(nk)
            v_l.append(nv)
        else:
            y, sp = pool_mixer(rmsnorm(h, mix_norm_odd[j]), st_pool[j], pos0, pool_w[j], pool_scale[j])
            pool_l.append(sp)
        h = h + y.astype(h.dtype)
        y, sc = conv_ffn(h, st_conv[i], ffn_norm[i], ffn_w_in[i], ffn_conv_w[i], ffn_conv_b[i], ffn_w_out[i])
        conv_l.append(sc)
        h = h + y.astype(h.dtype)
        gate = jax.nn.sigmoid(rmsnorm(h, ple_norm[i]) @ ple_w_gate[i])
        h = h + ((p[i] @ ple_w_proj[i]) * gate).astype(h.dtype)
    return h, jnp.stack(gla_l), jnp.stack(k_l), jnp.stack(v_l), jnp.stack(pool_l), jnp.stack(conv_l)


def setup_inputs(seed: int = 0) -> dict:
    key = jax.random.key(seed)
    ks = jax.random.split(key, 32)

    def nrm(n, shape, scale):
        return scale * jax.random.normal(ks[n], shape, jnp.float32)

    def gain(n, shape):
        return 1.0 + nrm(n, shape, 0.1)

    return {
        'x_prompt': nrm(0, (BATCH, SEQ, D_MODEL), 1.0),
        'x_sample': nrm(1, (DEC_BATCH, DEC_SEQ, D_MODEL), 1.0),
        'p_prompt': nrm(2, (DEPTH, BATCH, SEQ, PLE_DIM), 1.0),
        'p_sample': nrm(3, (DEPTH, DEC_BATCH, DEC_SEQ, PLE_DIM), 1.0),
        'state_gla': nrm(4, (N_EVEN, DEC_BATCH, GLA_HEADS, GLA_DK, GLA_DV), 0.3),
        'cache_swa_k': nrm(5, (N_EVEN, DEC_BATCH, WINDOW, SWA_KV_HEADS, SWA_HD), 1.0),
        'cache_swa_v': nrm(6, (N_EVEN, DEC_BATCH, WINDOW, SWA_KV_HEADS, SWA_HD), 1.0),
        'state_pool': nrm(7, (N_ODD, DEC_BATCH, POOL_BUF, D_MODEL), 1.0),
        'state_ffn_conv': nrm(8, (DEPTH, DEC_BATCH, CONV_W - 1, D_FF), 1.0),
        'mix_norm_even': gain(9, (N_EVEN, D_MODEL)),
        'w_in_even': nrm(10, (N_EVEN, D_MODEL, IN_COLS), D_MODEL ** -0.5),
        'gla_w_alpha': nrm(11, (N_EVEN, GLA_RANK, A_QK), GLA_RANK ** -0.5),
        'gla_b_alpha': nrm(12, (N_EVEN, A_QK), 0.1),
        'gla_out_norm': gain(13, (N_EVEN, GLA_DV)),
        'swa_q_norm': gain(14, (N_EVEN, SWA_HD)),
        'swa_k_norm': gain(15, (N_EVEN, SWA_HD)),
        'swa_sinks': nrm(16, (N_EVEN, SWA_HEADS), 1.0),
        'w_out_even': nrm(17, (N_EVEN, MIX_WIDTH, D_MODEL), MIX_WIDTH ** -0.5),
        'mix_norm_odd': gain(18, (N_ODD, D_MODEL)),
        'pool_w': nrm(19, (N_ODD, POOL_GROUPS, POOL_GC, POOL_GC), POOL_GC ** -0.5),
        'pool_scale': gain(20, (N_ODD, D_MODEL)),
        'ffn_norm': gain(21, (DEPTH, D_MODEL)),
        'ffn_w_in': nrm(22, (DEPTH, D_MODEL, 2 * D_FF), D_MODEL ** -0.5),
        'ffn_conv_w': nrm(23, (DEPTH, CONV_W, D_FF), CONV_W ** -0.5),
        'ffn_conv_b': nrm(24, (DEPTH, D_FF), 0.02),
        'ffn_w_out': nrm(25, (DEPTH, D_FF, D_MODEL), D_FF ** -0.5),
        'ple_norm': gain(26, (DEPTH, D_MODEL)),
        'ple_w_proj': nrm(27, (DEPTH, PLE_DIM, D_MODEL), PLE_DIM ** -0.5),
        'ple_w_gate': nrm(28, (DEPTH, D_MODEL, D_MODEL), D_MODEL ** -0.5),
    }


def reference(x_prompt, x_sample, p_prompt, p_sample, state_gla, cache_swa_k, cache_swa_v, state_pool, state_ffn_conv,
              mix_norm_even, w_in_even, gla_w_alpha, gla_b_alpha, gla_out_norm, swa_q_norm, swa_k_norm, swa_sinks, w_out_even,
              mix_norm_odd, pool_w, pool_scale,
              ffn_norm, ffn_w_in, ffn_conv_w, ffn_conv_b, ffn_w_out,
              ple_norm, ple_w_proj, ple_w_gate):
    params = (mix_norm_even, w_in_even, gla_w_alpha, gla_b_alpha, gla_out_norm, swa_q_norm, swa_k_norm, swa_sinks,
              w_out_even, mix_norm_odd, pool_w, pool_scale, ffn_norm, ffn_w_in, ffn_conv_w, ffn_conv_b, ffn_w_out,
              ple_norm, ple_w_proj, ple_w_gate)
    b, dt = x_prompt.shape[0], x_prompt.dtype
    y_prompt, gla_p, swa_k_p, swa_v_p, pool_p, conv_p = trunk(
        x_prompt, p_prompt,
        jnp.zeros((N_EVEN, b, GLA_HEADS, GLA_DK, GLA_DV), dt),
        jnp.zeros((N_EVEN, b, WINDOW, SWA_KV_HEADS, SWA_HD), dt),
        jnp.zeros((N_EVEN, b, WINDOW, SWA_KV_HEADS, SWA_HD), dt),
        jnp.zeros((N_ODD, b, POOL_BUF, D_MODEL), dt),
        jnp.zeros((DEPTH, b, CONV_W - 1, D_FF), dt),
        0, *params)
    y_sample, gla_s, swa_k_s, swa_v_s, pool_s, conv_s = trunk(
        x_sample, p_sample, state_gla, cache_swa_k, cache_swa_v, state_pool, state_ffn_conv,
        PAST_LEN, *params)
    return (y_prompt, y_sample, gla_p, swa_k_p, swa_v_p, pool_p, conv_p, gla_s, swa_k_s, swa_v_s, pool_s, conv_s)
```

```cpp
#include <hip/hip_runtime.h>
#include <hip/hip_cooperative_groups.h>
#include <cstdio>
#include <cstdint>
namespace cg = cooperative_groups;

#define LAS __attribute__((address_space(3)))
typedef unsigned short bf16_t;
typedef short bf16x8 __attribute__((ext_vector_type(8)));
typedef float f32x4 __attribute__((ext_vector_type(4)));
typedef float f32x2 __attribute__((ext_vector_type(2)));
typedef unsigned u32x4 __attribute__((ext_vector_type(4)));
typedef unsigned u32x2 __attribute__((ext_vector_type(2)));

constexpr int D = 1024, SEQ = 16384, NS = 128, DFF = 2816, PLE = 256;
constexpr int SROW = 16510;
constexpr int MT = 16640;
constexpr int MR = 16768;
constexpr int NPROJ = 2304;
constexpr int PQA = 0, PKA = 256, PVA = 512, PRA = 1024, PQB = 1536, PKB = 2048, PVB = 2176;
constexpr float EPS = 1e-6f;
constexpr int NTHREADS = 512;

constexpr size_t O_YP = 0, O_YS = 16777216, O_GLAP = 16908288, O_SKP = 16941056, O_SVP = 16957440, O_POOLP = 16973824, O_CONVP = 16989184,
                 O_GLAS = 17000448, O_SKS = 21194752, O_SVS = 23291904, O_POOLS = 25389056, O_CONVS = 27355136;

constexpr size_t MiB = 1u << 20;
constexpr size_t WS_WIN0 = 1 * MiB, WS_WOUT0 = 6 * MiB, WS_WFFI = 8 * MiB, WS_WFFO = 30 * MiB, WS_WGATE = 41 * MiB, WS_WPROJ = 45 * MiB, WS_WPOOL = 46 * MiB;
constexpr size_t WS_SSQ = 47 * MiB;
constexpr size_t WS_PBF = 55 * MiB, WS_R1 = 72 * MiB, WS_R2 = 105 * MiB, WS_BIG = 138 * MiB;
constexpr size_t PART_STRIDE = (size_t)(MR + 8) * 16 * 4;
constexpr size_t WFFI_BYTES = (size_t)5632 * 1024 * 2, WFFO_BYTES = (size_t)1024 * 2816 * 2, WGATE_BYTES = (size_t)1024 * 1024 * 2, WPROJ_BYTES = (size_t)1024 * 256 * 2;
constexpr size_t BIG_LA = (size_t)MT * NPROJ * 2;
constexpr int LDS_BYTES = 155648;

__device__ __forceinline__ unsigned cvt_pk_bf16(float lo, float hi) { unsigned r; asm volatile("v_cvt_pk_bf16_f32 %0, %1, %2" : "=v"(r) : "v"(lo), "v"(hi)); return r; }
__device__ __forceinline__ float bf_lo(unsigned w) { return __uint_as_float(w << 16); }
__device__ __forceinline__ float bf_hi(unsigned w) { return __uint_as_float(w & 0xffff0000u); }
__device__ __forceinline__ float bf2f(bf16_t v) { return __uint_as_float(((unsigned)v) << 16); }
__device__ __forceinline__ void unpack8(const u32x4 w, float* f) { f[0] = bf_lo(w.x); f[1] = bf_hi(w.x); f[2] = bf_lo(w.y); f[3] = bf_hi(w.y); f[4] = bf_lo(w.z); f[5] = bf_hi(w.z); f[6] = bf_lo(w.w); f[7] = bf_hi(w.w); }
__device__ __forceinline__ float wave_sum(float v) {
#pragma unroll
    for (int o = 1; o < 64; o <<= 1) v += __shfl_xor(v, o);
    return v;
}
__device__ __forceinline__ float wave_max(float v) {
#pragma unroll
    for (int o = 1; o < 64; o <<= 1) v = fmaxf(v, __shfl_xor(v, o));
    return v;
}
__device__ __forceinline__ int otid() { int t = threadIdx.x; asm volatile("" : "+v"(t)); return t; }
__device__ __forceinline__ bool row_valid(int row) { return row < SEQ || (row >= SROW && row < SROW + NS); }
__device__ __forceinline__ float* hrow_ptr(float* out, int row) { return row < SEQ ? out + O_YP + (size_t)row * D : out + O_YS + (size_t)(row - SROW) * D; }
__device__ __forceinline__ f32x2 gelu_pk(f32x2 v) {
    const f32x2 av = __builtin_elementwise_abs(v), d = av * 0.2316418882f + 1.0f;
    f32x2 t; t.x = __builtin_amdgcn_rcpf(d.x); t.y = __builtin_amdgcn_rcpf(d.y);
    f32x2 q = t * 0.5307027145f + (-0.7265760135f); q = q * t + 0.7107068705f; q = q * t + (-0.142248368f); q = q * t + 0.127414796f; q = q * t;
    const f32x2 s = (v * v) * (-0.72134752044f);
    f32x2 e; e.x = __builtin_amdgcn_exp2f(s.x); e.y = __builtin_amdgcn_exp2f(s.y);
    const f32x2 m = v * (q * e), r = v - m;
    f32x2 o; o.x = v.x < 0.f ? m.x : r.x; o.y = v.y < 0.f ? m.y : r.y; return o;
}

namespace pg8 {
constexpr int BM = 256, BK = 64, HALF = 128, HTB = HALF * BK * 2, STAGE_BYTES = 8 * HTB, NXCD = 8, WGM = 8;
__host__ __device__ __forceinline__ int lds_byte(int r, int c) { const int st = (r >> 4) * 2 + (c >> 5), rr = r & 15, cc = c & 31, ob = rr * 64 + cc * 2; return st * 1024 + (ob ^ (((ob >> 9) & 1) << 5)); }
__host__ __device__ __forceinline__ void stage_rc(int b, int& R, int& C) { const int st = b / 1024, sb = b % 1024, swz = sb ^ (((sb >> 9) & 1) << 5); R = (st >> 1) * 16 + swz / 64; C = (st & 1) * 32 + (swz % 64) / 2; }
__host__ __device__ __forceinline__ int perm32(int rho) { const int n = rho >> 4, i = rho & 15; return 8 * (i >> 2) + 4 * n + (i & 3); }

struct Unit { int pm, pn; };
struct Gemm { const bf16_t* A; const bf16_t* Bt; int lda, ldb, K, mstride, arow0, acolstep; };

struct StaticOrder {
    int nM, nN, nwg, G, c;
    __device__ void init(int nM_, int nN_, int G_, int c_) { nM = nM_; nN = nN_; nwg = nM * nN; G = G_; c = c_; }
    __device__ bool next(int i, Unit& u) const {
        const long L = (long)i * G + c; if (L >= nwg) return false;
        int wgid = (int)L; { const int q = nwg / NXCD, r = nwg % NXCD, xcd = wgid % NXCD, off = wgid / NXCD; wgid = (xcd < r ? xcd * (q + 1) : r * (q + 1) + (xcd - r) * q) + off; }
        const int nig = WGM * nN, gid = wgid / nig, fm = gid * WGM, gsz = (nM - fm) < WGM ? (nM - fm) : WGM;
        u.pm = fm + ((wgid % nig) % gsz); u.pn = (wgid % nig) / gsz; return true;
    }
};

template <class Epi>
__device__ __forceinline__ void gemm_phase(LAS unsigned char* lds, const Gemm g, const StaticOrder& S, const Epi& E) {
    const int tid = otid(), wid = __builtin_amdgcn_readfirstlane(tid >> 6), lane = tid & 63, wr = wid >> 2, wc = wid & 3, fr = lane & 15, fq = lane >> 4;
    const int K = g.K, nt = K / BK;
    unsigned voffA[2], voffB[2];
#pragma unroll
    for (int i = 0; i < 2; ++i) { int R, C; stage_rc(tid * 16 + i * 8192, R, C); const int Rb = (R & ~31) + perm32(R & 31);
        voffA[i] = (unsigned)(R * g.lda + C) * 2u; voffB[i] = (unsigned)(Rb * g.ldb + C) * 2u; }
    const size_t kstep = (size_t)(BK * 2);
    const size_t hstepA = (size_t)HALF * g.lda * 2, hstepB = (size_t)HALF * g.ldb * 2;
    const unsigned ldsw = (unsigned)wid * 1024u;
    const int aoff = lds_byte(wr * 64 + fr, fq * 8), boff = lds_byte(wc * 32 + fr, fq * 8);
#define PG8_SA(b, h) (((b) * 2 + (h)) * HTB)
#define PG8_SB(b, h) ((4 + (b) * 2 + (h)) * HTB)
#define PG8_STAGE(bufoff, gbase, voff) do { _Pragma("unroll") for (int _i = 0; _i < 2; ++_i) \
        __builtin_amdgcn_global_load_lds((const unsigned*)((const char*)(gbase) + (voff)[_i]), (LAS unsigned*)(lds + (bufoff) + ldsw + _i * 8192), 16, 0, 0); } while (0)
#define PG8_LDA(dst, b, h) do { _Pragma("unroll") for (int m = 0; m < 4; ++m) _Pragma("unroll") for (int k = 0; k < 2; ++k) dst[m][k] = *(const LAS bf16x8*)(lds + PG8_SA(b, h) + aoff + m * 2048 + k * 1024); } while (0)
#define PG8_LDB(dst, b, h) do { _Pragma("unroll") for (int n = 0; n < 2; ++n) _Pragma("unroll") for (int k = 0; k < 2; ++k) dst[n][k] = *(const LAS bf16x8*)(lds + PG8_SB(b, h) + boff + n * 2048 + k * 1024); } while (0)
#define PG8_MMA(ai, bj, At, Bt) do { __builtin_amdgcn_s_setprio(1); _Pragma("unroll") for (int m = 0; m < 4; ++m) _Pragma("unroll") for (int n = 0; n < 2; ++n) _Pragma("unroll") for (int k = 0; k < 2; ++k) \
        acc[ai][bj][m][n] = __builtin_amdgcn_mfma_f32_16x16x32_bf16(Bt[n][k], At[m][k], acc[ai][bj][m][n], 0, 0, 0); __builtin_amdgcn_s_setprio(0); } while (0)
#define PG8_WAIT_V(n) asm volatile("s_waitcnt vmcnt(" #n ")" ::: "memory")
#define PG8_WAIT_L(n) asm volatile("s_waitcnt lgkmcnt(" #n ")" ::: "memory")
#define PG8_BAR __builtin_amdgcn_s_barrier()
#define PG8_SCHED __builtin_amdgcn_sched_barrier(0)
#define PG8_ABASE(u) ((const char*)g.A + ((long)((long)(u).pm * g.mstride + g.arow0) * g.lda + (long)(u).pn * g.acolstep) * 2)
#define PG8_BBASE(u) ((const char*)g.Bt + (size_t)(u).pn * 256 * g.ldb * 2)
    Unit cur, nxt; int ui = 0;
    if (!S.next(0, cur)) return;
    f32x4 acc[2][2][4][2];
#pragma unroll
    for (int a = 0; a < 2; ++a)
#pragma unroll
        for (int b = 0; b < 2; ++b)
#pragma unroll
            for (int m = 0; m < 4; ++m)
#pragma unroll
                for (int n = 0; n < 2; ++n) acc[a][b][m][n] = (f32x4){0.f, 0.f, 0.f, 0.f};
    bf16x8 At[4][2], B0[2][2], B1[2][2];
    const char* cA = PG8_ABASE(cur); const char* cB = PG8_BBASE(cur);
    PG8_STAGE(PG8_SB(0, 0), cB, voffB); PG8_STAGE(PG8_SB(0, 1), cB + hstepB, voffB); PG8_STAGE(PG8_SA(0, 0), cA, voffA); PG8_STAGE(PG8_SA(0, 1), cA + hstepA, voffA);
    if (wr == 1) PG8_BAR;
    PG8_WAIT_V(2); PG8_BAR;
    PG8_STAGE(PG8_SB(1, 0), cB + kstep, voffB); PG8_STAGE(PG8_SA(1, 0), cA + kstep, voffA); PG8_STAGE(PG8_SB(1, 1), cB + hstepB + kstep, voffB);
    PG8_WAIT_V(6); PG8_BAR;
    for (;;) {
        const bool has_next = S.next(ui + 1, nxt);
        const char* nA = has_next ? PG8_ABASE(nxt) : cA; const char* nB = has_next ? PG8_BBASE(nxt) : cB;
#pragma unroll 1
        for (int t = 0; t < nt; t += 2) {
            const bool last = (t == nt - 2);
            const char* a1 = cA + (size_t)(t + 1) * kstep;
            const char* a2 = last ? nA : cA + (size_t)(t + 2) * kstep; const char* b2 = last ? nB : cB + (size_t)(t + 2) * kstep;
            const char* a3 = a2 + kstep; const char* b3 = b2 + kstep;
            PG8_LDB(B0, 0, 0); PG8_LDB(B1, 0, 1); PG8_SCHED; PG8_LDA(At, 0, 0); PG8_STAGE(PG8_SA(1, 1), a1 + hstepA, voffA);
            PG8_WAIT_V(8); PG8_WAIT_L(0); PG8_BAR; PG8_MMA(0, 0, At, B0); PG8_MMA(0, 1, At, B1); PG8_BAR; PG8_SCHED;
            PG8_LDA(At, 0, 1); PG8_STAGE(PG8_SB(0, 0), b2, voffB); PG8_STAGE(PG8_SB(0, 1), b2 + hstepB, voffB); PG8_STAGE(PG8_SA(0, 0), a2, voffA);
            PG8_WAIT_V(8); PG8_WAIT_L(0); PG8_BAR; PG8_MMA(1, 0, At, B0); PG8_MMA(1, 1, At, B1); PG8_BAR; PG8_SCHED;
            PG8_LDB(B0, 1, 0); PG8_LDB(B1, 1, 1); PG8_SCHED; PG8_LDA(At, 1, 0); PG8_STAGE(PG8_SA(0, 1), a2 + hstepA, voffA);
            PG8_WAIT_V(8); PG8_WAIT_L(0); PG8_BAR; PG8_MMA(0, 0, At, B0); PG8_MMA(0, 1, At, B1); PG8_BAR; PG8_SCHED;
            PG8_LDA(At, 1, 1); PG8_STAGE(PG8_SB(1, 0), b3, voffB); PG8_STAGE(PG8_SB(1, 1), b3 + hstepB, voffB); PG8_STAGE(PG8_SA(1, 0), a3, voffA);
            PG8_WAIT_V(8); PG8_WAIT_L(0); PG8_BAR; PG8_MMA(1, 0, At, B0); PG8_MMA(1, 1, At, B1); PG8_BAR; PG8_SCHED;
        }
        if (wr == 0) PG8_BAR;
        { int lane2 = lane; asm volatile("" : "+v"(lane2)); E(acc, cur, wr, wc, lane2 & 15, lane2 >> 4, lds + STAGE_BYTES); }
        if (!has_next) break;
#pragma unroll
        for (int a = 0; a < 2; ++a)
#pragma unroll
            for (int b = 0; b < 2; ++b)
#pragma unroll
                for (int m = 0; m < 4; ++m)
#pragma unroll
                    for (int n = 0; n < 2; ++n) acc[a][b][m][n] = (f32x4){0.f, 0.f, 0.f, 0.f};
        cur = nxt; cA = nA; cB = nB; ++ui;
        if (wr == 1) PG8_BAR;
    }
    PG8_WAIT_V(0);
    PG8_BAR;
#undef PG8_SA
#undef PG8_SB
#undef PG8_STAGE
#undef PG8_LDA
#undef PG8_LDB
#undef PG8_MMA
#undef PG8_WAIT_V
#undef PG8_WAIT_L
#undef PG8_BAR
#undef PG8_SCHED
#undef PG8_ABASE
#undef PG8_BBASE
}
}
using pg8::Unit;
typedef f32x4 AccT[2][2][4][2];

__device__ __forceinline__ float row_rs(const float* part, int row, int fq) {
    const f32x4 p = *(const f32x4*)(part + (long)row * 16 + fq * 4);
    float s = (p[0] + p[1]) + (p[2] + p[3]);
    s += __shfl_xor(s, 16); s += __shfl_xor(s, 32);
    return rsqrtf(s * (1.0f / D) + EPS);
}

struct EpiProj {
    bf16_t* proj; float* la; const float* ssq0; const float* b_alpha;
    __device__ __forceinline__ void operator()(const AccT& acc, const Unit& u, int wr, int wc, int fr, int fq, LAS unsigned char*) const {
#pragma unroll
        for (int ai = 0; ai < 2; ++ai)
#pragma unroll
            for (int m = 0; m < 4; ++m) {
                const int row = u.pm * 256 + ai * 128 + wr * 64 + m * 16 + fr;
                const float rs = rsqrtf(ssq0[row] * (1.0f / D) + EPS);
#pragma unroll
                for (int bj = 0; bj < 2; ++bj) {
                    const int col = u.pn * 256 + bj * 128 + wc * 32 + fq * 8;
                    const f32x4 v0 = acc[ai][bj][m][0] * rs, v1 = acc[ai][bj][m][1] * rs;
                    if (u.pn < 9) {
                        u32x4 w; w.x = cvt_pk_bf16(v0[0], v0[1]); w.y = cvt_pk_bf16(v0[2], v0[3]); w.z = cvt_pk_bf16(v1[0], v1[1]); w.w = cvt_pk_bf16(v1[2], v1[3]);
                        *(u32x4*)(proj + (size_t)row * NPROJ + col) = w;
                    } else {
                        const int c = col - NPROJ;
                        const f32x4 b0 = *(const f32x4*)(b_alpha + c), b1 = *(const f32x4*)(b_alpha + c + 4);
                        f32x4 o0, o1;
#pragma unroll
                        for (int j = 0; j < 4; ++j) {
                            const float z0 = v0[j] + b0[j], z1 = v1[j] + b1[j];
                            o0[j] = (fminf(z0, 0.f) - log1pf(__expf(-fabsf(z0)))) * 0.0625f;
                            o1[j] = (fminf(z1, 0.f) - log1pf(__expf(-fabsf(z1)))) * 0.0625f;
                        }
                        *(f32x4*)(la + (size_t)row * 256 + c) = o0; *(f32x4*)(la + (size_t)row * 256 + c + 4) = o1;
                    }
                }
            }
    }
};
struct EpiPP {
    bf16_t* pp;
    __device__ __forceinline__ void operator()(const AccT& acc, const Unit& u, int wr, int wc, int fr, int fq, LAS unsigned char*) const {
#pragma unroll
        for (int ai = 0; ai < 2; ++ai)
#pragma unroll
            for (int m = 0; m < 4; ++m) {
                const int row = u.pm * 256 + ai * 128 + wr * 64 + m * 16 + fr;
#pragma unroll
                for (int bj = 0; bj < 2; ++bj) {
                    const int col = u.pn * 256 + bj * 128 + wc * 32 + fq * 8;
                    const f32x4 v0 = acc[ai][bj][m][0], v1 = acc[ai][bj][m][1];
                    u32x4 w; w.x = cvt_pk_bf16(v0[0], v0[1]); w.y = cvt_pk_bf16(v0[2], v0[3]); w.z = cvt_pk_bf16(v1[0], v1[1]); w.w = cvt_pk_bf16(v1[2], v1[3]);
                    *(u32x4*)(pp + (size_t)row * D + col) = w;
                }
            }
    }
};
template <int MODE, bool WRITE_HB, bool WRITE_PART>
struct EpiRes {
    float* out; const float* xp; const float* xs; bf16_t* hb; float* part; const float* part_in; const bf16_t* pp; const float* scale;
    __device__ __forceinline__ void operator()(const AccT& acc, const Unit& u, int wr, int wc, int fr, int fq, LAS unsigned char*) const {
#pragma unroll
        for (int ai = 0; ai < 2; ++ai)
#pragma unroll
            for (int m = 0; m < 4; ++m) {
                const int row = u.pm * 256 + ai * 128 + wr * 64 + m * 16 + fr;
                const bool valid = row_valid(row);
                float rs = 1.f;
                if (MODE == 2) rs = row_rs(part_in, row, fq);
                float sq = 0.f;
                float* hp = hrow_ptr(out, valid ? row : 0);
                const float* bp = hp;
                if (MODE == 0) bp = (row < SEQ) ? xp + (size_t)row * D : xs + (size_t)((valid ? row : SROW) - SROW) * D;
#pragma unroll
                for (int bj = 0; bj < 2; ++bj) {
                    const int col = u.pn * 256 + bj * 128 + wc * 32 + fq * 8;
                    f32x4 v0 = acc[ai][bj][m][0], v1 = acc[ai][bj][m][1];
                    if (MODE == 2) {
                        const u32x4 pw = *(const u32x4*)(pp + (size_t)row * D + col);
                        float pf[8]; unpack8(pw, pf);
#pragma unroll
                        for (int j = 0; j < 4; ++j) {
                            v0[j] = pf[j] / (1.f + __expf(-v0[j] * rs));
                            v1[j] = pf[4 + j] / (1.f + __expf(-v1[j] * rs));
                        }
                    }
                    if (MODE == 3) { v0 = v0 * *(const f32x4*)(scale + col); v1 = v1 * *(const f32x4*)(scale + col + 4); }
                    if (valid) {
                        const f32x4 h0 = *(const f32x4*)(bp + col) + v0, h1 = *(const f32x4*)(bp + col + 4) + v1;
                        *(f32x4*)(hp + col) = h0; *(f32x4*)(hp + col + 4) = h1;
                        if (WRITE_HB) { u32x4 w; w.x = cvt_pk_bf16(h0[0], h0[1]); w.y = cvt_pk_bf16(h0[2], h0[3]); w.z = cvt_pk_bf16(h1[0], h1[1]); w.w = cvt_pk_bf16(h1[2], h1[3]);
                            *(u32x4*)(hb + (size_t)row * D + col) = w; }
                        sq += (h0[0] * h0[0] + h0[1] * h0[1]) + (h0[2] * h0[2] + h0[3] * h0[3]) + (h1[0] * h1[0] + h1[1] * h1[1]) + (h1[2] * h1[2] + h1[3] * h1[3]);
                    }
                }
                if (WRITE_PART) {
                    sq += __shfl_xor(sq, 16); sq += __shfl_xor(sq, 32);
                    if (fq == 0 && valid) part[(long)row * 16 + u.pn * 4 + wc] = sq;
                }
            }
    }
};
struct EpiFfn {
    const float* part_in; const float* convw; const float* convb; const float* cstate; float* convp_out; float* convs_out; bf16_t* G;
    __device__ __forceinline__ void operator()(AccT& acc, const Unit& u, int wr, int wc, int fr, int fq, LAS unsigned char* ldsx) const {
        const int lane = fr + 16 * fq;
        const int c0 = u.pn * 128 + wc * 32 + fq * 8;
        const bool sample = (u.pm == 65);
#pragma unroll
        for (int ai = 0; ai < 2; ++ai)
#pragma unroll
            for (int m = 0; m < 4; ++m) {
                const int grow = u.pm * 254 - 2 + ai * 128 + wr * 64 + m * 16 + fr;
                const float rs = row_rs(part_in, grow, fq);
#pragma unroll
                for (int bj = 0; bj < 2; ++bj)
#pragma unroll
                    for (int n = 0; n < 2; ++n) acc[ai][bj][m][n] = acc[ai][bj][m][n] * rs;
            }
        LAS f32x4* xch = (LAS f32x4*)ldsx;
        if (fr >= 14) {
#pragma unroll
            for (int ai = 0; ai < 2; ++ai) {
                const int slot = ((((ai * 2 + wr) * 4 + wc) * 4 + fq) * 2 + (fr - 14)) * 2;
                xch[slot] = acc[ai][0][3][0]; xch[slot + 1] = acc[ai][0][3][1];
            }
        }
        asm volatile("s_waitcnt lgkmcnt(0)" ::: "memory"); __builtin_amdgcn_s_barrier(); asm volatile("" ::: "memory");
        const int src1 = (lane & 48) | ((fr + 15) & 15), src2 = (lane & 48) | ((fr + 14) & 15);
#pragma unroll
        for (int n = 0; n < 2; ++n) {
            const int cn = c0 + 4 * n;
            const f32x4 w0 = *(const f32x4*)(convw + cn), w1 = *(const f32x4*)(convw + DFF + cn), w2 = *(const f32x4*)(convw + 2 * DFF + cn), cb = *(const f32x4*)(convb + cn);
#pragma unroll
            for (int ai = 0; ai < 2; ++ai)
#pragma unroll
                for (int m = 0; m < 4; ++m) {
                    const int tr = ai * 128 + wr * 64 + m * 16 + fr;
                    const int grow = u.pm * 254 - 2 + tr;
                    const f32x4 x = acc[ai][0][m][n];
                    f32x4 p;
                    if (m == 0) {
                        const int sa = (wr == 1) ? ai : 0, sw = (wr == 1) ? 0 : 1;
                        const bool has = (wr == 1) || (ai == 1);
                        const int slot = ((((sa * 2 + sw) * 4 + wc) * 4 + fq) * 2 + (fr >= 14 ? fr - 14 : 0)) * 2 + n;
                        p = xch[slot];
                        if (!has) p = (f32x4){0.f, 0.f, 0.f, 0.f};
                    } else p = acc[ai][0][m == 0 ? 0 : m - 1][n];
                    f32x4 p1, p2;
#pragma unroll
                    for (int j = 0; j < 4; ++j) {
                        const float x1 = __shfl(x[j], src1), x2 = __shfl(x[j], src2), q1 = __shfl(p[j], src1), q2 = __shfl(p[j], src2);
                        p1[j] = (fr >= 1) ? x1 : q1;
                        p2[j] = (fr >= 2) ? x2 : q2;
                    }
                    bool store;
                    if (sample) {
                        const int b = tr - 2;
                        store = (b >= 0 && b < NS);
                        if (store) {
                            const float* st = cstate + (size_t)b * 2 * DFF + cn;
                            p2 = *(const f32x4*)(st); p1 = *(const f32x4*)(st + DFF);
                            float* so = convs_out + (size_t)b * 2 * DFF + cn;
                            *(f32x4*)(so) = p1; *(f32x4*)(so + DFF) = x;
                        }
                    } else {
                        store = (tr >= 2 && grow < SEQ);
                        if (grow >= SEQ - 2 && grow < SEQ) *(f32x4*)(convp_out + (size_t)(grow - (SEQ - 2)) * DFF + cn) = x;
                    }
                    const f32x4 ac = cb + w0 * p2 + w1 * p1 + w2 * x;
                    const f32x4 v = acc[ai][1][m][n];
                    const f32x2 g0 = gelu_pk((f32x2){ac[0], ac[1]}), g1 = gelu_pk((f32x2){ac[2], ac[3]});
                    if (store) {
                        u32x2 w; w.x = cvt_pk_bf16(g0.x * v[0], g0.y * v[1]); w.y = cvt_pk_bf16(g1.x * v[2], g1.y * v[3]);
                        *(u32x2*)(G + (size_t)grow * DFF + cn) = w;
                    }
                    asm volatile("" ::: "memory");
                }
        }
    }
};

struct KArgs { const float* in[29]; float* out; unsigned char* ws; };
enum { I_XP = 0, I_XS, I_PP, I_PS, I_SGLA, I_CK, I_CV, I_SPOOL, I_SCONV, I_MNE, I_WIN, I_WALPHA, I_BALPHA, I_ONORM, I_QNORM, I_KNORM, I_SINKS, I_WOUT,
       I_MNO, I_POOLW, I_POOLSC, I_FNORM, I_FWIN, I_FCW, I_FCB, I_FWOUT, I_PNORM, I_PWPROJ, I_PWGATE };

__device__ __forceinline__ float* part_tab(unsigned char* ws, int i) { return (float*)(ws + WS_SSQ + 262144 + (size_t)i * PART_STRIDE) + 2 * 16; }

__device__ __forceinline__ void tr_item(const float* W, int ldsrc, int scol0, int k0, const float* gain, bf16_t* dst, int ldd, int drow0, LAS float* scr, int lane) {
#pragma unroll 8
    for (int i = 0; i < 32; ++i) { const int kk = 2 * i + (lane >> 5); const float gsc = gain ? gain[k0 + kk] : 1.f;
        scr[kk * 33 + (lane & 31)] = W[(size_t)(k0 + kk) * ldsrc + scol0 + (lane & 31)] * gsc; }
    asm volatile("s_waitcnt lgkmcnt(0)" ::: "memory");
    const int c = lane & 7;
#pragma unroll
    for (int j = 0; j < 4; ++j) { const int n = (lane >> 3) + 8 * j; const LAS float* s = scr + (8 * c) * 33 + n;
        u32x4 o; o.x = cvt_pk_bf16(s[0 * 33], s[1 * 33]); o.y = cvt_pk_bf16(s[2 * 33], s[3 * 33]); o.z = cvt_pk_bf16(s[4 * 33], s[5 * 33]); o.w = cvt_pk_bf16(s[6 * 33], s[7 * 33]);
        *(u32x4*)(dst + (size_t)(drow0 + n) * ldd + k0 + 8 * c) = o; }
    asm volatile("s_waitcnt lgkmcnt(0)" ::: "memory");
}
__device__ __forceinline__ void weff_item(const float* Win, const float* wal, int n0, int k0, const float* gain, bf16_t* dst, int drow0, LAS float* scr, int lane) {
#pragma unroll 2
    for (int i = 0; i < 32; ++i) { const int kk = 2 * i + (lane >> 5); const int k = k0 + kk; float s = 0.f;
#pragma unroll
        for (int r = 0; r < 16; ++r) s += Win[(size_t)k * 2320 + 1024 + r] * wal[r * 256 + n0 + (lane & 31)];
        scr[kk * 33 + (lane & 31)] = s * gain[k]; }
    asm volatile("s_waitcnt lgkmcnt(0)" ::: "memory");
    const int c = lane & 7;
#pragma unroll
    for (int j = 0; j < 4; ++j) { const int n = (lane >> 3) + 8 * j; const LAS float* s = scr + (8 * c) * 33 + n;
        u32x4 o; o.x = cvt_pk_bf16(s[0 * 33], s[1 * 33]); o.y = cvt_pk_bf16(s[2 * 33], s[3 * 33]); o.z = cvt_pk_bf16(s[4 * 33], s[5 * 33]); o.w = cvt_pk_bf16(s[6 * 33], s[7 * 33]);
        *(u32x4*)(dst + (size_t)(drow0 + n) * 1024 + k0 + 8 * c) = o; }
    asm volatile("s_waitcnt lgkmcnt(0)" ::: "memory");
}

__device__ __forceinline__ void p0_prologue(const KArgs& a, LAS unsigned char* lds, int vcu, int G) {
    const int tid = otid(), lane = tid & 63, wave = __builtin_amdgcn_readfirstlane(tid >> 6);
    LAS float* scr = (LAS float*)(lds + wave * 16384);
    const int gw = vcu * 8 + wave, NGW = G * 8;
    unsigned char* ws = a.ws;
    constexpr int I_A = 16 * 72, I_E = 16 * 8, I_O = 16 * 32, I_FI = 16 * 176, I_FO = 44 * 32, I_G = 16 * 32, I_P = 4 * 32, I_PL = 4 * 32;
    constexpr int NITEMS = I_A + I_E + I_O + 2 * I_FI + 2 * I_FO + 2 * I_G + 2 * I_P + I_PL;
    for (int it = gw; it < NITEMS; it += NGW) {
        int r = it;
        if (r < I_A) { const int kb = r / 72, nb = r % 72, n0 = nb * 32; tr_item(a.in[I_WIN], 2320, n0 < 1024 ? n0 : n0 + 16, kb * 64, a.in[I_MNE], (bf16_t*)(ws + WS_WIN0), 1024, n0, scr, lane); continue; } r -= I_A;
        if (r < I_E) { const int kb = r / 8, nb = r % 8; weff_item(a.in[I_WIN], a.in[I_WALPHA], nb * 32, kb * 64, a.in[I_MNE], (bf16_t*)(ws + WS_WIN0), NPROJ + nb * 32, scr, lane); continue; } r -= I_E;
        if (r < I_O) { const int kb = r / 32, nb = r % 32; tr_item(a.in[I_WOUT], 1024, nb * 32, kb * 64, nullptr, (bf16_t*)(ws + WS_WOUT0), 1024, nb * 32, scr, lane); continue; } r -= I_O;
        if (r < 2 * I_FI) { const int l = r / I_FI, q = r % I_FI, kb = q / 176, nb = q % 176, n0 = nb * 32;
            const int pn = n0 >> 8, rr = n0 & 255, bj = rr >> 7, ii = rr & 127;
            tr_item(a.in[I_FWIN] + (size_t)l * 1024 * 5632, 5632, bj * DFF + pn * 128 + ii, kb * 64, a.in[I_FNORM] + l * 1024, (bf16_t*)(ws + WS_WFFI + l * WFFI_BYTES), 1024, n0, scr, lane); continue; } r -= 2 * I_FI;
        if (r < 2 * I_FO) { const int l = r / I_FO, q = r % I_FO, kb = q / 32, nb = q % 32;
            tr_item(a.in[I_FWOUT] + (size_t)l * DFF * 1024, 1024, nb * 32, kb * 64, nullptr, (bf16_t*)(ws + WS_WFFO + l * WFFO_BYTES), DFF, nb * 32, scr, lane); continue; } r -= 2 * I_FO;
        if (r < 2 * I_G) { const int l = r / I_G, q = r % I_G, kb = q / 32, nb = q % 32;
            tr_item(a.in[I_PWGATE] + (size_t)l * 1024 * 1024, 1024, nb * 32, kb * 64, a.in[I_PNORM] + l * 1024, (bf16_t*)(ws + WS_WGATE + l * WGATE_BYTES), 1024, nb * 32, scr, lane); continue; } r -= 2 * I_G;
        if (r < 2 * I_P) { const int l = r / I_P, q = r % I_P, kb = q / 32, nb = q % 32;
            tr_item(a.in[I_PWPROJ] + (size_t)l * 256 * 1024, 1024, nb * 32, kb * 64, nullptr, (bf16_t*)(ws + WS_WPROJ + l * WPROJ_BYTES), 256, nb * 32, scr, lane); continue; } r -= 2 * I_P;
        { const int gq = r / 32, q = r % 32, kb = q / 8, nb = q % 8;
            tr_item(a.in[I_POOLW] + (size_t)gq * 65536, 256, nb * 32, kb * 64, nullptr, (bf16_t*)(ws + WS_WPOOL), 256, gq * 256 + nb * 32, scr, lane); }
    }
    bf16_t* xbf = (bf16_t*)(ws + WS_R1);
    float* ssq0 = (float*)(ws + WS_SSQ);
    for (int row = gw; row < MR; row += NGW) {
        const float* src = row < SEQ ? a.in[I_XP] + (size_t)row * D : ((row >= SROW && row < SROW + NS) ? a.in[I_XS] + (size_t)(row - SROW) * D : nullptr);
        float s = 0.f;
#pragma unroll
        for (int j = 0; j < 4; ++j) {
            f32x4 v = (f32x4){0.f, 0.f, 0.f, 0.f};
            if (src) v = *(const f32x4*)(src + j * 256 + lane * 4);
            s += (v[0] * v[0] + v[1] * v[1]) + (v[2] * v[2] + v[3] * v[3]);
            u32x2 w; w.x = cvt_pk_bf16(v[0], v[1]); w.y = cvt_pk_bf16(v[2], v[3]);
            *(u32x2*)(xbf + (size_t)row * D + j * 256 + lane * 4) = w;
        }
        s = wave_sum(s);
        if (lane == 0) ssq0[row] = s;
    }
    bf16_t* pbf = (bf16_t*)(ws + WS_PBF);
    for (int it = gw; it < 2 * MT; it += NGW) {
        const int l = it / MT, row = it % MT;
        const float* src = row < SEQ ? a.in[I_PP] + ((size_t)l * SEQ + row) * PLE : ((row >= SROW && row < SROW + NS) ? a.in[I_PS] + ((size_t)l * NS + (row - SROW)) * PLE : nullptr);
        f32x4 v = (f32x4){0.f, 0.f, 0.f, 0.f};
        if (src) v = *(const f32x4*)(src + lane * 4);
        u32x2 w; w.x = cvt_pk_bf16(v[0], v[1]); w.y = cvt_pk_bf16(v[2], v[3]);
        *(u32x2*)(pbf + (size_t)it * PLE + lane * 4) = w;
    }
    if (vcu == 0) { for (int i = tid; i < 1024; i += NTHREADS) ((u32x4*)(ws + WS_R2))[i] = (u32x4){0u, 0u, 0u, 0u}; }
    {
        u32x4* pt = (u32x4*)(ws + WS_SSQ + 262144);
        const size_t n16 = 6 * PART_STRIDE / 16;
        for (size_t i = (size_t)vcu * NTHREADS + tid; i < n16; i += (size_t)G * NTHREADS) pt[i] = (u32x4){0u, 0u, 0u, 0u};
    }
}

__device__ __forceinline__ void gla_load_b(const float* la, int c, int h, LAS float* bL, int tid) {
#pragma unroll
    for (int i = 0; i < 2; ++i) { const int e = tid + i * NTHREADS; const int t = e >> 4, d4 = (e & 15) * 4;
        *(LAS f32x4*)(bL + t * 64 + d4) = *(const f32x4*)(la + (size_t)(c * 64 + t) * 256 + h * 64 + d4); }
    __syncthreads();
    if (tid < 64) { float s = 0.f;
#pragma unroll 8
        for (int t = 0; t < 64; ++t) { s += bL[t * 64 + tid]; bL[t * 64 + tid] = s; } }
    __syncthreads();
}
__device__ __forceinline__ void gla_u_item(const KArgs& a, LAS unsigned char* lds, int item) {
    const int tid = otid(); const int c = item >> 2, h = item & 3;
    const bf16_t* proj = (const bf16_t*)(a.ws + WS_BIG); const float* la = (const float*)(a.ws + WS_BIG + BIG_LA);
    float* U = (float*)(a.ws + WS_R2 + 4096); float* Dc = U + (size_t)256 * 4 * 64 * 128;
    LAS float* bL = (LAS float*)lds; LAS float* kh = bL + 4096; LAS float* vL = kh + 4096;
    gla_load_b(la, c, h, bL, tid);
    { const int t = tid >> 3, d8 = (tid & 7) * 8;
      const u32x4 kw = *(const u32x4*)(proj + (size_t)(c * 64 + t) * NPROJ + PKA + h * 64 + d8); float kf[8]; unpack8(kw, kf);
#pragma unroll
      for (int j = 0; j < 8; ++j) kh[t * 64 + d8 + j] = kf[j] * __expf(bL[63 * 64 + d8 + j] - bL[t * 64 + d8 + j]);
#pragma unroll
      for (int i = 0; i < 2; ++i) { const int dv8 = d8 + i * 64;
          const u32x4 vw = *(const u32x4*)(proj + (size_t)(c * 64 + t) * NPROJ + PVA + h * 128 + dv8); float vf[8]; unpack8(vw, vf);
#pragma unroll
          for (int j = 0; j < 8; ++j) vL[t * 128 + dv8 + j] = vf[j]; } }
    __syncthreads();
    const int dk4 = (tid >> 5) * 4, dv4 = (tid & 31) * 4;
    f32x4 u0 = {0.f, 0.f, 0.f, 0.f}, u1 = u0, u2 = u0, u3 = u0;
#pragma unroll 4
    for (int t = 0; t < 64; ++t) { const f32x4 kk = *(const LAS f32x4*)(kh + t * 64 + dk4), vv = *(const LAS f32x4*)(vL + t * 128 + dv4);
        u0 += kk[0] * vv; u1 += kk[1] * vv; u2 += kk[2] * vv; u3 += kk[3] * vv; }
    float* up = U + ((size_t)(c * 4 + h) * 64 + dk4) * 128 + dv4;
    *(f32x4*)(up) = u0; *(f32x4*)(up + 128) = u1; *(f32x4*)(up + 256) = u2; *(f32x4*)(up + 384) = u3;
    if (tid < 64) Dc[(c * 4 + h) * 64 + tid] = __expf(bL[63 * 64 + tid]);
    __syncthreads();
}
__device__ __forceinline__ void gla_scan(const KArgs& a, int vcu) {
    const int tid = otid(); if (tid >= 128) return;
    const int e = vcu * 128 + tid; if (e >= 32768) return;
    float* U = (float*)(a.ws + WS_R2 + 4096); const float* Dc = U + (size_t)256 * 4 * 64 * 128;
    const int hd = e >> 7;
    float S = 0.f;
    for (int c0 = 0; c0 < 256; c0 += 8) {
        float u[8], d[8];
#pragma unroll
        for (int j = 0; j < 8; ++j) { u[j] = U[(size_t)(c0 + j) * 32768 + e]; d[j] = Dc[(c0 + j) * 256 + hd]; }
#pragma unroll
        for (int j = 0; j < 8; ++j) { U[(size_t)(c0 + j) * 32768 + e] = S; S = d[j] * S + u[j]; }
    }
    a.out[O_GLAP + e] = S;
}
__device__ __forceinline__ void gla_o_item(const KArgs& a, LAS unsigned char* lds, int item) {
    const int tid = otid(); const int c = item >> 2, h = item & 3;
    const bf16_t* proj = (const bf16_t*)(a.ws + WS_BIG); const float* la = (const float*)(a.ws + WS_BIG + BIG_LA);
    const float* U = (const float*)(a.ws + WS_R2 + 4096);
    bf16_t* mix = (bf16_t*)(a.ws + WS_R1);
    LAS float* bL = (LAS float*)lds; LAS float* qt = bL + 4096; LAS float* kt = qt + 64 * 68; LAS float* vL = kt + 64 * 68; LAS float* SL = vL + 8192; LAS float* att = SL + 8192;
    gla_load_b(la, c, h, bL, tid);
    { const int t = tid >> 3, d8 = (tid & 7) * 8;
      const u32x4 qw = *(const u32x4*)(proj + (size_t)(c * 64 + t) * NPROJ + PQA + h * 64 + d8); float qf[8]; unpack8(qw, qf);
      const u32x4 kw = *(const u32x4*)(proj + (size_t)(c * 64 + t) * NPROJ + PKA + h * 64 + d8); float kf[8]; unpack8(kw, kf);
#pragma unroll
      for (int j = 0; j < 8; ++j) { const float b = bL[t * 64 + d8 + j]; qt[t * 68 + d8 + j] = qf[j] * 0.125f * __expf(b); kt[t * 68 + d8 + j] = kf[j] * __expf(-b); }
#pragma unroll
      for (int i = 0; i < 2; ++i) { const int dv8 = d8 + i * 64;
          const u32x4 vw = *(const u32x4*)(proj + (size_t)(c * 64 + t) * NPROJ + PVA + h * 128 + dv8); float vf[8]; unpack8(vw, vf);
#pragma unroll
          for (int j = 0; j < 8; ++j) vL[t * 128 + dv8 + j] = vf[j]; }
#pragma unroll
      for (int i = 0; i < 4; ++i) { const int e = (tid + i * NTHREADS) * 4; *(LAS f32x4*)(SL + e) = *(const f32x4*)(U + (size_t)(c * 4 + h) * 8192 + e); } }
    __syncthreads();
    { const int i = tid >> 3, j0 = tid & 7;
      float s[8];
#pragma unroll
      for (int jj = 0; jj < 8; ++jj) s[jj] = 0.f;
#pragma unroll 4
      for (int dk = 0; dk < 64; dk += 4) { const f32x4 q4 = *(const LAS f32x4*)(qt + i * 68 + dk);
#pragma unroll
          for (int jj = 0; jj < 8; ++jj) { const f32x4 k4 = *(const LAS f32x4*)(kt + (j0 + 8 * jj) * 68 + dk); s[jj] += (q4[0] * k4[0] + q4[1] * k4[1]) + (q4[2] * k4[2] + q4[3] * k4[3]); } }
#pragma unroll
      for (int jj = 0; jj < 8; ++jj) { const int j = j0 + 8 * jj; att[i * 65 + j] = (j <= i) ? s[jj] : 0.f; } }
    __syncthreads();
    { const int i = tid >> 3, dv0 = (tid & 7) * 16;
      f32x4 o[4];
#pragma unroll
      for (int q = 0; q < 4; ++q) o[q] = (f32x4){0.f, 0.f, 0.f, 0.f};
      for (int j = 0; j <= i; ++j) { const float av = att[i * 65 + j];
#pragma unroll
          for (int q = 0; q < 4; ++q) o[q] += av * *(const LAS f32x4*)(vL + j * 128 + dv0 + q * 4); }
#pragma unroll 4
      for (int dk = 0; dk < 64; ++dk) { const float qv = qt[i * 68 + dk];
#pragma unroll
          for (int q = 0; q < 4; ++q) o[q] += qv * *(const LAS f32x4*)(SL + dk * 128 + dv0 + q * 4); }
      float ss = 0.f;
#pragma unroll
      for (int q = 0; q < 4; ++q) ss += (o[q][0] * o[q][0] + o[q][1] * o[q][1]) + (o[q][2] * o[q][2] + o[q][3] * o[q][3]);
      ss += __shfl_xor(ss, 1); ss += __shfl_xor(ss, 2); ss += __shfl_xor(ss, 4);
      const float rstd = rsqrtf(ss * (1.0f / 128.f) + EPS);
      const int t = c * 64 + i;
      const float* on = a.in[I_ONORM] + dv0;
      float rf[16];
      { const u32x4 r0 = *(const u32x4*)(proj + (size_t)t * NPROJ + PRA + h * 128 + dv0), r1 = *(const u32x4*)(proj + (size_t)t * NPROJ + PRA + h * 128 + dv0 + 8); unpack8(r0, rf); unpack8(r1, rf + 8); }
      float y[16];
#pragma unroll
      for (int q = 0; q < 4; ++q)
#pragma unroll
          for (int j = 0; j < 4; ++j) { const float r = rf[q * 4 + j]; y[q * 4 + j] = o[q][j] * rstd * on[q * 4 + j] * (r / (1.f + __expf(-r))); }
      u32x4 w0, w1;
      w0.x = cvt_pk_bf16(y[0], y[1]); w0.y = cvt_pk_bf16(y[2], y[3]); w0.z = cvt_pk_bf16(y[4], y[5]); w0.w = cvt_pk_bf16(y[6], y[7]);
      w1.x = cvt_pk_bf16(y[8], y[9]); w1.y = cvt_pk_bf16(y[10], y[11]); w1.z = cvt_pk_bf16(y[12], y[13]); w1.w = cvt_pk_bf16(y[14], y[15]);
      *(u32x4*)(mix + (size_t)t * D + h * 128 + dv0) = w0; *(u32x4*)(mix + (size_t)t * D + h * 128 + dv0 + 8) = w1; }
    __syncthreads();
}
__device__ __forceinline__ void gla_decode_item(const KArgs& a, int item, int lane) {
    const int b = item >> 2, h = item & 3; const int row = SROW + b;
    const bf16_t* proj = (const bf16_t*)(a.ws + WS_BIG); const float* la = (const float*)(a.ws + WS_BIG + BIG_LA);
    bf16_t* mix = (bf16_t*)(a.ws + WS_R1);
    const float* S0 = a.in[I_SGLA] + ((size_t)b * 4 + h) * 8192;
    float* S1 = a.out + O_GLAS + ((size_t)b * 4 + h) * 8192;
    const float qv = bf2f(proj[(size_t)row * NPROJ + PQA + h * 64 + lane]) * 0.125f;
    const float kv = bf2f(proj[(size_t)row * NPROJ + PKA + h * 64 + lane]);
    const float av = __expf(la[(size_t)row * 256 + h * 64 + lane]);
    const unsigned vw = *(const unsigned*)(proj + (size_t)row * NPROJ + PVA + h * 128 + lane * 2);
    const float v0 = bf_lo(vw), v1 = bf_hi(vw);
    float o0 = 0.f, o1 = 0.f;
#pragma unroll 8
    for (int dk = 0; dk < 64; ++dk) {
        const float q = __shfl(qv, dk), k = __shfl(kv, dk), al = __shfl(av, dk);
        const f32x2 s = *(const f32x2*)(S0 + dk * 128 + lane * 2);
        const float n0 = al * s.x + k * v0, n1 = al * s.y + k * v1;
        *(f32x2*)(S1 + dk * 128 + lane * 2) = (f32x2){n0, n1};
        o0 += q * n0; o1 += q * n1;
    }
    const float ss = wave_sum(o0 * o0 + o1 * o1);
    const float rstd = rsqrtf(ss * (1.0f / 128.f) + EPS);
    const unsigned rw = *(const unsigned*)(proj + (size_t)row * NPROJ + PRA + h * 128 + lane * 2);
    const float r0 = bf_lo(rw), r1 = bf_hi(rw);
    const float y0 = o0 * rstd * a.in[I_ONORM][lane * 2] * (r0 / (1.f + __expf(-r0))), y1 = o1 * rstd * a.in[I_ONORM][lane * 2 + 1] * (r1 / (1.f + __expf(-r1)));
    *(unsigned*)(mix + (size_t)row * D + h * 128 + lane * 2) = cvt_pk_bf16(y0, y1);
}

__device__ __forceinline__ void swa_unit(const KArgs& a, LAS unsigned char* lds, int unit) {
    const int tid = otid(); const int qblk = unit >> 1, kvh = unit & 1;
    const bf16_t* proj = (const bf16_t*)(a.ws + WS_BIG);
    bf16_t* mix = (bf16_t*)(a.ws + WS_R1);
    LAS float* Kw = (LAS float*)lds; LAS float* Vw = Kw + 255 * 68;
    const int tk0 = qblk * 128 - 127;
    const float* kn = a.in[I_KNORM];
    for (int idx = tid; idx < 256 * 8; idx += NTHREADS) {
        const int kk = idx >> 3, part = idx & 7; const int tk = tk0 + kk;
        float kf[8], vf[8];
#pragma unroll
        for (int j = 0; j < 8; ++j) { kf[j] = 0.f; vf[j] = 0.f; }
        if (kk < 255 && tk >= 0) {
            const u32x4 kw = *(const u32x4*)(proj + (size_t)tk * NPROJ + PKB + kvh * 64 + part * 8); unpack8(kw, kf);
            const u32x4 vw = *(const u32x4*)(proj + (size_t)tk * NPROJ + PVB + kvh * 64 + part * 8); unpack8(vw, vf);
        }
        float ss = 0.f;
#pragma unroll
        for (int j = 0; j < 8; ++j) ss += kf[j] * kf[j];
        ss += __shfl_xor(ss, 1); ss += __shfl_xor(ss, 2); ss += __shfl_xor(ss, 4);
        const float rstd = rsqrtf(ss * (1.0f / 64.f) + EPS);
#pragma unroll
        for (int j = 0; j < 8; ++j) kf[j] = kf[j] * rstd * kn[part * 8 + j];
        if (kk < 255) {
            *(LAS f32x4*)(Kw + kk * 68 + part * 8) = (f32x4){kf[0], kf[1], kf[2], kf[3]}; *(LAS f32x4*)(Kw + kk * 68 + part * 8 + 4) = (f32x4){kf[4], kf[5], kf[6], kf[7]};
            *(LAS f32x4*)(Vw + kk * 68 + part * 8) = (f32x4){vf[0], vf[1], vf[2], vf[3]}; *(LAS f32x4*)(Vw + kk * 68 + part * 8 + 4) = (f32x4){vf[4], vf[5], vf[6], vf[7]};
            if (qblk == 127 && kk >= 127) {
                const int w = kk - 127;
                float* ko = a.out + O_SKP + ((size_t)w * 2 + kvh) * 64 + part * 8; float* vo = a.out + O_SVP + ((size_t)w * 2 + kvh) * 64 + part * 8;
                *(f32x4*)ko = (f32x4){kf[0], kf[1], kf[2], kf[3]}; *(f32x4*)(ko + 4) = (f32x4){kf[4], kf[5], kf[6], kf[7]};
                *(f32x4*)vo = (f32x4){vf[0], vf[1], vf[2], vf[3]}; *(f32x4*)(vo + 4) = (f32x4){vf[4], vf[5], vf[6], vf[7]};
            }
        }
    }
    __syncthreads();
    const int g = tid >> 7, qi = tid & 127, hq = kvh * 4 + g; const int t = qblk * 128 + qi;
    float q[64];
    { float ss = 0.f;
#pragma unroll
      for (int p = 0; p < 8; ++p) { const u32x4 qw = *(const u32x4*)(proj + (size_t)t * NPROJ + PQB + hq * 64 + p * 8); unpack8(qw, q + p * 8); }
#pragma unroll
      for (int d = 0; d < 64; ++d) ss += q[d] * q[d];
      const float rstd = rsqrtf(ss * (1.0f / 64.f) + EPS) * 0.125f;
#pragma unroll
      for (int d = 0; d < 64; ++d) q[d] = q[d] * rstd * a.in[I_QNORM][d]; }
    const float slope = exp2f(-(float)(hq + 1));
    float mx = a.in[I_SINKS][hq], l = 1.f;
    float o[64];
#pragma unroll
    for (int d = 0; d < 64; ++d) o[d] = 0.f;
    for (int i = 0; i < 128; ++i) {
        const int kk = qi + i; const int tk = tk0 + kk;
        const LAS float* kr = Kw + kk * 68;
        float s0 = 0.f, s1 = 0.f, s2 = 0.f, s3 = 0.f;
#pragma unroll
        for (int d = 0; d < 64; d += 4) { const f32x4 k4 = *(const LAS f32x4*)(kr + d); s0 += q[d] * k4[0]; s1 += q[d + 1] * k4[1]; s2 += q[d + 2] * k4[2]; s3 += q[d + 3] * k4[3]; }
        float s = (s0 + s1) + (s2 + s3) - slope * (float)(127 - i);
        if (tk < 0) s = -1e30f;
        const float mn = fmaxf(mx, s); const float corr = __expf(mx - mn), p = __expf(s - mn);
        mx = mn; l = l * corr + p;
        const LAS float* vr = Vw + kk * 68;
#pragma unroll
        for (int d = 0; d < 64; d += 4) { const f32x4 v4 = *(const LAS f32x4*)(vr + d); o[d] = o[d] * corr + p * v4[0]; o[d + 1] = o[d + 1] * corr + p * v4[1]; o[d + 2] = o[d + 2] * corr + p * v4[2]; o[d + 3] = o[d + 3] * corr + p * v4[3]; }
    }
    const float inv = 1.f / l;
#pragma unroll
    for (int p = 0; p < 8; ++p) { u32x4 w; w.x = cvt_pk_bf16(o[p * 8] * inv, o[p * 8 + 1] * inv); w.y = cvt_pk_bf16(o[p * 8 + 2] * inv, o[p * 8 + 3] * inv);
        w.z = cvt_pk_bf16(o[p * 8 + 4] * inv, o[p * 8 + 5] * inv); w.w = cvt_pk_bf16(o[p * 8 + 6] * inv, o[p * 8 + 7] * inv);
        *(u32x4*)(mix + (size_t)t * D + 512 + hq * 64 + p * 8) = w; }
    __syncthreads();
}
__device__ __forceinline__ void swa_decode_item(const KArgs& a, int item, int lane) {
    const int b = item >> 3, kvh = (item >> 2) & 1, g = item & 3, hq = kvh * 4 + g; const int row = SROW + b;
    const bf16_t* proj = (const bf16_t*)(a.ws + WS_BIG);
    bf16_t* mix = (bf16_t*)(a.ws + WS_R1);
    const float* ck = a.in[I_CK] + (size_t)b * 128 * 128 + kvh * 64;
    const float* cv = a.in[I_CV] + (size_t)b * 128 * 128 + kvh * 64;
    float qd = bf2f(proj[(size_t)row * NPROJ + PQB + hq * 64 + lane]);
    { const float ss = wave_sum(qd * qd); qd = qd * rsqrtf(ss * (1.0f / 64.f) + EPS) * a.in[I_QNORM][lane] * 0.125f; }
    float kd = bf2f(proj[(size_t)row * NPROJ + PKB + kvh * 64 + lane]);
    { const float ss = wave_sum(kd * kd); kd = kd * rsqrtf(ss * (1.0f / 64.f) + EPS) * a.in[I_KNORM][lane]; }
    const float vd = bf2f(proj[(size_t)row * NPROJ + PVB + kvh * 64 + lane]);
    const float slope = exp2f(-(float)(hq + 1));
    float s0 = 0.f, s1 = 0.f;
    for (int d = 0; d < 64; d += 4) {
        const f32x4 k0 = *(const f32x4*)(ck + (size_t)lane * 128 + d), k1 = *(const f32x4*)(ck + (size_t)(lane + 64) * 128 + d);
        const float q0 = __shfl(qd, d), q1 = __shfl(qd, d + 1), q2 = __shfl(qd, d + 2), q3 = __shfl(qd, d + 3);
        s0 += (q0 * k0[0] + q1 * k0[1]) + (q2 * k0[2] + q3 * k0[3]);
        s1 += (q0 * k1[0] + q1 * k1[1]) + (q2 * k1[2] + q3 * k1[3]);
    }
    s0 -= slope * (float)(128 - lane); s1 -= slope * (float)(64 - lane);
    if (lane == 0) s0 = -1e30f;
    const float sn = wave_sum(qd * kd);
    const float sink = a.in[I_SINKS][hq];
    const float mx = fmaxf(fmaxf(wave_max(fmaxf(s0, s1)), sn), sink);
    const float p0 = __expf(s0 - mx), p1 = __expf(s1 - mx), pn = __expf(sn - mx);
    const float l = wave_sum(p0 + p1) + pn + __expf(sink - mx);
    float od = pn * vd;
#pragma unroll 8
    for (int w = 0; w < 64; ++w) { const float pa = __shfl(p0, w), pb = __shfl(p1, w); od += pa * cv[(size_t)w * 128 + lane] + pb * cv[(size_t)(w + 64) * 128 + lane]; }
    od /= l;
    const float oo = __shfl_down(od, 1);
    if ((lane & 1) == 0) *(unsigned*)(mix + (size_t)row * D + 512 + hq * 64 + lane) = cvt_pk_bf16(od, oo);
    if (g == 0) {
        float* ko = a.out + O_SKS + (size_t)b * 128 * 128 + kvh * 64; float* vo = a.out + O_SVS + (size_t)b * 128 * 128 + kvh * 64;
#pragma unroll 4
        for (int w = 0; w < 127; ++w) { ko[(size_t)w * 128 + lane] = ck[(size_t)(w + 1) * 128 + lane]; vo[(size_t)w * 128 + lane] = cv[(size_t)(w + 1) * 128 + lane]; }
        ko[(size_t)127 * 128 + lane] = kd; vo[(size_t)127 * 128 + lane] = vd;
    }
}

__device__ __forceinline__ void pool_item(const KArgs& a, LAS unsigned char* lds, int item, const float* part_in) {
    const int tid = otid();
    const float* h = a.out + O_YP; bf16_t* d1 = (bf16_t*)(a.ws + WS_R1);
    LAS float* rsL = (LAS float*)lds;
    const int r0 = item * 64;
    __syncthreads();
    if (tid < 80) { const int r = r0 - 16 + tid; float rs = 0.f;
        if (r >= 0) { float s = 0.f;
#pragma unroll
            for (int i = 0; i < 16; ++i) s += part_in[(long)r * 16 + i];
            rs = rsqrtf(s * (1.0f / D) + EPS); }
        rsL[tid] = rs; }
    __syncthreads();
#pragma unroll
    for (int cc = 0; cc < 2; ++cc) {
        const int c = tid + cc * NTHREADS; const int w = 2 << (c >> 8);
        const float gg = a.in[I_MNO][c];
        float s = 0.f;
        for (int r = r0 - w + 1; r < r0; ++r) if (r >= 0) s += h[(size_t)r * D + c] * rsL[r - r0 + 16] * gg;
        for (int r = r0; r < r0 + 64; ++r) {
            const float xn = h[(size_t)r * D + c] * rsL[r - r0 + 16] * gg;
            s += xn;
            const int cnt = (r + 1 < w) ? r + 1 : w;
            const float dd = s / (float)cnt - xn;
            d1[(size_t)r * D + c] = (bf16_t)(cvt_pk_bf16(dd, 0.f) & 0xffffu);
            const int ro = r - w + 1;
            if (ro >= 0) s -= h[(size_t)ro * D + c] * rsL[ro - r0 + 16] * gg;
            if (r >= SEQ - 15) a.out[O_POOLP + (size_t)(r - (SEQ - 15)) * D + c] = xn;
        }
    }
}
__device__ __forceinline__ void pool_sample_item(const KArgs& a, LAS unsigned char* lds, int b, const float* part_in) {
    const int tid = otid();
    const float* h = a.out + O_YS + (size_t)b * D; bf16_t* d1 = (bf16_t*)(a.ws + WS_R1);
    const float* st = a.in[I_SPOOL] + (size_t)b * 15 * D; float* so = a.out + O_POOLS + (size_t)b * 15 * D;
    float s = 0.f;
#pragma unroll
    for (int i = 0; i < 16; ++i) s += part_in[(long)(SROW + b) * 16 + i];
    const float rs = rsqrtf(s * (1.0f / D) + EPS);
#pragma unroll
    for (int cc = 0; cc < 2; ++cc) {
        const int c = tid + cc * NTHREADS; const int w = 2 << (c >> 8);
        const float xn = h[c] * rs * a.in[I_MNO][c];
        float sum = xn;
        for (int j = 16 - w; j < 15; ++j) sum += st[(size_t)j * D + c];
        const float dd = sum / (float)w - xn;
        d1[(size_t)(SROW + b) * D + c] = (bf16_t)(cvt_pk_bf16(dd, 0.f) & 0xffffu);
        for (int j = 0; j < 14; ++j) so[(size_t)j * D + c] = st[(size_t)(j + 1) * D + c];
        so[(size_t)14 * D + c] = xn;
    }
}

#ifndef PHM
#define PHM 0xFFFF
#endif
#define PH(k) if (PHM & (1 << (k)))
__global__ void __launch_bounds__(NTHREADS, 2) mega_fwd(KArgs a) {
    extern __shared__ __attribute__((aligned(16))) unsigned char lds_raw[];
    LAS unsigned char* lds = (LAS unsigned char*)lds_raw;
    cg::grid_group grid = cg::this_grid();
    const int G = gridDim.x, bx = blockIdx.x;
    const int vcu = (G % 8 == 0) ? (bx % 8) * (G / 8) + bx / 8 : bx;
    unsigned char* ws = a.ws;
    bf16_t* R1 = (bf16_t*)(ws + WS_R1); bf16_t* R2 = (bf16_t*)(ws + WS_R2 + 4096);
    bf16_t* BIGB = (bf16_t*)(ws + WS_BIG);
    const bf16_t* pbf = (const bf16_t*)(ws + WS_PBF);

    PH(0) p0_prologue(a, lds, vcu, G);
    grid.sync();
    PH(1) {
        pg8::Gemm g{R1, (const bf16_t*)(ws + WS_WIN0), 1024, 1024, 1024, 256, 0, 0};
        pg8::StaticOrder S; S.init(65, 10, G, bx);
        EpiProj E{BIGB, (float*)(ws + WS_BIG + BIG_LA), (const float*)(ws + WS_SSQ), a.in[I_BALPHA]};
        pg8::gemm_phase(lds, g, S, E);
    }
    grid.sync();
    PH(2) for (int it = vcu; it < 1024; it += G) gla_u_item(a, lds, it);
    PH(3) for (int it = vcu; it < 256; it += G) swa_unit(a, lds, it);
    PH(4) { const int tid = otid(), lane = tid & 63, wave = __builtin_amdgcn_readfirstlane(tid >> 6); for (int it = vcu * 8 + wave; it < 512; it += G * 8) gla_decode_item(a, it, lane); }
    PH(5) { const int tid = otid(), lane = tid & 63, wave = __builtin_amdgcn_readfirstlane(tid >> 6); for (int it = vcu * 8 + wave; it < 1024; it += G * 8) swa_decode_item(a, it, lane); }
    grid.sync();
    PH(6) gla_scan(a, vcu);
    grid.sync();
    PH(7) for (int it = vcu; it < 1024; it += G) gla_o_item(a, lds, it);
    grid.sync();
    PH(8) {
        pg8::Gemm g{R1, (const bf16_t*)(ws + WS_WOUT0), 1024, 1024, 1024, 256, 0, 0};
        pg8::StaticOrder S; S.init(65, 4, G, bx);
        EpiRes<0, true, true> E{a.out, a.in[I_XP], a.in[I_XS], R2, part_tab(ws, 0), nullptr, nullptr, nullptr};
        pg8::gemm_phase(lds, g, S, E);
    }
    grid.sync();
#pragma unroll 1
    for (int l = 0; l < 2; ++l) {
        bf16_t* G_ = BIGB;
        bf16_t* PPb = BIGB;
        PH(9) {
            pg8::Gemm g{R2, (const bf16_t*)(ws + WS_WFFI + l * WFFI_BYTES), 1024, 1024, 1024, 254, -2, 0};
            pg8::StaticOrder S; S.init(66, 22, G, bx);
            EpiFfn E{part_tab(ws, l == 0 ? 0 : 3), a.in[I_FCW] + (size_t)l * 3 * DFF, a.in[I_FCB] + (size_t)l * DFF, a.in[I_SCONV] + (size_t)l * NS * 2 * DFF,
                     a.out + O_CONVP + (size_t)l * 2 * DFF, a.out + O_CONVS + (size_t)l * NS * 2 * DFF, G_};
            pg8::gemm_phase(lds, g, S, E);
        }
        grid.sync();
        PH(10) {
            pg8::Gemm g{G_, (const bf16_t*)(ws + WS_WFFO + l * WFFO_BYTES), DFF, DFF, DFF, 256, 0, 0};
            pg8::StaticOrder S; S.init(65, 4, G, bx);
            EpiRes<1, true, true> E{a.out, nullptr, nullptr, R1, part_tab(ws, l == 0 ? 1 : 4), nullptr, nullptr, nullptr};
            pg8::gemm_phase(lds, g, S, E);
        }
        grid.sync();
        PH(11) {
            pg8::Gemm g{pbf + (size_t)l * MT * PLE, (const bf16_t*)(ws + WS_WPROJ + l * WPROJ_BYTES), PLE, PLE, PLE, 256, 0, 0};
            pg8::StaticOrder S; S.init(65, 4, G, bx);
            EpiPP E{PPb};
            pg8::gemm_phase(lds, g, S, E);
        }
        PH(12) {
            pg8::Gemm g{R1, (const bf16_t*)(ws + WS_WGATE + l * WGATE_BYTES), 1024, 1024, 1024, 256, 0, 0};
            pg8::StaticOrder S; S.init(65, 4, G, bx);
            if (l == 0) { EpiRes<2, false, true> E{a.out, nullptr, nullptr, nullptr, part_tab(ws, 2), part_tab(ws, 1), PPb, nullptr}; pg8::gemm_phase(lds, g, S, E); }
            else { EpiRes<2, false, false> E{a.out, nullptr, nullptr, nullptr, nullptr, part_tab(ws, 4), PPb, nullptr}; pg8::gemm_phase(lds, g, S, E); }
        }
        if (l == 0) {
            grid.sync();
            PH(13) for (int it = vcu; it < 256 + NS; it += G) { if (it < 256) pool_item(a, lds, it, part_tab(ws, 2)); else pool_sample_item(a, lds, it - 256, part_tab(ws, 2)); }
            grid.sync();
            PH(14) {
                pg8::Gemm g{R1, (const bf16_t*)(ws + WS_WPOOL), 1024, 256, 256, 256, 0, 256};
                pg8::StaticOrder S; S.init(65, 4, G, bx);
                EpiRes<3, true, true> E{a.out, nullptr, nullptr, R2, part_tab(ws, 3), nullptr, nullptr, a.in[I_POOLSC]};
                pg8::gemm_phase(lds, g, S, E);
            }
            grid.sync();
        }
    }
}

extern "C" void kernel_launch(void* const* d_in, const int* in_sizes, int n_in, void* d_out, int out_size, void* d_ws, size_t ws_size, hipStream_t stream) {
    static int grid = 0;
    if (grid == 0) {
        int dev = 0, cus = 0, per_cu = 0;
        hipGetDevice(&dev);
        hipDeviceGetAttribute(&cus, hipDeviceAttributeMultiprocessorCount, dev);
        hipFuncSetAttribute((const void*)mega_fwd, hipFuncAttributeMaxDynamicSharedMemorySize, LDS_BYTES);
        hipOccupancyMaxActiveBlocksPerMultiprocessor(&per_cu, (const void*)mega_fwd, NTHREADS, LDS_BYTES);
        if (per_cu < 1) { fprintf(stderr, "kernel_launch: occupancy query reports %d blocks per CU\n", per_cu); per_cu = 1; }
        if (per_cu > 1) per_cu = 1;
        grid = cus * per_cu;
        (void)hipGetLastError();
    }
    KArgs a{};
    for (int i = 0; i < 29; ++i) a.in[i] = (const float*)d_in[i];
    a.out = (float*)d_out; a.ws = (unsigned char*)d_ws;
    void* args[] = {&a};
    hipError_t e = hipLaunchCooperativeKernel((const void*)mega_fwd, dim3(grid), dim3(NTHREADS), args, LDS_BYTES, stream);
    if (e != hipSuccess) fprintf(stderr, "cooperative launch failed: %s (grid %d)\n", hipGetErrorString(e), grid);
}
```

```cpp
#include <hip/hip_runtime.h>
#include <hip/hip_cooperative_groups.h>
#include <cstdio>
#include <cstdint>
namespace cg = cooperative_groups;

#define LAS __attribute__((address_space(3)))
typedef unsigned short bf16_t;
typedef short bf16x8 __attribute__((ext_vector_type(8)));
typedef float f32x4 __attribute__((ext_vector_type(4)));
typedef float f32x2 __attribute__((ext_vector_type(2)));
typedef unsigned u32x4 __attribute__((ext_vector_type(4)));
typedef unsigned u32x2 __attribute__((ext_vector_type(2)));

constexpr int D = 1024, SEQ = 16384, NS = 128, DFF = 2816, PLE = 256;
constexpr int SROW = 16510;
constexpr int MT = 16640;
constexpr int MR = 16768;
constexpr int NPROJ = 2304;
constexpr int PQA = 0, PKA = 256, PVA = 512, PRA = 1024, PQB = 1536, PKB = 2048, PVB = 2176;
constexpr float EPS = 1e-6f;
constexpr int NTHREADS = 512;

constexpr size_t O_YP = 0, O_YS = 16777216, O_GLAP = 16908288, O_SKP = 16941056, O_SVP = 16957440, O_POOLP = 16973824, O_CONVP = 16989184,
                 O_GLAS = 17000448, O_SKS = 21194752, O_SVS = 23291904, O_POOLS = 25389056, O_CONVS = 27355136;

constexpr size_t MiB = 1u << 20;
constexpr size_t WS_WIN0 = 1 * MiB, WS_WOUT0 = 6 * MiB, WS_WFFI = 8 * MiB, WS_WFFO = 30 * MiB, WS_WGATE = 41 * MiB, WS_WPROJ = 45 * MiB, WS_WPOOL = 46 * MiB;
constexpr size_t WS_SSQ = 47 * MiB;
constexpr size_t WS_PBF = 55 * MiB, WS_R1 = 72 * MiB, WS_R2 = 105 * MiB, WS_BIG = 138 * MiB;
constexpr size_t PART_STRIDE = (size_t)(MR + 8) * 16 * 4;
constexpr size_t WFFI_BYTES = (size_t)5632 * 1024 * 2, WFFO_BYTES = (size_t)1024 * 2816 * 2, WGATE_BYTES = (size_t)1024 * 1024 * 2, WPROJ_BYTES = (size_t)1024 * 256 * 2;
constexpr size_t BIG_LA = (size_t)MT * NPROJ * 2;
constexpr int LDS_BYTES = 155648;

__device__ __forceinline__ unsigned cvt_pk_bf16(float lo, float hi) { unsigned r; asm volatile("v_cvt_pk_bf16_f32 %0, %1, %2" : "=v"(r) : "v"(lo), "v"(hi)); return r; }
__device__ __forceinline__ float bf_lo(unsigned w) { return __uint_as_float(w << 16); }
__device__ __forceinline__ float bf_hi(unsigned w) { return __uint_as_float(w & 0xffff0000u); }
__device__ __forceinline__ float bf2f(bf16_t v) { return __uint_as_float(((unsigned)v) << 16); }
__device__ __forceinline__ void unpack8(const u32x4 w, float* f) { f[0] = bf_lo(w.x); f[1] = bf_hi(w.x); f[2] = bf_lo(w.y); f[3] = bf_hi(w.y); f[4] = bf_lo(w.z); f[5] = bf_hi(w.z); f[6] = bf_lo(w.w); f[7] = bf_hi(w.w); }
__device__ __forceinline__ float wave_sum(float v) {
#pragma unroll
    for (int o = 1; o < 64; o <<= 1) v += __shfl_xor(v, o);
    return v;
}
__device__ __forceinline__ float wave_max(float v) {
#pragma unroll
    for (int o = 1; o < 64; o <<= 1) v = fmaxf(v, __shfl_xor(v, o));
    return v;
}
__device__ __forceinline__ int otid() { int t = threadIdx.x; asm volatile("" : "+v"(t)); return t; }
__device__ __forceinline__ bool row_valid(int row) { return row < SEQ || (row >= SROW && row < SROW + NS); }
__device__ __forceinline__ float* hrow_ptr(float* out, int row) { return row < SEQ ? out + O_YP + (size_t)row * D : out + O_YS + (size_t)(row - SROW) * D; }
__device__ __forceinline__ f32x2 gelu_pk(f32x2 v) {
    const f32x2 av = __builtin_elementwise_abs(v), d = av * 0.2316418882f + 1.0f;
    f32x2 t; t.x = __builtin_amdgcn_rcpf(d.x); t.y = __builtin_amdgcn_rcpf(d.y);
    f32x2 q = t * 0.5307027145f + (-0.7265760135f); q = q * t + 0.7107068705f; q = q * t + (-0.142248368f); q = q * t + 0.127414796f; q = q * t;
    const f32x2 s = (v * v) * (-0.72134752044f);
    f32x2 e; e.x = __builtin_amdgcn_exp2f(s.x); e.y = __builtin_amdgcn_exp2f(s.y);
    const f32x2 m = v * (q * e), r = v - m;
    f32x2 o; o.x = v.x < 0.f ? m.x : r.x; o.y = v.y < 0.f ? m.y : r.y; return o;
}

namespace pg8 {
constexpr int BM = 256, BK = 64, HALF = 128, HTB = HALF * BK * 2, STAGE_BYTES = 8 * HTB, NXCD = 8, WGM = 8;
__host__ __device__ __forceinline__ int lds_byte(int r, int c) { const int st = (r >> 4) * 2 + (c >> 5), rr = r & 15, cc = c & 31, ob = rr * 64 + cc * 2; return st * 1024 + (ob ^ (((ob >> 9) & 1) << 5)); }
__host__ __device__ __forceinline__ void stage_rc(int b, int& R, int& C) { const int st = b / 1024, sb = b % 1024, swz = sb ^ (((sb >> 9) & 1) << 5); R = (st >> 1) * 16 + swz / 64; C = (st & 1) * 32 + (swz % 64) / 2; }
__host__ __device__ __forceinline__ int perm32(int rho) { const int n = rho >> 4, i = rho & 15; return 8 * (i >> 2) + 4 * n + (i & 3); }

struct Unit { int pm, pn; };
struct Gemm { const bf16_t* A; const bf16_t* Bt; int lda, ldb, K, mstride, arow0, acolstep; };

struct StaticOrder {
    int nM, nN, nwg, G, c;
    __device__ void init(int nM_, int nN_, int G_, int c_) { nM = nM_; nN = nN_; nwg = nM * nN; G = G_; c = c_; }
    __device__ bool next(int i, Unit& u) const {
        const long L = (long)i * G + c; if (L >= nwg) return false;
        int wgid = (int)L; { const int q = nwg / NXCD, r = nwg % NXCD, xcd = wgid % NXCD, off = wgid / NXCD; wgid = (xcd < r ? xcd * (q + 1) : r * (q + 1) + (xcd - r) * q) + off; }
        const int nig = WGM * nN, gid = wgid / nig, fm = gid * WGM, gsz = (nM - fm) < WGM ? (nM - fm) : WGM;
        u.pm = fm + ((wgid % nig) % gsz); u.pn = (wgid % nig) / gsz; return true;
    }
};

template <class Epi>
__device__ __forceinline__ void gemm_phase(LAS unsigned char* lds, const Gemm g, const StaticOrder& S, const Epi& E) {
    const int tid = otid(), wid = __builtin_amdgcn_readfirstlane(tid >> 6), lane = tid & 63, wr = wid >> 2, wc = wid & 3, fr = lane & 15, fq = lane >> 4;
    const int K = g.K, nt = K / BK;
    unsigned voffA[2], voffB[2];
#pragma unroll
    for (int i = 0; i < 2; ++i) { int R, C; stage_rc(tid * 16 + i * 8192, R, C); const int Rb = (R & ~31) + perm32(R & 31);
        voffA[i] = (unsigned)(R * g.lda + C) * 2u; voffB[i] = (unsigned)(Rb * g.ldb + C) * 2u; }
    const size_t kstep = (size_t)(BK * 2);
    const size_t hstepA = (size_t)HALF * g.lda * 2, hstepB = (size_t)HALF * g.ldb * 2;
    const unsigned ldsw = (unsigned)wid * 1024u;
    const int aoff = lds_byte(wr * 64 + fr, fq * 8), boff = lds_byte(wc * 32 + fr, fq * 8);
#define PG8_SA(b, h) (((b) * 2 + (h)) * HTB)
#define PG8_SB(b, h) ((4 + (b) * 2 + (h)) * HTB)
#define PG8_STAGE(bufoff, gbase, voff) do { _Pragma("unroll") for (int _i = 0; _i < 2; ++_i) \
        __builtin_amdgcn_global_load_lds((const unsigned*)((const char*)(gbase) + (voff)[_i]), (LAS unsigned*)(lds + (bufoff) + ldsw + _i * 8192), 16, 0, 0); } while (0)
#define PG8_LDA(dst, b, h) do { _Pragma("unroll") for (int m = 0; m < 4; ++m) _Pragma("unroll") for (int k = 0; k < 2; ++k) dst[m][k] = *(const LAS bf16x8*)(lds + PG8_SA(b, h) + aoff + m * 2048 + k * 1024); } while (0)
#define PG8_LDB(dst, b, h) do { _Pragma("unroll") for (int n = 0; n < 2; ++n) _Pragma("unroll") for (int k = 0; k < 2; ++k) dst[n][k] = *(const LAS bf16x8*)(lds + PG8_SB(b, h) + boff + n * 2048 + k * 1024); } while (0)
#define PG8_MMA(ai, bj, At, Bt) do { __builtin_amdgcn_s_setprio(1); _Pragma("unroll") for (int m = 0; m < 4; ++m) _Pragma("unroll") for (int n = 0; n < 2; ++n) _Pragma("unroll") for (int k = 0; k < 2; ++k) \
        acc[ai][bj][m][n] = __builtin_amdgcn_mfma_f32_16x16x32_bf16(Bt[n][k], At[m][k], acc[ai][bj][m][n], 0, 0, 0); __builtin_amdgcn_s_setprio(0); } while (0)
#define PG8_WAIT_V(n) asm volatile("s_waitcnt vmcnt(" #n ")" ::: "memory")
#define PG8_WAIT_L(n) asm volatile("s_waitcnt lgkmcnt(" #n ")" ::: "memory")
#define PG8_BAR __builtin_amdgcn_s_barrier()
#define PG8_SCHED __builtin_amdgcn_sched_barrier(0)
#define PG8_ABASE(u) ((const char*)g.A + ((long)((long)(u).pm * g.mstride + g.arow0) * g.lda + (long)(u).pn * g.acolstep) * 2)
#define PG8_BBASE(u) ((const char*)g.Bt + (size_t)(u).pn * 256 * g.ldb * 2)
    Unit cur, nxt; int ui = 0;
    if (!S.next(0, cur)) return;
    f32x4 acc[2][2][4][2];
#pragma unroll
    for (int a = 0; a < 2; ++a)
#pragma unroll
        for (int b = 0; b < 2; ++b)
#pragma unroll
            for (int m = 0; m < 4; ++m)
#pragma unroll
                for (int n = 0; n < 2; ++n) acc[a][b][m][n] = (f32x4){0.f, 0.f, 0.f, 0.f};
    bf16x8 At[4][2], B0[2][2], B1[2][2];
    const char* cA = PG8_ABASE(cur); const char* cB = PG8_BBASE(cur);
    PG8_STAGE(PG8_SB(0, 0), cB, voffB); PG8_STAGE(PG8_SB(0, 1), cB + hstepB, voffB); PG8_STAGE(PG8_SA(0, 0), cA, voffA); PG8_STAGE(PG8_SA(0, 1), cA + hstepA, voffA);
    if (wr == 1) PG8_BAR;
    PG8_WAIT_V(2); PG8_BAR;
    PG8_STAGE(PG8_SB(1, 0), cB + kstep, voffB); PG8_STAGE(PG8_SA(1, 0), cA + kstep, voffA); PG8_STAGE(PG8_SB(1, 1), cB + hstepB + kstep, voffB);
    PG8_WAIT_V(6); PG8_BAR;
    for (;;) {
        const bool has_next = S.next(ui + 1, nxt);
        const char* nA = has_next ? PG8_ABASE(nxt) : cA; const char* nB = has_next ? PG8_BBASE(nxt) : cB;
#pragma unroll 1
        for (int t = 0; t < nt; t += 2) {
            const bool last = (t == nt - 2);
            const char* a1 = cA + (size_t)(t + 1) * kstep;
            const char* a2 = last ? nA : cA + (size_t)(t + 2) * kstep; const char* b2 = last ? nB : cB + (size_t)(t + 2) * kstep;
            const char* a3 = a2 + kstep; const char* b3 = b2 + kstep;
            PG8_LDB(B0, 0, 0); PG8_LDB(B1, 0, 1); PG8_SCHED; PG8_LDA(At, 0, 0); PG8_STAGE(PG8_SA(1, 1), a1 + hstepA, voffA);
            PG8_WAIT_V(8); PG8_WAIT_L(0); PG8_BAR; PG8_MMA(0, 0, At, B0); PG8_MMA(0, 1, At, B1); PG8_BAR; PG8_SCHED;
            PG8_LDA(At, 0, 1); PG8_STAGE(PG8_SB(0, 0), b2, voffB); PG8_STAGE(PG8_SB(0, 1), b2 + hstepB, voffB); PG8_STAGE(PG8_SA(0, 0), a2, voffA);
            PG8_WAIT_V(8); PG8_WAIT_L(0); PG8_BAR; PG8_MMA(1, 0, At, B0); PG8_MMA(1, 1, At, B1); PG8_BAR; PG8_SCHED;
            PG8_LDB(B0, 1, 0); PG8_LDB(B1, 1, 1); PG8_SCHED; PG8_LDA(At, 1, 0); PG8_STAGE(PG8_SA(0, 1), a2 + hstepA, voffA);
            PG8_WAIT_V(8); PG8_WAIT_L(0); PG8_BAR; PG8_MMA(0, 0, At, B0); PG8_MMA(0, 1, At, B1); PG8_BAR; PG8_SCHED;
            PG8_LDA(At, 1, 1); PG8_STAGE(PG8_SB(1, 0), b3, voffB); PG8_STAGE(PG8_SB(1, 1), b3 + hstepB, voffB); PG8_STAGE(PG8_SA(1, 0), a3, voffA);
            PG8_WAIT_V(8); PG8_WAIT_L(0); PG8_BAR; PG8_MMA(1, 0, At, B0); PG8_MMA(1, 1, At, B1); PG8_BAR; PG8_SCHED;
        }
        if (wr == 0) PG8_BAR;
        { int lane2 = lane; asm volatile("" : "+v"(lane2)); E(acc, cur, wr, wc, lane2 & 15, lane2 >> 4, lds + STAGE_BYTES); }
        if (!has_next) break;
#pragma unroll
        for (int a = 0; a < 2; ++a)
#pragma unroll
            for (int b = 0; b < 2; ++b)
#pragma unroll
                for (int m = 0; m < 4; ++m)
#pragma unroll
                    for (int n = 0; n < 2; ++n) acc[a][b][m][n] = (f32x4){0.f, 0.f, 0.f, 0.f};
        cur = nxt; cA = nA; cB = nB; ++ui;
        if (wr == 1) PG8_BAR;
    }
    PG8_WAIT_V(0);
    PG8_BAR;
#undef PG8_SA
#undef PG8_SB
#undef PG8_STAGE
#undef PG8_LDA
#undef PG8_LDB
#undef PG8_MMA
#undef PG8_WAIT_V
#undef PG8_WAIT_L
#undef PG8_BAR
#undef PG8_SCHED
#undef PG8_ABASE
#undef PG8_BBASE
}
}
using pg8::Unit;
typedef f32x4 AccT[2][2][4][2];

__device__ __forceinline__ float row_rs(const float* part, int row, int fq) {
    const f32x4 p = *(const f32x4*)(part + (long)row * 16 + fq * 4);
    float s = (p[0] + p[1]) + (p[2] + p[3]);
    s += __shfl_xor(s, 16); s += __shfl_xor(s, 32);
    return rsqrtf(s * (1.0f / D) + EPS);
}

struct EpiProj {
    bf16_t* proj; float* la; const float* ssq0; const float* b_alpha;
    __device__ __forceinline__ void operator()(const AccT& acc, const Unit& u, int wr, int wc, int fr, int fq, LAS unsigned char*) const {
#pragma unroll
        for (int ai = 0; ai < 2; ++ai)
#pragma unroll
            for (int m = 0; m < 4; ++m) {
                const int row = u.pm * 256 + ai * 128 + wr * 64 + m * 16 + fr;
                const float rs = rsqrtf(ssq0[row] * (1.0f / D) + EPS);
#pragma unroll
                for (int bj = 0; bj < 2; ++bj) {
                    const int col = u.pn * 256 + bj * 128 + wc * 32 + fq * 8;
                    const f32x4 v0 = acc[ai][bj][m][0] * rs, v1 = acc[ai][bj][m][1] * rs;
                    if (u.pn < 9) {
                        u32x4 w; w.x = cvt_pk_bf16(v0[0], v0[1]); w.y = cvt_pk_bf16(v0[2], v0[3]); w.z = cvt_pk_bf16(v1[0], v1[1]); w.w = cvt_pk_bf16(v1[2], v1[3]);
                        *(u32x4*)(proj + (size_t)row * NPROJ + col) = w;
                    } else {
                        const int c = col - NPROJ;
                        const f32x4 b0 = *(const f32x4*)(b_alpha + c), b1 = *(const f32x4*)(b_alpha + c + 4);
                        f32x4 o0, o1;
#pragma unroll
                        for (int j = 0; j < 4; ++j) {
                            const float z0 = v0[j] + b0[j], z1 = v1[j] + b1[j];
                            o0[j] = (fminf(z0, 0.f) - log1pf(__expf(-fabsf(z0)))) * 0.0625f;
                            o1[j] = (fminf(z1, 0.f) - log1pf(__expf(-fabsf(z1)))) * 0.0625f;
                        }
                        *(f32x4*)(la + (size_t)row * 256 + c) = o0; *(f32x4*)(la + (size_t)row * 256 + c + 4) = o1;
                    }
                }
            }
    }
};
struct EpiPP {
    bf16_t* pp;
    __device__ __forceinline__ void operator()(const AccT& acc, const Unit& u, int wr, int wc, int fr, int fq, LAS unsigned char*) const {
#pragma unroll
        for (int ai = 0; ai < 2; ++ai)
#pragma unroll
            for (int m = 0; m < 4; ++m) {
                const int row = u.pm * 256 + ai * 128 + wr * 64 + m * 16 + fr;
#pragma unroll
                for (int bj = 0; bj < 2; ++bj) {
                    const int col = u.pn * 256 + bj * 128 + wc * 32 + fq * 8;
                    const f32x4 v0 = acc[ai][bj][m][0], v1 = acc[ai][bj][m][1];
                    u32x4 w; w.x = cvt_pk_bf16(v0[0], v0[1]); w.y = cvt_pk_bf16(v0[2], v0[3]); w.z = cvt_pk_bf16(v1[0], v1[1]); w.w = cvt_pk_bf16(v1[2], v1[3]);
                    *(u32x4*)(pp + (size_t)row * D + col) = w;
                }
            }
    }
};
template <int MODE, bool WRITE_HB, bool WRITE_PART>
struct EpiRes {
    float* out; const float* xp; const float* xs; bf16_t* hb; float* part; const float* part_in; const bf16_t* pp; const float* scale;
    __device__ __forceinline__ void operator()(const AccT& acc, const Unit& u, int wr, int wc, int fr, int fq, LAS unsigned char*) const {
#pragma unroll
        for (int ai = 0; ai < 2; ++ai)
#pragma unroll
            for (int m = 0; m < 4; ++m) {
                const int row = u.pm * 256 + ai * 128 + wr * 64 + m * 16 + fr;
                const bool valid = row_valid(row);
                float rs = 1.f;
                if (MODE == 2) rs = row_rs(part_in, row, fq);
                float sq = 0.f;
                float* hp = hrow_ptr(out, valid ? row : 0);
                const float* bp = hp;
                if (MODE == 0) bp = (row < SEQ) ? xp + (size_t)row * D : xs + (size_t)((valid ? row : SROW) - SROW) * D;
#pragma unroll
                for (int bj = 0; bj < 2; ++bj) {
                    const int col = u.pn * 256 + bj * 128 + wc * 32 + fq * 8;
                    f32x4 v0 = acc[ai][bj][m][0], v1 = acc[ai][bj][m][1];
                    if (MODE == 2) {
                        const u32x4 pw = *(const u32x4*)(pp + (size_t)row * D + col);
                        float pf[8]; unpack8(pw, pf);
#pragma unroll
                        for (int j = 0; j < 4; ++j) {
                            v0[j] = pf[j] / (1.f + __expf(-v0[j] * rs));
                            v1[j] = pf[4 + j] / (1.f + __expf(-v1[j] * rs));
                        }
                    }
                    if (MODE == 3) { v0 = v0 * *(const f32x4*)(scale + col); v1 = v1 * *(const f32x4*)(scale + col + 4); }
                    if (valid) {
                        const f32x4 h0 = *(const f32x4*)(bp + col) + v0, h1 = *(const f32x4*)(bp + col + 4) + v1;
                        *(f32x4*)(hp + col) = h0; *(f32x4*)(hp + col + 4) = h1;
                        if (WRITE_HB) { u32x4 w; w.x = cvt_pk_bf16(h0[0], h0[1]); w.y = cvt_pk_bf16(h0[2], h0[3]); w.z = cvt_pk_bf16(h1[0], h1[1]); w.w = cvt_pk_bf16(h1[2], h1[3]);
                            *(u32x4*)(hb + (size_t)row * D + col) = w; }
                        sq += (h0[0] * h0[0] + h0[1] * h0[1]) + (h0[2] * h0[2] + h0[3] * h0[3]) + (h1[0] * h1[0] + h1[1] * h1[1]) + (h1[2] * h1[2] + h1[3] * h1[3]);
                    }
                }
                if (WRITE_PART) {
                    sq += __shfl_xor(sq, 16); sq += __shfl_xor(sq, 32);
                    if (fq == 0 && valid) part[(long)row * 16 + u.pn * 4 + wc] = sq;
                }
            }
    }
};
struct EpiFfn {
    const float* part_in; const float* convw; const float* convb; const float* cstate; float* convp_out; float* convs_out; bf16_t* G;
    __device__ __forceinline__ void operator()(AccT& acc, const Unit& u, int wr, int wc, int fr, int fq, LAS unsigned char* ldsx) const {
        const int lane = fr + 16 * fq;
        const int c0 = u.pn * 128 + wc * 32 + fq * 8;
        const bool sample = (u.pm == 65);
#pragma unroll
        for (int ai = 0; ai < 2; ++ai)
#pragma unroll
            for (int m = 0; m < 4; ++m) {
                const int grow = u.pm * 254 - 2 + ai * 128 + wr * 64 + m * 16 + fr;
                const float rs = row_rs(part_in, grow, fq);
#pragma unroll
                for (int bj = 0; bj < 2; ++bj)
#pragma unroll
                    for (int n = 0; n < 2; ++n) acc[ai][bj][m][n] = acc[ai][bj][m][n] * rs;
            }
        LAS f32x4* xch = (LAS f32x4*)ldsx;
        if (fr >= 14) {
#pragma unroll
            for (int ai = 0; ai < 2; ++ai) {
                const int slot = ((((ai * 2 + wr) * 4 + wc) * 4 + fq) * 2 + (fr - 14)) * 2;
                xch[slot] = acc[ai][0][3][0]; xch[slot + 1] = acc[ai][0][3][1];
            }
        }
        asm volatile("s_waitcnt lgkmcnt(0)" ::: "memory"); __builtin_amdgcn_s_barrier(); asm volatile("" ::: "memory");
        const int src1 = (lane & 48) | ((fr + 15) & 15), src2 = (lane & 48) | ((fr + 14) & 15);
#pragma unroll
        for (int n = 0; n < 2; ++n) {
            const int cn = c0 + 4 * n;
            const f32x4 w0 = *(const f32x4*)(convw + cn), w1 = *(const f32x4*)(convw + DFF + cn), w2 = *(const f32x4*)(convw + 2 * DFF + cn), cb = *(const f32x4*)(convb + cn);
#pragma unroll
            for (int ai = 0; ai < 2; ++ai)
#pragma unroll
                for (int m = 0; m < 4; ++m) {
                    const int tr = ai * 128 + wr * 64 + m * 16 + fr;
                    const int grow = u.pm * 254 - 2 + tr;
                    const f32x4 x = acc[ai][0][m][n];
                    f32x4 p;
                    if (m == 0) {
                        const int sa = (wr == 1) ? ai : 0, sw = (wr == 1) ? 0 : 1;
                        const bool has = (wr == 1) || (ai == 1);
                        const int slot = ((((sa * 2 + sw) * 4 + wc) * 4 + fq) * 2 + (fr >= 14 ? fr - 14 : 0)) * 2 + n;
                        p = xch[slot];
                        if (!has) p = (f32x4){0.f, 0.f, 0.f, 0.f};
                    } else p = acc[ai][0][m == 0 ? 0 : m - 1][n];
                    f32x4 p1, p2;
#pragma unroll
                    for (int j = 0; j < 4; ++j) {
                        const float x1 = __shfl(x[j], src1), x2 = __shfl(x[j], src2), q1 = __shfl(p[j], src1), q2 = __shfl(p[j], src2);
                        p1[j] = (fr >= 1) ? x1 : q1;
                        p2[j] = (fr >= 2) ? x2 : q2;
                    }
                    bool store;
                    if (sample) {
                        const int b = tr - 2;
                        store = (b >= 0 && b < NS);
                        if (store) {
                            const float* st = cstate + (size_t)b * 2 * DFF + cn;
                            p2 = *(const f32x4*)(st); p1 = *(const f32x4*)(st + DFF);
                            float* so = convs_out + (size_t)b * 2 * DFF + cn;
                            *(f32x4*)(so) = p1; *(f32x4*)(so + DFF) = x;
                        }
                    } else {
                        store = (tr >= 2 && grow < SEQ);
                        if (grow >= SEQ - 2 && grow < SEQ) *(f32x4*)(convp_out + (size_t)(grow - (SEQ - 2)) * DFF + cn) = x;
                    }
                    const f32x4 ac = cb + w0 * p2 + w1 * p1 + w2 * x;
                    const f32x4 v = acc[ai][1][m][n];
                    const f32x2 g0 = gelu_pk((f32x2){ac[0], ac[1]}), g1 = gelu_pk((f32x2){ac[2], ac[3]});
                    if (store) {
                        u32x2 w; w.x = cvt_pk_bf16(g0.x * v[0], g0.y * v[1]); w.y = cvt_pk_bf16(g1.x * v[2], g1.y * v[3]);
                        *(u32x2*)(G + (size_t)grow * DFF + cn) = w;
                    }
                    asm volatile("" ::: "memory");
                }
        }
    }
};

struct KArgs { const float* in[29]; float* out; unsigned char* ws; };
enum { I_XP = 0, I_XS, I_PP, I_PS, I_SGLA, I_CK, I_CV, I_SPOOL, I_SCONV, I_MNE, I_WIN, I_WALPHA, I_BALPHA, I_ONORM, I_QNORM, I_KNORM, I_SINKS, I_WOUT,
       I_MNO, I_POOLW, I_POOLSC, I_FNORM, I_FWIN, I_FCW, I_FCB, I_FWOUT, I_PNORM, I_PWPROJ, I_PWGATE };

__device__ __forceinline__ float* part_tab(unsigned char* ws, int i) { return (float*)(ws + WS_SSQ + 262144 + (size_t)i * PART_STRIDE) + 2 * 16; }

__device__ __forceinline__ void tr_item(const float* W, int ldsrc, int scol0, int k0, const float* gain, bf16_t* dst, int ldd, int drow0, LAS float* scr, int lane) {
#pragma unroll 8
    for (int i = 0; i < 32; ++i) { const int kk = 2 * i + (lane >> 5); const float gsc = gain ? gain[k0 + kk] : 1.f;
        scr[kk * 33 + (lane & 31)] = W[(size_t)(k0 + kk) * ldsrc + scol0 + (lane & 31)] * gsc; }
    asm volatile("s_waitcnt lgkmcnt(0)" ::: "memory");
    const int c = lane & 7;
#pragma unroll
    for (int j = 0; j < 4; ++j) { const int n = (lane >> 3) + 8 * j; const LAS float* s = scr + (8 * c) * 33 + n;
        u32x4 o; o.x = cvt_pk_bf16(s[0 * 33], s[1 * 33]); o.y = cvt_pk_bf16(s[2 * 33], s[3 * 33]); o.z = cvt_pk_bf16(s[4 * 33], s[5 * 33]); o.w = cvt_pk_bf16(s[6 * 33], s[7 * 33]);
        *(u32x4*)(dst + (size_t)(drow0 + n) * ldd + k0 + 8 * c) = o; }
    asm volatile("s_waitcnt lgkmcnt(0)" ::: "memory");
}
__device__ __forceinline__ void weff_item(const float* Win, const float* wal, int n0, int k0, const float* gain, bf16_t* dst, int drow0, LAS float* scr, int lane) {
#pragma unroll 2
    for (int i = 0; i < 32; ++i) { const int kk = 2 * i + (lane >> 5); const int k = k0 + kk; float s = 0.f;
#pragma unroll
        for (int r = 0; r < 16; ++r) s += Win[(size_t)k * 2320 + 1024 + r] * wal[r * 256 + n0 + (lane & 31)];
        scr[kk * 33 + (lane & 31)] = s * gain[k]; }
    asm volatile("s_waitcnt lgkmcnt(0)" ::: "memory");
    const int c = lane & 7;
#pragma unroll
    for (int j = 0; j < 4; ++j) { const int n = (lane >> 3) + 8 * j; const LAS float* s = scr + (8 * c) * 33 + n;
        u32x4 o; o.x = cvt_pk_bf16(s[0 * 33], s[1 * 33]); o.y = cvt_pk_bf16(s[2 * 33], s[3 * 33]); o.z = cvt_pk_bf16(s[4 * 33], s[5 * 33]); o.w = cvt_pk_bf16(s[6 * 33], s[7 * 33]);
        *(u32x4*)(dst + (size_t)(drow0 + n) * 1024 + k0 + 8 * c) = o; }
    asm volatile("s_waitcnt lgkmcnt(0)" ::: "memory");
}

__device__ __forceinline__ void p0_prologue(const KArgs& a, LAS unsigned char* lds, int vcu, int G) {
    const int tid = otid(), lane = tid & 63, wave = __builtin_amdgcn_readfirstlane(tid >> 6);
    LAS float* scr = (LAS float*)(lds + wave * 16384);
    const int gw = vcu * 8 + wave, NGW = G * 8;
    unsigned char* ws = a.ws;
    constexpr int I_A = 16 * 72, I_E = 16 * 8, I_O = 16 * 32, I_FI = 16 * 176, I_FO = 44 * 32, I_G = 16 * 32, I_P = 4 * 32, I_PL = 4 * 32;
    constexpr int NITEMS = I_A + I_E + I_O + 2 * I_FI + 2 * I_FO + 2 * I_G + 2 * I_P + I_PL;
    for (int it = gw; it < NITEMS; it += NGW) {
        int r = it;
        if (r < I_A) { const int kb = r / 72, nb = r % 72, n0 = nb * 32; tr_item(a.in[I_WIN], 2320, n0 < 1024 ? n0 : n0 + 16, kb * 64, a.in[I_MNE], (bf16_t*)(ws + WS_WIN0), 1024, n0, scr, lane); continue; } r -= I_A;
        if (r < I_E) { const int kb = r / 8, nb = r % 8; weff_item(a.in[I_WIN], a.in[I_WALPHA], nb * 32, kb * 64, a.in[I_MNE], (bf16_t*)(ws + WS_WIN0), NPROJ + nb * 32, scr, lane); continue; } r -= I_E;
        if (r < I_O) { const int kb = r / 32, nb = r % 32; tr_item(a.in[I_WOUT], 1024, nb * 32, kb * 64, nullptr, (bf16_t*)(ws + WS_WOUT0), 1024, nb * 32, scr, lane); continue; } r -= I_O;
        if (r < 2 * I_FI) { const int l = r / I_FI, q = r % I_FI, kb = q / 176, nb = q % 176, n0 = nb * 32;
            const int pn = n0 >> 8, rr = n0 & 255, bj = rr >> 7, ii = rr & 127;
            tr_item(a.in[I_FWIN] + (size_t)l * 1024 * 5632, 5632, bj * DFF + pn * 128 + ii, kb * 64, a.in[I_FNORM] + l * 1024, (bf16_t*)(ws + WS_WFFI + l * WFFI_BYTES), 1024, n0, scr, lane); continue; } r -= 2 * I_FI;
        if (r < 2 * I_FO) { const int l = r / I_FO, q = r % I_FO, kb = q / 32, nb = q % 32;
            tr_item(a.in[I_FWOUT] + (size_t)l * DFF * 1024, 1024, nb * 32, kb * 64, nullptr, (bf16_t*)(ws + WS_WFFO + l * WFFO_BYTES), DFF, nb * 32, scr, lane); continue; } r -= 2 * I_FO;
        if (r < 2 * I_G) { const int l = r / I_G, q = r % I_G, kb = q / 32, nb = q % 32;
            tr_item(a.in[I_PWGATE] + (size_t)l * 1024 * 1024, 1024, nb * 32, kb * 64, a.in[I_PNORM] + l * 1024, (bf16_t*)(ws + WS_WGATE + l * WGATE_BYTES), 1024, nb * 32, scr, lane); continue; } r -= 2 * I_G;
        if (r < 2 * I_P) { const int l = r / I_P, q = r % I_P, kb = q / 32, nb = q % 32;
            tr_item(a.in[I_PWPROJ] + (size_t)l * 256 * 1024, 1024, nb * 32, kb * 64, nullptr, (bf16_t*)(ws + WS_WPROJ + l * WPROJ_BYTES), 256, nb * 32, scr, lane); continue; } r -= 2 * I_P;
        { const int gq = r / 32, q = r % 32, kb = q / 8, nb = q % 8;
            tr_item(a.in[I_POOLW] + (size_t)gq * 65536, 256, nb * 32, kb * 64, nullptr, (bf16_t*)(ws + WS_WPOOL), 256, gq * 256 + nb * 32, scr, lane); }
    }
    bf16_t* xbf = (bf16_t*)(ws + WS_R1);
    float* ssq0 = (float*)(ws + WS_SSQ);
    for (int row = gw; row < MR; row += NGW) {
        const float* src = row < SEQ ? a.in[I_XP] + (size_t)row * D : ((row >= SROW && row < SROW + NS) ? a.in[I_XS] + (size_t)(row - SROW) * D : nullptr);
        float s = 0.f;
#pragma unroll
        for (int j = 0; j < 4; ++j) {
            f32x4 v = (f32x4){0.f, 0.f, 0.f, 0.f};
            if (src) v = *(const f32x4*)(src + j * 256 + lane * 4);
            s += (v[0] * v[0] + v[1] * v[1]) + (v[2] * v[2] + v[3] * v[3]);
            u32x2 w; w.x = cvt_pk_bf16(v[0], v[1]); w.y = cvt_pk_bf16(v[2], v[3]);
            *(u32x2*)(xbf + (size_t)row * D + j * 256 + lane * 4) = w;
        }
        s = wave_sum(s);
        if (lane == 0) ssq0[row] = s;
    }
    bf16_t* pbf = (bf16_t*)(ws + WS_PBF);
    for (int it = gw; it < 2 * MT; it += NGW) {
        const int l = it / MT, row = it % MT;
        const float* src = row < SEQ ? a.in[I_PP] + ((size_t)l * SEQ + row) * PLE : ((row >= SROW && row < SROW + NS) ? a.in[I_PS] + ((size_t)l * NS + (row - SROW)) * PLE : nullptr);
        f32x4 v = (f32x4){0.f, 0.f, 0.f, 0.f};
        if (src) v = *(const f32x4*)(src + lane * 4);
        u32x2 w; w.x = cvt_pk_bf16(v[0], v[1]); w.y = cvt_pk_bf16(v[2], v[3]);
        *(u32x2*)(pbf + (size_t)it * PLE + lane * 4) = w;
    }
    if (vcu == 0) { for (int i = tid; i < 1024; i += NTHREADS) ((u32x4*)(ws + WS_R2))[i] = (u32x4){0u, 0u, 0u, 0u}; }
    {
        u32x4* pt = (u32x4*)(ws + WS_SSQ + 262144);
        const size_t n16 = 6 * PART_STRIDE / 16;
        for (size_t i = (size_t)vcu * NTHREADS + tid; i < n16; i += (size_t)G * NTHREADS) pt[i] = (u32x4){0u, 0u, 0u, 0u};
    }
}

__device__ __forceinline__ void gla_load_b(const float* la, int c, int h, LAS float* bL, int tid) {
#pragma unroll
    for (int i = 0; i < 2; ++i) { const int e = tid + i * NTHREADS; const int t = e >> 4, d4 = (e & 15) * 4;
        *(LAS f32x4*)(bL + t * 64 + d4) = *(const f32x4*)(la + (size_t)(c * 64 + t) * 256 + h * 64 + d4); }
    __syncthreads();
    if (tid < 64) { float s = 0.f;
#pragma unroll 8
        for (int t = 0; t < 64; ++t) { s += bL[t * 64 + tid]; bL[t * 64 + tid] = s; } }
    __syncthreads();
}
__device__ __forceinline__ void gla_u_item(const KArgs& a, LAS unsigned char* lds, int item) {
    const int tid = otid(); const int c = item >> 2, h = item & 3;
    const bf16_t* proj = (const bf16_t*)(a.ws + WS_BIG); const float* la = (const float*)(a.ws + WS_BIG + BIG_LA);
    float* U = (float*)(a.ws + WS_R2 + 4096); float* Dc = U + (size_t)256 * 4 * 64 * 128;
    LAS float* bL = (LAS float*)lds; LAS float* kh = bL + 4096; LAS float* vL = kh + 4096;
    gla_load_b(la, c, h, bL, tid);
    { const int t = tid >> 3, d8 = (tid & 7) * 8;
      const u32x4 kw = *(const u32x4*)(proj + (size_t)(c * 64 + t) * NPROJ + PKA + h * 64 + d8); float kf[8]; unpack8(kw, kf);
#pragma unroll
      for (int j = 0; j < 8; ++j) kh[t * 64 + d8 + j] = kf[j] * __expf(bL[63 * 64 + d8 + j] - bL[t * 64 + d8 + j]);
#pragma unroll
      for (int i = 0; i < 2; ++i) { const int dv8 = d8 + i * 64;
          const u32x4 vw = *(const u32x4*)(proj + (size_t)(c * 64 + t) * NPROJ + PVA + h * 128 + dv8); float vf[8]; unpack8(vw, vf);
#pragma unroll
          for (int j = 0; j < 8; ++j) vL[t * 128 + dv8 + j] = vf[j]; } }
    __syncthreads();
    const int dk4 = (tid >> 5) * 4, dv4 = (tid & 31) * 4;
    f32x4 u0 = {0.f, 0.f, 0.f, 0.f}, u1 = u0, u2 = u0, u3 = u0;
#pragma unroll 4
    for (int t = 0; t < 64; ++t) { const f32x4 kk = *(const LAS f32x4*)(kh + t * 64 + dk4), vv = *(const LAS f32x4*)(vL + t * 128 + dv4);
        u0 += kk[0] * vv; u1 += kk[1] * vv; u2 += kk[2] * vv; u3 += kk[3] * vv; }
    float* up = U + ((size_t)(c * 4 + h) * 64 + dk4) * 128 + dv4;
    *(f32x4*)(up) = u0; *(f32x4*)(up + 128) = u1; *(f32x4*)(up + 256) = u2; *(f32x4*)(up + 384) = u3;
    if (tid < 64) Dc[(c * 4 + h) * 64 + tid] = __expf(bL[63 * 64 + tid]);
    __syncthreads();
}
__device__ __forceinline__ void gla_scan(const KArgs& a, int vcu) {
    const int tid = otid(); if (tid >= 128) return;
    const int e = vcu * 128 + tid; if (e >= 32768) return;
    float* U = (float*)(a.ws + WS_R2 + 4096); const float* Dc = U + (size_t)256 * 4 * 64 * 128;
    const int hd = e >> 7;
    float S = 0.f;
    for (int c0 = 0; c0 < 256; c0 += 8) {
        float u[8], d[8];
#pragma unroll
        for (int j = 0; j < 8; ++j) { u[j] = U[(size_t)(c0 + j) * 32768 + e]; d[j] = Dc[(c0 + j) * 256 + hd]; }
#pragma unroll
        for (int j = 0; j < 8; ++j) { U[(size_t)(c0 + j) * 32768 + e] = S; S = d[j] * S + u[j]; }
    }
    a.out[O_GLAP + e] = S;
}
__device__ __forceinline__ void gla_o_item(const KArgs& a, LAS unsigned char* lds, int item) {
    const int tid = otid(); const int c = item >> 2, h = item & 3;
    const bf16_t* proj = (const bf16_t*)(a.ws + WS_BIG); const float* la = (const float*)(a.ws + WS_BIG + BIG_LA);
    const float* U = (const float*)(a.ws + WS_R2 + 4096);
    bf16_t* mix = (bf16_t*)(a.ws + WS_R1);
    LAS float* bL = (LAS float*)lds; LAS float* qt = bL + 4096; LAS float* kt = qt + 64 * 68; LAS float* vL = kt + 64 * 68; LAS float* SL = vL + 8192; LAS float* att = SL + 8192;
    gla_load_b(la, c, h, bL, tid);
    { const int t = tid >> 3, d8 = (tid & 7) * 8;
      const u32x4 qw = *(const u32x4*)(proj + (size_t)(c * 64 + t) * NPROJ + PQA + h * 64 + d8); float qf[8]; unpack8(qw, qf);
      const u32x4 kw = *(const u32x4*)(proj + (size_t)(c * 64 + t) * NPROJ + PKA + h * 64 + d8); float kf[8]; unpack8(kw, kf);
#pragma unroll
      for (int j = 0; j < 8; ++j) { const float b = bL[t * 64 + d8 + j]; qt[t * 68 + d8 + j] = qf[j] * 0.125f * __expf(b); kt[t * 68 + d8 + j] = kf[j] * __expf(-b); }
#pragma unroll
      for (int i = 0; i < 2; ++i) { const int dv8 = d8 + i * 64;
          const u32x4 vw = *(const u32x4*)(proj + (size_t)(c * 64 + t) * NPROJ + PVA + h * 128 + dv8); float vf[8]; unpack8(vw, vf);
#pragma unroll
          for (int j = 0; j < 8; ++j) vL[t * 128 + dv8 + j] = vf[j]; }
#pragma unroll
      for (int i = 0; i < 4; ++i) { const int e = (tid + i * NTHREADS) * 4; *(LAS f32x4*)(SL + e) = *(const f32x4*)(U + (size_t)(c * 4 + h) * 8192 + e); } }
    __syncthreads();
    { const int i = tid >> 3, j0 = tid & 7;
      float s[8];
#pragma unroll
      for (int jj = 0; jj < 8; ++jj) s[jj] = 0.f;
#pragma unroll 4
      for (int dk = 0; dk < 64; dk += 4) { const f32x4 q4 = *(const LAS f32x4*)(qt + i * 68 + dk);
#pragma unroll
          for (int jj = 0; jj < 8; ++jj) { const f32x4 k4 = *(const LAS f32x4*)(kt + (j0 + 8 * jj) * 68 + dk); s[jj] += (q4[0] * k4[0] + q4[1] * k4[1]) + (q4[2] * k4[2] + q4[3] * k4[3]); } }
#pragma unroll
      for (int jj = 0; jj < 8; ++jj) { const int j = j0 + 8 * jj; att[i * 65 + j] = (j <= i) ? s[jj] : 0.f; } }
    __syncthreads();
    { const int i = tid >> 3, dv0 = (tid & 7) * 16;
      f32x4 o[4];
#pragma unroll
      for (int q = 0; q < 4; ++q) o[q] = (f32x4){0.f, 0.f, 0.f, 0.f};
      for (int j = 0; j <= i; ++j) { const float av = att[i * 65 + j];
#pragma unroll
          for (int q = 0; q < 4; ++q) o[q] += av * *(const LAS f32x4*)(vL + j * 128 + dv0 + q * 4); }
#pragma unroll 4
      for (int dk = 0; dk < 64; ++dk) { const float qv = qt[i * 68 + dk];
#pragma unroll
          for (int q = 0; q < 4; ++q) o[q] += qv * *(const LAS f32x4*)(SL + dk * 128 + dv0 + q * 4); }
      float ss = 0.f;
#pragma unroll
      for (int q = 0; q < 4; ++q) ss += (o[q][0] * o[q][0] + o[q][1] * o[q][1]) + (o[q][2] * o[q][2] + o[q][3] * o[q][3]);
      ss += __shfl_xor(ss, 1); ss += __shfl_xor(ss, 2); ss += __shfl_xor(ss, 4);
      const float rstd = rsqrtf(ss * (1.0f / 128.f) + EPS);
      const int t = c * 64 + i;
      const float* on = a.in[I_ONORM] + dv0;
      float rf[16];
      { const u32x4 r0 = *(const u32x4*)(proj + (size_t)t * NPROJ + PRA + h * 128 + dv0), r1 = *(const u32x4*)(proj + (size_t)t * NPROJ + PRA + h * 128 + dv0 + 8); unpack8(r0, rf); unpack8(r1, rf + 8); }
      float y[16];
#pragma unroll
      for (int q = 0; q < 4; ++q)
#pragma unroll
          for (int j = 0; j < 4; ++j) { const float r = rf[q * 4 + j]; y[q * 4 + j] = o[q][j] * rstd * on[q * 4 + j] * (r / (1.f + __expf(-r))); }
      u32x4 w0, w1;
      w0.x = cvt_pk_bf16(y[0], y[1]); w0.y = cvt_pk_bf16(y[2], y[3]); w0.z = cvt_pk_bf16(y[4], y[5]); w0.w = cvt_pk_bf16(y[6], y[7]);
      w1.x = cvt_pk_bf16(y[8], y[9]); w1.y = cvt_pk_bf16(y[10], y[11]); w1.z = cvt_pk_bf16(y[12], y[13]); w1.w = cvt_pk_bf16(y[14], y[15]);
      *(u32x4*)(mix + (size_t)t * D + h * 128 + dv0) = w0; *(u32x4*)(mix + (size_t)t * D + h * 128 + dv0 + 8) = w1; }
    __syncthreads();
}
__device__ __forceinline__ void gla_decode_item(const KArgs& a, int item, int lane) {
    const int b = item >> 2, h = item & 3; const int row = SROW + b;
    const bf16_t* proj = (const bf16_t*)(a.ws + WS_BIG); const float* la = (const float*)(a.ws + WS_BIG + BIG_LA);
    bf16_t* mix = (bf16_t*)(a.ws + WS_R1);
    const float* S0 = a.in[I_SGLA] + ((size_t)b * 4 + h) * 8192;
    float* S1 = a.out + O_GLAS + ((size_t)b * 4 + h) * 8192;
    const float qv = bf2f(proj[(size_t)row * NPROJ + PQA + h * 64 + lane]) * 0.125f;
    const float kv = bf2f(proj[(size_t)row * NPROJ + PKA + h * 64 + lane]);
    const float av = __expf(la[(size_t)row * 256 + h * 64 + lane]);
    const unsigned vw = *(const unsigned*)(proj + (size_t)row * NPROJ + PVA + h * 128 + lane * 2);
    const float v0 = bf_lo(vw), v1 = bf_hi(vw);
    float o0 = 0.f, o1 = 0.f;
#pragma unroll 8
    for (int dk = 0; dk < 64; ++dk) {
        const float q = __shfl(qv, dk), k = __shfl(kv, dk), al = __shfl(av, dk);
        const f32x2 s = *(const f32x2*)(S0 + dk * 128 + lane * 2);
        const float n0 = al * s.x + k * v0, n1 = al * s.y + k * v1;
        *(f32x2*)(S1 + dk * 128 + lane * 2) = (f32x2){n0, n1};
        o0 += q * n0; o1 += q * n1;
    }
    const float ss = wave_sum(o0 * o0 + o1 * o1);
    const float rstd = rsqrtf(ss * (1.0f / 128.f) + EPS);
    const unsigned rw = *(const unsigned*)(proj + (size_t)row * NPROJ + PRA + h * 128 + lane * 2);
    const float r0 = bf_lo(rw), r1 = bf_hi(rw);
    const float y0 = o0 * rstd * a.in[I_ONORM][lane * 2] * (r0 / (1.f + __expf(-r0))), y1 = o1 * rstd * a.in[I_ONORM][lane * 2 + 1] * (r1 / (1.f + __expf(-r1)));
    *(unsigned*)(mix + (size_t)row * D + h * 128 + lane * 2) = cvt_pk_bf16(y0, y1);
}

__device__ __forceinline__ void swa_unit(const KArgs& a, LAS unsigned char* lds, int unit) {
    const int tid = otid(); const int qblk = unit >> 1, kvh = unit & 1;
    const bf16_t* proj = (const bf16_t*)(a.ws + WS_BIG);
    bf16_t* mix = (bf16_t*)(a.ws + WS_R1);
    LAS float* Kw = (LAS float*)lds; LAS float* Vw = Kw + 255 * 68;
    const int tk0 = qblk * 128 - 127;
    const float* kn = a.in[I_KNORM];
    for (int idx = tid; idx < 256 * 8; idx += NTHREADS) {
        const int kk = idx >> 3, part = idx & 7; const int tk = tk0 + kk;
        float kf[8], vf[8];
#pragma unroll
        for (int j = 0; j < 8; ++j) { kf[j] = 0.f; vf[j] = 0.f; }
        if (kk < 255 && tk >= 0) {
            const u32x4 kw = *(const u32x4*)(proj + (size_t)tk * NPROJ + PKB + kvh * 64 + part * 8); unpack8(kw, kf);
            const u32x4 vw = *(const u32x4*)(proj + (size_t)tk * NPROJ + PVB + kvh * 64 + part * 8); unpack8(vw, vf);
        }
        float ss = 0.f;
#pragma unroll
        for (int j = 0; j < 8; ++j) ss += kf[j] * kf[j];
        ss += __shfl_xor(ss, 1); ss += __shfl_xor(ss, 2); ss += __shfl_xor(ss, 4);
        const float rstd = rsqrtf(ss * (1.0f / 64.f) + EPS);
#pragma unroll
        for (int j = 0; j < 8; ++j) kf[j] = kf[j] * rstd * kn[part * 8 + j];
        if (kk < 255) {
            *(LAS f32x4*)(Kw + kk * 68 + part * 8) = (f32x4){kf[0], kf[1], kf[2], kf[3]}; *(LAS f32x4*)(Kw + kk * 68 + part * 8 + 4) = (f32x4){kf[4], kf[5], kf[6], kf[7]};
            *(LAS f32x4*)(Vw + kk * 68 + part * 8) = (f32x4){vf[0], vf[1], vf[2], vf[3]}; *(LAS f32x4*)(Vw + kk * 68 + part * 8 + 4) = (f32x4){vf[4], vf[5], vf[6], vf[7]};
            if (qblk == 127 && kk >= 127) {
                const int w = kk - 127;
                float* ko = a.out + O_SKP + ((size_t)w * 2 + kvh) * 64 + part * 8; float* vo = a.out + O_SVP + ((size_t)w * 2 + kvh) * 64 + part * 8;
                *(f32x4*)ko = (f32x4){kf[0], kf[1], kf[2], kf[3]}; *(f32x4*)(ko + 4) = (f32x4){kf[4], kf[5], kf[6], kf[7]};
                *(f32x4*)vo = (f32x4){vf[0], vf[1], vf[2], vf[3]}; *(f32x4*)(vo + 4) = (f32x4){vf[4], vf[5], vf[6], vf[7]};
            }
        }
    }
    __syncthreads();
    const int g = tid >> 7, qi = tid & 127, hq = kvh * 4 + g; const int t = qblk * 128 + qi;
    float q[64];
    { float ss = 0.f;
#pragma unroll
      for (int p = 0; p < 8; ++p) { const u32x4 qw = *(const u32x4*)(proj + (size_t)t * NPROJ + PQB + hq * 64 + p * 8); unpack8(qw, q + p * 8); }
#pragma unroll
      for (int d = 0; d < 64; ++d) ss += q[d] * q[d];
      const float rstd = rsqrtf(ss * (1.0f / 64.f) + EPS) * 0.125f;
#pragma unroll
      for (int d = 0; d < 64; ++d) q[d] = q[d] * rstd * a.in[I_QNORM][d]; }
    const float slope = exp2f(-(float)(hq + 1));
    float mx = a.in[I_SINKS][hq], l = 1.f;
    float o[64];
#pragma unroll
    for (int d = 0; d < 64; ++d) o[d] = 0.f;
    for (int i = 0; i < 128; ++i) {
        const int kk = qi + i; const int tk = tk0 + kk;
        const LAS float* kr = Kw + kk * 68;
        float s0 = 0.f, s1 = 0.f, s2 = 0.f, s3 = 0.f;
#pragma unroll
        for (int d = 0; d < 64; d += 4) { const f32x4 k4 = *(const LAS f32x4*)(kr + d); s0 += q[d] * k4[0]; s1 += q[d + 1] * k4[1]; s2 += q[d + 2] * k4[2]; s3 += q[d + 3] * k4[3]; }
        float s = (s0 + s1) + (s2 + s3) - slope * (float)(127 - i);
        if (tk < 0) s = -1e30f;
        const float mn = fmaxf(mx, s); const float corr = __expf(mx - mn), p = __expf(s - mn);
        mx = mn; l = l * corr + p;
        const LAS float* vr = Vw + kk * 68;
#pragma unroll
        for (int d = 0; d < 64; d += 4) { const f32x4 v4 = *(const LAS f32x4*)(vr + d); o[d] = o[d] * corr + p * v4[0]; o[d + 1] = o[d + 1] * corr + p * v4[1]; o[d + 2] = o[d + 2] * corr + p * v4[2]; o[d + 3] = o[d + 3] * corr + p * v4[3]; }
    }
    const float inv = 1.f / l;
#pragma unroll
    for (int p = 0; p < 8; ++p) { u32x4 w; w.x = cvt_pk_bf16(o[p * 8] * inv, o[p * 8 + 1] * inv); w.y = cvt_pk_bf16(o[p * 8 + 2] * inv, o[p * 8 + 3] * inv);
        w.z = cvt_pk_bf16(o[p * 8 + 4] * inv, o[p * 8 + 5] * inv); w.w = cvt_pk_bf16(o[p * 8 + 6] * inv, o[p * 8 + 7] * inv);
        *(u32x4*)(mix + (size_t)t * D + 512 + hq * 64 + p * 8) = w; }
    __syncthreads();
}
__device__ __forceinline__ void swa_decode_item(const KArgs& a, int item, int lane) {
    const int b = item >> 3, kvh = (item >> 2) & 1, g = item & 3, hq = kvh * 4 + g; const int row = SROW + b;
    const bf16_t* proj = (const bf16_t*)(a.ws + WS_BIG);
    bf16_t* mix = (bf16_t*)(a.ws + WS_R1);
    const float* ck = a.in[I_CK] + (size_t)b * 128 * 128 + kvh * 64;
    const float* cv = a.in[I_CV] + (size_t)b * 128 * 128 + kvh * 64;
    float qd = bf2f(proj[(size_t)row * NPROJ + PQB + hq * 64 + lane]);
    { const float ss = wave_sum(qd * qd); qd = qd * rsqrtf(ss * (1.0f / 64.f) + EPS) * a.in[I_QNORM][lane] * 0.125f; }
    float kd = bf2f(proj[(size_t)row * NPROJ + PKB + kvh * 64 + lane]);
    { const float ss = wave_sum(kd * kd); kd = kd * rsqrtf(ss * (1.0f / 64.f) + EPS) * a.in[I_KNORM][lane]; }
    const float vd = bf2f(proj[(size_t)row * NPROJ + PVB + kvh * 64 + lane]);
    const float slope = exp2f(-(float)(hq + 1));
    float s0 = 0.f, s1 = 0.f;
    for (int d = 0; d < 64; d += 4) {
        const f32x4 k0 = *(const f32x4*)(ck + (size_t)lane * 128 + d), k1 = *(const f32x4*)(ck + (size_t)(lane + 64) * 128 + d);
        const float q0 = __shfl(qd, d), q1 = __shfl(qd, d + 1), q2 = __shfl(qd, d + 2), q3 = __shfl(qd, d + 3);
        s0 += (q0 * k0[0] + q1 * k0[1]) + (q2 * k0[2] + q3 * k0[3]);
        s1 += (q0 * k1[0] + q1 * k1[1]) + (q2 * k1[2] + q3 * k1[3]);
    }
    s0 -= slope * (float)(128 - lane); s1 -= slope * (float)(64 - lane);
    if (lane == 0) s0 = -1e30f;
    const float sn = wave_sum(qd * kd);
    const float sink = a.in[I_SINKS][hq];
    const float mx = fmaxf(fmaxf(wave_max(fmaxf(s0, s1)), sn), sink);
    const float p0 = __expf(s0 - mx), p1 = __expf(s1 - mx), pn = __expf(sn - mx);
    const float l = wave_sum(p0 + p1) + pn + __expf(sink - mx);
    float od = pn * vd;
#pragma unroll 8
    for (int w = 0; w < 64; ++w) { const float pa = __shfl(p0, w), pb = __shfl(p1, w); od += pa * cv[(size_t)w * 128 + lane] + pb * cv[(size_t)(w + 64) * 128 + lane]; }
    od /= l;
    const float oo = __shfl_down(od, 1);
    if ((lane & 1) == 0) *(unsigned*)(mix + (size_t)row * D + 512 + hq * 64 + lane) = cvt_pk_bf16(od, oo);
    if (g == 0) {
        float* ko = a.out + O_SKS + (size_t)b * 128 * 128 + kvh * 64; float* vo = a.out + O_SVS + (size_t)b * 128 * 128 + kvh * 64;
#pragma unroll 4
        for (int w = 0; w < 127; ++w) { ko[(size_t)w * 128 + lane] = ck[(size_t)(w + 1) * 128 + lane]; vo[(size_t)w * 128 + lane] = cv[(size_t)(w + 1) * 128 + lane]; }
        ko[(size_t)127 * 128 + lane] = kd; vo[(size_t)127 * 128 + lane] = vd;
    }
}

__device__ __forceinline__ void pool_item(const KArgs& a, LAS unsigned char* lds, int item, const float* part_in) {
    const int tid = otid();
    const float* h = a.out + O_YP; bf16_t* d1 = (bf16_t*)(a.ws + WS_R1);
    LAS float* rsL = (LAS float*)lds;
    const int r0 = item * 64;
    __syncthreads();
    if (tid < 80) { const int r = r0 - 16 + tid; float rs = 0.f;
        if (r >= 0) { float s = 0.f;
#pragma unroll
            for (int i = 0; i < 16; ++i) s += part_in[(long)r * 16 + i];
            rs = rsqrtf(s * (1.0f / D) + EPS); }
        rsL[tid] = rs; }
    __syncthreads();
#pragma unroll
    for (int cc = 0; cc < 2; ++cc) {
        const int c = tid + cc * NTHREADS; const int w = 2 << (c >> 8);
        const float gg = a.in[I_MNO][c];
        float s = 0.f;
        for (int r = r0 - w + 1; r < r0; ++r) if (r >= 0) s += h[(size_t)r * D + c] * rsL[r - r0 + 16] * gg;
        for (int r = r0; r < r0 + 64; ++r) {
            const float xn = h[(size_t)r * D + c] * rsL[r - r0 + 16] * gg;
            s += xn;
            const int cnt = (r + 1 < w) ? r + 1 : w;
            const float dd = s / (float)cnt - xn;
            d1[(size_t)r * D + c] = (bf16_t)(cvt_pk_bf16(dd, 0.f) & 0xffffu);
            const int ro = r - w + 1;
            if (ro >= 0) s -= h[(size_t)ro * D + c] * rsL[ro - r0 + 16] * gg;
            if (r >= SEQ - 15) a.out[O_POOLP + (size_t)(r - (SEQ - 15)) * D + c] = xn;
        }
    }
}
__device__ __forceinline__ void pool_sample_item(const KArgs& a, LAS unsigned char* lds, int b, const float* part_in) {
    const int tid = otid();
    const float* h = a.out + O_YS + (size_t)b * D; bf16_t* d1 = (bf16_t*)(a.ws + WS_R1);
    const float* st = a.in[I_SPOOL] + (size_t)b * 15 * D; float* so = a.out + O_POOLS + (size_t)b * 15 * D;
    float s = 0.f;
#pragma unroll
    for (int i = 0; i < 16; ++i) s += part_in[(long)(SROW + b) * 16 + i];
    const float rs = rsqrtf(s * (1.0f / D) + EPS);
#pragma unroll
    for (int cc = 0; cc < 2; ++cc) {
        const int c = tid + cc * NTHREADS; const int w = 2 << (c >> 8);
        const float xn = h[c] * rs * a.in[I_MNO][c];
        float sum = xn;
        for (int j = 16 - w; j < 15; ++j) sum += st[(size_t)j * D + c];
        const float dd = sum / (float)w - xn;
        d1[(size_t)(SROW + b) * D + c] = (bf16_t)(cvt_pk_bf16(dd, 0.f) & 0xffffu);
        for (int j = 0; j < 14; ++j) so[(size_t)j * D + c] = st[(size_t)(j + 1) * D + c];
        so[(size_t)14 * D + c] = xn;
    }
}


#define XB_TMO      128
#define XB_XCNT(j)  (256  + 64 * (j))
#define XB_XSUB(j)  (1280 + 64 * (j))
#define XB_XGEN(j)  (2304 + 64 * (j))
#define XB_TOP      3328
#define XB_TOPGEN   3392
#define XCD_BAR_WORDS 3456
#define XB_SPIN_CAP (1u << 18)
__device__ __forceinline__ unsigned xb_ld(unsigned* p)              { return __hip_atomic_load(p, __ATOMIC_RELAXED, __HIP_MEMORY_SCOPE_AGENT); }
__device__ __forceinline__ unsigned xb_add(unsigned* p, unsigned v) { return __hip_atomic_fetch_add(p, v, __ATOMIC_RELAXED, __HIP_MEMORY_SCOPE_AGENT); }
__device__ __forceinline__ unsigned xb_xcc_id() { return (unsigned)__builtin_amdgcn_s_getreg((3 << 11) | 20) & 0xFu; }
#define XB_SPIN(cond, bar) do { unsigned _sp = 0; while (cond) { __builtin_amdgcn_s_sleep(1); \
    if ((++_sp & 255u) == 0u) { if (xb_ld(&(bar)[XB_TMO])) break; if (_sp > XB_SPIN_CAP) { atomicAdd(&(bar)[XB_TMO], 1u); break; } } } } while (0)
struct XcdBarrier { unsigned* bar; unsigned x; volatile LAS unsigned* st; };
__device__ __forceinline__ XcdBarrier xcd_barrier_post(unsigned* bar, volatile LAS unsigned* st) {
    XcdBarrier b; b.bar = bar; b.x = xb_xcc_id(); b.st = st;
    if (threadIdx.x == 0) (void)xb_add(&bar[XB_XCNT(b.x)], 1u);
    return b;
}
__device__ __forceinline__ void xcd_barrier_complete(unsigned* bar, unsigned x, unsigned& nloc, unsigned& nx) {
    const unsigned G = gridDim.x * gridDim.y * gridDim.z;
    unsigned sum, cnt, mine, sp = 0u;
    for (;;) {
        sum = 0u; cnt = 0u; mine = 0u;
#pragma unroll
        for (unsigned j = 0; j < 16; ++j) { const unsigned c = xb_ld(&bar[XB_XCNT(j)]); sum += c; cnt += (c > 0u) ? 1u : 0u; mine = (j == x) ? c : mine; }
        if (sum == G) break;
        __builtin_amdgcn_s_sleep(1);
        if ((++sp & 255u) == 0u) { if (xb_ld(&bar[XB_TMO])) break; if (sp > XB_SPIN_CAP) { atomicAdd(&bar[XB_TMO], 1u); break; } }
    }
    nloc = mine > 0u ? mine : 1u; nx = cnt > 0u ? cnt : 1u;
}
__device__ __forceinline__ void xcd_barrier(const XcdBarrier& b) {
    asm volatile("s_waitcnt vmcnt(0)" ::: "memory");
    __syncthreads();
    if (threadIdx.x == 0) {
        unsigned* bar = b.bar;
        __builtin_amdgcn_s_waitcnt(0);
        unsigned nloc = b.st[0], nx = b.st[1];
        if (nloc == 0u) { xcd_barrier_complete(bar, b.x, nloc, nx); b.st[0] = nloc; b.st[1] = nx; }
        const unsigned old = xb_add(&bar[XB_XSUB(b.x)], 1u);
        const unsigned gen = old / nloc;
        if (old + 1u == (gen + 1u) * nloc) {
            __builtin_amdgcn_fence(__ATOMIC_RELEASE, "agent");
            asm volatile("s_waitcnt vmcnt(0)" ::: "memory");
            const unsigned og = xb_add(&bar[XB_TOP], 1u);
            const unsigned tg = og / nx;
            if (og + 1u == (tg + 1u) * nx) xb_add(&bar[XB_TOPGEN], 1u);
            else XB_SPIN(xb_ld(&bar[XB_TOPGEN]) == tg, bar);
            __builtin_amdgcn_fence(__ATOMIC_ACQUIRE, "agent");
            xb_add(&bar[XB_XGEN(b.x)], 1u);
            asm volatile("s_waitcnt vmcnt(0)" ::: "memory");
        } else {
            XB_SPIN(xb_ld(&bar[XB_XGEN(b.x)]) == gen, bar);
            __builtin_amdgcn_fence(__ATOMIC_ACQUIRE, "agent");
            asm volatile("s_waitcnt vmcnt(0)" ::: "memory");
        }
    }
    __syncthreads();
}

#ifndef DUPM
#define DUPM 0
#endif
#ifndef SYNCREP
#define SYNCREP 1
#endif
#define GSYNC() do { _Pragma("unroll 1") for (int sr_ = 0; sr_ < SYNCREP; ++sr_) xcd_barrier(xbar); } while (0)
#define PH(k) _Pragma("unroll 1") for (int rep_ = 0; rep_ < (((DUPM) >> (k)) & 1) + 1; ++rep_)
__global__ void __launch_bounds__(NTHREADS, 2) mega_fwd(KArgs a) {
    extern __shared__ __attribute__((aligned(16))) unsigned char lds_raw[];
    LAS unsigned char* lds = (LAS unsigned char*)lds_raw;
    cg::grid_group grid = cg::this_grid();
    const int G = gridDim.x, bx = blockIdx.x;
    const int vcu = (G % 8 == 0) ? (bx % 8) * (G / 8) + bx / 8 : bx;
    unsigned char* ws = a.ws;
    if (ws == nullptr) grid.sync();
    volatile LAS unsigned* xst = (volatile LAS unsigned*)(lds + LDS_BYTES - 64);
    if (threadIdx.x < 16) xst[threadIdx.x] = 0u;
    __syncthreads();
    const XcdBarrier xbar = xcd_barrier_post((unsigned*)(ws + 16384), xst);
    bf16_t* R1 = (bf16_t*)(ws + WS_R1); bf16_t* R2 = (bf16_t*)(ws + WS_R2 + 4096);
    bf16_t* BIGB = (bf16_t*)(ws + WS_BIG);
    const bf16_t* pbf = (const bf16_t*)(ws + WS_PBF);

    PH(0) p0_prologue(a, lds, vcu, G);
    GSYNC();
    PH(1) {
        pg8::Gemm g{R1, (const bf16_t*)(ws + WS_WIN0), 1024, 1024, 1024, 256, 0, 0};
        pg8::StaticOrder S; S.init(65, 10, G, bx);
        EpiProj E{BIGB, (float*)(ws + WS_BIG + BIG_LA), (const float*)(ws + WS_SSQ), a.in[I_BALPHA]};
        pg8::gemm_phase(lds, g, S, E);
    }
    GSYNC();
    PH(2) for (int it = vcu; it < 1024; it += G) gla_u_item(a, lds, it);
    PH(3) for (int it = vcu; it < 256; it += G) swa_unit(a, lds, it);
    PH(4) { const int tid = otid(), lane = tid & 63, wave = __builtin_amdgcn_readfirstlane(tid >> 6); for (int it = vcu * 8 + wave; it < 512; it += G * 8) gla_decode_item(a, it, lane); }
    PH(5) { const int tid = otid(), lane = tid & 63, wave = __builtin_amdgcn_readfirstlane(tid >> 6); for (int it = vcu * 8 + wave; it < 1024; it += G * 8) swa_decode_item(a, it, lane); }
    GSYNC();
    PH(6) gla_scan(a, vcu);
    GSYNC();
    PH(7) for (int it = vcu; it < 1024; it += G) gla_o_item(a, lds, it);
    GSYNC();
    PH(8) {
        pg8::Gemm g{R1, (const bf16_t*)(ws + WS_WOUT0), 1024, 1024, 1024, 256, 0, 0};
        pg8::StaticOrder S; S.init(65, 4, G, bx);
        EpiRes<0, true, true> E{a.out, a.in[I_XP], a.in[I_XS], R2, part_tab(ws, 0), nullptr, nullptr, nullptr};
        pg8::gemm_phase(lds, g, S, E);
    }
    GSYNC();
#pragma unroll 1
    for (int l = 0; l < 2; ++l) {
        bf16_t* G_ = BIGB;
        bf16_t* PPb = BIGB;
        PH(9) {
            pg8::Gemm g{R2, (const bf16_t*)(ws + WS_WFFI + l * WFFI_BYTES), 1024, 1024, 1024, 254, -2, 0};
            pg8::StaticOrder S; S.init(66, 22, G, bx);
            EpiFfn E{part_tab(ws, l == 0 ? 0 : 3), a.in[I_FCW] + (size_t)l * 3 * DFF, a.in[I_FCB] + (size_t)l * DFF, a.in[I_SCONV] + (size_t)l * NS * 2 * DFF,
                     a.out + O_CONVP + (size_t)l * 2 * DFF, a.out + O_CONVS + (size_t)l * NS * 2 * DFF, G_};
            pg8::gemm_phase(lds, g, S, E);
        }
        GSYNC();
        PH(10) {
            pg8::Gemm g{G_, (const bf16_t*)(ws + WS_WFFO + l * WFFO_BYTES), DFF, DFF, DFF, 256, 0, 0};
            pg8::StaticOrder S; S.init(65, 4, G, bx);
            EpiRes<1, true, true> E{a.out, nullptr, nullptr, R1, part_tab(ws, l == 0 ? 1 : 4), nullptr, nullptr, nullptr};
            pg8::gemm_phase(lds, g, S, E);
        }
        GSYNC();
        PH(11) {
            pg8::Gemm g{pbf + (size_t)l * MT * PLE, (const bf16_t*)(ws + WS_WPROJ + l * WPROJ_BYTES), PLE, PLE, PLE, 256, 0, 0};
            pg8::StaticOrder S; S.init(65, 4, G, bx);
            EpiPP E{PPb};
            pg8::gemm_phase(lds, g, S, E);
        }
        PH(12) {
            pg8::Gemm g{R1, (const bf16_t*)(ws + WS_WGATE + l * WGATE_BYTES), 1024, 1024, 1024, 256, 0, 0};
            pg8::StaticOrder S; S.init(65, 4, G, bx);
            if (l == 0) { EpiRes<2, false, true> E{a.out, nullptr, nullptr, nullptr, part_tab(ws, 2), part_tab(ws, 1), PPb, nullptr}; pg8::gemm_phase(lds, g, S, E); }
            else { EpiRes<2, false, false> E{a.out, nullptr, nullptr, nullptr, nullptr, part_tab(ws, 4), PPb, nullptr}; pg8::gemm_phase(lds, g, S, E); }
        }
        if (l == 0) {
            GSYNC();
            PH(13) for (int it = vcu; it < 256 + NS; it += G) { if (it < 256) pool_item(a, lds, it, part_tab(ws, 2)); else pool_sample_item(a, lds, it - 256, part_tab(ws, 2)); }
            GSYNC();
            PH(14) {
                pg8::Gemm g{R1, (const bf16_t*)(ws + WS_WPOOL), 1024, 256, 256, 256, 0, 256};
                pg8::StaticOrder S; S.init(65, 4, G, bx);
                EpiRes<3, true, true> E{a.out, nullptr, nullptr, R2, part_tab(ws, 3), nullptr, nullptr, a.in[I_POOLSC]};
                pg8::gemm_phase(lds, g, S, E);
            }
            GSYNC();
        }
    }
}

extern "C" void kernel_launch(void* const* d_in, const int* in_sizes, int n_in, void* d_out, int out_size, void* d_ws, size_t ws_size, hipStream_t stream) {
    static int grid = 0;
    if (grid == 0) {
        int dev = 0, cus = 0, per_cu = 0;
        hipGetDevice(&dev);
        hipDeviceGetAttribute(&cus, hipDeviceAttributeMultiprocessorCount, dev);
        hipFuncSetAttribute((const void*)mega_fwd, hipFuncAttributeMaxDynamicSharedMemorySize, LDS_BYTES);
        hipOccupancyMaxActiveBlocksPerMultiprocessor(&per_cu, (const void*)mega_fwd, NTHREADS, LDS_BYTES);
        if (per_cu < 1) { fprintf(stderr, "kernel_launch: occupancy query reports %d blocks per CU\n", per_cu); per_cu = 1; }
        if (per_cu > 1) per_cu = 1;
        grid = cus * per_cu;
        (void)hipGetLastError();
    }
    (void)hipMemsetAsync(d_ws, 0, 65536, stream);
    KArgs a{};
    for (int i = 0; i < 29; ++i) a.in[i] = (const float*)d_in[i];
    a.out = (float*)d_out; a.ws = (unsigned char*)d_ws;
    void* args[] = {&a};
    hipError_t e = hipLaunchCooperativeKernel((const void*)mega_fwd, dim3(grid), dim3(NTHREADS), args, LDS_BYTES, stream);
    if (e != hipSuccess) fprintf(stderr, "cooperative launch failed: %s (grid %d)\n", hipGetErrorString(e), grid);
}
```

```cpp
#include <hip/hip_runtime.h>
#include <hip/hip_cooperative_groups.h>
#include <cstdio>
#include <cstdint>
namespace cg = cooperative_groups;

#define LAS __attribute__((address_space(3)))
typedef unsigned short bf16_t;
typedef short bf16x8 __attribute__((ext_vector_type(8)));
typedef float f32x4 __attribute__((ext_vector_type(4)));
typedef float f32x2 __attribute__((ext_vector_type(2)));
typedef unsigned u32x4 __attribute__((ext_vector_type(4)));
typedef unsigned u32x2 __attribute__((ext_vector_type(2)));
typedef float f32x16 __attribute__((ext_vector_type(16)));

constexpr int D = 1024, SEQ = 16384, NS = 128, DFF = 2816, PLE = 256;
constexpr int SROW = 16510;
constexpr int MT = 16640;
constexpr int MR = 16768;
constexpr int NPROJ = 2304;
constexpr int PQA = 0, PKA = 256, PVA = 512, PRA = 1024, PQB = 1536, PKB = 2048, PVB = 2176;
constexpr float EPS = 1e-6f;
constexpr int NTHREADS = 512;

constexpr size_t O_YP = 0, O_YS = 16777216, O_GLAP = 16908288, O_SKP = 16941056, O_SVP = 16957440, O_POOLP = 16973824, O_CONVP = 16989184,
                 O_GLAS = 17000448, O_SKS = 21194752, O_SVS = 23291904, O_POOLS = 25389056, O_CONVS = 27355136;

constexpr size_t MiB = 1u << 20;
constexpr size_t WS_WIN0 = 1 * MiB, WS_WOUT0 = 6 * MiB, WS_WFFI = 8 * MiB, WS_WFFO = 30 * MiB, WS_WGATE = 41 * MiB, WS_WPROJ = 45 * MiB, WS_WPOOL = 46 * MiB;
constexpr size_t WS_SSQ = 47 * MiB;
constexpr size_t WS_PBF = 55 * MiB, WS_R1 = 72 * MiB, WS_R2 = 105 * MiB, WS_BIG = 138 * MiB;
constexpr size_t PART_STRIDE = (size_t)(MR + 8) * 16 * 4;
constexpr size_t WFFI_BYTES = (size_t)5632 * 1024 * 2, WFFO_BYTES = (size_t)1024 * 2816 * 2, WGATE_BYTES = (size_t)1024 * 1024 * 2, WPROJ_BYTES = (size_t)1024 * 256 * 2;
constexpr size_t BIG_LA = (size_t)MT * NPROJ * 2;
constexpr int LDS_BYTES = 155648;

__device__ __forceinline__ unsigned cvt_pk_bf16(float lo, float hi) { unsigned r; asm volatile("v_cvt_pk_bf16_f32 %0, %1, %2" : "=v"(r) : "v"(lo), "v"(hi)); return r; }
__device__ __forceinline__ float bf_lo(unsigned w) { return __uint_as_float(w << 16); }
__device__ __forceinline__ float bf_hi(unsigned w) { return __uint_as_float(w & 0xffff0000u); }
__device__ __forceinline__ float bf2f(bf16_t v) { return __uint_as_float(((unsigned)v) << 16); }
__device__ __forceinline__ void unpack8(const u32x4 w, float* f) { f[0] = bf_lo(w.x); f[1] = bf_hi(w.x); f[2] = bf_lo(w.y); f[3] = bf_hi(w.y); f[4] = bf_lo(w.z); f[5] = bf_hi(w.z); f[6] = bf_lo(w.w); f[7] = bf_hi(w.w); }
__device__ __forceinline__ float wave_sum(float v) {
#pragma unroll
    for (int o = 1; o < 64; o <<= 1) v += __shfl_xor(v, o);
    return v;
}
__device__ __forceinline__ float wave_max(float v) {
#pragma unroll
    for (int o = 1; o < 64; o <<= 1) v = fmaxf(v, __shfl_xor(v, o));
    return v;
}
__device__ __forceinline__ int otid() { int t = threadIdx.x; asm volatile("" : "+v"(t)); return t; }
__device__ __forceinline__ bool row_valid(int row) { return row < SEQ || (row >= SROW && row < SROW + NS); }
__device__ __forceinline__ float* hrow_ptr(float* out, int row) { return row < SEQ ? out + O_YP + (size_t)row * D : out + O_YS + (size_t)(row - SROW) * D; }
__device__ __forceinline__ f32x2 gelu_pk(f32x2 v) {
    const f32x2 av = __builtin_elementwise_abs(v), d = av * 0.2316418882f + 1.0f;
    f32x2 t; t.x = __builtin_amdgcn_rcpf(d.x); t.y = __builtin_amdgcn_rcpf(d.y);
    f32x2 q = t * 0.5307027145f + (-0.7265760135f); q = q * t + 0.7107068705f; q = q * t + (-0.142248368f); q = q * t + 0.127414796f; q = q * t;
    const f32x2 s = (v * v) * (-0.72134752044f);
    f32x2 e; e.x = __builtin_amdgcn_exp2f(s.x); e.y = __builtin_amdgcn_exp2f(s.y);
    const f32x2 m = v * (q * e), r = v - m;
    f32x2 o; o.x = v.x < 0.f ? m.x : r.x; o.y = v.y < 0.f ? m.y : r.y; return o;
}

namespace pg8 {
constexpr int BM = 256, BK = 64, HALF = 128, HTB = HALF * BK * 2, STAGE_BYTES = 8 * HTB, NXCD = 8, WGM = 8;
__host__ __device__ __forceinline__ int lds_byte(int r, int c) { const int st = (r >> 4) * 2 + (c >> 5), rr = r & 15, cc = c & 31, ob = rr * 64 + cc * 2; return st * 1024 + (ob ^ (((ob >> 9) & 1) << 5)); }
__host__ __device__ __forceinline__ void stage_rc(int b, int& R, int& C) { const int st = b / 1024, sb = b % 1024, swz = sb ^ (((sb >> 9) & 1) << 5); R = (st >> 1) * 16 + swz / 64; C = (st & 1) * 32 + (swz % 64) / 2; }
__host__ __device__ __forceinline__ int perm32(int rho) { const int n = rho >> 4, i = rho & 15; return 8 * (i >> 2) + 4 * n + (i & 3); }

struct Unit { int pm, pn; };
struct Gemm { const bf16_t* A; const bf16_t* Bt; int lda, ldb, K, mstride, arow0, acolstep; };

struct StaticOrder {
    int nM, nN, nwg, G, c;
    __device__ void init(int nM_, int nN_, int G_, int c_) { nM = nM_; nN = nN_; nwg = nM * nN; G = G_; c = c_; }
    __device__ bool next(int i, Unit& u) const {
        const long L = (long)i * G + c; if (L >= nwg) return false;
        int wgid = (int)L; { const int q = nwg / NXCD, r = nwg % NXCD, xcd = wgid % NXCD, off = wgid / NXCD; wgid = (xcd < r ? xcd * (q + 1) : r * (q + 1) + (xcd - r) * q) + off; }
        const int nig = WGM * nN, gid = wgid / nig, fm = gid * WGM, gsz = (nM - fm) < WGM ? (nM - fm) : WGM;
        u.pm = fm + ((wgid % nig) % gsz); u.pn = (wgid % nig) / gsz; return true;
    }
};

template <class Epi>
__device__ __forceinline__ void gemm_phase(LAS unsigned char* lds, const Gemm g, const StaticOrder& S, const Epi& E) {
    const int tid = otid(), wid = __builtin_amdgcn_readfirstlane(tid >> 6), lane = tid & 63, wr = wid >> 2, wc = wid & 3, fr = lane & 15, fq = lane >> 4;
    const int K = g.K, nt = K / BK;
    unsigned voffA[2], voffB[2];
#pragma unroll
    for (int i = 0; i < 2; ++i) { int R, C; stage_rc(tid * 16 + i * 8192, R, C); const int Rb = (R & ~31) + perm32(R & 31);
        voffA[i] = (unsigned)(R * g.lda + C) * 2u; voffB[i] = (unsigned)(Rb * g.ldb + C) * 2u; }
    const size_t kstep = (size_t)(BK * 2);
    const size_t hstepA = (size_t)HALF * g.lda * 2, hstepB = (size_t)HALF * g.ldb * 2;
    const unsigned ldsw = (unsigned)wid * 1024u;
    const int aoff = lds_byte(wr * 64 + fr, fq * 8), boff = lds_byte(wc * 32 + fr, fq * 8);
#define PG8_SA(b, h) (((b) * 2 + (h)) * HTB)
#define PG8_SB(b, h) ((4 + (b) * 2 + (h)) * HTB)
#define PG8_STAGE(bufoff, gbase, voff) do { _Pragma("unroll") for (int _i = 0; _i < 2; ++_i) \
        __builtin_amdgcn_global_load_lds((const unsigned*)((const char*)(gbase) + (voff)[_i]), (LAS unsigned*)(lds + (bufoff) + ldsw + _i * 8192), 16, 0, 0); } while (0)
#define PG8_LDA(dst, b, h) do { _Pragma("unroll") for (int m = 0; m < 4; ++m) _Pragma("unroll") for (int k = 0; k < 2; ++k) dst[m][k] = *(const LAS bf16x8*)(lds + PG8_SA(b, h) + aoff + m * 2048 + k * 1024); } while (0)
#define PG8_LDB(dst, b, h) do { _Pragma("unroll") for (int n = 0; n < 2; ++n) _Pragma("unroll") for (int k = 0; k < 2; ++k) dst[n][k] = *(const LAS bf16x8*)(lds + PG8_SB(b, h) + boff + n * 2048 + k * 1024); } while (0)
#define PG8_MMA(ai, bj, At, Bt) do { __builtin_amdgcn_s_setprio(1); _Pragma("unroll") for (int m = 0; m < 4; ++m) _Pragma("unroll") for (int n = 0; n < 2; ++n) _Pragma("unroll") for (int k = 0; k < 2; ++k) \
        acc[ai][bj][m][n] = __builtin_amdgcn_mfma_f32_16x16x32_bf16(Bt[n][k], At[m][k], acc[ai][bj][m][n], 0, 0, 0); __builtin_amdgcn_s_setprio(0); } while (0)
#define PG8_WAIT_V(n) asm volatile("s_waitcnt vmcnt(" #n ")" ::: "memory")
#define PG8_WAIT_L(n) asm volatile("s_waitcnt lgkmcnt(" #n ")" ::: "memory")
#define PG8_BAR __builtin_amdgcn_s_barrier()
#define PG8_SCHED __builtin_amdgcn_sched_barrier(0)
#define PG8_ABASE(u) ((const char*)g.A + ((long)((long)(u).pm * g.mstride + g.arow0) * g.lda + (long)(u).pn * g.acolstep) * 2)
#define PG8_BBASE(u) ((const char*)g.Bt + (size_t)(u).pn * 256 * g.ldb * 2)
    Unit cur, nxt; int ui = 0;
    if (!S.next(0, cur)) return;
    f32x4 acc[2][2][4][2];
#pragma unroll
    for (int a = 0; a < 2; ++a)
#pragma unroll
        for (int b = 0; b < 2; ++b)
#pragma unroll
            for (int m = 0; m < 4; ++m)
#pragma unroll
                for (int n = 0; n < 2; ++n) acc[a][b][m][n] = (f32x4){0.f, 0.f, 0.f, 0.f};
    bf16x8 At[4][2], B0[2][2], B1[2][2];
    const char* cA = PG8_ABASE(cur); const char* cB = PG8_BBASE(cur);
    PG8_STAGE(PG8_SB(0, 0), cB, voffB); PG8_STAGE(PG8_SB(0, 1), cB + hstepB, voffB); PG8_STAGE(PG8_SA(0, 0), cA, voffA); PG8_STAGE(PG8_SA(0, 1), cA + hstepA, voffA);
    if (wr == 1) PG8_BAR;
    PG8_WAIT_V(2); PG8_BAR;
    PG8_STAGE(PG8_SB(1, 0), cB + kstep, voffB); PG8_STAGE(PG8_SA(1, 0), cA + kstep, voffA); PG8_STAGE(PG8_SB(1, 1), cB + hstepB + kstep, voffB);
    PG8_WAIT_V(6); PG8_BAR;
    for (;;) {
        const bool has_next = S.next(ui + 1, nxt);
        const char* nA = has_next ? PG8_ABASE(nxt) : cA; const char* nB = has_next ? PG8_BBASE(nxt) : cB;
#pragma unroll 1
        for (int t = 0; t < nt; t += 2) {
            const bool last = (t == nt - 2);
            const char* a1 = cA + (size_t)(t + 1) * kstep;
            const char* a2 = last ? nA : cA + (size_t)(t + 2) * kstep; const char* b2 = last ? nB : cB + (size_t)(t + 2) * kstep;
            const char* a3 = a2 + kstep; const char* b3 = b2 + kstep;
            PG8_LDB(B0, 0, 0); PG8_LDB(B1, 0, 1); PG8_SCHED; PG8_LDA(At, 0, 0); PG8_STAGE(PG8_SA(1, 1), a1 + hstepA, voffA);
            PG8_WAIT_V(8); PG8_WAIT_L(0); PG8_BAR; PG8_MMA(0, 0, At, B0); PG8_MMA(0, 1, At, B1); PG8_BAR; PG8_SCHED;
            PG8_LDA(At, 0, 1); PG8_STAGE(PG8_SB(0, 0), b2, voffB); PG8_STAGE(PG8_SB(0, 1), b2 + hstepB, voffB); PG8_STAGE(PG8_SA(0, 0), a2, voffA);
            PG8_WAIT_V(8); PG8_WAIT_L(0); PG8_BAR; PG8_MMA(1, 0, At, B0); PG8_MMA(1, 1, At, B1); PG8_BAR; PG8_SCHED;
            PG8_LDB(B0, 1, 0); PG8_LDB(B1, 1, 1); PG8_SCHED; PG8_LDA(At, 1, 0); PG8_STAGE(PG8_SA(0, 1), a2 + hstepA, voffA);
            PG8_WAIT_V(8); PG8_WAIT_L(0); PG8_BAR; PG8_MMA(0, 0, At, B0); PG8_MMA(0, 1, At, B1); PG8_BAR; PG8_SCHED;
            PG8_LDA(At, 1, 1); PG8_STAGE(PG8_SB(1, 0), b3, voffB); PG8_STAGE(PG8_SB(1, 1), b3 + hstepB, voffB); PG8_STAGE(PG8_SA(1, 0), a3, voffA);
            PG8_WAIT_V(8); PG8_WAIT_L(0); PG8_BAR; PG8_MMA(1, 0, At, B0); PG8_MMA(1, 1, At, B1); PG8_BAR; PG8_SCHED;
        }
        if (wr == 0) PG8_BAR;
        { int lane2 = lane; asm volatile("" : "+v"(lane2)); E(acc, cur, wr, wc, lane2 & 15, lane2 >> 4, lds + STAGE_BYTES); }
        if (!has_next) break;
#pragma unroll
        for (int a = 0; a < 2; ++a)
#pragma unroll
            for (int b = 0; b < 2; ++b)
#pragma unroll
                for (int m = 0; m < 4; ++m)
#pragma unroll
                    for (int n = 0; n < 2; ++n) acc[a][b][m][n] = (f32x4){0.f, 0.f, 0.f, 0.f};
        cur = nxt; cA = nA; cB = nB; ++ui;
        if (wr == 1) PG8_BAR;
    }
    PG8_WAIT_V(0);
    PG8_BAR;
#undef PG8_SA
#undef PG8_SB
#undef PG8_STAGE
#undef PG8_LDA
#undef PG8_LDB
#undef PG8_MMA
#undef PG8_WAIT_V
#undef PG8_WAIT_L
#undef PG8_BAR
#undef PG8_SCHED
#undef PG8_ABASE
#undef PG8_BBASE
}
}
using pg8::Unit;
typedef f32x4 AccT[2][2][4][2];

__device__ __forceinline__ float row_rs(const float* part, int row, int fq) {
    const f32x4 p = *(const f32x4*)(part + (long)row * 16 + fq * 4);
    float s = (p[0] + p[1]) + (p[2] + p[3]);
    s += __shfl_xor(s, 16); s += __shfl_xor(s, 32);
    return rsqrtf(s * (1.0f / D) + EPS);
}

struct EpiProj {
    bf16_t* proj; float* la; const float* ssq0; const float* b_alpha;
    __device__ __forceinline__ void operator()(const AccT& acc, const Unit& u, int wr, int wc, int fr, int fq, LAS unsigned char*) const {
#pragma unroll
        for (int ai = 0; ai < 2; ++ai)
#pragma unroll
            for (int m = 0; m < 4; ++m) {
                const int row = u.pm * 256 + ai * 128 + wr * 64 + m * 16 + fr;
                const float rs = rsqrtf(ssq0[row] * (1.0f / D) + EPS);
#pragma unroll
                for (int bj = 0; bj < 2; ++bj) {
                    const int col = u.pn * 256 + bj * 128 + wc * 32 + fq * 8;
                    const f32x4 v0 = acc[ai][bj][m][0] * rs, v1 = acc[ai][bj][m][1] * rs;
                    if (u.pn < 9) {
                        u32x4 w; w.x = cvt_pk_bf16(v0[0], v0[1]); w.y = cvt_pk_bf16(v0[2], v0[3]); w.z = cvt_pk_bf16(v1[0], v1[1]); w.w = cvt_pk_bf16(v1[2], v1[3]);
                        *(u32x4*)(proj + (size_t)row * NPROJ + col) = w;
                    } else {
                        const int c = col - NPROJ;
                        const f32x4 b0 = *(const f32x4*)(b_alpha + c), b1 = *(const f32x4*)(b_alpha + c + 4);
                        f32x4 o0, o1;
#pragma unroll
                        for (int j = 0; j < 4; ++j) {
                            const float z0 = v0[j] + b0[j], z1 = v1[j] + b1[j];
                            o0[j] = (fminf(z0, 0.f) - log1pf(__expf(-fabsf(z0)))) * 0.0625f;
                            o1[j] = (fminf(z1, 0.f) - log1pf(__expf(-fabsf(z1)))) * 0.0625f;
                        }
                        *(f32x4*)(la + (size_t)row * 256 + c) = o0; *(f32x4*)(la + (size_t)row * 256 + c + 4) = o1;
                    }
                }
            }
    }
};
struct EpiPP {
    bf16_t* pp;
    __device__ __forceinline__ void operator()(const AccT& acc, const Unit& u, int wr, int wc, int fr, int fq, LAS unsigned char*) const {
#pragma unroll
        for (int ai = 0; ai < 2; ++ai)
#pragma unroll
            for (int m = 0; m < 4; ++m) {
                const int row = u.pm * 256 + ai * 128 + wr * 64 + m * 16 + fr;
#pragma unroll
                for (int bj = 0; bj < 2; ++bj) {
                    const int col = u.pn * 256 + bj * 128 + wc * 32 + fq * 8;
                    const f32x4 v0 = acc[ai][bj][m][0], v1 = acc[ai][bj][m][1];
                    u32x4 w; w.x = cvt_pk_bf16(v0[0], v0[1]); w.y = cvt_pk_bf16(v0[2], v0[3]); w.z = cvt_pk_bf16(v1[0], v1[1]); w.w = cvt_pk_bf16(v1[2], v1[3]);
                    *(u32x4*)(pp + (size_t)row * D + col) = w;
                }
            }
    }
};
template <int MODE, bool WRITE_HB, bool WRITE_PART>
struct EpiRes {
    float* out; const float* xp; const float* xs; bf16_t* hb; float* part; const float* part_in; const bf16_t* pp; const float* scale;
    __device__ __forceinline__ void operator()(const AccT& acc, const Unit& u, int wr, int wc, int fr, int fq, LAS unsigned char*) const {
#pragma unroll
        for (int ai = 0; ai < 2; ++ai)
#pragma unroll
            for (int m = 0; m < 4; ++m) {
                const int row = u.pm * 256 + ai * 128 + wr * 64 + m * 16 + fr;
                const bool valid = row_valid(row);
                float rs = 1.f;
                if (MODE == 2) rs = row_rs(part_in, row, fq);
                float sq = 0.f;
                float* hp = hrow_ptr(out, valid ? row : 0);
                const float* bp = hp;
                if (MODE == 0) bp = (row < SEQ) ? xp + (size_t)row * D : xs + (size_t)((valid ? row : SROW) - SROW) * D;
#pragma unroll
                for (int bj = 0; bj < 2; ++bj) {
                    const int col = u.pn * 256 + bj * 128 + wc * 32 + fq * 8;
                    f32x4 v0 = acc[ai][bj][m][0], v1 = acc[ai][bj][m][1];
                    if (MODE == 2) {
                        const u32x4 pw = *(const u32x4*)(pp + (size_t)row * D + col);
                        float pf[8]; unpack8(pw, pf);
#pragma unroll
                        for (int j = 0; j < 4; ++j) {
                            v0[j] = pf[j] / (1.f + __expf(-v0[j] * rs));
                            v1[j] = pf[4 + j] / (1.f + __expf(-v1[j] * rs));
                        }
                    }
                    if (MODE == 3) { v0 = v0 * *(const f32x4*)(scale + col); v1 = v1 * *(const f32x4*)(scale + col + 4); }
                    if (valid) {
                        const f32x4 h0 = *(const f32x4*)(bp + col) + v0, h1 = *(const f32x4*)(bp + col + 4) + v1;
                        *(f32x4*)(hp + col) = h0; *(f32x4*)(hp + col + 4) = h1;
                        if (WRITE_HB) { u32x4 w; w.x = cvt_pk_bf16(h0[0], h0[1]); w.y = cvt_pk_bf16(h0[2], h0[3]); w.z = cvt_pk_bf16(h1[0], h1[1]); w.w = cvt_pk_bf16(h1[2], h1[3]);
                            *(u32x4*)(hb + (size_t)row * D + col) = w; }
                        sq += (h0[0] * h0[0] + h0[1] * h0[1]) + (h0[2] * h0[2] + h0[3] * h0[3]) + (h1[0] * h1[0] + h1[1] * h1[1]) + (h1[2] * h1[2] + h1[3] * h1[3]);
                    }
                }
                if (WRITE_PART) {
                    sq += __shfl_xor(sq, 16); sq += __shfl_xor(sq, 32);
                    if (fq == 0 && valid) part[(long)row * 16 + u.pn * 4 + wc] = sq;
                }
            }
    }
};
struct EpiFfn {
    const float* part_in; const float* convw; const float* convb; const float* cstate; float* convp_out; float* convs_out; bf16_t* G;
    __device__ __forceinline__ void operator()(AccT& acc, const Unit& u, int wr, int wc, int fr, int fq, LAS unsigned char* ldsx) const {
        const int lane = fr + 16 * fq;
        const int c0 = u.pn * 128 + wc * 32 + fq * 8;
        const bool sample = (u.pm == 65);
#pragma unroll
        for (int ai = 0; ai < 2; ++ai)
#pragma unroll
            for (int m = 0; m < 4; ++m) {
                const int grow = u.pm * 254 - 2 + ai * 128 + wr * 64 + m * 16 + fr;
                const float rs = row_rs(part_in, grow, fq);
#pragma unroll
                for (int bj = 0; bj < 2; ++bj)
#pragma unroll
                    for (int n = 0; n < 2; ++n) acc[ai][bj][m][n] = acc[ai][bj][m][n] * rs;
            }
        LAS f32x4* xch = (LAS f32x4*)ldsx;
        if (fr >= 14) {
#pragma unroll
            for (int ai = 0; ai < 2; ++ai) {
                const int slot = ((((ai * 2 + wr) * 4 + wc) * 4 + fq) * 2 + (fr - 14)) * 2;
                xch[slot] = acc[ai][0][3][0]; xch[slot + 1] = acc[ai][0][3][1];
            }
        }
        asm volatile("s_waitcnt lgkmcnt(0)" ::: "memory"); __builtin_amdgcn_s_barrier(); asm volatile("" ::: "memory");
        const int src1 = (lane & 48) | ((fr + 15) & 15), src2 = (lane & 48) | ((fr + 14) & 15);
#pragma unroll
        for (int n = 0; n < 2; ++n) {
            const int cn = c0 + 4 * n;
            const f32x4 w0 = *(const f32x4*)(convw + cn), w1 = *(const f32x4*)(convw + DFF + cn), w2 = *(const f32x4*)(convw + 2 * DFF + cn), cb = *(const f32x4*)(convb + cn);
#pragma unroll
            for (int ai = 0; ai < 2; ++ai)
#pragma unroll
                for (int m = 0; m < 4; ++m) {
                    const int tr = ai * 128 + wr * 64 + m * 16 + fr;
                    const int grow = u.pm * 254 - 2 + tr;
                    const f32x4 x = acc[ai][0][m][n];
                    f32x4 p;
                    if (m == 0) {
                        const int sa = (wr == 1) ? ai : 0, sw = (wr == 1) ? 0 : 1;
                        const bool has = (wr == 1) || (ai == 1);
                        const int slot = ((((sa * 2 + sw) * 4 + wc) * 4 + fq) * 2 + (fr >= 14 ? fr - 14 : 0)) * 2 + n;
                        p = xch[slot];
                        if (!has) p = (f32x4){0.f, 0.f, 0.f, 0.f};
                    } else p = acc[ai][0][m == 0 ? 0 : m - 1][n];
                    f32x4 p1, p2;
#pragma unroll
                    for (int j = 0; j < 4; ++j) {
                        const float x1 = __shfl(x[j], src1), x2 = __shfl(x[j], src2), q1 = __shfl(p[j], src1), q2 = __shfl(p[j], src2);
                        p1[j] = (fr >= 1) ? x1 : q1;
                        p2[j] = (fr >= 2) ? x2 : q2;
                    }
                    bool store;
                    if (sample) {
                        const int b = tr - 2;
                        store = (b >= 0 && b < NS);
                        if (store) {
                            const float* st = cstate + (size_t)b * 2 * DFF + cn;
                            p2 = *(const f32x4*)(st); p1 = *(const f32x4*)(st + DFF);
                            float* so = convs_out + (size_t)b * 2 * DFF + cn;
                            *(f32x4*)(so) = p1; *(f32x4*)(so + DFF) = x;
                        }
                    } else {
                        store = (tr >= 2 && grow < SEQ);
                        if (grow >= SEQ - 2 && grow < SEQ) *(f32x4*)(convp_out + (size_t)(grow - (SEQ - 2)) * DFF + cn) = x;
                    }
                    const f32x4 ac = cb + w0 * p2 + w1 * p1 + w2 * x;
                    const f32x4 v = acc[ai][1][m][n];
                    const f32x2 g0 = gelu_pk((f32x2){ac[0], ac[1]}), g1 = gelu_pk((f32x2){ac[2], ac[3]});
                    if (store) {
                        u32x2 w; w.x = cvt_pk_bf16(g0.x * v[0], g0.y * v[1]); w.y = cvt_pk_bf16(g1.x * v[2], g1.y * v[3]);
                        *(u32x2*)(G + (size_t)grow * DFF + cn) = w;
                    }
                    asm volatile("" ::: "memory");
                }
        }
    }
};

struct KArgs { const float* in[29]; float* out; unsigned char* ws; };
enum { I_XP = 0, I_XS, I_PP, I_PS, I_SGLA, I_CK, I_CV, I_SPOOL, I_SCONV, I_MNE, I_WIN, I_WALPHA, I_BALPHA, I_ONORM, I_QNORM, I_KNORM, I_SINKS, I_WOUT,
       I_MNO, I_POOLW, I_POOLSC, I_FNORM, I_FWIN, I_FCW, I_FCB, I_FWOUT, I_PNORM, I_PWPROJ, I_PWGATE };

__device__ __forceinline__ float* part_tab(unsigned char* ws, int i) { return (float*)(ws + WS_SSQ + 262144 + (size_t)i * PART_STRIDE) + 2 * 16; }

__device__ __forceinline__ void tr_item(const float* W, int ldsrc, int scol0, int k0, const float* gain, bf16_t* dst, int ldd, int drow0, LAS float* scr, int lane) {
#pragma unroll 8
    for (int i = 0; i < 32; ++i) { const int kk = 2 * i + (lane >> 5); const float gsc = gain ? gain[k0 + kk] : 1.f;
        scr[kk * 33 + (lane & 31)] = W[(size_t)(k0 + kk) * ldsrc + scol0 + (lane & 31)] * gsc; }
    asm volatile("s_waitcnt lgkmcnt(0)" ::: "memory");
    const int c = lane & 7;
#pragma unroll
    for (int j = 0; j < 4; ++j) { const int n = (lane >> 3) + 8 * j; const LAS float* s = scr + (8 * c) * 33 + n;
        u32x4 o; o.x = cvt_pk_bf16(s[0 * 33], s[1 * 33]); o.y = cvt_pk_bf16(s[2 * 33], s[3 * 33]); o.z = cvt_pk_bf16(s[4 * 33], s[5 * 33]); o.w = cvt_pk_bf16(s[6 * 33], s[7 * 33]);
        *(u32x4*)(dst + (size_t)(drow0 + n) * ldd + k0 + 8 * c) = o; }
    asm volatile("s_waitcnt lgkmcnt(0)" ::: "memory");
}
__device__ __forceinline__ void weff_item(const float* Win, const float* wal, int n0, int k0, const float* gain, bf16_t* dst, int drow0, LAS float* scr, int lane) {
#pragma unroll 2
    for (int i = 0; i < 32; ++i) { const int kk = 2 * i + (lane >> 5); const int k = k0 + kk; float s = 0.f;
#pragma unroll
        for (int r = 0; r < 16; ++r) s += Win[(size_t)k * 2320 + 1024 + r] * wal[r * 256 + n0 + (lane & 31)];
        scr[kk * 33 + (lane & 31)] = s * gain[k]; }
    asm volatile("s_waitcnt lgkmcnt(0)" ::: "memory");
    const int c = lane & 7;
#pragma unroll
    for (int j = 0; j < 4; ++j) { const int n = (lane >> 3) + 8 * j; const LAS float* s = scr + (8 * c) * 33 + n;
        u32x4 o; o.x = cvt_pk_bf16(s[0 * 33], s[1 * 33]); o.y = cvt_pk_bf16(s[2 * 33], s[3 * 33]); o.z = cvt_pk_bf16(s[4 * 33], s[5 * 33]); o.w = cvt_pk_bf16(s[6 * 33], s[7 * 33]);
        *(u32x4*)(dst + (size_t)(drow0 + n) * 1024 + k0 + 8 * c) = o; }
    asm volatile("s_waitcnt lgkmcnt(0)" ::: "memory");
}

__device__ __forceinline__ void p0_prologue(const KArgs& a, LAS unsigned char* lds, int vcu, int G) {
    const int tid = otid(), lane = tid & 63, wave = __builtin_amdgcn_readfirstlane(tid >> 6);
    LAS float* scr = (LAS float*)(lds + wave * 16384);
    const int gw = vcu * 8 + wave, NGW = G * 8;
    unsigned char* ws = a.ws;
    constexpr int I_A = 16 * 72, I_E = 16 * 8, I_O = 16 * 32, I_FI = 16 * 176, I_FO = 44 * 32, I_G = 16 * 32, I_P = 4 * 32, I_PL = 4 * 32;
    constexpr int NITEMS = I_A + I_E + I_O + 2 * I_FI + 2 * I_FO + 2 * I_G + 2 * I_P + I_PL;
    for (int it = gw; it < NITEMS; it += NGW) {
        int r = it;
        if (r < I_A) { const int kb = r / 72, nb = r % 72, n0 = nb * 32; tr_item(a.in[I_WIN], 2320, n0 < 1024 ? n0 : n0 + 16, kb * 64, a.in[I_MNE], (bf16_t*)(ws + WS_WIN0), 1024, n0, scr, lane); continue; } r -= I_A;
        if (r < I_E) { const int kb = r / 8, nb = r % 8; weff_item(a.in[I_WIN], a.in[I_WALPHA], nb * 32, kb * 64, a.in[I_MNE], (bf16_t*)(ws + WS_WIN0), NPROJ + nb * 32, scr, lane); continue; } r -= I_E;
        if (r < I_O) { const int kb = r / 32, nb = r % 32; tr_item(a.in[I_WOUT], 1024, nb * 32, kb * 64, nullptr, (bf16_t*)(ws + WS_WOUT0), 1024, nb * 32, scr, lane); continue; } r -= I_O;
        if (r < 2 * I_FI) { const int l = r / I_FI, q = r % I_FI, kb = q / 176, nb = q % 176, n0 = nb * 32;
            const int pn = n0 >> 8, rr = n0 & 255, bj = rr >> 7, ii = rr & 127;
            tr_item(a.in[I_FWIN] + (size_t)l * 1024 * 5632, 5632, bj * DFF + pn * 128 + ii, kb * 64, a.in[I_FNORM] + l * 1024, (bf16_t*)(ws + WS_WFFI + l * WFFI_BYTES), 1024, n0, scr, lane); continue; } r -= 2 * I_FI;
        if (r < 2 * I_FO) { const int l = r / I_FO, q = r % I_FO, kb = q / 32, nb = q % 32;
            tr_item(a.in[I_FWOUT] + (size_t)l * DFF * 1024, 1024, nb * 32, kb * 64, nullptr, (bf16_t*)(ws + WS_WFFO + l * WFFO_BYTES), DFF, nb * 32, scr, lane); continue; } r -= 2 * I_FO;
        if (r < 2 * I_G) { const int l = r / I_G, q = r % I_G, kb = q / 32, nb = q % 32;
            tr_item(a.in[I_PWGATE] + (size_t)l * 1024 * 1024, 1024, nb * 32, kb * 64, a.in[I_PNORM] + l * 1024, (bf16_t*)(ws + WS_WGATE + l * WGATE_BYTES), 1024, nb * 32, scr, lane); continue; } r -= 2 * I_G;
        if (r < 2 * I_P) { const int l = r / I_P, q = r % I_P, kb = q / 32, nb = q % 32;
            tr_item(a.in[I_PWPROJ] + (size_t)l * 256 * 1024, 1024, nb * 32, kb * 64, nullptr, (bf16_t*)(ws + WS_WPROJ + l * WPROJ_BYTES), 256, nb * 32, scr, lane); continue; } r -= 2 * I_P;
        { const int gq = r / 32, q = r % 32, kb = q / 8, nb = q % 8;
            tr_item(a.in[I_POOLW] + (size_t)gq * 65536, 256, nb * 32, kb * 64, nullptr, (bf16_t*)(ws + WS_WPOOL), 256, gq * 256 + nb * 32, scr, lane); }
    }
    bf16_t* xbf = (bf16_t*)(ws + WS_R1);
    float* ssq0 = (float*)(ws + WS_SSQ);
    for (int row = gw; row < MR; row += NGW) {
        const float* src = row < SEQ ? a.in[I_XP] + (size_t)row * D : ((row >= SROW && row < SROW + NS) ? a.in[I_XS] + (size_t)(row - SROW) * D : nullptr);
        float s = 0.f;
#pragma unroll
        for (int j = 0; j < 4; ++j) {
            f32x4 v = (f32x4){0.f, 0.f, 0.f, 0.f};
            if (src) v = *(const f32x4*)(src + j * 256 + lane * 4);
            s += (v[0] * v[0] + v[1] * v[1]) + (v[2] * v[2] + v[3] * v[3]);
            u32x2 w; w.x = cvt_pk_bf16(v[0], v[1]); w.y = cvt_pk_bf16(v[2], v[3]);
            *(u32x2*)(xbf + (size_t)row * D + j * 256 + lane * 4) = w;
        }
        s = wave_sum(s);
        if (lane == 0) ssq0[row] = s;
    }
    bf16_t* pbf = (bf16_t*)(ws + WS_PBF);
    for (int it = gw; it < 2 * MT; it += NGW) {
        const int l = it / MT, row = it % MT;
        const float* src = row < SEQ ? a.in[I_PP] + ((size_t)l * SEQ + row) * PLE : ((row >= SROW && row < SROW + NS) ? a.in[I_PS] + ((size_t)l * NS + (row - SROW)) * PLE : nullptr);
        f32x4 v = (f32x4){0.f, 0.f, 0.f, 0.f};
        if (src) v = *(const f32x4*)(src + lane * 4);
        u32x2 w; w.x = cvt_pk_bf16(v[0], v[1]); w.y = cvt_pk_bf16(v[2], v[3]);
        *(u32x2*)(pbf + (size_t)it * PLE + lane * 4) = w;
    }
    if (vcu == 0) { for (int i = tid; i < 1024; i += NTHREADS) ((u32x4*)(ws + WS_R2))[i] = (u32x4){0u, 0u, 0u, 0u}; }
    {
        u32x4* pt = (u32x4*)(ws + WS_SSQ + 262144);
        const size_t n16 = 6 * PART_STRIDE / 16;
        for (size_t i = (size_t)vcu * NTHREADS + tid; i < n16; i += (size_t)G * NTHREADS) pt[i] = (u32x4){0u, 0u, 0u, 0u};
    }
}

__device__ __forceinline__ void gla_load_b(const float* la, int c, int h, LAS float* bL, int tid) {
#pragma unroll
    for (int i = 0; i < 2; ++i) { const int e = tid + i * NTHREADS; const int t = e >> 4, d4 = (e & 15) * 4;
        *(LAS f32x4*)(bL + t * 64 + d4) = *(const f32x4*)(la + (size_t)(c * 64 + t) * 256 + h * 64 + d4); }
    __syncthreads();
    if (tid < 64) { float s = 0.f;
#pragma unroll 8
        for (int t = 0; t < 64; ++t) { s += bL[t * 64 + tid]; bL[t * 64 + tid] = s; } }
    __syncthreads();
}
__device__ __forceinline__ void gla_u_item(const KArgs& a, LAS unsigned char* lds, int item) {
    const int tid = otid(); const int c = item >> 2, h = item & 3;
    const bf16_t* proj = (const bf16_t*)(a.ws + WS_BIG); const float* la = (const float*)(a.ws + WS_BIG + BIG_LA);
    float* U = (float*)(a.ws + WS_R2 + 4096); float* Dc = U + (size_t)256 * 4 * 64 * 128;
    LAS float* bL = (LAS float*)lds; LAS float* kh = bL + 4096; LAS float* vL = kh + 4096;
    gla_load_b(la, c, h, bL, tid);
    { const int t = tid >> 3, d8 = (tid & 7) * 8;
      const u32x4 kw = *(const u32x4*)(proj + (size_t)(c * 64 + t) * NPROJ + PKA + h * 64 + d8); float kf[8]; unpack8(kw, kf);
#pragma unroll
      for (int j = 0; j < 8; ++j) kh[t * 64 + d8 + j] = kf[j] * __expf(bL[63 * 64 + d8 + j] - bL[t * 64 + d8 + j]);
#pragma unroll
      for (int i = 0; i < 2; ++i) { const int dv8 = d8 + i * 64;
          const u32x4 vw = *(const u32x4*)(proj + (size_t)(c * 64 + t) * NPROJ + PVA + h * 128 + dv8); float vf[8]; unpack8(vw, vf);
#pragma unroll
          for (int j = 0; j < 8; ++j) vL[t * 128 + dv8 + j] = vf[j]; } }
    __syncthreads();
    const int dk4 = (tid >> 5) * 4, dv4 = (tid & 31) * 4;
    f32x4 u0 = {0.f, 0.f, 0.f, 0.f}, u1 = u0, u2 = u0, u3 = u0;
#pragma unroll 4
    for (int t = 0; t < 64; ++t) { const f32x4 kk = *(const LAS f32x4*)(kh + t * 64 + dk4), vv = *(const LAS f32x4*)(vL + t * 128 + dv4);
        u0 += kk[0] * vv; u1 += kk[1] * vv; u2 += kk[2] * vv; u3 += kk[3] * vv; }
    float* up = U + ((size_t)(c * 4 + h) * 64 + dk4) * 128 + dv4;
    *(f32x4*)(up) = u0; *(f32x4*)(up + 128) = u1; *(f32x4*)(up + 256) = u2; *(f32x4*)(up + 384) = u3;
    if (tid < 64) Dc[(c * 4 + h) * 64 + tid] = __expf(bL[63 * 64 + tid]);
    __syncthreads();
}
__device__ __forceinline__ void gla_scan(const KArgs& a, int vcu) {
    const int tid = otid(); if (tid >= 128) return;
    const int e = vcu * 128 + tid; if (e >= 32768) return;
    float* U = (float*)(a.ws + WS_R2 + 4096); const float* Dc = U + (size_t)256 * 4 * 64 * 128;
    const int hd = e >> 7;
    float S = 0.f;
    for (int c0 = 0; c0 < 256; c0 += 8) {
        float u[8], d[8];
#pragma unroll
        for (int j = 0; j < 8; ++j) { u[j] = U[(size_t)(c0 + j) * 32768 + e]; d[j] = Dc[(c0 + j) * 256 + hd]; }
#pragma unroll
        for (int j = 0; j < 8; ++j) { U[(size_t)(c0 + j) * 32768 + e] = S; S = d[j] * S + u[j]; }
    }
    a.out[O_GLAP + e] = S;
}
__device__ __forceinline__ void gla_o_item(const KArgs& a, LAS unsigned char* lds, int item) {
    const int tid = otid(); const int c = item >> 2, h = item & 3;
    const bf16_t* proj = (const bf16_t*)(a.ws + WS_BIG); const float* la = (const float*)(a.ws + WS_BIG + BIG_LA);
    const float* U = (const float*)(a.ws + WS_R2 + 4096);
    bf16_t* mix = (bf16_t*)(a.ws + WS_R1);
    LAS float* bL = (LAS float*)lds; LAS float* qt = bL + 4096; LAS float* kt = qt + 64 * 68; LAS float* vL = kt + 64 * 68; LAS float* SL = vL + 8192; LAS float* att = SL + 8192;
    gla_load_b(la, c, h, bL, tid);
    { const int t = tid >> 3, d8 = (tid & 7) * 8;
      const u32x4 qw = *(const u32x4*)(proj + (size_t)(c * 64 + t) * NPROJ + PQA + h * 64 + d8); float qf[8]; unpack8(qw, qf);
      const u32x4 kw = *(const u32x4*)(proj + (size_t)(c * 64 + t) * NPROJ + PKA + h * 64 + d8); float kf[8]; unpack8(kw, kf);
#pragma unroll
      for (int j = 0; j < 8; ++j) { const float b = bL[t * 64 + d8 + j]; qt[t * 68 + d8 + j] = qf[j] * 0.125f * __expf(b); kt[t * 68 + d8 + j] = kf[j] * __expf(-b); }
#pragma unroll
      for (int i = 0; i < 2; ++i) { const int dv8 = d8 + i * 64;
          const u32x4 vw = *(const u32x4*)(proj + (size_t)(c * 64 + t) * NPROJ + PVA + h * 128 + dv8); float vf[8]; unpack8(vw, vf);
#pragma unroll
          for (int j = 0; j < 8; ++j) vL[t * 128 + dv8 + j] = vf[j]; }
#pragma unroll
      for (int i = 0; i < 4; ++i) { const int e = (tid + i * NTHREADS) * 4; *(LAS f32x4*)(SL + e) = *(const f32x4*)(U + (size_t)(c * 4 + h) * 8192 + e); } }
    __syncthreads();
    { const int i = tid >> 3, j0 = tid & 7;
      float s[8];
#pragma unroll
      for (int jj = 0; jj < 8; ++jj) s[jj] = 0.f;
#pragma unroll 4
      for (int dk = 0; dk < 64; dk += 4) { const f32x4 q4 = *(const LAS f32x4*)(qt + i * 68 + dk);
#pragma unroll
          for (int jj = 0; jj < 8; ++jj) { const f32x4 k4 = *(const LAS f32x4*)(kt + (j0 + 8 * jj) * 68 + dk); s[jj] += (q4[0] * k4[0] + q4[1] * k4[1]) + (q4[2] * k4[2] + q4[3] * k4[3]); } }
#pragma unroll
      for (int jj = 0; jj < 8; ++jj) { const int j = j0 + 8 * jj; att[i * 65 + j] = (j <= i) ? s[jj] : 0.f; } }
    __syncthreads();
    { const int i = tid >> 3, dv0 = (tid & 7) * 16;
      f32x4 o[4];
#pragma unroll
      for (int q = 0; q < 4; ++q) o[q] = (f32x4){0.f, 0.f, 0.f, 0.f};
      for (int j = 0; j <= i; ++j) { const float av = att[i * 65 + j];
#pragma unroll
          for (int q = 0; q < 4; ++q) o[q] += av * *(const LAS f32x4*)(vL + j * 128 + dv0 + q * 4); }
#pragma unroll 4
      for (int dk = 0; dk < 64; ++dk) { const float qv = qt[i * 68 + dk];
#pragma unroll
          for (int q = 0; q < 4; ++q) o[q] += qv * *(const LAS f32x4*)(SL + dk * 128 + dv0 + q * 4); }
      float ss = 0.f;
#pragma unroll
      for (int q = 0; q < 4; ++q) ss += (o[q][0] * o[q][0] + o[q][1] * o[q][1]) + (o[q][2] * o[q][2] + o[q][3] * o[q][3]);
      ss += __shfl_xor(ss, 1); ss += __shfl_xor(ss, 2); ss += __shfl_xor(ss, 4);
      const float rstd = rsqrtf(ss * (1.0f / 128.f) + EPS);
      const int t = c * 64 + i;
      const float* on = a.in[I_ONORM] + dv0;
      float rf[16];
      { const u32x4 r0 = *(const u32x4*)(proj + (size_t)t * NPROJ + PRA + h * 128 + dv0), r1 = *(const u32x4*)(proj + (size_t)t * NPROJ + PRA + h * 128 + dv0 + 8); unpack8(r0, rf); unpack8(r1, rf + 8); }
      float y[16];
#pragma unroll
      for (int q = 0; q < 4; ++q)
#pragma unroll
          for (int j = 0; j < 4; ++j) { const float r = rf[q * 4 + j]; y[q * 4 + j] = o[q][j] * rstd * on[q * 4 + j] * (r / (1.f + __expf(-r))); }
      u32x4 w0, w1;
      w0.x = cvt_pk_bf16(y[0], y[1]); w0.y = cvt_pk_bf16(y[2], y[3]); w0.z = cvt_pk_bf16(y[4], y[5]); w0.w = cvt_pk_bf16(y[6], y[7]);
      w1.x = cvt_pk_bf16(y[8], y[9]); w1.y = cvt_pk_bf16(y[10], y[11]); w1.z = cvt_pk_bf16(y[12], y[13]); w1.w = cvt_pk_bf16(y[14], y[15]);
      *(u32x4*)(mix + (size_t)t * D + h * 128 + dv0) = w0; *(u32x4*)(mix + (size_t)t * D + h * 128 + dv0 + 8) = w1; }
    __syncthreads();
}
__device__ __forceinline__ int crow(int i, int hh) { return (i & 3) + 8 * (i >> 2) + 4 * hh; }
template <bool OUT>
__device__ __forceinline__ void gla_item_m(const KArgs& a, LAS unsigned char* lds, int item) {
    const int tid = otid(), lane = tid & 63, wave = __builtin_amdgcn_readfirstlane(tid >> 6);
    const int sc = item >> 2, h = item & 3;
    const bf16_t* proj = (const bf16_t*)(a.ws + WS_BIG); const float* la = (const float*)(a.ws + WS_BIG + BIG_LA);
    bf16_t* mix = (bf16_t*)(a.ws + WS_R1);
    float* US = (float*)(a.ws + WS_R2 + 4096); float* DS = US + (size_t)64 * 4 * 64 * 128;
    LAS float* bL = (LAS float*)lds; LAS float* segS = (LAS float*)(lds + 16384);
    LAS bf16_t* Qn = (LAS bf16_t*)(lds + 18432); LAS bf16_t* Kn = (LAS bf16_t*)(lds + 27648); LAS bf16_t* KT = (LAS bf16_t*)(lds + 36864);
    LAS bf16_t* VT = (LAS bf16_t*)(lds + 46080); LAS bf16_t* ST = (LAS bf16_t*)(lds + 64512); LAS float* red = (LAS float*)(lds + 82944);
    const int r = lane & 31, hh = lane >> 5;
    const int dkt = wave & 1, dvt = wave >> 1, it = wave & 1;
    f32x16 S = {};
    float* usp = US + ((size_t)(sc * 4 + h) * 64 + 32 * dkt) * 128 + 32 * dvt + r;
    if (OUT) {
#pragma unroll
        for (int i = 0; i < 16; ++i) S[i] = usp[(size_t)crow(i, hh) * 128];
    }
    float bsum = 0.f;
#pragma unroll 1
    for (int c = 0; c < 4; ++c) {
        const int T0 = sc * 256 + c * 64;
        if (OUT) {
#pragma unroll
            for (int q = 0; q < 4; ++q) { u32x2 w; w.x = cvt_pk_bf16(S[4 * q], S[4 * q + 1]); w.y = cvt_pk_bf16(S[4 * q + 2], S[4 * q + 3]);
                *(LAS u32x2*)(ST + (32 * dvt + r) * 72 + 32 * dkt + 8 * q + 4 * hh) = w; }
        }
        {
            const int dk = tid & 63, seg = tid >> 6;
            float v[8];
#pragma unroll
            for (int i = 0; i < 8; ++i) v[i] = la[(size_t)(T0 + 8 * seg + i) * 256 + h * 64 + dk];
#pragma unroll
            for (int i = 1; i < 8; ++i) v[i] += v[i - 1];
            segS[seg * 64 + dk] = v[7];
            __syncthreads();
            float off = 0.f;
#pragma unroll
            for (int s = 0; s < 8; ++s) { const float x = segS[s * 64 + dk]; off += (s < seg) ? x : 0.f; }
#pragma unroll
            for (int i = 0; i < 8; ++i) bL[(8 * seg + i) * 64 + dk] = v[i] + off;
            __syncthreads();
        }
        {
            const int t = tid >> 3, d8 = (tid & 7) * 8;
            const f32x4 b0 = *(const LAS f32x4*)(bL + t * 64 + d8), b1 = *(const LAS f32x4*)(bL + t * 64 + d8 + 4);
            const f32x4 l0 = *(const LAS f32x4*)(bL + 63 * 64 + d8), l1 = *(const LAS f32x4*)(bL + 63 * 64 + d8 + 4);
            float bb[8] = {b0[0], b0[1], b0[2], b0[3], b1[0], b1[1], b1[2], b1[3]}, bl[8] = {l0[0], l0[1], l0[2], l0[3], l1[0], l1[1], l1[2], l1[3]};
            const size_t prow = (size_t)(T0 + t) * NPROJ;
            float kf[8]; { const u32x4 kw = *(const u32x4*)(proj + prow + PKA + h * 64 + d8); unpack8(kw, kf); }
#pragma unroll
            for (int j = 0; j < 8; ++j) KT[(d8 + j) * 72 + t] = (bf16_t)(cvt_pk_bf16(kf[j] * __expf(bl[j] - bb[j]), 0.f) & 0xffffu);
            if (OUT) {
                float qf[8]; { const u32x4 qw = *(const u32x4*)(proj + prow + PQA + h * 64 + d8); unpack8(qw, qf); }
                float qq[8], kk[8];
#pragma unroll
                for (int j = 0; j < 8; ++j) { const float e = __expf(bb[j]); qq[j] = qf[j] * 0.125f * e; kk[j] = kf[j] * __expf(-bb[j]); }
                u32x4 w; w.x = cvt_pk_bf16(qq[0], qq[1]); w.y = cvt_pk_bf16(qq[2], qq[3]); w.z = cvt_pk_bf16(qq[4], qq[5]); w.w = cvt_pk_bf16(qq[6], qq[7]);
                *(LAS u32x4*)(Qn + t * 72 + d8) = w;
                w.x = cvt_pk_bf16(kk[0], kk[1]); w.y = cvt_pk_bf16(kk[2], kk[3]); w.z = cvt_pk_bf16(kk[4], kk[5]); w.w = cvt_pk_bf16(kk[6], kk[7]);
                *(LAS u32x4*)(Kn + t * 72 + d8) = w;
            }
#pragma unroll
            for (int i = 0; i < 2; ++i) { const int dv8 = d8 + 64 * i;
                const u32x4 vw = *(const u32x4*)(proj + prow + PVA + h * 128 + dv8);
                LAS bf16_t* vt = VT + dv8 * 72 + t;
                vt[0 * 72] = (bf16_t)(vw.x & 0xffffu); vt[1 * 72] = (bf16_t)(vw.x >> 16); vt[2 * 72] = (bf16_t)(vw.y & 0xffffu); vt[3 * 72] = (bf16_t)(vw.y >> 16);
                vt[4 * 72] = (bf16_t)(vw.z & 0xffffu); vt[5 * 72] = (bf16_t)(vw.z >> 16); vt[6 * 72] = (bf16_t)(vw.w & 0xffffu); vt[7 * 72] = (bf16_t)(vw.w >> 16); }
            if (tid < 64) bsum += bL[63 * 64 + tid];
        }
        __syncthreads();
        if (OUT) {
            bf16x8 qf[4];
#pragma unroll
            for (int s = 0; s < 4; ++s) qf[s] = *(const LAS bf16x8*)(Qn + (32 * it + r) * 72 + 16 * s + 8 * hh);
            f32x16 oacc = {};
#pragma unroll
            for (int jt = 0; jt < 2; ++jt) {
                if (jt <= it) {
                    f32x16 at = {};
#pragma unroll
                    for (int s = 0; s < 4; ++s) { const bf16x8 af = *(const LAS bf16x8*)(Kn + (32 * jt + r) * 72 + 16 * s + 8 * hh); at = __builtin_amdgcn_mfma_f32_32x32x16_bf16(af, qf[s], at, 0, 0, 0); }
                    if (jt == it) {
#pragma unroll
                        for (int i = 0; i < 16; ++i) if (crow(i, hh) > r) at[i] = 0.f;
                    }
#pragma unroll
                    for (int s2 = 0; s2 < 2; ++s2) {
                        u32x4 pw; pw.x = cvt_pk_bf16(at[8 * s2 + 0], at[8 * s2 + 1]); pw.y = cvt_pk_bf16(at[8 * s2 + 2], at[8 * s2 + 3]);
                        pw.z = cvt_pk_bf16(at[8 * s2 + 4], at[8 * s2 + 5]); pw.w = cvt_pk_bf16(at[8 * s2 + 6], at[8 * s2 + 7]);
                        const LAS bf16_t* vp = VT + (32 * dvt + r) * 72 + 32 * jt + 16 * s2 + 4 * hh;
                        const u32x2 v0 = *(const LAS u32x2*)vp, v1 = *(const LAS u32x2*)(vp + 8);
                        const u32x4 vv = (u32x4){v0.x, v0.y, v1.x, v1.y};
                        oacc = __builtin_amdgcn_mfma_f32_32x32x16_bf16(__builtin_bit_cast(bf16x8, vv), __builtin_bit_cast(bf16x8, pw), oacc, 0, 0, 0);
                    }
                }
            }
#pragma unroll
            for (int s = 0; s < 4; ++s) { const bf16x8 af = *(const LAS bf16x8*)(ST + (32 * dvt + r) * 72 + 16 * s + 8 * hh); oacc = __builtin_amdgcn_mfma_f32_32x32x16_bf16(af, qf[s], oacc, 0, 0, 0); }
            float ss = 0.f;
#pragma unroll
            for (int i = 0; i < 16; ++i) ss += oacc[i] * oacc[i];
            ss += __shfl_xor(ss, 32);
            if (hh == 0) red[wave * 32 + r] = ss;
            __syncthreads();
            const float tot = (red[it * 32 + r] + red[(it + 2) * 32 + r]) + (red[(it + 4) * 32 + r] + red[(it + 6) * 32 + r]);
            const float rstd = rsqrtf(tot * (1.0f / 128.f) + EPS);
            const int t = T0 + 32 * it + r;
#pragma unroll
            for (int q = 0; q < 4; ++q) {
                const int dv0 = 32 * dvt + 8 * q + 4 * hh;
                const u32x2 rw = *(const u32x2*)(proj + (size_t)t * NPROJ + PRA + h * 128 + dv0);
                const f32x4 on = *(const f32x4*)(a.in[I_ONORM] + dv0);
                const float r0 = bf_lo(rw.x), r1 = bf_hi(rw.x), r2 = bf_lo(rw.y), r3 = bf_hi(rw.y);
                const float y0 = oacc[4 * q] * rstd * on[0] * (r0 / (1.f + __expf(-r0))), y1 = oacc[4 * q + 1] * rstd * on[1] * (r1 / (1.f + __expf(-r1)));
                const float y2 = oacc[4 * q + 2] * rstd * on[2] * (r2 / (1.f + __expf(-r2))), y3 = oacc[4 * q + 3] * rstd * on[3] * (r3 / (1.f + __expf(-r3)));
                u32x2 w; w.x = cvt_pk_bf16(y0, y1); w.y = cvt_pk_bf16(y2, y3);
                *(u32x2*)(mix + (size_t)t * D + h * 128 + dv0) = w;
            }
        }
#pragma unroll
        for (int i = 0; i < 16; ++i) S[i] *= __expf(bL[63 * 64 + 32 * dkt + crow(i, hh)]);
#pragma unroll
        for (int s = 0; s < 4; ++s) {
            const bf16x8 af = *(const LAS bf16x8*)(KT + (32 * dkt + r) * 72 + 16 * s + 8 * hh), bf = *(const LAS bf16x8*)(VT + (32 * dvt + r) * 72 + 16 * s + 8 * hh);
            S = __builtin_amdgcn_mfma_f32_32x32x16_bf16(af, bf, S, 0, 0, 0);
        }
        __syncthreads();
    }
    if (!OUT) {
#pragma unroll
        for (int i = 0; i < 16; ++i) usp[(size_t)crow(i, hh) * 128] = S[i];
        if (tid < 64) DS[(sc * 4 + h) * 64 + tid] = __expf(bsum);
    }
}
__device__ __forceinline__ void gla_scan_m(const KArgs& a, int vcu) {
    const int tid = otid(); if (tid >= 128) return;
    const int e = vcu * 128 + tid; if (e >= 32768) return;
    float* US = (float*)(a.ws + WS_R2 + 4096); const float* DS = US + (size_t)64 * 4 * 64 * 128;
    const int hd = e >> 7;
    float S = 0.f;
    for (int c0 = 0; c0 < 64; c0 += 8) {
        float u[8], d[8];
#pragma unroll
        for (int j = 0; j < 8; ++j) { u[j] = US[(size_t)(c0 + j) * 32768 + e]; d[j] = DS[(c0 + j) * 256 + hd]; }
#pragma unroll
        for (int j = 0; j < 8; ++j) { US[(size_t)(c0 + j) * 32768 + e] = S; S = d[j] * S + u[j]; }
    }
    a.out[O_GLAP + e] = S;
}
__device__ __forceinline__ void gla_decode_item(const KArgs& a, int item, int lane) {
    const int b = item >> 2, h = item & 3; const int row = SROW + b;
    const bf16_t* proj = (const bf16_t*)(a.ws + WS_BIG); const float* la = (const float*)(a.ws + WS_BIG + BIG_LA);
    bf16_t* mix = (bf16_t*)(a.ws + WS_R1);
    const float* S0 = a.in[I_SGLA] + ((size_t)b * 4 + h) * 8192;
    float* S1 = a.out + O_GLAS + ((size_t)b * 4 + h) * 8192;
    const float qv = bf2f(proj[(size_t)row * NPROJ + PQA + h * 64 + lane]) * 0.125f;
    const float kv = bf2f(proj[(size_t)row * NPROJ + PKA + h * 64 + lane]);
    const float av = __expf(la[(size_t)row * 256 + h * 64 + lane]);
    const unsigned vw = *(const unsigned*)(proj + (size_t)row * NPROJ + PVA + h * 128 + lane * 2);
    const float v0 = bf_lo(vw), v1 = bf_hi(vw);
    float o0 = 0.f, o1 = 0.f;
#pragma unroll 8
    for (int dk = 0; dk < 64; ++dk) {
        const float q = __shfl(qv, dk), k = __shfl(kv, dk), al = __shfl(av, dk);
        const f32x2 s = *(const f32x2*)(S0 + dk * 128 + lane * 2);
        const float n0 = al * s.x + k * v0, n1 = al * s.y + k * v1;
        *(f32x2*)(S1 + dk * 128 + lane * 2) = (f32x2){n0, n1};
        o0 += q * n0; o1 += q * n1;
    }
    const float ss = wave_sum(o0 * o0 + o1 * o1);
    const float rstd = rsqrtf(ss * (1.0f / 128.f) + EPS);
    const unsigned rw = *(const unsigned*)(proj + (size_t)row * NPROJ + PRA + h * 128 + lane * 2);
    const float r0 = bf_lo(rw), r1 = bf_hi(rw);
    const float y0 = o0 * rstd * a.in[I_ONORM][lane * 2] * (r0 / (1.f + __expf(-r0))), y1 = o1 * rstd * a.in[I_ONORM][lane * 2 + 1] * (r1 / (1.f + __expf(-r1)));
    *(unsigned*)(mix + (size_t)row * D + h * 128 + lane * 2) = cvt_pk_bf16(y0, y1);
}

__device__ __forceinline__ void swa_unit(const KArgs& a, LAS unsigned char* lds, int unit) {
    const int tid = otid(); const int qblk = unit >> 1, kvh = unit & 1;
    const bf16_t* proj = (const bf16_t*)(a.ws + WS_BIG);
    bf16_t* mix = (bf16_t*)(a.ws + WS_R1);
    LAS float* Kw = (LAS float*)lds; LAS float* Vw = Kw + 255 * 68;
    const int tk0 = qblk * 128 - 127;
    const float* kn = a.in[I_KNORM];
    for (int idx = tid; idx < 256 * 8; idx += NTHREADS) {
        const int kk = idx >> 3, part = idx & 7; const int tk = tk0 + kk;
        float kf[8], vf[8];
#pragma unroll
        for (int j = 0; j < 8; ++j) { kf[j] = 0.f; vf[j] = 0.f; }
        if (kk < 255 && tk >= 0) {
            const u32x4 kw = *(const u32x4*)(proj + (size_t)tk * NPROJ + PKB + kvh * 64 + part * 8); unpack8(kw, kf);
            const u32x4 vw = *(const u32x4*)(proj + (size_t)tk * NPROJ + PVB + kvh * 64 + part * 8); unpack8(vw, vf);
        }
        float ss = 0.f;
#pragma unroll
        for (int j = 0; j < 8; ++j) ss += kf[j] * kf[j];
        ss += __shfl_xor(ss, 1); ss += __shfl_xor(ss, 2); ss += __shfl_xor(ss, 4);
        const float rstd = rsqrtf(ss * (1.0f / 64.f) + EPS);
#pragma unroll
        for (int j = 0; j < 8; ++j) kf[j] = kf[j] * rstd * kn[part * 8 + j];
        if (kk < 255) {
            *(LAS f32x4*)(Kw + kk * 68 + part * 8) = (f32x4){kf[0], kf[1], kf[2], kf[3]}; *(LAS f32x4*)(Kw + kk * 68 + part * 8 + 4) = (f32x4){kf[4], kf[5], kf[6], kf[7]};
            *(LAS f32x4*)(Vw + kk * 68 + part * 8) = (f32x4){vf[0], vf[1], vf[2], vf[3]}; *(LAS f32x4*)(Vw + kk * 68 + part * 8 + 4) = (f32x4){vf[4], vf[5], vf[6], vf[7]};
            if (qblk == 127 && kk >= 127) {
                const int w = kk - 127;
                float* ko = a.out + O_SKP + ((size_t)w * 2 + kvh) * 64 + part * 8; float* vo = a.out + O_SVP + ((size_t)w * 2 + kvh) * 64 + part * 8;
                *(f32x4*)ko = (f32x4){kf[0], kf[1], kf[2], kf[3]}; *(f32x4*)(ko + 4) = (f32x4){kf[4], kf[5], kf[6], kf[7]};
                *(f32x4*)vo = (f32x4){vf[0], vf[1], vf[2], vf[3]}; *(f32x4*)(vo + 4) = (f32x4){vf[4], vf[5], vf[6], vf[7]};
            }
        }
    }
    __syncthreads();
    const int g = tid >> 7, qi = tid & 127, hq = kvh * 4 + g; const int t = qblk * 128 + qi;
    float q[64];
    { float ss = 0.f;
#pragma unroll
      for (int p = 0; p < 8; ++p) { const u32x4 qw = *(const u32x4*)(proj + (size_t)t * NPROJ + PQB + hq * 64 + p * 8); unpack8(qw, q + p * 8); }
#pragma unroll
      for (int d = 0; d < 64; ++d) ss += q[d] * q[d];
      const float rstd = rsqrtf(ss * (1.0f / 64.f) + EPS) * 0.125f;
#pragma unroll
      for (int d = 0; d < 64; ++d) q[d] = q[d] * rstd * a.in[I_QNORM][d]; }
    const float slope = exp2f(-(float)(hq + 1));
    float mx = a.in[I_SINKS][hq], l = 1.f;
    float o[64];
#pragma unroll
    for (int d = 0; d < 64; ++d) o[d] = 0.f;
    for (int i = 0; i < 128; ++i) {
        const int kk = qi + i; const int tk = tk0 + kk;
        const LAS float* kr = Kw + kk * 68;
        float s0 = 0.f, s1 = 0.f, s2 = 0.f, s3 = 0.f;
#pragma unroll
        for (int d = 0; d < 64; d += 4) { const f32x4 k4 = *(const LAS f32x4*)(kr + d); s0 += q[d] * k4[0]; s1 += q[d + 1] * k4[1]; s2 += q[d + 2] * k4[2]; s3 += q[d + 3] * k4[3]; }
        float s = (s0 + s1) + (s2 + s3) - slope * (float)(127 - i);
        if (tk < 0) s = -1e30f;
        const float mn = fmaxf(mx, s); const float corr = __expf(mx - mn), p = __expf(s - mn);
        mx = mn; l = l * corr + p;
        const LAS float* vr = Vw + kk * 68;
#pragma unroll
        for (int d = 0; d < 64; d += 4) { const f32x4 v4 = *(const LAS f32x4*)(vr + d); o[d] = o[d] * corr + p * v4[0]; o[d + 1] = o[d + 1] * corr + p * v4[1]; o[d + 2] = o[d + 2] * corr + p * v4[2]; o[d + 3] = o[d + 3] * corr + p * v4[3]; }
    }
    const float inv = 1.f / l;
#pragma unroll
    for (int p = 0; p < 8; ++p) { u32x4 w; w.x = cvt_pk_bf16(o[p * 8] * inv, o[p * 8 + 1] * inv); w.y = cvt_pk_bf16(o[p * 8 + 2] * inv, o[p * 8 + 3] * inv);
        w.z = cvt_pk_bf16(o[p * 8 + 4] * inv, o[p * 8 + 5] * inv); w.w = cvt_pk_bf16(o[p * 8 + 6] * inv, o[p * 8 + 7] * inv);
        *(u32x4*)(mix + (size_t)t * D + 512 + hq * 64 + p * 8) = w; }
    __syncthreads();
}
__device__ __forceinline__ void swa_unit_m(const KArgs& a, LAS unsigned char* lds, int unit) {
    const int tid = otid(), lane = tid & 63, wave = __builtin_amdgcn_readfirstlane(tid >> 6);
    const int qb = unit >> 1, kvh = unit & 1; const int q0 = qb * 64, w0 = q0 - 128;
    const bf16_t* proj = (const bf16_t*)(a.ws + WS_BIG);
    bf16_t* mix = (bf16_t*)(a.ws + WS_R1);
    LAS bf16_t* Kl = (LAS bf16_t*)lds;
    LAS bf16_t* Vt = Kl + 192 * 72;
    const float* kn = a.in[I_KNORM];
#pragma unroll 1
    for (int c = tid; c < 1536; c += NTHREADS) {
        const int kk = c >> 3, part = c & 7; const int tk = w0 + kk;
        float kf[8];
        u32x4 vw = (u32x4){0u, 0u, 0u, 0u};
#pragma unroll
        for (int j = 0; j < 8; ++j) kf[j] = 0.f;
        if (tk >= 0) {
            const u32x4 kw = *(const u32x4*)(proj + (size_t)tk * NPROJ + PKB + kvh * 64 + part * 8); unpack8(kw, kf);
            vw = *(const u32x4*)(proj + (size_t)tk * NPROJ + PVB + kvh * 64 + part * 8);
        }
        float ss = 0.f;
#pragma unroll
        for (int j = 0; j < 8; ++j) ss += kf[j] * kf[j];
        ss += __shfl_xor(ss, 1); ss += __shfl_xor(ss, 2); ss += __shfl_xor(ss, 4);
        const float rstd = rsqrtf(ss * (1.0f / 64.f) + EPS);
#pragma unroll
        for (int j = 0; j < 8; ++j) kf[j] = kf[j] * rstd * kn[part * 8 + j];
        u32x4 kw2; kw2.x = cvt_pk_bf16(kf[0], kf[1]); kw2.y = cvt_pk_bf16(kf[2], kf[3]); kw2.z = cvt_pk_bf16(kf[4], kf[5]); kw2.w = cvt_pk_bf16(kf[6], kf[7]);
        *(LAS u32x4*)(Kl + kk * 72 + part * 8) = kw2;
        LAS bf16_t* vt = Vt + (part * 8) * 196 + kk;
        vt[0 * 196] = (bf16_t)(vw.x & 0xffffu); vt[1 * 196] = (bf16_t)(vw.x >> 16); vt[2 * 196] = (bf16_t)(vw.y & 0xffffu); vt[3 * 196] = (bf16_t)(vw.y >> 16);
        vt[4 * 196] = (bf16_t)(vw.z & 0xffffu); vt[5 * 196] = (bf16_t)(vw.z >> 16); vt[6 * 196] = (bf16_t)(vw.w & 0xffffu); vt[7 * 196] = (bf16_t)(vw.w >> 16);
        if (qb == 255 && kk >= 64) {
            const int w = kk - 64;
            float vf[8]; unpack8(vw, vf);
            float* ko = a.out + O_SKP + ((size_t)w * 2 + kvh) * 64 + part * 8; float* vo = a.out + O_SVP + ((size_t)w * 2 + kvh) * 64 + part * 8;
            *(f32x4*)ko = (f32x4){kf[0], kf[1], kf[2], kf[3]}; *(f32x4*)(ko + 4) = (f32x4){kf[4], kf[5], kf[6], kf[7]};
            *(f32x4*)vo = (f32x4){vf[0], vf[1], vf[2], vf[3]}; *(f32x4*)(vo + 4) = (f32x4){vf[4], vf[5], vf[6], vf[7]};
        }
    }
    __syncthreads();
    const int g = wave & 3, th = wave >> 2, hq = kvh * 4 + g;
    const int r = lane & 31, hh = lane >> 5;
    const int t = q0 + 32 * th + r;
    constexpr float LOG2E = 1.4426950408889634f;
    bf16x8 qf[4];
    {
        float qv[4][8]; float ss = 0.f;
#pragma unroll
        for (int s = 0; s < 4; ++s) { const u32x4 w = *(const u32x4*)(proj + (size_t)t * NPROJ + PQB + hq * 64 + 16 * s + 8 * hh); unpack8(w, qv[s]);
#pragma unroll
            for (int j = 0; j < 8; ++j) ss += qv[s][j] * qv[s][j]; }
        ss += __shfl_xor(ss, 32);
        const float rstd = rsqrtf(ss * (1.0f / 64.f) + EPS) * (0.125f * LOG2E);
        const float* qn = a.in[I_QNORM];
#pragma unroll
        for (int s = 0; s < 4; ++s) {
            u32x4 w;
            w.x = cvt_pk_bf16(qv[s][0] * rstd * qn[16 * s + 8 * hh + 0], qv[s][1] * rstd * qn[16 * s + 8 * hh + 1]);
            w.y = cvt_pk_bf16(qv[s][2] * rstd * qn[16 * s + 8 * hh + 2], qv[s][3] * rstd * qn[16 * s + 8 * hh + 3]);
            w.z = cvt_pk_bf16(qv[s][4] * rstd * qn[16 * s + 8 * hh + 4], qv[s][5] * rstd * qn[16 * s + 8 * hh + 5]);
            w.w = cvt_pk_bf16(qv[s][6] * rstd * qn[16 * s + 8 * hh + 6], qv[s][7] * rstd * qn[16 * s + 8 * hh + 7]);
            qf[s] = __builtin_bit_cast(bf16x8, w);
        }
    }
    f32x16 sacc[5];
#pragma unroll
    for (int k5 = 0; k5 < 5; ++k5) {
        const int kt = th + k5;
        f32x16 acc = {};
#pragma unroll
        for (int s = 0; s < 4; ++s) { const bf16x8 af = *(const LAS bf16x8*)(Kl + (kt * 32 + r) * 72 + 16 * s + 8 * hh); acc = __builtin_amdgcn_mfma_f32_32x32x16_bf16(af, qf[s], acc, 0, 0, 0); }
        sacc[k5] = acc;
    }
    const float slope2 = exp2f(-(float)(hq + 1)) * LOG2E;
    const float sink2 = a.in[I_SINKS][hq] * LOG2E;
    float mx = sink2;
#pragma unroll
    for (int k5 = 0; k5 < 5; ++k5)
#pragma unroll
        for (int i = 0; i < 16; ++i) {
            const int row = (i & 3) + 8 * (i >> 2) + 4 * hh;
            const int dist = 128 - 32 * k5 + r - row;
            const int tk = w0 + 32 * (th + k5) + row;
            float s = sacc[k5][i] - slope2 * (float)dist;
            if (dist < 0 || dist >= 128 || tk < 0) s = -1e30f;
            sacc[k5][i] = s; mx = fmaxf(mx, s);
        }
    mx = fmaxf(mx, __shfl_xor(mx, 32));
    float l = 0.f;
#pragma unroll
    for (int k5 = 0; k5 < 5; ++k5)
#pragma unroll
        for (int i = 0; i < 16; ++i) { const float p = exp2f(sacc[k5][i] - mx); sacc[k5][i] = p; l += p; }
    l += __shfl_xor(l, 32);
    l += exp2f(sink2 - mx);
    f32x16 oacc[2] = {{}, {}};
#pragma unroll
    for (int k5 = 0; k5 < 5; ++k5) {
        const int kt = th + k5;
#pragma unroll
        for (int s2 = 0; s2 < 2; ++s2) {
            u32x4 pw;
            pw.x = cvt_pk_bf16(sacc[k5][8 * s2 + 0], sacc[k5][8 * s2 + 1]); pw.y = cvt_pk_bf16(sacc[k5][8 * s2 + 2], sacc[k5][8 * s2 + 3]);
            pw.z = cvt_pk_bf16(sacc[k5][8 * s2 + 4], sacc[k5][8 * s2 + 5]); pw.w = cvt_pk_bf16(sacc[k5][8 * s2 + 6], sacc[k5][8 * s2 + 7]);
            const bf16x8 pf = __builtin_bit_cast(bf16x8, pw);
#pragma unroll
            for (int dt = 0; dt < 2; ++dt) {
                const LAS bf16_t* vp = Vt + (32 * dt + r) * 196 + kt * 32 + 16 * s2 + 4 * hh;
                const u32x2 v0 = *(const LAS u32x2*)vp, v1 = *(const LAS u32x2*)(vp + 8);
                const u32x4 vv = (u32x4){v0.x, v0.y, v1.x, v1.y};
                oacc[dt] = __builtin_amdgcn_mfma_f32_32x32x16_bf16(__builtin_bit_cast(bf16x8, vv), pf, oacc[dt], 0, 0, 0);
            }
        }
    }
    const float inv = 1.f / l;
#pragma unroll
    for (int dt = 0; dt < 2; ++dt)
#pragma unroll
        for (int q = 0; q < 4; ++q) {
            u32x2 w; w.x = cvt_pk_bf16(oacc[dt][4 * q] * inv, oacc[dt][4 * q + 1] * inv); w.y = cvt_pk_bf16(oacc[dt][4 * q + 2] * inv, oacc[dt][4 * q + 3] * inv);
            *(u32x2*)(mix + (size_t)t * D + 512 + hq * 64 + 32 * dt + 8 * q + 4 * hh) = w;
        }
    __syncthreads();
}
__device__ __forceinline__ void swa_decode_item(const KArgs& a, int item, int lane) {
    const int b = item >> 3, kvh = (item >> 2) & 1, g = item & 3, hq = kvh * 4 + g; const int row = SROW + b;
    const bf16_t* proj = (const bf16_t*)(a.ws + WS_BIG);
    bf16_t* mix = (bf16_t*)(a.ws + WS_R1);
    const float* ck = a.in[I_CK] + (size_t)b * 128 * 128 + kvh * 64;
    const float* cv = a.in[I_CV] + (size_t)b * 128 * 128 + kvh * 64;
    float qd = bf2f(proj[(size_t)row * NPROJ + PQB + hq * 64 + lane]);
    { const float ss = wave_sum(qd * qd); qd = qd * rsqrtf(ss * (1.0f / 64.f) + EPS) * a.in[I_QNORM][lane] * 0.125f; }
    float kd = bf2f(proj[(size_t)row * NPROJ + PKB + kvh * 64 + lane]);
    { const float ss = wave_sum(kd * kd); kd = kd * rsqrtf(ss * (1.0f / 64.f) + EPS) * a.in[I_KNORM][lane]; }
    const float vd = bf2f(proj[(size_t)row * NPROJ + PVB + kvh * 64 + lane]);
    const float slope = exp2f(-(float)(hq + 1));
    float s0 = 0.f, s1 = 0.f;
    for (int d = 0; d < 64; d += 4) {
        const f32x4 k0 = *(const f32x4*)(ck + (size_t)lane * 128 + d), k1 = *(const f32x4*)(ck + (size_t)(lane + 64) * 128 + d);
        const float q0 = __shfl(qd, d), q1 = __shfl(qd, d + 1), q2 = __shfl(qd, d + 2), q3 = __shfl(qd, d + 3);
        s0 += (q0 * k0[0] + q1 * k0[1]) + (q2 * k0[2] + q3 * k0[3]);
        s1 += (q0 * k1[0] + q1 * k1[1]) + (q2 * k1[2] + q3 * k1[3]);
    }
    s0 -= slope * (float)(128 - lane); s1 -= slope * (float)(64 - lane);
    if (lane == 0) s0 = -1e30f;
    const float sn = wave_sum(qd * kd);
    const float sink = a.in[I_SINKS][hq];
    const float mx = fmaxf(fmaxf(wave_max(fmaxf(s0, s1)), sn), sink);
    const float p0 = __expf(s0 - mx), p1 = __expf(s1 - mx), pn = __expf(sn - mx);
    const float l = wave_sum(p0 + p1) + pn + __expf(sink - mx);
    float od = pn * vd;
#pragma unroll 8
    for (int w = 0; w < 64; ++w) { const float pa = __shfl(p0, w), pb = __shfl(p1, w); od += pa * cv[(size_t)w * 128 + lane] + pb * cv[(size_t)(w + 64) * 128 + lane]; }
    od /= l;
    const float oo = __shfl_down(od, 1);
    if ((lane & 1) == 0) *(unsigned*)(mix + (size_t)row * D + 512 + hq * 64 + lane) = cvt_pk_bf16(od, oo);
    if (g == 0) {
        float* ko = a.out + O_SKS + (size_t)b * 128 * 128 + kvh * 64; float* vo = a.out + O_SVS + (size_t)b * 128 * 128 + kvh * 64;
#pragma unroll 4
        for (int w = 0; w < 127; ++w) { ko[(size_t)w * 128 + lane] = ck[(size_t)(w + 1) * 128 + lane]; vo[(size_t)w * 128 + lane] = cv[(size_t)(w + 1) * 128 + lane]; }
        ko[(size_t)127 * 128 + lane] = kd; vo[(size_t)127 * 128 + lane] = vd;
    }
}

__device__ __forceinline__ void pool_item(const KArgs& a, LAS unsigned char* lds, int item, const float* part_in) {
    const int tid = otid();
    const float* h = a.out + O_YP; bf16_t* d1 = (bf16_t*)(a.ws + WS_R1);
    LAS float* rsL = (LAS float*)lds;
    const int r0 = item * 64;
    __syncthreads();
    if (tid < 80) { const int r = r0 - 16 + tid; float rs = 0.f;
        if (r >= 0) { float s = 0.f;
#pragma unroll
            for (int i = 0; i < 16; ++i) s += part_in[(long)r * 16 + i];
            rs = rsqrtf(s * (1.0f / D) + EPS); }
        rsL[tid] = rs; }
    __syncthreads();
#pragma unroll
    for (int cc = 0; cc < 2; ++cc) {
        const int c = tid + cc * NTHREADS; const int w = 2 << (c >> 8);
        const float gg = a.in[I_MNO][c];
        float s = 0.f;
        for (int r = r0 - w + 1; r < r0; ++r) if (r >= 0) s += h[(size_t)r * D + c] * rsL[r - r0 + 16] * gg;
        for (int r = r0; r < r0 + 64; ++r) {
            const float xn = h[(size_t)r * D + c] * rsL[r - r0 + 16] * gg;
            s += xn;
            const int cnt = (r + 1 < w) ? r + 1 : w;
            const float dd = s / (float)cnt - xn;
            d1[(size_t)r * D + c] = (bf16_t)(cvt_pk_bf16(dd, 0.f) & 0xffffu);
            const int ro = r - w + 1;
            if (ro >= 0) s -= h[(size_t)ro * D + c] * rsL[ro - r0 + 16] * gg;
            if (r >= SEQ - 15) a.out[O_POOLP + (size_t)(r - (SEQ - 15)) * D + c] = xn;
        }
    }
}
__device__ __forceinline__ void pool_sample_item(const KArgs& a, LAS unsigned char* lds, int b, const float* part_in) {
    const int tid = otid();
    const float* h = a.out + O_YS + (size_t)b * D; bf16_t* d1 = (bf16_t*)(a.ws + WS_R1);
    const float* st = a.in[I_SPOOL] + (size_t)b * 15 * D; float* so = a.out + O_POOLS + (size_t)b * 15 * D;
    float s = 0.f;
#pragma unroll
    for (int i = 0; i < 16; ++i) s += part_in[(long)(SROW + b) * 16 + i];
    const float rs = rsqrtf(s * (1.0f / D) + EPS);
#pragma unroll
    for (int cc = 0; cc < 2; ++cc) {
        const int c = tid + cc * NTHREADS; const int w = 2 << (c >> 8);
        const float xn = h[c] * rs * a.in[I_MNO][c];
        float sum = xn;
        for (int j = 16 - w; j < 15; ++j) sum += st[(size_t)j * D + c];
        const float dd = sum / (float)w - xn;
        d1[(size_t)(SROW + b) * D + c] = (bf16_t)(cvt_pk_bf16(dd, 0.f) & 0xffffu);
        for (int j = 0; j < 14; ++j) so[(size_t)j * D + c] = st[(size_t)(j + 1) * D + c];
        so[(size_t)14 * D + c] = xn;
    }
}


#define XB_TMO      128
#define XB_XCNT(j)  (256  + 64 * (j))
#define XB_XSUB(j)  (1280 + 64 * (j))
#define XB_XGEN(j)  (2304 + 64 * (j))
#define XB_TOP      3328
#define XB_TOPGEN   3392
#define XCD_BAR_WORDS 3456
#define XB_SPIN_CAP (1u << 18)
__device__ __forceinline__ unsigned xb_ld(unsigned* p)              { return __hip_atomic_load(p, __ATOMIC_RELAXED, __HIP_MEMORY_SCOPE_AGENT); }
__device__ __forceinline__ unsigned xb_add(unsigned* p, unsigned v) { return __hip_atomic_fetch_add(p, v, __ATOMIC_RELAXED, __HIP_MEMORY_SCOPE_AGENT); }
__device__ __forceinline__ unsigned xb_xcc_id() { return (unsigned)__builtin_amdgcn_s_getreg((3 << 11) | 20) & 0xFu; }
#define XB_SPIN(cond, bar) do { unsigned _sp = 0; while (cond) { __builtin_amdgcn_s_sleep(1); \
    if ((++_sp & 255u) == 0u) { if (xb_ld(&(bar)[XB_TMO])) break; if (_sp > XB_SPIN_CAP) { atomicAdd(&(bar)[XB_TMO], 1u); break; } } } } while (0)
struct XcdBarrier { unsigned* bar; unsigned x; volatile LAS unsigned* st; };
__device__ __forceinline__ XcdBarrier xcd_barrier_post(unsigned* bar, volatile LAS unsigned* st) {
    XcdBarrier b; b.bar = bar; b.x = xb_xcc_id(); b.st = st;
    if (threadIdx.x == 0) (void)xb_add(&bar[XB_XCNT(b.x)], 1u);
    return b;
}
__device__ __forceinline__ void xcd_barrier_complete(unsigned* bar, unsigned x, unsigned& nloc, unsigned& nx) {
    const unsigned G = gridDim.x * gridDim.y * gridDim.z;
    unsigned sum, cnt, mine, sp = 0u;
    for (;;) {
        sum = 0u; cnt = 0u; mine = 0u;
#pragma unroll
        for (unsigned j = 0; j < 16; ++j) { const unsigned c = xb_ld(&bar[XB_XCNT(j)]); sum += c; cnt += (c > 0u) ? 1u : 0u; mine = (j == x) ? c : mine; }
        if (sum == G) break;
        __builtin_amdgcn_s_sleep(1);
        if ((++sp & 255u) == 0u) { if (xb_ld(&bar[XB_TMO])) break; if (sp > XB_SPIN_CAP) { atomicAdd(&bar[XB_TMO], 1u); break; } }
    }
    nloc = mine > 0u ? mine : 1u; nx = cnt > 0u ? cnt : 1u;
}
__device__ __forceinline__ void xcd_barrier(const XcdBarrier& b) {
    asm volatile("s_waitcnt vmcnt(0)" ::: "memory");
    __syncthreads();
    if (threadIdx.x == 0) {
        unsigned* bar = b.bar;
        __builtin_amdgcn_s_waitcnt(0);
        unsigned nloc = b.st[0], nx = b.st[1];
        if (nloc == 0u) { xcd_barrier_complete(bar, b.x, nloc, nx); b.st[0] = nloc; b.st[1] = nx; }
        const unsigned old = xb_add(&bar[XB_XSUB(b.x)], 1u);
        const unsigned gen = old / nloc;
        if (old + 1u == (gen + 1u) * nloc) {
            __builtin_amdgcn_fence(__ATOMIC_RELEASE, "agent");
            asm volatile("s_waitcnt vmcnt(0)" ::: "memory");
            const unsigned og = xb_add(&bar[XB_TOP], 1u);
            const unsigned tg = og / nx;
            if (og + 1u == (tg + 1u) * nx) xb_add(&bar[XB_TOPGEN], 1u);
            else XB_SPIN(xb_ld(&bar[XB_TOPGEN]) == tg, bar);
            __builtin_amdgcn_fence(__ATOMIC_ACQUIRE, "agent");
            xb_add(&bar[XB_XGEN(b.x)], 1u);
            asm volatile("s_waitcnt vmcnt(0)" ::: "memory");
        } else {
            XB_SPIN(xb_ld(&bar[XB_XGEN(b.x)]) == gen, bar);
            __builtin_amdgcn_fence(__ATOMIC_ACQUIRE, "agent");
            asm volatile("s_waitcnt vmcnt(0)" ::: "memory");
        }
    }
    __syncthreads();
}

#ifndef DUPM
#define DUPM 0
#endif
#ifndef SYNCREP
#define SYNCREP 1
#endif
#define GSYNC() do { _Pragma("unroll 1") for (int sr_ = 0; sr_ < SYNCREP; ++sr_) xcd_barrier(xbar); } while (0)
#define PH(k) _Pragma("unroll 1") for (int rep_ = 0; rep_ < (((DUPM) >> (k)) & 1) + 1; ++rep_)
__global__ void __launch_bounds__(NTHREADS, 2) mega_fwd(KArgs a) {
    extern __shared__ __attribute__((aligned(16))) unsigned char lds_raw[];
    LAS unsigned char* lds = (LAS unsigned char*)lds_raw;
    cg::grid_group grid = cg::this_grid();
    const int G = gridDim.x, bx = blockIdx.x;
    const int vcu = (G % 8 == 0) ? (bx % 8) * (G / 8) + bx / 8 : bx;
    unsigned char* ws = a.ws;
    if (ws == nullptr) grid.sync();
    volatile LAS unsigned* xst = (volatile LAS unsigned*)(lds + LDS_BYTES - 64);
    if (threadIdx.x < 16) xst[threadIdx.x] = 0u;
    __syncthreads();
    const XcdBarrier xbar = xcd_barrier_post((unsigned*)(ws + 16384), xst);
    bf16_t* R1 = (bf16_t*)(ws + WS_R1); bf16_t* R2 = (bf16_t*)(ws + WS_R2 + 4096);
    bf16_t* BIGB = (bf16_t*)(ws + WS_BIG);
    const bf16_t* pbf = (const bf16_t*)(ws + WS_PBF);

    PH(0) p0_prologue(a, lds, vcu, G);
    GSYNC();
    PH(1) {
        pg8::Gemm g{R1, (const bf16_t*)(ws + WS_WIN0), 1024, 1024, 1024, 256, 0, 0};
        pg8::StaticOrder S; S.init(65, 10, G, bx);
        EpiProj E{BIGB, (float*)(ws + WS_BIG + BIG_LA), (const float*)(ws + WS_SSQ), a.in[I_BALPHA]};
        pg8::gemm_phase(lds, g, S, E);
    }
    GSYNC();
    PH(2) for (int it = vcu; it < 256; it += G) gla_item_m<false>(a, lds, it);
    PH(3) for (int it = vcu; it < 512; it += G) swa_unit_m(a, lds, it);
    PH(4) { const int tid = otid(), lane = tid & 63, wave = __builtin_amdgcn_readfirstlane(tid >> 6); for (int it = vcu * 8 + wave; it < 512; it += G * 8) gla_decode_item(a, it, lane); }
    PH(5) { const int tid = otid(), lane = tid & 63, wave = __builtin_amdgcn_readfirstlane(tid >> 6); for (int it = vcu * 8 + wave; it < 1024; it += G * 8) swa_decode_item(a, it, lane); }
    GSYNC();
    PH(6) gla_scan_m(a, vcu);
    GSYNC();
    PH(7) for (int it = vcu; it < 256; it += G) gla_item_m<true>(a, lds, it);
    GSYNC();
    PH(8) {
        pg8::Gemm g{R1, (const bf16_t*)(ws + WS_WOUT0), 1024, 1024, 1024, 256, 0, 0};
        pg8::StaticOrder S; S.init(65, 4, G, bx);
        EpiRes<0, true, true> E{a.out, a.in[I_XP], a.in[I_XS], R2, part_tab(ws, 0), nullptr, nullptr, nullptr};
        pg8::gemm_phase(lds, g, S, E);
    }
    GSYNC();
#pragma unroll 1
    for (int l = 0; l < 2; ++l) {
        bf16_t* G_ = BIGB;
        bf16_t* PPb = BIGB;
        PH(9) {
            pg8::Gemm g{R2, (const bf16_t*)(ws + WS_WFFI + l * WFFI_BYTES), 1024, 1024, 1024, 254, -2, 0};
            pg8::StaticOrder S; S.init(66, 22, G, bx);
            EpiFfn E{part_tab(ws, l == 0 ? 0 : 3), a.in[I_FCW] + (size_t)l * 3 * DFF, a.in[I_FCB] + (size_t)l * DFF, a.in[I_SCONV] + (size_t)l * NS * 2 * DFF,
                     a.out + O_CONVP + (size_t)l * 2 * DFF, a.out + O_CONVS + (size_t)l * NS * 2 * DFF, G_};
            pg8::gemm_phase(lds, g, S, E);
        }
        GSYNC();
        PH(10) {
            pg8::Gemm g{G_, (const bf16_t*)(ws + WS_WFFO + l * WFFO_BYTES), DFF, DFF, DFF, 256, 0, 0};
            pg8::StaticOrder S; S.init(65, 4, G, bx);
            EpiRes<1, true, true> E{a.out, nullptr, nullptr, R1, part_tab(ws, l == 0 ? 1 : 4), nullptr, nullptr, nullptr};
            pg8::gemm_phase(lds, g, S, E);
        }
        GSYNC();
        PH(11) {
            pg8::Gemm g{pbf + (size_t)l * MT * PLE, (const bf16_t*)(ws + WS_WPROJ + l * WPROJ_BYTES), PLE, PLE, PLE, 256, 0, 0};
            pg8::StaticOrder S; S.init(65, 4, G, bx);
            EpiPP E{PPb};
            pg8::gemm_phase(lds, g, S, E);
        }
        PH(12) {
            pg8::Gemm g{R1, (const bf16_t*)(ws + WS_WGATE + l * WGATE_BYTES), 1024, 1024, 1024, 256, 0, 0};
            pg8::StaticOrder S; S.init(65, 4, G, bx);
            if (l == 0) { EpiRes<2, false, true> E{a.out, nullptr, nullptr, nullptr, part_tab(ws, 2), part_tab(ws, 1), PPb, nullptr}; pg8::gemm_phase(lds, g, S, E); }
            else { EpiRes<2, false, false> E{a.out, nullptr, nullptr, nullptr, nullptr, part_tab(ws, 4), PPb, nullptr}; pg8::gemm_phase(lds, g, S, E); }
        }
        if (l == 0) {
            GSYNC();
            PH(13) for (int it = vcu; it < 256 + NS; it += G) { if (it < 256) pool_item(a, lds, it, part_tab(ws, 2)); else pool_sample_item(a, lds, it - 256, part_tab(ws, 2)); }
            GSYNC();
            PH(14) {
                pg8::Gemm g{R1, (const bf16_t*)(ws + WS_WPOOL), 1024, 256, 256, 256, 0, 256};
                pg8::StaticOrder S; S.init(65, 4, G, bx);
                EpiRes<3, true, true> E{a.out, nullptr, nullptr, R2, part_tab(ws, 3), nullptr, nullptr, a.in[I_POOLSC]};
                pg8::gemm_phase(lds, g, S, E);
            }
            GSYNC();
        }
    }
}

extern "C" void kernel_launch(void* const* d_in, const int* in_sizes, int n_in, void* d_out, int out_size, void* d_ws, size_t ws_size, hipStream_t stream) {
    static int grid = 0;
    if (grid == 0) {
        int dev = 0, cus = 0, per_cu = 0;
        hipGetDevice(&dev);
        hipDeviceGetAttribute(&cus, hipDeviceAttributeMultiprocessorCount, dev);
        hipFuncSetAttribute((const void*)mega_fwd, hipFuncAttributeMaxDynamicSharedMemorySize, LDS_BYTES);
        hipOccupancyMaxActiveBlocksPerMultiprocessor(&per_cu, (const void*)mega_fwd, NTHREADS, LDS_BYTES);
        if (per_cu < 1) { fprintf(stderr, "kernel_launch: occupancy query reports %d blocks per CU\n", per_cu); per_cu = 1; }
        if (per_cu > 1) per_cu = 1;
        grid = cus * per_cu;
        (void)hipGetLastError();
    }
    (void)hipMemsetAsync(d_ws, 0, 65536, stream);
    KArgs a{};
    for (int i = 0; i < 29; ++i) a.in[i] = (const float*)d_in[i];
    a.out = (float*)d_out; a.ws = (unsigned char*)d_ws;
    void* args[] = {&a};
    hipError_t e = hipLaunchCooperativeKernel((const void*)mega_fwd, dim3(grid), dim3(NTHREADS), args, LDS_BYTES, stream);
    if (e != hipSuccess) fprintf(stderr, "cooperative launch failed: %s (grid %d)\n", hipGetErrorString(e), grid);
}
```

```cpp
#include <hip/hip_runtime.h>
#include <hip/hip_cooperative_groups.h>
#include <cstdio>
#include <cstdint>
namespace cg = cooperative_groups;

#define LAS __attribute__((address_space(3)))
typedef unsigned short bf16_t;
typedef short bf16x8 __attribute__((ext_vector_type(8)));
typedef float f32x4 __attribute__((ext_vector_type(4)));
typedef float f32x2 __attribute__((ext_vector_type(2)));
typedef unsigned u32x4 __attribute__((ext_vector_type(4)));
typedef unsigned u32x2 __attribute__((ext_vector_type(2)));
typedef float f32x16 __attribute__((ext_vector_type(16)));

constexpr int D = 1024, SEQ = 16384, NS = 128, DFF = 2816, PLE = 256;
constexpr int SROW = 16510;
constexpr int MT = 16640;
constexpr int MR = 16768;
constexpr int NPROJ = 2304;
constexpr int PQA = 0, PKA = 256, PVA = 512, PRA = 1024, PQB = 1536, PKB = 2048, PVB = 2176;
constexpr float EPS = 1e-6f;
constexpr int NTHREADS = 512;

constexpr size_t O_YP = 0, O_YS = 16777216, O_GLAP = 16908288, O_SKP = 16941056, O_SVP = 16957440, O_POOLP = 16973824, O_CONVP = 16989184,
                 O_GLAS = 17000448, O_SKS = 21194752, O_SVS = 23291904, O_POOLS = 25389056, O_CONVS = 27355136;

constexpr size_t MiB = 1u << 20;
constexpr size_t WS_WIN0 = 1 * MiB, WS_WOUT0 = 6 * MiB, WS_WFFI = 8 * MiB, WS_WFFO = 30 * MiB, WS_WGATE = 41 * MiB, WS_WPROJ = 45 * MiB, WS_WPOOL = 46 * MiB;
constexpr size_t WS_SSQ = 47 * MiB;
constexpr size_t WS_PBF = 55 * MiB, WS_R1 = 72 * MiB, WS_R2 = 105 * MiB, WS_BIG = 138 * MiB;
constexpr size_t PART_STRIDE = (size_t)(MR + 8) * 16 * 4;
constexpr size_t WFFI_BYTES = (size_t)5632 * 1024 * 2, WFFO_BYTES = (size_t)1024 * 2816 * 2, WGATE_BYTES = (size_t)1024 * 1024 * 2, WPROJ_BYTES = (size_t)1024 * 256 * 2;
constexpr size_t BIG_LA = (size_t)MT * NPROJ * 2;
constexpr int LDS_BYTES = 155648;

__device__ __forceinline__ unsigned cvt_pk_bf16(float lo, float hi) { unsigned r; asm volatile("v_cvt_pk_bf16_f32 %0, %1, %2" : "=v"(r) : "v"(lo), "v"(hi)); return r; }
__device__ __forceinline__ float bf_lo(unsigned w) { return __uint_as_float(w << 16); }
__device__ __forceinline__ float bf_hi(unsigned w) { return __uint_as_float(w & 0xffff0000u); }
__device__ __forceinline__ float bf2f(bf16_t v) { return __uint_as_float(((unsigned)v) << 16); }
__device__ __forceinline__ void unpack8(const u32x4 w, float* f) { f[0] = bf_lo(w.x); f[1] = bf_hi(w.x); f[2] = bf_lo(w.y); f[3] = bf_hi(w.y); f[4] = bf_lo(w.z); f[5] = bf_hi(w.z); f[6] = bf_lo(w.w); f[7] = bf_hi(w.w); }
__device__ __forceinline__ float wave_sum(float v) {
#pragma unroll
    for (int o = 1; o < 64; o <<= 1) v += __shfl_xor(v, o);
    return v;
}
__device__ __forceinline__ float wave_max(float v) {
#pragma unroll
    for (int o = 1; o < 64; o <<= 1) v = fmaxf(v, __shfl_xor(v, o));
    return v;
}
__device__ __forceinline__ int otid() { int t = threadIdx.x; asm volatile("" : "+v"(t)); return t; }
__device__ __forceinline__ bool row_valid(int row) { return row < SEQ || (row >= SROW && row < SROW + NS); }
__device__ __forceinline__ float* hrow_ptr(float* out, int row) { return row < SEQ ? out + O_YP + (size_t)row * D : out + O_YS + (size_t)(row - SROW) * D; }
__device__ __forceinline__ f32x2 gelu_pk(f32x2 v) {
    const f32x2 av = __builtin_elementwise_abs(v), d = av * 0.2316418882f + 1.0f;
    f32x2 t; t.x = __builtin_amdgcn_rcpf(d.x); t.y = __builtin_amdgcn_rcpf(d.y);
    f32x2 q = t * 0.5307027145f + (-0.7265760135f); q = q * t + 0.7107068705f; q = q * t + (-0.142248368f); q = q * t + 0.127414796f; q = q * t;
    const f32x2 s = (v * v) * (-0.72134752044f);
    f32x2 e; e.x = __builtin_amdgcn_exp2f(s.x); e.y = __builtin_amdgcn_exp2f(s.y);
    const f32x2 m = v * (q * e), r = v - m;
    f32x2 o; o.x = v.x < 0.f ? m.x : r.x; o.y = v.y < 0.f ? m.y : r.y; return o;
}

namespace pg8 {
constexpr int BM = 256, BK = 64, HALF = 128, HTB = HALF * BK * 2, STAGE_BYTES = 8 * HTB, NXCD = 8, WGM = 8;
__host__ __device__ __forceinline__ int lds_byte(int r, int c) { const int st = (r >> 4) * 2 + (c >> 5), rr = r & 15, cc = c & 31, ob = rr * 64 + cc * 2; return st * 1024 + (ob ^ (((ob >> 9) & 1) << 5)); }
__host__ __device__ __forceinline__ void stage_rc(int b, int& R, int& C) { const int st = b / 1024, sb = b % 1024, swz = sb ^ (((sb >> 9) & 1) << 5); R = (st >> 1) * 16 + swz / 64; C = (st & 1) * 32 + (swz % 64) / 2; }
__host__ __device__ __forceinline__ int perm32(int rho) { const int n = rho >> 4, i = rho & 15; return 8 * (i >> 2) + 4 * n + (i & 3); }

struct Unit { int pm, pn; };
struct Gemm { const bf16_t* A; const bf16_t* Bt; int lda, ldb, K, mstride, arow0, acolstep; };

struct StaticOrder {
    int nM, nN, nwg, G, c;
    __device__ void init(int nM_, int nN_, int G_, int c_) { nM = nM_; nN = nN_; nwg = nM * nN; G = G_; c = c_; }
    __device__ bool next(int i, Unit& u) const {
        const long L = (long)i * G + c; if (L >= nwg) return false;
        int wgid = (int)L; { const int q = nwg / NXCD, r = nwg % NXCD, xcd = wgid % NXCD, off = wgid / NXCD; wgid = (xcd < r ? xcd * (q + 1) : r * (q + 1) + (xcd - r) * q) + off; }
        const int nig = WGM * nN, gid = wgid / nig, fm = gid * WGM, gsz = (nM - fm) < WGM ? (nM - fm) : WGM;
        u.pm = fm + ((wgid % nig) % gsz); u.pn = (wgid % nig) / gsz; return true;
    }
};

template <class Epi>
__device__ __forceinline__ void gemm_phase(LAS unsigned char* lds, const Gemm g, const StaticOrder& S, const Epi& E) {
    const int tid = otid(), wid = __builtin_amdgcn_readfirstlane(tid >> 6), lane = tid & 63, wr = wid >> 2, wc = wid & 3, fr = lane & 15, fq = lane >> 4;
    const int K = g.K, nt = K / BK;
    unsigned voffA[2], voffB[2];
#pragma unroll
    for (int i = 0; i < 2; ++i) { int R, C; stage_rc(tid * 16 + i * 8192, R, C); const int Rb = (R & ~31) + perm32(R & 31);
        voffA[i] = (unsigned)(R * g.lda + C) * 2u; voffB[i] = (unsigned)(Rb * g.ldb + C) * 2u; }
    const size_t kstep = (size_t)(BK * 2);
    const size_t hstepA = (size_t)HALF * g.lda * 2, hstepB = (size_t)HALF * g.ldb * 2;
    const unsigned ldsw = (unsigned)wid * 1024u;
    const int aoff = lds_byte(wr * 64 + fr, fq * 8), boff = lds_byte(wc * 32 + fr, fq * 8);
#define PG8_SA(b, h) (((b) * 2 + (h)) * HTB)
#define PG8_SB(b, h) ((4 + (b) * 2 + (h)) * HTB)
#define PG8_STAGE(bufoff, gbase, voff) do { _Pragma("unroll") for (int _i = 0; _i < 2; ++_i) \
        __builtin_amdgcn_global_load_lds((const unsigned*)((const char*)(gbase) + (voff)[_i]), (LAS unsigned*)(lds + (bufoff) + ldsw + _i * 8192), 16, 0, 0); } while (0)
#define PG8_LDA(dst, b, h) do { _Pragma("unroll") for (int m = 0; m < 4; ++m) _Pragma("unroll") for (int k = 0; k < 2; ++k) dst[m][k] = *(const LAS bf16x8*)(lds + PG8_SA(b, h) + aoff + m * 2048 + k * 1024); } while (0)
#define PG8_LDB(dst, b, h) do { _Pragma("unroll") for (int n = 0; n < 2; ++n) _Pragma("unroll") for (int k = 0; k < 2; ++k) dst[n][k] = *(const LAS bf16x8*)(lds + PG8_SB(b, h) + boff + n * 2048 + k * 1024); } while (0)
#define PG8_MMA(ai, bj, At, Bt) do { __builtin_amdgcn_s_setprio(1); _Pragma("unroll") for (int m = 0; m < 4; ++m) _Pragma("unroll") for (int n = 0; n < 2; ++n) _Pragma("unroll") for (int k = 0; k < 2; ++k) \
        acc[ai][bj][m][n] = __builtin_amdgcn_mfma_f32_16x16x32_bf16(Bt[n][k], At[m][k], acc[ai][bj][m][n], 0, 0, 0); __builtin_amdgcn_s_setprio(0); } while (0)
#define PG8_WAIT_V(n) asm volatile("s_waitcnt vmcnt(" #n ")" ::: "memory")
#define PG8_WAIT_L(n) asm volatile("s_waitcnt lgkmcnt(" #n ")" ::: "memory")
#define PG8_BAR __builtin_amdgcn_s_barrier()
#define PG8_SCHED __builtin_amdgcn_sched_barrier(0)
#define PG8_ABASE(u) ((const char*)g.A + ((long)((long)(u).pm * g.mstride + g.arow0) * g.lda + (long)(u).pn * g.acolstep) * 2)
#define PG8_BBASE(u) ((const char*)g.Bt + (size_t)(u).pn * 256 * g.ldb * 2)
    Unit cur, nxt; int ui = 0;
    if (!S.next(0, cur)) return;
    f32x4 acc[2][2][4][2];
#pragma unroll
    for (int a = 0; a < 2; ++a)
#pragma unroll
        for (int b = 0; b < 2; ++b)
#pragma unroll
            for (int m = 0; m < 4; ++m)
#pragma unroll
                for (int n = 0; n < 2; ++n) acc[a][b][m][n] = (f32x4){0.f, 0.f, 0.f, 0.f};
    bf16x8 At[4][2], B0[2][2], B1[2][2];
    const char* cA = PG8_ABASE(cur); const char* cB = PG8_BBASE(cur);
    PG8_STAGE(PG8_SB(0, 0), cB, voffB); PG8_STAGE(PG8_SB(0, 1), cB + hstepB, voffB); PG8_STAGE(PG8_SA(0, 0), cA, voffA); PG8_STAGE(PG8_SA(0, 1), cA + hstepA, voffA);
    if (wr == 1) PG8_BAR;
    PG8_WAIT_V(2); PG8_BAR;
    PG8_STAGE(PG8_SB(1, 0), cB + kstep, voffB); PG8_STAGE(PG8_SA(1, 0), cA + kstep, voffA); PG8_STAGE(PG8_SB(1, 1), cB + hstepB + kstep, voffB);
    PG8_WAIT_V(6); PG8_BAR;
    for (;;) {
        const bool has_next = S.next(ui + 1, nxt);
        const char* nA = has_next ? PG8_ABASE(nxt) : cA; const char* nB = has_next ? PG8_BBASE(nxt) : cB;
#pragma unroll 1
        for (int t = 0; t < nt; t += 2) {
            const bool last = (t == nt - 2);
            const char* a1 = cA + (size_t)(t + 1) * kstep;
            const char* a2 = last ? nA : cA + (size_t)(t + 2) * kstep; const char* b2 = last ? nB : cB + (size_t)(t + 2) * kstep;
            const char* a3 = a2 + kstep; const char* b3 = b2 + kstep;
            PG8_LDB(B0, 0, 0); PG8_LDB(B1, 0, 1); PG8_SCHED; PG8_LDA(At, 0, 0); PG8_STAGE(PG8_SA(1, 1), a1 + hstepA, voffA);
            PG8_WAIT_V(8); PG8_WAIT_L(0); PG8_BAR; PG8_MMA(0, 0, At, B0); PG8_MMA(0, 1, At, B1); PG8_BAR; PG8_SCHED;
            PG8_LDA(At, 0, 1); PG8_STAGE(PG8_SB(0, 0), b2, voffB); PG8_STAGE(PG8_SB(0, 1), b2 + hstepB, voffB); PG8_STAGE(PG8_SA(0, 0), a2, voffA);
            PG8_WAIT_V(8); PG8_WAIT_L(0); PG8_BAR; PG8_MMA(1, 0, At, B0); PG8_MMA(1, 1, At, B1); PG8_BAR; PG8_SCHED;
            PG8_LDB(B0, 1, 0); PG8_LDB(B1, 1, 1); PG8_SCHED; PG8_LDA(At, 1, 0); PG8_STAGE(PG8_SA(0, 1), a2 + hstepA, voffA);
            PG8_WAIT_V(8); PG8_WAIT_L(0); PG8_BAR; PG8_MMA(0, 0, At, B0); PG8_MMA(0, 1, At, B1); PG8_BAR; PG8_SCHED;
            PG8_LDA(At, 1, 1); PG8_STAGE(PG8_SB(1, 0), b3, voffB); PG8_STAGE(PG8_SB(1, 1), b3 + hstepB, voffB); PG8_STAGE(PG8_SA(1, 0), a3, voffA);
            PG8_WAIT_V(8); PG8_WAIT_L(0); PG8_BAR; PG8_MMA(1, 0, At, B0); PG8_MMA(1, 1, At, B1); PG8_BAR; PG8_SCHED;
        }
        if (wr == 0) PG8_BAR;
        { int lane2 = lane; asm volatile("" : "+v"(lane2)); E(acc, cur, wr, wc, lane2 & 15, lane2 >> 4, lds + STAGE_BYTES); }
        if (!has_next) break;
#pragma unroll
        for (int a = 0; a < 2; ++a)
#pragma unroll
            for (int b = 0; b < 2; ++b)
#pragma unroll
                for (int m = 0; m < 4; ++m)
#pragma unroll
                    for (int n = 0; n < 2; ++n) acc[a][b][m][n] = (f32x4){0.f, 0.f, 0.f, 0.f};
        cur = nxt; cA = nA; cB = nB; ++ui;
        if (wr == 1) PG8_BAR;
    }
    PG8_WAIT_V(0);
    PG8_BAR;
#undef PG8_SA
#undef PG8_SB
#undef PG8_STAGE
#undef PG8_LDA
#undef PG8_LDB
#undef PG8_MMA
#undef PG8_WAIT_V
#undef PG8_WAIT_L
#undef PG8_BAR
#undef PG8_SCHED
#undef PG8_ABASE
#undef PG8_BBASE
}
}
using pg8::Unit;
typedef f32x4 AccT[2][2][4][2];

__device__ __forceinline__ float row_rs(const float* part, int row, int fq) {
    const f32x4 p = *(const f32x4*)(part + (long)row * 16 + fq * 4);
    float s = (p[0] + p[1]) + (p[2] + p[3]);
    s += __shfl_xor(s, 16); s += __shfl_xor(s, 32);
    return rsqrtf(s * (1.0f / D) + EPS);
}

struct EpiProj {
    bf16_t* proj; float* la; const float* ssq0; const float* b_alpha;
    __device__ __forceinline__ void operator()(const AccT& acc, const Unit& u, int wr, int wc, int fr, int fq, LAS unsigned char*) const {
#pragma unroll
        for (int ai = 0; ai < 2; ++ai)
#pragma unroll
            for (int m = 0; m < 4; ++m) {
                const int row = u.pm * 256 + ai * 128 + wr * 64 + m * 16 + fr;
                const float rs = rsqrtf(ssq0[row] * (1.0f / D) + EPS);
#pragma unroll
                for (int bj = 0; bj < 2; ++bj) {
                    const int col = u.pn * 256 + bj * 128 + wc * 32 + fq * 8;
                    const f32x4 v0 = acc[ai][bj][m][0] * rs, v1 = acc[ai][bj][m][1] * rs;
                    if (u.pn < 9) {
                        u32x4 w; w.x = cvt_pk_bf16(v0[0], v0[1]); w.y = cvt_pk_bf16(v0[2], v0[3]); w.z = cvt_pk_bf16(v1[0], v1[1]); w.w = cvt_pk_bf16(v1[2], v1[3]);
                        *(u32x4*)(proj + (size_t)row * NPROJ + col) = w;
                    } else {
                        const int c = col - NPROJ;
                        const f32x4 b0 = *(const f32x4*)(b_alpha + c), b1 = *(const f32x4*)(b_alpha + c + 4);
                        f32x4 o0, o1;
#pragma unroll
                        for (int j = 0; j < 4; ++j) {
                            const float z0 = v0[j] + b0[j], z1 = v1[j] + b1[j];
                            o0[j] = (fminf(z0, 0.f) - log1pf(__expf(-fabsf(z0)))) * 0.0625f;
                            o1[j] = (fminf(z1, 0.f) - log1pf(__expf(-fabsf(z1)))) * 0.0625f;
                        }
                        *(f32x4*)(la + (size_t)row * 256 + c) = o0; *(f32x4*)(la + (size_t)row * 256 + c + 4) = o1;
                    }
                }
            }
    }
};
struct EpiPP {
    bf16_t* pp;
    __device__ __forceinline__ void operator()(const AccT& acc, const Unit& u, int wr, int wc, int fr, int fq, LAS unsigned char*) const {
#pragma unroll
        for (int ai = 0; ai < 2; ++ai)
#pragma unroll
            for (int m = 0; m < 4; ++m) {
                const int row = u.pm * 256 + ai * 128 + wr * 64 + m * 16 + fr;
#pragma unroll
                for (int bj = 0; bj < 2; ++bj) {
                    const int col = u.pn * 256 + bj * 128 + wc * 32 + fq * 8;
                    const f32x4 v0 = acc[ai][bj][m][0], v1 = acc[ai][bj][m][1];
                    u32x4 w; w.x = cvt_pk_bf16(v0[0], v0[1]); w.y = cvt_pk_bf16(v0[2], v0[3]); w.z = cvt_pk_bf16(v1[0], v1[1]); w.w = cvt_pk_bf16(v1[2], v1[3]);
                    *(u32x4*)(pp + (size_t)row * D + col) = w;
                }
            }
    }
};
template <int MODE, bool WRITE_HB, bool WRITE_PART>
struct EpiRes {
    float* out; const float* xp; const float* xs; bf16_t* hb; float* part; const float* part_in; const bf16_t* pp; const float* scale;
    __device__ __forceinline__ void operator()(const AccT& acc, const Unit& u, int wr, int wc, int fr, int fq, LAS unsigned char*) const {
#pragma unroll
        for (int ai = 0; ai < 2; ++ai)
#pragma unroll
            for (int m = 0; m < 4; ++m) {
                const int row = u.pm * 256 + ai * 128 + wr * 64 + m * 16 + fr;
                const bool valid = row_valid(row);
                float rs = 1.f;
                if (MODE == 2) rs = row_rs(part_in, row, fq);
                float sq = 0.f;
                float* hp = hrow_ptr(out, valid ? row : 0);
                const float* bp = hp;
                if (MODE == 0) bp = (row < SEQ) ? xp + (size_t)row * D : xs + (size_t)((valid ? row : SROW) - SROW) * D;
#pragma unroll
                for (int bj = 0; bj < 2; ++bj) {
                    const int col = u.pn * 256 + bj * 128 + wc * 32 + fq * 8;
                    f32x4 v0 = acc[ai][bj][m][0], v1 = acc[ai][bj][m][1];
                    if (MODE == 2) {
                        const u32x4 pw = *(const u32x4*)(pp + (size_t)row * D + col);
                        float pf[8]; unpack8(pw, pf);
#pragma unroll
                        for (int j = 0; j < 4; ++j) {
                            v0[j] = pf[j] / (1.f + __expf(-v0[j] * rs));
                            v1[j] = pf[4 + j] / (1.f + __expf(-v1[j] * rs));
                        }
                    }
                    if (MODE == 3) { v0 = v0 * *(const f32x4*)(scale + col); v1 = v1 * *(const f32x4*)(scale + col + 4); }
                    if (valid) {
                        const f32x4 h0 = *(const f32x4*)(bp + col) + v0, h1 = *(const f32x4*)(bp + col + 4) + v1;
                        *(f32x4*)(hp + col) = h0; *(f32x4*)(hp + col + 4) = h1;
                        if (WRITE_HB) { u32x4 w; w.x = cvt_pk_bf16(h0[0], h0[1]); w.y = cvt_pk_bf16(h0[2], h0[3]); w.z = cvt_pk_bf16(h1[0], h1[1]); w.w = cvt_pk_bf16(h1[2], h1[3]);
                            *(u32x4*)(hb + (size_t)row * D + col) = w; }
                        sq += (h0[0] * h0[0] + h0[1] * h0[1]) + (h0[2] * h0[2] + h0[3] * h0[3]) + (h1[0] * h1[0] + h1[1] * h1[1]) + (h1[2] * h1[2] + h1[3] * h1[3]);
                    }
                }
                if (WRITE_PART) {
                    sq += __shfl_xor(sq, 16); sq += __shfl_xor(sq, 32);
                    if (fq == 0 && valid) part[(long)row * 16 + u.pn * 4 + wc] = sq;
                }
            }
    }
};
struct EpiFfn {
    const float* part_in; const float* convw; const float* convb; const float* cstate; float* convp_out; float* convs_out; bf16_t* G;
    __device__ __forceinline__ void operator()(AccT& acc, const Unit& u, int wr, int wc, int fr, int fq, LAS unsigned char* ldsx) const {
        const int lane = fr + 16 * fq;
        const int c0 = u.pn * 128 + wc * 32 + fq * 8;
        const bool sample = (u.pm == 65);
#pragma unroll
        for (int ai = 0; ai < 2; ++ai)
#pragma unroll
            for (int m = 0; m < 4; ++m) {
                const int grow = u.pm * 254 - 2 + ai * 128 + wr * 64 + m * 16 + fr;
                const float rs = row_rs(part_in, grow, fq);
#pragma unroll
                for (int bj = 0; bj < 2; ++bj)
#pragma unroll
                    for (int n = 0; n < 2; ++n) acc[ai][bj][m][n] = acc[ai][bj][m][n] * rs;
            }
        LAS f32x4* xch = (LAS f32x4*)ldsx;
        if (fr >= 14) {
#pragma unroll
            for (int ai = 0; ai < 2; ++ai) {
                const int slot = ((((ai * 2 + wr) * 4 + wc) * 4 + fq) * 2 + (fr - 14)) * 2;
                xch[slot] = acc[ai][0][3][0]; xch[slot + 1] = acc[ai][0][3][1];
            }
        }
        asm volatile("s_waitcnt lgkmcnt(0)" ::: "memory"); __builtin_amdgcn_s_barrier(); asm volatile("" ::: "memory");
        const int src1 = (lane & 48) | ((fr + 15) & 15), src2 = (lane & 48) | ((fr + 14) & 15);
#pragma unroll
        for (int n = 0; n < 2; ++n) {
            const int cn = c0 + 4 * n;
            const f32x4 w0 = *(const f32x4*)(convw + cn), w1 = *(const f32x4*)(convw + DFF + cn), w2 = *(const f32x4*)(convw + 2 * DFF + cn), cb = *(const f32x4*)(convb + cn);
#pragma unroll
            for (int ai = 0; ai < 2; ++ai)
#pragma unroll
                for (int m = 0; m < 4; ++m) {
                    const int tr = ai * 128 + wr * 64 + m * 16 + fr;
                    const int grow = u.pm * 254 - 2 + tr;
                    const f32x4 x = acc[ai][0][m][n];
                    f32x4 p;
                    if (m == 0) {
                        const int sa = (wr == 1) ? ai : 0, sw = (wr == 1) ? 0 : 1;
                        const bool has = (wr == 1) || (ai == 1);
                        const int slot = ((((sa * 2 + sw) * 4 + wc) * 4 + fq) * 2 + (fr >= 14 ? fr - 14 : 0)) * 2 + n;
                        p = xch[slot];
                        if (!has) p = (f32x4){0.f, 0.f, 0.f, 0.f};
                    } else p = acc[ai][0][m == 0 ? 0 : m - 1][n];
                    f32x4 p1, p2;
#pragma unroll
                    for (int j = 0; j < 4; ++j) {
                        const float x1 = __shfl(x[j], src1), x2 = __shfl(x[j], src2), q1 = __shfl(p[j], src1), q2 = __shfl(p[j], src2);
                        p1[j] = (fr >= 1) ? x1 : q1;
                        p2[j] = (fr >= 2) ? x2 : q2;
                    }
                    bool store;
                    if (sample) {
                        const int b = tr - 2;
                        store = (b >= 0 && b < NS);
                        if (store) {
                            const float* st = cstate + (size_t)b * 2 * DFF + cn;
                            p2 = *(const f32x4*)(st); p1 = *(const f32x4*)(st + DFF);
                            float* so = convs_out + (size_t)b * 2 * DFF + cn;
                            *(f32x4*)(so) = p1; *(f32x4*)(so + DFF) = x;
                        }
                    } else {
                        store = (tr >= 2 && grow < SEQ);
                        if (grow >= SEQ - 2 && grow < SEQ) *(f32x4*)(convp_out + (size_t)(grow - (SEQ - 2)) * DFF + cn) = x;
                    }
                    const f32x4 ac = cb + w0 * p2 + w1 * p1 + w2 * x;
                    const f32x4 v = acc[ai][1][m][n];
                    const f32x2 g0 = gelu_pk((f32x2){ac[0], ac[1]}), g1 = gelu_pk((f32x2){ac[2], ac[3]});
                    if (store) {
                        u32x2 w; w.x = cvt_pk_bf16(g0.x * v[0], g0.y * v[1]); w.y = cvt_pk_bf16(g1.x * v[2], g1.y * v[3]);
                        *(u32x2*)(G + (size_t)grow * DFF + cn) = w;
                    }
                    asm volatile("" ::: "memory");
                }
        }
    }
};

struct KArgs { const float* in[29]; float* out; unsigned char* ws; };
enum { I_XP = 0, I_XS, I_PP, I_PS, I_SGLA, I_CK, I_CV, I_SPOOL, I_SCONV, I_MNE, I_WIN, I_WALPHA, I_BALPHA, I_ONORM, I_QNORM, I_KNORM, I_SINKS, I_WOUT,
       I_MNO, I_POOLW, I_POOLSC, I_FNORM, I_FWIN, I_FCW, I_FCB, I_FWOUT, I_PNORM, I_PWPROJ, I_PWGATE };

__device__ __forceinline__ float* part_tab(unsigned char* ws, int i) { return (float*)(ws + WS_SSQ + 262144 + (size_t)i * PART_STRIDE) + 2 * 16; }

__device__ __forceinline__ void tr_item(const float* W, int ldsrc, int scol0, int k0, const float* gain, bf16_t* dst, int ldd, int drow0, LAS float* scr, int lane) {
#pragma unroll 8
    for (int i = 0; i < 32; ++i) { const int kk = 2 * i + (lane >> 5); const float gsc = gain ? gain[k0 + kk] : 1.f;
        scr[kk * 33 + (lane & 31)] = W[(size_t)(k0 + kk) * ldsrc + scol0 + (lane & 31)] * gsc; }
    asm volatile("s_waitcnt lgkmcnt(0)" ::: "memory");
    const int c = lane & 7;
#pragma unroll
    for (int j = 0; j < 4; ++j) { const int n = (lane >> 3) + 8 * j; const LAS float* s = scr + (8 * c) * 33 + n;
        u32x4 o; o.x = cvt_pk_bf16(s[0 * 33], s[1 * 33]); o.y = cvt_pk_bf16(s[2 * 33], s[3 * 33]); o.z = cvt_pk_bf16(s[4 * 33], s[5 * 33]); o.w = cvt_pk_bf16(s[6 * 33], s[7 * 33]);
        *(u32x4*)(dst + (size_t)(drow0 + n) * ldd + k0 + 8 * c) = o; }
    asm volatile("s_waitcnt lgkmcnt(0)" ::: "memory");
}
__device__ __forceinline__ void weff_item(const float* Win, const float* wal, int n0, int k0, const float* gain, bf16_t* dst, int drow0, LAS float* scr, int lane) {
#pragma unroll 2
    for (int i = 0; i < 32; ++i) { const int kk = 2 * i + (lane >> 5); const int k = k0 + kk; float s = 0.f;
#pragma unroll
        for (int r = 0; r < 16; ++r) s += Win[(size_t)k * 2320 + 1024 + r] * wal[r * 256 + n0 + (lane & 31)];
        scr[kk * 33 + (lane & 31)] = s * gain[k]; }
    asm volatile("s_waitcnt lgkmcnt(0)" ::: "memory");
    const int c = lane & 7;
#pragma unroll
    for (int j = 0; j < 4; ++j) { const int n = (lane >> 3) + 8 * j; const LAS float* s = scr + (8 * c) * 33 + n;
        u32x4 o; o.x = cvt_pk_bf16(s[0 * 33], s[1 * 33]); o.y = cvt_pk_bf16(s[2 * 33], s[3 * 33]); o.z = cvt_pk_bf16(s[4 * 33], s[5 * 33]); o.w = cvt_pk_bf16(s[6 * 33], s[7 * 33]);
        *(u32x4*)(dst + (size_t)(drow0 + n) * 1024 + k0 + 8 * c) = o; }
    asm volatile("s_waitcnt lgkmcnt(0)" ::: "memory");
}

__device__ __forceinline__ void p0_prologue(const KArgs& a, LAS unsigned char* lds, int vcu, int G) {
    const int tid = otid(), lane = tid & 63, wave = __builtin_amdgcn_readfirstlane(tid >> 6);
    LAS float* scr = (LAS float*)(lds + wave * 16384);
    const int gw = vcu * 8 + wave, NGW = G * 8;
    unsigned char* ws = a.ws;
    constexpr int I_A = 16 * 72, I_E = 16 * 8, I_O = 16 * 32, I_FI = 16 * 176, I_FO = 44 * 32, I_G = 16 * 32, I_P = 4 * 32, I_PL = 4 * 32;
    constexpr int NITEMS = I_A + I_E + I_O + 2 * I_FI + 2 * I_FO + 2 * I_G + 2 * I_P + I_PL;
    for (int it = gw; it < NITEMS; it += NGW) {
        int r = it;
        if (r < I_A) { const int kb = r / 72, nb = r % 72, n0 = nb * 32; tr_item(a.in[I_WIN], 2320, n0 < 1024 ? n0 : n0 + 16, kb * 64, a.in[I_MNE], (bf16_t*)(ws + WS_WIN0), 1024, n0, scr, lane); continue; } r -= I_A;
        if (r < I_E) { const int kb = r / 8, nb = r % 8; weff_item(a.in[I_WIN], a.in[I_WALPHA], nb * 32, kb * 64, a.in[I_MNE], (bf16_t*)(ws + WS_WIN0), NPROJ + nb * 32, scr, lane); continue; } r -= I_E;
        if (r < I_O) { const int kb = r / 32, nb = r % 32; tr_item(a.in[I_WOUT], 1024, nb * 32, kb * 64, nullptr, (bf16_t*)(ws + WS_WOUT0), 1024, nb * 32, scr, lane); continue; } r -= I_O;
        if (r < 2 * I_FI) { const int l = r / I_FI, q = r % I_FI, kb = q / 176, nb = q % 176, n0 = nb * 32;
            const int pn = n0 >> 8, rr = n0 & 255, bj = rr >> 7, ii = rr & 127;
            tr_item(a.in[I_FWIN] + (size_t)l * 1024 * 5632, 5632, bj * DFF + pn * 128 + ii, kb * 64, a.in[I_FNORM] + l * 1024, (bf16_t*)(ws + WS_WFFI + l * WFFI_BYTES), 1024, n0, scr, lane); continue; } r -= 2 * I_FI;
        if (r < 2 * I_FO) { const int l = r / I_FO, q = r % I_FO, kb = q / 32, nb = q % 32;
            tr_item(a.in[I_FWOUT] + (size_t)l * DFF * 1024, 1024, nb * 32, kb * 64, nullptr, (bf16_t*)(ws + WS_WFFO + l * WFFO_BYTES), DFF, nb * 32, scr, lane); continue; } r -= 2 * I_FO;
        if (r < 2 * I_G) { const int l = r / I_G, q = r % I_G, kb = q / 32, nb = q % 32;
            tr_item(a.in[I_PWGATE] + (size_t)l * 1024 * 1024, 1024, nb * 32, kb * 64, a.in[I_PNORM] + l * 1024, (bf16_t*)(ws + WS_WGATE + l * WGATE_BYTES), 1024, nb * 32, scr, lane); continue; } r -= 2 * I_G;
        if (r < 2 * I_P) { const int l = r / I_P, q = r % I_P, kb = q / 32, nb = q % 32;
            tr_item(a.in[I_PWPROJ] + (size_t)l * 256 * 1024, 1024, nb * 32, kb * 64, nullptr, (bf16_t*)(ws + WS_WPROJ + l * WPROJ_BYTES), 256, nb * 32, scr, lane); continue; } r -= 2 * I_P;
        { const int gq = r / 32, q = r % 32, kb = q / 8, nb = q % 8;
            tr_item(a.in[I_POOLW] + (size_t)gq * 65536, 256, nb * 32, kb * 64, nullptr, (bf16_t*)(ws + WS_WPOOL), 256, gq * 256 + nb * 32, scr, lane); }
    }
    bf16_t* xbf = (bf16_t*)(ws + WS_R1);
    float* ssq0 = (float*)(ws + WS_SSQ);
    for (int row = gw; row < MR; row += NGW) {
        const float* src = row < SEQ ? a.in[I_XP] + (size_t)row * D : ((row >= SROW && row < SROW + NS) ? a.in[I_XS] + (size_t)(row - SROW) * D : nullptr);
        float s = 0.f;
#pragma unroll
        for (int j = 0; j < 4; ++j) {
            f32x4 v = (f32x4){0.f, 0.f, 0.f, 0.f};
            if (src) v = *(const f32x4*)(src + j * 256 + lane * 4);
            s += (v[0] * v[0] + v[1] * v[1]) + (v[2] * v[2] + v[3] * v[3]);
            u32x2 w; w.x = cvt_pk_bf16(v[0], v[1]); w.y = cvt_pk_bf16(v[2], v[3]);
            *(u32x2*)(xbf + (size_t)row * D + j * 256 + lane * 4) = w;
        }
        s = wave_sum(s);
        if (lane == 0) ssq0[row] = s;
    }
    bf16_t* pbf = (bf16_t*)(ws + WS_PBF);
    for (int it = gw; it < 2 * MT; it += NGW) {
        const int l = it / MT, row = it % MT;
        const float* src = row < SEQ ? a.in[I_PP] + ((size_t)l * SEQ + row) * PLE : ((row >= SROW && row < SROW + NS) ? a.in[I_PS] + ((size_t)l * NS + (row - SROW)) * PLE : nullptr);
        f32x4 v = (f32x4){0.f, 0.f, 0.f, 0.f};
        if (src) v = *(const f32x4*)(src + lane * 4);
        u32x2 w; w.x = cvt_pk_bf16(v[0], v[1]); w.y = cvt_pk_bf16(v[2], v[3]);
        *(u32x2*)(pbf + (size_t)it * PLE + lane * 4) = w;
    }
    if (vcu == 0) { for (int i = tid; i < 1024; i += NTHREADS) ((u32x4*)(ws + WS_R2))[i] = (u32x4){0u, 0u, 0u, 0u}; }
    {
        u32x4* pt = (u32x4*)(ws + WS_SSQ + 262144);
        const size_t n16 = 6 * PART_STRIDE / 16;
        for (size_t i = (size_t)vcu * NTHREADS + tid; i < n16; i += (size_t)G * NTHREADS) pt[i] = (u32x4){0u, 0u, 0u, 0u};
    }
}

__device__ __forceinline__ void gla_load_b(const float* la, int c, int h, LAS float* bL, int tid) {
#pragma unroll
    for (int i = 0; i < 2; ++i) { const int e = tid + i * NTHREADS; const int t = e >> 4, d4 = (e & 15) * 4;
        *(LAS f32x4*)(bL + t * 64 + d4) = *(const f32x4*)(la + (size_t)(c * 64 + t) * 256 + h * 64 + d4); }
    __syncthreads();
    if (tid < 64) { float s = 0.f;
#pragma unroll 8
        for (int t = 0; t < 64; ++t) { s += bL[t * 64 + tid]; bL[t * 64 + tid] = s; } }
    __syncthreads();
}
__device__ __forceinline__ void gla_u_item(const KArgs& a, LAS unsigned char* lds, int item) {
    const int tid = otid(); const int c = item >> 2, h = item & 3;
    const bf16_t* proj = (const bf16_t*)(a.ws + WS_BIG); const float* la = (const float*)(a.ws + WS_BIG + BIG_LA);
    float* U = (float*)(a.ws + WS_R2 + 4096); float* Dc = U + (size_t)256 * 4 * 64 * 128;
    LAS float* bL = (LAS float*)lds; LAS float* kh = bL + 4096; LAS float* vL = kh + 4096;
    gla_load_b(la, c, h, bL, tid);
    { const int t = tid >> 3, d8 = (tid & 7) * 8;
      const u32x4 kw = *(const u32x4*)(proj + (size_t)(c * 64 + t) * NPROJ + PKA + h * 64 + d8); float kf[8]; unpack8(kw, kf);
#pragma unroll
      for (int j = 0; j < 8; ++j) kh[t * 64 + d8 + j] = kf[j] * __expf(bL[63 * 64 + d8 + j] - bL[t * 64 + d8 + j]);
#pragma unroll
      for (int i = 0; i < 2; ++i) { const int dv8 = d8 + i * 64;
          const u32x4 vw = *(const u32x4*)(proj + (size_t)(c * 64 + t) * NPROJ + PVA + h * 128 + dv8); float vf[8]; unpack8(vw, vf);
#pragma unroll
          for (int j = 0; j < 8; ++j) vL[t * 128 + dv8 + j] = vf[j]; } }
    __syncthreads();
    const int dk4 = (tid >> 5) * 4, dv4 = (tid & 31) * 4;
    f32x4 u0 = {0.f, 0.f, 0.f, 0.f}, u1 = u0, u2 = u0, u3 = u0;
#pragma unroll 4
    for (int t = 0; t < 64; ++t) { const f32x4 kk = *(const LAS f32x4*)(kh + t * 64 + dk4), vv = *(const LAS f32x4*)(vL + t * 128 + dv4);
        u0 += kk[0] * vv; u1 += kk[1] * vv; u2 += kk[2] * vv; u3 += kk[3] * vv; }
    float* up = U + ((size_t)(c * 4 + h) * 64 + dk4) * 128 + dv4;
    *(f32x4*)(up) = u0; *(f32x4*)(up + 128) = u1; *(f32x4*)(up + 256) = u2; *(f32x4*)(up + 384) = u3;
    if (tid < 64) Dc[(c * 4 + h) * 64 + tid] = __expf(bL[63 * 64 + tid]);
    __syncthreads();
}
__device__ __forceinline__ void gla_scan(const KArgs& a, int vcu) {
    const int tid = otid(); if (tid >= 128) return;
    const int e = vcu * 128 + tid; if (e >= 32768) return;
    float* U = (float*)(a.ws + WS_R2 + 4096); const float* Dc = U + (size_t)256 * 4 * 64 * 128;
    const int hd = e >> 7;
    float S = 0.f;
    for (int c0 = 0; c0 < 256; c0 += 8) {
        float u[8], d[8];
#pragma unroll
        for (int j = 0; j < 8; ++j) { u[j] = U[(size_t)(c0 + j) * 32768 + e]; d[j] = Dc[(c0 + j) * 256 + hd]; }
#pragma unroll
        for (int j = 0; j < 8; ++j) { U[(size_t)(c0 + j) * 32768 + e] = S; S = d[j] * S + u[j]; }
    }
    a.out[O_GLAP + e] = S;
}
__device__ __forceinline__ void gla_o_item(const KArgs& a, LAS unsigned char* lds, int item) {
    const int tid = otid(); const int c = item >> 2, h = item & 3;
    const bf16_t* proj = (const bf16_t*)(a.ws + WS_BIG); const float* la = (const float*)(a.ws + WS_BIG + BIG_LA);
    const float* U = (const float*)(a.ws + WS_R2 + 4096);
    bf16_t* mix = (bf16_t*)(a.ws + WS_R1);
    LAS float* bL = (LAS float*)lds; LAS float* qt = bL + 4096; LAS float* kt = qt + 64 * 68; LAS float* vL = kt + 64 * 68; LAS float* SL = vL + 8192; LAS float* att = SL + 8192;
    gla_load_b(la, c, h, bL, tid);
    { const int t = tid >> 3, d8 = (tid & 7) * 8;
      const u32x4 qw = *(const u32x4*)(proj + (size_t)(c * 64 + t) * NPROJ + PQA + h * 64 + d8); float qf[8]; unpack8(qw, qf);
      const u32x4 kw = *(const u32x4*)(proj + (size_t)(c * 64 + t) * NPROJ + PKA + h * 64 + d8); float kf[8]; unpack8(kw, kf);
#pragma unroll
      for (int j = 0; j < 8; ++j) { const float b = bL[t * 64 + d8 + j]; qt[t * 68 + d8 + j] = qf[j] * 0.125f * __expf(b); kt[t * 68 + d8 + j] = kf[j] * __expf(-b); }
#pragma unroll
      for (int i = 0; i < 2; ++i) { const int dv8 = d8 + i * 64;
          const u32x4 vw = *(const u32x4*)(proj + (size_t)(c * 64 + t) * NPROJ + PVA + h * 128 + dv8); float vf[8]; unpack8(vw, vf);
#pragma unroll
          for (int j = 0; j < 8; ++j) vL[t * 128 + dv8 + j] = vf[j]; }
#pragma unroll
      for (int i = 0; i < 4; ++i) { const int e = (tid + i * NTHREADS) * 4; *(LAS f32x4*)(SL + e) = *(const f32x4*)(U + (size_t)(c * 4 + h) * 8192 + e); } }
    __syncthreads();
    { const int i = tid >> 3, j0 = tid & 7;
      float s[8];
#pragma unroll
      for (int jj = 0; jj < 8; ++jj) s[jj] = 0.f;
#pragma unroll 4
      for (int dk = 0; dk < 64; dk += 4) { const f32x4 q4 = *(const LAS f32x4*)(qt + i * 68 + dk);
#pragma unroll
          for (int jj = 0; jj < 8; ++jj) { const f32x4 k4 = *(const LAS f32x4*)(kt + (j0 + 8 * jj) * 68 + dk); s[jj] += (q4[0] * k4[0] + q4[1] * k4[1]) + (q4[2] * k4[2] + q4[3] * k4[3]); } }
#pragma unroll
      for (int jj = 0; jj < 8; ++jj) { const int j = j0 + 8 * jj; att[i * 65 + j] = (j <= i) ? s[jj] : 0.f; } }
    __syncthreads();
    { const int i = tid >> 3, dv0 = (tid & 7) * 16;
      f32x4 o[4];
#pragma unroll
      for (int q = 0; q < 4; ++q) o[q] = (f32x4){0.f, 0.f, 0.f, 0.f};
      for (int j = 0; j <= i; ++j) { const float av = att[i * 65 + j];
#pragma unroll
          for (int q = 0; q < 4; ++q) o[q] += av * *(const LAS f32x4*)(vL + j * 128 + dv0 + q * 4); }
#pragma unroll 4
      for (int dk = 0; dk < 64; ++dk) { const float qv = qt[i * 68 + dk];
#pragma unroll
          for (int q = 0; q < 4; ++q) o[q] += qv * *(const LAS f32x4*)(SL + dk * 128 + dv0 + q * 4); }
      float ss = 0.f;
#pragma unroll
      for (int q = 0; q < 4; ++q) ss += (o[q][0] * o[q][0] + o[q][1] * o[q][1]) + (o[q][2] * o[q][2] + o[q][3] * o[q][3]);
      ss += __shfl_xor(ss, 1); ss += __shfl_xor(ss, 2); ss += __shfl_xor(ss, 4);
      const float rstd = rsqrtf(ss * (1.0f / 128.f) + EPS);
      const int t = c * 64 + i;
      const float* on = a.in[I_ONORM] + dv0;
      float rf[16];
      { const u32x4 r0 = *(const u32x4*)(proj + (size_t)t * NPROJ + PRA + h * 128 + dv0), r1 = *(const u32x4*)(proj + (size_t)t * NPROJ + PRA + h * 128 + dv0 + 8); unpack8(r0, rf); unpack8(r1, rf + 8); }
      float y[16];
#pragma unroll
      for (int q = 0; q < 4; ++q)
#pragma unroll
          for (int j = 0; j < 4; ++j) { const float r = rf[q * 4 + j]; y[q * 4 + j] = o[q][j] * rstd * on[q * 4 + j] * (r / (1.f + __expf(-r))); }
      u32x4 w0, w1;
      w0.x = cvt_pk_bf16(y[0], y[1]); w0.y = cvt_pk_bf16(y[2], y[3]); w0.z = cvt_pk_bf16(y[4], y[5]); w0.w = cvt_pk_bf16(y[6], y[7]);
      w1.x = cvt_pk_bf16(y[8], y[9]); w1.y = cvt_pk_bf16(y[10], y[11]); w1.z = cvt_pk_bf16(y[12], y[13]); w1.w = cvt_pk_bf16(y[14], y[15]);
      *(u32x4*)(mix + (size_t)t * D + h * 128 + dv0) = w0; *(u32x4*)(mix + (size_t)t * D + h * 128 + dv0 + 8) = w1; }
    __syncthreads();
}
__device__ __forceinline__ int crow(int i, int hh) { return (i & 3) + 8 * (i >> 2) + 4 * hh; }
template <bool OUT>
__device__ __forceinline__ void gla_item_m(const KArgs& a, LAS unsigned char* lds, int item) {
    const int tid = otid(), lane = tid & 63, wave = __builtin_amdgcn_readfirstlane(tid >> 6);
    const int sc = item >> 2, h = item & 3;
    const bf16_t* proj = (const bf16_t*)(a.ws + WS_BIG); const float* la = (const float*)(a.ws + WS_BIG + BIG_LA);
    bf16_t* mix = (bf16_t*)(a.ws + WS_R1);
    float* US = (float*)(a.ws + WS_R2 + 4096); float* DS = US + (size_t)64 * 4 * 64 * 128;
    LAS float* bL = (LAS float*)lds; LAS float* segS = (LAS float*)(lds + 16384);
    LAS bf16_t* Qn = (LAS bf16_t*)(lds + 18432); LAS bf16_t* Kn = (LAS bf16_t*)(lds + 27648); LAS bf16_t* KT = (LAS bf16_t*)(lds + 36864);
    LAS bf16_t* VT = (LAS bf16_t*)(lds + 46080); LAS bf16_t* ST = (LAS bf16_t*)(lds + 64512); LAS float* red = (LAS float*)(lds + 82944);
    const int r = lane & 31, hh = lane >> 5;
    const int dkt = wave & 1, dvt = wave >> 1, it = wave & 1;
    f32x16 S = {};
    float* usp = US + ((size_t)(sc * 4 + h) * 64 + 32 * dkt) * 128 + 32 * dvt + r;
    if (OUT) {
#pragma unroll
        for (int i = 0; i < 16; ++i) S[i] = usp[(size_t)crow(i, hh) * 128];
    }
    float bsum = 0.f;
#pragma unroll 1
    for (int c = 0; c < 4; ++c) {
        const int T0 = sc * 256 + c * 64;
        if (OUT) {
#pragma unroll
            for (int q = 0; q < 4; ++q) { u32x2 w; w.x = cvt_pk_bf16(S[4 * q], S[4 * q + 1]); w.y = cvt_pk_bf16(S[4 * q + 2], S[4 * q + 3]);
                *(LAS u32x2*)(ST + (32 * dvt + r) * 72 + 32 * dkt + 8 * q + 4 * hh) = w; }
        }
        {
            const int dk = tid & 63, seg = tid >> 6;
            float v[8];
#pragma unroll
            for (int i = 0; i < 8; ++i) v[i] = la[(size_t)(T0 + 8 * seg + i) * 256 + h * 64 + dk];
#pragma unroll
            for (int i = 1; i < 8; ++i) v[i] += v[i - 1];
            segS[seg * 64 + dk] = v[7];
            __syncthreads();
            float off = 0.f;
#pragma unroll
            for (int s = 0; s < 8; ++s) { const float x = segS[s * 64 + dk]; off += (s < seg) ? x : 0.f; }
#pragma unroll
            for (int i = 0; i < 8; ++i) bL[(8 * seg + i) * 64 + dk] = v[i] + off;
            __syncthreads();
        }
        {
            const int t = tid >> 3, d8 = (tid & 7) * 8;
            const f32x4 b0 = *(const LAS f32x4*)(bL + t * 64 + d8), b1 = *(const LAS f32x4*)(bL + t * 64 + d8 + 4);
            const f32x4 l0 = *(const LAS f32x4*)(bL + 63 * 64 + d8), l1 = *(const LAS f32x4*)(bL + 63 * 64 + d8 + 4);
            float bb[8] = {b0[0], b0[1], b0[2], b0[3], b1[0], b1[1], b1[2], b1[3]}, bl[8] = {l0[0], l0[1], l0[2], l0[3], l1[0], l1[1], l1[2], l1[3]};
            const size_t prow = (size_t)(T0 + t) * NPROJ;
            float kf[8]; { const u32x4 kw = *(const u32x4*)(proj + prow + PKA + h * 64 + d8); unpack8(kw, kf); }
#pragma unroll
            for (int j = 0; j < 8; ++j) KT[(d8 + j) * 72 + t] = (bf16_t)(cvt_pk_bf16(kf[j] * __expf(bl[j] - bb[j]), 0.f) & 0xffffu);
            if (OUT) {
                float qf[8]; { const u32x4 qw = *(const u32x4*)(proj + prow + PQA + h * 64 + d8); unpack8(qw, qf); }
                float qq[8], kk[8];
#pragma unroll
                for (int j = 0; j < 8; ++j) { const float e = __expf(bb[j]); qq[j] = qf[j] * 0.125f * e; kk[j] = kf[j] * __expf(-bb[j]); }
                u32x4 w; w.x = cvt_pk_bf16(qq[0], qq[1]); w.y = cvt_pk_bf16(qq[2], qq[3]); w.z = cvt_pk_bf16(qq[4], qq[5]); w.w = cvt_pk_bf16(qq[6], qq[7]);
                *(LAS u32x4*)(Qn + t * 72 + d8) = w;
                w.x = cvt_pk_bf16(kk[0], kk[1]); w.y = cvt_pk_bf16(kk[2], kk[3]); w.z = cvt_pk_bf16(kk[4], kk[5]); w.w = cvt_pk_bf16(kk[6], kk[7]);
                *(LAS u32x4*)(Kn + t * 72 + d8) = w;
            }
#pragma unroll
            for (int i = 0; i < 2; ++i) { const int dv8 = d8 + 64 * i;
                const u32x4 vw = *(const u32x4*)(proj + prow + PVA + h * 128 + dv8);
                LAS bf16_t* vt = VT + dv8 * 72 + t;
                vt[0 * 72] = (bf16_t)(vw.x & 0xffffu); vt[1 * 72] = (bf16_t)(vw.x >> 16); vt[2 * 72] = (bf16_t)(vw.y & 0xffffu); vt[3 * 72] = (bf16_t)(vw.y >> 16);
                vt[4 * 72] = (bf16_t)(vw.z & 0xffffu); vt[5 * 72] = (bf16_t)(vw.z >> 16); vt[6 * 72] = (bf16_t)(vw.w & 0xffffu); vt[7 * 72] = (bf16_t)(vw.w >> 16); }
            if (tid < 64) bsum += bL[63 * 64 + tid];
        }
        __syncthreads();
        if (OUT) {
            bf16x8 qf[4];
#pragma unroll
            for (int s = 0; s < 4; ++s) qf[s] = *(const LAS bf16x8*)(Qn + (32 * it + r) * 72 + 16 * s + 8 * hh);
            f32x16 oacc = {};
#pragma unroll
            for (int jt = 0; jt < 2; ++jt) {
                if (jt <= it) {
                    f32x16 at = {};
#pragma unroll
                    for (int s = 0; s < 4; ++s) { const bf16x8 af = *(const LAS bf16x8*)(Kn + (32 * jt + r) * 72 + 16 * s + 8 * hh); at = __builtin_amdgcn_mfma_f32_32x32x16_bf16(af, qf[s], at, 0, 0, 0); }
                    if (jt == it) {
#pragma unroll
                        for (int i = 0; i < 16; ++i) if (crow(i, hh) > r) at[i] = 0.f;
                    }
#pragma unroll
                    for (int s2 = 0; s2 < 2; ++s2) {
                        u32x4 pw; pw.x = cvt_pk_bf16(at[8 * s2 + 0], at[8 * s2 + 1]); pw.y = cvt_pk_bf16(at[8 * s2 + 2], at[8 * s2 + 3]);
                        pw.z = cvt_pk_bf16(at[8 * s2 + 4], at[8 * s2 + 5]); pw.w = cvt_pk_bf16(at[8 * s2 + 6], at[8 * s2 + 7]);
                        const LAS bf16_t* vp = VT + (32 * dvt + r) * 72 + 32 * jt + 16 * s2 + 4 * hh;
                        const u32x2 v0 = *(const LAS u32x2*)vp, v1 = *(const LAS u32x2*)(vp + 8);
                        const u32x4 vv = (u32x4){v0.x, v0.y, v1.x, v1.y};
                        oacc = __builtin_amdgcn_mfma_f32_32x32x16_bf16(__builtin_bit_cast(bf16x8, vv), __builtin_bit_cast(bf16x8, pw), oacc, 0, 0, 0);
                    }
                }
            }
#pragma unroll
            for (int s = 0; s < 4; ++s) { const bf16x8 af = *(const LAS bf16x8*)(ST + (32 * dvt + r) * 72 + 16 * s + 8 * hh); oacc = __builtin_amdgcn_mfma_f32_32x32x16_bf16(af, qf[s], oacc, 0, 0, 0); }
            float ss = 0.f;
#pragma unroll
            for (int i = 0; i < 16; ++i) ss += oacc[i] * oacc[i];
            ss += __shfl_xor(ss, 32);
            if (hh == 0) red[wave * 32 + r] = ss;
            __syncthreads();
            const float tot = (red[it * 32 + r] + red[(it + 2) * 32 + r]) + (red[(it + 4) * 32 + r] + red[(it + 6) * 32 + r]);
            const float rstd = rsqrtf(tot * (1.0f / 128.f) + EPS);
            const int t = T0 + 32 * it + r;
#pragma unroll
            for (int q = 0; q < 4; ++q) {
                const int dv0 = 32 * dvt + 8 * q + 4 * hh;
                const u32x2 rw = *(const u32x2*)(proj + (size_t)t * NPROJ + PRA + h * 128 + dv0);
                const f32x4 on = *(const f32x4*)(a.in[I_ONORM] + dv0);
                const float r0 = bf_lo(rw.x), r1 = bf_hi(rw.x), r2 = bf_lo(rw.y), r3 = bf_hi(rw.y);
                const float y0 = oacc[4 * q] * rstd * on[0] * (r0 / (1.f + __expf(-r0))), y1 = oacc[4 * q + 1] * rstd * on[1] * (r1 / (1.f + __expf(-r1)));
                const float y2 = oacc[4 * q + 2] * rstd * on[2] * (r2 / (1.f + __expf(-r2))), y3 = oacc[4 * q + 3] * rstd * on[3] * (r3 / (1.f + __expf(-r3)));
                u32x2 w; w.x = cvt_pk_bf16(y0, y1); w.y = cvt_pk_bf16(y2, y3);
                *(u32x2*)(mix + (size_t)t * D + h * 128 + dv0) = w;
            }
        }
#pragma unroll
        for (int i = 0; i < 16; ++i) S[i] *= __expf(bL[63 * 64 + 32 * dkt + crow(i, hh)]);
#pragma unroll
        for (int s = 0; s < 4; ++s) {
            const bf16x8 af = *(const LAS bf16x8*)(KT + (32 * dkt + r) * 72 + 16 * s + 8 * hh), bf = *(const LAS bf16x8*)(VT + (32 * dvt + r) * 72 + 16 * s + 8 * hh);
            S = __builtin_amdgcn_mfma_f32_32x32x16_bf16(af, bf, S, 0, 0, 0);
        }
        __syncthreads();
    }
    if (!OUT) {
#pragma unroll
        for (int i = 0; i < 16; ++i) usp[(size_t)crow(i, hh) * 128] = S[i];
        if (tid < 64) DS[(sc * 4 + h) * 64 + tid] = __expf(bsum);
    }
}
__device__ __forceinline__ void gla_scan_m(const KArgs& a, int vcu) {
    const int tid = otid(); if (tid >= 128) return;
    const int e = vcu * 128 + tid; if (e >= 32768) return;
    float* US = (float*)(a.ws + WS_R2 + 4096); const float* DS = US + (size_t)64 * 4 * 64 * 128;
    const int hd = e >> 7;
    float S = 0.f;
    for (int c0 = 0; c0 < 64; c0 += 8) {
        float u[8], d[8];
#pragma unroll
        for (int j = 0; j < 8; ++j) { u[j] = US[(size_t)(c0 + j) * 32768 + e]; d[j] = DS[(c0 + j) * 256 + hd]; }
#pragma unroll
        for (int j = 0; j < 8; ++j) { US[(size_t)(c0 + j) * 32768 + e] = S; S = d[j] * S + u[j]; }
    }
    a.out[O_GLAP + e] = S;
}
__device__ __forceinline__ void gla_decode_item(const KArgs& a, int item, int lane) {
    const int b = item >> 2, h = item & 3; const int row = SROW + b;
    const bf16_t* proj = (const bf16_t*)(a.ws + WS_BIG); const float* la = (const float*)(a.ws + WS_BIG + BIG_LA);
    bf16_t* mix = (bf16_t*)(a.ws + WS_R1);
    const float* S0 = a.in[I_SGLA] + ((size_t)b * 4 + h) * 8192;
    float* S1 = a.out + O_GLAS + ((size_t)b * 4 + h) * 8192;
    const float qv = bf2f(proj[(size_t)row * NPROJ + PQA + h * 64 + lane]) * 0.125f;
    const float kv = bf2f(proj[(size_t)row * NPROJ + PKA + h * 64 + lane]);
    const float av = __expf(la[(size_t)row * 256 + h * 64 + lane]);
    const unsigned vw = *(const unsigned*)(proj + (size_t)row * NPROJ + PVA + h * 128 + lane * 2);
    const float v0 = bf_lo(vw), v1 = bf_hi(vw);
    float o0 = 0.f, o1 = 0.f;
#pragma unroll 1
    for (int d0 = 0; d0 < 64; d0 += 16) {
        f32x2 sv[16];
#pragma unroll
        for (int j = 0; j < 16; ++j) sv[j] = __builtin_nontemporal_load((const f32x2*)(S0 + (d0 + j) * 128 + lane * 2));
#pragma unroll
        for (int j = 0; j < 16; ++j) {
            const int dk = d0 + j;
            const float q = __shfl(qv, dk), k = __shfl(kv, dk), al = __shfl(av, dk);
            const float n0 = al * sv[j].x + k * v0, n1 = al * sv[j].y + k * v1;
            __builtin_nontemporal_store((f32x2){n0, n1}, (f32x2*)(S1 + dk * 128 + lane * 2));
            o0 += q * n0; o1 += q * n1;
        }
    }
    const float ss = wave_sum(o0 * o0 + o1 * o1);
    const float rstd = rsqrtf(ss * (1.0f / 128.f) + EPS);
    const unsigned rw = *(const unsigned*)(proj + (size_t)row * NPROJ + PRA + h * 128 + lane * 2);
    const float r0 = bf_lo(rw), r1 = bf_hi(rw);
    const float y0 = o0 * rstd * a.in[I_ONORM][lane * 2] * (r0 / (1.f + __expf(-r0))), y1 = o1 * rstd * a.in[I_ONORM][lane * 2 + 1] * (r1 / (1.f + __expf(-r1)));
    *(unsigned*)(mix + (size_t)row * D + h * 128 + lane * 2) = cvt_pk_bf16(y0, y1);
}

__device__ __forceinline__ void swa_unit(const KArgs& a, LAS unsigned char* lds, int unit) {
    const int tid = otid(); const int qblk = unit >> 1, kvh = unit & 1;
    const bf16_t* proj = (const bf16_t*)(a.ws + WS_BIG);
    bf16_t* mix = (bf16_t*)(a.ws + WS_R1);
    LAS float* Kw = (LAS float*)lds; LAS float* Vw = Kw + 255 * 68;
    const int tk0 = qblk * 128 - 127;
    const float* kn = a.in[I_KNORM];
    for (int idx = tid; idx < 256 * 8; idx += NTHREADS) {
        const int kk = idx >> 3, part = idx & 7; const int tk = tk0 + kk;
        float kf[8], vf[8];
#pragma unroll
        for (int j = 0; j < 8; ++j) { kf[j] = 0.f; vf[j] = 0.f; }
        if (kk < 255 && tk >= 0) {
            const u32x4 kw = *(const u32x4*)(proj + (size_t)tk * NPROJ + PKB + kvh * 64 + part * 8); unpack8(kw, kf);
            const u32x4 vw = *(const u32x4*)(proj + (size_t)tk * NPROJ + PVB + kvh * 64 + part * 8); unpack8(vw, vf);
        }
        float ss = 0.f;
#pragma unroll
        for (int j = 0; j < 8; ++j) ss += kf[j] * kf[j];
        ss += __shfl_xor(ss, 1); ss += __shfl_xor(ss, 2); ss += __shfl_xor(ss, 4);
        const float rstd = rsqrtf(ss * (1.0f / 64.f) + EPS);
#pragma unroll
        for (int j = 0; j < 8; ++j) kf[j] = kf[j] * rstd * kn[part * 8 + j];
        if (kk < 255) {
            *(LAS f32x4*)(Kw + kk * 68 + part * 8) = (f32x4){kf[0], kf[1], kf[2], kf[3]}; *(LAS f32x4*)(Kw + kk * 68 + part * 8 + 4) = (f32x4){kf[4], kf[5], kf[6], kf[7]};
            *(LAS f32x4*)(Vw + kk * 68 + part * 8) = (f32x4){vf[0], vf[1], vf[2], vf[3]}; *(LAS f32x4*)(Vw + kk * 68 + part * 8 + 4) = (f32x4){vf[4], vf[5], vf[6], vf[7]};
            if (qblk == 127 && kk >= 127) {
                const int w = kk - 127;
                float* ko = a.out + O_SKP + ((size_t)w * 2 + kvh) * 64 + part * 8; float* vo = a.out + O_SVP + ((size_t)w * 2 + kvh) * 64 + part * 8;
                *(f32x4*)ko = (f32x4){kf[0], kf[1], kf[2], kf[3]}; *(f32x4*)(ko + 4) = (f32x4){kf[4], kf[5], kf[6], kf[7]};
                *(f32x4*)vo = (f32x4){vf[0], vf[1], vf[2], vf[3]}; *(f32x4*)(vo + 4) = (f32x4){vf[4], vf[5], vf[6], vf[7]};
            }
        }
    }
    __syncthreads();
    const int g = tid >> 7, qi = tid & 127, hq = kvh * 4 + g; const int t = qblk * 128 + qi;
    float q[64];
    { float ss = 0.f;
#pragma unroll
      for (int p = 0; p < 8; ++p) { const u32x4 qw = *(const u32x4*)(proj + (size_t)t * NPROJ + PQB + hq * 64 + p * 8); unpack8(qw, q + p * 8); }
#pragma unroll
      for (int d = 0; d < 64; ++d) ss += q[d] * q[d];
      const float rstd = rsqrtf(ss * (1.0f / 64.f) + EPS) * 0.125f;
#pragma unroll
      for (int d = 0; d < 64; ++d) q[d] = q[d] * rstd * a.in[I_QNORM][d]; }
    const float slope = exp2f(-(float)(hq + 1));
    float mx = a.in[I_SINKS][hq], l = 1.f;
    float o[64];
#pragma unroll
    for (int d = 0; d < 64; ++d) o[d] = 0.f;
    for (int i = 0; i < 128; ++i) {
        const int kk = qi + i; const int tk = tk0 + kk;
        const LAS float* kr = Kw + kk * 68;
        float s0 = 0.f, s1 = 0.f, s2 = 0.f, s3 = 0.f;
#pragma unroll
        for (int d = 0; d < 64; d += 4) { const f32x4 k4 = *(const LAS f32x4*)(kr + d); s0 += q[d] * k4[0]; s1 += q[d + 1] * k4[1]; s2 += q[d + 2] * k4[2]; s3 += q[d + 3] * k4[3]; }
        float s = (s0 + s1) + (s2 + s3) - slope * (float)(127 - i);
        if (tk < 0) s = -1e30f;
        const float mn = fmaxf(mx, s); const float corr = __expf(mx - mn), p = __expf(s - mn);
        mx = mn; l = l * corr + p;
        const LAS float* vr = Vw + kk * 68;
#pragma unroll
        for (int d = 0; d < 64; d += 4) { const f32x4 v4 = *(const LAS f32x4*)(vr + d); o[d] = o[d] * corr + p * v4[0]; o[d + 1] = o[d + 1] * corr + p * v4[1]; o[d + 2] = o[d + 2] * corr + p * v4[2]; o[d + 3] = o[d + 3] * corr + p * v4[3]; }
    }
    const float inv = 1.f / l;
#pragma unroll
    for (int p = 0; p < 8; ++p) { u32x4 w; w.x = cvt_pk_bf16(o[p * 8] * inv, o[p * 8 + 1] * inv); w.y = cvt_pk_bf16(o[p * 8 + 2] * inv, o[p * 8 + 3] * inv);
        w.z = cvt_pk_bf16(o[p * 8 + 4] * inv, o[p * 8 + 5] * inv); w.w = cvt_pk_bf16(o[p * 8 + 6] * inv, o[p * 8 + 7] * inv);
        *(u32x4*)(mix + (size_t)t * D + 512 + hq * 64 + p * 8) = w; }
    __syncthreads();
}
__device__ __forceinline__ void swa_unit_m(const KArgs& a, LAS unsigned char* lds, int unit) {
    const int tid = otid(), lane = tid & 63, wave = __builtin_amdgcn_readfirstlane(tid >> 6);
    const int qb = unit >> 1, kvh = unit & 1; const int q0 = qb * 64, w0 = q0 - 128;
    const bf16_t* proj = (const bf16_t*)(a.ws + WS_BIG);
    bf16_t* mix = (bf16_t*)(a.ws + WS_R1);
    LAS bf16_t* Kl = (LAS bf16_t*)lds;
    LAS bf16_t* Vt = Kl + 192 * 72;
    const float* kn = a.in[I_KNORM];
#pragma unroll 1
    for (int c = tid; c < 1536; c += NTHREADS) {
        const int kk = c >> 3, part = c & 7; const int tk = w0 + kk;
        float kf[8];
        u32x4 vw = (u32x4){0u, 0u, 0u, 0u};
#pragma unroll
        for (int j = 0; j < 8; ++j) kf[j] = 0.f;
        if (tk >= 0) {
            const u32x4 kw = *(const u32x4*)(proj + (size_t)tk * NPROJ + PKB + kvh * 64 + part * 8); unpack8(kw, kf);
            vw = *(const u32x4*)(proj + (size_t)tk * NPROJ + PVB + kvh * 64 + part * 8);
        }
        float ss = 0.f;
#pragma unroll
        for (int j = 0; j < 8; ++j) ss += kf[j] * kf[j];
        ss += __shfl_xor(ss, 1); ss += __shfl_xor(ss, 2); ss += __shfl_xor(ss, 4);
        const float rstd = rsqrtf(ss * (1.0f / 64.f) + EPS);
#pragma unroll
        for (int j = 0; j < 8; ++j) kf[j] = kf[j] * rstd * kn[part * 8 + j];
        u32x4 kw2; kw2.x = cvt_pk_bf16(kf[0], kf[1]); kw2.y = cvt_pk_bf16(kf[2], kf[3]); kw2.z = cvt_pk_bf16(kf[4], kf[5]); kw2.w = cvt_pk_bf16(kf[6], kf[7]);
        *(LAS u32x4*)(Kl + kk * 72 + part * 8) = kw2;
        LAS bf16_t* vt = Vt + (part * 8) * 196 + kk;
        vt[0 * 196] = (bf16_t)(vw.x & 0xffffu); vt[1 * 196] = (bf16_t)(vw.x >> 16); vt[2 * 196] = (bf16_t)(vw.y & 0xffffu); vt[3 * 196] = (bf16_t)(vw.y >> 16);
        vt[4 * 196] = (bf16_t)(vw.z & 0xffffu); vt[5 * 196] = (bf16_t)(vw.z >> 16); vt[6 * 196] = (bf16_t)(vw.w & 0xffffu); vt[7 * 196] = (bf16_t)(vw.w >> 16);
        if (qb == 255 && kk >= 64) {
            const int w = kk - 64;
            float vf[8]; unpack8(vw, vf);
            float* ko = a.out + O_SKP + ((size_t)w * 2 + kvh) * 64 + part * 8; float* vo = a.out + O_SVP + ((size_t)w * 2 + kvh) * 64 + part * 8;
            *(f32x4*)ko = (f32x4){kf[0], kf[1], kf[2], kf[3]}; *(f32x4*)(ko + 4) = (f32x4){kf[4], kf[5], kf[6], kf[7]};
            *(f32x4*)vo = (f32x4){vf[0], vf[1], vf[2], vf[3]}; *(f32x4*)(vo + 4) = (f32x4){vf[4], vf[5], vf[6], vf[7]};
        }
    }
    __syncthreads();
    const int g = wave & 3, th = wave >> 2, hq = kvh * 4 + g;
    const int r = lane & 31, hh = lane >> 5;
    const int t = q0 + 32 * th + r;
    constexpr float LOG2E = 1.4426950408889634f;
    bf16x8 qf[4];
    {
        float qv[4][8]; float ss = 0.f;
#pragma unroll
        for (int s = 0; s < 4; ++s) { const u32x4 w = *(const u32x4*)(proj + (size_t)t * NPROJ + PQB + hq * 64 + 16 * s + 8 * hh); unpack8(w, qv[s]);
#pragma unroll
            for (int j = 0; j < 8; ++j) ss += qv[s][j] * qv[s][j]; }
        ss += __shfl_xor(ss, 32);
        const float rstd = rsqrtf(ss * (1.0f / 64.f) + EPS) * (0.125f * LOG2E);
        const float* qn = a.in[I_QNORM];
#pragma unroll
        for (int s = 0; s < 4; ++s) {
            u32x4 w;
            w.x = cvt_pk_bf16(qv[s][0] * rstd * qn[16 * s + 8 * hh + 0], qv[s][1] * rstd * qn[16 * s + 8 * hh + 1]);
            w.y = cvt_pk_bf16(qv[s][2] * rstd * qn[16 * s + 8 * hh + 2], qv[s][3] * rstd * qn[16 * s + 8 * hh + 3]);
            w.z = cvt_pk_bf16(qv[s][4] * rstd * qn[16 * s + 8 * hh + 4], qv[s][5] * rstd * qn[16 * s + 8 * hh + 5]);
            w.w = cvt_pk_bf16(qv[s][6] * rstd * qn[16 * s + 8 * hh + 6], qv[s][7] * rstd * qn[16 * s + 8 * hh + 7]);
            qf[s] = __builtin_bit_cast(bf16x8, w);
        }
    }
    f32x16 sacc[5];
#pragma unroll
    for (int k5 = 0; k5 < 5; ++k5) {
        const int kt = th + k5;
        f32x16 acc = {};
#pragma unroll
        for (int s = 0; s < 4; ++s) { const bf16x8 af = *(const LAS bf16x8*)(Kl + (kt * 32 + r) * 72 + 16 * s + 8 * hh); acc = __builtin_amdgcn_mfma_f32_32x32x16_bf16(af, qf[s], acc, 0, 0, 0); }
        sacc[k5] = acc;
    }
    const float slope2 = exp2f(-(float)(hq + 1)) * LOG2E;
    const float sink2 = a.in[I_SINKS][hq] * LOG2E;
    float mx = sink2;
#pragma unroll
    for (int k5 = 0; k5 < 5; ++k5)
#pragma unroll
        for (int i = 0; i < 16; ++i) {
            const int row = (i & 3) + 8 * (i >> 2) + 4 * hh;
            const int dist = 128 - 32 * k5 + r - row;
            const int tk = w0 + 32 * (th + k5) + row;
            float s = sacc[k5][i] - slope2 * (float)dist;
            if (dist < 0 || dist >= 128 || tk < 0) s = -1e30f;
            sacc[k5][i] = s; mx = fmaxf(mx, s);
        }
    mx = fmaxf(mx, __shfl_xor(mx, 32));
    float l = 0.f;
#pragma unroll
    for (int k5 = 0; k5 < 5; ++k5)
#pragma unroll
        for (int i = 0; i < 16; ++i) { const float p = exp2f(sacc[k5][i] - mx); sacc[k5][i] = p; l += p; }
    l += __shfl_xor(l, 32);
    l += exp2f(sink2 - mx);
    f32x16 oacc[2] = {{}, {}};
#pragma unroll
    for (int k5 = 0; k5 < 5; ++k5) {
        const int kt = th + k5;
#pragma unroll
        for (int s2 = 0; s2 < 2; ++s2) {
            u32x4 pw;
            pw.x = cvt_pk_bf16(sacc[k5][8 * s2 + 0], sacc[k5][8 * s2 + 1]); pw.y = cvt_pk_bf16(sacc[k5][8 * s2 + 2], sacc[k5][8 * s2 + 3]);
            pw.z = cvt_pk_bf16(sacc[k5][8 * s2 + 4], sacc[k5][8 * s2 + 5]); pw.w = cvt_pk_bf16(sacc[k5][8 * s2 + 6], sacc[k5][8 * s2 + 7]);
            const bf16x8 pf = __builtin_bit_cast(bf16x8, pw);
#pragma unroll
            for (int dt = 0; dt < 2; ++dt) {
                const LAS bf16_t* vp = Vt + (32 * dt + r) * 196 + kt * 32 + 16 * s2 + 4 * hh;
                const u32x2 v0 = *(const LAS u32x2*)vp, v1 = *(const LAS u32x2*)(vp + 8);
                const u32x4 vv = (u32x4){v0.x, v0.y, v1.x, v1.y};
                oacc[dt] = __builtin_amdgcn_mfma_f32_32x32x16_bf16(__builtin_bit_cast(bf16x8, vv), pf, oacc[dt], 0, 0, 0);
            }
        }
    }
    const float inv = 1.f / l;
#pragma unroll
    for (int dt = 0; dt < 2; ++dt)
#pragma unroll
        for (int q = 0; q < 4; ++q) {
            u32x2 w; w.x = cvt_pk_bf16(oacc[dt][4 * q] * inv, oacc[dt][4 * q + 1] * inv); w.y = cvt_pk_bf16(oacc[dt][4 * q + 2] * inv, oacc[dt][4 * q + 3] * inv);
            *(u32x2*)(mix + (size_t)t * D + 512 + hq * 64 + 32 * dt + 8 * q + 4 * hh) = w;
        }
    __syncthreads();
}
__device__ __forceinline__ void swa_decode_item(const KArgs& a, int item, int lane) {
    const int b = item >> 3, kvh = (item >> 2) & 1, g = item & 3, hq = kvh * 4 + g; const int row = SROW + b;
    const bf16_t* proj = (const bf16_t*)(a.ws + WS_BIG);
    bf16_t* mix = (bf16_t*)(a.ws + WS_R1);
    const float* ck = a.in[I_CK] + (size_t)b * 128 * 128 + kvh * 64;
    const float* cv = a.in[I_CV] + (size_t)b * 128 * 128 + kvh * 64;
    float qd = bf2f(proj[(size_t)row * NPROJ + PQB + hq * 64 + lane]);
    { const float ss = wave_sum(qd * qd); qd = qd * rsqrtf(ss * (1.0f / 64.f) + EPS) * a.in[I_QNORM][lane] * 0.125f; }
    float kd = bf2f(proj[(size_t)row * NPROJ + PKB + kvh * 64 + lane]);
    { const float ss = wave_sum(kd * kd); kd = kd * rsqrtf(ss * (1.0f / 64.f) + EPS) * a.in[I_KNORM][lane]; }
    const float vd = bf2f(proj[(size_t)row * NPROJ + PVB + kvh * 64 + lane]);
    const float slope = exp2f(-(float)(hq + 1));
    float s0 = 0.f, s1 = 0.f;
    for (int d = 0; d < 64; d += 4) {
        const f32x4 k0 = *(const f32x4*)(ck + (size_t)lane * 128 + d), k1 = *(const f32x4*)(ck + (size_t)(lane + 64) * 128 + d);
        const float q0 = __shfl(qd, d), q1 = __shfl(qd, d + 1), q2 = __shfl(qd, d + 2), q3 = __shfl(qd, d + 3);
        s0 += (q0 * k0[0] + q1 * k0[1]) + (q2 * k0[2] + q3 * k0[3]);
        s1 += (q0 * k1[0] + q1 * k1[1]) + (q2 * k1[2] + q3 * k1[3]);
    }
    s0 -= slope * (float)(128 - lane); s1 -= slope * (float)(64 - lane);
    if (lane == 0) s0 = -1e30f;
    const float sn = wave_sum(qd * kd);
    const float sink = a.in[I_SINKS][hq];
    const float mx = fmaxf(fmaxf(wave_max(fmaxf(s0, s1)), sn), sink);
    const float p0 = __expf(s0 - mx), p1 = __expf(s1 - mx), pn = __expf(sn - mx);
    const float l = wave_sum(p0 + p1) + pn + __expf(sink - mx);
    float od = pn * vd;
#pragma unroll 1
    for (int w0 = 0; w0 < 64; w0 += 16) {
        float ca[16], cb[16];
#pragma unroll
        for (int j = 0; j < 16; ++j) { ca[j] = cv[(size_t)(w0 + j) * 128 + lane]; cb[j] = cv[(size_t)(w0 + j + 64) * 128 + lane]; }
#pragma unroll
        for (int j = 0; j < 16; ++j) { const float pa = __shfl(p0, w0 + j), pb = __shfl(p1, w0 + j); od += pa * ca[j] + pb * cb[j]; }
    }
    od /= l;
    const float oo = __shfl_down(od, 1);
    if ((lane & 1) == 0) *(unsigned*)(mix + (size_t)row * D + 512 + hq * 64 + lane) = cvt_pk_bf16(od, oo);
    if (g == 0) {
        float* __restrict__ ko = a.out + O_SKS + (size_t)b * 128 * 128 + kvh * 64; float* __restrict__ vo = a.out + O_SVS + (size_t)b * 128 * 128 + kvh * 64;
#pragma unroll 1
        for (int w0 = 0; w0 < 128; w0 += 16) {
            float ka[16], va[16];
#pragma unroll
            for (int j = 0; j < 16; ++j) { const int w = w0 + j + 1; ka[j] = (w < 128) ? ck[(size_t)w * 128 + lane] : kd; va[j] = (w < 128) ? cv[(size_t)w * 128 + lane] : vd; }
#pragma unroll
            for (int j = 0; j < 16; ++j) { ko[(size_t)(w0 + j) * 128 + lane] = ka[j]; vo[(size_t)(w0 + j) * 128 + lane] = va[j]; }
        }
    }
}

template <int W>
__device__ __forceinline__ void pool_core(const float* __restrict__ h, const LAS float* rsL, float gg, int r0, int c, bf16_t* __restrict__ d1, float* __restrict__ poolp) {
    float xn[31];
#pragma unroll
    for (int i = 0; i < 31; ++i) { const int r = r0 - 15 + i; xn[i] = (i >= 16 - W && r >= 0) ? h[(size_t)r * D + c] : 0.f; }
#pragma unroll
    for (int i = 0; i < 31; ++i) xn[i] *= rsL[i] * gg;
    float s = 0.f;
#pragma unroll
    for (int j = 1; j < W; ++j) s += xn[15 - j];
#pragma unroll
    for (int i = 0; i < 16; ++i) {
        const int r = r0 + i;
        s += xn[15 + i];
        const int cnt = (r + 1 < W) ? r + 1 : W;
        const float dd = s / (float)cnt - xn[15 + i];
        d1[(size_t)r * D + c] = (bf16_t)(cvt_pk_bf16(dd, 0.f) & 0xffffu);
        s -= xn[15 + i - (W - 1)];
        if (r >= SEQ - 15) poolp[(size_t)(r - (SEQ - 15)) * D + c] = xn[15 + i];
    }
}
__device__ __forceinline__ void pool_item(const KArgs& a, LAS unsigned char* lds, int item, const float* part_in) {
    const int tid = otid();
    const float* h = a.out + O_YP; bf16_t* d1 = (bf16_t*)(a.ws + WS_R1);
    LAS float* rsL = (LAS float*)lds;
    const int r0 = item * 16;
    __syncthreads();
    if (tid < 31) { const int r = r0 - 15 + tid; float rs = 0.f;
        if (r >= 0) { const f32x4 p0 = *(const f32x4*)(part_in + (long)r * 16), p1 = *(const f32x4*)(part_in + (long)r * 16 + 4), p2 = *(const f32x4*)(part_in + (long)r * 16 + 8), p3 = *(const f32x4*)(part_in + (long)r * 16 + 12);
            const float s = ((p0[0] + p0[1]) + (p0[2] + p0[3])) + ((p1[0] + p1[1]) + (p1[2] + p1[3])) + ((p2[0] + p2[1]) + (p2[2] + p2[3])) + ((p3[0] + p3[1]) + (p3[2] + p3[3]));
            rs = rsqrtf(s * (1.0f / D) + EPS); }
        rsL[tid] = rs; }
    __syncthreads();
#pragma unroll
    for (int cc = 0; cc < 2; ++cc) {
        const int c = tid + cc * NTHREADS; const int gq = __builtin_amdgcn_readfirstlane(c >> 8);
        const float gg = a.in[I_MNO][c];
        if (gq == 0) pool_core<2>(h, rsL, gg, r0, c, d1, a.out + O_POOLP);
        else if (gq == 1) pool_core<4>(h, rsL, gg, r0, c, d1, a.out + O_POOLP);
        else if (gq == 2) pool_core<8>(h, rsL, gg, r0, c, d1, a.out + O_POOLP);
        else pool_core<16>(h, rsL, gg, r0, c, d1, a.out + O_POOLP);
    }
}
__device__ __forceinline__ void pool_sample_item(const KArgs& a, LAS unsigned char* lds, int b, const float* part_in) {
    const int tid = otid();
    const float* __restrict__ h = a.out + O_YS + (size_t)b * D; bf16_t* __restrict__ d1 = (bf16_t*)(a.ws + WS_R1);
    const float* __restrict__ st = a.in[I_SPOOL] + (size_t)b * 15 * D; float* __restrict__ so = a.out + O_POOLS + (size_t)b * 15 * D;
    float s = 0.f;
#pragma unroll
    for (int i = 0; i < 16; ++i) s += part_in[(long)(SROW + b) * 16 + i];
    const float rs = rsqrtf(s * (1.0f / D) + EPS);
#pragma unroll
    for (int cc = 0; cc < 2; ++cc) {
        const int c = tid + cc * NTHREADS; const int w = 2 << (c >> 8);
        float sv[15];
#pragma unroll
        for (int j = 0; j < 15; ++j) sv[j] = st[(size_t)j * D + c];
        const float xn = h[c] * rs * a.in[I_MNO][c];
        float sum = xn;
#pragma unroll
        for (int j = 0; j < 15; ++j) sum += (j >= 16 - w) ? sv[j] : 0.f;
        const float dd = sum / (float)w - xn;
        d1[(size_t)(SROW + b) * D + c] = (bf16_t)(cvt_pk_bf16(dd, 0.f) & 0xffffu);
#pragma unroll
        for (int j = 0; j < 14; ++j) so[(size_t)j * D + c] = sv[j + 1];
        so[(size_t)14 * D + c] = xn;
    }
}

#define XB_TMO      128
#define XB_XCNT(j)  (256  + 64 * (j))
#define XB_XSUB(j)  (1280 + 64 * (j))
#define XB_XGEN(j)  (2304 + 64 * (j))
#define XB_TOP      3328
#define XB_TOPGEN   3392
#define XCD_BAR_WORDS 3456
#define XB_SPIN_CAP (1u << 18)
__device__ __forceinline__ unsigned xb_ld(unsigned* p)              { return __hip_atomic_load(p, __ATOMIC_RELAXED, __HIP_MEMORY_SCOPE_AGENT); }
__device__ __forceinline__ unsigned xb_add(unsigned* p, unsigned v) { return __hip_atomic_fetch_add(p, v, __ATOMIC_RELAXED, __HIP_MEMORY_SCOPE_AGENT); }
__device__ __forceinline__ unsigned xb_xcc_id() { return (unsigned)__builtin_amdgcn_s_getreg((3 << 11) | 20) & 0xFu; }
#define XB_SPIN(cond, bar) do { unsigned _sp = 0; while (cond) { __builtin_amdgcn_s_sleep(1); \
    if ((++_sp & 255u) == 0u) { if (xb_ld(&(bar)[XB_TMO])) break; if (_sp > XB_SPIN_CAP) { atomicAdd(&(bar)[XB_TMO], 1u); break; } } } } while (0)
struct XcdBarrier { unsigned* bar; unsigned x; volatile LAS unsigned* st; };
__device__ __forceinline__ XcdBarrier xcd_barrier_post(unsigned* bar, volatile LAS unsigned* st) {
    XcdBarrier b; b.bar = bar; b.x = xb_xcc_id(); b.st = st;
    if (threadIdx.x == 0) (void)xb_add(&bar[XB_XCNT(b.x)], 1u);
    return b;
}
__device__ __forceinline__ void xcd_barrier_complete(unsigned* bar, unsigned x, unsigned& nloc, unsigned& nx) {
    const unsigned G = gridDim.x * gridDim.y * gridDim.z;
    unsigned sum, cnt, mine, sp = 0u;
    for (;;) {
        sum = 0u; cnt = 0u; mine = 0u;
#pragma unroll
        for (unsigned j = 0; j < 16; ++j) { const unsigned c = xb_ld(&bar[XB_XCNT(j)]); sum += c; cnt += (c > 0u) ? 1u : 0u; mine = (j == x) ? c : mine; }
        if (sum == G) break;
        __builtin_amdgcn_s_sleep(1);
        if ((++sp & 255u) == 0u) { if (xb_ld(&bar[XB_TMO])) break; if (sp > XB_SPIN_CAP) { atomicAdd(&bar[XB_TMO], 1u); break; } }
    }
    nloc = mine > 0u ? mine : 1u; nx = cnt > 0u ? cnt : 1u;
}
__device__ __forceinline__ void xcd_barrier(const XcdBarrier& b) {
    asm volatile("s_waitcnt vmcnt(0)" ::: "memory");
    __syncthreads();
    if (threadIdx.x == 0) {
        unsigned* bar = b.bar;
        __builtin_amdgcn_s_waitcnt(0);
        unsigned nloc = b.st[0], nx = b.st[1];
        if (nloc == 0u) { xcd_barrier_complete(bar, b.x, nloc, nx); b.st[0] = nloc; b.st[1] = nx; }
        const unsigned old = xb_add(&bar[XB_XSUB(b.x)], 1u);
        const unsigned gen = old / nloc;
        if (old + 1u == (gen + 1u) * nloc) {
            __builtin_amdgcn_fence(__ATOMIC_RELEASE, "agent");
            asm volatile("s_waitcnt vmcnt(0)" ::: "memory");
            const unsigned og = xb_add(&bar[XB_TOP], 1u);
            const unsigned tg = og / nx;
            if (og + 1u == (tg + 1u) * nx) xb_add(&bar[XB_TOPGEN], 1u);
            else XB_SPIN(xb_ld(&bar[XB_TOPGEN]) == tg, bar);
            __builtin_amdgcn_fence(__ATOMIC_ACQUIRE, "agent");
            xb_add(&bar[XB_XGEN(b.x)], 1u);
            asm volatile("s_waitcnt vmcnt(0)" ::: "memory");
        } else {
            XB_SPIN(xb_ld(&bar[XB_XGEN(b.x)]) == gen, bar);
            __builtin_amdgcn_fence(__ATOMIC_ACQUIRE, "agent");
            asm volatile("s_waitcnt vmcnt(0)" ::: "memory");
        }
    }
    __syncthreads();
}

#ifndef DUPM
#define DUPM 0
#endif
#ifndef SYNCREP
#define SYNCREP 1
#endif
#define GSYNC() do { _Pragma("unroll 1") for (int sr_ = 0; sr_ < SYNCREP; ++sr_) xcd_barrier(xbar); } while (0)
#define PH(k) _Pragma("unroll 1") for (int rep_ = 0; rep_ < (((DUPM) >> (k)) & 1) + 1; ++rep_)
__global__ void __launch_bounds__(NTHREADS, 2) mega_fwd(KArgs a) {
    extern __shared__ __attribute__((aligned(16))) unsigned char lds_raw[];
    LAS unsigned char* lds = (LAS unsigned char*)lds_raw;
    cg::grid_group grid = cg::this_grid();
    const int G = gridDim.x, bx = blockIdx.x;
    const int vcu = (G % 8 == 0) ? (bx % 8) * (G / 8) + bx / 8 : bx;
    unsigned char* ws = a.ws;
    if (ws == nullptr) grid.sync();
    volatile LAS unsigned* xst = (volatile LAS unsigned*)(lds + LDS_BYTES - 64);
    if (threadIdx.x < 16) xst[threadIdx.x] = 0u;
    __syncthreads();
    const XcdBarrier xbar = xcd_barrier_post((unsigned*)(ws + 16384), xst);
    bf16_t* R1 = (bf16_t*)(ws + WS_R1); bf16_t* R2 = (bf16_t*)(ws + WS_R2 + 4096);
    bf16_t* BIGB = (bf16_t*)(ws + WS_BIG);
    const bf16_t* pbf = (const bf16_t*)(ws + WS_PBF);

    PH(0) p0_prologue(a, lds, vcu, G);
    GSYNC();
    PH(1) {
        pg8::Gemm g{R1, (const bf16_t*)(ws + WS_WIN0), 1024, 1024, 1024, 256, 0, 0};
        pg8::StaticOrder S; S.init(65, 10, G, bx);
        EpiProj E{BIGB, (float*)(ws + WS_BIG + BIG_LA), (const float*)(ws + WS_SSQ), a.in[I_BALPHA]};
        pg8::gemm_phase(lds, g, S, E);
    }
    GSYNC();
    PH(2) for (int it = vcu; it < 256; it += G) gla_item_m<false>(a, lds, it);
    PH(3) for (int it = vcu; it < 512; it += G) swa_unit_m(a, lds, it);
    PH(4) { const int tid = otid(), lane = tid & 63, wave = __builtin_amdgcn_readfirstlane(tid >> 6); for (int it = vcu * 8 + wave; it < 512; it += G * 8) gla_decode_item(a, it, lane); }
    PH(5) { const int tid = otid(), lane = tid & 63, wave = __builtin_amdgcn_readfirstlane(tid >> 6); for (int it = vcu * 8 + wave; it < 1024; it += G * 8) swa_decode_item(a, it, lane); }
    GSYNC();
    PH(6) gla_scan_m(a, vcu);
    GSYNC();
    PH(7) for (int it = vcu; it < 256; it += G) gla_item_m<true>(a, lds, it);
    GSYNC();
    PH(8) {
        pg8::Gemm g{R1, (const bf16_t*)(ws + WS_WOUT0), 1024, 1024, 1024, 256, 0, 0};
        pg8::StaticOrder S; S.init(65, 4, G, bx);
        EpiRes<0, true, true> E{a.out, a.in[I_XP], a.in[I_XS], R2, part_tab(ws, 0), nullptr, nullptr, nullptr};
        pg8::gemm_phase(lds, g, S, E);
    }
    GSYNC();
#pragma unroll 1
    for (int l = 0; l < 2; ++l) {
        bf16_t* G_ = BIGB;
        bf16_t* PPb = BIGB;
        PH(9) {
            pg8::Gemm g{R2, (const bf16_t*)(ws + WS_WFFI + l * WFFI_BYTES), 1024, 1024, 1024, 254, -2, 0};
            pg8::StaticOrder S; S.init(66, 22, G, bx);
            EpiFfn E{part_tab(ws, l == 0 ? 0 : 3), a.in[I_FCW] + (size_t)l * 3 * DFF, a.in[I_FCB] + (size_t)l * DFF, a.in[I_SCONV] + (size_t)l * NS * 2 * DFF,
                     a.out + O_CONVP + (size_t)l * 2 * DFF, a.out + O_CONVS + (size_t)l * NS * 2 * DFF, G_};
            pg8::gemm_phase(lds, g, S, E);
        }
        GSYNC();
        PH(10) {
            pg8::Gemm g{G_, (const bf16_t*)(ws + WS_WFFO + l * WFFO_BYTES), DFF, DFF, DFF, 256, 0, 0};
            pg8::StaticOrder S; S.init(65, 4, G, bx);
            EpiRes<1, true, true> E{a.out, nullptr, nullptr, R1, part_tab(ws, l == 0 ? 1 : 4), nullptr, nullptr, nullptr};
            pg8::gemm_phase(lds, g, S, E);
        }
        GSYNC();
        PH(11) {
            pg8::Gemm g{pbf + (size_t)l * MT * PLE, (const bf16_t*)(ws + WS_WPROJ + l * WPROJ_BYTES), PLE, PLE, PLE, 256, 0, 0};
            pg8::StaticOrder S; S.init(65, 4, G, bx);
            EpiPP E{PPb};
            pg8::gemm_phase(lds, g, S, E);
        }
        PH(12) {
            pg8::Gemm g{R1, (const bf16_t*)(ws + WS_WGATE + l * WGATE_BYTES), 1024, 1024, 1024, 256, 0, 0};
            pg8::StaticOrder S; S.init(65, 4, G, bx);
            if (l == 0) { EpiRes<2, false, true> E{a.out, nullptr, nullptr, nullptr, part_tab(ws, 2), part_tab(ws, 1), PPb, nullptr}; pg8::gemm_phase(lds, g, S, E); }
            else { EpiRes<2, false, false> E{a.out, nullptr, nullptr, nullptr, nullptr, part_tab(ws, 4), PPb, nullptr}; pg8::gemm_phase(lds, g, S, E); }
        }
        if (l == 0) {
            GSYNC();
            PH(13) for (int it = vcu; it < 1024 + NS; it += G) { if (it < 1024) pool_item(a, lds, it, part_tab(ws, 2)); else pool_sample_item(a, lds, it - 1024, part_tab(ws, 2)); }
            GSYNC();
            PH(14) {
                pg8::Gemm g{R1, (const bf16_t*)(ws + WS_WPOOL), 1024, 256, 256, 256, 0, 256};
                pg8::StaticOrder S; S.init(65, 4, G, bx);
                EpiRes<3, true, true> E{a.out, nullptr, nullptr, R2, part_tab(ws, 3), nullptr, nullptr, a.in[I_POOLSC]};
                pg8::gemm_phase(lds, g, S, E);
            }
            GSYNC();
        }
    }
}

extern "C" void kernel_launch(void* const* d_in, const int* in_sizes, int n_in, void* d_out, int out_size, void* d_ws, size_t ws_size, hipStream_t stream) {
    static int grid = 0;
    if (grid == 0) {
        int dev = 0, cus = 0, per_cu = 0;
        hipGetDevice(&dev);
        hipDeviceGetAttribute(&cus, hipDeviceAttributeMultiprocessorCount, dev);
        hipFuncSetAttribute((const void*)mega_fwd, hipFuncAttributeMaxDynamicSharedMemorySize, LDS_BYTES);
        hipOccupancyMaxActiveBlocksPerMultiprocessor(&per_cu, (const void*)mega_fwd, NTHREADS, LDS_BYTES);
        if (per_cu < 1) { fprintf(stderr, "kernel_launch: occupancy query reports %d blocks per CU\n", per_cu); per_cu = 1; }
        if (per_cu > 1) per_cu = 1;
        grid = cus * per_cu;
        (void)hipGetLastError();
    }
    (void)hipMemsetAsync(d_ws, 0, 65536, stream);
    KArgs a{};
    for (int i = 0; i < 29; ++i) a.in[i] = (const float*)d_in[i];
    a.out = (float*)d_out; a.ws = (unsigned char*)d_ws;
    void* args[] = {&a};
    hipError_t e = hipLaunchCooperativeKernel((const void*)mega_fwd, dim3(grid), dim3(NTHREADS), args, LDS_BYTES, stream);
    if (e != hipSuccess) fprintf(stderr, "cooperative launch failed: %s (grid %d)\n", hipGetErrorString(e), grid);
}
```

```cpp
#include <hip/hip_runtime.h>
#include <hip/hip_cooperative_groups.h>
#include <cstdio>
#include <cstdint>
namespace cg = cooperative_groups;

#define LAS __attribute__((address_space(3)))
typedef unsigned short bf16_t;
typedef short bf16x8 __attribute__((ext_vector_type(8)));
typedef float f32x4 __attribute__((ext_vector_type(4)));
typedef float f32x2 __attribute__((ext_vector_type(2)));
typedef unsigned u32x4 __attribute__((ext_vector_type(4)));
typedef unsigned u32x2 __attribute__((ext_vector_type(2)));
typedef float f32x16 __attribute__((ext_vector_type(16)));

constexpr int D = 1024, SEQ = 16384, NS = 128, DFF = 2816, PLE = 256;
constexpr int SROW = 16510;
constexpr int MT = 16640;
constexpr int MR = 16768;
constexpr int NPROJ = 2304;
constexpr int PQA = 0, PKA = 256, PVA = 512, PRA = 1024, PQB = 1536, PKB = 2048, PVB = 2176;
constexpr float EPS = 1e-6f;
constexpr int NTHREADS = 512;

constexpr size_t O_YP = 0, O_YS = 16777216, O_GLAP = 16908288, O_SKP = 16941056, O_SVP = 16957440, O_POOLP = 16973824, O_CONVP = 16989184,
                 O_GLAS = 17000448, O_SKS = 21194752, O_SVS = 23291904, O_POOLS = 25389056, O_CONVS = 27355136;

constexpr size_t MiB = 1u << 20;
constexpr size_t WS_WIN0 = 1 * MiB, WS_WOUT0 = 6 * MiB, WS_WFFI = 8 * MiB, WS_WFFO = 30 * MiB, WS_WGATE = 41 * MiB, WS_WPROJ = 45 * MiB, WS_WPOOL = 46 * MiB;
constexpr size_t WS_SSQ = 47 * MiB;
constexpr size_t WS_PBF = 55 * MiB, WS_R1 = 72 * MiB, WS_R2 = 105 * MiB, WS_BIG = 138 * MiB;
constexpr size_t PART_STRIDE = (size_t)(MR + 8) * 16 * 4;
constexpr size_t WFFI_BYTES = (size_t)5632 * 1024 * 2, WFFO_BYTES = (size_t)1024 * 2816 * 2, WGATE_BYTES = (size_t)1024 * 1024 * 2, WPROJ_BYTES = (size_t)1024 * 256 * 2;
constexpr size_t BIG_LA = (size_t)MT * NPROJ * 2;
constexpr int LDS_BYTES = 155648;

__device__ __forceinline__ unsigned cvt_pk_bf16(float lo, float hi) { unsigned r; asm volatile("v_cvt_pk_bf16_f32 %0, %1, %2" : "=v"(r) : "v"(lo), "v"(hi)); return r; }
__device__ __forceinline__ float bf_lo(unsigned w) { return __uint_as_float(w << 16); }
__device__ __forceinline__ float bf_hi(unsigned w) { return __uint_as_float(w & 0xffff0000u); }
__device__ __forceinline__ float bf2f(bf16_t v) { return __uint_as_float(((unsigned)v) << 16); }
__device__ __forceinline__ void unpack8(const u32x4 w, float* f) { f[0] = bf_lo(w.x); f[1] = bf_hi(w.x); f[2] = bf_lo(w.y); f[3] = bf_hi(w.y); f[4] = bf_lo(w.z); f[5] = bf_hi(w.z); f[6] = bf_lo(w.w); f[7] = bf_hi(w.w); }
__device__ __forceinline__ float wave_sum(float v) {
#pragma unroll
    for (int o = 1; o < 64; o <<= 1) v += __shfl_xor(v, o);
    return v;
}
__device__ __forceinline__ float wave_max(float v) {
#pragma unroll
    for (int o = 1; o < 64; o <<= 1) v = fmaxf(v, __shfl_xor(v, o));
    return v;
}
__device__ __forceinline__ int otid() { int t = threadIdx.x; asm volatile("" : "+v"(t)); return t; }
__device__ __forceinline__ bool row_valid(int row) { return row < SEQ || (row >= SROW && row < SROW + NS); }
__device__ __forceinline__ float* hrow_ptr(float* out, int row) { return row < SEQ ? out + O_YP + (size_t)row * D : out + O_YS + (size_t)(row - SROW) * D; }
__device__ __forceinline__ f32x2 gelu_pk(f32x2 v) {
    const f32x2 av = __builtin_elementwise_abs(v), d = av * 0.2316418882f + 1.0f;
    f32x2 t; t.x = __builtin_amdgcn_rcpf(d.x); t.y = __builtin_amdgcn_rcpf(d.y);
    f32x2 q = t * 0.5307027145f + (-0.7265760135f); q = q * t + 0.7107068705f; q = q * t + (-0.142248368f); q = q * t + 0.127414796f; q = q * t;
    const f32x2 s = (v * v) * (-0.72134752044f);
    f32x2 e; e.x = __builtin_amdgcn_exp2f(s.x); e.y = __builtin_amdgcn_exp2f(s.y);
    const f32x2 m = v * (q * e), r = v - m;
    f32x2 o; o.x = v.x < 0.f ? m.x : r.x; o.y = v.y < 0.f ? m.y : r.y; return o;
}

namespace pg8 {
constexpr int BM = 256, BK = 64, HALF = 128, HTB = HALF * BK * 2, STAGE_BYTES = 8 * HTB, NXCD = 8, WGM = 8;
__host__ __device__ __forceinline__ int lds_byte(int r, int c) { const int st = (r >> 4) * 2 + (c >> 5), rr = r & 15, cc = c & 31, ob = rr * 64 + cc * 2; return st * 1024 + (ob ^ (((ob >> 9) & 1) << 5)); }
__host__ __device__ __forceinline__ void stage_rc(int b, int& R, int& C) { const int st = b / 1024, sb = b % 1024, swz = sb ^ (((sb >> 9) & 1) << 5); R = (st >> 1) * 16 + swz / 64; C = (st & 1) * 32 + (swz % 64) / 2; }
__host__ __device__ __forceinline__ int perm32(int rho) { const int n = rho >> 4, i = rho & 15; return 8 * (i >> 2) + 4 * n + (i & 3); }

struct Unit { int pm, pn; };
struct Gemm { const bf16_t* A; const bf16_t* Bt; int lda, ldb, K, mstride, arow0, acolstep; };

struct StaticOrder {
    int nM, nN, nwg, G, c;
    __device__ void init(int nM_, int nN_, int G_, int c_) { nM = nM_; nN = nN_; nwg = nM * nN; G = G_; c = c_; }
    __device__ bool next(int i, Unit& u) const {
        const long L = (long)i * G + c; if (L >= nwg) return false;
        int wgid = (int)L; { const int q = nwg / NXCD, r = nwg % NXCD, xcd = wgid % NXCD, off = wgid / NXCD; wgid = (xcd < r ? xcd * (q + 1) : r * (q + 1) + (xcd - r) * q) + off; }
        const int nig = WGM * nN, gid = wgid / nig, fm = gid * WGM, gsz = (nM - fm) < WGM ? (nM - fm) : WGM;
        u.pm = fm + ((wgid % nig) % gsz); u.pn = (wgid % nig) / gsz; return true;
    }
};

template <class Epi>
__device__ __forceinline__ void gemm_phase(LAS unsigned char* lds, const Gemm g, const StaticOrder& S, const Epi& E) {
    const int tid = otid(), wid = __builtin_amdgcn_readfirstlane(tid >> 6), lane = tid & 63, wr = wid >> 2, wc = wid & 3, fr = lane & 15, fq = lane >> 4;
    const int K = g.K, nt = K / BK;
    unsigned voffA[2], voffB[2];
#pragma unroll
    for (int i = 0; i < 2; ++i) { int R, C; stage_rc(tid * 16 + i * 8192, R, C); const int Rb = (R & ~31) + perm32(R & 31);
        voffA[i] = (unsigned)(R * g.lda + C) * 2u; voffB[i] = (unsigned)(Rb * g.ldb + C) * 2u; }
    const size_t kstep = (size_t)(BK * 2);
    const size_t hstepA = (size_t)HALF * g.lda * 2, hstepB = (size_t)HALF * g.ldb * 2;
    const unsigned ldsw = (unsigned)wid * 1024u;
    const int aoff = lds_byte(wr * 64 + fr, fq * 8), boff = lds_byte(wc * 32 + fr, fq * 8);
#define PG8_SA(b, h) (((b) * 2 + (h)) * HTB)
#define PG8_SB(b, h) ((4 + (b) * 2 + (h)) * HTB)
#define PG8_STAGE(bufoff, gbase, voff) do { _Pragma("unroll") for (int _i = 0; _i < 2; ++_i) \
        __builtin_amdgcn_global_load_lds((const unsigned*)((const char*)(gbase) + (voff)[_i]), (LAS unsigned*)(lds + (bufoff) + ldsw + _i * 8192), 16, 0, 0); } while (0)
#define PG8_LDA(dst, b, h) do { _Pragma("unroll") for (int m = 0; m < 4; ++m) _Pragma("unroll") for (int k = 0; k < 2; ++k) dst[m][k] = *(const LAS bf16x8*)(lds + PG8_SA(b, h) + aoff + m * 2048 + k * 1024); } while (0)
#define PG8_LDB(dst, b, h) do { _Pragma("unroll") for (int n = 0; n < 2; ++n) _Pragma("unroll") for (int k = 0; k < 2; ++k) dst[n][k] = *(const LAS bf16x8*)(lds + PG8_SB(b, h) + boff + n * 2048 + k * 1024); } while (0)
#define PG8_MMA(ai, bj, At, Bt) do { __builtin_amdgcn_s_setprio(1); _Pragma("unroll") for (int m = 0; m < 4; ++m) _Pragma("unroll") for (int n = 0; n < 2; ++n) _Pragma("unroll") for (int k = 0; k < 2; ++k) \
        acc[ai][bj][m][n] = __builtin_amdgcn_mfma_f32_16x16x32_bf16(Bt[n][k], At[m][k], acc[ai][bj][m][n], 0, 0, 0); __builtin_amdgcn_s_setprio(0); } while (0)
#define PG8_WAIT_V(n) asm volatile("s_waitcnt vmcnt(" #n ")" ::: "memory")
#define PG8_WAIT_L(n) asm volatile("s_waitcnt lgkmcnt(" #n ")" ::: "memory")
#define PG8_BAR __builtin_amdgcn_s_barrier()
#define PG8_SCHED __builtin_amdgcn_sched_barrier(0)
#define PG8_ABASE(u) ((const char*)g.A + ((long)((long)(u).pm * g.mstride + g.arow0) * g.lda + (long)(u).pn * g.acolstep) * 2)
#define PG8_BBASE(u) ((const char*)g.Bt + (size_t)(u).pn * 256 * g.ldb * 2)
    Unit cur, nxt; int ui = 0;
    if (!S.next(0, cur)) return;
    f32x4 acc[2][2][4][2];
#pragma unroll
    for (int a = 0; a < 2; ++a)
#pragma unroll
        for (int b = 0; b < 2; ++b)
#pragma unroll
            for (int m = 0; m < 4; ++m)
#pragma unroll
                for (int n = 0; n < 2; ++n) acc[a][b][m][n] = (f32x4){0.f, 0.f, 0.f, 0.f};
    bf16x8 At[4][2], B0[2][2], B1[2][2];
    const char* cA = PG8_ABASE(cur); const char* cB = PG8_BBASE(cur);
    PG8_STAGE(PG8_SB(0, 0), cB, voffB); PG8_STAGE(PG8_SB(0, 1), cB + hstepB, voffB); PG8_STAGE(PG8_SA(0, 0), cA, voffA); PG8_STAGE(PG8_SA(0, 1), cA + hstepA, voffA);
    if (wr == 1) PG8_BAR;
    PG8_WAIT_V(2); PG8_BAR;
    PG8_STAGE(PG8_SB(1, 0), cB + kstep, voffB); PG8_STAGE(PG8_SA(1, 0), cA + kstep, voffA); PG8_STAGE(PG8_SB(1, 1), cB + hstepB + kstep, voffB);
    PG8_WAIT_V(6); PG8_BAR;
    for (;;) {
        const bool has_next = S.next(ui + 1, nxt);
        const char* nA = has_next ? PG8_ABASE(nxt) : cA; const char* nB = has_next ? PG8_BBASE(nxt) : cB;
#pragma unroll 1
        for (int t = 0; t < nt; t += 2) {
            const bool last = (t == nt - 2);
            const char* a1 = cA + (size_t)(t + 1) * kstep;
            const char* a2 = last ? nA : cA + (size_t)(t + 2) * kstep; const char* b2 = last ? nB : cB + (size_t)(t + 2) * kstep;
            const char* a3 = a2 + kstep; const char* b3 = b2 + kstep;
            PG8_LDB(B0, 0, 0); PG8_LDB(B1, 0, 1); PG8_SCHED; PG8_LDA(At, 0, 0); PG8_STAGE(PG8_SA(1, 1), a1 + hstepA, voffA);
            PG8_WAIT_V(8); PG8_WAIT_L(0); PG8_BAR; PG8_MMA(0, 0, At, B0); PG8_MMA(0, 1, At, B1); PG8_BAR; PG8_SCHED;
            PG8_LDA(At, 0, 1); PG8_STAGE(PG8_SB(0, 0), b2, voffB); PG8_STAGE(PG8_SB(0, 1), b2 + hstepB, voffB); PG8_STAGE(PG8_SA(0, 0), a2, voffA);
            PG8_WAIT_V(8); PG8_WAIT_L(0); PG8_BAR; PG8_MMA(1, 0, At, B0); PG8_MMA(1, 1, At, B1); PG8_BAR; PG8_SCHED;
            PG8_LDB(B0, 1, 0); PG8_LDB(B1, 1, 1); PG8_SCHED; PG8_LDA(At, 1, 0); PG8_STAGE(PG8_SA(0, 1), a2 + hstepA, voffA);
            PG8_WAIT_V(8); PG8_WAIT_L(0); PG8_BAR; PG8_MMA(0, 0, At, B0); PG8_MMA(0, 1, At, B1); PG8_BAR; PG8_SCHED;
            PG8_LDA(At, 1, 1); PG8_STAGE(PG8_SB(1, 0), b3, voffB); PG8_STAGE(PG8_SB(1, 1), b3 + hstepB, voffB); PG8_STAGE(PG8_SA(1, 0), a3, voffA);
            PG8_WAIT_V(8); PG8_WAIT_L(0); PG8_BAR; PG8_MMA(1, 0, At, B0); PG8_MMA(1, 1, At, B1); PG8_BAR; PG8_SCHED;
        }
        if (wr == 0) PG8_BAR;
        { int lane2 = lane; asm volatile("" : "+v"(lane2)); E(acc, cur, wr, wc, lane2 & 15, lane2 >> 4, lds + STAGE_BYTES); }
        if (!has_next) break;
#pragma unroll
        for (int a = 0; a < 2; ++a)
#pragma unroll
            for (int b = 0; b < 2; ++b)
#pragma unroll
                for (int m = 0; m < 4; ++m)
#pragma unroll
                    for (int n = 0; n < 2; ++n) acc[a][b][m][n] = (f32x4){0.f, 0.f, 0.f, 0.f};
        cur = nxt; cA = nA; cB = nB; ++ui;
        if (wr == 1) PG8_BAR;
    }
    PG8_WAIT_V(0);
    PG8_BAR;
#undef PG8_SA
#undef PG8_SB
#undef PG8_STAGE
#undef PG8_LDA
#undef PG8_LDB
#undef PG8_MMA
#undef PG8_WAIT_V
#undef PG8_WAIT_L
#undef PG8_BAR
#undef PG8_SCHED
#undef PG8_ABASE
#undef PG8_BBASE
}
}
using pg8::Unit;
typedef f32x4 AccT[2][2][4][2];

__device__ __forceinline__ float row_rs(const float* part, int row, int fq) {
    const f32x4 p = *(const f32x4*)(part + (long)row * 16 + fq * 4);
    float s = (p[0] + p[1]) + (p[2] + p[3]);
    s += __shfl_xor(s, 16); s += __shfl_xor(s, 32);
    return rsqrtf(s * (1.0f / D) + EPS);
}

struct EpiProj {
    bf16_t* proj; float* la; const float* ssq0; const float* b_alpha;
    __device__ __forceinline__ void operator()(const AccT& acc, const Unit& u, int wr, int wc, int fr, int fq, LAS unsigned char*) const {
#pragma unroll
        for (int ai = 0; ai < 2; ++ai)
#pragma unroll
            for (int m = 0; m < 4; ++m) {
                const int row = u.pm * 256 + ai * 128 + wr * 64 + m * 16 + fr;
                const float rs = rsqrtf(ssq0[row] * (1.0f / D) + EPS);
#pragma unroll
                for (int bj = 0; bj < 2; ++bj) {
                    const int col = u.pn * 256 + bj * 128 + wc * 32 + fq * 8;
                    const f32x4 v0 = acc[ai][bj][m][0] * rs, v1 = acc[ai][bj][m][1] * rs;
                    if (u.pn < 9) {
                        u32x4 w; w.x = cvt_pk_bf16(v0[0], v0[1]); w.y = cvt_pk_bf16(v0[2], v0[3]); w.z = cvt_pk_bf16(v1[0], v1[1]); w.w = cvt_pk_bf16(v1[2], v1[3]);
                        *(u32x4*)(proj + (size_t)row * NPROJ + col) = w;
                    } else {
                        const int c = col - NPROJ;
                        const f32x4 b0 = *(const f32x4*)(b_alpha + c), b1 = *(const f32x4*)(b_alpha + c + 4);
                        f32x4 o0, o1;
#pragma unroll
                        for (int j = 0; j < 4; ++j) {
                            const float z0 = v0[j] + b0[j], z1 = v1[j] + b1[j];
                            o0[j] = (fminf(z0, 0.f) - log1pf(__expf(-fabsf(z0)))) * 0.0625f;
                            o1[j] = (fminf(z1, 0.f) - log1pf(__expf(-fabsf(z1)))) * 0.0625f;
                        }
                        *(f32x4*)(la + (size_t)row * 256 + c) = o0; *(f32x4*)(la + (size_t)row * 256 + c + 4) = o1;
                    }
                }
            }
    }
};
struct EpiPP {
    bf16_t* pp;
    __device__ __forceinline__ void operator()(const AccT& acc, const Unit& u, int wr, int wc, int fr, int fq, LAS unsigned char*) const {
#pragma unroll
        for (int ai = 0; ai < 2; ++ai)
#pragma unroll
            for (int m = 0; m < 4; ++m) {
                const int row = u.pm * 256 + ai * 128 + wr * 64 + m * 16 + fr;
#pragma unroll
                for (int bj = 0; bj < 2; ++bj) {
                    const int col = u.pn * 256 + bj * 128 + wc * 32 + fq * 8;
                    const f32x4 v0 = acc[ai][bj][m][0], v1 = acc[ai][bj][m][1];
                    u32x4 w; w.x = cvt_pk_bf16(v0[0], v0[1]); w.y = cvt_pk_bf16(v0[2], v0[3]); w.z = cvt_pk_bf16(v1[0], v1[1]); w.w = cvt_pk_bf16(v1[2], v1[3]);
                    *(u32x4*)(pp + (size_t)row * D + col) = w;
                }
            }
    }
};
template <int MODE, bool WRITE_HB, bool WRITE_PART>
struct EpiRes {
    float* out; const float* xp; bf16_t* hb; float* part; const float* part_in; const bf16_t* pp; const float* scale;
    __device__ __forceinline__ void operator()(const AccT& acc, const Unit& u, int wr, int wc, int fr, int fq, LAS unsigned char*) const {
#pragma unroll
        for (int ai = 0; ai < 2; ++ai)
#pragma unroll
            for (int m = 0; m < 4; ++m) {
                const int row = u.pm * 256 + ai * 128 + wr * 64 + m * 16 + fr;
                float rs = 1.f;
                if (MODE == 2) rs = row_rs(part_in, row, fq);
                float sq = 0.f;
                float* hp = out + O_YP + (size_t)row * D;
                const float* bp = (MODE == 0) ? xp + (size_t)row * D : hp;
#pragma unroll
                for (int bj = 0; bj < 2; ++bj) {
                    const int col = u.pn * 256 + bj * 128 + wc * 32 + fq * 8;
                    f32x4 v0 = acc[ai][bj][m][0], v1 = acc[ai][bj][m][1];
                    if (MODE == 2) {
                        const u32x4 pw = *(const u32x4*)(pp + (size_t)row * D + col);
                        float pf[8]; unpack8(pw, pf);
#pragma unroll
                        for (int j = 0; j < 4; ++j) {
                            v0[j] = pf[j] / (1.f + __expf(-v0[j] * rs));
                            v1[j] = pf[4 + j] / (1.f + __expf(-v1[j] * rs));
                        }
                    }
                    if (MODE == 3) { v0 = v0 * *(const f32x4*)(scale + col); v1 = v1 * *(const f32x4*)(scale + col + 4); }
                    const f32x4 h0 = *(const f32x4*)(bp + col) + v0, h1 = *(const f32x4*)(bp + col + 4) + v1;
                    *(f32x4*)(hp + col) = h0; *(f32x4*)(hp + col + 4) = h1;
                    if (WRITE_HB) { u32x4 w; w.x = cvt_pk_bf16(h0[0], h0[1]); w.y = cvt_pk_bf16(h0[2], h0[3]); w.z = cvt_pk_bf16(h1[0], h1[1]); w.w = cvt_pk_bf16(h1[2], h1[3]);
                        *(u32x4*)(hb + (size_t)row * D + col) = w; }
                    sq += (h0[0] * h0[0] + h0[1] * h0[1]) + (h0[2] * h0[2] + h0[3] * h0[3]) + (h1[0] * h1[0] + h1[1] * h1[1]) + (h1[2] * h1[2] + h1[3] * h1[3]);
                }
                if (WRITE_PART) {
                    sq += __shfl_xor(sq, 16); sq += __shfl_xor(sq, 32);
                    if (fq == 0) part[(long)row * 16 + u.pn * 4 + wc] = sq;
                }
            }
    }
};
struct EpiFfn {
    const float* part_in; const float* convw; const float* convb; float* convp_out; bf16_t* G;
    __device__ __forceinline__ void operator()(AccT& acc, const Unit& u, int wr, int wc, int fr, int fq, LAS unsigned char* ldsx) const {
        const int lane = fr + 16 * fq;
        const int c0 = u.pn * 128 + wc * 32 + fq * 8;
#pragma unroll
        for (int ai = 0; ai < 2; ++ai)
#pragma unroll
            for (int m = 0; m < 4; ++m) {
                const int grow = u.pm * 254 - 2 + ai * 128 + wr * 64 + m * 16 + fr;
                const float rs = row_rs(part_in, grow, fq);
#pragma unroll
                for (int bj = 0; bj < 2; ++bj)
#pragma unroll
                    for (int n = 0; n < 2; ++n) acc[ai][bj][m][n] = acc[ai][bj][m][n] * rs;
            }
        LAS f32x4* xch = (LAS f32x4*)ldsx;
        if (fr >= 14) {
#pragma unroll
            for (int ai = 0; ai < 2; ++ai) {
                const int slot = ((((ai * 2 + wr) * 4 + wc) * 4 + fq) * 2 + (fr - 14)) * 2;
                xch[slot] = acc[ai][0][3][0]; xch[slot + 1] = acc[ai][0][3][1];
            }
        }
        asm volatile("s_waitcnt lgkmcnt(0)" ::: "memory"); __builtin_amdgcn_s_barrier(); asm volatile("" ::: "memory");
        const int src1 = (lane & 48) | ((fr + 15) & 15), src2 = (lane & 48) | ((fr + 14) & 15);
#pragma unroll
        for (int n = 0; n < 2; ++n) {
            const int cn = c0 + 4 * n;
            const f32x4 w0 = *(const f32x4*)(convw + cn), w1 = *(const f32x4*)(convw + DFF + cn), w2 = *(const f32x4*)(convw + 2 * DFF + cn), cb = *(const f32x4*)(convb + cn);
#pragma unroll
            for (int ai = 0; ai < 2; ++ai)
#pragma unroll
                for (int m = 0; m < 4; ++m) {
                    const int tr = ai * 128 + wr * 64 + m * 16 + fr;
                    const int grow = u.pm * 254 - 2 + tr;
                    const f32x4 x = acc[ai][0][m][n];
                    f32x4 p;
                    if (m == 0) {
                        const int sa = (wr == 1) ? ai : 0, sw = (wr == 1) ? 0 : 1;
                        const bool has = (wr == 1) || (ai == 1);
                        const int slot = ((((sa * 2 + sw) * 4 + wc) * 4 + fq) * 2 + (fr >= 14 ? fr - 14 : 0)) * 2 + n;
                        p = xch[slot];
                        if (!has) p = (f32x4){0.f, 0.f, 0.f, 0.f};
                    } else p = acc[ai][0][m == 0 ? 0 : m - 1][n];
                    f32x4 p1, p2;
#pragma unroll
                    for (int j = 0; j < 4; ++j) {
                        const float x1 = __shfl(x[j], src1), x2 = __shfl(x[j], src2), q1 = __shfl(p[j], src1), q2 = __shfl(p[j], src2);
                        p1[j] = (fr >= 1) ? x1 : q1;
                        p2[j] = (fr >= 2) ? x2 : q2;
                    }
                    const bool store = (tr >= 2 && grow < SEQ);
                    if (grow >= SEQ - 2 && grow < SEQ) *(f32x4*)(convp_out + (size_t)(grow - (SEQ - 2)) * DFF + cn) = x;
                    const f32x4 ac = cb + w0 * p2 + w1 * p1 + w2 * x;
                    const f32x4 v = acc[ai][1][m][n];
                    const f32x2 g0 = gelu_pk((f32x2){ac[0], ac[1]}), g1 = gelu_pk((f32x2){ac[2], ac[3]});
                    if (store) {
                        u32x2 w; w.x = cvt_pk_bf16(g0.x * v[0], g0.y * v[1]); w.y = cvt_pk_bf16(g1.x * v[2], g1.y * v[3]);
                        *(u32x2*)(G + (size_t)grow * DFF + cn) = w;
                    }
                    asm volatile("" ::: "memory");
                }
        }
    }
};

struct KArgs { const float* in[29]; float* out; unsigned char* ws; };
enum { I_XP = 0, I_XS, I_PP, I_PS, I_SGLA, I_CK, I_CV, I_SPOOL, I_SCONV, I_MNE, I_WIN, I_WALPHA, I_BALPHA, I_ONORM, I_QNORM, I_KNORM, I_SINKS, I_WOUT,
       I_MNO, I_POOLW, I_POOLSC, I_FNORM, I_FWIN, I_FCW, I_FCB, I_FWOUT, I_PNORM, I_PWPROJ, I_PWGATE };

__device__ __forceinline__ float* part_tab(unsigned char* ws, int i) { return (float*)(ws + WS_SSQ + 262144 + (size_t)i * PART_STRIDE) + 2 * 16; }

constexpr int SPART_PITCH = 68;
template <int K, int LDA, int LDB>
__device__ __forceinline__ void sgemm_tile(const bf16_t* __restrict__ A, const bf16_t* __restrict__ B0, const bf16_t* __restrict__ B1, LAS float* part) {
    const int tid = otid(), lane = tid & 63, wave = __builtin_amdgcn_readfirstlane(tid >> 6);
    const int kq = wave & 3, mh = wave >> 2, fr = lane & 15, fq = lane >> 4;
    constexpr int KQ = K / 4;
    const bf16_t* ap = A + (size_t)(64 * mh + fr) * LDA + kq * KQ + 8 * fq;
    const bf16_t* bp0 = B0 + (size_t)fr * LDB + kq * KQ + 8 * fq;
    const bf16_t* bp1 = B1 + (size_t)fr * LDB + kq * KQ + 8 * fq;
    f32x4 acc[4][4];
#pragma unroll
    for (int m = 0; m < 4; ++m)
#pragma unroll
        for (int n = 0; n < 4; ++n) acc[m][n] = (f32x4){0.f, 0.f, 0.f, 0.f};
#pragma unroll 2
    for (int k0 = 0; k0 < KQ; k0 += 32) {
        bf16x8 af[4], bf[4];
#pragma unroll
        for (int m = 0; m < 4; ++m) af[m] = *(const bf16x8*)(ap + (size_t)(16 * m) * LDA + k0);
        bf[0] = *(const bf16x8*)(bp0 + k0); bf[1] = *(const bf16x8*)(bp0 + (size_t)16 * LDB + k0);
        bf[2] = *(const bf16x8*)(bp1 + k0); bf[3] = *(const bf16x8*)(bp1 + (size_t)16 * LDB + k0);
#pragma unroll
        for (int m = 0; m < 4; ++m)
#pragma unroll
            for (int n = 0; n < 4; ++n) acc[m][n] = __builtin_amdgcn_mfma_f32_16x16x32_bf16(bf[n], af[m], acc[m][n], 0, 0, 0);
    }
#pragma unroll
    for (int m = 0; m < 4; ++m)
#pragma unroll
        for (int n = 0; n < 4; ++n) *(LAS f32x4*)(part + (kq * 128 + 64 * mh + 16 * m + fr) * SPART_PITCH + 16 * n + 4 * fq) = acc[m][n];
}
template <int N>
__device__ __forceinline__ void sreduce(const LAS float* part, int b, int col0, float* v) {
#pragma unroll
    for (int j = 0; j < N; j += 4) {
        f32x4 s = *(const LAS f32x4*)(part + b * SPART_PITCH + col0 + j);
#pragma unroll
        for (int kq = 1; kq < 4; ++kq) s += *(const LAS f32x4*)(part + (kq * 128 + b) * SPART_PITCH + col0 + j);
        v[j] = s[0]; v[j + 1] = s[1]; v[j + 2] = s[2]; v[j + 3] = s[3];
    }
}
template <int MODE, bool WRITE_HB, bool WRITE_PART>
__device__ __forceinline__ void s_res_epi(const KArgs& a, int b, int q, int n0, const float* v, bf16_t* hb, float* part, const float* ppv, float rs_in, const float* scale) {
    const int row = SROW + b, c0 = n0 + 16 * q;
    float* hp = a.out + O_YS + (size_t)b * D + c0;
    const float* bp = (MODE == 0) ? a.in[I_XS] + (size_t)b * D + c0 : hp;
    float hn[16]; float sq = 0.f;
#pragma unroll
    for (int j = 0; j < 16; j += 4) {
        const f32x4 bv = *(const f32x4*)(bp + j);
#pragma unroll
        for (int i = 0; i < 4; ++i) {
            float nv = v[j + i];
            if (MODE == 2) nv = ppv[j + i] / (1.f + __expf(-nv * rs_in));
            if (MODE == 3) nv = nv * scale[c0 + j + i];
            hn[j + i] = bv[i] + nv; sq += hn[j + i] * hn[j + i];
        }
        *(f32x4*)(hp + j) = (f32x4){hn[j], hn[j + 1], hn[j + 2], hn[j + 3]};
    }
    if (WRITE_HB) {
        u32x4 w0, w1;
        w0.x = cvt_pk_bf16(hn[0], hn[1]); w0.y = cvt_pk_bf16(hn[2], hn[3]); w0.z = cvt_pk_bf16(hn[4], hn[5]); w0.w = cvt_pk_bf16(hn[6], hn[7]);
        w1.x = cvt_pk_bf16(hn[8], hn[9]); w1.y = cvt_pk_bf16(hn[10], hn[11]); w1.z = cvt_pk_bf16(hn[12], hn[13]); w1.w = cvt_pk_bf16(hn[14], hn[15]);
        *(u32x4*)(hb + (size_t)row * D + c0) = w0; *(u32x4*)(hb + (size_t)row * D + c0 + 8) = w1;
    }
    if (WRITE_PART) {
        sq += __shfl_xor(sq, 1); sq += __shfl_xor(sq, 2);
        if (q == 0) part[(long)row * 16 + (n0 >> 6)] = sq;
    }
}
__device__ __forceinline__ float s_row_rs(const float* part, int b) {
    const float* p = part + (long)(SROW + b) * 16;
    const f32x4 p0 = *(const f32x4*)(p), p1 = *(const f32x4*)(p + 4), p2 = *(const f32x4*)(p + 8), p3 = *(const f32x4*)(p + 12);
    const float s = ((p0[0] + p0[1]) + (p0[2] + p0[3])) + ((p1[0] + p1[1]) + (p1[2] + p1[3])) + ((p2[0] + p2[1]) + (p2[2] + p2[3])) + ((p3[0] + p3[1]) + (p3[2] + p3[3]));
    return rsqrtf(s * (1.0f / D) + EPS);
}
__device__ __forceinline__ void s_proj_units(const KArgs& a, LAS unsigned char* lds, int u0, int G) {
    LAS float* part = (LAS float*)lds;
    const bf16_t* xbf = (const bf16_t*)(a.ws + WS_R1) + (size_t)SROW * D; const bf16_t* W = (const bf16_t*)(a.ws + WS_WIN0);
    bf16_t* proj = (bf16_t*)(a.ws + WS_BIG); float* la = (float*)(a.ws + WS_BIG + BIG_LA); const float* ssq0 = (const float*)(a.ws + WS_SSQ);
    for (int u = u0; u < 40; u += G) {
        const int n0 = u * 64;
        sgemm_tile<1024, 1024, 1024>(xbf, W + (size_t)n0 * 1024, W + (size_t)(n0 + 32) * 1024, part);
        __syncthreads();
        const int tid = otid(), b = tid >> 2, q = tid & 3, c0 = n0 + 16 * q, row = SROW + b;
        float v[16]; sreduce<16>(part, b, 16 * q, v);
        const float rs = rsqrtf(ssq0[row] * (1.0f / D) + EPS);
        if (n0 < NPROJ) {
            u32x4 w0, w1;
            w0.x = cvt_pk_bf16(v[0] * rs, v[1] * rs); w0.y = cvt_pk_bf16(v[2] * rs, v[3] * rs); w0.z = cvt_pk_bf16(v[4] * rs, v[5] * rs); w0.w = cvt_pk_bf16(v[6] * rs, v[7] * rs);
            w1.x = cvt_pk_bf16(v[8] * rs, v[9] * rs); w1.y = cvt_pk_bf16(v[10] * rs, v[11] * rs); w1.z = cvt_pk_bf16(v[12] * rs, v[13] * rs); w1.w = cvt_pk_bf16(v[14] * rs, v[15] * rs);
            *(u32x4*)(proj + (size_t)row * NPROJ + c0) = w0; *(u32x4*)(proj + (size_t)row * NPROJ + c0 + 8) = w1;
        } else {
            const int c = c0 - NPROJ;
#pragma unroll
            for (int j = 0; j < 16; j += 4) { f32x4 o;
#pragma unroll
                for (int i = 0; i < 4; ++i) { const float z = v[j + i] * rs + a.in[I_BALPHA][c + j + i]; o[i] = (fminf(z, 0.f) - log1pf(__expf(-fabsf(z)))) * 0.0625f; }
                *(f32x4*)(la + (size_t)row * 256 + c + j) = o; }
        }
        __syncthreads();
    }
}
template <int MODE, int K, int LDA>
__device__ __forceinline__ void s_res_units(const KArgs& a, LAS unsigned char* lds, int u0, int G, const bf16_t* A, const bf16_t* W, bf16_t* hb, float* part_out) {
    LAS float* part = (LAS float*)lds;
    for (int u = u0; u < 16; u += G) {
        const int n0 = u * 64;
        const bf16_t* Au = A + (size_t)SROW * LDA + (MODE == 3 ? (n0 >> 8) * 256 : 0);
        sgemm_tile<K, LDA, K>(Au, W + (size_t)n0 * K, W + (size_t)(n0 + 32) * K, part);
        __syncthreads();
        const int tid = otid(), b = tid >> 2, q = tid & 3;
        float v[16]; sreduce<16>(part, b, 16 * q, v);
        s_res_epi<MODE, true, true>(a, b, q, n0, v, hb, part_out, nullptr, 1.f, a.in[I_POOLSC]);
        __syncthreads();
    }
}
template <bool LAST>
__device__ __forceinline__ void s_ple_units(const KArgs& a, LAS unsigned char* lds, int u0, int G, const bf16_t* pb, const bf16_t* Wp, const bf16_t* hbA, const bf16_t* Wg, const float* part_in, float* part_out) {
    LAS float* part = (LAS float*)lds;
    for (int u = u0; u < 16; u += G) {
        const int n0 = u * 64;
        sgemm_tile<256, 256, 256>(pb + (size_t)SROW * PLE, Wp + (size_t)n0 * PLE, Wp + (size_t)(n0 + 32) * PLE, part);
        __syncthreads();
        const int tid = otid(), b = tid >> 2, q = tid & 3;
        float ppv[16]; sreduce<16>(part, b, 16 * q, ppv);
        __syncthreads();
        sgemm_tile<1024, 1024, 1024>(hbA + (size_t)SROW * D, Wg + (size_t)n0 * D, Wg + (size_t)(n0 + 32) * D, part);
        __syncthreads();
        float v[16]; sreduce<16>(part, b, 16 * q, v);
        const float rs = s_row_rs(part_in, b);
        s_res_epi<2, false, !LAST>(a, b, q, n0, v, nullptr, part_out, ppv, rs, nullptr);
        __syncthreads();
    }
}
__device__ __forceinline__ void s_ffn_units(const KArgs& a, LAS unsigned char* lds, int u0, int G, int l, const bf16_t* hbA, const float* part_in) {
    LAS float* part = (LAS float*)lds;
    const bf16_t* W = (const bf16_t*)(a.ws + WS_WFFI + l * WFFI_BYTES);
    bf16_t* Gb = (bf16_t*)(a.ws + WS_BIG);
    const float* convw = a.in[I_FCW] + (size_t)l * 3 * DFF; const float* convb = a.in[I_FCB] + (size_t)l * DFF;
    const float* cstate = a.in[I_SCONV] + (size_t)l * NS * 2 * DFF; float* convs = a.out + O_CONVS + (size_t)l * NS * 2 * DFF;
    for (int u = u0; u < 88; u += G) {
        const int ca = u * 32;
        const int nr = 256 * (ca >> 7) + (ca & 127);
        sgemm_tile<1024, 1024, 1024>(hbA + (size_t)SROW * D, W + (size_t)nr * 1024, W + (size_t)(nr + 128) * 1024, part);
        __syncthreads();
        const int tid = otid(), b = tid >> 2, q = tid & 3, c = ca + 8 * q;
        float av[8], vv[8]; sreduce<8>(part, b, 8 * q, av); sreduce<8>(part, b, 32 + 8 * q, vv);
        const float rs = s_row_rs(part_in, b);
        const float* st = cstate + (size_t)b * 2 * DFF + c; float* so = convs + (size_t)b * 2 * DFF + c;
        float g[8];
#pragma unroll
        for (int j = 0; j < 8; j += 4) {
            const f32x4 p2 = *(const f32x4*)(st + j), p1 = *(const f32x4*)(st + DFF + j);
            const f32x4 w0 = *(const f32x4*)(convw + c + j), w1 = *(const f32x4*)(convw + DFF + c + j), w2 = *(const f32x4*)(convw + 2 * DFF + c + j), cb = *(const f32x4*)(convb + c + j);
            const f32x4 x = (f32x4){av[j] * rs, av[j + 1] * rs, av[j + 2] * rs, av[j + 3] * rs};
            *(f32x4*)(so + j) = p1; *(f32x4*)(so + DFF + j) = x;
            const f32x4 ac = cb + w0 * p2 + w1 * p1 + w2 * x;
            const f32x2 g0 = gelu_pk((f32x2){ac[0], ac[1]}), g1 = gelu_pk((f32x2){ac[2], ac[3]});
            g[j] = g0.x * vv[j] * rs; g[j + 1] = g0.y * vv[j + 1] * rs; g[j + 2] = g1.x * vv[j + 2] * rs; g[j + 3] = g1.y * vv[j + 3] * rs;
        }
        u32x4 w; w.x = cvt_pk_bf16(g[0], g[1]); w.y = cvt_pk_bf16(g[2], g[3]); w.z = cvt_pk_bf16(g[4], g[5]); w.w = cvt_pk_bf16(g[6], g[7]);
        *(u32x4*)(Gb + (size_t)(SROW + b) * DFF + c) = w;
        __syncthreads();
    }
}

__device__ __forceinline__ void tr_item(const float* W, int ldsrc, int scol0, int k0, const float* gain, bf16_t* dst, int ldd, int drow0, LAS float* scr, int lane) {
    float wv[32];
#pragma unroll
    for (int i = 0; i < 32; ++i) { const int kk = 2 * i + (lane >> 5); wv[i] = __builtin_nontemporal_load(W + (size_t)(k0 + kk) * ldsrc + scol0 + (lane & 31)); }
#pragma unroll
    for (int i = 0; i < 32; ++i) { const int kk = 2 * i + (lane >> 5); const float gsc = gain ? gain[k0 + kk] : 1.f; scr[kk * 33 + (lane & 31)] = wv[i] * gsc; }
    asm volatile("s_waitcnt lgkmcnt(0)" ::: "memory");
    const int c = lane & 7;
#pragma unroll
    for (int j = 0; j < 4; ++j) { const int n = (lane >> 3) + 8 * j; const LAS float* s = scr + (8 * c) * 33 + n;
        u32x4 o; o.x = cvt_pk_bf16(s[0 * 33], s[1 * 33]); o.y = cvt_pk_bf16(s[2 * 33], s[3 * 33]); o.z = cvt_pk_bf16(s[4 * 33], s[5 * 33]); o.w = cvt_pk_bf16(s[6 * 33], s[7 * 33]);
        *(u32x4*)(dst + (size_t)(drow0 + n) * ldd + k0 + 8 * c) = o; }
    asm volatile("s_waitcnt lgkmcnt(0)" ::: "memory");
}
__device__ __forceinline__ void weff_item(const float* Win, const float* wal, int n0, int k0, const float* gain, bf16_t* dst, int drow0, LAS float* scr, int lane) {
#pragma unroll 2
    for (int i = 0; i < 32; ++i) { const int kk = 2 * i + (lane >> 5); const int k = k0 + kk; float s = 0.f;
#pragma unroll
        for (int r = 0; r < 16; ++r) s += Win[(size_t)k * 2320 + 1024 + r] * wal[r * 256 + n0 + (lane & 31)];
        scr[kk * 33 + (lane & 31)] = s * gain[k]; }
    asm volatile("s_waitcnt lgkmcnt(0)" ::: "memory");
    const int c = lane & 7;
#pragma unroll
    for (int j = 0; j < 4; ++j) { const int n = (lane >> 3) + 8 * j; const LAS float* s = scr + (8 * c) * 33 + n;
        u32x4 o; o.x = cvt_pk_bf16(s[0 * 33], s[1 * 33]); o.y = cvt_pk_bf16(s[2 * 33], s[3 * 33]); o.z = cvt_pk_bf16(s[4 * 33], s[5 * 33]); o.w = cvt_pk_bf16(s[6 * 33], s[7 * 33]);
        *(u32x4*)(dst + (size_t)(drow0 + n) * 1024 + k0 + 8 * c) = o; }
    asm volatile("s_waitcnt lgkmcnt(0)" ::: "memory");
}

__device__ __forceinline__ void p0_prologue(const KArgs& a, LAS unsigned char* lds, int vcu, int G) {
    const int tid = otid(), lane = tid & 63, wave = __builtin_amdgcn_readfirstlane(tid >> 6);
    LAS float* scr = (LAS float*)(lds + wave * 16384);
    const int gw = vcu * 8 + wave, NGW = G * 8;
    unsigned char* ws = a.ws;
    constexpr int I_A = 16 * 72, I_E = 16 * 8;
    for (int it = gw; it < I_A + I_E; it += NGW) {
        int r = it;
        if (r < I_A) { const int kb = r / 72, nb = r % 72, n0 = nb * 32; tr_item(a.in[I_WIN], 2320, n0 < 1024 ? n0 : n0 + 16, kb * 64, a.in[I_MNE], (bf16_t*)(ws + WS_WIN0), 1024, n0, scr, lane); continue; } r -= I_A;
        { const int kb = r / 8, nb = r % 8; weff_item(a.in[I_WIN], a.in[I_WALPHA], nb * 32, kb * 64, a.in[I_MNE], (bf16_t*)(ws + WS_WIN0), NPROJ + nb * 32, scr, lane); }
    }
    bf16_t* xbf = (bf16_t*)(ws + WS_R1);
    float* ssq0 = (float*)(ws + WS_SSQ);
    for (int row0 = gw * 2; row0 < MT; row0 += NGW * 2) {
        f32x4 v[2][4];
#pragma unroll
        for (int rr = 0; rr < 2; ++rr) { const int row = row0 + rr;
            const float* src = row < SEQ ? a.in[I_XP] + (size_t)row * D : ((row >= SROW && row < SROW + NS) ? a.in[I_XS] + (size_t)(row - SROW) * D : nullptr);
#pragma unroll
            for (int j = 0; j < 4; ++j) { v[rr][j] = (f32x4){0.f, 0.f, 0.f, 0.f}; if (src) v[rr][j] = __builtin_nontemporal_load((const f32x4*)(src + j * 256 + lane * 4)); } }
#pragma unroll
        for (int rr = 0; rr < 2; ++rr) { const int row = row0 + rr; float s = 0.f;
#pragma unroll
            for (int j = 0; j < 4; ++j) { const f32x4 x = v[rr][j]; s += (x[0] * x[0] + x[1] * x[1]) + (x[2] * x[2] + x[3] * x[3]);
                u32x2 w; w.x = cvt_pk_bf16(x[0], x[1]); w.y = cvt_pk_bf16(x[2], x[3]);
                *(u32x2*)(xbf + (size_t)row * D + j * 256 + lane * 4) = w; }
            s = wave_sum(s);
            if (lane == 0) ssq0[row] = s; }
    }
    if (vcu == 0) { for (int i = tid; i < 256; i += NTHREADS) ((u32x4*)(ws + WS_R2))[i] = (u32x4){0u, 0u, 0u, 0u}; }
    if (vcu == 1 && tid < 6 * 32) { float* pt = (float*)(ws + WS_SSQ + 262144 + (size_t)(tid >> 5) * PART_STRIDE); pt[tid & 31] = 0.f; }
}
__device__ __forceinline__ void p3_convert(const KArgs& a, LAS unsigned char* lds, int vcu, int G) {
    const int tid = otid(), lane = tid & 63, wave = __builtin_amdgcn_readfirstlane(tid >> 6);
    if (wave < 2) return;
    LAS float* scr = (LAS float*)(lds + wave * 16384);
    const int gw = vcu * 6 + (wave - 2), NGW = G * 6;
    unsigned char* ws = a.ws;
    constexpr int I_O = 16 * 32, I_FI = 16 * 176, I_FO = 44 * 32, I_G = 16 * 32, I_P = 4 * 32, I_PL = 4 * 32;
    constexpr int NITEMS = I_O + 2 * I_FI + 2 * I_FO + 2 * I_G + 2 * I_P + I_PL;
    for (int it = gw; it < NITEMS; it += NGW) {
        int r = it;
        if (r < I_O) { const int kb = r / 32, nb = r % 32; tr_item(a.in[I_WOUT], 1024, nb * 32, kb * 64, nullptr, (bf16_t*)(ws + WS_WOUT0), 1024, nb * 32, scr, lane); continue; } r -= I_O;
        if (r < 2 * I_FI) { const int l = r / I_FI, q = r % I_FI, kb = q / 176, nb = q % 176, n0 = nb * 32;
            const int pn = n0 >> 8, rr = n0 & 255, bj = rr >> 7, ii = rr & 127;
            tr_item(a.in[I_FWIN] + (size_t)l * 1024 * 5632, 5632, bj * DFF + pn * 128 + ii, kb * 64, a.in[I_FNORM] + l * 1024, (bf16_t*)(ws + WS_WFFI + l * WFFI_BYTES), 1024, n0, scr, lane); continue; } r -= 2 * I_FI;
        if (r < 2 * I_FO) { const int l = r / I_FO, q = r % I_FO, kb = q / 32, nb = q % 32;
            tr_item(a.in[I_FWOUT] + (size_t)l * DFF * 1024, 1024, nb * 32, kb * 64, nullptr, (bf16_t*)(ws + WS_WFFO + l * WFFO_BYTES), DFF, nb * 32, scr, lane); continue; } r -= 2 * I_FO;
        if (r < 2 * I_G) { const int l = r / I_G, q = r % I_G, kb = q / 32, nb = q % 32;
            tr_item(a.in[I_PWGATE] + (size_t)l * 1024 * 1024, 1024, nb * 32, kb * 64, a.in[I_PNORM] + l * 1024, (bf16_t*)(ws + WS_WGATE + l * WGATE_BYTES), 1024, nb * 32, scr, lane); continue; } r -= 2 * I_G;
        if (r < 2 * I_P) { const int l = r / I_P, q = r % I_P, kb = q / 32, nb = q % 32;
            tr_item(a.in[I_PWPROJ] + (size_t)l * 256 * 1024, 1024, nb * 32, kb * 64, nullptr, (bf16_t*)(ws + WS_WPROJ + l * WPROJ_BYTES), 256, nb * 32, scr, lane); continue; } r -= 2 * I_P;
        { const int gq = r / 32, q = r % 32, kb = q / 8, nb = q % 8;
            tr_item(a.in[I_POOLW] + (size_t)gq * 65536, 256, nb * 32, kb * 64, nullptr, (bf16_t*)(ws + WS_WPOOL), 256, gq * 256 + nb * 32, scr, lane); }
    }
    bf16_t* pbf = (bf16_t*)(ws + WS_PBF);
    for (int it0 = gw * 4; it0 < 2 * MT; it0 += NGW * 4) {
        f32x4 v[4];
#pragma unroll
        for (int rr = 0; rr < 4; ++rr) { const int it = it0 + rr; const int l = it / MT, row = it % MT;
            const float* src = row < SEQ ? a.in[I_PP] + ((size_t)l * SEQ + row) * PLE : ((row >= SROW && row < SROW + NS) ? a.in[I_PS] + ((size_t)l * NS + (row - SROW)) * PLE : nullptr);
            v[rr] = (f32x4){0.f, 0.f, 0.f, 0.f}; if (src) v[rr] = __builtin_nontemporal_load((const f32x4*)(src + lane * 4)); }
#pragma unroll
        for (int rr = 0; rr < 4; ++rr) { u32x2 w; w.x = cvt_pk_bf16(v[rr][0], v[rr][1]); w.y = cvt_pk_bf16(v[rr][2], v[rr][3]);
            *(u32x2*)(pbf + (size_t)(it0 + rr) * PLE + lane * 4) = w; }
    }
}

__device__ __forceinline__ int crow(int i, int hh) { return (i & 3) + 8 * (i >> 2) + 4 * hh; }
template <bool OUT>
__device__ __forceinline__ void gla_item_m(const KArgs& a, LAS unsigned char* lds, int item) {
    const int tid = otid(), lane = tid & 63, wave = __builtin_amdgcn_readfirstlane(tid >> 6);
    const int sc = item >> 2, h = item & 3;
    const bf16_t* proj = (const bf16_t*)(a.ws + WS_BIG); const float* la = (const float*)(a.ws + WS_BIG + BIG_LA);
    bf16_t* mix = (bf16_t*)(a.ws + WS_R1);
    float* US = (float*)(a.ws + WS_R2 + 4096); float* DS = US + (size_t)64 * 4 * 64 * 128;
    LAS float* bL = (LAS float*)lds; LAS float* segS = (LAS float*)(lds + 16384);
    LAS bf16_t* Qn = (LAS bf16_t*)(lds + 18432); LAS bf16_t* Kn = (LAS bf16_t*)(lds + 27648); LAS bf16_t* KT = (LAS bf16_t*)(lds + 36864);
    LAS bf16_t* VT = (LAS bf16_t*)(lds + 46080); LAS bf16_t* ST = (LAS bf16_t*)(lds + 64512); LAS float* red = (LAS float*)(lds + 82944);
    const int r = lane & 31, hh = lane >> 5;
    const int dkt = wave & 1, dvt = wave >> 1, it = wave & 1;
    f32x16 S = {};
    float* usp = US + ((size_t)(sc * 4 + h) * 64 + 32 * dkt) * 128 + 32 * dvt + r;
    if (OUT) {
#pragma unroll
        for (int i = 0; i < 16; ++i) S[i] = usp[(size_t)crow(i, hh) * 128];
    }
    float bsum = 0.f;
#pragma unroll 1
    for (int c = 0; c < 4; ++c) {
        const int T0 = sc * 256 + c * 64;
        if (OUT) {
#pragma unroll
            for (int q = 0; q < 4; ++q) { u32x2 w; w.x = cvt_pk_bf16(S[4 * q], S[4 * q + 1]); w.y = cvt_pk_bf16(S[4 * q + 2], S[4 * q + 3]);
                *(LAS u32x2*)(ST + (32 * dvt + r) * 72 + 32 * dkt + 8 * q + 4 * hh) = w; }
        }
        {
            const int dk = tid & 63, seg = tid >> 6;
            float v[8];
#pragma unroll
            for (int i = 0; i < 8; ++i) v[i] = la[(size_t)(T0 + 8 * seg + i) * 256 + h * 64 + dk];
#pragma unroll
            for (int i = 1; i < 8; ++i) v[i] += v[i - 1];
            segS[seg * 64 + dk] = v[7];
            __syncthreads();
            float off = 0.f;
#pragma unroll
            for (int s = 0; s < 8; ++s) { const float x = segS[s * 64 + dk]; off += (s < seg) ? x : 0.f; }
#pragma unroll
            for (int i = 0; i < 8; ++i) bL[(8 * seg + i) * 64 + dk] = v[i] + off;
            __syncthreads();
        }
        {
            const int t = tid >> 3, d8 = (tid & 7) * 8;
            const f32x4 b0 = *(const LAS f32x4*)(bL + t * 64 + d8), b1 = *(const LAS f32x4*)(bL + t * 64 + d8 + 4);
            const f32x4 l0 = *(const LAS f32x4*)(bL + 63 * 64 + d8), l1 = *(const LAS f32x4*)(bL + 63 * 64 + d8 + 4);
            float bb[8] = {b0[0], b0[1], b0[2], b0[3], b1[0], b1[1], b1[2], b1[3]}, bl[8] = {l0[0], l0[1], l0[2], l0[3], l1[0], l1[1], l1[2], l1[3]};
            const size_t prow = (size_t)(T0 + t) * NPROJ;
            float kf[8]; { const u32x4 kw = *(const u32x4*)(proj + prow + PKA + h * 64 + d8); unpack8(kw, kf); }
#pragma unroll
            for (int j = 0; j < 8; ++j) KT[(d8 + j) * 72 + t] = (bf16_t)(cvt_pk_bf16(kf[j] * __expf(bl[j] - bb[j]), 0.f) & 0xffffu);
            if (OUT) {
                float qf[8]; { const u32x4 qw = *(const u32x4*)(proj + prow + PQA + h * 64 + d8); unpack8(qw, qf); }
                float qq[8], kk[8];
#pragma unroll
                for (int j = 0; j < 8; ++j) { const float e = __expf(bb[j]); qq[j] = qf[j] * 0.125f * e; kk[j] = kf[j] * __expf(-bb[j]); }
                u32x4 w; w.x = cvt_pk_bf16(qq[0], qq[1]); w.y = cvt_pk_bf16(qq[2], qq[3]); w.z = cvt_pk_bf16(qq[4], qq[5]); w.w = cvt_pk_bf16(qq[6], qq[7]);
                *(LAS u32x4*)(Qn + t * 72 + d8) = w;
                w.x = cvt_pk_bf16(kk[0], kk[1]); w.y = cvt_pk_bf16(kk[2], kk[3]); w.z = cvt_pk_bf16(kk[4], kk[5]); w.w = cvt_pk_bf16(kk[6], kk[7]);
                *(LAS u32x4*)(Kn + t * 72 + d8) = w;
            }
#pragma unroll
            for (int i = 0; i < 2; ++i) { const int dv8 = d8 + 64 * i;
                const u32x4 vw = *(const u32x4*)(proj + prow + PVA + h * 128 + dv8);
                LAS bf16_t* vt = VT + dv8 * 72 + t;
                vt[0 * 72] = (bf16_t)(vw.x & 0xffffu); vt[1 * 72] = (bf16_t)(vw.x >> 16); vt[2 * 72] = (bf16_t)(vw.y & 0xffffu); vt[3 * 72] = (bf16_t)(vw.y >> 16);
                vt[4 * 72] = (bf16_t)(vw.z & 0xffffu); vt[5 * 72] = (bf16_t)(vw.z >> 16); vt[6 * 72] = (bf16_t)(vw.w & 0xffffu); vt[7 * 72] = (bf16_t)(vw.w >> 16); }
            if (tid < 64) bsum += bL[63 * 64 + tid];
        }
        __syncthreads();
        if (OUT) {
            bf16x8 qf[4];
#pragma unroll
            for (int s = 0; s < 4; ++s) qf[s] = *(const LAS bf16x8*)(Qn + (32 * it + r) * 72 + 16 * s + 8 * hh);
            f32x16 oacc = {};
#pragma unroll
            for (int jt = 0; jt < 2; ++jt) {
                if (jt <= it) {
                    f32x16 at = {};
#pragma unroll
                    for (int s = 0; s < 4; ++s) { const bf16x8 af = *(const LAS bf16x8*)(Kn + (32 * jt + r) * 72 + 16 * s + 8 * hh); at = __builtin_amdgcn_mfma_f32_32x32x16_bf16(af, qf[s], at, 0, 0, 0); }
                    if (jt == it) {
#pragma unroll
                        for (int i = 0; i < 16; ++i) if (crow(i, hh) > r) at[i] = 0.f;
                    }
#pragma unroll
                    for (int s2 = 0; s2 < 2; ++s2) {
                        u32x4 pw; pw.x = cvt_pk_bf16(at[8 * s2 + 0], at[8 * s2 + 1]); pw.y = cvt_pk_bf16(at[8 * s2 + 2], at[8 * s2 + 3]);
                        pw.z = cvt_pk_bf16(at[8 * s2 + 4], at[8 * s2 + 5]); pw.w = cvt_pk_bf16(at[8 * s2 + 6], at[8 * s2 + 7]);
                        const LAS bf16_t* vp = VT + (32 * dvt + r) * 72 + 32 * jt + 16 * s2 + 4 * hh;
                        const u32x2 v0 = *(const LAS u32x2*)vp, v1 = *(const LAS u32x2*)(vp + 8);
                        const u32x4 vv = (u32x4){v0.x, v0.y, v1.x, v1.y};
                        oacc = __builtin_amdgcn_mfma_f32_32x32x16_bf16(__builtin_bit_cast(bf16x8, vv), __builtin_bit_cast(bf16x8, pw), oacc, 0, 0, 0);
                    }
                }
            }
#pragma unroll
            for (int s = 0; s < 4; ++s) { const bf16x8 af = *(const LAS bf16x8*)(ST + (32 * dvt + r) * 72 + 16 * s + 8 * hh); oacc = __builtin_amdgcn_mfma_f32_32x32x16_bf16(af, qf[s], oacc, 0, 0, 0); }
            float ss = 0.f;
#pragma unroll
            for (int i = 0; i < 16; ++i) ss += oacc[i] * oacc[i];
            ss += __shfl_xor(ss, 32);
            if (hh == 0) red[wave * 32 + r] = ss;
            __syncthreads();
            const float tot = (red[it * 32 + r] + red[(it + 2) * 32 + r]) + (red[(it + 4) * 32 + r] + red[(it + 6) * 32 + r]);
            const float rstd = rsqrtf(tot * (1.0f / 128.f) + EPS);
            const int t = T0 + 32 * it + r;
#pragma unroll
            for (int q = 0; q < 4; ++q) {
                const int dv0 = 32 * dvt + 8 * q + 4 * hh;
                const u32x2 rw = *(const u32x2*)(proj + (size_t)t * NPROJ + PRA + h * 128 + dv0);
                const f32x4 on = *(const f32x4*)(a.in[I_ONORM] + dv0);
                const float r0 = bf_lo(rw.x), r1 = bf_hi(rw.x), r2 = bf_lo(rw.y), r3 = bf_hi(rw.y);
                const float y0 = oacc[4 * q] * rstd * on[0] * (r0 / (1.f + __expf(-r0))), y1 = oacc[4 * q + 1] * rstd * on[1] * (r1 / (1.f + __expf(-r1)));
                const float y2 = oacc[4 * q + 2] * rstd * on[2] * (r2 / (1.f + __expf(-r2))), y3 = oacc[4 * q + 3] * rstd * on[3] * (r3 / (1.f + __expf(-r3)));
                u32x2 w; w.x = cvt_pk_bf16(y0, y1); w.y = cvt_pk_bf16(y2, y3);
                *(u32x2*)(mix + (size_t)t * D + h * 128 + dv0) = w;
            }
        }
#pragma unroll
        for (int i = 0; i < 16; ++i) S[i] *= __expf(bL[63 * 64 + 32 * dkt + crow(i, hh)]);
#pragma unroll
        for (int s = 0; s < 4; ++s) {
            const bf16x8 af = *(const LAS bf16x8*)(KT + (32 * dkt + r) * 72 + 16 * s + 8 * hh), bf = *(const LAS bf16x8*)(VT + (32 * dvt + r) * 72 + 16 * s + 8 * hh);
            S = __builtin_amdgcn_mfma_f32_32x32x16_bf16(af, bf, S, 0, 0, 0);
        }
        __syncthreads();
    }
    if (!OUT) {
#pragma unroll
        for (int i = 0; i < 16; ++i) usp[(size_t)crow(i, hh) * 128] = S[i];
        if (tid < 64) DS[(sc * 4 + h) * 64 + tid] = __expf(bsum);
    }
}
__device__ __forceinline__ void gla_scan_m(const KArgs& a, int vcu) {
    const int tid = otid(); if (tid >= 128) return;
    const int e = vcu * 128 + tid; if (e >= 32768) return;
    float* US = (float*)(a.ws + WS_R2 + 4096); const float* DS = US + (size_t)64 * 4 * 64 * 128;
    const int hd = e >> 7;
    float S = 0.f;
    for (int c0 = 0; c0 < 64; c0 += 8) {
        float u[8], d[8];
#pragma unroll
        for (int j = 0; j < 8; ++j) { u[j] = US[(size_t)(c0 + j) * 32768 + e]; d[j] = DS[(c0 + j) * 256 + hd]; }
#pragma unroll
        for (int j = 0; j < 8; ++j) { US[(size_t)(c0 + j) * 32768 + e] = S; S = d[j] * S + u[j]; }
    }
    a.out[O_GLAP + e] = S;
}
__device__ __forceinline__ void gla_decode_item(const KArgs& a, int item, int lane) {
    const int b = item >> 2, h = item & 3; const int row = SROW + b;
    const bf16_t* proj = (const bf16_t*)(a.ws + WS_BIG); const float* la = (const float*)(a.ws + WS_BIG + BIG_LA);
    bf16_t* mix = (bf16_t*)(a.ws + WS_R1);
    const float* S0 = a.in[I_SGLA] + ((size_t)b * 4 + h) * 8192;
    float* S1 = a.out + O_GLAS + ((size_t)b * 4 + h) * 8192;
    const float qv = bf2f(proj[(size_t)row * NPROJ + PQA + h * 64 + lane]) * 0.125f;
    const float kv = bf2f(proj[(size_t)row * NPROJ + PKA + h * 64 + lane]);
    const float av = __expf(la[(size_t)row * 256 + h * 64 + lane]);
    const unsigned vw = *(const unsigned*)(proj + (size_t)row * NPROJ + PVA + h * 128 + lane * 2);
    const float v0 = bf_lo(vw), v1 = bf_hi(vw);
    float o0 = 0.f, o1 = 0.f;
#pragma unroll 1
    for (int d0 = 0; d0 < 64; d0 += 16) {
        f32x2 sv[16];
#pragma unroll
        for (int j = 0; j < 16; ++j) sv[j] = __builtin_nontemporal_load((const f32x2*)(S0 + (d0 + j) * 128 + lane * 2));
#pragma unroll
        for (int j = 0; j < 16; ++j) {
            const int dk = d0 + j;
            const float q = __shfl(qv, dk), k = __shfl(kv, dk), al = __shfl(av, dk);
            const float n0 = al * sv[j].x + k * v0, n1 = al * sv[j].y + k * v1;
            __builtin_nontemporal_store((f32x2){n0, n1}, (f32x2*)(S1 + dk * 128 + lane * 2));
            o0 += q * n0; o1 += q * n1;
        }
    }
    const float ss = wave_sum(o0 * o0 + o1 * o1);
    const float rstd = rsqrtf(ss * (1.0f / 128.f) + EPS);
    const unsigned rw = *(const unsigned*)(proj + (size_t)row * NPROJ + PRA + h * 128 + lane * 2);
    const float r0 = bf_lo(rw), r1 = bf_hi(rw);
    const float y0 = o0 * rstd * a.in[I_ONORM][lane * 2] * (r0 / (1.f + __expf(-r0))), y1 = o1 * rstd * a.in[I_ONORM][lane * 2 + 1] * (r1 / (1.f + __expf(-r1)));
    *(unsigned*)(mix + (size_t)row * D + h * 128 + lane * 2) = cvt_pk_bf16(y0, y1);
}

__device__ __forceinline__ void swa_unit_m(const KArgs& a, LAS unsigned char* lds, int unit) {
    const int tid = otid(), lane = tid & 63, wave = __builtin_amdgcn_readfirstlane(tid >> 6);
    const int qb = unit >> 1, kvh = unit & 1; const int q0 = qb * 64, w0 = q0 - 128;
    const bf16_t* proj = (const bf16_t*)(a.ws + WS_BIG);
    bf16_t* mix = (bf16_t*)(a.ws + WS_R1);
    LAS bf16_t* Kl = (LAS bf16_t*)lds;
    LAS bf16_t* Vt = Kl + 192 * 72;
    const float* kn = a.in[I_KNORM];
#pragma unroll 1
    for (int c = tid; c < 1536; c += NTHREADS) {
        const int kk = c >> 3, part = c & 7; const int tk = w0 + kk;
        float kf[8];
        u32x4 vw = (u32x4){0u, 0u, 0u, 0u};
#pragma unroll
        for (int j = 0; j < 8; ++j) kf[j] = 0.f;
        if (tk >= 0) {
            const u32x4 kw = *(const u32x4*)(proj + (size_t)tk * NPROJ + PKB + kvh * 64 + part * 8); unpack8(kw, kf);
            vw = *(const u32x4*)(proj + (size_t)tk * NPROJ + PVB + kvh * 64 + part * 8);
        }
        float ss = 0.f;
#pragma unroll
        for (int j = 0; j < 8; ++j) ss += kf[j] * kf[j];
        ss += __shfl_xor(ss, 1); ss += __shfl_xor(ss, 2); ss += __shfl_xor(ss, 4);
        const float rstd = rsqrtf(ss * (1.0f / 64.f) + EPS);
#pragma unroll
        for (int j = 0; j < 8; ++j) kf[j] = kf[j] * rstd * kn[part * 8 + j];
        u32x4 kw2; kw2.x = cvt_pk_bf16(kf[0], kf[1]); kw2.y = cvt_pk_bf16(kf[2], kf[3]); kw2.z = cvt_pk_bf16(kf[4], kf[5]); kw2.w = cvt_pk_bf16(kf[6], kf[7]);
        *(LAS u32x4*)(Kl + kk * 72 + part * 8) = kw2;
        LAS bf16_t* vt = Vt + (part * 8) * 196 + kk;
        vt[0 * 196] = (bf16_t)(vw.x & 0xffffu); vt[1 * 196] = (bf16_t)(vw.x >> 16); vt[2 * 196] = (bf16_t)(vw.y & 0xffffu); vt[3 * 196] = (bf16_t)(vw.y >> 16);
        vt[4 * 196] = (bf16_t)(vw.z & 0xffffu); vt[5 * 196] = (bf16_t)(vw.z >> 16); vt[6 * 196] = (bf16_t)(vw.w & 0xffffu); vt[7 * 196] = (bf16_t)(vw.w >> 16);
        if (qb == 255 && kk >= 64) {
            const int w = kk - 64;
            float vf[8]; unpack8(vw, vf);
            float* ko = a.out + O_SKP + ((size_t)w * 2 + kvh) * 64 + part * 8; float* vo = a.out + O_SVP + ((size_t)w * 2 + kvh) * 64 + part * 8;
            *(f32x4*)ko = (f32x4){kf[0], kf[1], kf[2], kf[3]}; *(f32x4*)(ko + 4) = (f32x4){kf[4], kf[5], kf[6], kf[7]};
            *(f32x4*)vo = (f32x4){vf[0], vf[1], vf[2], vf[3]}; *(f32x4*)(vo + 4) = (f32x4){vf[4], vf[5], vf[6], vf[7]};
        }
    }
    __syncthreads();
    const int g = wave & 3, th = wave >> 2, hq = kvh * 4 + g;
    const int r = lane & 31, hh = lane >> 5;
    const int t = q0 + 32 * th + r;
    constexpr float LOG2E = 1.4426950408889634f;
    bf16x8 qf[4];
    {
        float qv[4][8]; float ss = 0.f;
#pragma unroll
        for (int s = 0; s < 4; ++s) { const u32x4 w = *(const u32x4*)(proj + (size_t)t * NPROJ + PQB + hq * 64 + 16 * s + 8 * hh); unpack8(w, qv[s]);
#pragma unroll
            for (int j = 0; j < 8; ++j) ss += qv[s][j] * qv[s][j]; }
        ss += __shfl_xor(ss, 32);
        const float rstd = rsqrtf(ss * (1.0f / 64.f) + EPS) * (0.125f * LOG2E);
        const float* qn = a.in[I_QNORM];
#pragma unroll
        for (int s = 0; s < 4; ++s) {
            u32x4 w;
            w.x = cvt_pk_bf16(qv[s][0] * rstd * qn[16 * s + 8 * hh + 0], qv[s][1] * rstd * qn[16 * s + 8 * hh + 1]);
            w.y = cvt_pk_bf16(qv[s][2] * rstd * qn[16 * s + 8 * hh + 2], qv[s][3] * rstd * qn[16 * s + 8 * hh + 3]);
            w.z = cvt_pk_bf16(qv[s][4] * rstd * qn[16 * s + 8 * hh + 4], qv[s][5] * rstd * qn[16 * s + 8 * hh + 5]);
            w.w = cvt_pk_bf16(qv[s][6] * rstd * qn[16 * s + 8 * hh + 6], qv[s][7] * rstd * qn[16 * s + 8 * hh + 7]);
            qf[s] = __builtin_bit_cast(bf16x8, w);
        }
    }
    f32x16 sacc[5];
#pragma unroll
    for (int k5 = 0; k5 < 5; ++k5) {
        const int kt = th + k5;
        f32x16 acc = {};
#pragma unroll
        for (int s = 0; s < 4; ++s) { const bf16x8 af = *(const LAS bf16x8*)(Kl + (kt * 32 + r) * 72 + 16 * s + 8 * hh); acc = __builtin_amdgcn_mfma_f32_32x32x16_bf16(af, qf[s], acc, 0, 0, 0); }
        sacc[k5] = acc;
    }
    const float slope2 = exp2f(-(float)(hq + 1)) * LOG2E;
    const float sink2 = a.in[I_SINKS][hq] * LOG2E;
    float mx = sink2;
#pragma unroll
    for (int k5 = 0; k5 < 5; ++k5)
#pragma unroll
        for (int i = 0; i < 16; ++i) {
            const int row = (i & 3) + 8 * (i >> 2) + 4 * hh;
            const int dist = 128 - 32 * k5 + r - row;
            const int tk = w0 + 32 * (th + k5) + row;
            float s = sacc[k5][i] - slope2 * (float)dist;
            if (dist < 0 || dist >= 128 || tk < 0) s = -1e30f;
            sacc[k5][i] = s; mx = fmaxf(mx, s);
        }
    mx = fmaxf(mx, __shfl_xor(mx, 32));
    float l = 0.f;
#pragma unroll
    for (int k5 = 0; k5 < 5; ++k5)
#pragma unroll
        for (int i = 0; i < 16; ++i) { const float p = exp2f(sacc[k5][i] - mx); sacc[k5][i] = p; l += p; }
    l += __shfl_xor(l, 32);
    l += exp2f(sink2 - mx);
    f32x16 oacc[2] = {{}, {}};
#pragma unroll
    for (int k5 = 0; k5 < 5; ++k5) {
        const int kt = th + k5;
#pragma unroll
        for (int s2 = 0; s2 < 2; ++s2) {
            u32x4 pw;
            pw.x = cvt_pk_bf16(sacc[k5][8 * s2 + 0], sacc[k5][8 * s2 + 1]); pw.y = cvt_pk_bf16(sacc[k5][8 * s2 + 2], sacc[k5][8 * s2 + 3]);
            pw.z = cvt_pk_bf16(sacc[k5][8 * s2 + 4], sacc[k5][8 * s2 + 5]); pw.w = cvt_pk_bf16(sacc[k5][8 * s2 + 6], sacc[k5][8 * s2 + 7]);
            const bf16x8 pf = __builtin_bit_cast(bf16x8, pw);
#pragma unroll
            for (int dt = 0; dt < 2; ++dt) {
                const LAS bf16_t* vp = Vt + (32 * dt + r) * 196 + kt * 32 + 16 * s2 + 4 * hh;
                const u32x2 v0 = *(const LAS u32x2*)vp, v1 = *(const LAS u32x2*)(vp + 8);
                const u32x4 vv = (u32x4){v0.x, v0.y, v1.x, v1.y};
                oacc[dt] = __builtin_amdgcn_mfma_f32_32x32x16_bf16(__builtin_bit_cast(bf16x8, vv), pf, oacc[dt], 0, 0, 0);
            }
        }
    }
    const float inv = 1.f / l;
#pragma unroll
    for (int dt = 0; dt < 2; ++dt)
#pragma unroll
        for (int q = 0; q < 4; ++q) {
            u32x2 w; w.x = cvt_pk_bf16(oacc[dt][4 * q] * inv, oacc[dt][4 * q + 1] * inv); w.y = cvt_pk_bf16(oacc[dt][4 * q + 2] * inv, oacc[dt][4 * q + 3] * inv);
            *(u32x2*)(mix + (size_t)t * D + 512 + hq * 64 + 32 * dt + 8 * q + 4 * hh) = w;
        }
    __syncthreads();
}
__device__ __forceinline__ void swa_decode_item(const KArgs& a, int item, int lane) {
    const int b = item >> 3, kvh = (item >> 2) & 1, g = item & 3, hq = kvh * 4 + g; const int row = SROW + b;
    const bf16_t* proj = (const bf16_t*)(a.ws + WS_BIG);
    bf16_t* mix = (bf16_t*)(a.ws + WS_R1);
    const float* ck = a.in[I_CK] + (size_t)b * 128 * 128 + kvh * 64;
    const float* cv = a.in[I_CV] + (size_t)b * 128 * 128 + kvh * 64;
    float qd = bf2f(proj[(size_t)row * NPROJ + PQB + hq * 64 + lane]);
    { const float ss = wave_sum(qd * qd); qd = qd * rsqrtf(ss * (1.0f / 64.f) + EPS) * a.in[I_QNORM][lane] * 0.125f; }
    float kd = bf2f(proj[(size_t)row * NPROJ + PKB + kvh * 64 + lane]);
    { const float ss = wave_sum(kd * kd); kd = kd * rsqrtf(ss * (1.0f / 64.f) + EPS) * a.in[I_KNORM][lane]; }
    const float vd = bf2f(proj[(size_t)row * NPROJ + PVB + kvh * 64 + lane]);
    const float slope = exp2f(-(float)(hq + 1));
    float s0 = 0.f, s1 = 0.f;
    for (int d = 0; d < 64; d += 4) {
        const f32x4 k0 = *(const f32x4*)(ck + (size_t)lane * 128 + d), k1 = *(const f32x4*)(ck + (size_t)(lane + 64) * 128 + d);
        const float q0 = __shfl(qd, d), q1 = __shfl(qd, d + 1), q2 = __shfl(qd, d + 2), q3 = __shfl(qd, d + 3);
        s0 += (q0 * k0[0] + q1 * k0[1]) + (q2 * k0[2] + q3 * k0[3]);
        s1 += (q0 * k1[0] + q1 * k1[1]) + (q2 * k1[2] + q3 * k1[3]);
    }
    s0 -= slope * (float)(128 - lane); s1 -= slope * (float)(64 - lane);
    if (lane == 0) s0 = -1e30f;
    const float sn = wave_sum(qd * kd);
    const float sink = a.in[I_SINKS][hq];
    const float mx = fmaxf(fmaxf(wave_max(fmaxf(s0, s1)), sn), sink);
    const float p0 = __expf(s0 - mx), p1 = __expf(s1 - mx), pn = __expf(sn - mx);
    const float l = wave_sum(p0 + p1) + pn + __expf(sink - mx);
    float od = pn * vd;
#pragma unroll 1
    for (int w0 = 0; w0 < 64; w0 += 16) {
        float ca[16], cb[16];
#pragma unroll
        for (int j = 0; j < 16; ++j) { ca[j] = cv[(size_t)(w0 + j) * 128 + lane]; cb[j] = cv[(size_t)(w0 + j + 64) * 128 + lane]; }
#pragma unroll
        for (int j = 0; j < 16; ++j) { const float pa = __shfl(p0, w0 + j), pb = __shfl(p1, w0 + j); od += pa * ca[j] + pb * cb[j]; }
    }
    od /= l;
    const float oo = __shfl_down(od, 1);
    if ((lane & 1) == 0) *(unsigned*)(mix + (size_t)row * D + 512 + hq * 64 + lane) = cvt_pk_bf16(od, oo);
    if (g == 0) {
        float* __restrict__ ko = a.out + O_SKS + (size_t)b * 128 * 128 + kvh * 64; float* __restrict__ vo = a.out + O_SVS + (size_t)b * 128 * 128 + kvh * 64;
#pragma unroll 1
        for (int w0 = 0; w0 < 128; w0 += 16) {
            float ka[16], va[16];
#pragma unroll
            for (int j = 0; j < 16; ++j) { const int w = w0 + j + 1; ka[j] = (w < 128) ? ck[(size_t)w * 128 + lane] : kd; va[j] = (w < 128) ? cv[(size_t)w * 128 + lane] : vd; }
#pragma unroll
            for (int j = 0; j < 16; ++j) { ko[(size_t)(w0 + j) * 128 + lane] = ka[j]; vo[(size_t)(w0 + j) * 128 + lane] = va[j]; }
        }
    }
}

template <int W>
__device__ __forceinline__ void pool_core(const float* __restrict__ h, const LAS float* rsL, float gg, int r0, int c, bf16_t* __restrict__ d1, float* __restrict__ poolp) {
    float xn[31];
#pragma unroll
    for (int i = 0; i < 31; ++i) { const int r = r0 - 15 + i; xn[i] = (i >= 16 - W && r >= 0) ? h[(size_t)r * D + c] : 0.f; }
#pragma unroll
    for (int i = 0; i < 31; ++i) xn[i] *= rsL[i] * gg;
    float s = 0.f;
#pragma unroll
    for (int j = 1; j < W; ++j) s += xn[15 - j];
#pragma unroll
    for (int i = 0; i < 16; ++i) {
        const int r = r0 + i;
        s += xn[15 + i];
        const int cnt = (r + 1 < W) ? r + 1 : W;
        const float dd = s / (float)cnt - xn[15 + i];
        d1[(size_t)r * D + c] = (bf16_t)(cvt_pk_bf16(dd, 0.f) & 0xffffu);
        s -= xn[15 + i - (W - 1)];
        if (r >= SEQ - 15) poolp[(size_t)(r - (SEQ - 15)) * D + c] = xn[15 + i];
    }
}
__device__ __forceinline__ void pool_item(const KArgs& a, LAS unsigned char* lds, int item, const float* part_in) {
    const int tid = otid();
    const float* h = a.out + O_YP; bf16_t* d1 = (bf16_t*)(a.ws + WS_R1);
    LAS float* rsL = (LAS float*)lds;
    const int r0 = item * 16;
    __syncthreads();
    if (tid < 31) { const int r = r0 - 15 + tid; float rs = 0.f;
        if (r >= 0) { const f32x4 p0 = *(const f32x4*)(part_in + (long)r * 16), p1 = *(const f32x4*)(part_in + (long)r * 16 + 4), p2 = *(const f32x4*)(part_in + (long)r * 16 + 8), p3 = *(const f32x4*)(part_in + (long)r * 16 + 12);
            const float s = ((p0[0] + p0[1]) + (p0[2] + p0[3])) + ((p1[0] + p1[1]) + (p1[2] + p1[3])) + ((p2[0] + p2[1]) + (p2[2] + p2[3])) + ((p3[0] + p3[1]) + (p3[2] + p3[3]));
            rs = rsqrtf(s * (1.0f / D) + EPS); }
        rsL[tid] = rs; }
    __syncthreads();
#pragma unroll
    for (int cc = 0; cc < 2; ++cc) {
        const int c = tid + cc * NTHREADS; const int gq = __builtin_amdgcn_readfirstlane(c >> 8);
        const float gg = a.in[I_MNO][c];
        if (gq == 0) pool_core<2>(h, rsL, gg, r0, c, d1, a.out + O_POOLP);
        else if (gq == 1) pool_core<4>(h, rsL, gg, r0, c, d1, a.out + O_POOLP);
        else if (gq == 2) pool_core<8>(h, rsL, gg, r0, c, d1, a.out + O_POOLP);
        else pool_core<16>(h, rsL, gg, r0, c, d1, a.out + O_POOLP);
    }
}
__device__ __forceinline__ void pool_sample_item(const KArgs& a, LAS unsigned char* lds, int b, const float* part_in) {
    const int tid = otid();
    const float* __restrict__ h = a.out + O_YS + (size_t)b * D; bf16_t* __restrict__ d1 = (bf16_t*)(a.ws + WS_R1);
    const float* __restrict__ st = a.in[I_SPOOL] + (size_t)b * 15 * D; float* __restrict__ so = a.out + O_POOLS + (size_t)b * 15 * D;
    float s = 0.f;
#pragma unroll
    for (int i = 0; i < 16; ++i) s += part_in[(long)(SROW + b) * 16 + i];
    const float rs = rsqrtf(s * (1.0f / D) + EPS);
#pragma unroll
    for (int cc = 0; cc < 2; ++cc) {
        const int c = tid + cc * NTHREADS; const int w = 2 << (c >> 8);
        float sv[15];
#pragma unroll
        for (int j = 0; j < 15; ++j) sv[j] = st[(size_t)j * D + c];
        const float xn = h[c] * rs * a.in[I_MNO][c];
        float sum = xn;
#pragma unroll
        for (int j = 0; j < 15; ++j) sum += (j >= 16 - w) ? sv[j] : 0.f;
        const float dd = sum / (float)w - xn;
        d1[(size_t)(SROW + b) * D + c] = (bf16_t)(cvt_pk_bf16(dd, 0.f) & 0xffffu);
#pragma unroll
        for (int j = 0; j < 14; ++j) so[(size_t)j * D + c] = sv[j + 1];
        so[(size_t)14 * D + c] = xn;
    }
}

#define XB_TMO      128
#define XB_XCNT(j)  (256  + 64 * (j))
#define XB_XSUB(j)  (1280 + 64 * (j))
#define XB_XGEN(j)  (2304 + 64 * (j))
#define XB_TOP      3328
#define XB_TOPGEN   3392
#define XCD_BAR_WORDS 3456
#define XB_SPIN_CAP (1u << 18)
__device__ __forceinline__ unsigned xb_ld(unsigned* p)              { return __hip_atomic_load(p, __ATOMIC_RELAXED, __HIP_MEMORY_SCOPE_AGENT); }
__device__ __forceinline__ unsigned xb_add(unsigned* p, unsigned v) { return __hip_atomic_fetch_add(p, v, __ATOMIC_RELAXED, __HIP_MEMORY_SCOPE_AGENT); }
__device__ __forceinline__ unsigned xb_xcc_id() { return (unsigned)__builtin_amdgcn_s_getreg((3 << 11) | 20) & 0xFu; }
#define XB_SPIN(cond, bar) do { unsigned _sp = 0; while (cond) { __builtin_amdgcn_s_sleep(1); \
    if ((++_sp & 255u) == 0u) { if (xb_ld(&(bar)[XB_TMO])) break; if (_sp > XB_SPIN_CAP) { atomicAdd(&(bar)[XB_TMO], 1u); break; } } } } while (0)
struct XcdBarrier { unsigned* bar; unsigned x; volatile LAS unsigned* st; };
__device__ __forceinline__ XcdBarrier xcd_barrier_post(unsigned* bar, volatile LAS unsigned* st) {
    XcdBarrier b; b.bar = bar; b.x = xb_xcc_id(); b.st = st;
    if (threadIdx.x == 0) (void)xb_add(&bar[XB_XCNT(b.x)], 1u);
    return b;
}
__device__ __forceinline__ void xcd_barrier_complete(unsigned* bar, unsigned x, unsigned& nloc, unsigned& nx) {
    const unsigned G = gridDim.x * gridDim.y * gridDim.z;
    unsigned sum, cnt, mine, sp = 0u;
    for (;;) {
        sum = 0u; cnt = 0u; mine = 0u;
#pragma unroll
        for (unsigned j = 0; j < 16; ++j) { const unsigned c = xb_ld(&bar[XB_XCNT(j)]); sum += c; cnt += (c > 0u) ? 1u : 0u; mine = (j == x) ? c : mine; }
        if (sum == G) break;
        __builtin_amdgcn_s_sleep(1);
        if ((++sp & 255u) == 0u) { if (xb_ld(&bar[XB_TMO])) break; if (sp > XB_SPIN_CAP) { atomicAdd(&bar[XB_TMO], 1u); break; } }
    }
    nloc = mine > 0u ? mine : 1u; nx = cnt > 0u ? cnt : 1u;
}
__device__ __forceinline__ void xcd_barrier(const XcdBarrier& b) {
    asm volatile("s_waitcnt vmcnt(0)" ::: "memory");
    __syncthreads();
    if (threadIdx.x == 0) {
        unsigned* bar = b.bar;
        __builtin_amdgcn_s_waitcnt(0);
        unsigned nloc = b.st[0], nx = b.st[1];
        if (nloc == 0u) { xcd_barrier_complete(bar, b.x, nloc, nx); b.st[0] = nloc; b.st[1] = nx; }
        const unsigned old = xb_add(&bar[XB_XSUB(b.x)], 1u);
        const unsigned gen = old / nloc;
        if (old + 1u == (gen + 1u) * nloc) {
            __builtin_amdgcn_fence(__ATOMIC_RELEASE, "agent");
            asm volatile("s_waitcnt vmcnt(0)" ::: "memory");
            const unsigned og = xb_add(&bar[XB_TOP], 1u);
            const unsigned tg = og / nx;
            if (og + 1u == (tg + 1u) * nx) xb_add(&bar[XB_TOPGEN], 1u);
            else XB_SPIN(xb_ld(&bar[XB_TOPGEN]) == tg, bar);
            __builtin_amdgcn_fence(__ATOMIC_ACQUIRE, "agent");
            xb_add(&bar[XB_XGEN(b.x)], 1u);
            asm volatile("s_waitcnt vmcnt(0)" ::: "memory");
        } else {
            XB_SPIN(xb_ld(&bar[XB_XGEN(b.x)]) == gen, bar);
            __builtin_amdgcn_fence(__ATOMIC_ACQUIRE, "agent");
            asm volatile("s_waitcnt vmcnt(0)" ::: "memory");
        }
    }
    __syncthreads();
}

#ifndef DUPM
#define DUPM 0
#endif
#ifndef SYNCREP
#define SYNCREP 1
#endif
#define GSYNC() do { _Pragma("unroll 1") for (int sr_ = 0; sr_ < SYNCREP; ++sr_) xcd_barrier(xbar); } while (0)
#define PH(k) _Pragma("unroll 1") for (int rep_ = 0; rep_ < (((DUPM) >> (k)) & 1) + 1; ++rep_)
__global__ void __launch_bounds__(NTHREADS, 2) mega_fwd(KArgs a) {
    extern __shared__ __attribute__((aligned(16))) unsigned char lds_raw[];
    LAS unsigned char* lds = (LAS unsigned char*)lds_raw;
    cg::grid_group grid = cg::this_grid();
    const int G = gridDim.x, bx = blockIdx.x;
    const int vcu = (G % 8 == 0) ? (bx % 8) * (G / 8) + bx / 8 : bx;
    unsigned char* ws = a.ws;
    if (ws == nullptr) grid.sync();
    volatile LAS unsigned* xst = (volatile LAS unsigned*)(lds + LDS_BYTES - 64);
    if (threadIdx.x < 16) xst[threadIdx.x] = 0u;
    __syncthreads();
    const XcdBarrier xbar = xcd_barrier_post((unsigned*)(ws + 16384), xst);
    bf16_t* R1 = (bf16_t*)(ws + WS_R1); bf16_t* R2 = (bf16_t*)(ws + WS_R2 + 4096);
    bf16_t* BIGB = (bf16_t*)(ws + WS_BIG);
    const bf16_t* pbf = (const bf16_t*)(ws + WS_PBF);

    PH(0) p0_prologue(a, lds, vcu, G);
    GSYNC();
    PH(1) {
        pg8::Gemm g{R1, (const bf16_t*)(ws + WS_WIN0), 1024, 1024, 1024, 256, 0, 0};
        pg8::StaticOrder S; S.init(64, 10, G, bx);
        EpiProj E{BIGB, (float*)(ws + WS_BIG + BIG_LA), (const float*)(ws + WS_SSQ), a.in[I_BALPHA]};
        pg8::gemm_phase(lds, g, S, E);
        s_proj_units(a, lds, (bx - (640 % G) + G) % G, G);
    }
    GSYNC();
    PH(2) for (int it = vcu; it < 256; it += G) gla_item_m<false>(a, lds, it);
    PH(3) for (int it = vcu; it < 512; it += G) swa_unit_m(a, lds, it);
    PH(4) { const int tid = otid(), lane = tid & 63, wave = __builtin_amdgcn_readfirstlane(tid >> 6); for (int it = vcu * 8 + wave; it < 512; it += G * 8) gla_decode_item(a, it, lane); }
    PH(5) { const int tid = otid(), lane = tid & 63, wave = __builtin_amdgcn_readfirstlane(tid >> 6); for (int it = vcu * 8 + wave; it < 1024; it += G * 8) swa_decode_item(a, it, lane); }
    GSYNC();
    PH(6) { gla_scan_m(a, vcu); p3_convert(a, lds, vcu, G); }
    GSYNC();
    PH(7) for (int it = vcu; it < 256; it += G) gla_item_m<true>(a, lds, it);
    GSYNC();
    PH(8) {
        pg8::Gemm g{R1, (const bf16_t*)(ws + WS_WOUT0), 1024, 1024, 1024, 256, 0, 0};
        pg8::StaticOrder S; S.init(64, 4, G, bx);
        EpiRes<0, true, true> E{a.out, a.in[I_XP], R2, part_tab(ws, 0), nullptr, nullptr, nullptr};
        pg8::gemm_phase(lds, g, S, E);
        s_res_units<0, 1024, 1024>(a, lds, bx, G, R1, (const bf16_t*)(ws + WS_WOUT0), R2, part_tab(ws, 0));
    }
    GSYNC();
#pragma unroll 1
    for (int l = 0; l < 2; ++l) {
        bf16_t* G_ = BIGB;
        bf16_t* PPb = BIGB;
        PH(9) {
            pg8::Gemm g{R2, (const bf16_t*)(ws + WS_WFFI + l * WFFI_BYTES), 1024, 1024, 1024, 254, -2, 0};
            pg8::StaticOrder S; S.init(65, 22, G, bx);
            EpiFfn E{part_tab(ws, l == 0 ? 0 : 3), a.in[I_FCW] + (size_t)l * 3 * DFF, a.in[I_FCB] + (size_t)l * DFF, a.out + O_CONVP + (size_t)l * 2 * DFF, G_};
            pg8::gemm_phase(lds, g, S, E);
            s_ffn_units(a, lds, (bx - (1430 % G) + G) % G, G, l, R2, part_tab(ws, l == 0 ? 0 : 3));
        }
        GSYNC();
        PH(10) {
            pg8::Gemm g{G_, (const bf16_t*)(ws + WS_WFFO + l * WFFO_BYTES), DFF, DFF, DFF, 256, 0, 0};
            pg8::StaticOrder S; S.init(64, 4, G, bx);
            EpiRes<1, true, true> E{a.out, nullptr, R1, part_tab(ws, l == 0 ? 1 : 4), nullptr, nullptr, nullptr};
            pg8::gemm_phase(lds, g, S, E);
            s_res_units<1, DFF, DFF>(a, lds, bx, G, G_, (const bf16_t*)(ws + WS_WFFO + l * WFFO_BYTES), R1, part_tab(ws, l == 0 ? 1 : 4));
        }
        GSYNC();
        PH(11) {
            pg8::Gemm g{pbf + (size_t)l * MT * PLE, (const bf16_t*)(ws + WS_WPROJ + l * WPROJ_BYTES), PLE, PLE, PLE, 256, 0, 0};
            pg8::StaticOrder S; S.init(64, 4, G, bx);
            EpiPP E{PPb};
            pg8::gemm_phase(lds, g, S, E);
        }
        PH(12) {
            pg8::Gemm g{R1, (const bf16_t*)(ws + WS_WGATE + l * WGATE_BYTES), 1024, 1024, 1024, 256, 0, 0};
            pg8::StaticOrder S; S.init(64, 4, G, bx);
            if (l == 0) { EpiRes<2, false, true> E{a.out, nullptr, nullptr, part_tab(ws, 2), part_tab(ws, 1), PPb, nullptr}; pg8::gemm_phase(lds, g, S, E);
                s_ple_units<false>(a, lds, bx, G, pbf, (const bf16_t*)(ws + WS_WPROJ), R1, (const bf16_t*)(ws + WS_WGATE), part_tab(ws, 1), part_tab(ws, 2)); }
            else { EpiRes<2, false, false> E{a.out, nullptr, nullptr, nullptr, part_tab(ws, 4), PPb, nullptr}; pg8::gemm_phase(lds, g, S, E);
                s_ple_units<true>(a, lds, bx, G, pbf + (size_t)MT * PLE, (const bf16_t*)(ws + WS_WPROJ + WPROJ_BYTES), R1, (const bf16_t*)(ws + WS_WGATE + WGATE_BYTES), part_tab(ws, 4), nullptr); }
        }
        if (l == 0) {
            GSYNC();
            PH(13) for (int it = vcu; it < 1024 + NS; it += G) { if (it < 1024) pool_item(a, lds, it, part_tab(ws, 2)); else pool_sample_item(a, lds, it - 1024, part_tab(ws, 2)); }
            GSYNC();
            PH(14) {
                pg8::Gemm g{R1, (const bf16_t*)(ws + WS_WPOOL), 1024, 256, 256, 256, 0, 256};
                pg8::StaticOrder S; S.init(64, 4, G, bx);
                EpiRes<3, true, true> E{a.out, nullptr, R2, part_tab(ws, 3), nullptr, nullptr, a.in[I_POOLSC]};
                pg8::gemm_phase(lds, g, S, E);
                s_res_units<3, 256, 1024>(a, lds, bx, G, R1, (const bf16_t*)(ws + WS_WPOOL), R2, part_tab(ws, 3));
            }
            GSYNC();
        }
    }
}

extern "C" void kernel_launch(void* const* d_in, const int* in_sizes, int n_in, void* d_out, int out_size, void* d_ws, size_t ws_size, hipStream_t stream) {
    static int grid = 0;
    if (grid == 0) {
        int dev = 0, cus = 0, per_cu = 0;
        hipGetDevice(&dev);
        hipDeviceGetAttribute(&cus, hipDeviceAttributeMultiprocessorCount, dev);
        hipFuncSetAttribute((const void*)mega_fwd, hipFuncAttributeMaxDynamicSharedMemorySize, LDS_BYTES);
        hipOccupancyMaxActiveBlocksPerMultiprocessor(&per_cu, (const void*)mega_fwd, NTHREADS, LDS_BYTES);
        if (per_cu < 1) { fprintf(stderr, "kernel_launch: occupancy query reports %d blocks per CU\n", per_cu); per_cu = 1; }
        if (per_cu > 1) per_cu = 1;
        grid = cus * per_cu;
        (void)hipGetLastError();
    }
    (void)hipMemsetAsync(d_ws, 0, 65536, stream);
    KArgs a{};
    for (int i = 0; i < 29; ++i) a.in[i] = (const float*)d_in[i];
    a.out = (float*)d_out; a.ws = (unsigned char*)d_ws;
    void* args[] = {&a};
    hipError_t e = hipLaunchCooperativeKernel((const void*)mega_fwd, dim3(grid), dim3(NTHREADS), args, LDS_BYTES, stream);
    if (e != hipSuccess) fprintf(stderr, "cooperative launch failed: %s (grid %d)\n", hipGetErrorString(e), grid);
}
```

```cpp
#include <hip/hip_runtime.h>
#include <hip/hip_cooperative_groups.h>
#include <cstdio>
#include <cstdint>
namespace cg = cooperative_groups;

#define LAS __attribute__((address_space(3)))
typedef unsigned short bf16_t;
typedef short bf16x8 __attribute__((ext_vector_type(8)));
typedef float f32x4 __attribute__((ext_vector_type(4)));
typedef float f32x2 __attribute__((ext_vector_type(2)));
typedef unsigned u32x4 __attribute__((ext_vector_type(4)));
typedef unsigned u32x2 __attribute__((ext_vector_type(2)));
typedef float f32x16 __attribute__((ext_vector_type(16)));

constexpr int D = 1024, SEQ = 16384, NS = 128, DFF = 2816, PLE = 256;
constexpr int SROW = 16510;
constexpr int MT = 16640;
constexpr int MR = 16768;
constexpr int NPROJ = 2304;
constexpr int PQA = 0, PKA = 256, PVA = 512, PRA = 1024, PQB = 1536, PKB = 2048, PVB = 2176;
constexpr float EPS = 1e-6f;
constexpr int NTHREADS = 512;

constexpr size_t O_YP = 0, O_YS = 16777216, O_GLAP = 16908288, O_SKP = 16941056, O_SVP = 16957440, O_POOLP = 16973824, O_CONVP = 16989184,
                 O_GLAS = 17000448, O_SKS = 21194752, O_SVS = 23291904, O_POOLS = 25389056, O_CONVS = 27355136;

constexpr size_t MiB = 1u << 20;
constexpr size_t WS_WIN0 = 1 * MiB, WS_WOUT0 = 6 * MiB, WS_WFFI = 8 * MiB, WS_WFFO = 30 * MiB, WS_WGATE = 41 * MiB, WS_WPROJ = 45 * MiB, WS_WPOOL = 46 * MiB;
constexpr size_t WS_SSQ = 47 * MiB;
constexpr size_t WS_PBF = 55 * MiB, WS_R1 = 72 * MiB, WS_R2 = 105 * MiB, WS_BIG = 138 * MiB;
constexpr size_t PART_STRIDE = (size_t)(MR + 8) * 16 * 4;
constexpr size_t WFFI_BYTES = (size_t)5632 * 1024 * 2, WFFO_BYTES = (size_t)1024 * 2816 * 2, WGATE_BYTES = (size_t)1024 * 1024 * 2, WPROJ_BYTES = (size_t)1024 * 256 * 2;
constexpr size_t BIG_LA = (size_t)MT * NPROJ * 2;
constexpr int LDS_BYTES = 155648;

__device__ __forceinline__ unsigned cvt_pk_bf16(float lo, float hi) { unsigned r; asm volatile("v_cvt_pk_bf16_f32 %0, %1, %2" : "=v"(r) : "v"(lo), "v"(hi)); return r; }
__device__ __forceinline__ float bf_lo(unsigned w) { return __uint_as_float(w << 16); }
__device__ __forceinline__ float bf_hi(unsigned w) { return __uint_as_float(w & 0xffff0000u); }
__device__ __forceinline__ float bf2f(bf16_t v) { return __uint_as_float(((unsigned)v) << 16); }
__device__ __forceinline__ void unpack8(const u32x4 w, float* f) { f[0] = bf_lo(w.x); f[1] = bf_hi(w.x); f[2] = bf_lo(w.y); f[3] = bf_hi(w.y); f[4] = bf_lo(w.z); f[5] = bf_hi(w.z); f[6] = bf_lo(w.w); f[7] = bf_hi(w.w); }
__device__ __forceinline__ float wave_sum(float v) {
#pragma unroll
    for (int o = 1; o < 64; o <<= 1) v += __shfl_xor(v, o);
    return v;
}
__device__ __forceinline__ float wave_max(float v) {
#pragma unroll
    for (int o = 1; o < 64; o <<= 1) v = fmaxf(v, __shfl_xor(v, o));
    return v;
}
__device__ __forceinline__ int otid() { int t = threadIdx.x; asm volatile("" : "+v"(t)); return t; }
__device__ __forceinline__ bool row_valid(int row) { return row < SEQ || (row >= SROW && row < SROW + NS); }
__device__ __forceinline__ float* hrow_ptr(float* out, int row) { return row < SEQ ? out + O_YP + (size_t)row * D : out + O_YS + (size_t)(row - SROW) * D; }
__device__ __forceinline__ f32x2 gelu_pk(f32x2 v) {
    const f32x2 av = __builtin_elementwise_abs(v), d = av * 0.2316418882f + 1.0f;
    f32x2 t; t.x = __builtin_amdgcn_rcpf(d.x); t.y = __builtin_amdgcn_rcpf(d.y);
    f32x2 q = t * 0.5307027145f + (-0.7265760135f); q = q * t + 0.7107068705f; q = q * t + (-0.142248368f); q = q * t + 0.127414796f; q = q * t;
    const f32x2 s = (v * v) * (-0.72134752044f);
    f32x2 e; e.x = __builtin_amdgcn_exp2f(s.x); e.y = __builtin_amdgcn_exp2f(s.y);
    const f32x2 m = v * (q * e), r = v - m;
    f32x2 o; o.x = v.x < 0.f ? m.x : r.x; o.y = v.y < 0.f ? m.y : r.y; return o;
}

namespace pg8 {
constexpr int BM = 256, BK = 64, HALF = 128, HTB = HALF * BK * 2, STAGE_BYTES = 8 * HTB, NXCD = 8, WGM = 8;
__host__ __device__ __forceinline__ int lds_byte(int r, int c) { const int st = (r >> 4) * 2 + (c >> 5), rr = r & 15, cc = c & 31, ob = rr * 64 + cc * 2; return st * 1024 + (ob ^ (((ob >> 9) & 1) << 5)); }
__host__ __device__ __forceinline__ void stage_rc(int b, int& R, int& C) { const int st = b / 1024, sb = b % 1024, swz = sb ^ (((sb >> 9) & 1) << 5); R = (st >> 1) * 16 + swz / 64; C = (st & 1) * 32 + (swz % 64) / 2; }
__host__ __device__ __forceinline__ int perm32(int rho) { const int n = rho >> 4, i = rho & 15; return 8 * (i >> 2) + 4 * n + (i & 3); }

struct Unit { int pm, pn; };
struct Gemm { const bf16_t* A; const bf16_t* Bt; int lda, ldb, K, mstride, arow0, acolstep; };

struct StaticOrder {
    int nM, nN, nwg, G, c;
    __device__ void init(int nM_, int nN_, int G_, int c_) { nM = nM_; nN = nN_; nwg = nM * nN; G = G_; c = c_; }
    __device__ bool next(int i, Unit& u) const {
        const long L = (long)i * G + c; if (L >= nwg) return false;
        int wgid = (int)L; { const int q = nwg / NXCD, r = nwg % NXCD, xcd = wgid % NXCD, off = wgid / NXCD; wgid = (xcd < r ? xcd * (q + 1) : r * (q + 1) + (xcd - r) * q) + off; }
        const int nig = WGM * nN, gid = wgid / nig, fm = gid * WGM, gsz = (nM - fm) < WGM ? (nM - fm) : WGM;
        u.pm = fm + ((wgid % nig) % gsz); u.pn = (wgid % nig) / gsz; return true;
    }
};

template <class Epi>
__device__ __forceinline__ void gemm_phase(LAS unsigned char* lds, const Gemm g, const StaticOrder& S, const Epi& E) {
    const int tid = otid(), wid = __builtin_amdgcn_readfirstlane(tid >> 6), lane = tid & 63, wr = wid >> 2, wc = wid & 3, fr = lane & 15, fq = lane >> 4;
    const int K = g.K, nt = K / BK;
    unsigned voffA[2], voffB[2];
#pragma unroll
    for (int i = 0; i < 2; ++i) { int R, C; stage_rc(tid * 16 + i * 8192, R, C); const int Rb = (R & ~31) + perm32(R & 31);
        voffA[i] = (unsigned)(R * g.lda + C) * 2u; voffB[i] = (unsigned)(Rb * g.ldb + C) * 2u; }
    const size_t kstep = (size_t)(BK * 2);
    const size_t hstepA = (size_t)HALF * g.lda * 2, hstepB = (size_t)HALF * g.ldb * 2;
    const unsigned ldsw = (unsigned)wid * 1024u;
    const int aoff = lds_byte(wr * 64 + fr, fq * 8), boff = lds_byte(wc * 32 + fr, fq * 8);
#define PG8_SA(b, h) (((b) * 2 + (h)) * HTB)
#define PG8_SB(b, h) ((4 + (b) * 2 + (h)) * HTB)
#define PG8_STAGE(bufoff, gbase, voff) do { _Pragma("unroll") for (int _i = 0; _i < 2; ++_i) \
        __builtin_amdgcn_global_load_lds((const unsigned*)((const char*)(gbase) + (voff)[_i]), (LAS unsigned*)(lds + (bufoff) + ldsw + _i * 8192), 16, 0, 0); } while (0)
#define PG8_LDA(dst, b, h) do { _Pragma("unroll") for (int m = 0; m < 4; ++m) _Pragma("unroll") for (int k = 0; k < 2; ++k) dst[m][k] = *(const LAS bf16x8*)(lds + PG8_SA(b, h) + aoff + m * 2048 + k * 1024); } while (0)
#define PG8_LDB(dst, b, h) do { _Pragma("unroll") for (int n = 0; n < 2; ++n) _Pragma("unroll") for (int k = 0; k < 2; ++k) dst[n][k] = *(const LAS bf16x8*)(lds + PG8_SB(b, h) + boff + n * 2048 + k * 1024); } while (0)
#define PG8_MMA(ai, bj, At, Bt) do { __builtin_amdgcn_s_setprio(1); _Pragma("unroll") for (int m = 0; m < 4; ++m) _Pragma("unroll") for (int n = 0; n < 2; ++n) _Pragma("unroll") for (int k = 0; k < 2; ++k) \
        acc[ai][bj][m][n] = __builtin_amdgcn_mfma_f32_16x16x32_bf16(Bt[n][k], At[m][k], acc[ai][bj][m][n], 0, 0, 0); __builtin_amdgcn_s_setprio(0); } while (0)
#define PG8_WAIT_V(n) asm volatile("s_waitcnt vmcnt(" #n ")" ::: "memory")
#define PG8_WAIT_L(n) asm volatile("s_waitcnt lgkmcnt(" #n ")" ::: "memory")
#define PG8_BAR __builtin_amdgcn_s_barrier()
#define PG8_SCHED __builtin_amdgcn_sched_barrier(0)
#define PG8_ABASE(u) ((const char*)g.A + ((long)((long)(u).pm * g.mstride + g.arow0) * g.lda + (long)(u).pn * g.acolstep) * 2)
#define PG8_BBASE(u) ((const char*)g.Bt + (size_t)(u).pn * 256 * g.ldb * 2)
    Unit cur, nxt; int ui = 0;
    if (!S.next(0, cur)) return;
    f32x4 acc[2][2][4][2];
#pragma unroll
    for (int a = 0; a < 2; ++a)
#pragma unroll
        for (int b = 0; b < 2; ++b)
#pragma unroll
            for (int m = 0; m < 4; ++m)
#pragma unroll
                for (int n = 0; n < 2; ++n) acc[a][b][m][n] = (f32x4){0.f, 0.f, 0.f, 0.f};
    bf16x8 At[4][2], B0[2][2], B1[2][2];
    const char* cA = PG8_ABASE(cur); const char* cB = PG8_BBASE(cur);
    PG8_STAGE(PG8_SB(0, 0), cB, voffB); PG8_STAGE(PG8_SB(0, 1), cB + hstepB, voffB); PG8_STAGE(PG8_SA(0, 0), cA, voffA); PG8_STAGE(PG8_SA(0, 1), cA + hstepA, voffA);
    if (wr == 1) PG8_BAR;
    PG8_WAIT_V(2); PG8_BAR;
    PG8_STAGE(PG8_SB(1, 0), cB + kstep, voffB); PG8_STAGE(PG8_SA(1, 0), cA + kstep, voffA); PG8_STAGE(PG8_SB(1, 1), cB + hstepB + kstep, voffB);
    PG8_WAIT_V(6); PG8_BAR;
    for (;;) {
        const bool has_next = S.next(ui + 1, nxt);
        const char* nA = has_next ? PG8_ABASE(nxt) : cA; const char* nB = has_next ? PG8_BBASE(nxt) : cB;
#pragma unroll 1
        for (int t = 0; t < nt; t += 2) {
            const bool last = (t == nt - 2);
            const char* a1 = cA + (size_t)(t + 1) * kstep;
            const char* a2 = last ? nA : cA + (size_t)(t + 2) * kstep; const char* b2 = last ? nB : cB + (size_t)(t + 2) * kstep;
            const char* a3 = a2 + kstep; const char* b3 = b2 + kstep;
            PG8_LDB(B0, 0, 0); PG8_LDB(B1, 0, 1); PG8_SCHED; PG8_LDA(At, 0, 0); PG8_STAGE(PG8_SA(1, 1), a1 + hstepA, voffA);
            PG8_WAIT_V(8); PG8_WAIT_L(0); PG8_BAR; PG8_MMA(0, 0, At, B0); PG8_MMA(0, 1, At, B1); PG8_BAR; PG8_SCHED;
            PG8_LDA(At, 0, 1); PG8_STAGE(PG8_SB(0, 0), b2, voffB); PG8_STAGE(PG8_SB(0, 1), b2 + hstepB, voffB); PG8_STAGE(PG8_SA(0, 0), a2, voffA);
            PG8_WAIT_V(8); PG8_WAIT_L(0); PG8_BAR; PG8_MMA(1, 0, At, B0); PG8_MMA(1, 1, At, B1); PG8_BAR; PG8_SCHED;
            PG8_LDB(B0, 1, 0); PG8_LDB(B1, 1, 1); PG8_SCHED; PG8_LDA(At, 1, 0); PG8_STAGE(PG8_SA(0, 1), a2 + hstepA, voffA);
            PG8_WAIT_V(8); PG8_WAIT_L(0); PG8_BAR; PG8_MMA(0, 0, At, B0); PG8_MMA(0, 1, At, B1); PG8_BAR; PG8_SCHED;
            PG8_LDA(At, 1, 1); PG8_STAGE(PG8_SB(1, 0), b3, voffB); PG8_STAGE(PG8_SB(1, 1), b3 + hstepB, voffB); PG8_STAGE(PG8_SA(1, 0), a3, voffA);
            PG8_WAIT_V(8); PG8_WAIT_L(0); PG8_BAR; PG8_MMA(1, 0, At, B0); PG8_MMA(1, 1, At, B1); PG8_BAR; PG8_SCHED;
        }
        if (wr == 0) PG8_BAR;
        { int lane2 = lane; asm volatile("" : "+v"(lane2)); E(acc, cur, wr, wc, lane2 & 15, lane2 >> 4, lds + STAGE_BYTES); }
        if (!has_next) break;
#pragma unroll
        for (int a = 0; a < 2; ++a)
#pragma unroll
            for (int b = 0; b < 2; ++b)
#pragma unroll
                for (int m = 0; m < 4; ++m)
#pragma unroll
                    for (int n = 0; n < 2; ++n) acc[a][b][m][n] = (f32x4){0.f, 0.f, 0.f, 0.f};
        cur = nxt; cA = nA; cB = nB; ++ui;
        if (wr == 1) PG8_BAR;
    }
    PG8_WAIT_V(0);
    PG8_BAR;
#undef PG8_SA
#undef PG8_SB
#undef PG8_STAGE
#undef PG8_LDA
#undef PG8_LDB
#undef PG8_MMA
#undef PG8_WAIT_V
#undef PG8_WAIT_L
#undef PG8_BAR
#undef PG8_SCHED
#undef PG8_ABASE
#undef PG8_BBASE
}
}
using pg8::Unit;
typedef f32x4 AccT[2][2][4][2];

__device__ __forceinline__ float row_rs(const float* part, int row, int fq) {
    const f32x4 p = *(const f32x4*)(part + (long)row * 16 + fq * 4);
    float s = (p[0] + p[1]) + (p[2] + p[3]);
    s += __shfl_xor(s, 16); s += __shfl_xor(s, 32);
    return rsqrtf(s * (1.0f / D) + EPS);
}

struct EpiProj {
    bf16_t* proj; float* la; const float* ssq0; const float* b_alpha;
    __device__ __forceinline__ void operator()(const AccT& acc, const Unit& u, int wr, int wc, int fr, int fq, LAS unsigned char*) const {
#pragma unroll
        for (int ai = 0; ai < 2; ++ai)
#pragma unroll
            for (int m = 0; m < 4; ++m) {
                const int row = u.pm * 256 + ai * 128 + wr * 64 + m * 16 + fr;
                const float rs = rsqrtf(ssq0[row] * (1.0f / D) + EPS);
#pragma unroll
                for (int bj = 0; bj < 2; ++bj) {
                    const int col = u.pn * 256 + bj * 128 + wc * 32 + fq * 8;
                    const f32x4 v0 = acc[ai][bj][m][0] * rs, v1 = acc[ai][bj][m][1] * rs;
                    if (u.pn < 9) {
                        u32x4 w; w.x = cvt_pk_bf16(v0[0], v0[1]); w.y = cvt_pk_bf16(v0[2], v0[3]); w.z = cvt_pk_bf16(v1[0], v1[1]); w.w = cvt_pk_bf16(v1[2], v1[3]);
                        *(u32x4*)(proj + (size_t)row * NPROJ + col) = w;
                    } else {
                        const int c = col - NPROJ;
                        const f32x4 b0 = *(const f32x4*)(b_alpha + c), b1 = *(const f32x4*)(b_alpha + c + 4);
                        f32x4 o0, o1;
#pragma unroll
                        for (int j = 0; j < 4; ++j) {
                            const float z0 = v0[j] + b0[j], z1 = v1[j] + b1[j];
                            o0[j] = (fminf(z0, 0.f) - log1pf(__expf(-fabsf(z0)))) * 0.0625f;
                            o1[j] = (fminf(z1, 0.f) - log1pf(__expf(-fabsf(z1)))) * 0.0625f;
                        }
                        *(f32x4*)(la + (size_t)row * 256 + c) = o0; *(f32x4*)(la + (size_t)row * 256 + c + 4) = o1;
                    }
                }
            }
    }
};
struct EpiPP {
    bf16_t* pp;
    __device__ __forceinline__ void operator()(const AccT& acc, const Unit& u, int wr, int wc, int fr, int fq, LAS unsigned char*) const {
#pragma unroll
        for (int ai = 0; ai < 2; ++ai)
#pragma unroll
            for (int m = 0; m < 4; ++m) {
                const int row = u.pm * 256 + ai * 128 + wr * 64 + m * 16 + fr;
#pragma unroll
                for (int bj = 0; bj < 2; ++bj) {
                    const int col = u.pn * 256 + bj * 128 + wc * 32 + fq * 8;
                    const f32x4 v0 = acc[ai][bj][m][0], v1 = acc[ai][bj][m][1];
                    u32x4 w; w.x = cvt_pk_bf16(v0[0], v0[1]); w.y = cvt_pk_bf16(v0[2], v0[3]); w.z = cvt_pk_bf16(v1[0], v1[1]); w.w = cvt_pk_bf16(v1[2], v1[3]);
                    *(u32x4*)(pp + (size_t)row * D + col) = w;
                }
            }
    }
};
template <int MODE, bool WRITE_HB, bool WRITE_PART, bool WRITE_F32>
struct EpiRes {
    float* out; const float* xp; const bf16_t* hbin; bf16_t* hb; float* part; const float* part_in; const bf16_t* pp; const float* scale;
    __device__ __forceinline__ void operator()(const AccT& acc, const Unit& u, int wr, int wc, int fr, int fq, LAS unsigned char*) const {
#pragma unroll
        for (int ai = 0; ai < 2; ++ai)
#pragma unroll
            for (int m = 0; m < 4; ++m) {
                const int row = u.pm * 256 + ai * 128 + wr * 64 + m * 16 + fr;
                float rs = 1.f;
                if (MODE == 2) rs = row_rs(part_in, row, fq);
                float sq = 0.f;
#pragma unroll
                for (int bj = 0; bj < 2; ++bj) {
                    const int col = u.pn * 256 + bj * 128 + wc * 32 + fq * 8;
                    f32x4 v0 = acc[ai][bj][m][0], v1 = acc[ai][bj][m][1];
                    if (MODE == 2) {
                        const u32x4 pw = *(const u32x4*)(pp + (size_t)row * D + col);
                        float pf[8]; unpack8(pw, pf);
#pragma unroll
                        for (int j = 0; j < 4; ++j) {
                            v0[j] = pf[j] / (1.f + __expf(-v0[j] * rs));
                            v1[j] = pf[4 + j] / (1.f + __expf(-v1[j] * rs));
                        }
                    }
                    if (MODE == 3) { v0 = v0 * *(const f32x4*)(scale + col); v1 = v1 * *(const f32x4*)(scale + col + 4); }
                    f32x4 b0, b1;
                    if (MODE == 0) { b0 = *(const f32x4*)(xp + (size_t)row * D + col); b1 = *(const f32x4*)(xp + (size_t)row * D + col + 4); }
                    else { const u32x4 bw = *(const u32x4*)(hbin + (size_t)row * D + col); float bf[8]; unpack8(bw, bf); b0 = (f32x4){bf[0], bf[1], bf[2], bf[3]}; b1 = (f32x4){bf[4], bf[5], bf[6], bf[7]}; }
                    const f32x4 h0 = b0 + v0, h1 = b1 + v1;
                    if (WRITE_F32) { float* hp = out + O_YP + (size_t)row * D; *(f32x4*)(hp + col) = h0; *(f32x4*)(hp + col + 4) = h1; }
                    if (WRITE_HB) { u32x4 w; w.x = cvt_pk_bf16(h0[0], h0[1]); w.y = cvt_pk_bf16(h0[2], h0[3]); w.z = cvt_pk_bf16(h1[0], h1[1]); w.w = cvt_pk_bf16(h1[2], h1[3]);
                        *(u32x4*)(hb + (size_t)row * D + col) = w; }
                    sq += (h0[0] * h0[0] + h0[1] * h0[1]) + (h0[2] * h0[2] + h0[3] * h0[3]) + (h1[0] * h1[0] + h1[1] * h1[1]) + (h1[2] * h1[2] + h1[3] * h1[3]);
                }
                if (WRITE_PART) {
                    sq += __shfl_xor(sq, 16); sq += __shfl_xor(sq, 32);
                    if (fq == 0) part[(long)row * 16 + u.pn * 4 + wc] = sq;
                }
            }
    }
};
struct EpiFfn {
    const float* part_in; const float* convw; const float* convb; float* convp_out; bf16_t* G;
    __device__ __forceinline__ void operator()(AccT& acc, const Unit& u, int wr, int wc, int fr, int fq, LAS unsigned char* ldsx) const {
        const int c0 = u.pn * 128 + wc * 32 + fq * 8;
#pragma unroll
        for (int ai = 0; ai < 2; ++ai)
#pragma unroll
            for (int m = 0; m < 4; ++m) {
                const int grow = u.pm * 254 - 2 + ai * 128 + wr * 64 + m * 16 + fr;
                const float rs = row_rs(part_in, grow, fq);
#pragma unroll
                for (int bj = 0; bj < 2; ++bj)
#pragma unroll
                    for (int n = 0; n < 2; ++n) acc[ai][bj][m][n] = acc[ai][bj][m][n] * rs;
            }
        LAS f32x4* xch = (LAS f32x4*)ldsx;
        if (fr >= 14) {
#pragma unroll
            for (int ai = 0; ai < 2; ++ai) {
                const int slot = ((((ai * 2 + wr) * 4 + wc) * 4 + fq) * 2 + (fr - 14)) * 2;
                xch[slot] = acc[ai][0][3][0]; xch[slot + 1] = acc[ai][0][3][1];
            }
        }
        asm volatile("s_waitcnt lgkmcnt(0)" ::: "memory"); __builtin_amdgcn_s_barrier(); asm volatile("" ::: "memory");
        f32x4 w0[2], w1[2], w2[2], cb[2];
#pragma unroll
        for (int n = 0; n < 2; ++n) { const int cn = c0 + 4 * n;
            w0[n] = *(const f32x4*)(convw + cn); w1[n] = *(const f32x4*)(convw + DFF + cn); w2[n] = *(const f32x4*)(convw + 2 * DFF + cn); cb[n] = *(const f32x4*)(convb + cn); }
#pragma unroll
        for (int ai = 0; ai < 2; ++ai)
#pragma unroll
            for (int m = 0; m < 4; ++m) {
                const int tr = ai * 128 + wr * 64 + m * 16 + fr;
                const int grow = u.pm * 254 - 2 + tr;
                const bool store = (tr >= 2 && grow < SEQ);
                u32x4 w;
#pragma unroll
                for (int n = 0; n < 2; ++n) {
                    const f32x4 x = acc[ai][0][m][n];
                    f32x4 p;
                    if (m == 0) {
                        const int sa = (wr == 1) ? ai : 0, sw = (wr == 1) ? 0 : 1;
                        const bool has = (wr == 1) || (ai == 1);
                        const int slot = ((((sa * 2 + sw) * 4 + wc) * 4 + fq) * 2 + (fr >= 14 ? fr - 14 : 0)) * 2 + n;
                        p = xch[slot];
                        if (!has) p = (f32x4){0.f, 0.f, 0.f, 0.f};
                    } else p = acc[ai][0][m == 0 ? 0 : m - 1][n];
                    f32x4 p1, p2;
#pragma unroll
                    for (int j = 0; j < 4; ++j) {
                        const float xf = x[j], pf = p[j]; const int xi = __float_as_int(xf), pi = __float_as_int(pf);
                        const int r1 = __builtin_amdgcn_update_dpp(0, pi, 0x121, 0xf, 0xf, false), r2 = __builtin_amdgcn_update_dpp(0, pi, 0x122, 0xf, 0xf, false);
                        p1[j] = __int_as_float(__builtin_amdgcn_update_dpp(r1, xi, 0x111, 0xf, 0xf, false));
                        p2[j] = __int_as_float(__builtin_amdgcn_update_dpp(r2, xi, 0x112, 0xf, 0xf, false));
                    }
                    if (grow >= SEQ - 2 && grow < SEQ) *(f32x4*)(convp_out + (size_t)(grow - (SEQ - 2)) * DFF + c0 + 4 * n) = x;
                    const f32x4 ac = cb[n] + w0[n] * p2 + w1[n] * p1 + w2[n] * x;
                    const f32x4 v = acc[ai][1][m][n];
                    const f32x2 g0 = gelu_pk((f32x2){ac[0], ac[1]}), g1 = gelu_pk((f32x2){ac[2], ac[3]});
                    const unsigned lo = cvt_pk_bf16(g0.x * v[0], g0.y * v[1]), hi = cvt_pk_bf16(g1.x * v[2], g1.y * v[3]);
                    if (n == 0) { w.x = lo; w.y = hi; } else { w.z = lo; w.w = hi; }
                }
                if (store) *(u32x4*)(G + (size_t)grow * DFF + c0) = w;
                asm volatile("" ::: "memory");
            }
    }
};

struct EpiNull {
    __device__ __forceinline__ void operator()(const AccT& acc, const Unit& u, int wr, int wc, int fr, int fq, LAS unsigned char*) const {
#pragma unroll
        for (int ai = 0; ai < 2; ++ai)
#pragma unroll
            for (int bj = 0; bj < 2; ++bj)
#pragma unroll
                for (int m = 0; m < 4; ++m) { asm volatile("" :: "v"(acc[ai][bj][m][0]), "v"(acc[ai][bj][m][1])); }
    }
};
struct KArgs { const float* in[29]; float* out; unsigned char* ws; };
enum { I_XP = 0, I_XS, I_PP, I_PS, I_SGLA, I_CK, I_CV, I_SPOOL, I_SCONV, I_MNE, I_WIN, I_WALPHA, I_BALPHA, I_ONORM, I_QNORM, I_KNORM, I_SINKS, I_WOUT,
       I_MNO, I_POOLW, I_POOLSC, I_FNORM, I_FWIN, I_FCW, I_FCB, I_FWOUT, I_PNORM, I_PWPROJ, I_PWGATE };

__device__ __forceinline__ float* part_tab(unsigned char* ws, int i) { return (float*)(ws + WS_SSQ + 262144 + (size_t)i * PART_STRIDE) + 2 * 16; }

constexpr int SPART_PITCH = 68;
template <int K, int LDA, int LDB>
__device__ __forceinline__ void sgemm_tile(const bf16_t* __restrict__ A, const bf16_t* __restrict__ B0, const bf16_t* __restrict__ B1, LAS float* part) {
    const int tid = otid(), lane = tid & 63, wave = __builtin_amdgcn_readfirstlane(tid >> 6);
    const int kq = wave & 3, mh = wave >> 2, fr = lane & 15, fq = lane >> 4;
    constexpr int KQ = K / 4;
    const bf16_t* ap = A + (size_t)(64 * mh + fr) * LDA + kq * KQ + 8 * fq;
    const bf16_t* bp0 = B0 + (size_t)fr * LDB + kq * KQ + 8 * fq;
    const bf16_t* bp1 = B1 + (size_t)fr * LDB + kq * KQ + 8 * fq;
    f32x4 acc[4][4];
#pragma unroll
    for (int m = 0; m < 4; ++m)
#pragma unroll
        for (int n = 0; n < 4; ++n) acc[m][n] = (f32x4){0.f, 0.f, 0.f, 0.f};
    constexpr int NSTEP = KQ / 32, NB = (NSTEP >= 4) ? 4 : NSTEP;
    static_assert(KQ % 32 == 0, "K quarter must be a multiple of 32");
#pragma unroll 1
    for (int k0 = 0; k0 + 32 * NB <= KQ; k0 += 32 * NB) {
        bf16x8 af[NB][4], bf[NB][4];
#pragma unroll
        for (int s = 0; s < NB; ++s) {
#pragma unroll
            for (int m = 0; m < 4; ++m) af[s][m] = *(const bf16x8*)(ap + (size_t)(16 * m) * LDA + k0 + 32 * s);
            bf[s][0] = *(const bf16x8*)(bp0 + k0 + 32 * s); bf[s][1] = *(const bf16x8*)(bp0 + (size_t)16 * LDB + k0 + 32 * s);
            bf[s][2] = *(const bf16x8*)(bp1 + k0 + 32 * s); bf[s][3] = *(const bf16x8*)(bp1 + (size_t)16 * LDB + k0 + 32 * s);
        }
#pragma unroll
        for (int s = 0; s < NB; ++s)
#pragma unroll
            for (int m = 0; m < 4; ++m)
#pragma unroll
                for (int n = 0; n < 4; ++n) acc[m][n] = __builtin_amdgcn_mfma_f32_16x16x32_bf16(bf[s][n], af[s][m], acc[m][n], 0, 0, 0);
    }
    constexpr int REM = NSTEP % NB;
    if (REM > 0) {
        constexpr int k0 = (NSTEP - REM) * 32;
        bf16x8 af[REM > 0 ? REM : 1][4], bf[REM > 0 ? REM : 1][4];
#pragma unroll
        for (int s = 0; s < REM; ++s) {
#pragma unroll
            for (int m = 0; m < 4; ++m) af[s][m] = *(const bf16x8*)(ap + (size_t)(16 * m) * LDA + k0 + 32 * s);
            bf[s][0] = *(const bf16x8*)(bp0 + k0 + 32 * s); bf[s][1] = *(const bf16x8*)(bp0 + (size_t)16 * LDB + k0 + 32 * s);
            bf[s][2] = *(const bf16x8*)(bp1 + k0 + 32 * s); bf[s][3] = *(const bf16x8*)(bp1 + (size_t)16 * LDB + k0 + 32 * s);
        }
#pragma unroll
        for (int s = 0; s < REM; ++s)
#pragma unroll
            for (int m = 0; m < 4; ++m)
#pragma unroll
                for (int n = 0; n < 4; ++n) acc[m][n] = __builtin_amdgcn_mfma_f32_16x16x32_bf16(bf[s][n], af[s][m], acc[m][n], 0, 0, 0);
    }
#pragma unroll
    for (int m = 0; m < 4; ++m)
#pragma unroll
        for (int n = 0; n < 4; ++n) *(LAS f32x4*)(part + (kq * 128 + 64 * mh + 16 * m + fr) * SPART_PITCH + 16 * n + 4 * fq) = acc[m][n];
}
template <int N>
__device__ __forceinline__ void sreduce(const LAS float* part, int b, int col0, float* v) {
#pragma unroll
    for (int j = 0; j < N; j += 4) {
        f32x4 s = *(const LAS f32x4*)(part + b * SPART_PITCH + col0 + j);
#pragma unroll
        for (int kq = 1; kq < 4; ++kq) s += *(const LAS f32x4*)(part + (kq * 128 + b) * SPART_PITCH + col0 + j);
        v[j] = s[0]; v[j + 1] = s[1]; v[j + 2] = s[2]; v[j + 3] = s[3];
    }
}
template <int MODE, bool WRITE_HB, bool WRITE_PART, bool WRITE_F32>
__device__ __forceinline__ void s_res_epi(const KArgs& a, int b, int q, int n0, const float* v, const bf16_t* hbin, bf16_t* hb, float* part, const float* ppv, float rs_in, const float* scale) {
    const int row = SROW + b, c0 = n0 + 16 * q;
    float base[16];
    if (MODE == 0) {
#pragma unroll
        for (int j = 0; j < 16; j += 4) { const f32x4 bv = *(const f32x4*)(a.in[I_XS] + (size_t)b * D + c0 + j); base[j] = bv[0]; base[j + 1] = bv[1]; base[j + 2] = bv[2]; base[j + 3] = bv[3]; }
    } else {
        const u32x4 w0 = *(const u32x4*)(hbin + (size_t)row * D + c0), w1 = *(const u32x4*)(hbin + (size_t)row * D + c0 + 8);
        unpack8(w0, base); unpack8(w1, base + 8);
    }
    float hn[16]; float sq = 0.f;
#pragma unroll
    for (int j = 0; j < 16; ++j) {
        float nv = v[j];
        if (MODE == 2) nv = ppv[j] / (1.f + __expf(-nv * rs_in));
        if (MODE == 3) nv = nv * scale[c0 + j];
        hn[j] = base[j] + nv; sq += hn[j] * hn[j];
    }
    if (WRITE_F32) {
        float* hp = a.out + O_YS + (size_t)b * D + c0;
#pragma unroll
        for (int j = 0; j < 16; j += 4) *(f32x4*)(hp + j) = (f32x4){hn[j], hn[j + 1], hn[j + 2], hn[j + 3]};
    }
    if (WRITE_HB) {
        u32x4 w0, w1;
        w0.x = cvt_pk_bf16(hn[0], hn[1]); w0.y = cvt_pk_bf16(hn[2], hn[3]); w0.z = cvt_pk_bf16(hn[4], hn[5]); w0.w = cvt_pk_bf16(hn[6], hn[7]);
        w1.x = cvt_pk_bf16(hn[8], hn[9]); w1.y = cvt_pk_bf16(hn[10], hn[11]); w1.z = cvt_pk_bf16(hn[12], hn[13]); w1.w = cvt_pk_bf16(hn[14], hn[15]);
        *(u32x4*)(hb + (size_t)row * D + c0) = w0; *(u32x4*)(hb + (size_t)row * D + c0 + 8) = w1;
    }
    if (WRITE_PART) {
        sq += __shfl_xor(sq, 1); sq += __shfl_xor(sq, 2);
        if (q == 0) part[(long)row * 16 + (n0 >> 6)] = sq;
    }
}
__device__ __forceinline__ float s_row_rs(const float* part, int b) {
    const float* p = part + (long)(SROW + b) * 16;
    const f32x4 p0 = *(const f32x4*)(p), p1 = *(const f32x4*)(p + 4), p2 = *(const f32x4*)(p + 8), p3 = *(const f32x4*)(p + 12);
    const float s = ((p0[0] + p0[1]) + (p0[2] + p0[3])) + ((p1[0] + p1[1]) + (p1[2] + p1[3])) + ((p2[0] + p2[1]) + (p2[2] + p2[3])) + ((p3[0] + p3[1]) + (p3[2] + p3[3]));
    return rsqrtf(s * (1.0f / D) + EPS);
}
__device__ __forceinline__ void s_proj_units(const KArgs& a, LAS unsigned char* lds, int u0, int G) {
    LAS float* part = (LAS float*)lds;
    const bf16_t* xbf = (const bf16_t*)(a.ws + WS_R1) + (size_t)SROW * D; const bf16_t* W = (const bf16_t*)(a.ws + WS_WIN0);
    bf16_t* proj = (bf16_t*)(a.ws + WS_BIG); float* la = (float*)(a.ws + WS_BIG + BIG_LA); const float* ssq0 = (const float*)(a.ws + WS_SSQ);
    for (int u = u0; u < 40; u += G) {
        const int n0 = u * 64;
        sgemm_tile<1024, 1024, 1024>(xbf, W + (size_t)n0 * 1024, W + (size_t)(n0 + 32) * 1024, part);
        __syncthreads();
        const int tid = otid(), b = tid >> 2, q = tid & 3, c0 = n0 + 16 * q, row = SROW + b;
        float v[16]; sreduce<16>(part, b, 16 * q, v);
        const float rs = rsqrtf(ssq0[row] * (1.0f / D) + EPS);
        if (n0 < NPROJ) {
            u32x4 w0, w1;
            w0.x = cvt_pk_bf16(v[0] * rs, v[1] * rs); w0.y = cvt_pk_bf16(v[2] * rs, v[3] * rs); w0.z = cvt_pk_bf16(v[4] * rs, v[5] * rs); w0.w = cvt_pk_bf16(v[6] * rs, v[7] * rs);
            w1.x = cvt_pk_bf16(v[8] * rs, v[9] * rs); w1.y = cvt_pk_bf16(v[10] * rs, v[11] * rs); w1.z = cvt_pk_bf16(v[12] * rs, v[13] * rs); w1.w = cvt_pk_bf16(v[14] * rs, v[15] * rs);
            *(u32x4*)(proj + (size_t)row * NPROJ + c0) = w0; *(u32x4*)(proj + (size_t)row * NPROJ + c0 + 8) = w1;
        } else {
            const int c = c0 - NPROJ;
#pragma unroll
            for (int j = 0; j < 16; j += 4) { f32x4 o;
#pragma unroll
                for (int i = 0; i < 4; ++i) { const float z = v[j + i] * rs + a.in[I_BALPHA][c + j + i]; o[i] = (fminf(z, 0.f) - log1pf(__expf(-fabsf(z)))) * 0.0625f; }
                *(f32x4*)(la + (size_t)row * 256 + c + j) = o; }
        }
        __syncthreads();
    }
}
template <int MODE, int K, int LDA>
__device__ __forceinline__ void s_res_units(const KArgs& a, LAS unsigned char* lds, int u0, int G, const bf16_t* A, const bf16_t* W, const bf16_t* hbin, bf16_t* hb, float* part_out) {
    LAS float* part = (LAS float*)lds;
    for (int u = u0; u < 16; u += G) {
        const int n0 = u * 64;
        const bf16_t* Au = A + (size_t)SROW * LDA + (MODE == 3 ? (n0 >> 8) * 256 : 0);
        sgemm_tile<K, LDA, K>(Au, W + (size_t)n0 * K, W + (size_t)(n0 + 32) * K, part);
        __syncthreads();
        const int tid = otid(), b = tid >> 2, q = tid & 3;
        float v[16]; sreduce<16>(part, b, 16 * q, v);
        s_res_epi<MODE, true, true, false>(a, b, q, n0, v, hbin, hb, part_out, nullptr, 1.f, a.in[I_POOLSC]);
        __syncthreads();
    }
}
template <bool LAST>
__device__ __forceinline__ void s_ple_units(const KArgs& a, LAS unsigned char* lds, int u0, int G, const bf16_t* pb, const bf16_t* Wp, const bf16_t* hbA, const bf16_t* Wg, const float* part_in, float* part_out, bf16_t* hbout) {
    LAS float* part = (LAS float*)lds;
    for (int u = u0; u < 16; u += G) {
        const int n0 = u * 64;
        sgemm_tile<256, 256, 256>(pb + (size_t)SROW * PLE, Wp + (size_t)n0 * PLE, Wp + (size_t)(n0 + 32) * PLE, part);
        __syncthreads();
        const int tid = otid(), b = tid >> 2, q = tid & 3;
        float ppv[16]; sreduce<16>(part, b, 16 * q, ppv);
        __syncthreads();
        sgemm_tile<1024, 1024, 1024>(hbA + (size_t)SROW * D, Wg + (size_t)n0 * D, Wg + (size_t)(n0 + 32) * D, part);
        __syncthreads();
        float v[16]; sreduce<16>(part, b, 16 * q, v);
        const float rs = s_row_rs(part_in, b);
        s_res_epi<2, !LAST, !LAST, LAST>(a, b, q, n0, v, hbA, hbout, part_out, ppv, rs, nullptr);
        __syncthreads();
    }
}
__device__ __forceinline__ void s_ffn_units(const KArgs& a, LAS unsigned char* lds, int u0, int G, int l, const bf16_t* hbA, const float* part_in) {
    LAS float* part = (LAS float*)lds;
    const bf16_t* W = (const bf16_t*)(a.ws + WS_WFFI + l * WFFI_BYTES);
    bf16_t* Gb = (bf16_t*)(a.ws + WS_BIG);
    const float* convw = a.in[I_FCW] + (size_t)l * 3 * DFF; const float* convb = a.in[I_FCB] + (size_t)l * DFF;
    const float* cstate = a.in[I_SCONV] + (size_t)l * NS * 2 * DFF; float* convs = a.out + O_CONVS + (size_t)l * NS * 2 * DFF;
    for (int u = u0; u < 88; u += G) {
        const int ca = u * 32;
        const int nr = 256 * (ca >> 7) + (ca & 127);
        sgemm_tile<1024, 1024, 1024>(hbA + (size_t)SROW * D, W + (size_t)nr * 1024, W + (size_t)(nr + 128) * 1024, part);
        __syncthreads();
        const int tid = otid(), b = tid >> 2, q = tid & 3, c = ca + 8 * q;
        float av[8], vv[8]; sreduce<8>(part, b, 8 * q, av); sreduce<8>(part, b, 32 + 8 * q, vv);
        const float rs = s_row_rs(part_in, b);
        const float* st = cstate + (size_t)b * 2 * DFF + c; float* so = convs + (size_t)b * 2 * DFF + c;
        float g[8];
#pragma unroll
        for (int j = 0; j < 8; j += 4) {
            const f32x4 p2 = *(const f32x4*)(st + j), p1 = *(const f32x4*)(st + DFF + j);
            const f32x4 w0 = *(const f32x4*)(convw + c + j), w1 = *(const f32x4*)(convw + DFF + c + j), w2 = *(const f32x4*)(convw + 2 * DFF + c + j), cb = *(const f32x4*)(convb + c + j);
            const f32x4 x = (f32x4){av[j] * rs, av[j + 1] * rs, av[j + 2] * rs, av[j + 3] * rs};
            *(f32x4*)(so + j) = p1; *(f32x4*)(so + DFF + j) = x;
            const f32x4 ac = cb + w0 * p2 + w1 * p1 + w2 * x;
            const f32x2 g0 = gelu_pk((f32x2){ac[0], ac[1]}), g1 = gelu_pk((f32x2){ac[2], ac[3]});
            g[j] = g0.x * vv[j] * rs; g[j + 1] = g0.y * vv[j + 1] * rs; g[j + 2] = g1.x * vv[j + 2] * rs; g[j + 3] = g1.y * vv[j + 3] * rs;
        }
        u32x4 w; w.x = cvt_pk_bf16(g[0], g[1]); w.y = cvt_pk_bf16(g[2], g[3]); w.z = cvt_pk_bf16(g[4], g[5]); w.w = cvt_pk_bf16(g[6], g[7]);
        *(u32x4*)(Gb + (size_t)(SROW + b) * DFF + c) = w;
        __syncthreads();
    }
}

__device__ __forceinline__ void tr_item(const float* W, int ldsrc, int scol0, int k0, const float* gain, bf16_t* dst, int ldd, int drow0, LAS float* scr, int lane) {
    float wv[32];
#pragma unroll
    for (int i = 0; i < 32; ++i) { const int kk = 2 * i + (lane >> 5); wv[i] = __builtin_nontemporal_load(W + (size_t)(k0 + kk) * ldsrc + scol0 + (lane & 31)); }
#pragma unroll
    for (int i = 0; i < 32; ++i) { const int kk = 2 * i + (lane >> 5); const float gsc = gain ? gain[k0 + kk] : 1.f; scr[kk * 33 + (lane & 31)] = wv[i] * gsc; }
    asm volatile("s_waitcnt lgkmcnt(0)" ::: "memory");
    const int c = lane & 7;
#pragma unroll
    for (int j = 0; j < 4; ++j) { const int n = (lane >> 3) + 8 * j; const LAS float* s = scr + (8 * c) * 33 + n;
        u32x4 o; o.x = cvt_pk_bf16(s[0 * 33], s[1 * 33]); o.y = cvt_pk_bf16(s[2 * 33], s[3 * 33]); o.z = cvt_pk_bf16(s[4 * 33], s[5 * 33]); o.w = cvt_pk_bf16(s[6 * 33], s[7 * 33]);
        *(u32x4*)(dst + (size_t)(drow0 + n) * ldd + k0 + 8 * c) = o; }
    asm volatile("s_waitcnt lgkmcnt(0)" ::: "memory");
}
__device__ __forceinline__ void weff_item(const float* Win, const float* wal, int n0, int k0, const float* gain, bf16_t* dst, int drow0, LAS float* scr, int lane) {
#pragma unroll 2
    for (int i = 0; i < 32; ++i) { const int kk = 2 * i + (lane >> 5); const int k = k0 + kk; float s = 0.f;
#pragma unroll
        for (int r = 0; r < 16; ++r) s += Win[(size_t)k * 2320 + 1024 + r] * wal[r * 256 + n0 + (lane & 31)];
        scr[kk * 33 + (lane & 31)] = s * gain[k]; }
    asm volatile("s_waitcnt lgkmcnt(0)" ::: "memory");
    const int c = lane & 7;
#pragma unroll
    for (int j = 0; j < 4; ++j) { const int n = (lane >> 3) + 8 * j; const LAS float* s = scr + (8 * c) * 33 + n;
        u32x4 o; o.x = cvt_pk_bf16(s[0 * 33], s[1 * 33]); o.y = cvt_pk_bf16(s[2 * 33], s[3 * 33]); o.z = cvt_pk_bf16(s[4 * 33], s[5 * 33]); o.w = cvt_pk_bf16(s[6 * 33], s[7 * 33]);
        *(u32x4*)(dst + (size_t)(drow0 + n) * 1024 + k0 + 8 * c) = o; }
    asm volatile("s_waitcnt lgkmcnt(0)" ::: "memory");
}

__device__ __forceinline__ void p0_prologue(const KArgs& a, LAS unsigned char* lds, int vcu, int G) {
    const int tid = otid(), lane = tid & 63, wave = __builtin_amdgcn_readfirstlane(tid >> 6);
    LAS float* scr = (LAS float*)(lds + wave * 16384);
    const int gw = vcu * 8 + wave, NGW = G * 8;
    unsigned char* ws = a.ws;
    constexpr int I_A = 16 * 72, I_E = 16 * 8;
    for (int it = gw; it < I_A + I_E; it += NGW) {
        int r = it;
        if (r < I_A) { const int kb = r / 72, nb = r % 72, n0 = nb * 32; tr_item(a.in[I_WIN], 2320, n0 < 1024 ? n0 : n0 + 16, kb * 64, a.in[I_MNE], (bf16_t*)(ws + WS_WIN0), 1024, n0, scr, lane); continue; } r -= I_A;
        { const int kb = r / 8, nb = r % 8; weff_item(a.in[I_WIN], a.in[I_WALPHA], nb * 32, kb * 64, a.in[I_MNE], (bf16_t*)(ws + WS_WIN0), NPROJ + nb * 32, scr, lane); }
    }
    bf16_t* xbf = (bf16_t*)(ws + WS_R1);
    float* ssq0 = (float*)(ws + WS_SSQ);
    for (int row0 = gw * 2; row0 < MT; row0 += NGW * 2) {
        f32x4 v[2][4];
#pragma unroll
        for (int rr = 0; rr < 2; ++rr) { const int row = row0 + rr;
            const float* src = row < SEQ ? a.in[I_XP] + (size_t)row * D : ((row >= SROW && row < SROW + NS) ? a.in[I_XS] + (size_t)(row - SROW) * D : nullptr);
#pragma unroll
            for (int j = 0; j < 4; ++j) { v[rr][j] = (f32x4){0.f, 0.f, 0.f, 0.f}; if (src) v[rr][j] = __builtin_nontemporal_load((const f32x4*)(src + j * 256 + lane * 4)); } }
#pragma unroll
        for (int rr = 0; rr < 2; ++rr) { const int row = row0 + rr; float s = 0.f;
#pragma unroll
            for (int j = 0; j < 4; ++j) { const f32x4 x = v[rr][j]; s += (x[0] * x[0] + x[1] * x[1]) + (x[2] * x[2] + x[3] * x[3]);
                u32x2 w; w.x = cvt_pk_bf16(x[0], x[1]); w.y = cvt_pk_bf16(x[2], x[3]);
                *(u32x2*)(xbf + (size_t)row * D + j * 256 + lane * 4) = w; }
            s = wave_sum(s);
            if (lane == 0) ssq0[row] = s; }
    }
    if (vcu == 0) { for (int i = tid; i < 256; i += NTHREADS) ((u32x4*)(ws + WS_R2))[i] = (u32x4){0u, 0u, 0u, 0u}; }
    if (vcu == 1 && tid < 6 * 32) { float* pt = (float*)(ws + WS_SSQ + 262144 + (size_t)(tid >> 5) * PART_STRIDE); pt[tid & 31] = 0.f; }
}
__device__ __forceinline__ void p3_convert(const KArgs& a, LAS unsigned char* lds, int vcu, int G) {
    const int tid = otid(), lane = tid & 63, wave = __builtin_amdgcn_readfirstlane(tid >> 6);
    if (wave < 2) return;
    LAS float* scr = (LAS float*)(lds + wave * 16384);
    const int gw = vcu * 6 + (wave - 2), NGW = G * 6;
    unsigned char* ws = a.ws;
    constexpr int I_O = 16 * 32, I_FI = 16 * 176, I_FO = 44 * 32, I_G = 16 * 32, I_P = 4 * 32, I_PL = 4 * 32;
    constexpr int NITEMS = I_O + 2 * I_FI + 2 * I_FO + 2 * I_G + 2 * I_P + I_PL;
    for (int it = gw; it < NITEMS; it += NGW) {
        int r = it;
        if (r < I_O) { const int kb = r / 32, nb = r % 32; tr_item(a.in[I_WOUT], 1024, nb * 32, kb * 64, nullptr, (bf16_t*)(ws + WS_WOUT0), 1024, nb * 32, scr, lane); continue; } r -= I_O;
        if (r < 2 * I_FI) { const int l = r / I_FI, q = r % I_FI, kb = q / 176, nb = q % 176, n0 = nb * 32;
            const int pn = n0 >> 8, rr = n0 & 255, bj = rr >> 7, ii = rr & 127;
            tr_item(a.in[I_FWIN] + (size_t)l * 1024 * 5632, 5632, bj * DFF + pn * 128 + ii, kb * 64, a.in[I_FNORM] + l * 1024, (bf16_t*)(ws + WS_WFFI + l * WFFI_BYTES), 1024, n0, scr, lane); continue; } r -= 2 * I_FI;
        if (r < 2 * I_FO) { const int l = r / I_FO, q = r % I_FO, kb = q / 32, nb = q % 32;
            tr_item(a.in[I_FWOUT] + (size_t)l * DFF * 1024, 1024, nb * 32, kb * 64, nullptr, (bf16_t*)(ws + WS_WFFO + l * WFFO_BYTES), DFF, nb * 32, scr, lane); continue; } r -= 2 * I_FO;
        if (r < 2 * I_G) { const int l = r / I_G, q = r % I_G, kb = q / 32, nb = q % 32;
            tr_item(a.in[I_PWGATE] + (size_t)l * 1024 * 1024, 1024, nb * 32, kb * 64, a.in[I_PNORM] + l * 1024, (bf16_t*)(ws + WS_WGATE + l * WGATE_BYTES), 1024, nb * 32, scr, lane); continue; } r -= 2 * I_G;
        if (r < 2 * I_P) { const int l = r / I_P, q = r % I_P, kb = q / 32, nb = q % 32;
            tr_item(a.in[I_PWPROJ] + (size_t)l * 256 * 1024, 1024, nb * 32, kb * 64, nullptr, (bf16_t*)(ws + WS_WPROJ + l * WPROJ_BYTES), 256, nb * 32, scr, lane); continue; } r -= 2 * I_P;
        { const int gq = r / 32, q = r % 32, kb = q / 8, nb = q % 8;
            tr_item(a.in[I_POOLW] + (size_t)gq * 65536, 256, nb * 32, kb * 64, nullptr, (bf16_t*)(ws + WS_WPOOL), 256, gq * 256 + nb * 32, scr, lane); }
    }
    bf16_t* pbf = (bf16_t*)(ws + WS_PBF);
    for (int it0 = gw * 4; it0 < 2 * MT; it0 += NGW * 4) {
        f32x4 v[4];
#pragma unroll
        for (int rr = 0; rr < 4; ++rr) { const int it = it0 + rr; const int l = it / MT, row = it % MT;
            const float* src = row < SEQ ? a.in[I_PP] + ((size_t)l * SEQ + row) * PLE : ((row >= SROW && row < SROW + NS) ? a.in[I_PS] + ((size_t)l * NS + (row - SROW)) * PLE : nullptr);
            v[rr] = (f32x4){0.f, 0.f, 0.f, 0.f}; if (src) v[rr] = __builtin_nontemporal_load((const f32x4*)(src + lane * 4)); }
#pragma unroll
        for (int rr = 0; rr < 4; ++rr) { u32x2 w; w.x = cvt_pk_bf16(v[rr][0], v[rr][1]); w.y = cvt_pk_bf16(v[rr][2], v[rr][3]);
            *(u32x2*)(pbf + (size_t)(it0 + rr) * PLE + lane * 4) = w; }
    }
}

__device__ __forceinline__ int crow(int i, int hh) { return (i & 3) + 8 * (i >> 2) + 4 * hh; }
template <bool OUT>
__device__ __forceinline__ void gla_item_m(const KArgs& a, LAS unsigned char* lds, int item) {
    const int tid = otid(), lane = tid & 63, wave = __builtin_amdgcn_readfirstlane(tid >> 6);
    const int sc = item >> 2, h = item & 3;
    const bf16_t* proj = (const bf16_t*)(a.ws + WS_BIG); const float* la = (const float*)(a.ws + WS_BIG + BIG_LA);
    bf16_t* mix = (bf16_t*)(a.ws + WS_R1);
    float* US = (float*)(a.ws + WS_R2 + 4096); float* DS = US + (size_t)64 * 4 * 64 * 128;
    LAS float* bL = (LAS float*)lds; LAS float* segS = (LAS float*)(lds + 16384);
    LAS bf16_t* Qn = (LAS bf16_t*)(lds + 18432); LAS bf16_t* Kn = (LAS bf16_t*)(lds + 27648); LAS bf16_t* KT = (LAS bf16_t*)(lds + 36864);
    LAS bf16_t* VT = (LAS bf16_t*)(lds + 46080); LAS bf16_t* ST = (LAS bf16_t*)(lds + 64512); LAS float* red = (LAS float*)(lds + 82944);
    const int r = lane & 31, hh = lane >> 5;
    const int dkt = wave & 1, dvt = wave >> 1, it = wave & 1;
    f32x16 S = {};
    float* usp = US + ((size_t)(sc * 4 + h) * 64 + 32 * dkt) * 128 + 32 * dvt + r;
    if (OUT) {
#pragma unroll
        for (int i = 0; i < 16; ++i) S[i] = usp[(size_t)crow(i, hh) * 128];
    }
    float bsum = 0.f;
#pragma unroll 1
    for (int c = 0; c < 4; ++c) {
        const int T0 = sc * 256 + c * 64;
        if (OUT) {
#pragma unroll
            for (int q = 0; q < 4; ++q) { u32x2 w; w.x = cvt_pk_bf16(S[4 * q], S[4 * q + 1]); w.y = cvt_pk_bf16(S[4 * q + 2], S[4 * q + 3]);
                *(LAS u32x2*)(ST + (32 * dvt + r) * 72 + 32 * dkt + 8 * q + 4 * hh) = w; }
        }
        {
            const int dk = tid & 63, seg = tid >> 6;
            float v[8];
#pragma unroll
            for (int i = 0; i < 8; ++i) v[i] = la[(size_t)(T0 + 8 * seg + i) * 256 + h * 64 + dk];
#pragma unroll
            for (int i = 1; i < 8; ++i) v[i] += v[i - 1];
            segS[seg * 64 + dk] = v[7];
            __syncthreads();
            float off = 0.f;
#pragma unroll
            for (int s = 0; s < 8; ++s) { const float x = segS[s * 64 + dk]; off += (s < seg) ? x : 0.f; }
#pragma unroll
            for (int i = 0; i < 8; ++i) bL[(8 * seg + i) * 64 + dk] = v[i] + off;
            __syncthreads();
        }
        {
            const int t = tid >> 3, d8 = (tid & 7) * 8;
            const f32x4 b0 = *(const LAS f32x4*)(bL + t * 64 + d8), b1 = *(const LAS f32x4*)(bL + t * 64 + d8 + 4);
            const f32x4 l0 = *(const LAS f32x4*)(bL + 63 * 64 + d8), l1 = *(const LAS f32x4*)(bL + 63 * 64 + d8 + 4);
            float bb[8] = {b0[0], b0[1], b0[2], b0[3], b1[0], b1[1], b1[2], b1[3]}, bl[8] = {l0[0], l0[1], l0[2], l0[3], l1[0], l1[1], l1[2], l1[3]};
            const size_t prow = (size_t)(T0 + t) * NPROJ;
            float kf[8]; { const u32x4 kw = *(const u32x4*)(proj + prow + PKA + h * 64 + d8); unpack8(kw, kf); }
#pragma unroll
            for (int j = 0; j < 8; ++j) KT[(d8 + j) * 72 + t] = (bf16_t)(cvt_pk_bf16(kf[j] * __expf(bl[j] - bb[j]), 0.f) & 0xffffu);
            if (OUT) {
                float qf[8]; { const u32x4 qw = *(const u32x4*)(proj + prow + PQA + h * 64 + d8); unpack8(qw, qf); }
                float qq[8], kk[8];
#pragma unroll
                for (int j = 0; j < 8; ++j) { const float e = __expf(bb[j]); qq[j] = qf[j] * 0.125f * e; kk[j] = kf[j] * __expf(-bb[j]); }
                u32x4 w; w.x = cvt_pk_bf16(qq[0], qq[1]); w.y = cvt_pk_bf16(qq[2], qq[3]); w.z = cvt_pk_bf16(qq[4], qq[5]); w.w = cvt_pk_bf16(qq[6], qq[7]);
                *(LAS u32x4*)(Qn + t * 72 + d8) = w;
                w.x = cvt_pk_bf16(kk[0], kk[1]); w.y = cvt_pk_bf16(kk[2], kk[3]); w.z = cvt_pk_bf16(kk[4], kk[5]); w.w = cvt_pk_bf16(kk[6], kk[7]);
                *(LAS u32x4*)(Kn + t * 72 + d8) = w;
            }
#pragma unroll
            for (int i = 0; i < 2; ++i) { const int dv8 = d8 + 64 * i;
                const u32x4 vw = *(const u32x4*)(proj + prow + PVA + h * 128 + dv8);
                LAS bf16_t* vt = VT + dv8 * 72 + t;
                vt[0 * 72] = (bf16_t)(vw.x & 0xffffu); vt[1 * 72] = (bf16_t)(vw.x >> 16); vt[2 * 72] = (bf16_t)(vw.y & 0xffffu); vt[3 * 72] = (bf16_t)(vw.y >> 16);
                vt[4 * 72] = (bf16_t)(vw.z & 0xffffu); vt[5 * 72] = (bf16_t)(vw.z >> 16); vt[6 * 72] = (bf16_t)(vw.w & 0xffffu); vt[7 * 72] = (bf16_t)(vw.w >> 16); }
            if (tid < 64) bsum += bL[63 * 64 + tid];
        }
        __syncthreads();
        if (OUT) {
            bf16x8 qf[4];
#pragma unroll
            for (int s = 0; s < 4; ++s) qf[s] = *(const LAS bf16x8*)(Qn + (32 * it + r) * 72 + 16 * s + 8 * hh);
            f32x16 oacc = {};
#pragma unroll
            for (int jt = 0; jt < 2; ++jt) {
                if (jt <= it) {
                    f32x16 at = {};
#pragma unroll
                    for (int s = 0; s < 4; ++s) { const bf16x8 af = *(const LAS bf16x8*)(Kn + (32 * jt + r) * 72 + 16 * s + 8 * hh); at = __builtin_amdgcn_mfma_f32_32x32x16_bf16(af, qf[s], at, 0, 0, 0); }
                    if (jt == it) {
#pragma unroll
                        for (int i = 0; i < 16; ++i) if (crow(i, hh) > r) at[i] = 0.f;
                    }
#pragma unroll
                    for (int s2 = 0; s2 < 2; ++s2) {
                        u32x4 pw; pw.x = cvt_pk_bf16(at[8 * s2 + 0], at[8 * s2 + 1]); pw.y = cvt_pk_bf16(at[8 * s2 + 2], at[8 * s2 + 3]);
                        pw.z = cvt_pk_bf16(at[8 * s2 + 4], at[8 * s2 + 5]); pw.w = cvt_pk_bf16(at[8 * s2 + 6], at[8 * s2 + 7]);
                        const LAS bf16_t* vp = VT + (32 * dvt + r) * 72 + 32 * jt + 16 * s2 + 4 * hh;
                        const u32x2 v0 = *(const LAS u32x2*)vp, v1 = *(const LAS u32x2*)(vp + 8);
                        const u32x4 vv = (u32x4){v0.x, v0.y, v1.x, v1.y};
                        oacc = __builtin_amdgcn_mfma_f32_32x32x16_bf16(__builtin_bit_cast(bf16x8, vv), __builtin_bit_cast(bf16x8, pw), oacc, 0, 0, 0);
                    }
                }
            }
#pragma unroll
            for (int s = 0; s < 4; ++s) { const bf16x8 af = *(const LAS bf16x8*)(ST + (32 * dvt + r) * 72 + 16 * s + 8 * hh); oacc = __builtin_amdgcn_mfma_f32_32x32x16_bf16(af, qf[s], oacc, 0, 0, 0); }
            float ss = 0.f;
#pragma unroll
            for (int i = 0; i < 16; ++i) ss += oacc[i] * oacc[i];
            ss += __shfl_xor(ss, 32);
            if (hh == 0) red[wave * 32 + r] = ss;
            __syncthreads();
            const float tot = (red[it * 32 + r] + red[(it + 2) * 32 + r]) + (red[(it + 4) * 32 + r] + red[(it + 6) * 32 + r]);
            const float rstd = rsqrtf(tot * (1.0f / 128.f) + EPS);
            const int t = T0 + 32 * it + r;
#pragma unroll
            for (int q = 0; q < 4; ++q) {
                const int dv0 = 32 * dvt + 8 * q + 4 * hh;
                const u32x2 rw = *(const u32x2*)(proj + (size_t)t * NPROJ + PRA + h * 128 + dv0);
                const f32x4 on = *(const f32x4*)(a.in[I_ONORM] + dv0);
                const float r0 = bf_lo(rw.x), r1 = bf_hi(rw.x), r2 = bf_lo(rw.y), r3 = bf_hi(rw.y);
                const float y0 = oacc[4 * q] * rstd * on[0] * (r0 / (1.f + __expf(-r0))), y1 = oacc[4 * q + 1] * rstd * on[1] * (r1 / (1.f + __expf(-r1)));
                const float y2 = oacc[4 * q + 2] * rstd * on[2] * (r2 / (1.f + __expf(-r2))), y3 = oacc[4 * q + 3] * rstd * on[3] * (r3 / (1.f + __expf(-r3)));
                u32x2 w; w.x = cvt_pk_bf16(y0, y1); w.y = cvt_pk_bf16(y2, y3);
                *(u32x2*)(mix + (size_t)t * D + h * 128 + dv0) = w;
            }
        }
#pragma unroll
        for (int i = 0; i < 16; ++i) S[i] *= __expf(bL[63 * 64 + 32 * dkt + crow(i, hh)]);
#pragma unroll
        for (int s = 0; s < 4; ++s) {
            const bf16x8 af = *(const LAS bf16x8*)(KT + (32 * dkt + r) * 72 + 16 * s + 8 * hh), bf = *(const LAS bf16x8*)(VT + (32 * dvt + r) * 72 + 16 * s + 8 * hh);
            S = __builtin_amdgcn_mfma_f32_32x32x16_bf16(af, bf, S, 0, 0, 0);
        }
        __syncthreads();
    }
    if (!OUT) {
#pragma unroll
        for (int i = 0; i < 16; ++i) usp[(size_t)crow(i, hh) * 128] = S[i];
        if (tid < 64) DS[(sc * 4 + h) * 64 + tid] = __expf(bsum);
    }
}
__device__ __forceinline__ void gla_scan_m(const KArgs& a, int vcu) {
    const int tid = otid(); if (tid >= 128) return;
    const int e = vcu * 128 + tid; if (e >= 32768) return;
    float* US = (float*)(a.ws + WS_R2 + 4096); const float* DS = US + (size_t)64 * 4 * 64 * 128;
    const int hd = e >> 7;
    float S = 0.f;
    for (int c0 = 0; c0 < 64; c0 += 8) {
        float u[8], d[8];
#pragma unroll
        for (int j = 0; j < 8; ++j) { u[j] = US[(size_t)(c0 + j) * 32768 + e]; d[j] = DS[(c0 + j) * 256 + hd]; }
#pragma unroll
        for (int j = 0; j < 8; ++j) { US[(size_t)(c0 + j) * 32768 + e] = S; S = d[j] * S + u[j]; }
    }
    a.out[O_GLAP + e] = S;
}
__device__ __forceinline__ void gla_decode_item(const KArgs& a, int item, int lane) {
    const int b = item >> 2, h = item & 3; const int row = SROW + b;
    const bf16_t* proj = (const bf16_t*)(a.ws + WS_BIG); const float* la = (const float*)(a.ws + WS_BIG + BIG_LA);
    bf16_t* mix = (bf16_t*)(a.ws + WS_R1);
    const float* S0 = a.in[I_SGLA] + ((size_t)b * 4 + h) * 8192;
    float* S1 = a.out + O_GLAS + ((size_t)b * 4 + h) * 8192;
    const float qv = bf2f(proj[(size_t)row * NPROJ + PQA + h * 64 + lane]) * 0.125f;
    const float kv = bf2f(proj[(size_t)row * NPROJ + PKA + h * 64 + lane]);
    const float av = __expf(la[(size_t)row * 256 + h * 64 + lane]);
    const unsigned vw = *(const unsigned*)(proj + (size_t)row * NPROJ + PVA + h * 128 + lane * 2);
    const float v0 = bf_lo(vw), v1 = bf_hi(vw);
    float o0 = 0.f, o1 = 0.f;
#pragma unroll 1
    for (int d0 = 0; d0 < 64; d0 += 16) {
        f32x2 sv[16];
#pragma unroll
        for (int j = 0; j < 16; ++j) sv[j] = __builtin_nontemporal_load((const f32x2*)(S0 + (d0 + j) * 128 + lane * 2));
#pragma unroll
        for (int j = 0; j < 16; ++j) {
            const int dk = d0 + j;
            const float q = __shfl(qv, dk), k = __shfl(kv, dk), al = __shfl(av, dk);
            const float n0 = al * sv[j].x + k * v0, n1 = al * sv[j].y + k * v1;
            __builtin_nontemporal_store((f32x2){n0, n1}, (f32x2*)(S1 + dk * 128 + lane * 2));
            o0 += q * n0; o1 += q * n1;
        }
    }
    const float ss = wave_sum(o0 * o0 + o1 * o1);
    const float rstd = rsqrtf(ss * (1.0f / 128.f) + EPS);
    const unsigned rw = *(const unsigned*)(proj + (size_t)row * NPROJ + PRA + h * 128 + lane * 2);
    const float r0 = bf_lo(rw), r1 = bf_hi(rw);
    const float y0 = o0 * rstd * a.in[I_ONORM][lane * 2] * (r0 / (1.f + __expf(-r0))), y1 = o1 * rstd * a.in[I_ONORM][lane * 2 + 1] * (r1 / (1.f + __expf(-r1)));
    *(unsigned*)(mix + (size_t)row * D + h * 128 + lane * 2) = cvt_pk_bf16(y0, y1);
}

__device__ __forceinline__ void swa_unit_m(const KArgs& a, LAS unsigned char* lds, int unit) {
    const int tid = otid(), lane = tid & 63, wave = __builtin_amdgcn_readfirstlane(tid >> 6);
    const int qb = unit >> 1, kvh = unit & 1; const int q0 = qb * 64, w0 = q0 - 128;
    const bf16_t* proj = (const bf16_t*)(a.ws + WS_BIG);
    bf16_t* mix = (bf16_t*)(a.ws + WS_R1);
    LAS bf16_t* Kl = (LAS bf16_t*)lds;
    LAS bf16_t* Vt = Kl + 192 * 72;
    const float* kn = a.in[I_KNORM];
#pragma unroll 1
    for (int c = tid; c < 1536; c += NTHREADS) {
        const int kk = c >> 3, part = c & 7; const int tk = w0 + kk;
        float kf[8];
        u32x4 vw = (u32x4){0u, 0u, 0u, 0u};
#pragma unroll
        for (int j = 0; j < 8; ++j) kf[j] = 0.f;
        if (tk >= 0) {
            const u32x4 kw = *(const u32x4*)(proj + (size_t)tk * NPROJ + PKB + kvh * 64 + part * 8); unpack8(kw, kf);
            vw = *(const u32x4*)(proj + (size_t)tk * NPROJ + PVB + kvh * 64 + part * 8);
        }
        float ss = 0.f;
#pragma unroll
        for (int j = 0; j < 8; ++j) ss += kf[j] * kf[j];
        ss += __shfl_xor(ss, 1); ss += __shfl_xor(ss, 2); ss += __shfl_xor(ss, 4);
        const float rstd = rsqrtf(ss * (1.0f / 64.f) + EPS);
#pragma unroll
        for (int j = 0; j < 8; ++j) kf[j] = kf[j] * rstd * kn[part * 8 + j];
        u32x4 kw2; kw2.x = cvt_pk_bf16(kf[0], kf[1]); kw2.y = cvt_pk_bf16(kf[2], kf[3]); kw2.z = cvt_pk_bf16(kf[4], kf[5]); kw2.w = cvt_pk_bf16(kf[6], kf[7]);
        *(LAS u32x4*)(Kl + kk * 72 + part * 8) = kw2;
        LAS bf16_t* vt = Vt + (part * 8) * 196 + kk;
        vt[0 * 196] = (bf16_t)(vw.x & 0xffffu); vt[1 * 196] = (bf16_t)(vw.x >> 16); vt[2 * 196] = (bf16_t)(vw.y & 0xffffu); vt[3 * 196] = (bf16_t)(vw.y >> 16);
        vt[4 * 196] = (bf16_t)(vw.z & 0xffffu); vt[5 * 196] = (bf16_t)(vw.z >> 16); vt[6 * 196] = (bf16_t)(vw.w & 0xffffu); vt[7 * 196] = (bf16_t)(vw.w >> 16);
        if (qb == 255 && kk >= 64) {
            const int w = kk - 64;
            float vf[8]; unpack8(vw, vf);
            float* ko = a.out + O_SKP + ((size_t)w * 2 + kvh) * 64 + part * 8; float* vo = a.out + O_SVP + ((size_t)w * 2 + kvh) * 64 + part * 8;
            *(f32x4*)ko = (f32x4){kf[0], kf[1], kf[2], kf[3]}; *(f32x4*)(ko + 4) = (f32x4){kf[4], kf[5], kf[6], kf[7]};
            *(f32x4*)vo = (f32x4){vf[0], vf[1], vf[2], vf[3]}; *(f32x4*)(vo + 4) = (f32x4){vf[4], vf[5], vf[6], vf[7]};
        }
    }
    __syncthreads();
    const int g = wave & 3, th = wave >> 2, hq = kvh * 4 + g;
    const int r = lane & 31, hh = lane >> 5;
    const int t = q0 + 32 * th + r;
    constexpr float LOG2E = 1.4426950408889634f;
    bf16x8 qf[4];
    {
        float qv[4][8]; float ss = 0.f;
#pragma unroll
        for (int s = 0; s < 4; ++s) { const u32x4 w = *(const u32x4*)(proj + (size_t)t * NPROJ + PQB + hq * 64 + 16 * s + 8 * hh); unpack8(w, qv[s]);
#pragma unroll
            for (int j = 0; j < 8; ++j) ss += qv[s][j] * qv[s][j]; }
        ss += __shfl_xor(ss, 32);
        const float rstd = rsqrtf(ss * (1.0f / 64.f) + EPS) * (0.125f * LOG2E);
        const float* qn = a.in[I_QNORM];
#pragma unroll
        for (int s = 0; s < 4; ++s) {
            u32x4 w;
            w.x = cvt_pk_bf16(qv[s][0] * rstd * qn[16 * s + 8 * hh + 0], qv[s][1] * rstd * qn[16 * s + 8 * hh + 1]);
            w.y = cvt_pk_bf16(qv[s][2] * rstd * qn[16 * s + 8 * hh + 2], qv[s][3] * rstd * qn[16 * s + 8 * hh + 3]);
            w.z = cvt_pk_bf16(qv[s][4] * rstd * qn[16 * s + 8 * hh + 4], qv[s][5] * rstd * qn[16 * s + 8 * hh + 5]);
            w.w = cvt_pk_bf16(qv[s][6] * rstd * qn[16 * s + 8 * hh + 6], qv[s][7] * rstd * qn[16 * s + 8 * hh + 7]);
            qf[s] = __builtin_bit_cast(bf16x8, w);
        }
    }
    f32x16 sacc[5];
#pragma unroll
    for (int k5 = 0; k5 < 5; ++k5) {
        const int kt = th + k5;
        f32x16 acc = {};
#pragma unroll
        for (int s = 0; s < 4; ++s) { const bf16x8 af = *(const LAS bf16x8*)(Kl + (kt * 32 + r) * 72 + 16 * s + 8 * hh); acc = __builtin_amdgcn_mfma_f32_32x32x16_bf16(af, qf[s], acc, 0, 0, 0); }
        sacc[k5] = acc;
    }
    const float slope2 = exp2f(-(float)(hq + 1)) * LOG2E;
    const float sink2 = a.in[I_SINKS][hq] * LOG2E;
    float mx = sink2;
#pragma unroll
    for (int k5 = 0; k5 < 5; ++k5)
#pragma unroll
        for (int i = 0; i < 16; ++i) {
            const int row = (i & 3) + 8 * (i >> 2) + 4 * hh;
            const int dist = 128 - 32 * k5 + r - row;
            const int tk = w0 + 32 * (th + k5) + row;
            float s = sacc[k5][i] - slope2 * (float)dist;
            if (dist < 0 || dist >= 128 || tk < 0) s = -1e30f;
            sacc[k5][i] = s; mx = fmaxf(mx, s);
        }
    mx = fmaxf(mx, __shfl_xor(mx, 32));
    float l = 0.f;
#pragma unroll
    for (int k5 = 0; k5 < 5; ++k5)
#pragma unroll
        for (int i = 0; i < 16; ++i) { const float p = exp2f(sacc[k5][i] - mx); sacc[k5][i] = p; l += p; }
    l += __shfl_xor(l, 32);
    l += exp2f(sink2 - mx);
    f32x16 oacc[2] = {{}, {}};
#pragma unroll
    for (int k5 = 0; k5 < 5; ++k5) {
        const int kt = th + k5;
#pragma unroll
        for (int s2 = 0; s2 < 2; ++s2) {
            u32x4 pw;
            pw.x = cvt_pk_bf16(sacc[k5][8 * s2 + 0], sacc[k5][8 * s2 + 1]); pw.y = cvt_pk_bf16(sacc[k5][8 * s2 + 2], sacc[k5][8 * s2 + 3]);
            pw.z = cvt_pk_bf16(sacc[k5][8 * s2 + 4], sacc[k5][8 * s2 + 5]); pw.w = cvt_pk_bf16(sacc[k5][8 * s2 + 6], sacc[k5][8 * s2 + 7]);
            const bf16x8 pf = __builtin_bit_cast(bf16x8, pw);
#pragma unroll
            for (int dt = 0; dt < 2; ++dt) {
                const LAS bf16_t* vp = Vt + (32 * dt + r) * 196 + kt * 32 + 16 * s2 + 4 * hh;
                const u32x2 v0 = *(const LAS u32x2*)vp, v1 = *(const LAS u32x2*)(vp + 8);
                const u32x4 vv = (u32x4){v0.x, v0.y, v1.x, v1.y};
                oacc[dt] = __builtin_amdgcn_mfma_f32_32x32x16_bf16(__builtin_bit_cast(bf16x8, vv), pf, oacc[dt], 0, 0, 0);
            }
        }
    }
    const float inv = 1.f / l;
#pragma unroll
    for (int dt = 0; dt < 2; ++dt)
#pragma unroll
        for (int q = 0; q < 4; ++q) {
            u32x2 w; w.x = cvt_pk_bf16(oacc[dt][4 * q] * inv, oacc[dt][4 * q + 1] * inv); w.y = cvt_pk_bf16(oacc[dt][4 * q + 2] * inv, oacc[dt][4 * q + 3] * inv);
            *(u32x2*)(mix + (size_t)t * D + 512 + hq * 64 + 32 * dt + 8 * q + 4 * hh) = w;
        }
    __syncthreads();
}
__device__ __forceinline__ void swa_decode_item(const KArgs& a, int item, int lane) {
    const int b = item >> 3, kvh = (item >> 2) & 1, g = item & 3, hq = kvh * 4 + g; const int row = SROW + b;
    const bf16_t* proj = (const bf16_t*)(a.ws + WS_BIG);
    bf16_t* mix = (bf16_t*)(a.ws + WS_R1);
    const float* ck = a.in[I_CK] + (size_t)b * 128 * 128 + kvh * 64;
    const float* cv = a.in[I_CV] + (size_t)b * 128 * 128 + kvh * 64;
    float qd = bf2f(proj[(size_t)row * NPROJ + PQB + hq * 64 + lane]);
    { const float ss = wave_sum(qd * qd); qd = qd * rsqrtf(ss * (1.0f / 64.f) + EPS) * a.in[I_QNORM][lane] * 0.125f; }
    float kd = bf2f(proj[(size_t)row * NPROJ + PKB + kvh * 64 + lane]);
    { const float ss = wave_sum(kd * kd); kd = kd * rsqrtf(ss * (1.0f / 64.f) + EPS) * a.in[I_KNORM][lane]; }
    const float vd = bf2f(proj[(size_t)row * NPROJ + PVB + kvh * 64 + lane]);
    const float slope = exp2f(-(float)(hq + 1));
    float s0 = 0.f, s1 = 0.f;
    for (int d = 0; d < 64; d += 4) {
        const f32x4 k0 = *(const f32x4*)(ck + (size_t)lane * 128 + d), k1 = *(const f32x4*)(ck + (size_t)(lane + 64) * 128 + d);
        const float q0 = __shfl(qd, d), q1 = __shfl(qd, d + 1), q2 = __shfl(qd, d + 2), q3 = __shfl(qd, d + 3);
        s0 += (q0 * k0[0] + q1 * k0[1]) + (q2 * k0[2] + q3 * k0[3]);
        s1 += (q0 * k1[0] + q1 * k1[1]) + (q2 * k1[2] + q3 * k1[3]);
    }
    s0 -= slope * (float)(128 - lane); s1 -= slope * (float)(64 - lane);
    if (lane == 0) s0 = -1e30f;
    const float sn = wave_sum(qd * kd);
    const float sink = a.in[I_SINKS][hq];
    const float mx = fmaxf(fmaxf(wave_max(fmaxf(s0, s1)), sn), sink);
    const float p0 = __expf(s0 - mx), p1 = __expf(s1 - mx), pn = __expf(sn - mx);
    const float l = wave_sum(p0 + p1) + pn + __expf(sink - mx);
    float od = pn * vd;
#pragma unroll 1
    for (int w0 = 0; w0 < 64; w0 += 16) {
        float ca[16], cb[16];
#pragma unroll
        for (int j = 0; j < 16; ++j) { ca[j] = cv[(size_t)(w0 + j) * 128 + lane]; cb[j] = cv[(size_t)(w0 + j + 64) * 128 + lane]; }
#pragma unroll
        for (int j = 0; j < 16; ++j) { const float pa = __shfl(p0, w0 + j), pb = __shfl(p1, w0 + j); od += pa * ca[j] + pb * cb[j]; }
    }
    od /= l;
    const float oo = __shfl_down(od, 1);
    if ((lane & 1) == 0) *(unsigned*)(mix + (size_t)row * D + 512 + hq * 64 + lane) = cvt_pk_bf16(od, oo);
    if (g == 0) {
        float* __restrict__ ko = a.out + O_SKS + (size_t)b * 128 * 128 + kvh * 64; float* __restrict__ vo = a.out + O_SVS + (size_t)b * 128 * 128 + kvh * 64;
#pragma unroll 1
        for (int w0 = 0; w0 < 128; w0 += 16) {
            float ka[16], va[16];
#pragma unroll
            for (int j = 0; j < 16; ++j) { const int w = w0 + j + 1; ka[j] = (w < 128) ? ck[(size_t)w * 128 + lane] : kd; va[j] = (w < 128) ? cv[(size_t)w * 128 + lane] : vd; }
#pragma unroll
            for (int j = 0; j < 16; ++j) { ko[(size_t)(w0 + j) * 128 + lane] = ka[j]; vo[(size_t)(w0 + j) * 128 + lane] = va[j]; }
        }
    }
}

template <int W>
__device__ __forceinline__ void pool_core(const bf16_t* __restrict__ h, const LAS float* rsL, float gg, int r0, int c, bf16_t* __restrict__ d1, float* __restrict__ poolp) {
    float xn[31];
#pragma unroll
    for (int i = 0; i < 31; ++i) { const int r = r0 - 15 + i; xn[i] = (i >= 16 - W && r >= 0) ? bf2f(h[(size_t)r * D + c]) : 0.f; }
#pragma unroll
    for (int i = 0; i < 31; ++i) xn[i] *= rsL[i] * gg;
    float s = 0.f;
#pragma unroll
    for (int j = 1; j < W; ++j) s += xn[15 - j];
#pragma unroll
    for (int i = 0; i < 16; ++i) {
        const int r = r0 + i;
        s += xn[15 + i];
        const int cnt = (r + 1 < W) ? r + 1 : W;
        const float dd = s / (float)cnt - xn[15 + i];
        d1[(size_t)r * D + c] = (bf16_t)(cvt_pk_bf16(dd, 0.f) & 0xffffu);
        s -= xn[15 + i - (W - 1)];
        if (r >= SEQ - 15) poolp[(size_t)(r - (SEQ - 15)) * D + c] = xn[15 + i];
    }
}
__device__ __forceinline__ void pool_item(const KArgs& a, LAS unsigned char* lds, int item, const float* part_in) {
    const int tid = otid();
    const bf16_t* h = (const bf16_t*)(a.ws + WS_R2 + 4096); bf16_t* d1 = (bf16_t*)(a.ws + WS_R1);
    LAS float* rsL = (LAS float*)lds;
    const int r0 = item * 16;
    __syncthreads();
    if (tid < 31) { const int r = r0 - 15 + tid; float rs = 0.f;
        if (r >= 0) { const f32x4 p0 = *(const f32x4*)(part_in + (long)r * 16), p1 = *(const f32x4*)(part_in + (long)r * 16 + 4), p2 = *(const f32x4*)(part_in + (long)r * 16 + 8), p3 = *(const f32x4*)(part_in + (long)r * 16 + 12);
            const float s = ((p0[0] + p0[1]) + (p0[2] + p0[3])) + ((p1[0] + p1[1]) + (p1[2] + p1[3])) + ((p2[0] + p2[1]) + (p2[2] + p2[3])) + ((p3[0] + p3[1]) + (p3[2] + p3[3]));
            rs = rsqrtf(s * (1.0f / D) + EPS); }
        rsL[tid] = rs; }
    __syncthreads();
#pragma unroll
    for (int cc = 0; cc < 2; ++cc) {
        const int c = tid + cc * NTHREADS; const int gq = __builtin_amdgcn_readfirstlane(c >> 8);
        const float gg = a.in[I_MNO][c];
        if (gq == 0) pool_core<2>(h, rsL, gg, r0, c, d1, a.out + O_POOLP);
        else if (gq == 1) pool_core<4>(h, rsL, gg, r0, c, d1, a.out + O_POOLP);
        else if (gq == 2) pool_core<8>(h, rsL, gg, r0, c, d1, a.out + O_POOLP);
        else pool_core<16>(h, rsL, gg, r0, c, d1, a.out + O_POOLP);
    }
}
__device__ __forceinline__ void pool_sample_item(const KArgs& a, LAS unsigned char* lds, int b, const float* part_in) {
    const int tid = otid();
    const bf16_t* __restrict__ h = (const bf16_t*)(a.ws + WS_R2 + 4096) + (size_t)(SROW + b) * D; bf16_t* __restrict__ d1 = (bf16_t*)(a.ws + WS_R1);
    const float* __restrict__ st = a.in[I_SPOOL] + (size_t)b * 15 * D; float* __restrict__ so = a.out + O_POOLS + (size_t)b * 15 * D;
    float s = 0.f;
#pragma unroll
    for (int i = 0; i < 16; ++i) s += part_in[(long)(SROW + b) * 16 + i];
    const float rs = rsqrtf(s * (1.0f / D) + EPS);
#pragma unroll
    for (int cc = 0; cc < 2; ++cc) {
        const int c = tid + cc * NTHREADS; const int w = 2 << (c >> 8);
        float sv[15];
#pragma unroll
        for (int j = 0; j < 15; ++j) sv[j] = st[(size_t)j * D + c];
        const float xn = bf2f(h[c]) * rs * a.in[I_MNO][c];
        float sum = xn;
#pragma unroll
        for (int j = 0; j < 15; ++j) sum += (j >= 16 - w) ? sv[j] : 0.f;
        const float dd = sum / (float)w - xn;
        d1[(size_t)(SROW + b) * D + c] = (bf16_t)(cvt_pk_bf16(dd, 0.f) & 0xffffu);
#pragma unroll
        for (int j = 0; j < 14; ++j) so[(size_t)j * D + c] = sv[j + 1];
        so[(size_t)14 * D + c] = xn;
    }
}

#define XB_TMO      128
#define XB_XCNT(j)  (256  + 64 * (j))
#define XB_XSUB(j)  (1280 + 64 * (j))
#define XB_XGEN(j)  (2304 + 64 * (j))
#define XB_TOP      3328
#define XB_TOPGEN   3392
#define XCD_BAR_WORDS 3456
#define XB_SPIN_CAP (1u << 18)
__device__ __forceinline__ unsigned xb_ld(unsigned* p)              { return __hip_atomic_load(p, __ATOMIC_RELAXED, __HIP_MEMORY_SCOPE_AGENT); }
__device__ __forceinline__ unsigned xb_add(unsigned* p, unsigned v) { return __hip_atomic_fetch_add(p, v, __ATOMIC_RELAXED, __HIP_MEMORY_SCOPE_AGENT); }
__device__ __forceinline__ unsigned xb_xcc_id() { return (unsigned)__builtin_amdgcn_s_getreg((3 << 11) | 20) & 0xFu; }
#define XB_SPIN(cond, bar) do { unsigned _sp = 0; while (cond) { __builtin_amdgcn_s_sleep(1); \
    if ((++_sp & 255u) == 0u) { if (xb_ld(&(bar)[XB_TMO])) break; if (_sp > XB_SPIN_CAP) { atomicAdd(&(bar)[XB_TMO], 1u); break; } } } } while (0)
struct XcdBarrier { unsigned* bar; unsigned x; volatile LAS unsigned* st; };
__device__ __forceinline__ XcdBarrier xcd_barrier_post(unsigned* bar, volatile LAS unsigned* st) {
    XcdBarrier b; b.bar = bar; b.x = xb_xcc_id(); b.st = st;
    if (threadIdx.x == 0) (void)xb_add(&bar[XB_XCNT(b.x)], 1u);
    return b;
}
__device__ __forceinline__ void xcd_barrier_complete(unsigned* bar, unsigned x, unsigned& nloc, unsigned& nx) {
    const unsigned G = gridDim.x * gridDim.y * gridDim.z;
    unsigned sum, cnt, mine, sp = 0u;
    for (;;) {
        sum = 0u; cnt = 0u; mine = 0u;
#pragma unroll
        for (unsigned j = 0; j < 16; ++j) { const unsigned c = xb_ld(&bar[XB_XCNT(j)]); sum += c; cnt += (c > 0u) ? 1u : 0u; mine = (j == x) ? c : mine; }
        if (sum == G) break;
        __builtin_amdgcn_s_sleep(1);
        if ((++sp & 255u) == 0u) { if (xb_ld(&bar[XB_TMO])) break; if (sp > XB_SPIN_CAP) { atomicAdd(&bar[XB_TMO], 1u); break; } }
    }
    nloc = mine > 0u ? mine : 1u; nx = cnt > 0u ? cnt : 1u;
}
__device__ __forceinline__ void xcd_barrier(const XcdBarrier& b) {
    asm volatile("s_waitcnt vmcnt(0)" ::: "memory");
    __syncthreads();
    if (threadIdx.x == 0) {
        unsigned* bar = b.bar;
        __builtin_amdgcn_s_waitcnt(0);
        unsigned nloc = b.st[0], nx = b.st[1];
        if (nloc == 0u) { xcd_barrier_complete(bar, b.x, nloc, nx); b.st[0] = nloc; b.st[1] = nx; }
        const unsigned old = xb_add(&bar[XB_XSUB(b.x)], 1u);
        const unsigned gen = old / nloc;
        if (old + 1u == (gen + 1u) * nloc) {
            __builtin_amdgcn_fence(__ATOMIC_RELEASE, "agent");
            asm volatile("s_waitcnt vmcnt(0)" ::: "memory");
            const unsigned og = xb_add(&bar[XB_TOP], 1u);
            const unsigned tg = og / nx;
            if (og + 1u == (tg + 1u) * nx) xb_add(&bar[XB_TOPGEN], 1u);
            else XB_SPIN(xb_ld(&bar[XB_TOPGEN]) == tg, bar);
            __builtin_amdgcn_fence(__ATOMIC_ACQUIRE, "agent");
            xb_add(&bar[XB_XGEN(b.x)], 1u);
            asm volatile("s_waitcnt vmcnt(0)" ::: "memory");
        } else {
            XB_SPIN(xb_ld(&bar[XB_XGEN(b.x)]) == gen, bar);
            __builtin_amdgcn_fence(__ATOMIC_ACQUIRE, "agent");
            asm volatile("s_waitcnt vmcnt(0)" ::: "memory");
        }
    }
    __syncthreads();
}

#ifndef DUPM
#define DUPM 0
#endif
#ifndef SYNCREP
#define SYNCREP 1
#endif
#define GSYNC() do { _Pragma("unroll 1") for (int sr_ = 0; sr_ < SYNCREP; ++sr_) xcd_barrier(xbar); } while (0)
#define PH(k) _Pragma("unroll 1") for (int rep_ = 0; rep_ < (((DUPM) >> (k)) & 1) + 1; ++rep_)
__global__ void __launch_bounds__(NTHREADS, 2) mega_fwd(KArgs a) {
    extern __shared__ __attribute__((aligned(16))) unsigned char lds_raw[];
    LAS unsigned char* lds = (LAS unsigned char*)lds_raw;
    cg::grid_group grid = cg::this_grid();
    const int G = gridDim.x, bx = blockIdx.x;
    const int vcu = (G % 8 == 0) ? (bx % 8) * (G / 8) + bx / 8 : bx;
    unsigned char* ws = a.ws;
    if (ws == nullptr) grid.sync();
    volatile LAS unsigned* xst = (volatile LAS unsigned*)(lds + LDS_BYTES - 64);
    if (threadIdx.x < 16) xst[threadIdx.x] = 0u;
    __syncthreads();
    const XcdBarrier xbar = xcd_barrier_post((unsigned*)(ws + 16384), xst);
    bf16_t* R1 = (bf16_t*)(ws + WS_R1); bf16_t* R2 = (bf16_t*)(ws + WS_R2 + 4096);
    bf16_t* BIGB = (bf16_t*)(ws + WS_BIG);
    const bf16_t* pbf = (const bf16_t*)(ws + WS_PBF);

    PH(0) p0_prologue(a, lds, vcu, G);
    GSYNC();
    PH(1) {
        pg8::Gemm g{R1, (const bf16_t*)(ws + WS_WIN0), 1024, 1024, 1024, 256, 0, 0};
        pg8::StaticOrder S; S.init(64, 10, G, bx);
        EpiProj E{BIGB, (float*)(ws + WS_BIG + BIG_LA), (const float*)(ws + WS_SSQ), a.in[I_BALPHA]};
        pg8::gemm_phase(lds, g, S, E);
        s_proj_units(a, lds, (bx - (640 % G) + G) % G, G);
    }
    GSYNC();
    PH(2) for (int it = vcu; it < 256; it += G) gla_item_m<false>(a, lds, it);
    PH(3) for (int it = vcu; it < 512; it += G) swa_unit_m(a, lds, it);
    PH(4) { const int tid = otid(), lane = tid & 63, wave = __builtin_amdgcn_readfirstlane(tid >> 6); for (int it = vcu * 8 + wave; it < 512; it += G * 8) gla_decode_item(a, it, lane); }
    PH(5) { const int tid = otid(), lane = tid & 63, wave = __builtin_amdgcn_readfirstlane(tid >> 6); for (int it = vcu * 8 + wave; it < 1024; it += G * 8) swa_decode_item(a, it, lane); }
    GSYNC();
    PH(6) { gla_scan_m(a, vcu); p3_convert(a, lds, vcu, G); }
    GSYNC();
    PH(7) for (int it = vcu; it < 256; it += G) gla_item_m<true>(a, lds, it);
    GSYNC();
    PH(8) {
        pg8::Gemm g{R1, (const bf16_t*)(ws + WS_WOUT0), 1024, 1024, 1024, 256, 0, 0};
        pg8::StaticOrder S; S.init(64, 4, G, bx);
        EpiRes<0, true, true, false> E{a.out, a.in[I_XP], nullptr, R2, part_tab(ws, 0), nullptr, nullptr, nullptr};
        pg8::gemm_phase(lds, g, S, E);
        s_res_units<0, 1024, 1024>(a, lds, bx, G, R1, (const bf16_t*)(ws + WS_WOUT0), nullptr, R2, part_tab(ws, 0));
    }
#if defined(PROBE_FFNK)
    {
        pg8::Gemm g{R2, (const bf16_t*)(ws + WS_WFFI), 1024, 1024, 1024, 254, -2, 0};
        pg8::StaticOrder S; S.init(65, 22, G, bx);
        EpiNull E{};
        pg8::gemm_phase(lds, g, S, E);
    }
#endif
#if defined(PROBE_KLOOP)
    {
        pg8::Gemm g{R1, (const bf16_t*)(ws + WS_WOUT0), 1024, 1024, 1024, 256, 0, 0};
        pg8::StaticOrder S; S.init(64, 4, G, bx);
        EpiNull E{};
        for (int rep = 0; rep < PROBE_KLOOP; ++rep) pg8::gemm_phase(lds, g, S, E);
    }
#endif
#if defined(PROBE_SMALL)
    for (int rep = 0; rep < PROBE_SMALL; ++rep) s_res_units<0, 1024, 1024>(a, lds, bx, G, R1, (const bf16_t*)(ws + WS_WOUT0), nullptr, (bf16_t*)(ws + WS_BIG), part_tab(ws, 5));
#endif
    GSYNC();
#pragma unroll 1
    for (int l = 0; l < 2; ++l) {
        bf16_t* G_ = BIGB;
        bf16_t* PPb = BIGB;
        PH(9) {
            pg8::Gemm g{R2, (const bf16_t*)(ws + WS_WFFI + l * WFFI_BYTES), 1024, 1024, 1024, 254, -2, 0};
            pg8::StaticOrder S; S.init(65, 22, G, bx);
            EpiFfn E{part_tab(ws, l == 0 ? 0 : 3), a.in[I_FCW] + (size_t)l * 3 * DFF, a.in[I_FCB] + (size_t)l * DFF, a.out + O_CONVP + (size_t)l * 2 * DFF, G_};
            pg8::gemm_phase(lds, g, S, E);
            s_ffn_units(a, lds, (bx - (1430 % G) + G) % G, G, l, R2, part_tab(ws, l == 0 ? 0 : 3));
        }
        GSYNC();
        PH(10) {
            pg8::Gemm g{G_, (const bf16_t*)(ws + WS_WFFO + l * WFFO_BYTES), DFF, DFF, DFF, 256, 0, 0};
            pg8::StaticOrder S; S.init(64, 4, G, bx);
            EpiRes<1, true, true, false> E{a.out, nullptr, R2, R1, part_tab(ws, l == 0 ? 1 : 4), nullptr, nullptr, nullptr};
            pg8::gemm_phase(lds, g, S, E);
            s_res_units<1, DFF, DFF>(a, lds, bx, G, G_, (const bf16_t*)(ws + WS_WFFO + l * WFFO_BYTES), R2, R1, part_tab(ws, l == 0 ? 1 : 4));
        }
        GSYNC();
        PH(11) {
            pg8::Gemm g{pbf + (size_t)l * MT * PLE, (const bf16_t*)(ws + WS_WPROJ + l * WPROJ_BYTES), PLE, PLE, PLE, 256, 0, 0};
            pg8::StaticOrder S; S.init(64, 4, G, bx);
            EpiPP E{PPb};
            pg8::gemm_phase(lds, g, S, E);
        }
        PH(12) {
            pg8::Gemm g{R1, (const bf16_t*)(ws + WS_WGATE + l * WGATE_BYTES), 1024, 1024, 1024, 256, 0, 0};
            pg8::StaticOrder S; S.init(64, 4, G, bx);
            if (l == 0) { EpiRes<2, true, true, false> E{a.out, nullptr, R1, R2, part_tab(ws, 2), part_tab(ws, 1), PPb, nullptr}; pg8::gemm_phase(lds, g, S, E);
                s_ple_units<false>(a, lds, bx, G, pbf, (const bf16_t*)(ws + WS_WPROJ), R1, (const bf16_t*)(ws + WS_WGATE), part_tab(ws, 1), part_tab(ws, 2), R2); }
            else { EpiRes<2, false, false, true> E{a.out, nullptr, R1, nullptr, nullptr, part_tab(ws, 4), PPb, nullptr}; pg8::gemm_phase(lds, g, S, E);
                s_ple_units<true>(a, lds, bx, G, pbf + (size_t)MT * PLE, (const bf16_t*)(ws + WS_WPROJ + WPROJ_BYTES), R1, (const bf16_t*)(ws + WS_WGATE + WGATE_BYTES), part_tab(ws, 4), nullptr, nullptr); }
        }
        if (l == 0) {
            GSYNC();
            PH(13) for (int it = vcu; it < 1024 + NS; it += G) { if (it < 1024) pool_item(a, lds, it, part_tab(ws, 2)); else pool_sample_item(a, lds, it - 1024, part_tab(ws, 2)); }
            GSYNC();
            PH(14) {
                pg8::Gemm g{R1, (const bf16_t*)(ws + WS_WPOOL), 1024, 256, 256, 256, 0, 256};
                pg8::StaticOrder S; S.init(64, 4, G, bx);
                EpiRes<3, true, true, false> E{a.out, nullptr, R2, R2, part_tab(ws, 3), nullptr, nullptr, a.in[I_POOLSC]};
                pg8::gemm_phase(lds, g, S, E);
                s_res_units<3, 256, 1024>(a, lds, bx, G, R1, (const bf16_t*)(ws + WS_WPOOL), R2, R2, part_tab(ws, 3));
            }
            GSYNC();
        }
    }
}

extern "C" void kernel_launch(void* const* d_in, const int* in_sizes, int n_in, void* d_out, int out_size, void* d_ws, size_t ws_size, hipStream_t stream) {
    static int grid = 0;
    if (grid == 0) {
        int dev = 0, cus = 0, per_cu = 0;
        hipGetDevice(&dev);
        hipDeviceGetAttribute(&cus, hipDeviceAttributeMultiprocessorCount, dev);
        hipFuncSetAttribute((const void*)mega_fwd, hipFuncAttributeMaxDynamicSharedMemorySize, LDS_BYTES);
        hipOccupancyMaxActiveBlocksPerMultiprocessor(&per_cu, (const void*)mega_fwd, NTHREADS, LDS_BYTES);
        if (per_cu < 1) { fprintf(stderr, "kernel_launch: occupancy query reports %d blocks per CU\n", per_cu); per_cu = 1; }
        if (per_cu > 1) per_cu = 1;
        grid = cus * per_cu;
        (void)hipGetLastError();
    }
    (void)hipMemsetAsync(d_ws, 0, 65536, stream);
    KArgs a{};
    for (int i = 0; i < 29; ++i) a.in[i] = (const float*)d_in[i];
    a.out = (float*)d_out; a.ws = (unsigned char*)d_ws;
    void* args[] = {&a};
    hipError_t e = hipLaunchCooperativeKernel((const void*)mega_fwd, dim3(grid), dim3(NTHREADS), args, LDS_BYTES, stream);
    if (e != hipSuccess) fprintf(stderr, "cooperative launch failed: %s (grid %d)\n", hipGetErrorString(e), grid);
}
```

```cpp
#include <hip/hip_runtime.h>
#include <hip/hip_cooperative_groups.h>
#include <cstdio>
#include <cstdint>
namespace cg = cooperative_groups;

#define LAS __attribute__((address_space(3)))
typedef unsigned short bf16_t;
typedef short bf16x8 __attribute__((ext_vector_type(8)));
typedef float f32x4 __attribute__((ext_vector_type(4)));
typedef float f32x2 __attribute__((ext_vector_type(2)));
typedef unsigned u32x4 __attribute__((ext_vector_type(4)));
typedef unsigned u32x2 __attribute__((ext_vector_type(2)));
typedef float f32x16 __attribute__((ext_vector_type(16)));

constexpr int D = 1024, SEQ = 16384, NS = 128, DFF = 2816, PLE = 256;
constexpr int SROW = 16510;
constexpr int MT = 16640;
constexpr int MR = 16768;
constexpr int NPROJ = 2304;
constexpr int PQA = 0, PKA = 256, PVA = 512, PRA = 1024, PQB = 1536, PKB = 2048, PVB = 2176;
constexpr float EPS = 1e-6f;
constexpr int NTHREADS = 512;

constexpr size_t O_YP = 0, O_YS = 16777216, O_GLAP = 16908288, O_SKP = 16941056, O_SVP = 16957440, O_POOLP = 16973824, O_CONVP = 16989184,
                 O_GLAS = 17000448, O_SKS = 21194752, O_SVS = 23291904, O_POOLS = 25389056, O_CONVS = 27355136;

constexpr size_t MiB = 1u << 20;
constexpr size_t WS_WIN0 = 1 * MiB, WS_WOUT0 = 6 * MiB, WS_WFFI = 8 * MiB, WS_WFFO = 30 * MiB, WS_WGATE = 41 * MiB, WS_WPROJ = 45 * MiB, WS_WPOOL = 46 * MiB;
constexpr size_t WS_SSQ = 47 * MiB;
constexpr size_t WS_PBF = 55 * MiB, WS_R1 = 72 * MiB, WS_R2 = 105 * MiB, WS_BIG = 138 * MiB;
constexpr size_t PART_STRIDE = (size_t)(MR + 8) * 16 * 4;
constexpr size_t WFFI_BYTES = (size_t)5632 * 1024 * 2, WFFO_BYTES = (size_t)1024 * 2816 * 2, WGATE_BYTES = (size_t)1024 * 1024 * 2, WPROJ_BYTES = (size_t)1024 * 256 * 2;
constexpr size_t BIG_LA = (size_t)MT * NPROJ * 2;
constexpr int LDS_BYTES = 155648;

__device__ __forceinline__ unsigned cvt_pk_bf16(float lo, float hi) { unsigned r; asm volatile("v_cvt_pk_bf16_f32 %0, %1, %2" : "=v"(r) : "v"(lo), "v"(hi)); return r; }
__device__ __forceinline__ float bf_lo(unsigned w) { return __uint_as_float(w << 16); }
__device__ __forceinline__ float bf_hi(unsigned w) { return __uint_as_float(w & 0xffff0000u); }
__device__ __forceinline__ float bf2f(bf16_t v) { return __uint_as_float(((unsigned)v) << 16); }
__device__ __forceinline__ void unpack8(const u32x4 w, float* f) { f[0] = bf_lo(w.x); f[1] = bf_hi(w.x); f[2] = bf_lo(w.y); f[3] = bf_hi(w.y); f[4] = bf_lo(w.z); f[5] = bf_hi(w.z); f[6] = bf_lo(w.w); f[7] = bf_hi(w.w); }
__device__ __forceinline__ float wave_sum(float v) {
#pragma unroll
    for (int o = 1; o < 64; o <<= 1) v += __shfl_xor(v, o);
    return v;
}
__device__ __forceinline__ float wave_max(float v) {
#pragma unroll
    for (int o = 1; o < 64; o <<= 1) v = fmaxf(v, __shfl_xor(v, o));
    return v;
}
__device__ __forceinline__ int otid() { int t = threadIdx.x; asm volatile("" : "+v"(t)); return t; }
__device__ __forceinline__ bool row_valid(int row) { return row < SEQ || (row >= SROW && row < SROW + NS); }
__device__ __forceinline__ float* hrow_ptr(float* out, int row) { return row < SEQ ? out + O_YP + (size_t)row * D : out + O_YS + (size_t)(row - SROW) * D; }
__device__ __forceinline__ f32x2 gelu_pk(f32x2 v) {
    const f32x2 av = __builtin_elementwise_abs(v), d = av * 0.2316418882f + 1.0f;
    f32x2 t; t.x = __builtin_amdgcn_rcpf(d.x); t.y = __builtin_amdgcn_rcpf(d.y);
    f32x2 q = t * 0.5307027145f + (-0.7265760135f); q = q * t + 0.7107068705f; q = q * t + (-0.142248368f); q = q * t + 0.127414796f; q = q * t;
    const f32x2 s = (v * v) * (-0.72134752044f);
    f32x2 e; e.x = __builtin_amdgcn_exp2f(s.x); e.y = __builtin_amdgcn_exp2f(s.y);
    const f32x2 m = v * (q * e), r = v - m;
    f32x2 o; o.x = v.x < 0.f ? m.x : r.x; o.y = v.y < 0.f ? m.y : r.y; return o;
}

namespace pg8 {
constexpr int BM = 256, BK = 64, HALF = 128, HTB = HALF * BK * 2, STAGE_BYTES = 8 * HTB, NXCD = 8, WGM = 8;
__host__ __device__ __forceinline__ int lds_byte(int r, int c) { const int st = (r >> 4) * 2 + (c >> 5), rr = r & 15, cc = c & 31, ob = rr * 64 + cc * 2; return st * 1024 + (ob ^ (((ob >> 9) & 1) << 5)); }
__host__ __device__ __forceinline__ void stage_rc(int b, int& R, int& C) { const int st = b / 1024, sb = b % 1024, swz = sb ^ (((sb >> 9) & 1) << 5); R = (st >> 1) * 16 + swz / 64; C = (st & 1) * 32 + (swz % 64) / 2; }
__host__ __device__ __forceinline__ int perm32(int rho) { const int n = rho >> 4, i = rho & 15; return 8 * (i >> 2) + 4 * n + (i & 3); }

struct Unit { int pm, pn; };
struct Gemm { const bf16_t* A; const bf16_t* Bt; int lda, ldb, K, mstride, arow0, acolstep; };

struct StaticOrder {
    int nM, nN, nwg, G, c;
    __device__ void init(int nM_, int nN_, int G_, int c_) { nM = nM_; nN = nN_; nwg = nM * nN; G = G_; c = c_; }
    __device__ bool next(int i, Unit& u) const {
        const long L = (long)i * G + c; if (L >= nwg) return false;
        int wgid = (int)L; { const int q = nwg / NXCD, r = nwg % NXCD, xcd = wgid % NXCD, off = wgid / NXCD; wgid = (xcd < r ? xcd * (q + 1) : r * (q + 1) + (xcd - r) * q) + off; }
        const int nig = WGM * nN, gid = wgid / nig, fm = gid * WGM, gsz = (nM - fm) < WGM ? (nM - fm) : WGM;
        u.pm = fm + ((wgid % nig) % gsz); u.pn = (wgid % nig) / gsz; return true;
    }
};

template <class Epi>
__device__ __forceinline__ void gemm_phase(LAS unsigned char* lds, const Gemm g, const StaticOrder& S, const Epi& E) {
    const int tid = otid(), wid = __builtin_amdgcn_readfirstlane(tid >> 6), lane = tid & 63, wr = wid >> 2, wc = wid & 3, fr = lane & 15, fq = lane >> 4;
    const int K = g.K, nt = K / BK;
    unsigned voffA[2], voffB[2];
#pragma unroll
    for (int i = 0; i < 2; ++i) { int R, C; stage_rc(tid * 16 + i * 8192, R, C); const int Rb = (R & ~31) + perm32(R & 31);
        voffA[i] = (unsigned)(R * g.lda + C) * 2u; voffB[i] = (unsigned)(Rb * g.ldb + C) * 2u; }
    const size_t kstep = (size_t)(BK * 2);
    const size_t hstepA = (size_t)HALF * g.lda * 2, hstepB = (size_t)HALF * g.ldb * 2;
    const unsigned ldsw = (unsigned)wid * 1024u;
    const int aoff = lds_byte(wr * 64 + fr, fq * 8), boff = lds_byte(wc * 32 + fr, fq * 8);
#define PG8_SA(b, h) (((b) * 2 + (h)) * HTB)
#define PG8_SB(b, h) ((4 + (b) * 2 + (h)) * HTB)
#define PG8_STAGE(bufoff, gbase, voff) do { _Pragma("unroll") for (int _i = 0; _i < 2; ++_i) \
        __builtin_amdgcn_global_load_lds((const unsigned*)((const char*)(gbase) + (voff)[_i]), (LAS unsigned*)(lds + (bufoff) + ldsw + _i * 8192), 16, 0, 0); } while (0)
#define PG8_LDA(dst, b, h) do { _Pragma("unroll") for (int m = 0; m < 4; ++m) _Pragma("unroll") for (int k = 0; k < 2; ++k) dst[m][k] = *(const LAS bf16x8*)(lds + PG8_SA(b, h) + aoff + m * 2048 + k * 1024); } while (0)
#define PG8_LDB(dst, b, h) do { _Pragma("unroll") for (int n = 0; n < 2; ++n) _Pragma("unroll") for (int k = 0; k < 2; ++k) dst[n][k] = *(const LAS bf16x8*)(lds + PG8_SB(b, h) + boff + n * 2048 + k * 1024); } while (0)
#define PG8_MMA(ai, bj, At, Bt) do { __builtin_amdgcn_s_setprio(1); _Pragma("unroll") for (int m = 0; m < 4; ++m) _Pragma("unroll") for (int n = 0; n < 2; ++n) _Pragma("unroll") for (int k = 0; k < 2; ++k) \
        acc[ai][bj][m][n] = __builtin_amdgcn_mfma_f32_16x16x32_bf16(Bt[n][k], At[m][k], acc[ai][bj][m][n], 0, 0, 0); __builtin_amdgcn_s_setprio(0); } while (0)
#define PG8_WAIT_V(n) asm volatile("s_waitcnt vmcnt(" #n ")" ::: "memory")
#define PG8_WAIT_L(n) asm volatile("s_waitcnt lgkmcnt(" #n ")" ::: "memory")
#define PG8_BAR __builtin_amdgcn_s_barrier()
#define PG8_SCHED __builtin_amdgcn_sched_barrier(0)
#define PG8_ABASE(u) ((const char*)g.A + ((long)((long)(u).pm * g.mstride + g.arow0) * g.lda + (long)(u).pn * g.acolstep) * 2)
#define PG8_BBASE(u) ((const char*)g.Bt + (size_t)(u).pn * 256 * g.ldb * 2)
    Unit cur, nxt; int ui = 0;
    if (!S.next(0, cur)) return;
    f32x4 acc[2][2][4][2];
#pragma unroll
    for (int a = 0; a < 2; ++a)
#pragma unroll
        for (int b = 0; b < 2; ++b)
#pragma unroll
            for (int m = 0; m < 4; ++m)
#pragma unroll
                for (int n = 0; n < 2; ++n) acc[a][b][m][n] = (f32x4){0.f, 0.f, 0.f, 0.f};
    bf16x8 At[4][2], B0[2][2], B1[2][2];
    const char* cA = PG8_ABASE(cur); const char* cB = PG8_BBASE(cur);
    PG8_STAGE(PG8_SB(0, 0), cB, voffB); PG8_STAGE(PG8_SB(0, 1), cB + hstepB, voffB); PG8_STAGE(PG8_SA(0, 0), cA, voffA); PG8_STAGE(PG8_SA(0, 1), cA + hstepA, voffA);
    if (wr == 1) PG8_BAR;
    PG8_WAIT_V(2); PG8_BAR;
    PG8_STAGE(PG8_SB(1, 0), cB + kstep, voffB); PG8_STAGE(PG8_SA(1, 0), cA + kstep, voffA); PG8_STAGE(PG8_SB(1, 1), cB + hstepB + kstep, voffB);
    PG8_WAIT_V(6); PG8_BAR;
    for (;;) {
        const bool has_next = S.next(ui + 1, nxt);
        const char* nA = has_next ? PG8_ABASE(nxt) : cA; const char* nB = has_next ? PG8_BBASE(nxt) : cB;
#pragma unroll 1
        for (int t = 0; t < nt; t += 2) {
            const bool last = (t == nt - 2);
            const char* a1 = cA + (size_t)(t + 1) * kstep;
            const char* a2 = last ? nA : cA + (size_t)(t + 2) * kstep; const char* b2 = last ? nB : cB + (size_t)(t + 2) * kstep;
            const char* a3 = a2 + kstep; const char* b3 = b2 + kstep;
            PG8_LDB(B0, 0, 0); PG8_LDB(B1, 0, 1); PG8_SCHED; PG8_LDA(At, 0, 0); PG8_STAGE(PG8_SA(1, 1), a1 + hstepA, voffA);
            PG8_WAIT_V(8); PG8_WAIT_L(0); PG8_BAR; PG8_MMA(0, 0, At, B0); PG8_MMA(0, 1, At, B1); PG8_BAR; PG8_SCHED;
            PG8_LDA(At, 0, 1); PG8_STAGE(PG8_SB(0, 0), b2, voffB); PG8_STAGE(PG8_SB(0, 1), b2 + hstepB, voffB); PG8_STAGE(PG8_SA(0, 0), a2, voffA);
            PG8_WAIT_V(8); PG8_WAIT_L(0); PG8_BAR; PG8_MMA(1, 0, At, B0); PG8_MMA(1, 1, At, B1); PG8_BAR; PG8_SCHED;
            PG8_LDB(B0, 1, 0); PG8_LDB(B1, 1, 1); PG8_SCHED; PG8_LDA(At, 1, 0); PG8_STAGE(PG8_SA(0, 1), a2 + hstepA, voffA);
            PG8_WAIT_V(8); PG8_WAIT_L(0); PG8_BAR; PG8_MMA(0, 0, At, B0); PG8_MMA(0, 1, At, B1); PG8_BAR; PG8_SCHED;
            PG8_LDA(At, 1, 1); PG8_STAGE(PG8_SB(1, 0), b3, voffB); PG8_STAGE(PG8_SB(1, 1), b3 + hstepB, voffB); PG8_STAGE(PG8_SA(1, 0), a3, voffA);
            PG8_WAIT_V(8); PG8_WAIT_L(0); PG8_BAR; PG8_MMA(1, 0, At, B0); PG8_MMA(1, 1, At, B1); PG8_BAR; PG8_SCHED;
        }
        if (wr == 0) PG8_BAR;
        { int lane2 = lane; asm volatile("" : "+v"(lane2)); E(acc, cur, wr, wc, lane2 & 15, lane2 >> 4, lds + STAGE_BYTES); }
        if (!has_next) break;
#pragma unroll
        for (int a = 0; a < 2; ++a)
#pragma unroll
            for (int b = 0; b < 2; ++b)
#pragma unroll
                for (int m = 0; m < 4; ++m)
#pragma unroll
                    for (int n = 0; n < 2; ++n) acc[a][b][m][n] = (f32x4){0.f, 0.f, 0.f, 0.f};
        cur = nxt; cA = nA; cB = nB; ++ui;
        if (wr == 1) PG8_BAR;
    }
    PG8_WAIT_V(0);
    PG8_BAR;
#undef PG8_SA
#undef PG8_SB
#undef PG8_STAGE
#undef PG8_LDA
#undef PG8_LDB
#undef PG8_MMA
#undef PG8_WAIT_V
#undef PG8_WAIT_L
#undef PG8_BAR
#undef PG8_SCHED
#undef PG8_ABASE
#undef PG8_BBASE
}
}
using pg8::Unit;
typedef f32x4 AccT[2][2][4][2];

__device__ __forceinline__ float row_rs(const float* part, int row, int fq) {
    const f32x4 p = *(const f32x4*)(part + (long)row * 16 + fq * 4);
    float s = (p[0] + p[1]) + (p[2] + p[3]);
    s += __shfl_xor(s, 16); s += __shfl_xor(s, 32);
    return rsqrtf(s * (1.0f / D) + EPS);
}

struct EpiProj {
    bf16_t* proj; float* la; const float* ssq0; const float* b_alpha;
    __device__ __forceinline__ void operator()(const AccT& acc, const Unit& u, int wr, int wc, int fr, int fq, LAS unsigned char*) const {
        float rsv[2][4];
#pragma unroll
        for (int ai = 0; ai < 2; ++ai)
#pragma unroll
            for (int m = 0; m < 4; ++m) rsv[ai][m] = ssq0[u.pm * 256 + ai * 128 + wr * 64 + m * 16 + fr];
        f32x4 bb[2][2];
        if (u.pn >= 9) {
#pragma unroll
            for (int bj = 0; bj < 2; ++bj) { const int c = bj * 128 + wc * 32 + fq * 8; bb[bj][0] = *(const f32x4*)(b_alpha + c); bb[bj][1] = *(const f32x4*)(b_alpha + c + 4); }
        }
#pragma unroll
        for (int ai = 0; ai < 2; ++ai)
#pragma unroll
            for (int m = 0; m < 4; ++m) {
                const int row = u.pm * 256 + ai * 128 + wr * 64 + m * 16 + fr;
                const float rs = rsqrtf(rsv[ai][m] * (1.0f / D) + EPS);
#pragma unroll
                for (int bj = 0; bj < 2; ++bj) {
                    const int col = u.pn * 256 + bj * 128 + wc * 32 + fq * 8;
                    const f32x4 v0 = acc[ai][bj][m][0] * rs, v1 = acc[ai][bj][m][1] * rs;
                    if (u.pn < 9) {
                        u32x4 w; w.x = cvt_pk_bf16(v0[0], v0[1]); w.y = cvt_pk_bf16(v0[2], v0[3]); w.z = cvt_pk_bf16(v1[0], v1[1]); w.w = cvt_pk_bf16(v1[2], v1[3]);
                        *(u32x4*)(proj + (size_t)row * NPROJ + col) = w;
                    } else {
                        const int c = col - NPROJ;
                        f32x4 o0, o1;
#pragma unroll
                        for (int j = 0; j < 4; ++j) {
                            const float z0 = v0[j] + bb[bj][0][j], z1 = v1[j] + bb[bj][1][j];
                            o0[j] = (fminf(z0, 0.f) - log1pf(__expf(-fabsf(z0)))) * 0.0625f;
                            o1[j] = (fminf(z1, 0.f) - log1pf(__expf(-fabsf(z1)))) * 0.0625f;
                        }
                        *(f32x4*)(la + (size_t)row * 256 + c) = o0; *(f32x4*)(la + (size_t)row * 256 + c + 4) = o1;
                    }
                }
            }
    }
};
struct EpiPP {
    bf16_t* pp;
    __device__ __forceinline__ void operator()(const AccT& acc, const Unit& u, int wr, int wc, int fr, int fq, LAS unsigned char*) const {
#pragma unroll
        for (int ai = 0; ai < 2; ++ai)
#pragma unroll
            for (int m = 0; m < 4; ++m) {
                const int row = u.pm * 256 + ai * 128 + wr * 64 + m * 16 + fr;
#pragma unroll
                for (int bj = 0; bj < 2; ++bj) {
                    const int col = u.pn * 256 + bj * 128 + wc * 32 + fq * 8;
                    const f32x4 v0 = acc[ai][bj][m][0], v1 = acc[ai][bj][m][1];
                    u32x4 w; w.x = cvt_pk_bf16(v0[0], v0[1]); w.y = cvt_pk_bf16(v0[2], v0[3]); w.z = cvt_pk_bf16(v1[0], v1[1]); w.w = cvt_pk_bf16(v1[2], v1[3]);
                    *(u32x4*)(pp + (size_t)row * D + col) = w;
                }
            }
    }
};
template <int MODE, bool WRITE_HB, bool WRITE_PART, bool WRITE_F32>
struct EpiRes {
    float* out; const float* xp; const bf16_t* hbin; bf16_t* hb; float* part; const float* part_in; const bf16_t* pp; const float* scale;
    __device__ __forceinline__ void operator()(const AccT& acc, const Unit& u, int wr, int wc, int fr, int fq, LAS unsigned char*) const {
        f32x4 sc[2][2];
        if (MODE == 3) {
#pragma unroll
            for (int bj = 0; bj < 2; ++bj) { const int col = u.pn * 256 + bj * 128 + wc * 32 + fq * 8; sc[bj][0] = *(const f32x4*)(scale + col); sc[bj][1] = *(const f32x4*)(scale + col + 4); }
        }
#pragma unroll
        for (int aq = 0; aq < 4; ++aq) {
            const int ai = aq >> 1, m0 = (aq & 1) * 2;
            f32x4 xb[4][2][2]; u32x4 hw[4][2]; u32x4 pw[4][2]; f32x4 pin[4];
#pragma unroll
            for (int m = m0; m < m0 + 2; ++m) {
                const int row = u.pm * 256 + ai * 128 + wr * 64 + m * 16 + fr;
                if (MODE == 2) pin[m] = *(const f32x4*)(part_in + (long)row * 16 + fq * 4);
#pragma unroll
                for (int bj = 0; bj < 2; ++bj) {
                    const int col = u.pn * 256 + bj * 128 + wc * 32 + fq * 8;
                    if (MODE == 0) { xb[m][bj][0] = *(const f32x4*)(xp + (size_t)row * D + col); xb[m][bj][1] = *(const f32x4*)(xp + (size_t)row * D + col + 4); }
                    else hw[m][bj] = *(const u32x4*)(hbin + (size_t)row * D + col);
                    if (MODE == 2) pw[m][bj] = *(const u32x4*)(pp + (size_t)row * D + col);
                }
            }
#pragma unroll
            for (int m = m0; m < m0 + 2; ++m) {
                const int row = u.pm * 256 + ai * 128 + wr * 64 + m * 16 + fr;
                float rs = 1.f;
                if (MODE == 2) { float s = (pin[m][0] + pin[m][1]) + (pin[m][2] + pin[m][3]); s += __shfl_xor(s, 16); s += __shfl_xor(s, 32); rs = rsqrtf(s * (1.0f / D) + EPS); }
                float sq = 0.f;
#pragma unroll
                for (int bj = 0; bj < 2; ++bj) {
                    const int col = u.pn * 256 + bj * 128 + wc * 32 + fq * 8;
                    f32x4 v0 = acc[ai][bj][m][0], v1 = acc[ai][bj][m][1];
                    if (MODE == 2) {
                        float pf[8]; unpack8(pw[m][bj], pf);
#pragma unroll
                        for (int j = 0; j < 4; ++j) {
                            v0[j] = pf[j] / (1.f + __expf(-v0[j] * rs));
                            v1[j] = pf[4 + j] / (1.f + __expf(-v1[j] * rs));
                        }
                    }
                    if (MODE == 3) { v0 = v0 * sc[bj][0]; v1 = v1 * sc[bj][1]; }
                    f32x4 b0, b1;
                    if (MODE == 0) { b0 = xb[m][bj][0]; b1 = xb[m][bj][1]; }
                    else { float bf[8]; unpack8(hw[m][bj], bf); b0 = (f32x4){bf[0], bf[1], bf[2], bf[3]}; b1 = (f32x4){bf[4], bf[5], bf[6], bf[7]}; }
                    const f32x4 h0 = b0 + v0, h1 = b1 + v1;
                    if (WRITE_F32) { float* hp = out + O_YP + (size_t)row * D; *(f32x4*)(hp + col) = h0; *(f32x4*)(hp + col + 4) = h1; }
                    if (WRITE_HB) { u32x4 w; w.x = cvt_pk_bf16(h0[0], h0[1]); w.y = cvt_pk_bf16(h0[2], h0[3]); w.z = cvt_pk_bf16(h1[0], h1[1]); w.w = cvt_pk_bf16(h1[2], h1[3]);
                        *(u32x4*)(hb + (size_t)row * D + col) = w; }
                    sq += (h0[0] * h0[0] + h0[1] * h0[1]) + (h0[2] * h0[2] + h0[3] * h0[3]) + (h1[0] * h1[0] + h1[1] * h1[1]) + (h1[2] * h1[2] + h1[3] * h1[3]);
                }
                if (WRITE_PART) {
                    sq += __shfl_xor(sq, 16); sq += __shfl_xor(sq, 32);
                    if (fq == 0) part[(long)row * 16 + u.pn * 4 + wc] = sq;
                }
            }
        }
    }
};
struct EpiFfn {
    const float* part_in; const float* convw; const float* convb; float* convp_out; bf16_t* G;
    __device__ __forceinline__ void operator()(AccT& acc, const Unit& u, int wr, int wc, int fr, int fq, LAS unsigned char* ldsx) const {
        const int c0 = u.pn * 128 + wc * 32 + fq * 8;
#pragma unroll
        for (int ai = 0; ai < 2; ++ai)
#pragma unroll
            for (int m = 0; m < 4; ++m) {
                const int grow = u.pm * 254 - 2 + ai * 128 + wr * 64 + m * 16 + fr;
                const float rs = row_rs(part_in, grow, fq);
#pragma unroll
                for (int bj = 0; bj < 2; ++bj)
#pragma unroll
                    for (int n = 0; n < 2; ++n) acc[ai][bj][m][n] = acc[ai][bj][m][n] * rs;
            }
        LAS f32x4* xch = (LAS f32x4*)ldsx;
        if (fr >= 14) {
#pragma unroll
            for (int ai = 0; ai < 2; ++ai) {
                const int slot = ((((ai * 2 + wr) * 4 + wc) * 4 + fq) * 2 + (fr - 14)) * 2;
                xch[slot] = acc[ai][0][3][0]; xch[slot + 1] = acc[ai][0][3][1];
            }
        }
        asm volatile("s_waitcnt lgkmcnt(0)" ::: "memory"); __builtin_amdgcn_s_barrier(); asm volatile("" ::: "memory");
        f32x4 w0[2], w1[2], w2[2], cb[2];
#pragma unroll
        for (int n = 0; n < 2; ++n) { const int cn = c0 + 4 * n;
            w0[n] = *(const f32x4*)(convw + cn); w1[n] = *(const f32x4*)(convw + DFF + cn); w2[n] = *(const f32x4*)(convw + 2 * DFF + cn); cb[n] = *(const f32x4*)(convb + cn); }
#pragma unroll
        for (int ai = 0; ai < 2; ++ai)
#pragma unroll
            for (int m = 0; m < 4; ++m) {
                const int tr = ai * 128 + wr * 64 + m * 16 + fr;
                const int grow = u.pm * 254 - 2 + tr;
                const bool store = (tr >= 2 && grow < SEQ);
                u32x4 w;
#pragma unroll
                for (int n = 0; n < 2; ++n) {
                    const f32x4 x = acc[ai][0][m][n];
                    f32x4 p;
                    if (m == 0) {
                        const int sa = (wr == 1) ? ai : 0, sw = (wr == 1) ? 0 : 1;
                        const bool has = (wr == 1) || (ai == 1);
                        const int slot = ((((sa * 2 + sw) * 4 + wc) * 4 + fq) * 2 + (fr >= 14 ? fr - 14 : 0)) * 2 + n;
                        p = xch[slot];
                        if (!has) p = (f32x4){0.f, 0.f, 0.f, 0.f};
                    } else p = acc[ai][0][m == 0 ? 0 : m - 1][n];
                    f32x4 p1, p2;
#pragma unroll
                    for (int j = 0; j < 4; ++j) {
                        const float xf = x[j], pf = p[j]; const int xi = __float_as_int(xf), pi = __float_as_int(pf);
                        const int r1 = __builtin_amdgcn_update_dpp(0, pi, 0x121, 0xf, 0xf, false), r2 = __builtin_amdgcn_update_dpp(0, pi, 0x122, 0xf, 0xf, false);
                        p1[j] = __int_as_float(__builtin_amdgcn_update_dpp(r1, xi, 0x111, 0xf, 0xf, false));
                        p2[j] = __int_as_float(__builtin_amdgcn_update_dpp(r2, xi, 0x112, 0xf, 0xf, false));
                    }
                    if (grow >= SEQ - 2 && grow < SEQ) *(f32x4*)(convp_out + (size_t)(grow - (SEQ - 2)) * DFF + c0 + 4 * n) = x;
                    const f32x4 ac = cb[n] + w0[n] * p2 + w1[n] * p1 + w2[n] * x;
                    const f32x4 v = acc[ai][1][m][n];
                    const f32x2 g0 = gelu_pk((f32x2){ac[0], ac[1]}), g1 = gelu_pk((f32x2){ac[2], ac[3]});
                    const unsigned lo = cvt_pk_bf16(g0.x * v[0], g0.y * v[1]), hi = cvt_pk_bf16(g1.x * v[2], g1.y * v[3]);
                    if (n == 0) { w.x = lo; w.y = hi; } else { w.z = lo; w.w = hi; }
                }
                if (store) *(u32x4*)(G + (size_t)grow * DFF + c0) = w;
                asm volatile("" ::: "memory");
            }
    }
};

struct EpiNull {
    __device__ __forceinline__ void operator()(const AccT& acc, const Unit& u, int wr, int wc, int fr, int fq, LAS unsigned char*) const {
#pragma unroll
        for (int ai = 0; ai < 2; ++ai)
#pragma unroll
            for (int bj = 0; bj < 2; ++bj)
#pragma unroll
                for (int m = 0; m < 4; ++m) { asm volatile("" :: "v"(acc[ai][bj][m][0]), "v"(acc[ai][bj][m][1])); }
    }
};
struct KArgs { const float* in[29]; float* out; unsigned char* ws; };
enum { I_XP = 0, I_XS, I_PP, I_PS, I_SGLA, I_CK, I_CV, I_SPOOL, I_SCONV, I_MNE, I_WIN, I_WALPHA, I_BALPHA, I_ONORM, I_QNORM, I_KNORM, I_SINKS, I_WOUT,
       I_MNO, I_POOLW, I_POOLSC, I_FNORM, I_FWIN, I_FCW, I_FCB, I_FWOUT, I_PNORM, I_PWPROJ, I_PWGATE };

__device__ __forceinline__ float* part_tab(unsigned char* ws, int i) { return (float*)(ws + WS_SSQ + 262144 + (size_t)i * PART_STRIDE) + 2 * 16; }

constexpr int SPART_PITCH = 68;
constexpr int SG_STAGE = 24576, SG_NST = 4, SG_PART_OFF = SG_STAGE * SG_NST;
template <int K, int LDA, int LDB>
__device__ __forceinline__ void sgemm_tile(const bf16_t* __restrict__ A, const bf16_t* __restrict__ B0, const bf16_t* __restrict__ B1, LAS unsigned char* lds) {
    const int tid = otid(), lane = tid & 63, wave = __builtin_amdgcn_readfirstlane(tid >> 6);
    const int fr = lane & 15, fq = lane >> 4, mq = wave >> 1, nh = wave & 1;
    constexpr int NCH = K / 64;
    static_assert(K % 64 == 0 && NCH >= SG_NST, "K must be a multiple of 64 and at least 4 chunks");
    const int prow = lane >> 3, ppc = lane & 7;
    const char* gsrc[3]; unsigned ldst[3];
#pragma unroll
    for (int j = 0; j < 3; ++j) {
        const int i = wave + 8 * j;
        if (j < 2) { const int row = 8 * i + prow; gsrc[j] = (const char*)(A + (size_t)row * LDA) + 16 * (ppc ^ (row & 7)); }
        else { const int row = 8 * (i - 16) + prow; const bf16_t* bp = row < 32 ? B0 + (size_t)row * LDB : B1 + (size_t)(row - 32) * LDB; gsrc[j] = (const char*)bp + 16 * (ppc ^ (row & 7)); }
        ldst[j] = (unsigned)i * 1024u;
    }
#define SG_DMA(c) do { const int st_ = ((c) % SG_NST) * SG_STAGE; _Pragma("unroll") for (int j_ = 0; j_ < 3; ++j_) \
        __builtin_amdgcn_global_load_lds((const unsigned*)(gsrc[j_] + (size_t)(c) * 128), (LAS unsigned*)(lds + st_ + ldst[j_]), 16, 0, 0); } while (0)
    f32x4 acc[2][2];
#pragma unroll
    for (int m = 0; m < 2; ++m)
#pragma unroll
        for (int n = 0; n < 2; ++n) acc[m][n] = (f32x4){0.f, 0.f, 0.f, 0.f};
    int aoff[2][2], boff[2][2];
#pragma unroll
    for (int m = 0; m < 2; ++m)
#pragma unroll
        for (int s = 0; s < 2; ++s) {
            const int ra = 16 * (2 * mq + m) + fr, rb = 16 * (2 * nh + m) + fr;
            aoff[m][s] = ra * 128 + 16 * ((4 * s + fq) ^ (ra & 7));
            boff[m][s] = 16384 + rb * 128 + 16 * ((4 * s + fq) ^ (rb & 7));
        }
    SG_DMA(0); SG_DMA(1); SG_DMA(2);
#pragma unroll 1
    for (int c = 0; c < NCH; ++c) {
        if (c + 3 < NCH) { SG_DMA(c + 3); asm volatile("s_waitcnt vmcnt(9)" ::: "memory"); }
        else if (c + 2 < NCH) asm volatile("s_waitcnt vmcnt(6)" ::: "memory");
        else if (c + 1 < NCH) asm volatile("s_waitcnt vmcnt(3)" ::: "memory");
        else asm volatile("s_waitcnt vmcnt(0)" ::: "memory");
        __builtin_amdgcn_s_barrier(); asm volatile("" ::: "memory");
        const LAS unsigned char* st = lds + (c % SG_NST) * SG_STAGE;
#pragma unroll
        for (int s = 0; s < 2; ++s) {
            const bf16x8 a0 = *(const LAS bf16x8*)(st + aoff[0][s]), a1 = *(const LAS bf16x8*)(st + aoff[1][s]);
            const bf16x8 b0 = *(const LAS bf16x8*)(st + boff[0][s]), b1 = *(const LAS bf16x8*)(st + boff[1][s]);
            acc[0][0] = __builtin_amdgcn_mfma_f32_16x16x32_bf16(b0, a0, acc[0][0], 0, 0, 0);
            acc[0][1] = __builtin_amdgcn_mfma_f32_16x16x32_bf16(b1, a0, acc[0][1], 0, 0, 0);
            acc[1][0] = __builtin_amdgcn_mfma_f32_16x16x32_bf16(b0, a1, acc[1][0], 0, 0, 0);
            acc[1][1] = __builtin_amdgcn_mfma_f32_16x16x32_bf16(b1, a1, acc[1][1], 0, 0, 0);
        }
        asm volatile("s_waitcnt lgkmcnt(0)" ::: "memory"); __builtin_amdgcn_s_barrier(); asm volatile("" ::: "memory");
    }
#undef SG_DMA
    LAS float* part = (LAS float*)(lds + SG_PART_OFF);
#pragma unroll
    for (int m = 0; m < 2; ++m)
#pragma unroll
        for (int n = 0; n < 2; ++n) *(LAS f32x4*)(part + (16 * (2 * mq + m) + fr) * SPART_PITCH + 16 * (2 * nh + n) + 4 * fq) = acc[m][n];
}
template <int N>
__device__ __forceinline__ void sreduce(const LAS float* part, int b, int col0, float* v) {
#pragma unroll
    for (int j = 0; j < N; j += 4) {
        const f32x4 s = *(const LAS f32x4*)(part + b * SPART_PITCH + col0 + j);
        v[j] = s[0]; v[j + 1] = s[1]; v[j + 2] = s[2]; v[j + 3] = s[3];
    }
}
template <int MODE, bool WRITE_HB, bool WRITE_PART, bool WRITE_F32>
__device__ __forceinline__ void s_res_epi(const KArgs& a, int b, int q, int n0, const float* v, const bf16_t* hbin, bf16_t* hb, float* part, const float* ppv, float rs_in, const float* scale) {
    const int row = SROW + b, c0 = n0 + 16 * q;
    float base[16];
    if (MODE == 0) {
#pragma unroll
        for (int j = 0; j < 16; j += 4) { const f32x4 bv = *(const f32x4*)(a.in[I_XS] + (size_t)b * D + c0 + j); base[j] = bv[0]; base[j + 1] = bv[1]; base[j + 2] = bv[2]; base[j + 3] = bv[3]; }
    } else {
        const u32x4 w0 = *(const u32x4*)(hbin + (size_t)row * D + c0), w1 = *(const u32x4*)(hbin + (size_t)row * D + c0 + 8);
        unpack8(w0, base); unpack8(w1, base + 8);
    }
    float hn[16]; float sq = 0.f;
#pragma unroll
    for (int j = 0; j < 16; ++j) {
        float nv = v[j];
        if (MODE == 2) nv = ppv[j] / (1.f + __expf(-nv * rs_in));
        if (MODE == 3) nv = nv * scale[c0 + j];
        hn[j] = base[j] + nv; sq += hn[j] * hn[j];
    }
    if (WRITE_F32) {
        float* hp = a.out + O_YS + (size_t)b * D + c0;
#pragma unroll
        for (int j = 0; j < 16; j += 4) *(f32x4*)(hp + j) = (f32x4){hn[j], hn[j + 1], hn[j + 2], hn[j + 3]};
    }
    if (WRITE_HB) {
        u32x4 w0, w1;
        w0.x = cvt_pk_bf16(hn[0], hn[1]); w0.y = cvt_pk_bf16(hn[2], hn[3]); w0.z = cvt_pk_bf16(hn[4], hn[5]); w0.w = cvt_pk_bf16(hn[6], hn[7]);
        w1.x = cvt_pk_bf16(hn[8], hn[9]); w1.y = cvt_pk_bf16(hn[10], hn[11]); w1.z = cvt_pk_bf16(hn[12], hn[13]); w1.w = cvt_pk_bf16(hn[14], hn[15]);
        *(u32x4*)(hb + (size_t)row * D + c0) = w0; *(u32x4*)(hb + (size_t)row * D + c0 + 8) = w1;
    }
    if (WRITE_PART) {
        sq += __shfl_xor(sq, 1); sq += __shfl_xor(sq, 2);
        if (q == 0) part[(long)row * 16 + (n0 >> 6)] = sq;
    }
}
__device__ __forceinline__ float s_row_rs(const float* part, int b) {
    const float* p = part + (long)(SROW + b) * 16;
    const f32x4 p0 = *(const f32x4*)(p), p1 = *(const f32x4*)(p + 4), p2 = *(const f32x4*)(p + 8), p3 = *(const f32x4*)(p + 12);
    const float s = ((p0[0] + p0[1]) + (p0[2] + p0[3])) + ((p1[0] + p1[1]) + (p1[2] + p1[3])) + ((p2[0] + p2[1]) + (p2[2] + p2[3])) + ((p3[0] + p3[1]) + (p3[2] + p3[3]));
    return rsqrtf(s * (1.0f / D) + EPS);
}
__device__ __forceinline__ void s_proj_units(const KArgs& a, LAS unsigned char* lds, int u0, int G) {
    LAS float* part = (LAS float*)(lds + SG_PART_OFF);
    const bf16_t* xbf = (const bf16_t*)(a.ws + WS_R1) + (size_t)SROW * D; const bf16_t* W = (const bf16_t*)(a.ws + WS_WIN0);
    bf16_t* proj = (bf16_t*)(a.ws + WS_BIG); float* la = (float*)(a.ws + WS_BIG + BIG_LA); const float* ssq0 = (const float*)(a.ws + WS_SSQ);
    for (int u = u0; u < 40; u += G) {
        const int n0 = u * 64;
        sgemm_tile<1024, 1024, 1024>(xbf, W + (size_t)n0 * 1024, W + (size_t)(n0 + 32) * 1024, lds);
        __syncthreads();
        const int tid = otid(), b = tid >> 2, q = tid & 3, c0 = n0 + 16 * q, row = SROW + b;
        float v[16]; sreduce<16>(part, b, 16 * q, v);
        const float rs = rsqrtf(ssq0[row] * (1.0f / D) + EPS);
        if (n0 < NPROJ) {
            u32x4 w0, w1;
            w0.x = cvt_pk_bf16(v[0] * rs, v[1] * rs); w0.y = cvt_pk_bf16(v[2] * rs, v[3] * rs); w0.z = cvt_pk_bf16(v[4] * rs, v[5] * rs); w0.w = cvt_pk_bf16(v[6] * rs, v[7] * rs);
            w1.x = cvt_pk_bf16(v[8] * rs, v[9] * rs); w1.y = cvt_pk_bf16(v[10] * rs, v[11] * rs); w1.z = cvt_pk_bf16(v[12] * rs, v[13] * rs); w1.w = cvt_pk_bf16(v[14] * rs, v[15] * rs);
            *(u32x4*)(proj + (size_t)row * NPROJ + c0) = w0; *(u32x4*)(proj + (size_t)row * NPROJ + c0 + 8) = w1;
        } else {
            const int c = c0 - NPROJ;
#pragma unroll
            for (int j = 0; j < 16; j += 4) { f32x4 o;
#pragma unroll
                for (int i = 0; i < 4; ++i) { const float z = v[j + i] * rs + a.in[I_BALPHA][c + j + i]; o[i] = (fminf(z, 0.f) - log1pf(__expf(-fabsf(z)))) * 0.0625f; }
                *(f32x4*)(la + (size_t)row * 256 + c + j) = o; }
        }
        __syncthreads();
    }
}
template <int MODE, int K, int LDA>
__device__ __forceinline__ void s_res_units(const KArgs& a, LAS unsigned char* lds, int u0, int G, const bf16_t* A, const bf16_t* W, const bf16_t* hbin, bf16_t* hb, float* part_out) {
    LAS float* part = (LAS float*)(lds + SG_PART_OFF);
    for (int u = u0; u < 16; u += G) {
        const int n0 = u * 64;
        const bf16_t* Au = A + (size_t)SROW * LDA + (MODE == 3 ? (n0 >> 8) * 256 : 0);
        sgemm_tile<K, LDA, K>(Au, W + (size_t)n0 * K, W + (size_t)(n0 + 32) * K, lds);
        __syncthreads();
        const int tid = otid(), b = tid >> 2, q = tid & 3;
        float v[16]; sreduce<16>(part, b, 16 * q, v);
        s_res_epi<MODE, true, true, false>(a, b, q, n0, v, hbin, hb, part_out, nullptr, 1.f, a.in[I_POOLSC]);
        __syncthreads();
    }
}
template <bool LAST>
__device__ __forceinline__ void s_ple_units(const KArgs& a, LAS unsigned char* lds, int u0, int G, const bf16_t* pb, const bf16_t* Wp, const bf16_t* hbA, const bf16_t* Wg, const float* part_in, float* part_out, bf16_t* hbout) {
    LAS float* part = (LAS float*)(lds + SG_PART_OFF);
    for (int u = u0; u < 16; u += G) {
        const int n0 = u * 64;
        sgemm_tile<256, 256, 256>(pb + (size_t)SROW * PLE, Wp + (size_t)n0 * PLE, Wp + (size_t)(n0 + 32) * PLE, lds);
        __syncthreads();
        const int tid = otid(), b = tid >> 2, q = tid & 3;
        float ppv[16]; sreduce<16>(part, b, 16 * q, ppv);
        __syncthreads();
        sgemm_tile<1024, 1024, 1024>(hbA + (size_t)SROW * D, Wg + (size_t)n0 * D, Wg + (size_t)(n0 + 32) * D, lds);
        __syncthreads();
        float v[16]; sreduce<16>(part, b, 16 * q, v);
        const float rs = s_row_rs(part_in, b);
        s_res_epi<2, !LAST, !LAST, LAST>(a, b, q, n0, v, hbA, hbout, part_out, ppv, rs, nullptr);
        __syncthreads();
    }
}
__device__ __forceinline__ void s_ffn_units(const KArgs& a, LAS unsigned char* lds, int u0, int G, int l, const bf16_t* hbA, const float* part_in) {
    LAS float* part = (LAS float*)(lds + SG_PART_OFF);
    const bf16_t* W = (const bf16_t*)(a.ws + WS_WFFI + l * WFFI_BYTES);
    bf16_t* Gb = (bf16_t*)(a.ws + WS_BIG);
    const float* convw = a.in[I_FCW] + (size_t)l * 3 * DFF; const float* convb = a.in[I_FCB] + (size_t)l * DFF;
    const float* cstate = a.in[I_SCONV] + (size_t)l * NS * 2 * DFF; float* convs = a.out + O_CONVS + (size_t)l * NS * 2 * DFF;
    for (int u = u0; u < 88; u += G) {
        const int ca = u * 32;
        const int nr = 256 * (ca >> 7) + (ca & 127);
        sgemm_tile<1024, 1024, 1024>(hbA + (size_t)SROW * D, W + (size_t)nr * 1024, W + (size_t)(nr + 128) * 1024, lds);
        __syncthreads();
        const int tid = otid(), b = tid >> 2, q = tid & 3, c = ca + 8 * q;
        float av[8], vv[8]; sreduce<8>(part, b, 8 * q, av); sreduce<8>(part, b, 32 + 8 * q, vv);
        const float rs = s_row_rs(part_in, b);
        const float* st = cstate + (size_t)b * 2 * DFF + c; float* so = convs + (size_t)b * 2 * DFF + c;
        float g[8];
#pragma unroll
        for (int j = 0; j < 8; j += 4) {
            const f32x4 p2 = *(const f32x4*)(st + j), p1 = *(const f32x4*)(st + DFF + j);
            const f32x4 w0 = *(const f32x4*)(convw + c + j), w1 = *(const f32x4*)(convw + DFF + c + j), w2 = *(const f32x4*)(convw + 2 * DFF + c + j), cb = *(const f32x4*)(convb + c + j);
            const f32x4 x = (f32x4){av[j] * rs, av[j + 1] * rs, av[j + 2] * rs, av[j + 3] * rs};
            *(f32x4*)(so + j) = p1; *(f32x4*)(so + DFF + j) = x;
            const f32x4 ac = cb + w0 * p2 + w1 * p1 + w2 * x;
            const f32x2 g0 = gelu_pk((f32x2){ac[0], ac[1]}), g1 = gelu_pk((f32x2){ac[2], ac[3]});
            g[j] = g0.x * vv[j] * rs; g[j + 1] = g0.y * vv[j + 1] * rs; g[j + 2] = g1.x * vv[j + 2] * rs; g[j + 3] = g1.y * vv[j + 3] * rs;
        }
        u32x4 w; w.x = cvt_pk_bf16(g[0], g[1]); w.y = cvt_pk_bf16(g[2], g[3]); w.z = cvt_pk_bf16(g[4], g[5]); w.w = cvt_pk_bf16(g[6], g[7]);
        *(u32x4*)(Gb + (size_t)(SROW + b) * DFF + c) = w;
        __syncthreads();
    }
}

__device__ __forceinline__ void tr_item(const float* W, int ldsrc, int scol0, int k0, const float* gain, bf16_t* dst, int ldd, int drow0, LAS float* scr, int lane) {
    float wv[32];
#pragma unroll
    for (int i = 0; i < 32; ++i) { const int kk = 2 * i + (lane >> 5); wv[i] = __builtin_nontemporal_load(W + (size_t)(k0 + kk) * ldsrc + scol0 + (lane & 31)); }
#pragma unroll
    for (int i = 0; i < 32; ++i) { const int kk = 2 * i + (lane >> 5); const float gsc = gain ? gain[k0 + kk] : 1.f; scr[kk * 33 + (lane & 31)] = wv[i] * gsc; }
    asm volatile("s_waitcnt lgkmcnt(0)" ::: "memory");
    const int c = lane & 7;
#pragma unroll
    for (int j = 0; j < 4; ++j) { const int n = (lane >> 3) + 8 * j; const LAS float* s = scr + (8 * c) * 33 + n;
        u32x4 o; o.x = cvt_pk_bf16(s[0 * 33], s[1 * 33]); o.y = cvt_pk_bf16(s[2 * 33], s[3 * 33]); o.z = cvt_pk_bf16(s[4 * 33], s[5 * 33]); o.w = cvt_pk_bf16(s[6 * 33], s[7 * 33]);
        *(u32x4*)(dst + (size_t)(drow0 + n) * ldd + k0 + 8 * c) = o; }
    asm volatile("s_waitcnt lgkmcnt(0)" ::: "memory");
}
__device__ __forceinline__ void weff_item(const float* Win, const float* wal, int n0, int k0, const float* gain, bf16_t* dst, int drow0, LAS float* scr, int lane) {
#pragma unroll 2
    for (int i = 0; i < 32; ++i) { const int kk = 2 * i + (lane >> 5); const int k = k0 + kk; float s = 0.f;
#pragma unroll
        for (int r = 0; r < 16; ++r) s += Win[(size_t)k * 2320 + 1024 + r] * wal[r * 256 + n0 + (lane & 31)];
        scr[kk * 33 + (lane & 31)] = s * gain[k]; }
    asm volatile("s_waitcnt lgkmcnt(0)" ::: "memory");
    const int c = lane & 7;
#pragma unroll
    for (int j = 0; j < 4; ++j) { const int n = (lane >> 3) + 8 * j; const LAS float* s = scr + (8 * c) * 33 + n;
        u32x4 o; o.x = cvt_pk_bf16(s[0 * 33], s[1 * 33]); o.y = cvt_pk_bf16(s[2 * 33], s[3 * 33]); o.z = cvt_pk_bf16(s[4 * 33], s[5 * 33]); o.w = cvt_pk_bf16(s[6 * 33], s[7 * 33]);
        *(u32x4*)(dst + (size_t)(drow0 + n) * 1024 + k0 + 8 * c) = o; }
    asm volatile("s_waitcnt lgkmcnt(0)" ::: "memory");
}

__device__ __forceinline__ void p0_prologue(const KArgs& a, LAS unsigned char* lds, int vcu, int G) {
    const int tid = otid(), lane = tid & 63, wave = __builtin_amdgcn_readfirstlane(tid >> 6);
    LAS float* scr = (LAS float*)(lds + wave * 16384);
    const int gw = vcu * 8 + wave, NGW = G * 8;
    unsigned char* ws = a.ws;
    constexpr int I_A = 16 * 72, I_E = 16 * 8;
    for (int it = gw; it < I_A + I_E; it += NGW) {
        int r = it;
        if (r < I_A) { const int kb = r / 72, nb = r % 72, n0 = nb * 32; tr_item(a.in[I_WIN], 2320, n0 < 1024 ? n0 : n0 + 16, kb * 64, a.in[I_MNE], (bf16_t*)(ws + WS_WIN0), 1024, n0, scr, lane); continue; } r -= I_A;
        { const int kb = r / 8, nb = r % 8; weff_item(a.in[I_WIN], a.in[I_WALPHA], nb * 32, kb * 64, a.in[I_MNE], (bf16_t*)(ws + WS_WIN0), NPROJ + nb * 32, scr, lane); }
    }
    bf16_t* xbf = (bf16_t*)(ws + WS_R1);
    float* ssq0 = (float*)(ws + WS_SSQ);
    for (int row0 = gw * 2; row0 < MT; row0 += NGW * 2) {
        f32x4 v[2][4];
#pragma unroll
        for (int rr = 0; rr < 2; ++rr) { const int row = row0 + rr;
            const float* src = row < SEQ ? a.in[I_XP] + (size_t)row * D : ((row >= SROW && row < SROW + NS) ? a.in[I_XS] + (size_t)(row - SROW) * D : nullptr);
#pragma unroll
            for (int j = 0; j < 4; ++j) { v[rr][j] = (f32x4){0.f, 0.f, 0.f, 0.f}; if (src) v[rr][j] = __builtin_nontemporal_load((const f32x4*)(src + j * 256 + lane * 4)); } }
#pragma unroll
        for (int rr = 0; rr < 2; ++rr) { const int row = row0 + rr; float s = 0.f;
#pragma unroll
            for (int j = 0; j < 4; ++j) { const f32x4 x = v[rr][j]; s += (x[0] * x[0] + x[1] * x[1]) + (x[2] * x[2] + x[3] * x[3]);
                u32x2 w; w.x = cvt_pk_bf16(x[0], x[1]); w.y = cvt_pk_bf16(x[2], x[3]);
                *(u32x2*)(xbf + (size_t)row * D + j * 256 + lane * 4) = w; }
            s = wave_sum(s);
            if (lane == 0) ssq0[row] = s; }
    }
    if (vcu == 0) { for (int i = tid; i < 256; i += NTHREADS) ((u32x4*)(ws + WS_R2))[i] = (u32x4){0u, 0u, 0u, 0u}; }
    if (vcu == 1 && tid < 6 * 32) { float* pt = (float*)(ws + WS_SSQ + 262144 + (size_t)(tid >> 5) * PART_STRIDE); pt[tid & 31] = 0.f; }
}
__device__ __forceinline__ void p3_convert(const KArgs& a, LAS unsigned char* lds, int vcu, int G) {
    const int tid = otid(), lane = tid & 63, wave = __builtin_amdgcn_readfirstlane(tid >> 6);
    if (wave < 2) return;
    LAS float* scr = (LAS float*)(lds + wave * 16384);
    const int gw = vcu * 6 + (wave - 2), NGW = G * 6;
    unsigned char* ws = a.ws;
    constexpr int I_O = 16 * 32, I_FI = 16 * 176, I_FO = 44 * 32, I_G = 16 * 32, I_P = 4 * 32, I_PL = 4 * 32;
    constexpr int NITEMS = I_O + 2 * I_FI + 2 * I_FO + 2 * I_G + 2 * I_P + I_PL;
    for (int it = gw; it < NITEMS; it += NGW) {
        int r = it;
        if (r < I_O) { const int kb = r / 32, nb = r % 32; tr_item(a.in[I_WOUT], 1024, nb * 32, kb * 64, nullptr, (bf16_t*)(ws + WS_WOUT0), 1024, nb * 32, scr, lane); continue; } r -= I_O;
        if (r < 2 * I_FI) { const int l = r / I_FI, q = r % I_FI, kb = q / 176, nb = q % 176, n0 = nb * 32;
            const int pn = n0 >> 8, rr = n0 & 255, bj = rr >> 7, ii = rr & 127;
            tr_item(a.in[I_FWIN] + (size_t)l * 1024 * 5632, 5632, bj * DFF + pn * 128 + ii, kb * 64, a.in[I_FNORM] + l * 1024, (bf16_t*)(ws + WS_WFFI + l * WFFI_BYTES), 1024, n0, scr, lane); continue; } r -= 2 * I_FI;
        if (r < 2 * I_FO) { const int l = r / I_FO, q = r % I_FO, kb = q / 32, nb = q % 32;
            tr_item(a.in[I_FWOUT] + (size_t)l * DFF * 1024, 1024, nb * 32, kb * 64, nullptr, (bf16_t*)(ws + WS_WFFO + l * WFFO_BYTES), DFF, nb * 32, scr, lane); continue; } r -= 2 * I_FO;
        if (r < 2 * I_G) { const int l = r / I_G, q = r % I_G, kb = q / 32, nb = q % 32;
            tr_item(a.in[I_PWGATE] + (size_t)l * 1024 * 1024, 1024, nb * 32, kb * 64, a.in[I_PNORM] + l * 1024, (bf16_t*)(ws + WS_WGATE + l * WGATE_BYTES), 1024, nb * 32, scr, lane); continue; } r -= 2 * I_G;
        if (r < 2 * I_P) { const int l = r / I_P, q = r % I_P, kb = q / 32, nb = q % 32;
            tr_item(a.in[I_PWPROJ] + (size_t)l * 256 * 1024, 1024, nb * 32, kb * 64, nullptr, (bf16_t*)(ws + WS_WPROJ + l * WPROJ_BYTES), 256, nb * 32, scr, lane); continue; } r -= 2 * I_P;
        { const int gq = r / 32, q = r % 32, kb = q / 8, nb = q % 8;
            tr_item(a.in[I_POOLW] + (size_t)gq * 65536, 256, nb * 32, kb * 64, nullptr, (bf16_t*)(ws + WS_WPOOL), 256, gq * 256 + nb * 32, scr, lane); }
    }
    bf16_t* pbf = (bf16_t*)(ws + WS_PBF);
    for (int it0 = gw * 4; it0 < 2 * MT; it0 += NGW * 4) {
        f32x4 v[4];
#pragma unroll
        for (int rr = 0; rr < 4; ++rr) { const int it = it0 + rr; const int l = it / MT, row = it % MT;
            const float* src = row < SEQ ? a.in[I_PP] + ((size_t)l * SEQ + row) * PLE : ((row >= SROW && row < SROW + NS) ? a.in[I_PS] + ((size_t)l * NS + (row - SROW)) * PLE : nullptr);
            v[rr] = (f32x4){0.f, 0.f, 0.f, 0.f}; if (src) v[rr] = __builtin_nontemporal_load((const f32x4*)(src + lane * 4)); }
#pragma unroll
        for (int rr = 0; rr < 4; ++rr) { u32x2 w; w.x = cvt_pk_bf16(v[rr][0], v[rr][1]); w.y = cvt_pk_bf16(v[rr][2], v[rr][3]);
            *(u32x2*)(pbf + (size_t)(it0 + rr) * PLE + lane * 4) = w; }
    }
}

__device__ __forceinline__ int crow(int i, int hh) { return (i & 3) + 8 * (i >> 2) + 4 * hh; }
template <bool OUT>
__device__ __forceinline__ void gla_item_m(const KArgs& a, LAS unsigned char* lds, int item) {
    const int tid = otid(), lane = tid & 63, wave = __builtin_amdgcn_readfirstlane(tid >> 6);
    const int sc = item >> 2, h = item & 3;
    const bf16_t* proj = (const bf16_t*)(a.ws + WS_BIG); const float* la = (const float*)(a.ws + WS_BIG + BIG_LA);
    bf16_t* mix = (bf16_t*)(a.ws + WS_R1);
    float* US = (float*)(a.ws + WS_R2 + 4096); float* DS = US + (size_t)64 * 4 * 64 * 128;
    LAS float* bL = (LAS float*)lds; LAS float* segS = (LAS float*)(lds + 16384);
    LAS bf16_t* Qn = (LAS bf16_t*)(lds + 18432); LAS bf16_t* Kn = (LAS bf16_t*)(lds + 27648); LAS bf16_t* KT = (LAS bf16_t*)(lds + 36864);
    LAS bf16_t* VT = (LAS bf16_t*)(lds + 46080); LAS bf16_t* ST = (LAS bf16_t*)(lds + 64512); LAS float* red = (LAS float*)(lds + 82944);
    const int r = lane & 31, hh = lane >> 5;
    const int dkt = wave & 1, dvt = wave >> 1, it = wave & 1;
    f32x16 S = {};
    float* usp = US + ((size_t)(sc * 4 + h) * 64 + 32 * dkt) * 128 + 32 * dvt + r;
    if (OUT) {
#pragma unroll
        for (int i = 0; i < 16; ++i) S[i] = usp[(size_t)crow(i, hh) * 128];
    }
    float bsum = 0.f;
#pragma unroll 1
    for (int c = 0; c < 4; ++c) {
        const int T0 = sc * 256 + c * 64;
        if (OUT) {
#pragma unroll
            for (int q = 0; q < 4; ++q) { u32x2 w; w.x = cvt_pk_bf16(S[4 * q], S[4 * q + 1]); w.y = cvt_pk_bf16(S[4 * q + 2], S[4 * q + 3]);
                *(LAS u32x2*)(ST + (32 * dvt + r) * 72 + 32 * dkt + 8 * q + 4 * hh) = w; }
        }
        {
            const int dk = tid & 63, seg = tid >> 6;
            float v[8];
#pragma unroll
            for (int i = 0; i < 8; ++i) v[i] = la[(size_t)(T0 + 8 * seg + i) * 256 + h * 64 + dk];
#pragma unroll
            for (int i = 1; i < 8; ++i) v[i] += v[i - 1];
            segS[seg * 64 + dk] = v[7];
            __syncthreads();
            float off = 0.f;
#pragma unroll
            for (int s = 0; s < 8; ++s) { const float x = segS[s * 64 + dk]; off += (s < seg) ? x : 0.f; }
#pragma unroll
            for (int i = 0; i < 8; ++i) bL[(8 * seg + i) * 64 + dk] = v[i] + off;
            __syncthreads();
        }
        {
            const int t = tid >> 3, d8 = (tid & 7) * 8;
            const f32x4 b0 = *(const LAS f32x4*)(bL + t * 64 + d8), b1 = *(const LAS f32x4*)(bL + t * 64 + d8 + 4);
            const f32x4 l0 = *(const LAS f32x4*)(bL + 63 * 64 + d8), l1 = *(const LAS f32x4*)(bL + 63 * 64 + d8 + 4);
            float bb[8] = {b0[0], b0[1], b0[2], b0[3], b1[0], b1[1], b1[2], b1[3]}, bl[8] = {l0[0], l0[1], l0[2], l0[3], l1[0], l1[1], l1[2], l1[3]};
            const size_t prow = (size_t)(T0 + t) * NPROJ;
            float kf[8]; { const u32x4 kw = *(const u32x4*)(proj + prow + PKA + h * 64 + d8); unpack8(kw, kf); }
#pragma unroll
            for (int j = 0; j < 8; ++j) KT[(d8 + j) * 72 + t] = (bf16_t)(cvt_pk_bf16(kf[j] * __expf(bl[j] - bb[j]), 0.f) & 0xffffu);
            if (OUT) {
                float qf[8]; { const u32x4 qw = *(const u32x4*)(proj + prow + PQA + h * 64 + d8); unpack8(qw, qf); }
                float qq[8], kk[8];
#pragma unroll
                for (int j = 0; j < 8; ++j) { const float e = __expf(bb[j]); qq[j] = qf[j] * 0.125f * e; kk[j] = kf[j] * __expf(-bb[j]); }
                u32x4 w; w.x = cvt_pk_bf16(qq[0], qq[1]); w.y = cvt_pk_bf16(qq[2], qq[3]); w.z = cvt_pk_bf16(qq[4], qq[5]); w.w = cvt_pk_bf16(qq[6], qq[7]);
                *(LAS u32x4*)(Qn + t * 72 + d8) = w;
                w.x = cvt_pk_bf16(kk[0], kk[1]); w.y = cvt_pk_bf16(kk[2], kk[3]); w.z = cvt_pk_bf16(kk[4], kk[5]); w.w = cvt_pk_bf16(kk[6], kk[7]);
                *(LAS u32x4*)(Kn + t * 72 + d8) = w;
            }
#pragma unroll
            for (int i = 0; i < 2; ++i) { const int dv8 = d8 + 64 * i;
                const u32x4 vw = *(const u32x4*)(proj + prow + PVA + h * 128 + dv8);
                LAS bf16_t* vt = VT + dv8 * 72 + t;
                vt[0 * 72] = (bf16_t)(vw.x & 0xffffu); vt[1 * 72] = (bf16_t)(vw.x >> 16); vt[2 * 72] = (bf16_t)(vw.y & 0xffffu); vt[3 * 72] = (bf16_t)(vw.y >> 16);
                vt[4 * 72] = (bf16_t)(vw.z & 0xffffu); vt[5 * 72] = (bf16_t)(vw.z >> 16); vt[6 * 72] = (bf16_t)(vw.w & 0xffffu); vt[7 * 72] = (bf16_t)(vw.w >> 16); }
            if (tid < 64) bsum += bL[63 * 64 + tid];
        }
        __syncthreads();
        if (OUT) {
            bf16x8 qf[4];
#pragma unroll
            for (int s = 0; s < 4; ++s) qf[s] = *(const LAS bf16x8*)(Qn + (32 * it + r) * 72 + 16 * s + 8 * hh);
            f32x16 oacc = {};
#pragma unroll
            for (int jt = 0; jt < 2; ++jt) {
                if (jt <= it) {
                    f32x16 at = {};
#pragma unroll
                    for (int s = 0; s < 4; ++s) { const bf16x8 af = *(const LAS bf16x8*)(Kn + (32 * jt + r) * 72 + 16 * s + 8 * hh); at = __builtin_amdgcn_mfma_f32_32x32x16_bf16(af, qf[s], at, 0, 0, 0); }
                    if (jt == it) {
#pragma unroll
                        for (int i = 0; i < 16; ++i) if (crow(i, hh) > r) at[i] = 0.f;
                    }
#pragma unroll
                    for (int s2 = 0; s2 < 2; ++s2) {
                        u32x4 pw; pw.x = cvt_pk_bf16(at[8 * s2 + 0], at[8 * s2 + 1]); pw.y = cvt_pk_bf16(at[8 * s2 + 2], at[8 * s2 + 3]);
                        pw.z = cvt_pk_bf16(at[8 * s2 + 4], at[8 * s2 + 5]); pw.w = cvt_pk_bf16(at[8 * s2 + 6], at[8 * s2 + 7]);
                        const LAS bf16_t* vp = VT + (32 * dvt + r) * 72 + 32 * jt + 16 * s2 + 4 * hh;
                        const u32x2 v0 = *(const LAS u32x2*)vp, v1 = *(const LAS u32x2*)(vp + 8);
                        const u32x4 vv = (u32x4){v0.x, v0.y, v1.x, v1.y};
                        oacc = __builtin_amdgcn_mfma_f32_32x32x16_bf16(__builtin_bit_cast(bf16x8, vv), __builtin_bit_cast(bf16x8, pw), oacc, 0, 0, 0);
                    }
                }
            }
#pragma unroll
            for (int s = 0; s < 4; ++s) { const bf16x8 af = *(const LAS bf16x8*)(ST + (32 * dvt + r) * 72 + 16 * s + 8 * hh); oacc = __builtin_amdgcn_mfma_f32_32x32x16_bf16(af, qf[s], oacc, 0, 0, 0); }
            float ss = 0.f;
#pragma unroll
            for (int i = 0; i < 16; ++i) ss += oacc[i] * oacc[i];
            ss += __shfl_xor(ss, 32);
            if (hh == 0) red[wave * 32 + r] = ss;
            __syncthreads();
            const float tot = (red[it * 32 + r] + red[(it + 2) * 32 + r]) + (red[(it + 4) * 32 + r] + red[(it + 6) * 32 + r]);
            const float rstd = rsqrtf(tot * (1.0f / 128.f) + EPS);
            const int t = T0 + 32 * it + r;
#pragma unroll
            for (int q = 0; q < 4; ++q) {
                const int dv0 = 32 * dvt + 8 * q + 4 * hh;
                const u32x2 rw = *(const u32x2*)(proj + (size_t)t * NPROJ + PRA + h * 128 + dv0);
                const f32x4 on = *(const f32x4*)(a.in[I_ONORM] + dv0);
                const float r0 = bf_lo(rw.x), r1 = bf_hi(rw.x), r2 = bf_lo(rw.y), r3 = bf_hi(rw.y);
                const float y0 = oacc[4 * q] * rstd * on[0] * (r0 / (1.f + __expf(-r0))), y1 = oacc[4 * q + 1] * rstd * on[1] * (r1 / (1.f + __expf(-r1)));
                const float y2 = oacc[4 * q + 2] * rstd * on[2] * (r2 / (1.f + __expf(-r2))), y3 = oacc[4 * q + 3] * rstd * on[3] * (r3 / (1.f + __expf(-r3)));
                u32x2 w; w.x = cvt_pk_bf16(y0, y1); w.y = cvt_pk_bf16(y2, y3);
                *(u32x2*)(mix + (size_t)t * D + h * 128 + dv0) = w;
            }
        }
#pragma unroll
        for (int i = 0; i < 16; ++i) S[i] *= __expf(bL[63 * 64 + 32 * dkt + crow(i, hh)]);
#pragma unroll
        for (int s = 0; s < 4; ++s) {
            const bf16x8 af = *(const LAS bf16x8*)(KT + (32 * dkt + r) * 72 + 16 * s + 8 * hh), bf = *(const LAS bf16x8*)(VT + (32 * dvt + r) * 72 + 16 * s + 8 * hh);
            S = __builtin_amdgcn_mfma_f32_32x32x16_bf16(af, bf, S, 0, 0, 0);
        }
        __syncthreads();
    }
    if (!OUT) {
#pragma unroll
        for (int i = 0; i < 16; ++i) usp[(size_t)crow(i, hh) * 128] = S[i];
        if (tid < 64) DS[(sc * 4 + h) * 64 + tid] = __expf(bsum);
    }
}
__device__ __forceinline__ void gla_scan_m(const KArgs& a, int vcu) {
    const int tid = otid(); if (tid >= 128) return;
    const int e = vcu * 128 + tid; if (e >= 32768) return;
    float* US = (float*)(a.ws + WS_R2 + 4096); const float* DS = US + (size_t)64 * 4 * 64 * 128;
    const int hd = e >> 7;
    float S = 0.f;
    for (int c0 = 0; c0 < 64; c0 += 8) {
        float u[8], d[8];
#pragma unroll
        for (int j = 0; j < 8; ++j) { u[j] = US[(size_t)(c0 + j) * 32768 + e]; d[j] = DS[(c0 + j) * 256 + hd]; }
#pragma unroll
        for (int j = 0; j < 8; ++j) { US[(size_t)(c0 + j) * 32768 + e] = S; S = d[j] * S + u[j]; }
    }
    a.out[O_GLAP + e] = S;
}
__device__ __forceinline__ void gla_decode_item(const KArgs& a, int item, int lane) {
    const int b = item >> 2, h = item & 3; const int row = SROW + b;
    const bf16_t* proj = (const bf16_t*)(a.ws + WS_BIG); const float* la = (const float*)(a.ws + WS_BIG + BIG_LA);
    bf16_t* mix = (bf16_t*)(a.ws + WS_R1);
    const float* S0 = a.in[I_SGLA] + ((size_t)b * 4 + h) * 8192;
    float* S1 = a.out + O_GLAS + ((size_t)b * 4 + h) * 8192;
    const float qv = bf2f(proj[(size_t)row * NPROJ + PQA + h * 64 + lane]) * 0.125f;
    const float kv = bf2f(proj[(size_t)row * NPROJ + PKA + h * 64 + lane]);
    const float av = __expf(la[(size_t)row * 256 + h * 64 + lane]);
    const unsigned vw = *(const unsigned*)(proj + (size_t)row * NPROJ + PVA + h * 128 + lane * 2);
    const float v0 = bf_lo(vw), v1 = bf_hi(vw);
    float o0 = 0.f, o1 = 0.f;
#pragma unroll 1
    for (int d0 = 0; d0 < 64; d0 += 16) {
        f32x2 sv[16];
#pragma unroll
        for (int j = 0; j < 16; ++j) sv[j] = __builtin_nontemporal_load((const f32x2*)(S0 + (d0 + j) * 128 + lane * 2));
#pragma unroll
        for (int j = 0; j < 16; ++j) {
            const int dk = d0 + j;
            const float q = __shfl(qv, dk), k = __shfl(kv, dk), al = __shfl(av, dk);
            const float n0 = al * sv[j].x + k * v0, n1 = al * sv[j].y + k * v1;
            __builtin_nontemporal_store((f32x2){n0, n1}, (f32x2*)(S1 + dk * 128 + lane * 2));
            o0 += q * n0; o1 += q * n1;
        }
    }
    const float ss = wave_sum(o0 * o0 + o1 * o1);
    const float rstd = rsqrtf(ss * (1.0f / 128.f) + EPS);
    const unsigned rw = *(const unsigned*)(proj + (size_t)row * NPROJ + PRA + h * 128 + lane * 2);
    const float r0 = bf_lo(rw), r1 = bf_hi(rw);
    const float y0 = o0 * rstd * a.in[I_ONORM][lane * 2] * (r0 / (1.f + __expf(-r0))), y1 = o1 * rstd * a.in[I_ONORM][lane * 2 + 1] * (r1 / (1.f + __expf(-r1)));
    *(unsigned*)(mix + (size_t)row * D + h * 128 + lane * 2) = cvt_pk_bf16(y0, y1);
}

__device__ __forceinline__ void swa_unit_m(const KArgs& a, LAS unsigned char* lds, int unit) {
    const int tid = otid(), lane = tid & 63, wave = __builtin_amdgcn_readfirstlane(tid >> 6);
    const int qb = unit >> 1, kvh = unit & 1; const int q0 = qb * 64, w0 = q0 - 128;
    const bf16_t* proj = (const bf16_t*)(a.ws + WS_BIG);
    bf16_t* mix = (bf16_t*)(a.ws + WS_R1);
    LAS bf16_t* Kl = (LAS bf16_t*)lds;
    LAS bf16_t* Vt = Kl + 192 * 72;
    const float* kn = a.in[I_KNORM];
#pragma unroll 1
    for (int c = tid; c < 1536; c += NTHREADS) {
        const int kk = c >> 3, part = c & 7; const int tk = w0 + kk;
        float kf[8];
        u32x4 vw = (u32x4){0u, 0u, 0u, 0u};
#pragma unroll
        for (int j = 0; j < 8; ++j) kf[j] = 0.f;
        if (tk >= 0) {
            const u32x4 kw = *(const u32x4*)(proj + (size_t)tk * NPROJ + PKB + kvh * 64 + part * 8); unpack8(kw, kf);
            vw = *(const u32x4*)(proj + (size_t)tk * NPROJ + PVB + kvh * 64 + part * 8);
        }
        float ss = 0.f;
#pragma unroll
        for (int j = 0; j < 8; ++j) ss += kf[j] * kf[j];
        ss += __shfl_xor(ss, 1); ss += __shfl_xor(ss, 2); ss += __shfl_xor(ss, 4);
        const float rstd = rsqrtf(ss * (1.0f / 64.f) + EPS);
#pragma unroll
        for (int j = 0; j < 8; ++j) kf[j] = kf[j] * rstd * kn[part * 8 + j];
        u32x4 kw2; kw2.x = cvt_pk_bf16(kf[0], kf[1]); kw2.y = cvt_pk_bf16(kf[2], kf[3]); kw2.z = cvt_pk_bf16(kf[4], kf[5]); kw2.w = cvt_pk_bf16(kf[6], kf[7]);
        *(LAS u32x4*)(Kl + kk * 72 + part * 8) = kw2;
        LAS bf16_t* vt = Vt + (part * 8) * 196 + kk;
        vt[0 * 196] = (bf16_t)(vw.x & 0xffffu); vt[1 * 196] = (bf16_t)(vw.x >> 16); vt[2 * 196] = (bf16_t)(vw.y & 0xffffu); vt[3 * 196] = (bf16_t)(vw.y >> 16);
        vt[4 * 196] = (bf16_t)(vw.z & 0xffffu); vt[5 * 196] = (bf16_t)(vw.z >> 16); vt[6 * 196] = (bf16_t)(vw.w & 0xffffu); vt[7 * 196] = (bf16_t)(vw.w >> 16);
        if (qb == 255 && kk >= 64) {
            const int w = kk - 64;
            float vf[8]; unpack8(vw, vf);
            float* ko = a.out + O_SKP + ((size_t)w * 2 + kvh) * 64 + part * 8; float* vo = a.out + O_SVP + ((size_t)w * 2 + kvh) * 64 + part * 8;
            *(f32x4*)ko = (f32x4){kf[0], kf[1], kf[2], kf[3]}; *(f32x4*)(ko + 4) = (f32x4){kf[4], kf[5], kf[6], kf[7]};
            *(f32x4*)vo = (f32x4){vf[0], vf[1], vf[2], vf[3]}; *(f32x4*)(vo + 4) = (f32x4){vf[4], vf[5], vf[6], vf[7]};
        }
    }
    __syncthreads();
    const int g = wave & 3, th = wave >> 2, hq = kvh * 4 + g;
    const int r = lane & 31, hh = lane >> 5;
    const int t = q0 + 32 * th + r;
    constexpr float LOG2E = 1.4426950408889634f;
    bf16x8 qf[4];
    {
        float qv[4][8]; float ss = 0.f;
#pragma unroll
        for (int s = 0; s < 4; ++s) { const u32x4 w = *(const u32x4*)(proj + (size_t)t * NPROJ + PQB + hq * 64 + 16 * s + 8 * hh); unpack8(w, qv[s]);
#pragma unroll
            for (int j = 0; j < 8; ++j) ss += qv[s][j] * qv[s][j]; }
        ss += __shfl_xor(ss, 32);
        const float rstd = rsqrtf(ss * (1.0f / 64.f) + EPS) * (0.125f * LOG2E);
        const float* qn = a.in[I_QNORM];
#pragma unroll
        for (int s = 0; s < 4; ++s) {
            u32x4 w;
            w.x = cvt_pk_bf16(qv[s][0] * rstd * qn[16 * s + 8 * hh + 0], qv[s][1] * rstd * qn[16 * s + 8 * hh + 1]);
            w.y = cvt_pk_bf16(qv[s][2] * rstd * qn[16 * s + 8 * hh + 2], qv[s][3] * rstd * qn[16 * s + 8 * hh + 3]);
            w.z = cvt_pk_bf16(qv[s][4] * rstd * qn[16 * s + 8 * hh + 4], qv[s][5] * rstd * qn[16 * s + 8 * hh + 5]);
            w.w = cvt_pk_bf16(qv[s][6] * rstd * qn[16 * s + 8 * hh + 6], qv[s][7] * rstd * qn[16 * s + 8 * hh + 7]);
            qf[s] = __builtin_bit_cast(bf16x8, w);
        }
    }
    f32x16 sacc[5];
#pragma unroll
    for (int k5 = 0; k5 < 5; ++k5) {
        const int kt = th + k5;
        f32x16 acc = {};
#pragma unroll
        for (int s = 0; s < 4; ++s) { const bf16x8 af = *(const LAS bf16x8*)(Kl + (kt * 32 + r) * 72 + 16 * s + 8 * hh); acc = __builtin_amdgcn_mfma_f32_32x32x16_bf16(af, qf[s], acc, 0, 0, 0); }
        sacc[k5] = acc;
    }
    const float slope2 = exp2f(-(float)(hq + 1)) * LOG2E;
    const float sink2 = a.in[I_SINKS][hq] * LOG2E;
    float mx = sink2;
#pragma unroll
    for (int k5 = 0; k5 < 5; ++k5)
#pragma unroll
        for (int i = 0; i < 16; ++i) {
            const int row = (i & 3) + 8 * (i >> 2) + 4 * hh;
            const int dist = 128 - 32 * k5 + r - row;
            const int tk = w0 + 32 * (th + k5) + row;
            float s = sacc[k5][i] - slope2 * (float)dist;
            if (dist < 0 || dist >= 128 || tk < 0) s = -1e30f;
            sacc[k5][i] = s; mx = fmaxf(mx, s);
        }
    mx = fmaxf(mx, __shfl_xor(mx, 32));
    float l = 0.f;
#pragma unroll
    for (int k5 = 0; k5 < 5; ++k5)
#pragma unroll
        for (int i = 0; i < 16; ++i) { const float p = exp2f(sacc[k5][i] - mx); sacc[k5][i] = p; l += p; }
    l += __shfl_xor(l, 32);
    l += exp2f(sink2 - mx);
    f32x16 oacc[2] = {{}, {}};
#pragma unroll
    for (int k5 = 0; k5 < 5; ++k5) {
        const int kt = th + k5;
#pragma unroll
        for (int s2 = 0; s2 < 2; ++s2) {
            u32x4 pw;
            pw.x = cvt_pk_bf16(sacc[k5][8 * s2 + 0], sacc[k5][8 * s2 + 1]); pw.y = cvt_pk_bf16(sacc[k5][8 * s2 + 2], sacc[k5][8 * s2 + 3]);
            pw.z = cvt_pk_bf16(sacc[k5][8 * s2 + 4], sacc[k5][8 * s2 + 5]); pw.w = cvt_pk_bf16(sacc[k5][8 * s2 + 6], sacc[k5][8 * s2 + 7]);
            const bf16x8 pf = __builtin_bit_cast(bf16x8, pw);
#pragma unroll
            for (int dt = 0; dt < 2; ++dt) {
                const LAS bf16_t* vp = Vt + (32 * dt + r) * 196 + kt * 32 + 16 * s2 + 4 * hh;
                const u32x2 v0 = *(const LAS u32x2*)vp, v1 = *(const LAS u32x2*)(vp + 8);
                const u32x4 vv = (u32x4){v0.x, v0.y, v1.x, v1.y};
                oacc[dt] = __builtin_amdgcn_mfma_f32_32x32x16_bf16(__builtin_bit_cast(bf16x8, vv), pf, oacc[dt], 0, 0, 0);
            }
        }
    }
    const float inv = 1.f / l;
#pragma unroll
    for (int dt = 0; dt < 2; ++dt)
#pragma unroll
        for (int q = 0; q < 4; ++q) {
            u32x2 w; w.x = cvt_pk_bf16(oacc[dt][4 * q] * inv, oacc[dt][4 * q + 1] * inv); w.y = cvt_pk_bf16(oacc[dt][4 * q + 2] * inv, oacc[dt][4 * q + 3] * inv);
            *(u32x2*)(mix + (size_t)t * D + 512 + hq * 64 + 32 * dt + 8 * q + 4 * hh) = w;
        }
    __syncthreads();
}
__device__ __forceinline__ void swa_decode_item(const KArgs& a, int item, int lane) {
    const int b = item >> 3, kvh = (item >> 2) & 1, g = item & 3, hq = kvh * 4 + g; const int row = SROW + b;
    const bf16_t* proj = (const bf16_t*)(a.ws + WS_BIG);
    bf16_t* mix = (bf16_t*)(a.ws + WS_R1);
    const float* ck = a.in[I_CK] + (size_t)b * 128 * 128 + kvh * 64;
    const float* cv = a.in[I_CV] + (size_t)b * 128 * 128 + kvh * 64;
    float qd = bf2f(proj[(size_t)row * NPROJ + PQB + hq * 64 + lane]);
    { const float ss = wave_sum(qd * qd); qd = qd * rsqrtf(ss * (1.0f / 64.f) + EPS) * a.in[I_QNORM][lane] * 0.125f; }
    float kd = bf2f(proj[(size_t)row * NPROJ + PKB + kvh * 64 + lane]);
    { const float ss = wave_sum(kd * kd); kd = kd * rsqrtf(ss * (1.0f / 64.f) + EPS) * a.in[I_KNORM][lane]; }
    const float vd = bf2f(proj[(size_t)row * NPROJ + PVB + kvh * 64 + lane]);
    const float slope = exp2f(-(float)(hq + 1));
    float s0 = 0.f, s1 = 0.f;
    for (int d = 0; d < 64; d += 4) {
        const f32x4 k0 = *(const f32x4*)(ck + (size_t)lane * 128 + d), k1 = *(const f32x4*)(ck + (size_t)(lane + 64) * 128 + d);
        const float q0 = __shfl(qd, d), q1 = __shfl(qd, d + 1), q2 = __shfl(qd, d + 2), q3 = __shfl(qd, d + 3);
        s0 += (q0 * k0[0] + q1 * k0[1]) + (q2 * k0[2] + q3 * k0[3]);
        s1 += (q0 * k1[0] + q1 * k1[1]) + (q2 * k1[2] + q3 * k1[3]);
    }
    s0 -= slope * (float)(128 - lane); s1 -= slope * (float)(64 - lane);
    if (lane == 0) s0 = -1e30f;
    const float sn = wave_sum(qd * kd);
    const float sink = a.in[I_SINKS][hq];
    const float mx = fmaxf(fmaxf(wave_max(fmaxf(s0, s1)), sn), sink);
    const float p0 = __expf(s0 - mx), p1 = __expf(s1 - mx), pn = __expf(sn - mx);
    const float l = wave_sum(p0 + p1) + pn + __expf(sink - mx);
    float od = pn * vd;
#pragma unroll 1
    for (int w0 = 0; w0 < 64; w0 += 16) {
        float ca[16], cb[16];
#pragma unroll
        for (int j = 0; j < 16; ++j) { ca[j] = cv[(size_t)(w0 + j) * 128 + lane]; cb[j] = cv[(size_t)(w0 + j + 64) * 128 + lane]; }
#pragma unroll
        for (int j = 0; j < 16; ++j) { const float pa = __shfl(p0, w0 + j), pb = __shfl(p1, w0 + j); od += pa * ca[j] + pb * cb[j]; }
    }
    od /= l;
    const float oo = __shfl_down(od, 1);
    if ((lane & 1) == 0) *(unsigned*)(mix + (size_t)row * D + 512 + hq * 64 + lane) = cvt_pk_bf16(od, oo);
    if (g == 0) {
        float* __restrict__ ko = a.out + O_SKS + (size_t)b * 128 * 128 + kvh * 64; float* __restrict__ vo = a.out + O_SVS + (size_t)b * 128 * 128 + kvh * 64;
#pragma unroll 1
        for (int w0 = 0; w0 < 128; w0 += 16) {
            float ka[16], va[16];
#pragma unroll
            for (int j = 0; j < 16; ++j) { const int w = w0 + j + 1; ka[j] = (w < 128) ? ck[(size_t)w * 128 + lane] : kd; va[j] = (w < 128) ? cv[(size_t)w * 128 + lane] : vd; }
#pragma unroll
            for (int j = 0; j < 16; ++j) { ko[(size_t)(w0 + j) * 128 + lane] = ka[j]; vo[(size_t)(w0 + j) * 128 + lane] = va[j]; }
        }
    }
}

template <int W>
__device__ __forceinline__ void pool_core(const bf16_t* __restrict__ h, const LAS float* rsL, float gg, int r0, int c, bf16_t* __restrict__ d1, float* __restrict__ poolp) {
    float xn[31];
#pragma unroll
    for (int i = 0; i < 31; ++i) { const int r = r0 - 15 + i; xn[i] = (i >= 16 - W && r >= 0) ? bf2f(h[(size_t)r * D + c]) : 0.f; }
#pragma unroll
    for (int i = 0; i < 31; ++i) xn[i] *= rsL[i] * gg;
    float s = 0.f;
#pragma unroll
    for (int j = 1; j < W; ++j) s += xn[15 - j];
#pragma unroll
    for (int i = 0; i < 16; ++i) {
        const int r = r0 + i;
        s += xn[15 + i];
        const int cnt = (r + 1 < W) ? r + 1 : W;
        const float dd = s / (float)cnt - xn[15 + i];
        d1[(size_t)r * D + c] = (bf16_t)(cvt_pk_bf16(dd, 0.f) & 0xffffu);
        s -= xn[15 + i - (W - 1)];
        if (r >= SEQ - 15) poolp[(size_t)(r - (SEQ - 15)) * D + c] = xn[15 + i];
    }
}
__device__ __forceinline__ void pool_item(const KArgs& a, LAS unsigned char* lds, int item, const float* part_in) {
    const int tid = otid();
    const bf16_t* h = (const bf16_t*)(a.ws + WS_R2 + 4096); bf16_t* d1 = (bf16_t*)(a.ws + WS_R1);
    LAS float* rsL = (LAS float*)lds;
    const int r0 = item * 16;
    __syncthreads();
    if (tid < 31) { const int r = r0 - 15 + tid; float rs = 0.f;
        if (r >= 0) { const f32x4 p0 = *(const f32x4*)(part_in + (long)r * 16), p1 = *(const f32x4*)(part_in + (long)r * 16 + 4), p2 = *(const f32x4*)(part_in + (long)r * 16 + 8), p3 = *(const f32x4*)(part_in + (long)r * 16 + 12);
            const float s = ((p0[0] + p0[1]) + (p0[2] + p0[3])) + ((p1[0] + p1[1]) + (p1[2] + p1[3])) + ((p2[0] + p2[1]) + (p2[2] + p2[3])) + ((p3[0] + p3[1]) + (p3[2] + p3[3]));
            rs = rsqrtf(s * (1.0f / D) + EPS); }
        rsL[tid] = rs; }
    __syncthreads();
#pragma unroll
    for (int cc = 0; cc < 2; ++cc) {
        const int c = tid + cc * NTHREADS; const int gq = __builtin_amdgcn_readfirstlane(c >> 8);
        const float gg = a.in[I_MNO][c];
        if (gq == 0) pool_core<2>(h, rsL, gg, r0, c, d1, a.out + O_POOLP);
        else if (gq == 1) pool_core<4>(h, rsL, gg, r0, c, d1, a.out + O_POOLP);
        else if (gq == 2) pool_core<8>(h, rsL, gg, r0, c, d1, a.out + O_POOLP);
        else pool_core<16>(h, rsL, gg, r0, c, d1, a.out + O_POOLP);
    }
}
__device__ __forceinline__ void pool_sample_item(const KArgs& a, LAS unsigned char* lds, int b, const float* part_in) {
    const int tid = otid();
    const bf16_t* __restrict__ h = (const bf16_t*)(a.ws + WS_R2 + 4096) + (size_t)(SROW + b) * D; bf16_t* __restrict__ d1 = (bf16_t*)(a.ws + WS_R1);
    const float* __restrict__ st = a.in[I_SPOOL] + (size_t)b * 15 * D; float* __restrict__ so = a.out + O_POOLS + (size_t)b * 15 * D;
    float s = 0.f;
#pragma unroll
    for (int i = 0; i < 16; ++i) s += part_in[(long)(SROW + b) * 16 + i];
    const float rs = rsqrtf(s * (1.0f / D) + EPS);
#pragma unroll
    for (int cc = 0; cc < 2; ++cc) {
        const int c = tid + cc * NTHREADS; const int w = 2 << (c >> 8);
        float sv[15];
#pragma unroll
        for (int j = 0; j < 15; ++j) sv[j] = st[(size_t)j * D + c];
        const float xn = bf2f(h[c]) * rs * a.in[I_MNO][c];
        float sum = xn;
#pragma unroll
        for (int j = 0; j < 15; ++j) sum += (j >= 16 - w) ? sv[j] : 0.f;
        const float dd = sum / (float)w - xn;
        d1[(size_t)(SROW + b) * D + c] = (bf16_t)(cvt_pk_bf16(dd, 0.f) & 0xffffu);
#pragma unroll
        for (int j = 0; j < 14; ++j) so[(size_t)j * D + c] = sv[j + 1];
        so[(size_t)14 * D + c] = xn;
    }
}

#define XB_TMO      128
#define XB_XCNT(j)  (256  + 64 * (j))
#define XB_XSUB(j)  (1280 + 64 * (j))
#define XB_XGEN(j)  (2304 + 64 * (j))
#define XB_TOP      3328
#define XB_TOPGEN   3392
#define XCD_BAR_WORDS 3456
#define XB_SPIN_CAP (1u << 18)
__device__ __forceinline__ unsigned xb_ld(unsigned* p)              { return __hip_atomic_load(p, __ATOMIC_RELAXED, __HIP_MEMORY_SCOPE_AGENT); }
__device__ __forceinline__ unsigned xb_add(unsigned* p, unsigned v) { return __hip_atomic_fetch_add(p, v, __ATOMIC_RELAXED, __HIP_MEMORY_SCOPE_AGENT); }
__device__ __forceinline__ unsigned xb_xcc_id() { return (unsigned)__builtin_amdgcn_s_getreg((3 << 11) | 20) & 0xFu; }
#define XB_SPIN(cond, bar) do { unsigned _sp = 0; while (cond) { __builtin_amdgcn_s_sleep(1); \
    if ((++_sp & 255u) == 0u) { if (xb_ld(&(bar)[XB_TMO])) break; if (_sp > XB_SPIN_CAP) { atomicAdd(&(bar)[XB_TMO], 1u); break; } } } } while (0)
struct XcdBarrier { unsigned* bar; unsigned x; volatile LAS unsigned* st; };
__device__ __forceinline__ XcdBarrier xcd_barrier_post(unsigned* bar, volatile LAS unsigned* st) {
    XcdBarrier b; b.bar = bar; b.x = xb_xcc_id(); b.st = st;
    if (threadIdx.x == 0) (void)xb_add(&bar[XB_XCNT(b.x)], 1u);
    return b;
}
__device__ __forceinline__ void xcd_barrier_complete(unsigned* bar, unsigned x, unsigned& nloc, unsigned& nx) {
    const unsigned G = gridDim.x * gridDim.y * gridDim.z;
    unsigned sum, cnt, mine, sp = 0u;
    for (;;) {
        sum = 0u; cnt = 0u; mine = 0u;
#pragma unroll
        for (unsigned j = 0; j < 16; ++j) { const unsigned c = xb_ld(&bar[XB_XCNT(j)]); sum += c; cnt += (c > 0u) ? 1u : 0u; mine = (j == x) ? c : mine; }
        if (sum == G) break;
        __builtin_amdgcn_s_sleep(1);
        if ((++sp & 255u) == 0u) { if (xb_ld(&bar[XB_TMO])) break; if (sp > XB_SPIN_CAP) { atomicAdd(&bar[XB_TMO], 1u); break; } }
    }
    nloc = mine > 0u ? mine : 1u; nx = cnt > 0u ? cnt : 1u;
}
__device__ __forceinline__ void xcd_barrier(const XcdBarrier& b) {
    asm volatile("s_waitcnt vmcnt(0)" ::: "memory");
    __syncthreads();
    if (threadIdx.x == 0) {
        unsigned* bar = b.bar;
        __builtin_amdgcn_s_waitcnt(0);
        unsigned nloc = b.st[0], nx = b.st[1];
        if (nloc == 0u) { xcd_barrier_complete(bar, b.x, nloc, nx); b.st[0] = nloc; b.st[1] = nx; }
        const unsigned old = xb_add(&bar[XB_XSUB(b.x)], 1u);
        const unsigned gen = old / nloc;
        if (old + 1u == (gen + 1u) * nloc) {
            __builtin_amdgcn_fence(__ATOMIC_RELEASE, "agent");
            asm volatile("s_waitcnt vmcnt(0)" ::: "memory");
            const unsigned og = xb_add(&bar[XB_TOP], 1u);
            const unsigned tg = og / nx;
            if (og + 1u == (tg + 1u) * nx) xb_add(&bar[XB_TOPGEN], 1u);
            else XB_SPIN(xb_ld(&bar[XB_TOPGEN]) == tg, bar);
            __builtin_amdgcn_fence(__ATOMIC_ACQUIRE, "agent");
            xb_add(&bar[XB_XGEN(b.x)], 1u);
            asm volatile("s_waitcnt vmcnt(0)" ::: "memory");
        } else {
            XB_SPIN(xb_ld(&bar[XB_XGEN(b.x)]) == gen, bar);
            __builtin_amdgcn_fence(__ATOMIC_ACQUIRE, "agent");
            asm volatile("s_waitcnt vmcnt(0)" ::: "memory");
        }
    }
    __syncthreads();
}

#ifndef DUPM
#define DUPM 0
#endif
#ifndef SYNCREP
#define SYNCREP 1
#endif
#define GSYNC() do { _Pragma("unroll 1") for (int sr_ = 0; sr_ < SYNCREP; ++sr_) xcd_barrier(xbar); } while (0)
#define PH(k) _Pragma("unroll 1") for (int rep_ = 0; rep_ < (((DUPM) >> (k)) & 1) + 1; ++rep_)
__global__ void __launch_bounds__(NTHREADS, 2) mega_fwd(KArgs a) {
    extern __shared__ __attribute__((aligned(16))) unsigned char lds_raw[];
    LAS unsigned char* lds = (LAS unsigned char*)lds_raw;
    cg::grid_group grid = cg::this_grid();
    const int G = gridDim.x, bx = blockIdx.x;
    const int vcu = (G % 8 == 0) ? (bx % 8) * (G / 8) + bx / 8 : bx;
    unsigned char* ws = a.ws;
    if (ws == nullptr) grid.sync();
    volatile LAS unsigned* xst = (volatile LAS unsigned*)(lds + LDS_BYTES - 64);
    if (threadIdx.x < 16) xst[threadIdx.x] = 0u;
    __syncthreads();
    const XcdBarrier xbar = xcd_barrier_post((unsigned*)(ws + 16384), xst);
    bf16_t* R1 = (bf16_t*)(ws + WS_R1); bf16_t* R2 = (bf16_t*)(ws + WS_R2 + 4096);
    bf16_t* BIGB = (bf16_t*)(ws + WS_BIG);
    const bf16_t* pbf = (const bf16_t*)(ws + WS_PBF);

    PH(0) p0_prologue(a, lds, vcu, G);
    GSYNC();
    PH(1) {
        pg8::Gemm g{R1, (const bf16_t*)(ws + WS_WIN0), 1024, 1024, 1024, 256, 0, 0};
        pg8::StaticOrder S; S.init(64, 10, G, bx);
        EpiProj E{BIGB, (float*)(ws + WS_BIG + BIG_LA), (const float*)(ws + WS_SSQ), a.in[I_BALPHA]};
        pg8::gemm_phase(lds, g, S, E);
        s_proj_units(a, lds, (bx - (640 % G) + G) % G, G);
    }
    GSYNC();
    PH(2) for (int it = vcu; it < 256; it += G) gla_item_m<false>(a, lds, it);
    PH(3) for (int it = vcu; it < 512; it += G) swa_unit_m(a, lds, it);
    PH(4) { const int tid = otid(), lane = tid & 63, wave = __builtin_amdgcn_readfirstlane(tid >> 6); for (int it = vcu * 8 + wave; it < 512; it += G * 8) gla_decode_item(a, it, lane); }
    PH(5) { const int tid = otid(), lane = tid & 63, wave = __builtin_amdgcn_readfirstlane(tid >> 6); for (int it = vcu * 8 + wave; it < 1024; it += G * 8) swa_decode_item(a, it, lane); }
    GSYNC();
    PH(6) { gla_scan_m(a, vcu); p3_convert(a, lds, vcu, G); }
#if defined(PROBE_CONV)
    p3_convert(a, lds, vcu, G);
#endif
    GSYNC();
    PH(7) for (int it = vcu; it < 256; it += G) gla_item_m<true>(a, lds, it);
    GSYNC();
    PH(8) {
        pg8::Gemm g{R1, (const bf16_t*)(ws + WS_WOUT0), 1024, 1024, 1024, 256, 0, 0};
        pg8::StaticOrder S; S.init(64, 4, G, bx);
        EpiRes<0, true, true, false> E{a.out, a.in[I_XP], nullptr, R2, part_tab(ws, 0), nullptr, nullptr, nullptr};
        pg8::gemm_phase(lds, g, S, E);
        s_res_units<0, 1024, 1024>(a, lds, bx, G, R1, (const bf16_t*)(ws + WS_WOUT0), nullptr, R2, part_tab(ws, 0));
    }
#if defined(PROBE_FFNK)
    {
        pg8::Gemm g{R2, (const bf16_t*)(ws + WS_WFFI), 1024, 1024, 1024, 254, -2, 0};
        pg8::StaticOrder S; S.init(65, 22, G, bx);
        EpiNull E{};
        pg8::gemm_phase(lds, g, S, E);
    }
#endif
#if defined(PROBE_KLOOP)
    {
        pg8::Gemm g{R1, (const bf16_t*)(ws + WS_WOUT0), 1024, 1024, 1024, 256, 0, 0};
        pg8::StaticOrder S; S.init(64, 4, G, bx);
        EpiNull E{};
        for (int rep = 0; rep < PROBE_KLOOP; ++rep) pg8::gemm_phase(lds, g, S, E);
    }
#endif
#if defined(PROBE_SMALL)
    for (int rep = 0; rep < PROBE_SMALL; ++rep) s_res_units<0, 1024, 1024>(a, lds, bx, G, R1, (const bf16_t*)(ws + WS_WOUT0), nullptr, (bf16_t*)(ws + WS_BIG), part_tab(ws, 5));
#endif
    GSYNC();
#pragma unroll 1
    for (int l = 0; l < 2; ++l) {
        bf16_t* G_ = BIGB;
        bf16_t* PPb = BIGB;
        PH(9) {
            pg8::Gemm g{R2, (const bf16_t*)(ws + WS_WFFI + l * WFFI_BYTES), 1024, 1024, 1024, 254, -2, 0};
            pg8::StaticOrder S; S.init(65, 22, G, bx);
            EpiFfn E{part_tab(ws, l == 0 ? 0 : 3), a.in[I_FCW] + (size_t)l * 3 * DFF, a.in[I_FCB] + (size_t)l * DFF, a.out + O_CONVP + (size_t)l * 2 * DFF, G_};
            pg8::gemm_phase(lds, g, S, E);
            s_ffn_units(a, lds, (bx - (1430 % G) + G) % G, G, l, R2, part_tab(ws, l == 0 ? 0 : 3));
        }
        GSYNC();
        PH(10) {
            pg8::Gemm g{G_, (const bf16_t*)(ws + WS_WFFO + l * WFFO_BYTES), DFF, DFF, DFF, 256, 0, 0};
            pg8::StaticOrder S; S.init(64, 4, G, bx);
            EpiRes<1, true, true, false> E{a.out, nullptr, R2, R1, part_tab(ws, l == 0 ? 1 : 4), nullptr, nullptr, nullptr};
            pg8::gemm_phase(lds, g, S, E);
            s_res_units<1, DFF, DFF>(a, lds, bx, G, G_, (const bf16_t*)(ws + WS_WFFO + l * WFFO_BYTES), R2, R1, part_tab(ws, l == 0 ? 1 : 4));
        }
        GSYNC();
        PH(11) {
            pg8::Gemm g{pbf + (size_t)l * MT * PLE, (const bf16_t*)(ws + WS_WPROJ + l * WPROJ_BYTES), PLE, PLE, PLE, 256, 0, 0};
            pg8::StaticOrder S; S.init(64, 4, G, bx);
            EpiPP E{PPb};
            pg8::gemm_phase(lds, g, S, E);
        }
        PH(12) {
            pg8::Gemm g{R1, (const bf16_t*)(ws + WS_WGATE + l * WGATE_BYTES), 1024, 1024, 1024, 256, 0, 0};
            pg8::StaticOrder S; S.init(64, 4, G, bx);
            if (l == 0) { EpiRes<2, true, true, false> E{a.out, nullptr, R1, R2, part_tab(ws, 2), part_tab(ws, 1), PPb, nullptr}; pg8::gemm_phase(lds, g, S, E);
                s_ple_units<false>(a, lds, bx, G, pbf, (const bf16_t*)(ws + WS_WPROJ), R1, (const bf16_t*)(ws + WS_WGATE), part_tab(ws, 1), part_tab(ws, 2), R2); }
            else { EpiRes<2, false, false, true> E{a.out, nullptr, R1, nullptr, nullptr, part_tab(ws, 4), PPb, nullptr}; pg8::gemm_phase(lds, g, S, E);
                s_ple_units<true>(a, lds, bx, G, pbf + (size_t)MT * PLE, (const bf16_t*)(ws + WS_WPROJ + WPROJ_BYTES), R1, (const bf16_t*)(ws + WS_WGATE + WGATE_BYTES), part_tab(ws, 4), nullptr, nullptr); }
        }
        if (l == 0) {
            GSYNC();
            PH(13) for (int it = vcu; it < 1024 + NS; it += G) { if (it < 1024) pool_item(a, lds, it, part_tab(ws, 2)); else pool_sample_item(a, lds, it - 1024, part_tab(ws, 2)); }
            GSYNC();
            PH(14) {
                pg8::Gemm g{R1, (const bf16_t*)(ws + WS_WPOOL), 1024, 256, 256, 256, 0, 256};
                pg8::StaticOrder S; S.init(64, 4, G, bx);
                EpiRes<3, true, true, false> E{a.out, nullptr, R2, R2, part_tab(ws, 3), nullptr, nullptr, a.in[I_POOLSC]};
                pg8::gemm_phase(lds, g, S, E);
                s_res_units<3, 256, 1024>(a, lds, bx, G, R1, (const bf16_t*)(ws + WS_WPOOL), R2, R2, part_tab(ws, 3));
            }
            GSYNC();
        }
    }
}

extern "C" void kernel_launch(void* const* d_in, const int* in_sizes, int n_in, void* d_out, int out_size, void* d_ws, size_t ws_size, hipStream_t stream) {
    static int grid = 0;
    if (grid == 0) {
        int dev = 0, cus = 0, per_cu = 0;
        hipGetDevice(&dev);
        hipDeviceGetAttribute(&cus, hipDeviceAttributeMultiprocessorCount, dev);
        hipFuncSetAttribute((const void*)mega_fwd, hipFuncAttributeMaxDynamicSharedMemorySize, LDS_BYTES);
        hipOccupancyMaxActiveBlocksPerMultiprocessor(&per_cu, (const void*)mega_fwd, NTHREADS, LDS_BYTES);
        if (per_cu < 1) { fprintf(stderr, "kernel_launch: occupancy query reports %d blocks per CU\n", per_cu); per_cu = 1; }
        if (per_cu > 1) per_cu = 1;
        grid = cus * per_cu;
        (void)hipGetLastError();
    }
    (void)hipMemsetAsync(d_ws, 0, 65536, stream);
    KArgs a{};
    for (int i = 0; i < 29; ++i) a.in[i] = (const float*)d_in[i];
    a.out = (float*)d_out; a.ws = (unsigned char*)d_ws;
    void* args[] = {&a};
    hipError_t e = hipLaunchCooperativeKernel((const void*)mega_fwd, dim3(grid), dim3(NTHREADS), args, LDS_BYTES, stream);
    if (e != hipSuccess) fprintf(stderr, "cooperative launch failed: %s (grid %d)\n", hipGetErrorString(e), grid);
}
```

```cpp
#include <hip/hip_runtime.h>
#include <hip/hip_cooperative_groups.h>
#include <cstdio>
#include <cstdint>
namespace cg = cooperative_groups;

#define LAS __attribute__((address_space(3)))
typedef unsigned short bf16_t;
typedef short bf16x8 __attribute__((ext_vector_type(8)));
typedef float f32x4 __attribute__((ext_vector_type(4)));
typedef float f32x2 __attribute__((ext_vector_type(2)));
typedef unsigned u32x4 __attribute__((ext_vector_type(4)));
typedef unsigned u32x2 __attribute__((ext_vector_type(2)));
typedef float f32x16 __attribute__((ext_vector_type(16)));

constexpr int D = 1024, SEQ = 16384, NS = 128, DFF = 2816, PLE = 256;
constexpr int SROW = 16510;
constexpr int MT = 16640;
constexpr int MR = 16768;
constexpr int NPROJ = 2304;
constexpr int PQA = 0, PKA = 256, PVA = 512, PRA = 1024, PQB = 1536, PKB = 2048, PVB = 2176;
constexpr float EPS = 1e-6f;
constexpr int NTHREADS = 512;

constexpr size_t O_YP = 0, O_YS = 16777216, O_GLAP = 16908288, O_SKP = 16941056, O_SVP = 16957440, O_POOLP = 16973824, O_CONVP = 16989184,
                 O_GLAS = 17000448, O_SKS = 21194752, O_SVS = 23291904, O_POOLS = 25389056, O_CONVS = 27355136;

constexpr size_t MiB = 1u << 20;
constexpr size_t WS_WIN0 = 1 * MiB, WS_WOUT0 = 6 * MiB, WS_WFFI = 8 * MiB, WS_WFFO = 30 * MiB, WS_WGATE = 41 * MiB, WS_WPROJ = 45 * MiB, WS_WPOOL = 46 * MiB;
constexpr size_t WS_SSQ = 47 * MiB;
constexpr size_t WS_PBF = 55 * MiB, WS_R1 = 72 * MiB, WS_R2 = 105 * MiB, WS_BIG = 138 * MiB;
constexpr size_t PART_STRIDE = (size_t)(MR + 8) * 16 * 4;
constexpr size_t WFFI_BYTES = (size_t)5632 * 1024 * 2, WFFO_BYTES = (size_t)1024 * 2816 * 2, WGATE_BYTES = (size_t)1024 * 1024 * 2, WPROJ_BYTES = (size_t)1024 * 256 * 2;
constexpr size_t BIG_LA = (size_t)MT * NPROJ * 2;
constexpr int LDS_BYTES = 155648;

__device__ __forceinline__ unsigned cvt_pk_bf16(float lo, float hi) { unsigned r; asm volatile("v_cvt_pk_bf16_f32 %0, %1, %2" : "=v"(r) : "v"(lo), "v"(hi)); return r; }
__device__ __forceinline__ float bf_lo(unsigned w) { return __uint_as_float(w << 16); }
__device__ __forceinline__ float bf_hi(unsigned w) { return __uint_as_float(w & 0xffff0000u); }
__device__ __forceinline__ float bf2f(bf16_t v) { return __uint_as_float(((unsigned)v) << 16); }
__device__ __forceinline__ void unpack8(const u32x4 w, float* f) { f[0] = bf_lo(w.x); f[1] = bf_hi(w.x); f[2] = bf_lo(w.y); f[3] = bf_hi(w.y); f[4] = bf_lo(w.z); f[5] = bf_hi(w.z); f[6] = bf_lo(w.w); f[7] = bf_hi(w.w); }
__device__ __forceinline__ float wave_sum(float v) {
#pragma unroll
    for (int o = 1; o < 64; o <<= 1) v += __shfl_xor(v, o);
    return v;
}
__device__ __forceinline__ float wave_max(float v) {
#pragma unroll
    for (int o = 1; o < 64; o <<= 1) v = fmaxf(v, __shfl_xor(v, o));
    return v;
}
__device__ __forceinline__ int otid() { int t = threadIdx.x; asm volatile("" : "+v"(t)); return t; }
__device__ __forceinline__ bool row_valid(int row) { return row < SEQ || (row >= SROW && row < SROW + NS); }
__device__ __forceinline__ float* hrow_ptr(float* out, int row) { return row < SEQ ? out + O_YP + (size_t)row * D : out + O_YS + (size_t)(row - SROW) * D; }
__device__ __forceinline__ f32x2 gelu_pk(f32x2 v) {
    const f32x2 av = __builtin_elementwise_abs(v), d = av * 0.2316418882f + 1.0f;
    f32x2 t; t.x = __builtin_amdgcn_rcpf(d.x); t.y = __builtin_amdgcn_rcpf(d.y);
    f32x2 q = t * 0.5307027145f + (-0.7265760135f); q = q * t + 0.7107068705f; q = q * t + (-0.142248368f); q = q * t + 0.127414796f; q = q * t;
    const f32x2 s = (v * v) * (-0.72134752044f);
    f32x2 e; e.x = __builtin_amdgcn_exp2f(s.x); e.y = __builtin_amdgcn_exp2f(s.y);
    const f32x2 m = v * (q * e), r = v - m;
    f32x2 o; o.x = v.x < 0.f ? m.x : r.x; o.y = v.y < 0.f ? m.y : r.y; return o;
}

namespace pg8 {
constexpr int BM = 256, BK = 64, HALF = 128, HTB = HALF * BK * 2, STAGE_BYTES = 8 * HTB, NXCD = 8, WGM = 8;
__host__ __device__ __forceinline__ int lds_byte(int r, int c) { const int st = (r >> 4) * 2 + (c >> 5), rr = r & 15, cc = c & 31, ob = rr * 64 + cc * 2; return st * 1024 + (ob ^ (((ob >> 9) & 1) << 5)); }
__host__ __device__ __forceinline__ void stage_rc(int b, int& R, int& C) { const int st = b / 1024, sb = b % 1024, swz = sb ^ (((sb >> 9) & 1) << 5); R = (st >> 1) * 16 + swz / 64; C = (st & 1) * 32 + (swz % 64) / 2; }
__host__ __device__ __forceinline__ int perm32(int rho) { const int n = rho >> 4, i = rho & 15; return 8 * (i >> 2) + 4 * n + (i & 3); }

struct Unit { int pm, pn; };
struct Gemm { const bf16_t* A; const bf16_t* Bt; int lda, ldb, K, mstride, arow0, acolstep; };

struct StaticOrder {
    int nM, nN, nwg, G, c;
    __device__ void init(int nM_, int nN_, int G_, int c_) { nM = nM_; nN = nN_; nwg = nM * nN; G = G_; c = c_; }
    __device__ bool next(int i, Unit& u) const {
        const long L = (long)i * G + c; if (L >= nwg) return false;
        int wgid = (int)L; { const int q = nwg / NXCD, r = nwg % NXCD, xcd = wgid % NXCD, off = wgid / NXCD; wgid = (xcd < r ? xcd * (q + 1) : r * (q + 1) + (xcd - r) * q) + off; }
        const int nig = WGM * nN, gid = wgid / nig, fm = gid * WGM, gsz = (nM - fm) < WGM ? (nM - fm) : WGM;
        u.pm = fm + ((wgid % nig) % gsz); u.pn = (wgid % nig) / gsz; return true;
    }
};

template <class Epi>
__device__ __forceinline__ void gemm_phase(LAS unsigned char* lds, const Gemm g, const StaticOrder& S, const Epi& E) {
    const int tid = otid(), wid = __builtin_amdgcn_readfirstlane(tid >> 6), lane = tid & 63, wr = wid >> 2, wc = wid & 3, fr = lane & 15, fq = lane >> 4;
    const int K = g.K, nt = K / BK;
    unsigned voffA[2], voffB[2];
#pragma unroll
    for (int i = 0; i < 2; ++i) { int R, C; stage_rc(tid * 16 + i * 8192, R, C); const int Rb = (R & ~31) + perm32(R & 31);
        voffA[i] = (unsigned)(R * g.lda + C) * 2u; voffB[i] = (unsigned)(Rb * g.ldb + C) * 2u; }
    const size_t kstep = (size_t)(BK * 2);
    const size_t hstepA = (size_t)HALF * g.lda * 2, hstepB = (size_t)HALF * g.ldb * 2;
    const unsigned ldsw = (unsigned)wid * 1024u;
    const int aoff = lds_byte(wr * 64 + fr, fq * 8), boff = lds_byte(wc * 32 + fr, fq * 8);
#define PG8_SA(b, h) (((b) * 2 + (h)) * HTB)
#define PG8_SB(b, h) ((4 + (b) * 2 + (h)) * HTB)
#define PG8_STAGE(bufoff, gbase, voff) do { _Pragma("unroll") for (int _i = 0; _i < 2; ++_i) \
        __builtin_amdgcn_global_load_lds((const unsigned*)((const char*)(gbase) + (voff)[_i]), (LAS unsigned*)(lds + (bufoff) + ldsw + _i * 8192), 16, 0, 0); } while (0)
#define PG8_LDA(dst, b, h) do { _Pragma("unroll") for (int m = 0; m < 4; ++m) _Pragma("unroll") for (int k = 0; k < 2; ++k) dst[m][k] = *(const LAS bf16x8*)(lds + PG8_SA(b, h) + aoff + m * 2048 + k * 1024); } while (0)
#define PG8_LDB(dst, b, h) do { _Pragma("unroll") for (int n = 0; n < 2; ++n) _Pragma("unroll") for (int k = 0; k < 2; ++k) dst[n][k] = *(const LAS bf16x8*)(lds + PG8_SB(b, h) + boff + n * 2048 + k * 1024); } while (0)
#define PG8_MMA(ai, bj, At, Bt) do { __builtin_amdgcn_s_setprio(1); _Pragma("unroll") for (int m = 0; m < 4; ++m) _Pragma("unroll") for (int n = 0; n < 2; ++n) _Pragma("unroll") for (int k = 0; k < 2; ++k) \
        acc[ai][bj][m][n] = __builtin_amdgcn_mfma_f32_16x16x32_bf16(Bt[n][k], At[m][k], acc[ai][bj][m][n], 0, 0, 0); __builtin_amdgcn_s_setprio(0); } while (0)
#define PG8_WAIT_V(n) asm volatile("s_waitcnt vmcnt(" #n ")" ::: "memory")
#define PG8_WAIT_L(n) asm volatile("s_waitcnt lgkmcnt(" #n ")" ::: "memory")
#define PG8_BAR __builtin_amdgcn_s_barrier()
#define PG8_SCHED __builtin_amdgcn_sched_barrier(0)
#define PG8_ABASE(u) ((const char*)g.A + ((long)((long)(u).pm * g.mstride + g.arow0) * g.lda + (long)(u).pn * g.acolstep) * 2)
#define PG8_BBASE(u) ((const char*)g.Bt + (size_t)(u).pn * 256 * g.ldb * 2)
    Unit cur, nxt; int ui = 0;
    if (!S.next(0, cur)) return;
    f32x4 acc[2][2][4][2];
#pragma unroll
    for (int a = 0; a < 2; ++a)
#pragma unroll
        for (int b = 0; b < 2; ++b)
#pragma unroll
            for (int m = 0; m < 4; ++m)
#pragma unroll
                for (int n = 0; n < 2; ++n) acc[a][b][m][n] = (f32x4){0.f, 0.f, 0.f, 0.f};
    bf16x8 At[4][2], B0[2][2], B1[2][2];
    const char* cA = PG8_ABASE(cur); const char* cB = PG8_BBASE(cur);
    PG8_STAGE(PG8_SB(0, 0), cB, voffB); PG8_STAGE(PG8_SB(0, 1), cB + hstepB, voffB); PG8_STAGE(PG8_SA(0, 0), cA, voffA); PG8_STAGE(PG8_SA(0, 1), cA + hstepA, voffA);
    if (wr == 1) PG8_BAR;
    PG8_WAIT_V(2); PG8_BAR;
    PG8_STAGE(PG8_SB(1, 0), cB + kstep, voffB); PG8_STAGE(PG8_SA(1, 0), cA + kstep, voffA); PG8_STAGE(PG8_SB(1, 1), cB + hstepB + kstep, voffB);
    PG8_WAIT_V(6); PG8_BAR;
    for (;;) {
        const bool has_next = S.next(ui + 1, nxt);
        const char* nA = has_next ? PG8_ABASE(nxt) : cA; const char* nB = has_next ? PG8_BBASE(nxt) : cB;
#pragma unroll 1
        for (int t = 0; t < nt; t += 2) {
            const bool last = (t == nt - 2);
            const char* a1 = cA + (size_t)(t + 1) * kstep;
            const char* a2 = last ? nA : cA + (size_t)(t + 2) * kstep; const char* b2 = last ? nB : cB + (size_t)(t + 2) * kstep;
            const char* a3 = a2 + kstep; const char* b3 = b2 + kstep;
            PG8_LDB(B0, 0, 0); PG8_LDB(B1, 0, 1); PG8_SCHED; PG8_LDA(At, 0, 0); PG8_STAGE(PG8_SA(1, 1), a1 + hstepA, voffA);
            PG8_WAIT_V(8); PG8_WAIT_L(0); PG8_BAR; PG8_MMA(0, 0, At, B0); PG8_MMA(0, 1, At, B1); PG8_BAR; PG8_SCHED;
            PG8_LDA(At, 0, 1); PG8_STAGE(PG8_SB(0, 0), b2, voffB); PG8_STAGE(PG8_SB(0, 1), b2 + hstepB, voffB); PG8_STAGE(PG8_SA(0, 0), a2, voffA);
            PG8_WAIT_V(8); PG8_WAIT_L(0); PG8_BAR; PG8_MMA(1, 0, At, B0); PG8_MMA(1, 1, At, B1); PG8_BAR; PG8_SCHED;
            PG8_LDB(B0, 1, 0); PG8_LDB(B1, 1, 1); PG8_SCHED; PG8_LDA(At, 1, 0); PG8_STAGE(PG8_SA(0, 1), a2 + hstepA, voffA);
            PG8_WAIT_V(8); PG8_WAIT_L(0); PG8_BAR; PG8_MMA(0, 0, At, B0); PG8_MMA(0, 1, At, B1); PG8_BAR; PG8_SCHED;
            PG8_LDA(At, 1, 1); PG8_STAGE(PG8_SB(1, 0), b3, voffB); PG8_STAGE(PG8_SB(1, 1), b3 + hstepB, voffB); PG8_STAGE(PG8_SA(1, 0), a3, voffA);
            PG8_WAIT_V(8); PG8_WAIT_L(0); PG8_BAR; PG8_MMA(1, 0, At, B0); PG8_MMA(1, 1, At, B1); PG8_BAR; PG8_SCHED;
        }
        if (wr == 0) PG8_BAR;
        { int lane2 = lane; asm volatile("" : "+v"(lane2)); E(acc, cur, wr, wc, lane2 & 15, lane2 >> 4, lds + STAGE_BYTES); }
        if (!has_next) break;
#pragma unroll
        for (int a = 0; a < 2; ++a)
#pragma unroll
            for (int b = 0; b < 2; ++b)
#pragma unroll
                for (int m = 0; m < 4; ++m)
#pragma unroll
                    for (int n = 0; n < 2; ++n) acc[a][b][m][n] = (f32x4){0.f, 0.f, 0.f, 0.f};
        cur = nxt; cA = nA; cB = nB; ++ui;
        if (wr == 1) PG8_BAR;
    }
    PG8_WAIT_V(0);
    PG8_BAR;
#undef PG8_SA
#undef PG8_SB
#undef PG8_STAGE
#undef PG8_LDA
#undef PG8_LDB
#undef PG8_MMA
#undef PG8_WAIT_V
#undef PG8_WAIT_L
#undef PG8_BAR
#undef PG8_SCHED
#undef PG8_ABASE
#undef PG8_BBASE
}
}
using pg8::Unit;
typedef f32x4 AccT[2][2][4][2];

__device__ __forceinline__ float row_rs(const float* part, int row, int fq) {
    const f32x4 p = *(const f32x4*)(part + (long)row * 16 + fq * 4);
    float s = (p[0] + p[1]) + (p[2] + p[3]);
    s += __shfl_xor(s, 16); s += __shfl_xor(s, 32);
    return rsqrtf(s * (1.0f / D) + EPS);
}

struct EpiProj {
    bf16_t* proj; float* la; const float* ssq0; const float* b_alpha;
    __device__ __forceinline__ void operator()(const AccT& acc, const Unit& u, int wr, int wc, int fr, int fq, LAS unsigned char*) const {
        float rsv[2][4];
#pragma unroll
        for (int ai = 0; ai < 2; ++ai)
#pragma unroll
            for (int m = 0; m < 4; ++m) rsv[ai][m] = ssq0[u.pm * 256 + ai * 128 + wr * 64 + m * 16 + fr];
        f32x4 bb[2][2];
        if (u.pn >= 9) {
#pragma unroll
            for (int bj = 0; bj < 2; ++bj) { const int c = bj * 128 + wc * 32 + fq * 8; bb[bj][0] = *(const f32x4*)(b_alpha + c); bb[bj][1] = *(const f32x4*)(b_alpha + c + 4); }
        }
#pragma unroll
        for (int ai = 0; ai < 2; ++ai)
#pragma unroll
            for (int m = 0; m < 4; ++m) {
                const int row = u.pm * 256 + ai * 128 + wr * 64 + m * 16 + fr;
                const float rs = rsqrtf(rsv[ai][m] * (1.0f / D) + EPS);
#pragma unroll
                for (int bj = 0; bj < 2; ++bj) {
                    const int col = u.pn * 256 + bj * 128 + wc * 32 + fq * 8;
                    const f32x4 v0 = acc[ai][bj][m][0] * rs, v1 = acc[ai][bj][m][1] * rs;
                    if (u.pn < 9) {
                        u32x4 w; w.x = cvt_pk_bf16(v0[0], v0[1]); w.y = cvt_pk_bf16(v0[2], v0[3]); w.z = cvt_pk_bf16(v1[0], v1[1]); w.w = cvt_pk_bf16(v1[2], v1[3]);
                        *(u32x4*)(proj + (size_t)row * NPROJ + col) = w;
                    } else {
                        const int c = col - NPROJ;
                        f32x4 o0, o1;
#pragma unroll
                        for (int j = 0; j < 4; ++j) {
                            const float z0 = v0[j] + bb[bj][0][j], z1 = v1[j] + bb[bj][1][j];
                            o0[j] = (fminf(z0, 0.f) - log1pf(__expf(-fabsf(z0)))) * 0.0625f;
                            o1[j] = (fminf(z1, 0.f) - log1pf(__expf(-fabsf(z1)))) * 0.0625f;
                        }
                        *(f32x4*)(la + (size_t)row * 256 + c) = o0; *(f32x4*)(la + (size_t)row * 256 + c + 4) = o1;
                    }
                }
            }
    }
};
struct EpiPP {
    bf16_t* pp;
    __device__ __forceinline__ void operator()(const AccT& acc, const Unit& u, int wr, int wc, int fr, int fq, LAS unsigned char*) const {
#pragma unroll
        for (int ai = 0; ai < 2; ++ai)
#pragma unroll
            for (int m = 0; m < 4; ++m) {
                const int row = u.pm * 256 + ai * 128 + wr * 64 + m * 16 + fr;
#pragma unroll
                for (int bj = 0; bj < 2; ++bj) {
                    const int col = u.pn * 256 + bj * 128 + wc * 32 + fq * 8;
                    const f32x4 v0 = acc[ai][bj][m][0], v1 = acc[ai][bj][m][1];
                    u32x4 w; w.x = cvt_pk_bf16(v0[0], v0[1]); w.y = cvt_pk_bf16(v0[2], v0[3]); w.z = cvt_pk_bf16(v1[0], v1[1]); w.w = cvt_pk_bf16(v1[2], v1[3]);
                    *(u32x4*)(pp + (size_t)row * D + col) = w;
                }
            }
    }
};
template <int MODE, bool WRITE_HB, bool WRITE_PART, bool WRITE_F32>
struct EpiRes {
    float* out; const float* xp; const bf16_t* hbin; bf16_t* hb; float* part; const float* part_in; const bf16_t* pp; const float* scale;
    struct Q { f32x4 xb[2][2][2]; u32x4 hw[2][2]; u32x4 pw[2][2]; f32x4 pin[2]; };
    __device__ __forceinline__ void fetch(Q& q, const Unit& u, int aq, int wr, int wc, int fr, int fq) const {
        const int ai = aq >> 1, m0 = (aq & 1) * 2;
#pragma unroll
        for (int mm = 0; mm < 2; ++mm) {
            const int row = u.pm * 256 + ai * 128 + wr * 64 + (m0 + mm) * 16 + fr;
            if (MODE == 2) q.pin[mm] = *(const f32x4*)(part_in + (long)row * 16 + fq * 4);
#pragma unroll
            for (int bj = 0; bj < 2; ++bj) {
                const int col = u.pn * 256 + bj * 128 + wc * 32 + fq * 8;
                if (MODE == 0) { q.xb[mm][bj][0] = *(const f32x4*)(xp + (size_t)row * D + col); q.xb[mm][bj][1] = *(const f32x4*)(xp + (size_t)row * D + col + 4); }
                else q.hw[mm][bj] = *(const u32x4*)(hbin + (size_t)row * D + col);
                if (MODE == 2) q.pw[mm][bj] = *(const u32x4*)(pp + (size_t)row * D + col);
            }
        }
    }
    __device__ __forceinline__ void operator()(const AccT& acc, const Unit& u, int wr, int wc, int fr, int fq, LAS unsigned char*) const {
        f32x4 sc[2][2];
        if (MODE == 3) {
#pragma unroll
            for (int bj = 0; bj < 2; ++bj) { const int col = u.pn * 256 + bj * 128 + wc * 32 + fq * 8; sc[bj][0] = *(const f32x4*)(scale + col); sc[bj][1] = *(const f32x4*)(scale + col + 4); }
        }
        constexpr bool PIPE = (MODE == 1 || MODE == 3);
        Q qa, qb;
        fetch(qa, u, 0, wr, wc, fr, fq);
#pragma unroll
        for (int aq = 0; aq < 4; ++aq) {
            const int ai = aq >> 1, m0 = (aq & 1) * 2;
            Q& cur = (aq & 1) ? qb : qa; Q& nxt = (aq & 1) ? qa : qb;
            if (PIPE && aq < 3) fetch(nxt, u, aq + 1, wr, wc, fr, fq);
#pragma unroll
            for (int mm = 0; mm < 2; ++mm) {
                const int m = m0 + mm;
                const int row = u.pm * 256 + ai * 128 + wr * 64 + m * 16 + fr;
                float rs = 1.f;
                if (MODE == 2) { float s = (cur.pin[mm][0] + cur.pin[mm][1]) + (cur.pin[mm][2] + cur.pin[mm][3]); s += __shfl_xor(s, 16); s += __shfl_xor(s, 32); rs = rsqrtf(s * (1.0f / D) + EPS); }
                float sq = 0.f;
#pragma unroll
                for (int bj = 0; bj < 2; ++bj) {
                    const int col = u.pn * 256 + bj * 128 + wc * 32 + fq * 8;
                    f32x4 v0 = acc[ai][bj][m][0], v1 = acc[ai][bj][m][1];
                    if (MODE == 2) {
                        float pf[8]; unpack8(cur.pw[mm][bj], pf);
#pragma unroll
                        for (int j = 0; j < 4; ++j) {
                            v0[j] = pf[j] / (1.f + __expf(-v0[j] * rs));
                            v1[j] = pf[4 + j] / (1.f + __expf(-v1[j] * rs));
                        }
                    }
                    if (MODE == 3) { v0 = v0 * sc[bj][0]; v1 = v1 * sc[bj][1]; }
                    f32x4 b0, b1;
                    if (MODE == 0) { b0 = cur.xb[mm][bj][0]; b1 = cur.xb[mm][bj][1]; }
                    else { float bf[8]; unpack8(cur.hw[mm][bj], bf); b0 = (f32x4){bf[0], bf[1], bf[2], bf[3]}; b1 = (f32x4){bf[4], bf[5], bf[6], bf[7]}; }
                    const f32x4 h0 = b0 + v0, h1 = b1 + v1;
                    if (WRITE_F32) { float* hp = out + O_YP + (size_t)row * D; *(f32x4*)(hp + col) = h0; *(f32x4*)(hp + col + 4) = h1; }
                    if (WRITE_HB) { u32x4 w; w.x = cvt_pk_bf16(h0[0], h0[1]); w.y = cvt_pk_bf16(h0[2], h0[3]); w.z = cvt_pk_bf16(h1[0], h1[1]); w.w = cvt_pk_bf16(h1[2], h1[3]);
                        *(u32x4*)(hb + (size_t)row * D + col) = w; }
                    sq += (h0[0] * h0[0] + h0[1] * h0[1]) + (h0[2] * h0[2] + h0[3] * h0[3]) + (h1[0] * h1[0] + h1[1] * h1[1]) + (h1[2] * h1[2] + h1[3] * h1[3]);
                }
                if (WRITE_PART) {
                    sq += __shfl_xor(sq, 16); sq += __shfl_xor(sq, 32);
                    if (fq == 0) part[(long)row * 16 + u.pn * 4 + wc] = sq;
                }
            }
            if (!PIPE && aq < 3) fetch(nxt, u, aq + 1, wr, wc, fr, fq);
        }
    }
};
struct EpiFfn {
    const float* part_in; const float* convw; const float* convb; float* convp_out; bf16_t* G;
    __device__ __forceinline__ void operator()(AccT& acc, const Unit& u, int wr, int wc, int fr, int fq, LAS unsigned char* ldsx) const {
        const int c0 = u.pn * 128 + wc * 32 + fq * 8;
#pragma unroll
        for (int ai = 0; ai < 2; ++ai)
#pragma unroll
            for (int m = 0; m < 4; ++m) {
                const int grow = u.pm * 254 - 2 + ai * 128 + wr * 64 + m * 16 + fr;
                const float rs = row_rs(part_in, grow, fq);
#pragma unroll
                for (int bj = 0; bj < 2; ++bj)
#pragma unroll
                    for (int n = 0; n < 2; ++n) acc[ai][bj][m][n] = acc[ai][bj][m][n] * rs;
            }
        LAS f32x4* xch = (LAS f32x4*)ldsx;
        if (fr >= 14) {
#pragma unroll
            for (int ai = 0; ai < 2; ++ai) {
                const int slot = ((((ai * 2 + wr) * 4 + wc) * 4 + fq) * 2 + (fr - 14)) * 2;
                xch[slot] = acc[ai][0][3][0]; xch[slot + 1] = acc[ai][0][3][1];
            }
        }
        asm volatile("s_waitcnt lgkmcnt(0)" ::: "memory"); __builtin_amdgcn_s_barrier(); asm volatile("" ::: "memory");
        f32x4 w0[2], w1[2], w2[2], cb[2];
#pragma unroll
        for (int n = 0; n < 2; ++n) { const int cn = c0 + 4 * n;
            w0[n] = *(const f32x4*)(convw + cn); w1[n] = *(const f32x4*)(convw + DFF + cn); w2[n] = *(const f32x4*)(convw + 2 * DFF + cn); cb[n] = *(const f32x4*)(convb + cn); }
#pragma unroll
        for (int ai = 0; ai < 2; ++ai)
#pragma unroll
            for (int m = 0; m < 4; ++m) {
                const int tr = ai * 128 + wr * 64 + m * 16 + fr;
                const int grow = u.pm * 254 - 2 + tr;
                const bool store = (tr >= 2 && grow < SEQ);
                u32x4 w;
#pragma unroll
                for (int n = 0; n < 2; ++n) {
                    const f32x4 x = acc[ai][0][m][n];
                    f32x4 p;
                    if (m == 0) {
                        const int sa = (wr == 1) ? ai : 0, sw = (wr == 1) ? 0 : 1;
                        const bool has = (wr == 1) || (ai == 1);
                        const int slot = ((((sa * 2 + sw) * 4 + wc) * 4 + fq) * 2 + (fr >= 14 ? fr - 14 : 0)) * 2 + n;
                        p = xch[slot];
                        if (!has) p = (f32x4){0.f, 0.f, 0.f, 0.f};
                    } else p = acc[ai][0][m == 0 ? 0 : m - 1][n];
                    f32x4 p1, p2;
#pragma unroll
                    for (int j = 0; j < 4; ++j) {
                        const float xf = x[j], pf = p[j]; const int xi = __float_as_int(xf), pi = __float_as_int(pf);
                        const int r1 = __builtin_amdgcn_mov_dpp(pi, 0x121, 0xf, 0xf, true), r2 = __builtin_amdgcn_mov_dpp(pi, 0x122, 0xf, 0xf, true);
                        p1[j] = __int_as_float(__builtin_amdgcn_update_dpp(r1, xi, 0x111, 0xf, 0xf, false));
                        p2[j] = __int_as_float(__builtin_amdgcn_update_dpp(r2, xi, 0x112, 0xf, 0xf, false));
                    }
                    if (grow >= SEQ - 2 && grow < SEQ) *(f32x4*)(convp_out + (size_t)(grow - (SEQ - 2)) * DFF + c0 + 4 * n) = x;
                    const f32x4 ac = cb[n] + w0[n] * p2 + w1[n] * p1 + w2[n] * x;
                    const f32x4 v = acc[ai][1][m][n];
                    const f32x2 g0 = gelu_pk((f32x2){ac[0], ac[1]}), g1 = gelu_pk((f32x2){ac[2], ac[3]});
                    const unsigned lo = cvt_pk_bf16(g0.x * v[0], g0.y * v[1]), hi = cvt_pk_bf16(g1.x * v[2], g1.y * v[3]);
                    if (n == 0) { w.x = lo; w.y = hi; } else { w.z = lo; w.w = hi; }
                }
                if (store) *(u32x4*)(G + (size_t)grow * DFF + c0) = w;
                asm volatile("" ::: "memory");
            }
    }
};

template <int NT>
struct EpiStoreOnly {
    bf16_t* dst;
    __device__ __forceinline__ void operator()(const AccT& acc, const Unit& u, int wr, int wc, int fr, int fq, LAS unsigned char*) const {
#pragma unroll
        for (int ai = 0; ai < 2; ++ai)
#pragma unroll
            for (int m = 0; m < 4; ++m) {
                const int row = u.pm * 254 + ai * 128 + wr * 64 + m * 16 + fr;
#pragma unroll
                for (int bj = 0; bj < 2; ++bj) {
                    const int col = (u.pn & 3) * 256 + bj * 128 + wc * 32 + fq * 8;
                    const f32x4 v0 = acc[ai][bj][m][0], v1 = acc[ai][bj][m][1];
                    u32x4 w; w.x = cvt_pk_bf16(v0[0], v0[1]); w.y = cvt_pk_bf16(v0[2], v0[3]); w.z = cvt_pk_bf16(v1[0], v1[1]); w.w = cvt_pk_bf16(v1[2], v1[3]);
                    if (NT) __builtin_nontemporal_store(w, (u32x4*)(dst + (size_t)row * D + col)); else *(u32x4*)(dst + (size_t)row * D + col) = w;
                }
            }
    }
};
struct EpiNull {
    __device__ __forceinline__ void operator()(const AccT& acc, const Unit& u, int wr, int wc, int fr, int fq, LAS unsigned char*) const {
#pragma unroll
        for (int ai = 0; ai < 2; ++ai)
#pragma unroll
            for (int bj = 0; bj < 2; ++bj)
#pragma unroll
                for (int m = 0; m < 4; ++m) { asm volatile("" :: "v"(acc[ai][bj][m][0]), "v"(acc[ai][bj][m][1])); }
    }
};
struct KArgs { const float* in[29]; float* out; unsigned char* ws; };
enum { I_XP = 0, I_XS, I_PP, I_PS, I_SGLA, I_CK, I_CV, I_SPOOL, I_SCONV, I_MNE, I_WIN, I_WALPHA, I_BALPHA, I_ONORM, I_QNORM, I_KNORM, I_SINKS, I_WOUT,
       I_MNO, I_POOLW, I_POOLSC, I_FNORM, I_FWIN, I_FCW, I_FCB, I_FWOUT, I_PNORM, I_PWPROJ, I_PWGATE };

__device__ __forceinline__ float* part_tab(unsigned char* ws, int i) { return (float*)(ws + WS_SSQ + 262144 + (size_t)i * PART_STRIDE) + 2 * 16; }

constexpr int SPART_PITCH = 68;
constexpr int SG_STAGE = 24576, SG_NST = 4, SG_PART_OFF = SG_STAGE * SG_NST;
template <int K, int LDA, int LDB>
__device__ __forceinline__ void sgemm_tile(const bf16_t* __restrict__ A, const bf16_t* __restrict__ B0, const bf16_t* __restrict__ B1, LAS unsigned char* lds) {
    const int tid = otid(), lane = tid & 63, wave = __builtin_amdgcn_readfirstlane(tid >> 6);
    const int fr = lane & 15, fq = lane >> 4, mq = wave >> 1, nh = wave & 1;
    constexpr int NCH = K / 64;
    static_assert(K % 64 == 0 && NCH >= SG_NST, "K must be a multiple of 64 and at least 4 chunks");
    const int prow = lane >> 3, ppc = lane & 7;
    const char* gsrc[3]; unsigned ldst[3];
#pragma unroll
    for (int j = 0; j < 3; ++j) {
        const int i = wave + 8 * j;
        if (j < 2) { const int row = 8 * i + prow; gsrc[j] = (const char*)(A + (size_t)row * LDA) + 16 * (ppc ^ (row & 7)); }
        else { const int row = 8 * (i - 16) + prow; const bf16_t* bp = row < 32 ? B0 + (size_t)row * LDB : B1 + (size_t)(row - 32) * LDB; gsrc[j] = (const char*)bp + 16 * (ppc ^ (row & 7)); }
        ldst[j] = (unsigned)i * 1024u;
    }
#define SG_DMA(c) do { const int st_ = ((c) % SG_NST) * SG_STAGE; _Pragma("unroll") for (int j_ = 0; j_ < 3; ++j_) \
        __builtin_amdgcn_global_load_lds((const unsigned*)(gsrc[j_] + (size_t)(c) * 128), (LAS unsigned*)(lds + st_ + ldst[j_]), 16, 0, 0); } while (0)
    f32x4 acc[2][2];
#pragma unroll
    for (int m = 0; m < 2; ++m)
#pragma unroll
        for (int n = 0; n < 2; ++n) acc[m][n] = (f32x4){0.f, 0.f, 0.f, 0.f};
    int aoff[2][2], boff[2][2];
#pragma unroll
    for (int m = 0; m < 2; ++m)
#pragma unroll
        for (int s = 0; s < 2; ++s) {
            const int ra = 16 * (2 * mq + m) + fr, rb = 16 * (2 * nh + m) + fr;
            aoff[m][s] = ra * 128 + 16 * ((4 * s + fq) ^ (ra & 7));
            boff[m][s] = 16384 + rb * 128 + 16 * ((4 * s + fq) ^ (rb & 7));
        }
    SG_DMA(0); SG_DMA(1); SG_DMA(2);
#pragma unroll 1
    for (int c = 0; c < NCH; ++c) {
        if (c + 3 < NCH) { SG_DMA(c + 3); asm volatile("s_waitcnt vmcnt(9)" ::: "memory"); }
        else if (c + 2 < NCH) asm volatile("s_waitcnt vmcnt(6)" ::: "memory");
        else if (c + 1 < NCH) asm volatile("s_waitcnt vmcnt(3)" ::: "memory");
        else asm volatile("s_waitcnt vmcnt(0)" ::: "memory");
        __builtin_amdgcn_s_barrier(); asm volatile("" ::: "memory");
        const LAS unsigned char* st = lds + (c % SG_NST) * SG_STAGE;
#pragma unroll
        for (int s = 0; s < 2; ++s) {
            const bf16x8 a0 = *(const LAS bf16x8*)(st + aoff[0][s]), a1 = *(const LAS bf16x8*)(st + aoff[1][s]);
            const bf16x8 b0 = *(const LAS bf16x8*)(st + boff[0][s]), b1 = *(const LAS bf16x8*)(st + boff[1][s]);
            acc[0][0] = __builtin_amdgcn_mfma_f32_16x16x32_bf16(b0, a0, acc[0][0], 0, 0, 0);
            acc[0][1] = __builtin_amdgcn_mfma_f32_16x16x32_bf16(b1, a0, acc[0][1], 0, 0, 0);
            acc[1][0] = __builtin_amdgcn_mfma_f32_16x16x32_bf16(b0, a1, acc[1][0], 0, 0, 0);
            acc[1][1] = __builtin_amdgcn_mfma_f32_16x16x32_bf16(b1, a1, acc[1][1], 0, 0, 0);
        }
        asm volatile("s_waitcnt lgkmcnt(0)" ::: "memory"); __builtin_amdgcn_s_barrier(); asm volatile("" ::: "memory");
    }
#undef SG_DMA
    LAS float* part = (LAS float*)(lds + SG_PART_OFF);
#pragma unroll
    for (int m = 0; m < 2; ++m)
#pragma unroll
        for (int n = 0; n < 2; ++n) *(LAS f32x4*)(part + (16 * (2 * mq + m) + fr) * SPART_PITCH + 16 * (2 * nh + n) + 4 * fq) = acc[m][n];
}
template <int N>
__device__ __forceinline__ void sreduce(const LAS float* part, int b, int col0, float* v) {
#pragma unroll
    for (int j = 0; j < N; j += 4) {
        const f32x4 s = *(const LAS f32x4*)(part + b * SPART_PITCH + col0 + j);
        v[j] = s[0]; v[j + 1] = s[1]; v[j + 2] = s[2]; v[j + 3] = s[3];
    }
}
template <int MODE, bool WRITE_HB, bool WRITE_PART, bool WRITE_F32>
__device__ __forceinline__ void s_res_epi(const KArgs& a, int b, int q, int n0, const float* v, const bf16_t* hbin, bf16_t* hb, float* part, const float* ppv, float rs_in, const float* scale) {
    const int row = SROW + b, c0 = n0 + 16 * q;
    float base[16];
    if (MODE == 0) {
#pragma unroll
        for (int j = 0; j < 16; j += 4) { const f32x4 bv = *(const f32x4*)(a.in[I_XS] + (size_t)b * D + c0 + j); base[j] = bv[0]; base[j + 1] = bv[1]; base[j + 2] = bv[2]; base[j + 3] = bv[3]; }
    } else {
        const u32x4 w0 = *(const u32x4*)(hbin + (size_t)row * D + c0), w1 = *(const u32x4*)(hbin + (size_t)row * D + c0 + 8);
        unpack8(w0, base); unpack8(w1, base + 8);
    }
    float hn[16]; float sq = 0.f;
#pragma unroll
    for (int j = 0; j < 16; ++j) {
        float nv = v[j];
        if (MODE == 2) nv = ppv[j] / (1.f + __expf(-nv * rs_in));
        if (MODE == 3) nv = nv * scale[c0 + j];
        hn[j] = base[j] + nv; sq += hn[j] * hn[j];
    }
    if (WRITE_F32) {
        float* hp = a.out + O_YS + (size_t)b * D + c0;
#pragma unroll
        for (int j = 0; j < 16; j += 4) *(f32x4*)(hp + j) = (f32x4){hn[j], hn[j + 1], hn[j + 2], hn[j + 3]};
    }
    if (WRITE_HB) {
        u32x4 w0, w1;
        w0.x = cvt_pk_bf16(hn[0], hn[1]); w0.y = cvt_pk_bf16(hn[2], hn[3]); w0.z = cvt_pk_bf16(hn[4], hn[5]); w0.w = cvt_pk_bf16(hn[6], hn[7]);
        w1.x = cvt_pk_bf16(hn[8], hn[9]); w1.y = cvt_pk_bf16(hn[10], hn[11]); w1.z = cvt_pk_bf16(hn[12], hn[13]); w1.w = cvt_pk_bf16(hn[14], hn[15]);
        *(u32x4*)(hb + (size_t)row * D + c0) = w0; *(u32x4*)(hb + (size_t)row * D + c0 + 8) = w1;
    }
    if (WRITE_PART) {
        sq += __shfl_xor(sq, 1); sq += __shfl_xor(sq, 2);
        if (q == 0) part[(long)row * 16 + (n0 >> 6)] = sq;
    }
}
__device__ __forceinline__ float s_row_rs(const float* part, int b) {
    const float* p = part + (long)(SROW + b) * 16;
    const f32x4 p0 = *(const f32x4*)(p), p1 = *(const f32x4*)(p + 4), p2 = *(const f32x4*)(p + 8), p3 = *(const f32x4*)(p + 12);
    const float s = ((p0[0] + p0[1]) + (p0[2] + p0[3])) + ((p1[0] + p1[1]) + (p1[2] + p1[3])) + ((p2[0] + p2[1]) + (p2[2] + p2[3])) + ((p3[0] + p3[1]) + (p3[2] + p3[3]));
    return rsqrtf(s * (1.0f / D) + EPS);
}
__device__ __forceinline__ void s_proj_units(const KArgs& a, LAS unsigned char* lds, int u0, int G) {
    LAS float* part = (LAS float*)(lds + SG_PART_OFF);
    const bf16_t* xbf = (const bf16_t*)(a.ws + WS_R1) + (size_t)SROW * D; const bf16_t* W = (const bf16_t*)(a.ws + WS_WIN0);
    bf16_t* proj = (bf16_t*)(a.ws + WS_BIG); float* la = (float*)(a.ws + WS_BIG + BIG_LA); const float* ssq0 = (const float*)(a.ws + WS_SSQ);
    for (int u = u0; u < 40; u += G) {
        const int n0 = u * 64;
        sgemm_tile<1024, 1024, 1024>(xbf, W + (size_t)n0 * 1024, W + (size_t)(n0 + 32) * 1024, lds);
        __syncthreads();
        const int tid = otid(), b = tid >> 2, q = tid & 3, c0 = n0 + 16 * q, row = SROW + b;
        float v[16]; sreduce<16>(part, b, 16 * q, v);
        const float rs = rsqrtf(ssq0[row] * (1.0f / D) + EPS);
        if (n0 < NPROJ) {
            u32x4 w0, w1;
            w0.x = cvt_pk_bf16(v[0] * rs, v[1] * rs); w0.y = cvt_pk_bf16(v[2] * rs, v[3] * rs); w0.z = cvt_pk_bf16(v[4] * rs, v[5] * rs); w0.w = cvt_pk_bf16(v[6] * rs, v[7] * rs);
            w1.x = cvt_pk_bf16(v[8] * rs, v[9] * rs); w1.y = cvt_pk_bf16(v[10] * rs, v[11] * rs); w1.z = cvt_pk_bf16(v[12] * rs, v[13] * rs); w1.w = cvt_pk_bf16(v[14] * rs, v[15] * rs);
            *(u32x4*)(proj + (size_t)row * NPROJ + c0) = w0; *(u32x4*)(proj + (size_t)row * NPROJ + c0 + 8) = w1;
        } else {
            const int c = c0 - NPROJ;
#pragma unroll
            for (int j = 0; j < 16; j += 4) { f32x4 o;
#pragma unroll
                for (int i = 0; i < 4; ++i) { const float z = v[j + i] * rs + a.in[I_BALPHA][c + j + i]; o[i] = (fminf(z, 0.f) - log1pf(__expf(-fabsf(z)))) * 0.0625f; }
                *(f32x4*)(la + (size_t)row * 256 + c + j) = o; }
        }
        __syncthreads();
    }
}
template <int MODE, int K, int LDA>
__device__ __forceinline__ void s_res_units(const KArgs& a, LAS unsigned char* lds, int u0, int G, const bf16_t* A, const bf16_t* W, const bf16_t* hbin, bf16_t* hb, float* part_out) {
    LAS float* part = (LAS float*)(lds + SG_PART_OFF);
    for (int u = u0; u < 16; u += G) {
        const int n0 = u * 64;
        const bf16_t* Au = A + (size_t)SROW * LDA + (MODE == 3 ? (n0 >> 8) * 256 : 0);
        sgemm_tile<K, LDA, K>(Au, W + (size_t)n0 * K, W + (size_t)(n0 + 32) * K, lds);
        __syncthreads();
        const int tid = otid(), b = tid >> 2, q = tid & 3;
        float v[16]; sreduce<16>(part, b, 16 * q, v);
        s_res_epi<MODE, true, true, false>(a, b, q, n0, v, hbin, hb, part_out, nullptr, 1.f, a.in[I_POOLSC]);
        __syncthreads();
    }
}
template <bool LAST>
__device__ __forceinline__ void s_ple_units(const KArgs& a, LAS unsigned char* lds, int u0, int G, const bf16_t* pb, const bf16_t* Wp, const bf16_t* hbA, const bf16_t* Wg, const float* part_in, float* part_out, bf16_t* hbout) {
    LAS float* part = (LAS float*)(lds + SG_PART_OFF);
    for (int u = u0; u < 16; u += G) {
        const int n0 = u * 64;
        sgemm_tile<256, 256, 256>(pb + (size_t)SROW * PLE, Wp + (size_t)n0 * PLE, Wp + (size_t)(n0 + 32) * PLE, lds);
        __syncthreads();
        const int tid = otid(), b = tid >> 2, q = tid & 3;
        float ppv[16]; sreduce<16>(part, b, 16 * q, ppv);
        __syncthreads();
        sgemm_tile<1024, 1024, 1024>(hbA + (size_t)SROW * D, Wg + (size_t)n0 * D, Wg + (size_t)(n0 + 32) * D, lds);
        __syncthreads();
        float v[16]; sreduce<16>(part, b, 16 * q, v);
        const float rs = s_row_rs(part_in, b);
        s_res_epi<2, !LAST, !LAST, LAST>(a, b, q, n0, v, hbA, hbout, part_out, ppv, rs, nullptr);
        __syncthreads();
    }
}
__device__ __forceinline__ void s_ffn_units(const KArgs& a, LAS unsigned char* lds, int u0, int G, int l, const bf16_t* hbA, const float* part_in) {
    LAS float* part = (LAS float*)(lds + SG_PART_OFF);
    const bf16_t* W = (const bf16_t*)(a.ws + WS_WFFI + l * WFFI_BYTES);
    bf16_t* Gb = (bf16_t*)(a.ws + WS_BIG);
    const float* convw = a.in[I_FCW] + (size_t)l * 3 * DFF; const float* convb = a.in[I_FCB] + (size_t)l * DFF;
    const float* cstate = a.in[I_SCONV] + (size_t)l * NS * 2 * DFF; float* convs = a.out + O_CONVS + (size_t)l * NS * 2 * DFF;
    for (int u = u0; u < 88; u += G) {
        const int ca = u * 32;
        const int nr = 256 * (ca >> 7) + (ca & 127);
        sgemm_tile<1024, 1024, 1024>(hbA + (size_t)SROW * D, W + (size_t)nr * 1024, W + (size_t)(nr + 128) * 1024, lds);
        __syncthreads();
        const int tid = otid(), b = tid >> 2, q = tid & 3, c = ca + 8 * q;
        float av[8], vv[8]; sreduce<8>(part, b, 8 * q, av); sreduce<8>(part, b, 32 + 8 * q, vv);
        const float rs = s_row_rs(part_in, b);
        const float* st = cstate + (size_t)b * 2 * DFF + c; float* so = convs + (size_t)b * 2 * DFF + c;
        float g[8];
#pragma unroll
        for (int j = 0; j < 8; j += 4) {
            const f32x4 p2 = *(const f32x4*)(st + j), p1 = *(const f32x4*)(st + DFF + j);
            const f32x4 w0 = *(const f32x4*)(convw + c + j), w1 = *(const f32x4*)(convw + DFF + c + j), w2 = *(const f32x4*)(convw + 2 * DFF + c + j), cb = *(const f32x4*)(convb + c + j);
            const f32x4 x = (f32x4){av[j] * rs, av[j + 1] * rs, av[j + 2] * rs, av[j + 3] * rs};
            *(f32x4*)(so + j) = p1; *(f32x4*)(so + DFF + j) = x;
            const f32x4 ac = cb + w0 * p2 + w1 * p1 + w2 * x;
            const f32x2 g0 = gelu_pk((f32x2){ac[0], ac[1]}), g1 = gelu_pk((f32x2){ac[2], ac[3]});
            g[j] = g0.x * vv[j] * rs; g[j + 1] = g0.y * vv[j + 1] * rs; g[j + 2] = g1.x * vv[j + 2] * rs; g[j + 3] = g1.y * vv[j + 3] * rs;
        }
        u32x4 w; w.x = cvt_pk_bf16(g[0], g[1]); w.y = cvt_pk_bf16(g[2], g[3]); w.z = cvt_pk_bf16(g[4], g[5]); w.w = cvt_pk_bf16(g[6], g[7]);
        *(u32x4*)(Gb + (size_t)(SROW + b) * DFF + c) = w;
        __syncthreads();
    }
}

__device__ __forceinline__ void tr_item(const float* W, int ldsrc, int scol0, int k0, const float* gain, bf16_t* dst, int ldd, int drow0, LAS float* scr, int lane) {
    float wv[32];
#pragma unroll
    for (int i = 0; i < 32; ++i) { const int kk = 2 * i + (lane >> 5); wv[i] = __builtin_nontemporal_load(W + (size_t)(k0 + kk) * ldsrc + scol0 + (lane & 31)); }
#pragma unroll
    for (int i = 0; i < 32; ++i) { const int kk = 2 * i + (lane >> 5); const float gsc = gain ? gain[k0 + kk] : 1.f; scr[kk * 33 + (lane & 31)] = wv[i] * gsc; }
    asm volatile("s_waitcnt lgkmcnt(0)" ::: "memory");
    const int c = lane & 7;
#pragma unroll
    for (int j = 0; j < 4; ++j) { const int n = (lane >> 3) + 8 * j; const LAS float* s = scr + (8 * c) * 33 + n;
        u32x4 o; o.x = cvt_pk_bf16(s[0 * 33], s[1 * 33]); o.y = cvt_pk_bf16(s[2 * 33], s[3 * 33]); o.z = cvt_pk_bf16(s[4 * 33], s[5 * 33]); o.w = cvt_pk_bf16(s[6 * 33], s[7 * 33]);
        *(u32x4*)(dst + (size_t)(drow0 + n) * ldd + k0 + 8 * c) = o; }
    asm volatile("s_waitcnt lgkmcnt(0)" ::: "memory");
}
__device__ __forceinline__ void weff_item(const float* Win, const float* wal, int n0, int k0, const float* gain, bf16_t* dst, int drow0, LAS float* scr, int lane) {
#pragma unroll 2
    for (int i = 0; i < 32; ++i) { const int kk = 2 * i + (lane >> 5); const int k = k0 + kk; float s = 0.f;
#pragma unroll
        for (int r = 0; r < 16; ++r) s += Win[(size_t)k * 2320 + 1024 + r] * wal[r * 256 + n0 + (lane & 31)];
        scr[kk * 33 + (lane & 31)] = s * gain[k]; }
    asm volatile("s_waitcnt lgkmcnt(0)" ::: "memory");
    const int c = lane & 7;
#pragma unroll
    for (int j = 0; j < 4; ++j) { const int n = (lane >> 3) + 8 * j; const LAS float* s = scr + (8 * c) * 33 + n;
        u32x4 o; o.x = cvt_pk_bf16(s[0 * 33], s[1 * 33]); o.y = cvt_pk_bf16(s[2 * 33], s[3 * 33]); o.z = cvt_pk_bf16(s[4 * 33], s[5 * 33]); o.w = cvt_pk_bf16(s[6 * 33], s[7 * 33]);
        *(u32x4*)(dst + (size_t)(drow0 + n) * 1024 + k0 + 8 * c) = o; }
    asm volatile("s_waitcnt lgkmcnt(0)" ::: "memory");
}

__device__ __forceinline__ void p0_prologue(const KArgs& a, LAS unsigned char* lds, int vcu, int G) {
    const int tid = otid(), lane = tid & 63, wave = __builtin_amdgcn_readfirstlane(tid >> 6);
    LAS float* scr = (LAS float*)(lds + wave * 16384);
    const int gw = vcu * 8 + wave, NGW = G * 8;
    unsigned char* ws = a.ws;
    constexpr int I_A = 16 * 72, I_E = 16 * 8;
    for (int it = gw; it < I_A + I_E; it += NGW) {
        int r = it;
        if (r < I_A) { const int kb = r / 72, nb = r % 72, n0 = nb * 32; tr_item(a.in[I_WIN], 2320, n0 < 1024 ? n0 : n0 + 16, kb * 64, a.in[I_MNE], (bf16_t*)(ws + WS_WIN0), 1024, n0, scr, lane); continue; } r -= I_A;
        { const int kb = r / 8, nb = r % 8; weff_item(a.in[I_WIN], a.in[I_WALPHA], nb * 32, kb * 64, a.in[I_MNE], (bf16_t*)(ws + WS_WIN0), NPROJ + nb * 32, scr, lane); }
    }
    bf16_t* xbf = (bf16_t*)(ws + WS_R1);
    float* ssq0 = (float*)(ws + WS_SSQ);
    for (int row0 = gw * 2; row0 < MT; row0 += NGW * 2) {
        f32x4 v[2][4];
#pragma unroll
        for (int rr = 0; rr < 2; ++rr) { const int row = row0 + rr;
            const float* src = row < SEQ ? a.in[I_XP] + (size_t)row * D : ((row >= SROW && row < SROW + NS) ? a.in[I_XS] + (size_t)(row - SROW) * D : nullptr);
#pragma unroll
            for (int j = 0; j < 4; ++j) { v[rr][j] = (f32x4){0.f, 0.f, 0.f, 0.f}; if (src) v[rr][j] = __builtin_nontemporal_load((const f32x4*)(src + j * 256 + lane * 4)); } }
#pragma unroll
        for (int rr = 0; rr < 2; ++rr) { const int row = row0 + rr; float s = 0.f;
#pragma unroll
            for (int j = 0; j < 4; ++j) { const f32x4 x = v[rr][j]; s += (x[0] * x[0] + x[1] * x[1]) + (x[2] * x[2] + x[3] * x[3]);
                u32x2 w; w.x = cvt_pk_bf16(x[0], x[1]); w.y = cvt_pk_bf16(x[2], x[3]);
                *(u32x2*)(xbf + (size_t)row * D + j * 256 + lane * 4) = w; }
            s = wave_sum(s);
            if (lane == 0) ssq0[row] = s; }
    }
    if (vcu == 0) { for (int i = tid; i < 256; i += NTHREADS) ((u32x4*)(ws + WS_R2))[i] = (u32x4){0u, 0u, 0u, 0u}; }
    if (vcu == 1 && tid < 6 * 32) { float* pt = (float*)(ws + WS_SSQ + 262144 + (size_t)(tid >> 5) * PART_STRIDE); pt[tid & 31] = 0.f; }
}
constexpr int CONV_ITEMS = 16 * 32 + 2 * 16 * 176 + 2 * 44 * 32 + 2 * 16 * 32 + 2 * 4 * 32 + 4 * 32;
constexpr int CONV_SPLIT = 10368;
__device__ __forceinline__ void p3_convert(const KArgs& a, LAS unsigned char* lds, int gw, int NGW, int it_lo, int it_hi, bool do_p) {
    const int tid = otid(), lane = tid & 63, wave = __builtin_amdgcn_readfirstlane(tid >> 6);
    LAS float* scr = (LAS float*)(lds + wave * 16384);
    unsigned char* ws = a.ws;
    constexpr int I_O = 16 * 32, I_FI = 16 * 176, I_FO = 44 * 32, I_G = 16 * 32, I_P = 4 * 32, I_PL = 4 * 32;
    static_assert(CONV_ITEMS == I_O + 2 * I_FI + 2 * I_FO + 2 * I_G + 2 * I_P + I_PL, "item count");
    for (int it = it_lo + gw; it < it_hi; it += NGW) {
        int r = it;
        if (r < I_O) { const int kb = r / 32, nb = r % 32; tr_item(a.in[I_WOUT], 1024, nb * 32, kb * 64, nullptr, (bf16_t*)(ws + WS_WOUT0), 1024, nb * 32, scr, lane); continue; } r -= I_O;
        if (r < 2 * I_FI) { const int l = r / I_FI, q = r % I_FI, kb = q / 176, nb = q % 176, n0 = nb * 32;
            const int pn = n0 >> 8, rr = n0 & 255, bj = rr >> 7, ii = rr & 127;
            tr_item(a.in[I_FWIN] + (size_t)l * 1024 * 5632, 5632, bj * DFF + pn * 128 + ii, kb * 64, a.in[I_FNORM] + l * 1024, (bf16_t*)(ws + WS_WFFI + l * WFFI_BYTES), 1024, n0, scr, lane); continue; } r -= 2 * I_FI;
        if (r < 2 * I_FO) { const int l = r / I_FO, q = r % I_FO, kb = q / 32, nb = q % 32;
            tr_item(a.in[I_FWOUT] + (size_t)l * DFF * 1024, 1024, nb * 32, kb * 64, nullptr, (bf16_t*)(ws + WS_WFFO + l * WFFO_BYTES), DFF, nb * 32, scr, lane); continue; } r -= 2 * I_FO;
        if (r < 2 * I_G) { const int l = r / I_G, q = r % I_G, kb = q / 32, nb = q % 32;
            tr_item(a.in[I_PWGATE] + (size_t)l * 1024 * 1024, 1024, nb * 32, kb * 64, a.in[I_PNORM] + l * 1024, (bf16_t*)(ws + WS_WGATE + l * WGATE_BYTES), 1024, nb * 32, scr, lane); continue; } r -= 2 * I_G;
        if (r < 2 * I_P) { const int l = r / I_P, q = r % I_P, kb = q / 32, nb = q % 32;
            tr_item(a.in[I_PWPROJ] + (size_t)l * 256 * 1024, 1024, nb * 32, kb * 64, nullptr, (bf16_t*)(ws + WS_WPROJ + l * WPROJ_BYTES), 256, nb * 32, scr, lane); continue; } r -= 2 * I_P;
        { const int gq = r / 32, q = r % 32, kb = q / 8, nb = q % 8;
            tr_item(a.in[I_POOLW] + (size_t)gq * 65536, 256, nb * 32, kb * 64, nullptr, (bf16_t*)(ws + WS_WPOOL), 256, gq * 256 + nb * 32, scr, lane); }
    }
    bf16_t* pbf = (bf16_t*)(ws + WS_PBF);
    if (do_p)
    for (int it0 = gw * 4; it0 < 2 * MT; it0 += NGW * 4) {
        f32x4 v[4];
#pragma unroll
        for (int rr = 0; rr < 4; ++rr) { const int it = it0 + rr; const int l = it / MT, row = it % MT;
            const float* src = row < SEQ ? a.in[I_PP] + ((size_t)l * SEQ + row) * PLE : ((row >= SROW && row < SROW + NS) ? a.in[I_PS] + ((size_t)l * NS + (row - SROW)) * PLE : nullptr);
            v[rr] = (f32x4){0.f, 0.f, 0.f, 0.f}; if (src) v[rr] = __builtin_nontemporal_load((const f32x4*)(src + lane * 4)); }
#pragma unroll
        for (int rr = 0; rr < 4; ++rr) { u32x2 w; w.x = cvt_pk_bf16(v[rr][0], v[rr][1]); w.y = cvt_pk_bf16(v[rr][2], v[rr][3]);
            *(u32x2*)(pbf + (size_t)(it0 + rr) * PLE + lane * 4) = w; }
    }
}

__device__ __forceinline__ int crow(int i, int hh) { return (i & 3) + 8 * (i >> 2) + 4 * hh; }
template <bool OUT>
__device__ __forceinline__ void gla_item_m(const KArgs& a, LAS unsigned char* lds, int item) {
    const int tid = otid(), lane = tid & 63, wave = __builtin_amdgcn_readfirstlane(tid >> 6);
    const int sc = item >> 2, h = item & 3;
    const bf16_t* proj = (const bf16_t*)(a.ws + WS_BIG); const float* la = (const float*)(a.ws + WS_BIG + BIG_LA);
    bf16_t* mix = (bf16_t*)(a.ws + WS_R1);
    float* US = (float*)(a.ws + WS_R2 + 4096); float* DS = US + (size_t)64 * 4 * 64 * 128;
    LAS float* bL = (LAS float*)lds; LAS float* segS = (LAS float*)(lds + 16384);
    LAS bf16_t* Qn = (LAS bf16_t*)(lds + 18432); LAS bf16_t* Kn = (LAS bf16_t*)(lds + 27648); LAS bf16_t* KT = (LAS bf16_t*)(lds + 36864);
    LAS bf16_t* VT = (LAS bf16_t*)(lds + 46080); LAS bf16_t* ST = (LAS bf16_t*)(lds + 64512); LAS float* red = (LAS float*)(lds + 82944);
    const int r = lane & 31, hh = lane >> 5;
    const int dkt = wave & 1, dvt = wave >> 1, it = wave & 1;
    f32x16 S = {};
    float* usp = US + ((size_t)(sc * 4 + h) * 64 + 32 * dkt) * 128 + 32 * dvt + r;
    if (OUT) {
#pragma unroll
        for (int i = 0; i < 16; ++i) S[i] = usp[(size_t)crow(i, hh) * 128];
    }
    float bsum = 0.f;
    const int sdk = tid & 63, sseg = tid >> 6, st_t = tid >> 3, sd8 = (tid & 7) * 8;
    float nla[8]; u32x4 nkw, nqw, nvw[2]; u32x2 nrw[4];
#define GLA_FETCH(cc) do { const int T0n = sc * 256 + (cc) * 64; \
        _Pragma("unroll") for (int i = 0; i < 8; ++i) nla[i] = la[(size_t)(T0n + 8 * sseg + i) * 256 + h * 64 + sdk]; \
        const size_t prow_ = (size_t)(T0n + st_t) * NPROJ; \
        nkw = *(const u32x4*)(proj + prow_ + PKA + h * 64 + sd8); \
        if (OUT) nqw = *(const u32x4*)(proj + prow_ + PQA + h * 64 + sd8); \
        nvw[0] = *(const u32x4*)(proj + prow_ + PVA + h * 128 + sd8); nvw[1] = *(const u32x4*)(proj + prow_ + PVA + h * 128 + sd8 + 64); \
        if (OUT) { _Pragma("unroll") for (int q = 0; q < 4; ++q) nrw[q] = *(const u32x2*)(proj + (size_t)(T0n + 32 * it + r) * NPROJ + PRA + h * 128 + 32 * dvt + 8 * q + 4 * hh); } } while (0)
    GLA_FETCH(0);
#pragma unroll 1
    for (int c = 0; c < 4; ++c) {
        const int T0 = sc * 256 + c * 64;
        float v[8]; u32x4 kw_c = nkw, qw_c = nqw, vw_c0 = nvw[0], vw_c1 = nvw[1]; u32x2 rw_c[4];
#pragma unroll
        for (int i = 0; i < 8; ++i) v[i] = nla[i];
#pragma unroll
        for (int q = 0; q < 4; ++q) rw_c[q] = nrw[q];
        if (c < 3) GLA_FETCH(c + 1);
        if (OUT) {
#pragma unroll
            for (int q = 0; q < 4; ++q) { u32x2 w; w.x = cvt_pk_bf16(S[4 * q], S[4 * q + 1]); w.y = cvt_pk_bf16(S[4 * q + 2], S[4 * q + 3]);
                *(LAS u32x2*)(ST + (32 * dvt + r) * 72 + 32 * dkt + 8 * q + 4 * hh) = w; }
        }
        {
            const int dk = sdk, seg = sseg;
#pragma unroll
            for (int i = 1; i < 8; ++i) v[i] += v[i - 1];
            segS[seg * 64 + dk] = v[7];
            __syncthreads();
            float off = 0.f;
#pragma unroll
            for (int s = 0; s < 8; ++s) { const float x = segS[s * 64 + dk]; off += (s < seg) ? x : 0.f; }
#pragma unroll
            for (int i = 0; i < 8; ++i) bL[(8 * seg + i) * 64 + dk] = v[i] + off;
            __syncthreads();
        }
        {
            const int t = st_t, d8 = sd8;
            const f32x4 b0 = *(const LAS f32x4*)(bL + t * 64 + d8), b1 = *(const LAS f32x4*)(bL + t * 64 + d8 + 4);
            const f32x4 l0 = *(const LAS f32x4*)(bL + 63 * 64 + d8), l1 = *(const LAS f32x4*)(bL + 63 * 64 + d8 + 4);
            float bb[8] = {b0[0], b0[1], b0[2], b0[3], b1[0], b1[1], b1[2], b1[3]}, bl[8] = {l0[0], l0[1], l0[2], l0[3], l1[0], l1[1], l1[2], l1[3]};
            float kf[8]; unpack8(kw_c, kf);
#pragma unroll
            for (int j = 0; j < 8; ++j) KT[(d8 + j) * 72 + t] = (bf16_t)(cvt_pk_bf16(kf[j] * __expf(bl[j] - bb[j]), 0.f) & 0xffffu);
            if (OUT) {
                float qf[8]; unpack8(qw_c, qf);
                float qq[8], kk[8];
#pragma unroll
                for (int j = 0; j < 8; ++j) { const float e = __expf(bb[j]); qq[j] = qf[j] * 0.125f * e; kk[j] = kf[j] * __expf(-bb[j]); }
                u32x4 w; w.x = cvt_pk_bf16(qq[0], qq[1]); w.y = cvt_pk_bf16(qq[2], qq[3]); w.z = cvt_pk_bf16(qq[4], qq[5]); w.w = cvt_pk_bf16(qq[6], qq[7]);
                *(LAS u32x4*)(Qn + t * 72 + d8) = w;
                w.x = cvt_pk_bf16(kk[0], kk[1]); w.y = cvt_pk_bf16(kk[2], kk[3]); w.z = cvt_pk_bf16(kk[4], kk[5]); w.w = cvt_pk_bf16(kk[6], kk[7]);
                *(LAS u32x4*)(Kn + t * 72 + d8) = w;
            }
#pragma unroll
            for (int i = 0; i < 2; ++i) { const int dv8 = d8 + 64 * i;
                const u32x4 vw = (i == 0) ? vw_c0 : vw_c1;
                LAS bf16_t* vt = VT + dv8 * 72 + t;
                vt[0 * 72] = (bf16_t)(vw.x & 0xffffu); vt[1 * 72] = (bf16_t)(vw.x >> 16); vt[2 * 72] = (bf16_t)(vw.y & 0xffffu); vt[3 * 72] = (bf16_t)(vw.y >> 16);
                vt[4 * 72] = (bf16_t)(vw.z & 0xffffu); vt[5 * 72] = (bf16_t)(vw.z >> 16); vt[6 * 72] = (bf16_t)(vw.w & 0xffffu); vt[7 * 72] = (bf16_t)(vw.w >> 16); }
            if (tid < 64) bsum += bL[63 * 64 + tid];
        }
        __syncthreads();
        if (OUT) {
            bf16x8 qf[4];
#pragma unroll
            for (int s = 0; s < 4; ++s) qf[s] = *(const LAS bf16x8*)(Qn + (32 * it + r) * 72 + 16 * s + 8 * hh);
            f32x16 oacc = {};
#pragma unroll
            for (int jt = 0; jt < 2; ++jt) {
                if (jt <= it) {
                    f32x16 at = {};
#pragma unroll
                    for (int s = 0; s < 4; ++s) { const bf16x8 af = *(const LAS bf16x8*)(Kn + (32 * jt + r) * 72 + 16 * s + 8 * hh); at = __builtin_amdgcn_mfma_f32_32x32x16_bf16(af, qf[s], at, 0, 0, 0); }
                    if (jt == it) {
#pragma unroll
                        for (int i = 0; i < 16; ++i) if (crow(i, hh) > r) at[i] = 0.f;
                    }
#pragma unroll
                    for (int s2 = 0; s2 < 2; ++s2) {
                        u32x4 pw; pw.x = cvt_pk_bf16(at[8 * s2 + 0], at[8 * s2 + 1]); pw.y = cvt_pk_bf16(at[8 * s2 + 2], at[8 * s2 + 3]);
                        pw.z = cvt_pk_bf16(at[8 * s2 + 4], at[8 * s2 + 5]); pw.w = cvt_pk_bf16(at[8 * s2 + 6], at[8 * s2 + 7]);
                        const LAS bf16_t* vp = VT + (32 * dvt + r) * 72 + 32 * jt + 16 * s2 + 4 * hh;
                        const u32x2 v0 = *(const LAS u32x2*)vp, v1 = *(const LAS u32x2*)(vp + 8);
                        const u32x4 vv = (u32x4){v0.x, v0.y, v1.x, v1.y};
                        oacc = __builtin_amdgcn_mfma_f32_32x32x16_bf16(__builtin_bit_cast(bf16x8, vv), __builtin_bit_cast(bf16x8, pw), oacc, 0, 0, 0);
                    }
                }
            }
#pragma unroll
            for (int s = 0; s < 4; ++s) { const bf16x8 af = *(const LAS bf16x8*)(ST + (32 * dvt + r) * 72 + 16 * s + 8 * hh); oacc = __builtin_amdgcn_mfma_f32_32x32x16_bf16(af, qf[s], oacc, 0, 0, 0); }
            float ss = 0.f;
#pragma unroll
            for (int i = 0; i < 16; ++i) ss += oacc[i] * oacc[i];
            ss += __shfl_xor(ss, 32);
            if (hh == 0) red[wave * 32 + r] = ss;
            __syncthreads();
            const float tot = (red[it * 32 + r] + red[(it + 2) * 32 + r]) + (red[(it + 4) * 32 + r] + red[(it + 6) * 32 + r]);
            const float rstd = rsqrtf(tot * (1.0f / 128.f) + EPS);
            const int t = T0 + 32 * it + r;
#pragma unroll
            for (int q = 0; q < 4; ++q) {
                const int dv0 = 32 * dvt + 8 * q + 4 * hh;
                const u32x2 rw = rw_c[q];
                const f32x4 on = *(const f32x4*)(a.in[I_ONORM] + dv0);
                const float r0 = bf_lo(rw.x), r1 = bf_hi(rw.x), r2 = bf_lo(rw.y), r3 = bf_hi(rw.y);
                const float y0 = oacc[4 * q] * rstd * on[0] * (r0 / (1.f + __expf(-r0))), y1 = oacc[4 * q + 1] * rstd * on[1] * (r1 / (1.f + __expf(-r1)));
                const float y2 = oacc[4 * q + 2] * rstd * on[2] * (r2 / (1.f + __expf(-r2))), y3 = oacc[4 * q + 3] * rstd * on[3] * (r3 / (1.f + __expf(-r3)));
                u32x2 w; w.x = cvt_pk_bf16(y0, y1); w.y = cvt_pk_bf16(y2, y3);
                *(u32x2*)(mix + (size_t)t * D + h * 128 + dv0) = w;
            }
        }
#pragma unroll
        for (int i = 0; i < 16; ++i) S[i] *= __expf(bL[63 * 64 + 32 * dkt + crow(i, hh)]);
#pragma unroll
        for (int s = 0; s < 4; ++s) {
            const bf16x8 af = *(const LAS bf16x8*)(KT + (32 * dkt + r) * 72 + 16 * s + 8 * hh), bf = *(const LAS bf16x8*)(VT + (32 * dvt + r) * 72 + 16 * s + 8 * hh);
            S = __builtin_amdgcn_mfma_f32_32x32x16_bf16(af, bf, S, 0, 0, 0);
        }
        __syncthreads();
    }
#undef GLA_FETCH
    if (!OUT) {
#pragma unroll
        for (int i = 0; i < 16; ++i) usp[(size_t)crow(i, hh) * 128] = S[i];
        if (tid < 64) DS[(sc * 4 + h) * 64 + tid] = __expf(bsum);
    }
}
__device__ __forceinline__ void gla_scan_m(const KArgs& a, int vcu) {
    const int tid = otid(); if (tid >= 128) return;
    const int e = vcu * 128 + tid; if (e >= 32768) return;
    float* US = (float*)(a.ws + WS_R2 + 4096); const float* DS = US + (size_t)64 * 4 * 64 * 128;
    const int hd = e >> 7;
    float S = 0.f;
    for (int c0 = 0; c0 < 64; c0 += 8) {
        float u[8], d[8];
#pragma unroll
        for (int j = 0; j < 8; ++j) { u[j] = US[(size_t)(c0 + j) * 32768 + e]; d[j] = DS[(c0 + j) * 256 + hd]; }
#pragma unroll
        for (int j = 0; j < 8; ++j) { US[(size_t)(c0 + j) * 32768 + e] = S; S = d[j] * S + u[j]; }
    }
    a.out[O_GLAP + e] = S;
}
__device__ __forceinline__ void gla_decode_item(const KArgs& a, int item, int lane) {
    const int b = item >> 2, h = item & 3; const int row = SROW + b;
    const bf16_t* proj = (const bf16_t*)(a.ws + WS_BIG); const float* la = (const float*)(a.ws + WS_BIG + BIG_LA);
    bf16_t* mix = (bf16_t*)(a.ws + WS_R1);
    const float* S0 = a.in[I_SGLA] + ((size_t)b * 4 + h) * 8192;
    float* S1 = a.out + O_GLAS + ((size_t)b * 4 + h) * 8192;
    const float qv = bf2f(proj[(size_t)row * NPROJ + PQA + h * 64 + lane]) * 0.125f;
    const float kv = bf2f(proj[(size_t)row * NPROJ + PKA + h * 64 + lane]);
    const float av = __expf(la[(size_t)row * 256 + h * 64 + lane]);
    const unsigned vw = *(const unsigned*)(proj + (size_t)row * NPROJ + PVA + h * 128 + lane * 2);
    const float v0 = bf_lo(vw), v1 = bf_hi(vw);
    float o0 = 0.f, o1 = 0.f;
#pragma unroll 1
    for (int d0 = 0; d0 < 64; d0 += 16) {
        f32x2 sv[16];
#pragma unroll
        for (int j = 0; j < 16; ++j) sv[j] = __builtin_nontemporal_load((const f32x2*)(S0 + (d0 + j) * 128 + lane * 2));
#pragma unroll
        for (int j = 0; j < 16; ++j) {
            const int dk = d0 + j;
            const float q = __shfl(qv, dk), k = __shfl(kv, dk), al = __shfl(av, dk);
            const float n0 = al * sv[j].x + k * v0, n1 = al * sv[j].y + k * v1;
            __builtin_nontemporal_store((f32x2){n0, n1}, (f32x2*)(S1 + dk * 128 + lane * 2));
            o0 += q * n0; o1 += q * n1;
        }
    }
    const float ss = wave_sum(o0 * o0 + o1 * o1);
    const float rstd = rsqrtf(ss * (1.0f / 128.f) + EPS);
    const unsigned rw = *(const unsigned*)(proj + (size_t)row * NPROJ + PRA + h * 128 + lane * 2);
    const float r0 = bf_lo(rw), r1 = bf_hi(rw);
    const float y0 = o0 * rstd * a.in[I_ONORM][lane * 2] * (r0 / (1.f + __expf(-r0))), y1 = o1 * rstd * a.in[I_ONORM][lane * 2 + 1] * (r1 / (1.f + __expf(-r1)));
    *(unsigned*)(mix + (size_t)row * D + h * 128 + lane * 2) = cvt_pk_bf16(y0, y1);
}

__device__ __forceinline__ void swa_unit_m(const KArgs& a, LAS unsigned char* lds, int unit) {
    const int tid = otid(), lane = tid & 63, wave = __builtin_amdgcn_readfirstlane(tid >> 6);
    const int qb = unit >> 1, kvh = unit & 1; const int q0 = qb * 64, w0 = q0 - 128;
    const bf16_t* proj = (const bf16_t*)(a.ws + WS_BIG);
    bf16_t* mix = (bf16_t*)(a.ws + WS_R1);
    LAS bf16_t* Kl = (LAS bf16_t*)lds;
    LAS bf16_t* Vt = Kl + 192 * 72;
    const float* kn = a.in[I_KNORM];
    const int g = wave & 3, th = wave >> 2, hq = kvh * 4 + g;
    const int r = lane & 31, hh = lane >> 5;
    const int t = q0 + 32 * th + r;
    u32x4 kwv[3], vwv[3], qwv[4];
#pragma unroll
    for (int i = 0; i < 3; ++i) { const int c = tid + i * NTHREADS; const int kk = c >> 3, part = c & 7; const int tk = w0 + kk;
        kwv[i] = (u32x4){0u, 0u, 0u, 0u}; vwv[i] = (u32x4){0u, 0u, 0u, 0u};
        if (tk >= 0) { kwv[i] = *(const u32x4*)(proj + (size_t)tk * NPROJ + PKB + kvh * 64 + part * 8); vwv[i] = *(const u32x4*)(proj + (size_t)tk * NPROJ + PVB + kvh * 64 + part * 8); } }
#pragma unroll
    for (int s = 0; s < 4; ++s) qwv[s] = *(const u32x4*)(proj + (size_t)t * NPROJ + PQB + hq * 64 + 16 * s + 8 * hh);
#pragma unroll
    for (int i = 0; i < 3; ++i) {
        const int c = tid + i * NTHREADS; const int kk = c >> 3, part = c & 7;
        float kf[8]; unpack8(kwv[i], kf);
        const u32x4 vw = vwv[i];
        float ss = 0.f;
#pragma unroll
        for (int j = 0; j < 8; ++j) ss += kf[j] * kf[j];
        ss += __shfl_xor(ss, 1); ss += __shfl_xor(ss, 2); ss += __shfl_xor(ss, 4);
        const float rstd = rsqrtf(ss * (1.0f / 64.f) + EPS);
#pragma unroll
        for (int j = 0; j < 8; ++j) kf[j] = kf[j] * rstd * kn[part * 8 + j];
        u32x4 kw2; kw2.x = cvt_pk_bf16(kf[0], kf[1]); kw2.y = cvt_pk_bf16(kf[2], kf[3]); kw2.z = cvt_pk_bf16(kf[4], kf[5]); kw2.w = cvt_pk_bf16(kf[6], kf[7]);
        *(LAS u32x4*)(Kl + kk * 72 + part * 8) = kw2;
        LAS bf16_t* vt = Vt + (part * 8) * 196 + kk;
        vt[0 * 196] = (bf16_t)(vw.x & 0xffffu); vt[1 * 196] = (bf16_t)(vw.x >> 16); vt[2 * 196] = (bf16_t)(vw.y & 0xffffu); vt[3 * 196] = (bf16_t)(vw.y >> 16);
        vt[4 * 196] = (bf16_t)(vw.z & 0xffffu); vt[5 * 196] = (bf16_t)(vw.z >> 16); vt[6 * 196] = (bf16_t)(vw.w & 0xffffu); vt[7 * 196] = (bf16_t)(vw.w >> 16);
        if (qb == 255 && kk >= 64) {
            const int w = kk - 64;
            float vf[8]; unpack8(vw, vf);
            float* ko = a.out + O_SKP + ((size_t)w * 2 + kvh) * 64 + part * 8; float* vo = a.out + O_SVP + ((size_t)w * 2 + kvh) * 64 + part * 8;
            *(f32x4*)ko = (f32x4){kf[0], kf[1], kf[2], kf[3]}; *(f32x4*)(ko + 4) = (f32x4){kf[4], kf[5], kf[6], kf[7]};
            *(f32x4*)vo = (f32x4){vf[0], vf[1], vf[2], vf[3]}; *(f32x4*)(vo + 4) = (f32x4){vf[4], vf[5], vf[6], vf[7]};
        }
    }
    __syncthreads();
    constexpr float LOG2E = 1.4426950408889634f;
    bf16x8 qf[4];
    {
        float qv[4][8]; float ss = 0.f;
#pragma unroll
        for (int s = 0; s < 4; ++s) { unpack8(qwv[s], qv[s]);
#pragma unroll
            for (int j = 0; j < 8; ++j) ss += qv[s][j] * qv[s][j]; }
        ss += __shfl_xor(ss, 32);
        const float rstd = rsqrtf(ss * (1.0f / 64.f) + EPS) * (0.125f * LOG2E);
        const float* qn = a.in[I_QNORM];
#pragma unroll
        for (int s = 0; s < 4; ++s) {
            u32x4 w;
            w.x = cvt_pk_bf16(qv[s][0] * rstd * qn[16 * s + 8 * hh + 0], qv[s][1] * rstd * qn[16 * s + 8 * hh + 1]);
            w.y = cvt_pk_bf16(qv[s][2] * rstd * qn[16 * s + 8 * hh + 2], qv[s][3] * rstd * qn[16 * s + 8 * hh + 3]);
            w.z = cvt_pk_bf16(qv[s][4] * rstd * qn[16 * s + 8 * hh + 4], qv[s][5] * rstd * qn[16 * s + 8 * hh + 5]);
            w.w = cvt_pk_bf16(qv[s][6] * rstd * qn[16 * s + 8 * hh + 6], qv[s][7] * rstd * qn[16 * s + 8 * hh + 7]);
            qf[s] = __builtin_bit_cast(bf16x8, w);
        }
    }
    f32x16 sacc[5];
#pragma unroll
    for (int k5 = 0; k5 < 5; ++k5) {
        const int kt = th + k5;
        f32x16 acc = {};
#pragma unroll
        for (int s = 0; s < 4; ++s) { const bf16x8 af = *(const LAS bf16x8*)(Kl + (kt * 32 + r) * 72 + 16 * s + 8 * hh); acc = __builtin_amdgcn_mfma_f32_32x32x16_bf16(af, qf[s], acc, 0, 0, 0); }
        sacc[k5] = acc;
    }
    const float slope2 = exp2f(-(float)(hq + 1)) * LOG2E;
    const float sink2 = a.in[I_SINKS][hq] * LOG2E;
    float mx = sink2;
#pragma unroll
    for (int k5 = 0; k5 < 5; ++k5)
#pragma unroll
        for (int i = 0; i < 16; ++i) {
            const int row = (i & 3) + 8 * (i >> 2) + 4 * hh;
            const int dist = 128 - 32 * k5 + r - row;
            const int tk = w0 + 32 * (th + k5) + row;
            float s = sacc[k5][i] - slope2 * (float)dist;
            if (dist < 0 || dist >= 128 || tk < 0) s = -1e30f;
            sacc[k5][i] = s; mx = fmaxf(mx, s);
        }
    mx = fmaxf(mx, __shfl_xor(mx, 32));
    float l = 0.f;
#pragma unroll
    for (int k5 = 0; k5 < 5; ++k5)
#pragma unroll
        for (int i = 0; i < 16; ++i) { const float p = exp2f(sacc[k5][i] - mx); sacc[k5][i] = p; l += p; }
    l += __shfl_xor(l, 32);
    l += exp2f(sink2 - mx);
    f32x16 oacc[2] = {{}, {}};
#pragma unroll
    for (int k5 = 0; k5 < 5; ++k5) {
        const int kt = th + k5;
#pragma unroll
        for (int s2 = 0; s2 < 2; ++s2) {
            u32x4 pw;
            pw.x = cvt_pk_bf16(sacc[k5][8 * s2 + 0], sacc[k5][8 * s2 + 1]); pw.y = cvt_pk_bf16(sacc[k5][8 * s2 + 2], sacc[k5][8 * s2 + 3]);
            pw.z = cvt_pk_bf16(sacc[k5][8 * s2 + 4], sacc[k5][8 * s2 + 5]); pw.w = cvt_pk_bf16(sacc[k5][8 * s2 + 6], sacc[k5][8 * s2 + 7]);
            const bf16x8 pf = __builtin_bit_cast(bf16x8, pw);
#pragma unroll
            for (int dt = 0; dt < 2; ++dt) {
                const LAS bf16_t* vp = Vt + (32 * dt + r) * 196 + kt * 32 + 16 * s2 + 4 * hh;
                const u32x2 v0 = *(const LAS u32x2*)vp, v1 = *(const LAS u32x2*)(vp + 8);
                const u32x4 vv = (u32x4){v0.x, v0.y, v1.x, v1.y};
                oacc[dt] = __builtin_amdgcn_mfma_f32_32x32x16_bf16(__builtin_bit_cast(bf16x8, vv), pf, oacc[dt], 0, 0, 0);
            }
        }
    }
    const float inv = 1.f / l;
#pragma unroll
    for (int dt = 0; dt < 2; ++dt)
#pragma unroll
        for (int q = 0; q < 4; ++q) {
            u32x2 w; w.x = cvt_pk_bf16(oacc[dt][4 * q] * inv, oacc[dt][4 * q + 1] * inv); w.y = cvt_pk_bf16(oacc[dt][4 * q + 2] * inv, oacc[dt][4 * q + 3] * inv);
            *(u32x2*)(mix + (size_t)t * D + 512 + hq * 64 + 32 * dt + 8 * q + 4 * hh) = w;
        }
    __syncthreads();
}
__device__ __forceinline__ void swa_decode_item(const KArgs& a, int item, int lane) {
    const int b = item >> 3, kvh = (item >> 2) & 1, g = item & 3, hq = kvh * 4 + g; const int row = SROW + b;
    const bf16_t* proj = (const bf16_t*)(a.ws + WS_BIG);
    bf16_t* mix = (bf16_t*)(a.ws + WS_R1);
    const float* ck = a.in[I_CK] + (size_t)b * 128 * 128 + kvh * 64;
    const float* cv = a.in[I_CV] + (size_t)b * 128 * 128 + kvh * 64;
    float qd = bf2f(proj[(size_t)row * NPROJ + PQB + hq * 64 + lane]);
    { const float ss = wave_sum(qd * qd); qd = qd * rsqrtf(ss * (1.0f / 64.f) + EPS) * a.in[I_QNORM][lane] * 0.125f; }
    float kd = bf2f(proj[(size_t)row * NPROJ + PKB + kvh * 64 + lane]);
    { const float ss = wave_sum(kd * kd); kd = kd * rsqrtf(ss * (1.0f / 64.f) + EPS) * a.in[I_KNORM][lane]; }
    const float vd = bf2f(proj[(size_t)row * NPROJ + PVB + kvh * 64 + lane]);
    const float slope = exp2f(-(float)(hq + 1));
    float s0 = 0.f, s1 = 0.f;
    {
        f32x4 k0[16], k1[16];
#pragma unroll
        for (int i = 0; i < 16; ++i) { k0[i] = *(const f32x4*)(ck + (size_t)lane * 128 + 4 * i); k1[i] = *(const f32x4*)(ck + (size_t)(lane + 64) * 128 + 4 * i); }
#pragma unroll
        for (int i = 0; i < 16; ++i) {
            const float q0 = __shfl(qd, 4 * i), q1 = __shfl(qd, 4 * i + 1), q2 = __shfl(qd, 4 * i + 2), q3 = __shfl(qd, 4 * i + 3);
            s0 += (q0 * k0[i][0] + q1 * k0[i][1]) + (q2 * k0[i][2] + q3 * k0[i][3]);
            s1 += (q0 * k1[i][0] + q1 * k1[i][1]) + (q2 * k1[i][2] + q3 * k1[i][3]);
        }
    }
    s0 -= slope * (float)(128 - lane); s1 -= slope * (float)(64 - lane);
    if (lane == 0) s0 = -1e30f;
    const float sn = wave_sum(qd * kd);
    const float sink = a.in[I_SINKS][hq];
    const float mx = fmaxf(fmaxf(wave_max(fmaxf(s0, s1)), sn), sink);
    const float p0 = __expf(s0 - mx), p1 = __expf(s1 - mx), pn = __expf(sn - mx);
    const float l = wave_sum(p0 + p1) + pn + __expf(sink - mx);
    float od = pn * vd;
#pragma unroll 1
    for (int w0 = 0; w0 < 64; w0 += 16) {
        float ca[16], cb[16];
#pragma unroll
        for (int j = 0; j < 16; ++j) { ca[j] = cv[(size_t)(w0 + j) * 128 + lane]; cb[j] = cv[(size_t)(w0 + j + 64) * 128 + lane]; }
#pragma unroll
        for (int j = 0; j < 16; ++j) { const float pa = __shfl(p0, w0 + j), pb = __shfl(p1, w0 + j); od += pa * ca[j] + pb * cb[j]; }
    }
    od /= l;
    const float oo = __shfl_down(od, 1);
    if ((lane & 1) == 0) *(unsigned*)(mix + (size_t)row * D + 512 + hq * 64 + lane) = cvt_pk_bf16(od, oo);
    {
        float* __restrict__ ko = a.out + O_SKS + (size_t)b * 128 * 128 + kvh * 64; float* __restrict__ vo = a.out + O_SVS + (size_t)b * 128 * 128 + kvh * 64;
        float ka[32], va[32];
#pragma unroll
        for (int j = 0; j < 32; ++j) { const int w = 32 * g + j + 1; ka[j] = (w < 128) ? ck[(size_t)w * 128 + lane] : kd; va[j] = (w < 128) ? cv[(size_t)w * 128 + lane] : vd; }
#pragma unroll
        for (int j = 0; j < 32; ++j) { ko[(size_t)(32 * g + j) * 128 + lane] = ka[j]; vo[(size_t)(32 * g + j) * 128 + lane] = va[j]; }
    }
}

template <int W>
__device__ __forceinline__ void pool_core(const bf16_t* __restrict__ h, const LAS float* rsL, const f32x4 gg, int r0, int half, int c4, bf16_t* __restrict__ d1, float* __restrict__ poolp) {
    const int rb = r0 + 8 * half;
    float xn[23][4];
#pragma unroll
    for (int i = 0; i < 23; ++i) { const int r = rb - 15 + i;
        u32x2 w = (u32x2){0u, 0u};
        if (i >= 16 - W && r >= 0) w = *(const u32x2*)(h + (size_t)r * D + c4);
        const float rs = rsL[8 * half + i];
        xn[i][0] = bf_lo(w.x) * rs * gg[0]; xn[i][1] = bf_hi(w.x) * rs * gg[1]; xn[i][2] = bf_lo(w.y) * rs * gg[2]; xn[i][3] = bf_hi(w.y) * rs * gg[3]; }
    float s[4] = {0.f, 0.f, 0.f, 0.f};
#pragma unroll
    for (int k = 1; k < W; ++k)
#pragma unroll
        for (int j = 0; j < 4; ++j) s[j] += xn[15 - k][j];
#pragma unroll
    for (int i = 0; i < 8; ++i) {
        const int r = rb + i;
        const int cnt = (r + 1 < W) ? r + 1 : W; const float ic = 1.0f / (float)cnt;
        float dd[4];
#pragma unroll
        for (int j = 0; j < 4; ++j) { s[j] += xn[15 + i][j]; dd[j] = s[j] * ic - xn[15 + i][j]; s[j] -= xn[15 + i - (W - 1)][j]; }
        u32x2 w; w.x = cvt_pk_bf16(dd[0], dd[1]); w.y = cvt_pk_bf16(dd[2], dd[3]);
        *(u32x2*)(d1 + (size_t)r * D + c4) = w;
        if (r >= SEQ - 15) *(f32x4*)(poolp + (size_t)(r - (SEQ - 15)) * D + c4) = (f32x4){xn[15 + i][0], xn[15 + i][1], xn[15 + i][2], xn[15 + i][3]};
    }
}
__device__ __forceinline__ void pool_item(const KArgs& a, LAS unsigned char* lds, int item, const float* part_in) {
    const int tid = otid();
    const bf16_t* h = (const bf16_t*)(a.ws + WS_R2 + 4096); bf16_t* d1 = (bf16_t*)(a.ws + WS_R1);
    LAS float* rsL = (LAS float*)lds;
    const int r0 = item * 16;
    __syncthreads();
    if (tid < 31) { const int r = r0 - 15 + tid; float rs = 0.f;
        if (r >= 0) { const f32x4 p0 = *(const f32x4*)(part_in + (long)r * 16), p1 = *(const f32x4*)(part_in + (long)r * 16 + 4), p2 = *(const f32x4*)(part_in + (long)r * 16 + 8), p3 = *(const f32x4*)(part_in + (long)r * 16 + 12);
            const float s = ((p0[0] + p0[1]) + (p0[2] + p0[3])) + ((p1[0] + p1[1]) + (p1[2] + p1[3])) + ((p2[0] + p2[1]) + (p2[2] + p2[3])) + ((p3[0] + p3[1]) + (p3[2] + p3[3]));
            rs = rsqrtf(s * (1.0f / D) + EPS); }
        rsL[tid] = rs; }
    __syncthreads();
    const int c4 = 4 * (tid & 255), half = tid >> 8; const int gq = __builtin_amdgcn_readfirstlane(c4 >> 8);
    const f32x4 gg = *(const f32x4*)(a.in[I_MNO] + c4);
    if (gq == 0) pool_core<2>(h, rsL, gg, r0, half, c4, d1, a.out + O_POOLP);
    else if (gq == 1) pool_core<4>(h, rsL, gg, r0, half, c4, d1, a.out + O_POOLP);
    else if (gq == 2) pool_core<8>(h, rsL, gg, r0, half, c4, d1, a.out + O_POOLP);
    else pool_core<16>(h, rsL, gg, r0, half, c4, d1, a.out + O_POOLP);
}
__device__ __forceinline__ void pool_sample_item(const KArgs& a, LAS unsigned char* lds, int b, const float* part_in) {
    const int tid = otid();
    const bf16_t* __restrict__ h = (const bf16_t*)(a.ws + WS_R2 + 4096) + (size_t)(SROW + b) * D; bf16_t* __restrict__ d1 = (bf16_t*)(a.ws + WS_R1);
    const float* __restrict__ st = a.in[I_SPOOL] + (size_t)b * 15 * D; float* __restrict__ so = a.out + O_POOLS + (size_t)b * 15 * D;
    float s = 0.f;
#pragma unroll
    for (int i = 0; i < 16; ++i) s += part_in[(long)(SROW + b) * 16 + i];
    const float rs = rsqrtf(s * (1.0f / D) + EPS);
#pragma unroll
    for (int cc = 0; cc < 2; ++cc) {
        const int c = tid + cc * NTHREADS; const int w = 2 << (c >> 8);
        float sv[15];
#pragma unroll
        for (int j = 0; j < 15; ++j) sv[j] = st[(size_t)j * D + c];
        const float xn = bf2f(h[c]) * rs * a.in[I_MNO][c];
        float sum = xn;
#pragma unroll
        for (int j = 0; j < 15; ++j) sum += (j >= 16 - w) ? sv[j] : 0.f;
        const float dd = sum / (float)w - xn;
        d1[(size_t)(SROW + b) * D + c] = (bf16_t)(cvt_pk_bf16(dd, 0.f) & 0xffffu);
#pragma unroll
        for (int j = 0; j < 14; ++j) so[(size_t)j * D + c] = sv[j + 1];
        so[(size_t)14 * D + c] = xn;
    }
}

#define XB_TMO      128
#define XB_XCNT(j)  (256  + 64 * (j))
#define XB_XSUB(j)  (1280 + 64 * (j))
#define XB_XGEN(j)  (2304 + 64 * (j))
#define XB_TOP      3328
#define XB_TOPGEN   3392
#define XCD_BAR_WORDS 3456
#define XB_SPIN_CAP (1u << 18)
__device__ __forceinline__ unsigned xb_ld(unsigned* p)              { return __hip_atomic_load(p, __ATOMIC_RELAXED, __HIP_MEMORY_SCOPE_AGENT); }
__device__ __forceinline__ unsigned xb_add(unsigned* p, unsigned v) { return __hip_atomic_fetch_add(p, v, __ATOMIC_RELAXED, __HIP_MEMORY_SCOPE_AGENT); }
__device__ __forceinline__ unsigned xb_xcc_id() { return (unsigned)__builtin_amdgcn_s_getreg((3 << 11) | 20) & 0xFu; }
#define XB_SPIN(cond, bar) do { unsigned _sp = 0; while (cond) { __builtin_amdgcn_s_sleep(1); \
    if ((++_sp & 255u) == 0u) { if (xb_ld(&(bar)[XB_TMO])) break; if (_sp > XB_SPIN_CAP) { atomicAdd(&(bar)[XB_TMO], 1u); break; } } } } while (0)
struct XcdBarrier { unsigned* bar; unsigned x; volatile LAS unsigned* st; };
__device__ __forceinline__ XcdBarrier xcd_barrier_post(unsigned* bar, volatile LAS unsigned* st) {
    XcdBarrier b; b.bar = bar; b.x = xb_xcc_id(); b.st = st;
    if (threadIdx.x == 0) (void)xb_add(&bar[XB_XCNT(b.x)], 1u);
    return b;
}
__device__ __forceinline__ void xcd_barrier_complete(unsigned* bar, unsigned x, unsigned& nloc, unsigned& nx) {
    const unsigned G = gridDim.x * gridDim.y * gridDim.z;
    unsigned sum, cnt, mine, sp = 0u;
    for (;;) {
        sum = 0u; cnt = 0u; mine = 0u;
#pragma unroll
        for (unsigned j = 0; j < 16; ++j) { const unsigned c = xb_ld(&bar[XB_XCNT(j)]); sum += c; cnt += (c > 0u) ? 1u : 0u; mine = (j == x) ? c : mine; }
        if (sum == G) break;
        __builtin_amdgcn_s_sleep(1);
        if ((++sp & 255u) == 0u) { if (xb_ld(&bar[XB_TMO])) break; if (sp > XB_SPIN_CAP) { atomicAdd(&bar[XB_TMO], 1u); break; } }
    }
    nloc = mine > 0u ? mine : 1u; nx = cnt > 0u ? cnt : 1u;
}
__device__ __forceinline__ void xcd_barrier(const XcdBarrier& b) {
    asm volatile("s_waitcnt vmcnt(0)" ::: "memory");
    __syncthreads();
    if (threadIdx.x == 0) {
        unsigned* bar = b.bar;
        __builtin_amdgcn_s_waitcnt(0);
        unsigned nloc = b.st[0], nx = b.st[1];
        if (nloc == 0u) { xcd_barrier_complete(bar, b.x, nloc, nx); b.st[0] = nloc; b.st[1] = nx; }
        const unsigned old = xb_add(&bar[XB_XSUB(b.x)], 1u);
        const unsigned gen = old / nloc;
        if (old + 1u == (gen + 1u) * nloc) {
            __builtin_amdgcn_fence(__ATOMIC_RELEASE, "agent");
            asm volatile("s_waitcnt vmcnt(0)" ::: "memory");
            const unsigned og = xb_add(&bar[XB_TOP], 1u);
            const unsigned tg = og / nx;
            if (og + 1u == (tg + 1u) * nx) xb_add(&bar[XB_TOPGEN], 1u);
            else XB_SPIN(xb_ld(&bar[XB_TOPGEN]) == tg, bar);
            __builtin_amdgcn_fence(__ATOMIC_ACQUIRE, "agent");
            xb_add(&bar[XB_XGEN(b.x)], 1u);
            asm volatile("s_waitcnt vmcnt(0)" ::: "memory");
        } else {
            XB_SPIN(xb_ld(&bar[XB_XGEN(b.x)]) == gen, bar);
            __builtin_amdgcn_fence(__ATOMIC_ACQUIRE, "agent");
            asm volatile("s_waitcnt vmcnt(0)" ::: "memory");
        }
    }
    __syncthreads();
}

#ifndef DUPM
#define DUPM 0
#endif
#ifndef SYNCREP
#define SYNCREP 1
#endif
#define GSYNC() do { _Pragma("unroll 1") for (int sr_ = 0; sr_ < SYNCREP; ++sr_) xcd_barrier(xbar); } while (0)
#define PH(k) _Pragma("unroll 1") for (int rep_ = 0; rep_ < (((DUPM) >> (k)) & 1) + 1; ++rep_)
__global__ void __launch_bounds__(NTHREADS, 2) mega_fwd(KArgs a) {
    extern __shared__ __attribute__((aligned(16))) unsigned char lds_raw[];
    LAS unsigned char* lds = (LAS unsigned char*)lds_raw;
    cg::grid_group grid = cg::this_grid();
    const int G = gridDim.x, bx = blockIdx.x;
    const int vcu = (G % 8 == 0) ? (bx % 8) * (G / 8) + bx / 8 : bx;
    unsigned char* ws = a.ws;
    if (ws == nullptr) grid.sync();
    volatile LAS unsigned* xst = (volatile LAS unsigned*)(lds + LDS_BYTES - 64);
    if (threadIdx.x < 16) xst[threadIdx.x] = 0u;
    __syncthreads();
    const XcdBarrier xbar = xcd_barrier_post((unsigned*)(ws + 16384), xst);
    bf16_t* R1 = (bf16_t*)(ws + WS_R1); bf16_t* R2 = (bf16_t*)(ws + WS_R2 + 4096);
    bf16_t* BIGB = (bf16_t*)(ws + WS_BIG);
    const bf16_t* pbf = (const bf16_t*)(ws + WS_PBF);

#ifndef NPASS
#define NPASS 1
#endif
#pragma unroll 1
    for (int pass_ = 0; pass_ < NPASS; ++pass_) {
    if (pass_ > 0) GSYNC();
    PH(0) p0_prologue(a, lds, vcu, G);
    GSYNC();
    PH(1) {
        pg8::Gemm g{R1, (const bf16_t*)(ws + WS_WIN0), 1024, 1024, 1024, 256, 0, 0};
        pg8::StaticOrder S; S.init(64, 10, G, bx);
        EpiProj E{BIGB, (float*)(ws + WS_BIG + BIG_LA), (const float*)(ws + WS_SSQ), a.in[I_BALPHA]};
        pg8::gemm_phase(lds, g, S, E);
        s_proj_units(a, lds, (bx - (640 % G) + G) % G, G);
        if (bx >= (640 % G)) { const int wv = __builtin_amdgcn_readfirstlane(otid() >> 6); __syncthreads(); p3_convert(a, lds, (bx - (640 % G)) * 8 + wv, (G - (640 % G)) * 8, 0, CONV_SPLIT, false); }
    }
    GSYNC();
    PH(2) for (int it = vcu; it < 256; it += G) gla_item_m<false>(a, lds, it);
    PH(3) for (int it = vcu; it < 512; it += G) swa_unit_m(a, lds, it);
    PH(4) { const int tid = otid(), lane = tid & 63, wave = __builtin_amdgcn_readfirstlane(tid >> 6); for (int it = vcu * 8 + wave; it < 512; it += G * 8) gla_decode_item(a, it, lane); }
    PH(5) { const int tid = otid(), lane = tid & 63, wave = __builtin_amdgcn_readfirstlane(tid >> 6); for (int it = vcu * 8 + wave; it < 1024; it += G * 8) swa_decode_item(a, it, lane); }
    GSYNC();
    PH(6) { gla_scan_m(a, vcu); const int wv = __builtin_amdgcn_readfirstlane(otid() >> 6); if (wv >= 2) p3_convert(a, lds, vcu * 6 + (wv - 2), G * 6, CONV_SPLIT, CONV_ITEMS, true); }
    GSYNC();
    PH(7) for (int it = vcu; it < 256; it += G) gla_item_m<true>(a, lds, it);
    GSYNC();
    PH(8) {
        pg8::Gemm g{R1, (const bf16_t*)(ws + WS_WOUT0), 1024, 1024, 1024, 256, 0, 0};
        pg8::StaticOrder S; S.init(64, 4, G, bx);
        EpiRes<0, true, true, false> E{a.out, a.in[I_XP], nullptr, R2, part_tab(ws, 0), nullptr, nullptr, nullptr};
        pg8::gemm_phase(lds, g, S, E);
        s_res_units<0, 1024, 1024>(a, lds, bx, G, R1, (const bf16_t*)(ws + WS_WOUT0), nullptr, R2, part_tab(ws, 0));
    }
#if defined(PROBE_FFNK)
    {
        pg8::Gemm g{R2, (const bf16_t*)(ws + WS_WFFI), 1024, 1024, 1024, 254, -2, 0};
        pg8::StaticOrder S; S.init(65, 22, G, bx);
#if PROBE_FFNK == 1
        EpiNull E{};
#elif PROBE_FFNK == 2
        EpiStoreOnly<0> E{R1};
#else
        EpiStoreOnly<1> E{R1};
#endif
        pg8::gemm_phase(lds, g, S, E);
    }
#endif
#if defined(PROBE_KLOOP)
    {
        pg8::Gemm g{R1, (const bf16_t*)(ws + WS_WOUT0), 1024, 1024, 1024, 256, 0, 0};
        pg8::StaticOrder S; S.init(64, 4, G, bx);
#if PROBE_KVAR == 1
        EpiStoreOnly<0> E{R1};
#elif PROBE_KVAR == 2
        EpiRes<1, true, false, false> E{a.out, nullptr, R2, R1, nullptr, nullptr, nullptr, nullptr};
#else
        EpiNull E{};
#endif
        for (int rep = 0; rep < PROBE_KLOOP; ++rep) pg8::gemm_phase(lds, g, S, E);
    }
#endif
#if defined(PROBE_SMALL)
    for (int rep = 0; rep < PROBE_SMALL; ++rep) s_res_units<0, 1024, 1024>(a, lds, bx, G, R1, (const bf16_t*)(ws + WS_WOUT0), nullptr, (bf16_t*)(ws + WS_BIG), part_tab(ws, 5));
#endif
    GSYNC();
#pragma unroll 1
    for (int l = 0; l < 2; ++l) {
        bf16_t* G_ = BIGB;
        bf16_t* PPb = BIGB;
        PH(9) {
            pg8::Gemm g{R2, (const bf16_t*)(ws + WS_WFFI + l * WFFI_BYTES), 1024, 1024, 1024, 254, -2, 0};
            pg8::StaticOrder S; S.init(65, 22, G, bx);
            EpiFfn E{part_tab(ws, l == 0 ? 0 : 3), a.in[I_FCW] + (size_t)l * 3 * DFF, a.in[I_FCB] + (size_t)l * DFF, a.out + O_CONVP + (size_t)l * 2 * DFF, G_};
            pg8::gemm_phase(lds, g, S, E);
            s_ffn_units(a, lds, (bx - (1430 % G) + G) % G, G, l, R2, part_tab(ws, l == 0 ? 0 : 3));
        }
        GSYNC();
        PH(10) {
            pg8::Gemm g{G_, (const bf16_t*)(ws + WS_WFFO + l * WFFO_BYTES), DFF, DFF, DFF, 256, 0, 0};
            pg8::StaticOrder S; S.init(64, 4, G, bx);
            EpiRes<1, true, true, false> E{a.out, nullptr, R2, R1, part_tab(ws, l == 0 ? 1 : 4), nullptr, nullptr, nullptr};
            pg8::gemm_phase(lds, g, S, E);
            s_res_units<1, DFF, DFF>(a, lds, bx, G, G_, (const bf16_t*)(ws + WS_WFFO + l * WFFO_BYTES), R2, R1, part_tab(ws, l == 0 ? 1 : 4));
        }
        GSYNC();
        PH(11) {
            pg8::Gemm g{pbf + (size_t)l * MT * PLE, (const bf16_t*)(ws + WS_WPROJ + l * WPROJ_BYTES), PLE, PLE, PLE, 256, 0, 0};
            pg8::StaticOrder S; S.init(64, 4, G, bx);
            EpiPP E{PPb};
            pg8::gemm_phase(lds, g, S, E);
        }
        PH(12) {
            pg8::Gemm g{R1, (const bf16_t*)(ws + WS_WGATE + l * WGATE_BYTES), 1024, 1024, 1024, 256, 0, 0};
            pg8::StaticOrder S; S.init(64, 4, G, bx);
            if (l == 0) { EpiRes<2, true, true, false> E{a.out, nullptr, R1, R2, part_tab(ws, 2), part_tab(ws, 1), PPb, nullptr}; pg8::gemm_phase(lds, g, S, E);
                s_ple_units<false>(a, lds, bx, G, pbf, (const bf16_t*)(ws + WS_WPROJ), R1, (const bf16_t*)(ws + WS_WGATE), part_tab(ws, 1), part_tab(ws, 2), R2); }
            else { EpiRes<2, false, false, true> E{a.out, nullptr, R1, nullptr, nullptr, part_tab(ws, 4), PPb, nullptr}; pg8::gemm_phase(lds, g, S, E);
                s_ple_units<true>(a, lds, bx, G, pbf + (size_t)MT * PLE, (const bf16_t*)(ws + WS_WPROJ + WPROJ_BYTES), R1, (const bf16_t*)(ws + WS_WGATE + WGATE_BYTES), part_tab(ws, 4), nullptr, nullptr); }
        }
        if (l == 0) {
            GSYNC();
            PH(13) for (int it = vcu; it < 1024 + NS; it += G) { if (it < 1024) pool_item(a, lds, it, part_tab(ws, 2)); else pool_sample_item(a, lds, it - 1024, part_tab(ws, 2)); }
            GSYNC();
            PH(14) {
                pg8::Gemm g{R1, (const bf16_t*)(ws + WS_WPOOL), 1024, 256, 256, 256, 0, 256};
                pg8::StaticOrder S; S.init(64, 4, G, bx);
                EpiRes<3, true, true, false> E{a.out, nullptr, R2, R2, part_tab(ws, 3), nullptr, nullptr, a.in[I_POOLSC]};
                pg8::gemm_phase(lds, g, S, E);
                s_res_units<3, 256, 1024>(a, lds, bx, G, R1, (const bf16_t*)(ws + WS_WPOOL), R2, R2, part_tab(ws, 3));
            }
            GSYNC();
        }
    }
    }
}

extern "C" void kernel_launch(void* const* d_in, const int* in_sizes, int n_in, void* d_out, int out_size, void* d_ws, size_t ws_size, hipStream_t stream) {
    static int grid = 0;
    if (grid == 0) {
        int dev = 0, cus = 0, per_cu = 0;
        hipGetDevice(&dev);
        hipDeviceGetAttribute(&cus, hipDeviceAttributeMultiprocessorCount, dev);
        hipFuncSetAttribute((const void*)mega_fwd, hipFuncAttributeMaxDynamicSharedMemorySize, LDS_BYTES);
        hipOccupancyMaxActiveBlocksPerMultiprocessor(&per_cu, (const void*)mega_fwd, NTHREADS, LDS_BYTES);
        if (per_cu < 1) { fprintf(stderr, "kernel_launch: occupancy query reports %d blocks per CU\n", per_cu); per_cu = 1; }
        if (per_cu > 1) per_cu = 1;
        grid = cus * per_cu;
        (void)hipGetLastError();
    }
    (void)hipMemsetAsync(d_ws, 0, 65536, stream);
    KArgs a{};
    for (int i = 0; i < 29; ++i) a.in[i] = (const float*)d_in[i];
    a.out = (float*)d_out; a.ws = (unsigned char*)d_ws;
    void* args[] = {&a};
    hipError_t e = hipLaunchCooperativeKernel((const void*)mega_fwd, dim3(grid), dim3(NTHREADS), args, LDS_BYTES, stream);
#if defined(PROBE_TWICE)
    (void)hipMemsetAsync(d_ws, 0, 65536, stream);
    e = hipLaunchCooperativeKernel((const void*)mega_fwd, dim3(grid), dim3(NTHREADS), args, LDS_BYTES, stream);
#endif
    if (e != hipSuccess) fprintf(stderr, "cooperative launch failed: %s (grid %d)\n", hipGetErrorString(e), grid);
}
```

```cpp
#include <hip/hip_runtime.h>
#include <hip/hip_cooperative_groups.h>
#include <cstdio>
#include <cstdint>
namespace cg = cooperative_groups;

#define LAS __attribute__((address_space(3)))
typedef unsigned short bf16_t;
typedef short bf16x8 __attribute__((ext_vector_type(8)));
typedef float f32x4 __attribute__((ext_vector_type(4)));
typedef float f32x2 __attribute__((ext_vector_type(2)));
typedef unsigned u32x4 __attribute__((ext_vector_type(4)));
typedef unsigned u32x2 __attribute__((ext_vector_type(2)));
typedef float f32x16 __attribute__((ext_vector_type(16)));

constexpr int D = 1024, SEQ = 16384, NS = 128, DFF = 2816, PLE = 256;
constexpr int SROW = 16510;
constexpr int MT = 16640;
constexpr int MR = 16768;
constexpr int NPROJ = 2304;
constexpr int PQA = 0, PKA = 256, PVA = 512, PRA = 1024, PQB = 1536, PKB = 2048, PVB = 2176;
constexpr float EPS = 1e-6f;
constexpr int NTHREADS = 512;

constexpr size_t O_YP = 0, O_YS = 16777216, O_GLAP = 16908288, O_SKP = 16941056, O_SVP = 16957440, O_POOLP = 16973824, O_CONVP = 16989184,
                 O_GLAS = 17000448, O_SKS = 21194752, O_SVS = 23291904, O_POOLS = 25389056, O_CONVS = 27355136;

constexpr size_t MiB = 1u << 20;
constexpr size_t WS_WIN0 = 1 * MiB, WS_WOUT0 = 6 * MiB, WS_WFFI = 8 * MiB, WS_WFFO = 30 * MiB, WS_WGATE = 41 * MiB, WS_WPROJ = 45 * MiB, WS_WPOOL = 46 * MiB;
constexpr size_t WS_SSQ = 47 * MiB;
constexpr size_t WS_PBF = 55 * MiB, WS_R1 = 72 * MiB, WS_R2 = 105 * MiB, WS_BIG = 138 * MiB;
constexpr size_t PART_STRIDE = (size_t)(MR + 8) * 16 * 4;
constexpr size_t WFFI_BYTES = (size_t)5632 * 1024 * 2, WFFO_BYTES = (size_t)1024 * 2816 * 2, WGATE_BYTES = (size_t)1024 * 1024 * 2, WPROJ_BYTES = (size_t)1024 * 256 * 2;
constexpr size_t BIG_LA = (size_t)MT * NPROJ * 2;
constexpr int LDS_BYTES = 155648;

#ifndef NT_STORES
#define NT_STORES 0
#endif
typedef unsigned u32x4_fwd __attribute__((ext_vector_type(4)));
#if NT_STORES == 2
__device__ __forceinline__ void st16_sc1(void* p, u32x4_fwd v);
#define ST16(p, v) st16_sc1((void*)(p), (v))
#elif NT_STORES
#define ST16(p, v) __builtin_nontemporal_store((v), (p))
#else
#define ST16(p, v) (*(p) = (v))
#endif
#if NT_STORES == 2
__device__ __forceinline__ void st16_sc1(void* p, u32x4_fwd v) { asm volatile("global_store_dwordx4 %0, %1, off sc1\n\ts_nop 1" :: "v"(p), "v"(v) : "memory"); }
#endif
__device__ __forceinline__ unsigned cvt_pk_bf16(float lo, float hi) { unsigned r; asm volatile("v_cvt_pk_bf16_f32 %0, %1, %2" : "=v"(r) : "v"(lo), "v"(hi)); return r; }
__device__ __forceinline__ float bf_lo(unsigned w) { return __uint_as_float(w << 16); }
__device__ __forceinline__ float bf_hi(unsigned w) { return __uint_as_float(w & 0xffff0000u); }
__device__ __forceinline__ float bf2f(bf16_t v) { return __uint_as_float(((unsigned)v) << 16); }
__device__ __forceinline__ void unpack8(const u32x4 w, float* f) { f[0] = bf_lo(w.x); f[1] = bf_hi(w.x); f[2] = bf_lo(w.y); f[3] = bf_hi(w.y); f[4] = bf_lo(w.z); f[5] = bf_hi(w.z); f[6] = bf_lo(w.w); f[7] = bf_hi(w.w); }
__device__ __forceinline__ float wave_sum(float v) {
#pragma unroll
    for (int o = 1; o < 64; o <<= 1) v += __shfl_xor(v, o);
    return v;
}
__device__ __forceinline__ float wave_max(float v) {
#pragma unroll
    for (int o = 1; o < 64; o <<= 1) v = fmaxf(v, __shfl_xor(v, o));
    return v;
}
__device__ __forceinline__ int otid() { int t = threadIdx.x; asm volatile("" : "+v"(t)); return t; }
__device__ __forceinline__ bool row_valid(int row) { return row < SEQ || (row >= SROW && row < SROW + NS); }
__device__ __forceinline__ float* hrow_ptr(float* out, int row) { return row < SEQ ? out + O_YP + (size_t)row * D : out + O_YS + (size_t)(row - SROW) * D; }
__device__ __forceinline__ f32x2 gelu_pk(f32x2 v) {
    const f32x2 av = __builtin_elementwise_abs(v), d = av * 0.2316418882f + 1.0f;
    f32x2 t; t.x = __builtin_amdgcn_rcpf(d.x); t.y = __builtin_amdgcn_rcpf(d.y);
    f32x2 q = t * 0.5307027145f + (-0.7265760135f); q = q * t + 0.7107068705f; q = q * t + (-0.142248368f); q = q * t + 0.127414796f; q = q * t;
    const f32x2 s = (v * v) * (-0.72134752044f);
    f32x2 e; e.x = __builtin_amdgcn_exp2f(s.x); e.y = __builtin_amdgcn_exp2f(s.y);
    const f32x2 m = v * (q * e), r = v - m;
    f32x2 o; o.x = v.x < 0.f ? m.x : r.x; o.y = v.y < 0.f ? m.y : r.y; return o;
}

namespace pg8 {
constexpr int BM = 256, BK = 64, HALF = 128, HTB = HALF * BK * 2, STAGE_BYTES = 8 * HTB, NXCD = 8, WGM = 8;
__host__ __device__ __forceinline__ int lds_byte(int r, int c) { const int st = (r >> 4) * 2 + (c >> 5), rr = r & 15, cc = c & 31, ob = rr * 64 + cc * 2; return st * 1024 + (ob ^ (((ob >> 9) & 1) << 5)); }
__host__ __device__ __forceinline__ void stage_rc(int b, int& R, int& C) { const int st = b / 1024, sb = b % 1024, swz = sb ^ (((sb >> 9) & 1) << 5); R = (st >> 1) * 16 + swz / 64; C = (st & 1) * 32 + (swz % 64) / 2; }
__host__ __device__ __forceinline__ int perm32(int rho) { const int n = rho >> 4, i = rho & 15; return 8 * (i >> 2) + 4 * n + (i & 3); }

struct Unit { int pm, pn; };
struct Gemm { const bf16_t* A; const bf16_t* Bt; int lda, ldb, K, mstride, arow0, acolstep; };

struct StaticOrder {
    int nM, nN, nwg, G, c;
    __device__ void init(int nM_, int nN_, int G_, int c_) { nM = nM_; nN = nN_; nwg = nM * nN; G = G_; c = c_; }
    __device__ bool next(int i, Unit& u) const {
        const long L = (long)i * G + c; if (L >= nwg) return false;
        int wgid = (int)L; { const int q = nwg / NXCD, r = nwg % NXCD, xcd = wgid % NXCD, off = wgid / NXCD; wgid = (xcd < r ? xcd * (q + 1) : r * (q + 1) + (xcd - r) * q) + off; }
        const int nig = WGM * nN, gid = wgid / nig, fm = gid * WGM, gsz = (nM - fm) < WGM ? (nM - fm) : WGM;
        u.pm = fm + ((wgid % nig) % gsz); u.pn = (wgid % nig) / gsz; return true;
    }
};

template <class Epi>
__device__ __forceinline__ void gemm_phase(LAS unsigned char* lds, const Gemm g, const StaticOrder& S, const Epi& E) {
    const int tid = otid(), wid = __builtin_amdgcn_readfirstlane(tid >> 6), lane = tid & 63, wr = wid >> 2, wc = wid & 3, fr = lane & 15, fq = lane >> 4;
    const int K = g.K, nt = K / BK;
    unsigned voffA[2], voffB[2];
#pragma unroll
    for (int i = 0; i < 2; ++i) { int R, C; stage_rc(tid * 16 + i * 8192, R, C); const int Rb = (R & ~31) + perm32(R & 31);
        voffA[i] = (unsigned)(R * g.lda + C) * 2u; voffB[i] = (unsigned)(Rb * g.ldb + C) * 2u; }
    const size_t kstep = (size_t)(BK * 2);
    const size_t hstepA = (size_t)HALF * g.lda * 2, hstepB = (size_t)HALF * g.ldb * 2;
    const unsigned ldsw = (unsigned)wid * 1024u;
    const int aoff = lds_byte(wr * 64 + fr, fq * 8), boff = lds_byte(wc * 32 + fr, fq * 8);
#define PG8_SA(b, h) (((b) * 2 + (h)) * HTB)
#define PG8_SB(b, h) ((4 + (b) * 2 + (h)) * HTB)
#define PG8_STAGE(bufoff, gbase, voff) do { _Pragma("unroll") for (int _i = 0; _i < 2; ++_i) \
        __builtin_amdgcn_global_load_lds((const unsigned*)((const char*)(gbase) + (voff)[_i]), (LAS unsigned*)(lds + (bufoff) + ldsw + _i * 8192), 16, 0, 0); } while (0)
#define PG8_LDA(dst, b, h) do { _Pragma("unroll") for (int m = 0; m < 4; ++m) _Pragma("unroll") for (int k = 0; k < 2; ++k) dst[m][k] = *(const LAS bf16x8*)(lds + PG8_SA(b, h) + aoff + m * 2048 + k * 1024); } while (0)
#define PG8_LDB(dst, b, h) do { _Pragma("unroll") for (int n = 0; n < 2; ++n) _Pragma("unroll") for (int k = 0; k < 2; ++k) dst[n][k] = *(const LAS bf16x8*)(lds + PG8_SB(b, h) + boff + n * 2048 + k * 1024); } while (0)
#define PG8_MMA(ai, bj, At, Bt) do { __builtin_amdgcn_s_setprio(1); _Pragma("unroll") for (int m = 0; m < 4; ++m) _Pragma("unroll") for (int n = 0; n < 2; ++n) _Pragma("unroll") for (int k = 0; k < 2; ++k) \
        acc[ai][bj][m][n] = __builtin_amdgcn_mfma_f32_16x16x32_bf16(Bt[n][k], At[m][k], acc[ai][bj][m][n], 0, 0, 0); __builtin_amdgcn_s_setprio(0); } while (0)
#define PG8_WAIT_V(n) asm volatile("s_waitcnt vmcnt(" #n ")" ::: "memory")
#define PG8_WAIT_L(n) asm volatile("s_waitcnt lgkmcnt(" #n ")" ::: "memory")
#define PG8_BAR __builtin_amdgcn_s_barrier()
#define PG8_SCHED __builtin_amdgcn_sched_barrier(0)
#define PG8_ABASE(u) ((const char*)g.A + ((long)((long)(u).pm * g.mstride + g.arow0) * g.lda + (long)(u).pn * g.acolstep) * 2)
#define PG8_BBASE(u) ((const char*)g.Bt + (size_t)(u).pn * 256 * g.ldb * 2)
    Unit cur, nxt; int ui = 0;
    if (!S.next(0, cur)) return;
    f32x4 acc[2][2][4][2];
#pragma unroll
    for (int a = 0; a < 2; ++a)
#pragma unroll
        for (int b = 0; b < 2; ++b)
#pragma unroll
            for (int m = 0; m < 4; ++m)
#pragma unroll
                for (int n = 0; n < 2; ++n) acc[a][b][m][n] = (f32x4){0.f, 0.f, 0.f, 0.f};
    bf16x8 At[4][2], B0[2][2], B1[2][2];
    const char* cA = PG8_ABASE(cur); const char* cB = PG8_BBASE(cur);
    PG8_STAGE(PG8_SB(0, 0), cB, voffB); PG8_STAGE(PG8_SB(0, 1), cB + hstepB, voffB); PG8_STAGE(PG8_SA(0, 0), cA, voffA); PG8_STAGE(PG8_SA(0, 1), cA + hstepA, voffA);
    if (wr == 1) PG8_BAR;
    PG8_WAIT_V(2); PG8_BAR;
    PG8_STAGE(PG8_SB(1, 0), cB + kstep, voffB); PG8_STAGE(PG8_SA(1, 0), cA + kstep, voffA); PG8_STAGE(PG8_SB(1, 1), cB + hstepB + kstep, voffB);
    PG8_WAIT_V(6); PG8_BAR;
    for (;;) {
        const bool has_next = S.next(ui + 1, nxt);
        const char* nA = has_next ? PG8_ABASE(nxt) : cA; const char* nB = has_next ? PG8_BBASE(nxt) : cB;
#pragma unroll 1
        for (int t = 0; t < nt; t += 2) {
            const bool last = (t == nt - 2);
            const char* a1 = cA + (size_t)(t + 1) * kstep;
            const char* a2 = last ? nA : cA + (size_t)(t + 2) * kstep; const char* b2 = last ? nB : cB + (size_t)(t + 2) * kstep;
            const char* a3 = a2 + kstep; const char* b3 = b2 + kstep;
            PG8_LDB(B0, 0, 0); PG8_LDB(B1, 0, 1); PG8_SCHED; PG8_LDA(At, 0, 0); PG8_STAGE(PG8_SA(1, 1), a1 + hstepA, voffA);
            PG8_WAIT_V(8); PG8_WAIT_L(0); PG8_BAR; PG8_MMA(0, 0, At, B0); PG8_MMA(0, 1, At, B1); PG8_BAR; PG8_SCHED;
            PG8_LDA(At, 0, 1); PG8_STAGE(PG8_SB(0, 0), b2, voffB); PG8_STAGE(PG8_SB(0, 1), b2 + hstepB, voffB); PG8_STAGE(PG8_SA(0, 0), a2, voffA);
            PG8_WAIT_V(8); PG8_WAIT_L(0); PG8_BAR; PG8_MMA(1, 0, At, B0); PG8_MMA(1, 1, At, B1); PG8_BAR; PG8_SCHED;
            PG8_LDB(B0, 1, 0); PG8_LDB(B1, 1, 1); PG8_SCHED; PG8_LDA(At, 1, 0); PG8_STAGE(PG8_SA(0, 1), a2 + hstepA, voffA);
            PG8_WAIT_V(8); PG8_WAIT_L(0); PG8_BAR; PG8_MMA(0, 0, At, B0); PG8_MMA(0, 1, At, B1); PG8_BAR; PG8_SCHED;
            PG8_LDA(At, 1, 1); PG8_STAGE(PG8_SB(1, 0), b3, voffB); PG8_STAGE(PG8_SB(1, 1), b3 + hstepB, voffB); PG8_STAGE(PG8_SA(1, 0), a3, voffA);
            PG8_WAIT_V(8); PG8_WAIT_L(0); PG8_BAR; PG8_MMA(1, 0, At, B0); PG8_MMA(1, 1, At, B1); PG8_BAR; PG8_SCHED;
        }
        if (wr == 0) PG8_BAR;
        { int lane2 = lane; asm volatile("" : "+v"(lane2)); E(acc, cur, wr, wc, lane2 & 15, lane2 >> 4, lds + STAGE_BYTES); }
        if (!has_next) break;
#pragma unroll
        for (int a = 0; a < 2; ++a)
#pragma unroll
            for (int b = 0; b < 2; ++b)
#pragma unroll
                for (int m = 0; m < 4; ++m)
#pragma unroll
                    for (int n = 0; n < 2; ++n) acc[a][b][m][n] = (f32x4){0.f, 0.f, 0.f, 0.f};
        cur = nxt; cA = nA; cB = nB; ++ui;
        if (wr == 1) PG8_BAR;
    }
    PG8_WAIT_V(0);
    PG8_BAR;
#undef PG8_SA
#undef PG8_SB
#undef PG8_STAGE
#undef PG8_LDA
#undef PG8_LDB
#undef PG8_MMA
#undef PG8_WAIT_V
#undef PG8_WAIT_L
#undef PG8_BAR
#undef PG8_SCHED
#undef PG8_ABASE
#undef PG8_BBASE
}
}
using pg8::Unit;
typedef f32x4 AccT[2][2][4][2];

__device__ __forceinline__ float row_rs(const float* part, int row, int fq) {
    const f32x4 p = *(const f32x4*)(part + (long)row * 16 + fq * 4);
    float s = (p[0] + p[1]) + (p[2] + p[3]);
    s += __shfl_xor(s, 16); s += __shfl_xor(s, 32);
    return rsqrtf(s * (1.0f / D) + EPS);
}

struct EpiProj {
    bf16_t* proj; float* la; const float* ssq0; const float* b_alpha;
    __device__ __forceinline__ void operator()(const AccT& acc, const Unit& u, int wr, int wc, int fr, int fq, LAS unsigned char*) const {
        float rsv[2][4];
#pragma unroll
        for (int ai = 0; ai < 2; ++ai)
#pragma unroll
            for (int m = 0; m < 4; ++m) rsv[ai][m] = ssq0[u.pm * 256 + ai * 128 + wr * 64 + m * 16 + fr];
        f32x4 bb[2][2];
        if (u.pn >= 9) {
#pragma unroll
            for (int bj = 0; bj < 2; ++bj) { const int c = bj * 128 + wc * 32 + fq * 8; bb[bj][0] = *(const f32x4*)(b_alpha + c); bb[bj][1] = *(const f32x4*)(b_alpha + c + 4); }
        }
#pragma unroll
        for (int ai = 0; ai < 2; ++ai)
#pragma unroll
            for (int m = 0; m < 4; ++m) {
                const int row = u.pm * 256 + ai * 128 + wr * 64 + m * 16 + fr;
                const float rs = rsqrtf(rsv[ai][m] * (1.0f / D) + EPS);
#pragma unroll
                for (int bj = 0; bj < 2; ++bj) {
                    const int col = u.pn * 256 + bj * 128 + wc * 32 + fq * 8;
                    const f32x4 v0 = acc[ai][bj][m][0] * rs, v1 = acc[ai][bj][m][1] * rs;
                    if (u.pn < 9) {
                        u32x4 w; w.x = cvt_pk_bf16(v0[0], v0[1]); w.y = cvt_pk_bf16(v0[2], v0[3]); w.z = cvt_pk_bf16(v1[0], v1[1]); w.w = cvt_pk_bf16(v1[2], v1[3]);
                        ST16((u32x4*)(proj + (size_t)row * NPROJ + col), w);
                    } else {
                        const int c = col - NPROJ;
                        f32x4 o0, o1;
#pragma unroll
                        for (int j = 0; j < 4; ++j) {
                            const float z0 = v0[j] + bb[bj][0][j], z1 = v1[j] + bb[bj][1][j];
                            o0[j] = (fminf(z0, 0.f) - __logf(1.0f + __expf(-fabsf(z0)))) * 0.0625f;
                            o1[j] = (fminf(z1, 0.f) - __logf(1.0f + __expf(-fabsf(z1)))) * 0.0625f;
                        }
                        *(f32x4*)(la + (size_t)row * 256 + c) = o0; *(f32x4*)(la + (size_t)row * 256 + c + 4) = o1;
                    }
                }
            }
    }
};
struct EpiPP {
    bf16_t* pp;
    __device__ __forceinline__ void operator()(const AccT& acc, const Unit& u, int wr, int wc, int fr, int fq, LAS unsigned char*) const {
#pragma unroll
        for (int ai = 0; ai < 2; ++ai)
#pragma unroll
            for (int m = 0; m < 4; ++m) {
                const int row = u.pm * 256 + ai * 128 + wr * 64 + m * 16 + fr;
#pragma unroll
                for (int bj = 0; bj < 2; ++bj) {
                    const int col = u.pn * 256 + bj * 128 + wc * 32 + fq * 8;
                    const f32x4 v0 = acc[ai][bj][m][0], v1 = acc[ai][bj][m][1];
                    u32x4 w; w.x = cvt_pk_bf16(v0[0], v0[1]); w.y = cvt_pk_bf16(v0[2], v0[3]); w.z = cvt_pk_bf16(v1[0], v1[1]); w.w = cvt_pk_bf16(v1[2], v1[3]);
                    ST16((u32x4*)(pp + (size_t)row * D + col), w);
                }
            }
    }
};
template <int MODE, bool WRITE_HB, bool WRITE_PART, bool WRITE_F32>
struct EpiRes {
    float* out; const float* xp; const bf16_t* hbin; bf16_t* hb; float* part; const float* part_in; const bf16_t* pp; const float* scale;
    struct Q { f32x4 xb[2][2][2]; u32x4 hw[2][2]; u32x4 pw[2][2]; f32x4 pin[2]; };
    __device__ __forceinline__ void fetch(Q& q, const Unit& u, int aq, int wr, int wc, int fr, int fq) const {
        const int ai = aq >> 1, m0 = (aq & 1) * 2;
#pragma unroll
        for (int mm = 0; mm < 2; ++mm) {
            const int row = u.pm * 256 + ai * 128 + wr * 64 + (m0 + mm) * 16 + fr;
            if (MODE == 2) q.pin[mm] = *(const f32x4*)(part_in + (long)row * 16 + fq * 4);
#pragma unroll
            for (int bj = 0; bj < 2; ++bj) {
                const int col = u.pn * 256 + bj * 128 + wc * 32 + fq * 8;
                if (MODE == 0) { q.xb[mm][bj][0] = *(const f32x4*)(xp + (size_t)row * D + col); q.xb[mm][bj][1] = *(const f32x4*)(xp + (size_t)row * D + col + 4); }
                else q.hw[mm][bj] = *(const u32x4*)(hbin + (size_t)row * D + col);
                if (MODE == 2) q.pw[mm][bj] = *(const u32x4*)(pp + (size_t)row * D + col);
            }
        }
    }
    __device__ __forceinline__ void operator()(const AccT& acc, const Unit& u, int wr, int wc, int fr, int fq, LAS unsigned char*) const {
        f32x4 sc[2][2];
        if (MODE == 3) {
#pragma unroll
            for (int bj = 0; bj < 2; ++bj) { const int col = u.pn * 256 + bj * 128 + wc * 32 + fq * 8; sc[bj][0] = *(const f32x4*)(scale + col); sc[bj][1] = *(const f32x4*)(scale + col + 4); }
        }
        constexpr bool PIPE = (MODE == 1 || MODE == 3);
        Q qa, qb;
        fetch(qa, u, 0, wr, wc, fr, fq);
#pragma unroll
        for (int aq = 0; aq < 4; ++aq) {
            const int ai = aq >> 1, m0 = (aq & 1) * 2;
            Q& cur = (aq & 1) ? qb : qa; Q& nxt = (aq & 1) ? qa : qb;
            if (PIPE && aq < 3) fetch(nxt, u, aq + 1, wr, wc, fr, fq);
#pragma unroll
            for (int mm = 0; mm < 2; ++mm) {
                const int m = m0 + mm;
                const int row = u.pm * 256 + ai * 128 + wr * 64 + m * 16 + fr;
                float rs = 1.f;
                if (MODE == 2) { float s = (cur.pin[mm][0] + cur.pin[mm][1]) + (cur.pin[mm][2] + cur.pin[mm][3]); s += __shfl_xor(s, 16); s += __shfl_xor(s, 32); rs = rsqrtf(s * (1.0f / D) + EPS); }
                float sq = 0.f;
#pragma unroll
                for (int bj = 0; bj < 2; ++bj) {
                    const int col = u.pn * 256 + bj * 128 + wc * 32 + fq * 8;
                    f32x4 v0 = acc[ai][bj][m][0], v1 = acc[ai][bj][m][1];
                    if (MODE == 2) {
                        float pf[8]; unpack8(cur.pw[mm][bj], pf);
#pragma unroll
                        for (int j = 0; j < 4; ++j) {
                            v0[j] = pf[j] * __builtin_amdgcn_rcpf(1.f + __expf(-v0[j] * rs));
                            v1[j] = pf[4 + j] * __builtin_amdgcn_rcpf(1.f + __expf(-v1[j] * rs));
                        }
                    }
                    if (MODE == 3) { v0 = v0 * sc[bj][0]; v1 = v1 * sc[bj][1]; }
                    f32x4 b0, b1;
                    if (MODE == 0) { b0 = cur.xb[mm][bj][0]; b1 = cur.xb[mm][bj][1]; }
                    else { float bf[8]; unpack8(cur.hw[mm][bj], bf); b0 = (f32x4){bf[0], bf[1], bf[2], bf[3]}; b1 = (f32x4){bf[4], bf[5], bf[6], bf[7]}; }
                    const f32x4 h0 = b0 + v0, h1 = b1 + v1;
                    if (WRITE_F32) { float* hp = out + O_YP + (size_t)row * D; *(f32x4*)(hp + col) = h0; *(f32x4*)(hp + col + 4) = h1; }
                    if (WRITE_HB) { u32x4 w; w.x = cvt_pk_bf16(h0[0], h0[1]); w.y = cvt_pk_bf16(h0[2], h0[3]); w.z = cvt_pk_bf16(h1[0], h1[1]); w.w = cvt_pk_bf16(h1[2], h1[3]);
                        ST16((u32x4*)(hb + (size_t)row * D + col), w); }
                    sq += (h0[0] * h0[0] + h0[1] * h0[1]) + (h0[2] * h0[2] + h0[3] * h0[3]) + (h1[0] * h1[0] + h1[1] * h1[1]) + (h1[2] * h1[2] + h1[3] * h1[3]);
                }
                if (WRITE_PART) {
                    sq += __shfl_xor(sq, 16); sq += __shfl_xor(sq, 32);
                    if (fq == 0) part[(long)row * 16 + u.pn * 4 + wc] = sq;
                }
            }
            if (!PIPE && aq < 3) fetch(nxt, u, aq + 1, wr, wc, fr, fq);
        }
    }
};
struct EpiFfn {
    const float* part_in; const float* convw; const float* convb; float* convp_out; bf16_t* G;
    __device__ __forceinline__ void operator()(AccT& acc, const Unit& u, int wr, int wc, int fr, int fq, LAS unsigned char* ldsx) const {
        const int c0 = u.pn * 128 + wc * 32 + fq * 8;
#pragma unroll
        for (int ai = 0; ai < 2; ++ai)
#pragma unroll
            for (int m = 0; m < 4; ++m) {
                const int grow = u.pm * 254 - 2 + ai * 128 + wr * 64 + m * 16 + fr;
                const float rs = row_rs(part_in, grow, fq);
#pragma unroll
                for (int bj = 0; bj < 2; ++bj)
#pragma unroll
                    for (int n = 0; n < 2; ++n) acc[ai][bj][m][n] = acc[ai][bj][m][n] * rs;
            }
        LAS f32x4* xch = (LAS f32x4*)ldsx;
        if (fr >= 14) {
#pragma unroll
            for (int ai = 0; ai < 2; ++ai) {
                const int slot = ((((ai * 2 + wr) * 4 + wc) * 4 + fq) * 2 + (fr - 14)) * 2;
                xch[slot] = acc[ai][0][3][0]; xch[slot + 1] = acc[ai][0][3][1];
            }
        }
        asm volatile("s_waitcnt lgkmcnt(0)" ::: "memory"); __builtin_amdgcn_s_barrier(); asm volatile("" ::: "memory");
        f32x4 w0[2], w1[2], w2[2], cb[2];
#pragma unroll
        for (int n = 0; n < 2; ++n) { const int cn = c0 + 4 * n;
            w0[n] = *(const f32x4*)(convw + cn); w1[n] = *(const f32x4*)(convw + DFF + cn); w2[n] = *(const f32x4*)(convw + 2 * DFF + cn); cb[n] = *(const f32x4*)(convb + cn); }
#pragma unroll
        for (int ai = 0; ai < 2; ++ai)
#pragma unroll
            for (int m = 0; m < 4; ++m) {
                const int tr = ai * 128 + wr * 64 + m * 16 + fr;
                const int grow = u.pm * 254 - 2 + tr;
                const bool store = (tr >= 2 && grow < SEQ);
                u32x4 w;
#pragma unroll
                for (int n = 0; n < 2; ++n) {
                    const f32x4 x = acc[ai][0][m][n];
                    f32x4 p;
                    if (m == 0) {
                        const int sa = (wr == 1) ? ai : 0, sw = (wr == 1) ? 0 : 1;
                        const bool has = (wr == 1) || (ai == 1);
                        const int slot = ((((sa * 2 + sw) * 4 + wc) * 4 + fq) * 2 + (fr >= 14 ? fr - 14 : 0)) * 2 + n;
                        p = xch[slot];
                        if (!has) p = (f32x4){0.f, 0.f, 0.f, 0.f};
                    } else p = acc[ai][0][m == 0 ? 0 : m - 1][n];
                    f32x4 p1, p2;
#pragma unroll
                    for (int j = 0; j < 4; ++j) {
                        const float xf = x[j], pf = p[j]; const int xi = __float_as_int(xf), pi = __float_as_int(pf);
                        const int r1 = __builtin_amdgcn_mov_dpp(pi, 0x121, 0xf, 0xf, true), r2 = __builtin_amdgcn_mov_dpp(pi, 0x122, 0xf, 0xf, true);
                        p1[j] = __int_as_float(__builtin_amdgcn_update_dpp(r1, xi, 0x111, 0xf, 0xf, false));
                        p2[j] = __int_as_float(__builtin_amdgcn_update_dpp(r2, xi, 0x112, 0xf, 0xf, false));
                    }
                    if (grow >= SEQ - 2 && grow < SEQ) *(f32x4*)(convp_out + (size_t)(grow - (SEQ - 2)) * DFF + c0 + 4 * n) = x;
                    const f32x4 ac = cb[n] + w0[n] * p2 + w1[n] * p1 + w2[n] * x;
                    const f32x4 v = acc[ai][1][m][n];
                    const f32x2 g0 = gelu_pk((f32x2){ac[0], ac[1]}), g1 = gelu_pk((f32x2){ac[2], ac[3]});
                    const unsigned lo = cvt_pk_bf16(g0.x * v[0], g0.y * v[1]), hi = cvt_pk_bf16(g1.x * v[2], g1.y * v[3]);
                    if (n == 0) { w.x = lo; w.y = hi; } else { w.z = lo; w.w = hi; }
                }
                if (store) ST16((u32x4*)(G + (size_t)grow * DFF + c0), w);
                asm volatile("" ::: "memory");
            }
    }
};

template <int NT>
struct EpiStoreOnly {
    bf16_t* dst;
    __device__ __forceinline__ void operator()(const AccT& acc, const Unit& u, int wr, int wc, int fr, int fq, LAS unsigned char*) const {
#pragma unroll
        for (int ai = 0; ai < 2; ++ai)
#pragma unroll
            for (int m = 0; m < 4; ++m) {
                const int row = u.pm * 254 + ai * 128 + wr * 64 + m * 16 + fr;
#pragma unroll
                for (int bj = 0; bj < 2; ++bj) {
                    const int col = (u.pn & 3) * 256 + bj * 128 + wc * 32 + fq * 8;
                    const f32x4 v0 = acc[ai][bj][m][0], v1 = acc[ai][bj][m][1];
                    u32x4 w; w.x = cvt_pk_bf16(v0[0], v0[1]); w.y = cvt_pk_bf16(v0[2], v0[3]); w.z = cvt_pk_bf16(v1[0], v1[1]); w.w = cvt_pk_bf16(v1[2], v1[3]);
                    if (NT) __builtin_nontemporal_store(w, (u32x4*)(dst + (size_t)row * D + col)); else *(u32x4*)(dst + (size_t)row * D + col) = w;
                }
            }
    }
};
struct EpiNull {
    __device__ __forceinline__ void operator()(const AccT& acc, const Unit& u, int wr, int wc, int fr, int fq, LAS unsigned char*) const {
#pragma unroll
        for (int ai = 0; ai < 2; ++ai)
#pragma unroll
            for (int bj = 0; bj < 2; ++bj)
#pragma unroll
                for (int m = 0; m < 4; ++m) { asm volatile("" :: "v"(acc[ai][bj][m][0]), "v"(acc[ai][bj][m][1])); }
    }
};
struct KArgs { const float* in[29]; float* out; unsigned char* ws; };
enum { I_XP = 0, I_XS, I_PP, I_PS, I_SGLA, I_CK, I_CV, I_SPOOL, I_SCONV, I_MNE, I_WIN, I_WALPHA, I_BALPHA, I_ONORM, I_QNORM, I_KNORM, I_SINKS, I_WOUT,
       I_MNO, I_POOLW, I_POOLSC, I_FNORM, I_FWIN, I_FCW, I_FCB, I_FWOUT, I_PNORM, I_PWPROJ, I_PWGATE };

__device__ __forceinline__ float* part_tab(unsigned char* ws, int i) { return (float*)(ws + WS_SSQ + 262144 + (size_t)i * PART_STRIDE) + 2 * 16; }

constexpr int SG_STAGE = 24576, SG_NST = 6, SPART_PITCH = 36;
constexpr size_t WS_SPART = WS_SSQ + 6750208;
__device__ __forceinline__ float* spart_tab(unsigned char* ws, int i) { return (float*)(ws + WS_SPART) + (size_t)i * 128 * 32; }
template <int K, int LDA, int LDB>
__device__ __forceinline__ void sgemm_tile(const bf16_t* __restrict__ A, const bf16_t* __restrict__ B0, const bf16_t* __restrict__ B1, LAS unsigned char* lds) {
    const int tid = otid(), lane = tid & 63, wave = __builtin_amdgcn_readfirstlane(tid >> 6);
    const int fr = lane & 15, fq = lane >> 4, mb = wave >> 1, nb = wave & 1;
    constexpr int NSTG = K / 128;
    static_assert(K % 128 == 0 && NSTG >= 2, "K must be a multiple of 128");
    const int prow = lane >> 4, ppc = lane & 15;
    const char* gsrc[3]; unsigned ldst[3];
#pragma unroll
    for (int j = 0; j < 3; ++j) {
        if (j < 2) { const int i = wave + 8 * j, row = 4 * i + prow; gsrc[j] = (const char*)(A + (size_t)row * LDA) + 16 * (ppc ^ (row & 15)); ldst[j] = (unsigned)i * 1024u; }
        else { const int row = 4 * wave + prow; const bf16_t* bp = row < 16 ? B0 + (size_t)row * LDB : B1 + (size_t)(row - 16) * LDB; gsrc[j] = (const char*)bp + 16 * (ppc ^ (row & 15)); ldst[j] = 16384u + (unsigned)wave * 1024u; }
    }
#define SG_DMA(c) do { const int st_ = ((c) % SG_NST) * SG_STAGE; _Pragma("unroll") for (int j_ = 0; j_ < 3; ++j_) \
        __builtin_amdgcn_global_load_lds((const unsigned*)(gsrc[j_] + (size_t)(c) * 256), (LAS unsigned*)(lds + st_ + ldst[j_]), 16, 0, 0); } while (0)
    f32x4 acc = (f32x4){0.f, 0.f, 0.f, 0.f};
    int aoff[4], boff[4];
#pragma unroll
    for (int s = 0; s < 4; ++s) { aoff[s] = (16 * mb + fr) * 256 + 16 * ((4 * s + fq) ^ fr); boff[s] = 16384 + (16 * nb + fr) * 256 + 16 * ((4 * s + fq) ^ fr); }
#pragma unroll
    for (int c = 0; c < (NSTG < 5 ? NSTG : 5); ++c) SG_DMA(c);
#pragma unroll 1
    for (int c = 0; c < NSTG; ++c) {
        if (c + 5 < NSTG) SG_DMA(c + 5);
        const int ahead = (NSTG - 1 - c) < 5 ? (NSTG - 1 - c) : 5;
        if (ahead == 5) asm volatile("s_waitcnt vmcnt(15)" ::: "memory");
        else if (ahead == 4) asm volatile("s_waitcnt vmcnt(12)" ::: "memory");
        else if (ahead == 3) asm volatile("s_waitcnt vmcnt(9)" ::: "memory");
        else if (ahead == 2) asm volatile("s_waitcnt vmcnt(6)" ::: "memory");
        else if (ahead == 1) asm volatile("s_waitcnt vmcnt(3)" ::: "memory");
        else asm volatile("s_waitcnt vmcnt(0)" ::: "memory");
        __builtin_amdgcn_s_barrier(); asm volatile("" ::: "memory");
        const LAS unsigned char* st = lds + (c % SG_NST) * SG_STAGE;
#pragma unroll
        for (int s = 0; s < 4; ++s) {
            const bf16x8 af = *(const LAS bf16x8*)(st + aoff[s]), bf = *(const LAS bf16x8*)(st + boff[s]);
            acc = __builtin_amdgcn_mfma_f32_16x16x32_bf16(bf, af, acc, 0, 0, 0);
        }
        asm volatile("s_waitcnt lgkmcnt(0)" ::: "memory"); __builtin_amdgcn_s_barrier(); asm volatile("" ::: "memory");
    }
#undef SG_DMA
    *(LAS f32x4*)((LAS float*)lds + (16 * mb + fr) * SPART_PITCH + 16 * nb + 4 * fq) = acc;
}
__device__ __forceinline__ f32x4 sread4(const LAS unsigned char* lds, int b, int col0) { return *(const LAS f32x4*)((const LAS float*)lds + b * SPART_PITCH + col0); }
__device__ __forceinline__ float s_row_rs(const float* spart, int sb) {
    const float* p = spart + (size_t)sb * 32; float s = 0.f;
#pragma unroll
    for (int i = 0; i < 32; i += 4) { const f32x4 v = *(const f32x4*)(p + i); s += (v[0] + v[1]) + (v[2] + v[3]); }
    return rsqrtf(s * (1.0f / D) + EPS);
}
template <int MODE, bool WRITE_HB, bool WRITE_PART, bool WRITE_F32>
__device__ __forceinline__ void s_res_epi(const KArgs& a, int sb, int q, int cu, const f32x4 v, const bf16_t* hbin, bf16_t* hb, float* spart, const f32x4 ppv, float rs_in, const float* scale) {
    const int row = SROW + sb, c0 = 32 * cu + 4 * q;
    f32x4 base;
    if (MODE == 0) base = *(const f32x4*)(a.in[I_XS] + (size_t)sb * D + c0);
    else { const u32x2 w = *(const u32x2*)(hbin + (size_t)row * D + c0); base = (f32x4){bf_lo(w.x), bf_hi(w.x), bf_lo(w.y), bf_hi(w.y)}; }
    f32x4 hn; float sq = 0.f;
#pragma unroll
    for (int j = 0; j < 4; ++j) {
        float nv = v[j];
        if (MODE == 2) nv = ppv[j] * __builtin_amdgcn_rcpf(1.f + __expf(-nv * rs_in));
        if (MODE == 3) nv = nv * scale[c0 + j];
        hn[j] = base[j] + nv; sq += hn[j] * hn[j];
    }
    if (WRITE_F32) *(f32x4*)(a.out + O_YS + (size_t)sb * D + c0) = hn;
    if (WRITE_HB) { u32x2 w; w.x = cvt_pk_bf16(hn[0], hn[1]); w.y = cvt_pk_bf16(hn[2], hn[3]); *(u32x2*)(hb + (size_t)row * D + c0) = w; }
    if (WRITE_PART) {
        sq += __shfl_xor(sq, 1); sq += __shfl_xor(sq, 2); sq += __shfl_xor(sq, 4);
        if (q == 0) spart[(size_t)sb * 32 + cu] = sq;
    }
}
__device__ __forceinline__ void s_proj_units(const KArgs& a, LAS unsigned char* lds, int u0, int ustep) {
    const bf16_t* xbf = (const bf16_t*)(a.ws + WS_R1) + (size_t)SROW * D; const bf16_t* W = (const bf16_t*)(a.ws + WS_WIN0);
    bf16_t* proj = (bf16_t*)(a.ws + WS_BIG); float* la = (float*)(a.ws + WS_BIG + BIG_LA); const float* ssq0 = (const float*)(a.ws + WS_SSQ);
    for (int u = u0; u < 160; u += ustep) {
        const int rh = u & 1, cu = u >> 1, n0 = cu * 32;
        sgemm_tile<1024, 1024, 1024>(xbf + (size_t)(64 * rh) * D, W + (size_t)n0 * 1024, W + (size_t)(n0 + 16) * 1024, lds);
        __syncthreads();
        const int tid = otid(), b = tid >> 3, q = tid & 7, sb = 64 * rh + b, c0 = n0 + 4 * q, row = SROW + sb;
        const f32x4 v = sread4(lds, b, 4 * q);
        const float rs = rsqrtf(ssq0[row] * (1.0f / D) + EPS);
        if (n0 < NPROJ) {
            u32x2 w; w.x = cvt_pk_bf16(v[0] * rs, v[1] * rs); w.y = cvt_pk_bf16(v[2] * rs, v[3] * rs);
            *(u32x2*)(proj + (size_t)row * NPROJ + c0) = w;
        } else {
            const int c = c0 - NPROJ; f32x4 o;
#pragma unroll
            for (int i = 0; i < 4; ++i) { const float z = v[i] * rs + a.in[I_BALPHA][c + i]; o[i] = (fminf(z, 0.f) - __logf(1.0f + __expf(-fabsf(z)))) * 0.0625f; }
            *(f32x4*)(la + (size_t)row * 256 + c) = o;
        }
        __syncthreads();
    }
}
template <int MODE, int K, int LDA>
__device__ __forceinline__ void s_res_units(const KArgs& a, LAS unsigned char* lds, int u0, int ustep, const bf16_t* A, const bf16_t* W, const bf16_t* hbin, bf16_t* hb, float* spart_out) {
    for (int u = u0; u < 64; u += ustep) {
        const int rh = u & 1, cu = u >> 1, n0 = cu * 32;
        const bf16_t* Au = A + (size_t)(SROW + 64 * rh) * LDA + (MODE == 3 ? (n0 >> 8) * 256 : 0);
        sgemm_tile<K, LDA, K>(Au, W + (size_t)n0 * K, W + (size_t)(n0 + 16) * K, lds);
        __syncthreads();
        const int tid = otid(), b = tid >> 3, q = tid & 7;
        const f32x4 v = sread4(lds, b, 4 * q);
        s_res_epi<MODE, true, true, false>(a, 64 * rh + b, q, cu, v, hbin, hb, spart_out, v, 1.f, a.in[I_POOLSC]);
        __syncthreads();
    }
}
template <bool LAST>
__device__ __forceinline__ void s_ple_units(const KArgs& a, LAS unsigned char* lds, int u0, int ustep, const bf16_t* pb, const bf16_t* Wp, const bf16_t* hbA, const bf16_t* Wg, const float* spart_in, float* spart_out, bf16_t* hbout) {
    for (int u = u0; u < 64; u += ustep) {
        const int rh = u & 1, cu = u >> 1, n0 = cu * 32;
        sgemm_tile<256, 256, 256>(pb + (size_t)(SROW + 64 * rh) * PLE, Wp + (size_t)n0 * PLE, Wp + (size_t)(n0 + 16) * PLE, lds);
        __syncthreads();
        const int tid = otid(), b = tid >> 3, q = tid & 7;
        const f32x4 ppv = sread4(lds, b, 4 * q);
        __syncthreads();
        sgemm_tile<1024, 1024, 1024>(hbA + (size_t)(SROW + 64 * rh) * D, Wg + (size_t)n0 * D, Wg + (size_t)(n0 + 16) * D, lds);
        __syncthreads();
        const f32x4 v = sread4(lds, b, 4 * q);
        const float rs = s_row_rs(spart_in, 64 * rh + b);
        s_res_epi<2, !LAST, !LAST, LAST>(a, 64 * rh + b, q, cu, v, hbA, hbout, spart_out, ppv, rs, nullptr);
        __syncthreads();
    }
}
__device__ __forceinline__ void s_ffn_units(const KArgs& a, LAS unsigned char* lds, int u0, int ustep, int l, const bf16_t* hbA, const float* spart_in) {
    const bf16_t* W = (const bf16_t*)(a.ws + WS_WFFI + l * WFFI_BYTES);
    bf16_t* Gb = (bf16_t*)(a.ws + WS_BIG);
    const float* convw = a.in[I_FCW] + (size_t)l * 3 * DFF; const float* convb = a.in[I_FCB] + (size_t)l * DFF;
    const float* cstate = a.in[I_SCONV] + (size_t)l * NS * 2 * DFF; float* convs = a.out + O_CONVS + (size_t)l * NS * 2 * DFF;
    for (int u = u0; u < 352; u += ustep) {
        const int rh = u & 1, cu = u >> 1, ca = cu * 16;
        const int nr = 256 * (ca >> 7) + (ca & 127);
        sgemm_tile<1024, 1024, 1024>(hbA + (size_t)(SROW + 64 * rh) * D, W + (size_t)nr * 1024, W + (size_t)(nr + 128) * 1024, lds);
        __syncthreads();
        const int tid = otid(), b = tid >> 3, q = tid & 7, sb = 64 * rh + b;
        if (q < 4) {
            const int c = ca + 4 * q;
            const f32x4 av = sread4(lds, b, 4 * q), vv = sread4(lds, b, 16 + 4 * q);
            const float rs = s_row_rs(spart_in, sb);
            const float* st = cstate + (size_t)sb * 2 * DFF + c; float* so = convs + (size_t)sb * 2 * DFF + c;
            const f32x4 p2 = *(const f32x4*)(st), p1 = *(const f32x4*)(st + DFF);
            const f32x4 w0 = *(const f32x4*)(convw + c), w1 = *(const f32x4*)(convw + DFF + c), w2 = *(const f32x4*)(convw + 2 * DFF + c), cb = *(const f32x4*)(convb + c);
            const f32x4 x = av * rs;
            *(f32x4*)(so) = p1; *(f32x4*)(so + DFF) = x;
            const f32x4 ac = cb + w0 * p2 + w1 * p1 + w2 * x;
            const f32x2 g0 = gelu_pk((f32x2){ac[0], ac[1]}), g1 = gelu_pk((f32x2){ac[2], ac[3]});
            u32x2 w; w.x = cvt_pk_bf16(g0.x * vv[0] * rs, g0.y * vv[1] * rs); w.y = cvt_pk_bf16(g1.x * vv[2] * rs, g1.y * vv[3] * rs);
            *(u32x2*)(Gb + (size_t)(SROW + sb) * DFF + c) = w;
        }
        __syncthreads();
    }
}

__device__ __forceinline__ void tr_item(const float* W, int ldsrc, int scol0, int k0, const float* gain, bf16_t* dst, int ldd, int drow0, LAS float* scr, int lane) {
    float wv[32];
#pragma unroll
    for (int i = 0; i < 32; ++i) { const int kk = 2 * i + (lane >> 5); wv[i] = __builtin_nontemporal_load(W + (size_t)(k0 + kk) * ldsrc + scol0 + (lane & 31)); }
#pragma unroll
    for (int i = 0; i < 32; ++i) { const int kk = 2 * i + (lane >> 5); const float gsc = gain ? gain[k0 + kk] : 1.f; scr[kk * 33 + (lane & 31)] = wv[i] * gsc; }
    asm volatile("s_waitcnt lgkmcnt(0)" ::: "memory");
    const int c = lane & 7;
#pragma unroll
    for (int j = 0; j < 4; ++j) { const int n = (lane >> 3) + 8 * j; const LAS float* s = scr + (8 * c) * 33 + n;
        u32x4 o; o.x = cvt_pk_bf16(s[0 * 33], s[1 * 33]); o.y = cvt_pk_bf16(s[2 * 33], s[3 * 33]); o.z = cvt_pk_bf16(s[4 * 33], s[5 * 33]); o.w = cvt_pk_bf16(s[6 * 33], s[7 * 33]);
        *(u32x4*)(dst + (size_t)(drow0 + n) * ldd + k0 + 8 * c) = o; }
    asm volatile("s_waitcnt lgkmcnt(0)" ::: "memory");
}
__device__ __forceinline__ void weff_item(const float* Win, const float* wal, int n0, int k0, const float* gain, bf16_t* dst, int drow0, LAS float* scr, int lane) {
#pragma unroll 2
    for (int i = 0; i < 32; ++i) { const int kk = 2 * i + (lane >> 5); const int k = k0 + kk; float s = 0.f;
#pragma unroll
        for (int r = 0; r < 16; ++r) s += Win[(size_t)k * 2320 + 1024 + r] * wal[r * 256 + n0 + (lane & 31)];
        scr[kk * 33 + (lane & 31)] = s * gain[k]; }
    asm volatile("s_waitcnt lgkmcnt(0)" ::: "memory");
    const int c = lane & 7;
#pragma unroll
    for (int j = 0; j < 4; ++j) { const int n = (lane >> 3) + 8 * j; const LAS float* s = scr + (8 * c) * 33 + n;
        u32x4 o; o.x = cvt_pk_bf16(s[0 * 33], s[1 * 33]); o.y = cvt_pk_bf16(s[2 * 33], s[3 * 33]); o.z = cvt_pk_bf16(s[4 * 33], s[5 * 33]); o.w = cvt_pk_bf16(s[6 * 33], s[7 * 33]);
        *(u32x4*)(dst + (size_t)(drow0 + n) * 1024 + k0 + 8 * c) = o; }
    asm volatile("s_waitcnt lgkmcnt(0)" ::: "memory");
}

__device__ __forceinline__ void p0_prologue(const KArgs& a, LAS unsigned char* lds, int vcu, int G) {
    const int tid = otid(), lane = tid & 63, wave = __builtin_amdgcn_readfirstlane(tid >> 6);
    LAS float* scr = (LAS float*)(lds + wave * 16384);
    const int gw = vcu * 8 + wave, NGW = G * 8;
    unsigned char* ws = a.ws;
    constexpr int I_A = 16 * 72, I_E = 16 * 8;
    for (int it = gw; it < I_A + I_E; it += NGW) {
        int r = it;
        if (r < I_A) { const int kb = r / 72, nb = r % 72, n0 = nb * 32; tr_item(a.in[I_WIN], 2320, n0 < 1024 ? n0 : n0 + 16, kb * 64, a.in[I_MNE], (bf16_t*)(ws + WS_WIN0), 1024, n0, scr, lane); continue; } r -= I_A;
        { const int kb = r / 8, nb = r % 8; weff_item(a.in[I_WIN], a.in[I_WALPHA], nb * 32, kb * 64, a.in[I_MNE], (bf16_t*)(ws + WS_WIN0), NPROJ + nb * 32, scr, lane); }
    }
    bf16_t* xbf = (bf16_t*)(ws + WS_R1);
    float* ssq0 = (float*)(ws + WS_SSQ);
    for (int row0 = gw * 2; row0 < MT; row0 += NGW * 2) {
        f32x4 v[2][4];
#pragma unroll
        for (int rr = 0; rr < 2; ++rr) { const int row = row0 + rr;
            const float* src = row < SEQ ? a.in[I_XP] + (size_t)row * D : ((row >= SROW && row < SROW + NS) ? a.in[I_XS] + (size_t)(row - SROW) * D : nullptr);
#pragma unroll
            for (int j = 0; j < 4; ++j) { v[rr][j] = (f32x4){0.f, 0.f, 0.f, 0.f}; if (src) v[rr][j] = __builtin_nontemporal_load((const f32x4*)(src + j * 256 + lane * 4)); } }
#pragma unroll
        for (int rr = 0; rr < 2; ++rr) { const int row = row0 + rr; float s = 0.f;
#pragma unroll
            for (int j = 0; j < 4; ++j) { const f32x4 x = v[rr][j]; s += (x[0] * x[0] + x[1] * x[1]) + (x[2] * x[2] + x[3] * x[3]);
                u32x2 w; w.x = cvt_pk_bf16(x[0], x[1]); w.y = cvt_pk_bf16(x[2], x[3]);
                *(u32x2*)(xbf + (size_t)row * D + j * 256 + lane * 4) = w; }
            s = wave_sum(s);
            if (lane == 0) ssq0[row] = s; }
    }
    if (vcu == 0) { for (int i = tid; i < 256; i += NTHREADS) ((u32x4*)(ws + WS_R2))[i] = (u32x4){0u, 0u, 0u, 0u}; }
    if (vcu == 1 && tid < 6 * 32) { float* pt = (float*)(ws + WS_SSQ + 262144 + (size_t)(tid >> 5) * PART_STRIDE); pt[tid & 31] = 0.f; }
}
constexpr int CONV_ITEMS = 16 * 32 + 2 * 16 * 176 + 2 * 44 * 32 + 2 * 16 * 32 + 2 * 4 * 32 + 4 * 32;
constexpr int CONV_SPLIT = 10368;
__device__ __forceinline__ void p3_convert(const KArgs& a, LAS unsigned char* lds, int gw, int NGW, int it_lo, int it_hi, bool do_p) {
    const int tid = otid(), lane = tid & 63, wave = __builtin_amdgcn_readfirstlane(tid >> 6);
    LAS float* scr = (LAS float*)(lds + wave * 16384);
    unsigned char* ws = a.ws;
    constexpr int I_O = 16 * 32, I_FI = 16 * 176, I_FO = 44 * 32, I_G = 16 * 32, I_P = 4 * 32, I_PL = 4 * 32;
    static_assert(CONV_ITEMS == I_O + 2 * I_FI + 2 * I_FO + 2 * I_G + 2 * I_P + I_PL, "item count");
    for (int it = it_lo + gw; it < it_hi; it += NGW) {
        int r = it;
        if (r < I_O) { const int kb = r / 32, nb = r % 32; tr_item(a.in[I_WOUT], 1024, nb * 32, kb * 64, nullptr, (bf16_t*)(ws + WS_WOUT0), 1024, nb * 32, scr, lane); continue; } r -= I_O;
        if (r < 2 * I_FI) { const int l = r / I_FI, q = r % I_FI, kb = q / 176, nb = q % 176, n0 = nb * 32;
            const int pn = n0 >> 8, rr = n0 & 255, bj = rr >> 7, ii = rr & 127;
            tr_item(a.in[I_FWIN] + (size_t)l * 1024 * 5632, 5632, bj * DFF + pn * 128 + ii, kb * 64, a.in[I_FNORM] + l * 1024, (bf16_t*)(ws + WS_WFFI + l * WFFI_BYTES), 1024, n0, scr, lane); continue; } r -= 2 * I_FI;
        if (r < 2 * I_FO) { const int l = r / I_FO, q = r % I_FO, kb = q / 32, nb = q % 32;
            tr_item(a.in[I_FWOUT] + (size_t)l * DFF * 1024, 1024, nb * 32, kb * 64, nullptr, (bf16_t*)(ws + WS_WFFO + l * WFFO_BYTES), DFF, nb * 32, scr, lane); continue; } r -= 2 * I_FO;
        if (r < 2 * I_G) { const int l = r / I_G, q = r % I_G, kb = q / 32, nb = q % 32;
            tr_item(a.in[I_PWGATE] + (size_t)l * 1024 * 1024, 1024, nb * 32, kb * 64, a.in[I_PNORM] + l * 1024, (bf16_t*)(ws + WS_WGATE + l * WGATE_BYTES), 1024, nb * 32, scr, lane); continue; } r -= 2 * I_G;
        if (r < 2 * I_P) { const int l = r / I_P, q = r % I_P, kb = q / 32, nb = q % 32;
            tr_item(a.in[I_PWPROJ] + (size_t)l * 256 * 1024, 1024, nb * 32, kb * 64, nullptr, (bf16_t*)(ws + WS_WPROJ + l * WPROJ_BYTES), 256, nb * 32, scr, lane); continue; } r -= 2 * I_P;
        { const int gq = r / 32, q = r % 32, kb = q / 8, nb = q % 8;
            tr_item(a.in[I_POOLW] + (size_t)gq * 65536, 256, nb * 32, kb * 64, nullptr, (bf16_t*)(ws + WS_WPOOL), 256, gq * 256 + nb * 32, scr, lane); }
    }
    bf16_t* pbf = (bf16_t*)(ws + WS_PBF);
    if (do_p)
    for (int it0 = gw * 4; it0 < 2 * MT; it0 += NGW * 4) {
        f32x4 v[4];
#pragma unroll
        for (int rr = 0; rr < 4; ++rr) { const int it = it0 + rr; const int l = it / MT, row = it % MT;
            const float* src = row < SEQ ? a.in[I_PP] + ((size_t)l * SEQ + row) * PLE : ((row >= SROW && row < SROW + NS) ? a.in[I_PS] + ((size_t)l * NS + (row - SROW)) * PLE : nullptr);
            v[rr] = (f32x4){0.f, 0.f, 0.f, 0.f}; if (src) v[rr] = __builtin_nontemporal_load((const f32x4*)(src + lane * 4)); }
#pragma unroll
        for (int rr = 0; rr < 4; ++rr) { u32x2 w; w.x = cvt_pk_bf16(v[rr][0], v[rr][1]); w.y = cvt_pk_bf16(v[rr][2], v[rr][3]);
            *(u32x2*)(pbf + (size_t)(it0 + rr) * PLE + lane * 4) = w; }
    }
}

__device__ __forceinline__ int crow(int i, int hh) { return (i & 3) + 8 * (i >> 2) + 4 * hh; }
template <bool OUT>
__device__ __forceinline__ void gla_item_m(const KArgs& a, LAS unsigned char* lds, int item) {
    const int tid = otid(), lane = tid & 63, wave = __builtin_amdgcn_readfirstlane(tid >> 6);
    const int sc = item >> 2, h = item & 3;
    const bf16_t* proj = (const bf16_t*)(a.ws + WS_BIG); const float* la = (const float*)(a.ws + WS_BIG + BIG_LA);
    bf16_t* mix = (bf16_t*)(a.ws + WS_R1);
    float* US = (float*)(a.ws + WS_R2 + 4096); float* DS = US + (size_t)64 * 4 * 64 * 128;
    LAS float* bL = (LAS float*)lds; LAS float* segS = (LAS float*)(lds + 16384);
    LAS bf16_t* Qn = (LAS bf16_t*)(lds + 18432); LAS bf16_t* Kn = (LAS bf16_t*)(lds + 27648); LAS bf16_t* KT = (LAS bf16_t*)(lds + 36864);
    LAS bf16_t* VT = (LAS bf16_t*)(lds + 46080); LAS bf16_t* ST = (LAS bf16_t*)(lds + 64512); LAS float* red = (LAS float*)(lds + 82944);
    const int r = lane & 31, hh = lane >> 5;
    const int dkt = wave & 1, dvt = wave >> 1, it = wave & 1;
    f32x16 S = {};
    float* usp = US + ((size_t)(sc * 4 + h) * 64 + 32 * dkt) * 128 + 32 * dvt + r;
    if (OUT) {
#pragma unroll
        for (int i = 0; i < 16; ++i) S[i] = usp[(size_t)crow(i, hh) * 128];
    }
    float bsum = 0.f;
    const int sdk = tid & 63, sseg = tid >> 6, st_t = tid >> 3, sd8 = (tid & 7) * 8;
    float nla[8]; u32x4 nkw, nqw, nvw[2]; u32x2 nrw[4];
#define GLA_FETCH(cc) do { const int T0n = sc * 256 + (cc) * 64; \
        _Pragma("unroll") for (int i = 0; i < 8; ++i) nla[i] = la[(size_t)(T0n + 8 * sseg + i) * 256 + h * 64 + sdk]; \
        const size_t prow_ = (size_t)(T0n + st_t) * NPROJ; \
        nkw = *(const u32x4*)(proj + prow_ + PKA + h * 64 + sd8); \
        if (OUT) nqw = *(const u32x4*)(proj + prow_ + PQA + h * 64 + sd8); \
        nvw[0] = *(const u32x4*)(proj + prow_ + PVA + h * 128 + sd8); nvw[1] = *(const u32x4*)(proj + prow_ + PVA + h * 128 + sd8 + 64); \
        if (OUT) { _Pragma("unroll") for (int q = 0; q < 4; ++q) nrw[q] = *(const u32x2*)(proj + (size_t)(T0n + 32 * it + r) * NPROJ + PRA + h * 128 + 32 * dvt + 8 * q + 4 * hh); } } while (0)
    GLA_FETCH(0);
#pragma unroll 1
    for (int c = 0; c < 4; ++c) {
        const int T0 = sc * 256 + c * 64;
        float v[8]; u32x4 kw_c = nkw, qw_c = nqw, vw_c0 = nvw[0], vw_c1 = nvw[1]; u32x2 rw_c[4];
#pragma unroll
        for (int i = 0; i < 8; ++i) v[i] = nla[i];
#pragma unroll
        for (int q = 0; q < 4; ++q) rw_c[q] = nrw[q];
        if (c < 3) GLA_FETCH(c + 1);
        if (OUT) {
#pragma unroll
            for (int q = 0; q < 4; ++q) { u32x2 w; w.x = cvt_pk_bf16(S[4 * q], S[4 * q + 1]); w.y = cvt_pk_bf16(S[4 * q + 2], S[4 * q + 3]);
                *(LAS u32x2*)(ST + (32 * dvt + r) * 72 + 32 * dkt + 8 * q + 4 * hh) = w; }
        }
        {
            const int dk = sdk, seg = sseg;
#pragma unroll
            for (int i = 1; i < 8; ++i) v[i] += v[i - 1];
            segS[seg * 64 + dk] = v[7];
            __syncthreads();
            float off = 0.f;
#pragma unroll
            for (int s = 0; s < 8; ++s) { const float x = segS[s * 64 + dk]; off += (s < seg) ? x : 0.f; }
#pragma unroll
            for (int i = 0; i < 8; ++i) bL[(8 * seg + i) * 64 + dk] = v[i] + off;
            __syncthreads();
        }
        {
            const int t = st_t, d8 = sd8;
            const f32x4 b0 = *(const LAS f32x4*)(bL + t * 64 + d8), b1 = *(const LAS f32x4*)(bL + t * 64 + d8 + 4);
            const f32x4 l0 = *(const LAS f32x4*)(bL + 63 * 64 + d8), l1 = *(const LAS f32x4*)(bL + 63 * 64 + d8 + 4);
            float bb[8] = {b0[0], b0[1], b0[2], b0[3], b1[0], b1[1], b1[2], b1[3]}, bl[8] = {l0[0], l0[1], l0[2], l0[3], l1[0], l1[1], l1[2], l1[3]};
            float kf[8]; unpack8(kw_c, kf);
#pragma unroll
            for (int j = 0; j < 8; ++j) KT[(d8 + j) * 72 + t] = (bf16_t)(cvt_pk_bf16(kf[j] * __expf(bl[j] - bb[j]), 0.f) & 0xffffu);
            if (OUT) {
                float qf[8]; unpack8(qw_c, qf);
                float qq[8], kk[8];
#pragma unroll
                for (int j = 0; j < 8; ++j) { const float e = __expf(bb[j]); qq[j] = qf[j] * 0.125f * e; kk[j] = kf[j] * __expf(-bb[j]); }
                u32x4 w; w.x = cvt_pk_bf16(qq[0], qq[1]); w.y = cvt_pk_bf16(qq[2], qq[3]); w.z = cvt_pk_bf16(qq[4], qq[5]); w.w = cvt_pk_bf16(qq[6], qq[7]);
                *(LAS u32x4*)(Qn + t * 72 + d8) = w;
                w.x = cvt_pk_bf16(kk[0], kk[1]); w.y = cvt_pk_bf16(kk[2], kk[3]); w.z = cvt_pk_bf16(kk[4], kk[5]); w.w = cvt_pk_bf16(kk[6], kk[7]);
                *(LAS u32x4*)(Kn + t * 72 + d8) = w;
            }
#pragma unroll
            for (int i = 0; i < 2; ++i) { const int dv8 = d8 + 64 * i;
                const u32x4 vw = (i == 0) ? vw_c0 : vw_c1;
                LAS bf16_t* vt = VT + dv8 * 72 + t;
                vt[0 * 72] = (bf16_t)(vw.x & 0xffffu); vt[1 * 72] = (bf16_t)(vw.x >> 16); vt[2 * 72] = (bf16_t)(vw.y & 0xffffu); vt[3 * 72] = (bf16_t)(vw.y >> 16);
                vt[4 * 72] = (bf16_t)(vw.z & 0xffffu); vt[5 * 72] = (bf16_t)(vw.z >> 16); vt[6 * 72] = (bf16_t)(vw.w & 0xffffu); vt[7 * 72] = (bf16_t)(vw.w >> 16); }
            if (tid < 64) bsum += bL[63 * 64 + tid];
        }
        __syncthreads();
        if (OUT) {
            bf16x8 qf[4];
#pragma unroll
            for (int s = 0; s < 4; ++s) qf[s] = *(const LAS bf16x8*)(Qn + (32 * it + r) * 72 + 16 * s + 8 * hh);
            f32x16 oacc = {};
#pragma unroll
            for (int jt = 0; jt < 2; ++jt) {
                if (jt <= it) {
                    f32x16 at = {};
#pragma unroll
                    for (int s = 0; s < 4; ++s) { const bf16x8 af = *(const LAS bf16x8*)(Kn + (32 * jt + r) * 72 + 16 * s + 8 * hh); at = __builtin_amdgcn_mfma_f32_32x32x16_bf16(af, qf[s], at, 0, 0, 0); }
                    if (jt == it) {
#pragma unroll
                        for (int i = 0; i < 16; ++i) if (crow(i, hh) > r) at[i] = 0.f;
                    }
#pragma unroll
                    for (int s2 = 0; s2 < 2; ++s2) {
                        u32x4 pw; pw.x = cvt_pk_bf16(at[8 * s2 + 0], at[8 * s2 + 1]); pw.y = cvt_pk_bf16(at[8 * s2 + 2], at[8 * s2 + 3]);
                        pw.z = cvt_pk_bf16(at[8 * s2 + 4], at[8 * s2 + 5]); pw.w = cvt_pk_bf16(at[8 * s2 + 6], at[8 * s2 + 7]);
                        const LAS bf16_t* vp = VT + (32 * dvt + r) * 72 + 32 * jt + 16 * s2 + 4 * hh;
                        const u32x2 v0 = *(const LAS u32x2*)vp, v1 = *(const LAS u32x2*)(vp + 8);
                        const u32x4 vv = (u32x4){v0.x, v0.y, v1.x, v1.y};
                        oacc = __builtin_amdgcn_mfma_f32_32x32x16_bf16(__builtin_bit_cast(bf16x8, vv), __builtin_bit_cast(bf16x8, pw), oacc, 0, 0, 0);
                    }
                }
            }
#pragma unroll
            for (int s = 0; s < 4; ++s) { const bf16x8 af = *(const LAS bf16x8*)(ST + (32 * dvt + r) * 72 + 16 * s + 8 * hh); oacc = __builtin_amdgcn_mfma_f32_32x32x16_bf16(af, qf[s], oacc, 0, 0, 0); }
            float ss = 0.f;
#pragma unroll
            for (int i = 0; i < 16; ++i) ss += oacc[i] * oacc[i];
            ss += __shfl_xor(ss, 32);
            if (hh == 0) red[wave * 32 + r] = ss;
            __syncthreads();
            const float tot = (red[it * 32 + r] + red[(it + 2) * 32 + r]) + (red[(it + 4) * 32 + r] + red[(it + 6) * 32 + r]);
            const float rstd = rsqrtf(tot * (1.0f / 128.f) + EPS);
            const int t = T0 + 32 * it + r;
#pragma unroll
            for (int q = 0; q < 4; ++q) {
                const int dv0 = 32 * dvt + 8 * q + 4 * hh;
                const u32x2 rw = rw_c[q];
                const f32x4 on = *(const f32x4*)(a.in[I_ONORM] + dv0);
                const float r0 = bf_lo(rw.x), r1 = bf_hi(rw.x), r2 = bf_lo(rw.y), r3 = bf_hi(rw.y);
                const float y0 = oacc[4 * q] * rstd * on[0] * (r0 * __builtin_amdgcn_rcpf(1.f + __expf(-r0))), y1 = oacc[4 * q + 1] * rstd * on[1] * (r1 * __builtin_amdgcn_rcpf(1.f + __expf(-r1)));
                const float y2 = oacc[4 * q + 2] * rstd * on[2] * (r2 * __builtin_amdgcn_rcpf(1.f + __expf(-r2))), y3 = oacc[4 * q + 3] * rstd * on[3] * (r3 * __builtin_amdgcn_rcpf(1.f + __expf(-r3)));
                u32x2 w; w.x = cvt_pk_bf16(y0, y1); w.y = cvt_pk_bf16(y2, y3);
                *(u32x2*)(mix + (size_t)t * D + h * 128 + dv0) = w;
            }
        }
#pragma unroll
        for (int i = 0; i < 16; ++i) S[i] *= __expf(bL[63 * 64 + 32 * dkt + crow(i, hh)]);
#pragma unroll
        for (int s = 0; s < 4; ++s) {
            const bf16x8 af = *(const LAS bf16x8*)(KT + (32 * dkt + r) * 72 + 16 * s + 8 * hh), bf = *(const LAS bf16x8*)(VT + (32 * dvt + r) * 72 + 16 * s + 8 * hh);
            S = __builtin_amdgcn_mfma_f32_32x32x16_bf16(af, bf, S, 0, 0, 0);
        }
        __syncthreads();
    }
#undef GLA_FETCH
    if (!OUT) {
#pragma unroll
        for (int i = 0; i < 16; ++i) usp[(size_t)crow(i, hh) * 128] = S[i];
        if (tid < 64) DS[(sc * 4 + h) * 64 + tid] = __expf(bsum);
    }
}
__device__ __forceinline__ void gla_scan_m(const KArgs& a, int vcu) {
    const int tid = otid(); if (tid >= 128) return;
    const int e = vcu * 128 + tid; if (e >= 32768) return;
    float* US = (float*)(a.ws + WS_R2 + 4096); const float* DS = US + (size_t)64 * 4 * 64 * 128;
    const int hd = e >> 7;
    float S = 0.f;
    for (int c0 = 0; c0 < 64; c0 += 8) {
        float u[8], d[8];
#pragma unroll
        for (int j = 0; j < 8; ++j) { u[j] = US[(size_t)(c0 + j) * 32768 + e]; d[j] = DS[(c0 + j) * 256 + hd]; }
#pragma unroll
        for (int j = 0; j < 8; ++j) { US[(size_t)(c0 + j) * 32768 + e] = S; S = d[j] * S + u[j]; }
    }
    a.out[O_GLAP + e] = S;
}
__device__ __forceinline__ void gla_decode_item(const KArgs& a, int item, int lane) {
    const int b = item >> 2, h = item & 3; const int row = SROW + b;
    const bf16_t* proj = (const bf16_t*)(a.ws + WS_BIG); const float* la = (const float*)(a.ws + WS_BIG + BIG_LA);
    bf16_t* mix = (bf16_t*)(a.ws + WS_R1);
    const float* S0 = a.in[I_SGLA] + ((size_t)b * 4 + h) * 8192;
    float* S1 = a.out + O_GLAS + ((size_t)b * 4 + h) * 8192;
    const float qv = bf2f(proj[(size_t)row * NPROJ + PQA + h * 64 + lane]) * 0.125f;
    const float kv = bf2f(proj[(size_t)row * NPROJ + PKA + h * 64 + lane]);
    const float av = __expf(la[(size_t)row * 256 + h * 64 + lane]);
    const unsigned vw = *(const unsigned*)(proj + (size_t)row * NPROJ + PVA + h * 128 + lane * 2);
    const float v0 = bf_lo(vw), v1 = bf_hi(vw);
    float o0 = 0.f, o1 = 0.f;
#pragma unroll 1
    for (int d0 = 0; d0 < 64; d0 += 16) {
        f32x2 sv[16];
#pragma unroll
        for (int j = 0; j < 16; ++j) sv[j] = __builtin_nontemporal_load((const f32x2*)(S0 + (d0 + j) * 128 + lane * 2));
#pragma unroll
        for (int j = 0; j < 16; ++j) {
            const int dk = d0 + j;
            const float q = __shfl(qv, dk), k = __shfl(kv, dk), al = __shfl(av, dk);
            const float n0 = al * sv[j].x + k * v0, n1 = al * sv[j].y + k * v1;
            __builtin_nontemporal_store((f32x2){n0, n1}, (f32x2*)(S1 + dk * 128 + lane * 2));
            o0 += q * n0; o1 += q * n1;
        }
    }
    const float ss = wave_sum(o0 * o0 + o1 * o1);
    const float rstd = rsqrtf(ss * (1.0f / 128.f) + EPS);
    const unsigned rw = *(const unsigned*)(proj + (size_t)row * NPROJ + PRA + h * 128 + lane * 2);
    const float r0 = bf_lo(rw), r1 = bf_hi(rw);
    const float y0 = o0 * rstd * a.in[I_ONORM][lane * 2] * (r0 / (1.f + __expf(-r0))), y1 = o1 * rstd * a.in[I_ONORM][lane * 2 + 1] * (r1 / (1.f + __expf(-r1)));
    *(unsigned*)(mix + (size_t)row * D + h * 128 + lane * 2) = cvt_pk_bf16(y0, y1);
}

__device__ __forceinline__ void swa_unit_m(const KArgs& a, LAS unsigned char* lds, int unit) {
    const int tid = otid(), lane = tid & 63, wave = __builtin_amdgcn_readfirstlane(tid >> 6);
    const int qb = unit >> 1, kvh = unit & 1; const int q0 = qb * 64, w0 = q0 - 128;
    const bf16_t* proj = (const bf16_t*)(a.ws + WS_BIG);
    bf16_t* mix = (bf16_t*)(a.ws + WS_R1);
    LAS bf16_t* Kl = (LAS bf16_t*)lds;
    LAS bf16_t* Vt = Kl + 192 * 72;
    const float* kn = a.in[I_KNORM];
    const int g = wave & 3, th = wave >> 2, hq = kvh * 4 + g;
    const int r = lane & 31, hh = lane >> 5;
    const int t = q0 + 32 * th + r;
    u32x4 kwv[3], vwv[3], qwv[4];
#pragma unroll
    for (int i = 0; i < 3; ++i) { const int c = tid + i * NTHREADS; const int kk = c >> 3, part = c & 7; const int tk = w0 + kk;
        kwv[i] = (u32x4){0u, 0u, 0u, 0u}; vwv[i] = (u32x4){0u, 0u, 0u, 0u};
        if (tk >= 0) { kwv[i] = *(const u32x4*)(proj + (size_t)tk * NPROJ + PKB + kvh * 64 + part * 8); vwv[i] = *(const u32x4*)(proj + (size_t)tk * NPROJ + PVB + kvh * 64 + part * 8); } }
#pragma unroll
    for (int s = 0; s < 4; ++s) qwv[s] = *(const u32x4*)(proj + (size_t)t * NPROJ + PQB + hq * 64 + 16 * s + 8 * hh);
#pragma unroll
    for (int i = 0; i < 3; ++i) {
        const int c = tid + i * NTHREADS; const int kk = c >> 3, part = c & 7;
        float kf[8]; unpack8(kwv[i], kf);
        const u32x4 vw = vwv[i];
        float ss = 0.f;
#pragma unroll
        for (int j = 0; j < 8; ++j) ss += kf[j] * kf[j];
        ss += __shfl_xor(ss, 1); ss += __shfl_xor(ss, 2); ss += __shfl_xor(ss, 4);
        const float rstd = rsqrtf(ss * (1.0f / 64.f) + EPS);
#pragma unroll
        for (int j = 0; j < 8; ++j) kf[j] = kf[j] * rstd * kn[part * 8 + j];
        u32x4 kw2; kw2.x = cvt_pk_bf16(kf[0], kf[1]); kw2.y = cvt_pk_bf16(kf[2], kf[3]); kw2.z = cvt_pk_bf16(kf[4], kf[5]); kw2.w = cvt_pk_bf16(kf[6], kf[7]);
        *(LAS u32x4*)(Kl + kk * 72 + part * 8) = kw2;
        LAS bf16_t* vt = Vt + (part * 8) * 196 + kk;
        vt[0 * 196] = (bf16_t)(vw.x & 0xffffu); vt[1 * 196] = (bf16_t)(vw.x >> 16); vt[2 * 196] = (bf16_t)(vw.y & 0xffffu); vt[3 * 196] = (bf16_t)(vw.y >> 16);
        vt[4 * 196] = (bf16_t)(vw.z & 0xffffu); vt[5 * 196] = (bf16_t)(vw.z >> 16); vt[6 * 196] = (bf16_t)(vw.w & 0xffffu); vt[7 * 196] = (bf16_t)(vw.w >> 16);
        if (qb == 255 && kk >= 64) {
            const int w = kk - 64;
            float vf[8]; unpack8(vw, vf);
            float* ko = a.out + O_SKP + ((size_t)w * 2 + kvh) * 64 + part * 8; float* vo = a.out + O_SVP + ((size_t)w * 2 + kvh) * 64 + part * 8;
            *(f32x4*)ko = (f32x4){kf[0], kf[1], kf[2], kf[3]}; *(f32x4*)(ko + 4) = (f32x4){kf[4], kf[5], kf[6], kf[7]};
            *(f32x4*)vo = (f32x4){vf[0], vf[1], vf[2], vf[3]}; *(f32x4*)(vo + 4) = (f32x4){vf[4], vf[5], vf[6], vf[7]};
        }
    }
    __syncthreads();
    constexpr float LOG2E = 1.4426950408889634f;
    bf16x8 qf[4];
    {
        float qv[4][8]; float ss = 0.f;
#pragma unroll
        for (int s = 0; s < 4; ++s) { unpack8(qwv[s], qv[s]);
#pragma unroll
            for (int j = 0; j < 8; ++j) ss += qv[s][j] * qv[s][j]; }
        ss += __shfl_xor(ss, 32);
        const float rstd = rsqrtf(ss * (1.0f / 64.f) + EPS) * (0.125f * LOG2E);
        const float* qn = a.in[I_QNORM];
#pragma unroll
        for (int s = 0; s < 4; ++s) {
            u32x4 w;
            w.x = cvt_pk_bf16(qv[s][0] * rstd * qn[16 * s + 8 * hh + 0], qv[s][1] * rstd * qn[16 * s + 8 * hh + 1]);
            w.y = cvt_pk_bf16(qv[s][2] * rstd * qn[16 * s + 8 * hh + 2], qv[s][3] * rstd * qn[16 * s + 8 * hh + 3]);
            w.z = cvt_pk_bf16(qv[s][4] * rstd * qn[16 * s + 8 * hh + 4], qv[s][5] * rstd * qn[16 * s + 8 * hh + 5]);
            w.w = cvt_pk_bf16(qv[s][6] * rstd * qn[16 * s + 8 * hh + 6], qv[s][7] * rstd * qn[16 * s + 8 * hh + 7]);
            qf[s] = __builtin_bit_cast(bf16x8, w);
        }
    }
    f32x16 sacc[5];
#pragma unroll
    for (int k5 = 0; k5 < 5; ++k5) {
        const int kt = th + k5;
        f32x16 acc = {};
#pragma unroll
        for (int s = 0; s < 4; ++s) { const bf16x8 af = *(const LAS bf16x8*)(Kl + (kt * 32 + r) * 72 + 16 * s + 8 * hh); acc = __builtin_amdgcn_mfma_f32_32x32x16_bf16(af, qf[s], acc, 0, 0, 0); }
        sacc[k5] = acc;
    }
    const float slope2 = exp2f(-(float)(hq + 1)) * LOG2E;
    const float sink2 = a.in[I_SINKS][hq] * LOG2E;
    float mx = sink2;
#pragma unroll
    for (int k5 = 0; k5 < 5; ++k5)
#pragma unroll
        for (int i = 0; i < 16; ++i) {
            const int row = (i & 3) + 8 * (i >> 2) + 4 * hh;
            const int dist = 128 - 32 * k5 + r - row;
            const int tk = w0 + 32 * (th + k5) + row;
            float s = sacc[k5][i] - slope2 * (float)dist;
            if (dist < 0 || dist >= 128 || tk < 0) s = -1e30f;
            sacc[k5][i] = s; mx = fmaxf(mx, s);
        }
    mx = fmaxf(mx, __shfl_xor(mx, 32));
    float l = 0.f;
#pragma unroll
    for (int k5 = 0; k5 < 5; ++k5)
#pragma unroll
        for (int i = 0; i < 16; ++i) { const float p = __builtin_amdgcn_exp2f(sacc[k5][i] - mx); sacc[k5][i] = p; l += p; }
    l += __shfl_xor(l, 32);
    l += exp2f(sink2 - mx);
    f32x16 oacc[2] = {{}, {}};
#pragma unroll
    for (int k5 = 0; k5 < 5; ++k5) {
        const int kt = th + k5;
#pragma unroll
        for (int s2 = 0; s2 < 2; ++s2) {
            u32x4 pw;
            pw.x = cvt_pk_bf16(sacc[k5][8 * s2 + 0], sacc[k5][8 * s2 + 1]); pw.y = cvt_pk_bf16(sacc[k5][8 * s2 + 2], sacc[k5][8 * s2 + 3]);
            pw.z = cvt_pk_bf16(sacc[k5][8 * s2 + 4], sacc[k5][8 * s2 + 5]); pw.w = cvt_pk_bf16(sacc[k5][8 * s2 + 6], sacc[k5][8 * s2 + 7]);
            const bf16x8 pf = __builtin_bit_cast(bf16x8, pw);
#pragma unroll
            for (int dt = 0; dt < 2; ++dt) {
                const LAS bf16_t* vp = Vt + (32 * dt + r) * 196 + kt * 32 + 16 * s2 + 4 * hh;
                const u32x2 v0 = *(const LAS u32x2*)vp, v1 = *(const LAS u32x2*)(vp + 8);
                const u32x4 vv = (u32x4){v0.x, v0.y, v1.x, v1.y};
                oacc[dt] = __builtin_amdgcn_mfma_f32_32x32x16_bf16(__builtin_bit_cast(bf16x8, vv), pf, oacc[dt], 0, 0, 0);
            }
        }
    }
    const float inv = 1.f / l;
#pragma unroll
    for (int dt = 0; dt < 2; ++dt)
#pragma unroll
        for (int q = 0; q < 4; ++q) {
            u32x2 w; w.x = cvt_pk_bf16(oacc[dt][4 * q] * inv, oacc[dt][4 * q + 1] * inv); w.y = cvt_pk_bf16(oacc[dt][4 * q + 2] * inv, oacc[dt][4 * q + 3] * inv);
            *(u32x2*)(mix + (size_t)t * D + 512 + hq * 64 + 32 * dt + 8 * q + 4 * hh) = w;
        }
    __syncthreads();
}
__device__ __forceinline__ void swa_decode_item(const KArgs& a, int item, int lane) {
    const int b = item >> 3, kvh = (item >> 2) & 1, g = item & 3, hq = kvh * 4 + g; const int row = SROW + b;
    const bf16_t* proj = (const bf16_t*)(a.ws + WS_BIG);
    bf16_t* mix = (bf16_t*)(a.ws + WS_R1);
    const float* ck = a.in[I_CK] + (size_t)b * 128 * 128 + kvh * 64;
    const float* cv = a.in[I_CV] + (size_t)b * 128 * 128 + kvh * 64;
    float qd = bf2f(proj[(size_t)row * NPROJ + PQB + hq * 64 + lane]);
    { const float ss = wave_sum(qd * qd); qd = qd * rsqrtf(ss * (1.0f / 64.f) + EPS) * a.in[I_QNORM][lane] * 0.125f; }
    float kd = bf2f(proj[(size_t)row * NPROJ + PKB + kvh * 64 + lane]);
    { const float ss = wave_sum(kd * kd); kd = kd * rsqrtf(ss * (1.0f / 64.f) + EPS) * a.in[I_KNORM][lane]; }
    const float vd = bf2f(proj[(size_t)row * NPROJ + PVB + kvh * 64 + lane]);
    const float slope = exp2f(-(float)(hq + 1));
    float s0 = 0.f, s1 = 0.f;
    {
        f32x4 k0[16], k1[16];
#pragma unroll
        for (int i = 0; i < 16; ++i) { k0[i] = *(const f32x4*)(ck + (size_t)lane * 128 + 4 * i); k1[i] = *(const f32x4*)(ck + (size_t)(lane + 64) * 128 + 4 * i); }
#pragma unroll
        for (int i = 0; i < 16; ++i) {
            const float q0 = __shfl(qd, 4 * i), q1 = __shfl(qd, 4 * i + 1), q2 = __shfl(qd, 4 * i + 2), q3 = __shfl(qd, 4 * i + 3);
            s0 += (q0 * k0[i][0] + q1 * k0[i][1]) + (q2 * k0[i][2] + q3 * k0[i][3]);
            s1 += (q0 * k1[i][0] + q1 * k1[i][1]) + (q2 * k1[i][2] + q3 * k1[i][3]);
        }
    }
    s0 -= slope * (float)(128 - lane); s1 -= slope * (float)(64 - lane);
    if (lane == 0) s0 = -1e30f;
    const float sn = wave_sum(qd * kd);
    const float sink = a.in[I_SINKS][hq];
    const float mx = fmaxf(fmaxf(wave_max(fmaxf(s0, s1)), sn), sink);
    const float p0 = __expf(s0 - mx), p1 = __expf(s1 - mx), pn = __expf(sn - mx);
    const float l = wave_sum(p0 + p1) + pn + __expf(sink - mx);
    float od = pn * vd;
#pragma unroll 1
    for (int w0 = 0; w0 < 64; w0 += 16) {
        float ca[16], cb[16];
#pragma unroll
        for (int j = 0; j < 16; ++j) { ca[j] = cv[(size_t)(w0 + j) * 128 + lane]; cb[j] = cv[(size_t)(w0 + j + 64) * 128 + lane]; }
#pragma unroll
        for (int j = 0; j < 16; ++j) { const float pa = __shfl(p0, w0 + j), pb = __shfl(p1, w0 + j); od += pa * ca[j] + pb * cb[j]; }
    }
    od /= l;
    const float oo = __shfl_down(od, 1);
    if ((lane & 1) == 0) *(unsigned*)(mix + (size_t)row * D + 512 + hq * 64 + lane) = cvt_pk_bf16(od, oo);
    {
        float* __restrict__ ko = a.out + O_SKS + (size_t)b * 128 * 128 + kvh * 64; float* __restrict__ vo = a.out + O_SVS + (size_t)b * 128 * 128 + kvh * 64;
        float ka[32], va[32];
#pragma unroll
        for (int j = 0; j < 32; ++j) { const int w = 32 * g + j + 1; ka[j] = (w < 128) ? ck[(size_t)w * 128 + lane] : kd; va[j] = (w < 128) ? cv[(size_t)w * 128 + lane] : vd; }
#pragma unroll
        for (int j = 0; j < 32; ++j) { ko[(size_t)(32 * g + j) * 128 + lane] = ka[j]; vo[(size_t)(32 * g + j) * 128 + lane] = va[j]; }
    }
}

template <int W>
__device__ __forceinline__ void pool_core(const bf16_t* __restrict__ h, const LAS float* rsL, const f32x4 gg, int r0, int half, int c4, bf16_t* __restrict__ d1, float* __restrict__ poolp) {
    const int rb = r0 + 8 * half;
    float xn[23][4];
#pragma unroll
    for (int i = 0; i < 23; ++i) { const int r = rb - 15 + i;
        u32x2 w = (u32x2){0u, 0u};
        if (i >= 16 - W && r >= 0) w = *(const u32x2*)(h + (size_t)r * D + c4);
        const float rs = rsL[8 * half + i];
        xn[i][0] = bf_lo(w.x) * rs * gg[0]; xn[i][1] = bf_hi(w.x) * rs * gg[1]; xn[i][2] = bf_lo(w.y) * rs * gg[2]; xn[i][3] = bf_hi(w.y) * rs * gg[3]; }
    float s[4] = {0.f, 0.f, 0.f, 0.f};
#pragma unroll
    for (int k = 1; k < W; ++k)
#pragma unroll
        for (int j = 0; j < 4; ++j) s[j] += xn[15 - k][j];
#pragma unroll
    for (int i = 0; i < 8; ++i) {
        const int r = rb + i;
        const int cnt = (r + 1 < W) ? r + 1 : W; const float ic = 1.0f / (float)cnt;
        float dd[4];
#pragma unroll
        for (int j = 0; j < 4; ++j) { s[j] += xn[15 + i][j]; dd[j] = s[j] * ic - xn[15 + i][j]; s[j] -= xn[15 + i - (W - 1)][j]; }
        u32x2 w; w.x = cvt_pk_bf16(dd[0], dd[1]); w.y = cvt_pk_bf16(dd[2], dd[3]);
        *(u32x2*)(d1 + (size_t)r * D + c4) = w;
        if (r >= SEQ - 15) *(f32x4*)(poolp + (size_t)(r - (SEQ - 15)) * D + c4) = (f32x4){xn[15 + i][0], xn[15 + i][1], xn[15 + i][2], xn[15 + i][3]};
    }
}
__device__ __forceinline__ void pool_item(const KArgs& a, LAS unsigned char* lds, int item, const float* part_in) {
    const int tid = otid();
    const bf16_t* h = (const bf16_t*)(a.ws + WS_R2 + 4096); bf16_t* d1 = (bf16_t*)(a.ws + WS_R1);
    LAS float* rsL = (LAS float*)lds;
    const int r0 = item * 16;
    __syncthreads();
    if (tid < 31) { const int r = r0 - 15 + tid; float rs = 0.f;
        if (r >= 0) { const f32x4 p0 = *(const f32x4*)(part_in + (long)r * 16), p1 = *(const f32x4*)(part_in + (long)r * 16 + 4), p2 = *(const f32x4*)(part_in + (long)r * 16 + 8), p3 = *(const f32x4*)(part_in + (long)r * 16 + 12);
            const float s = ((p0[0] + p0[1]) + (p0[2] + p0[3])) + ((p1[0] + p1[1]) + (p1[2] + p1[3])) + ((p2[0] + p2[1]) + (p2[2] + p2[3])) + ((p3[0] + p3[1]) + (p3[2] + p3[3]));
            rs = rsqrtf(s * (1.0f / D) + EPS); }
        rsL[tid] = rs; }
    __syncthreads();
    const int c4 = 4 * (tid & 255), half = tid >> 8; const int gq = __builtin_amdgcn_readfirstlane(c4 >> 8);
    const f32x4 gg = *(const f32x4*)(a.in[I_MNO] + c4);
    if (gq == 0) pool_core<2>(h, rsL, gg, r0, half, c4, d1, a.out + O_POOLP);
    else if (gq == 1) pool_core<4>(h, rsL, gg, r0, half, c4, d1, a.out + O_POOLP);
    else if (gq == 2) pool_core<8>(h, rsL, gg, r0, half, c4, d1, a.out + O_POOLP);
    else pool_core<16>(h, rsL, gg, r0, half, c4, d1, a.out + O_POOLP);
}
template <int W>
__device__ __forceinline__ void pool_tile_core(const LAS unsigned char* slab, const LAS float* rsL, const f32x4 gg, int pm, int rl0, int cq, int gq, bf16_t* __restrict__ d1, float* __restrict__ poolp) {
    float xn[23][4];
#pragma unroll
    for (int i = 0; i < 23; ++i) { const int sl = rl0 + i;
        u32x2 w = (u32x2){0u, 0u};
        if (i >= 16 - W) w = *(const LAS u32x2*)(slab + sl * 512 + cq * 8);
        const float rs = rsL[sl];
        xn[i][0] = bf_lo(w.x) * rs * gg[0]; xn[i][1] = bf_hi(w.x) * rs * gg[1]; xn[i][2] = bf_lo(w.y) * rs * gg[2]; xn[i][3] = bf_hi(w.y) * rs * gg[3]; }
    float s[4] = {0.f, 0.f, 0.f, 0.f};
#pragma unroll
    for (int k = 1; k < W; ++k)
#pragma unroll
        for (int j = 0; j < 4; ++j) s[j] += xn[15 - k][j];
    const int c4 = 256 * gq + 4 * cq;
#pragma unroll
    for (int i = 0; i < 8; ++i) {
        const int r = 256 * pm + rl0 + i;
        const int cnt = (r + 1 < W) ? r + 1 : W; const float ic = __builtin_amdgcn_rcpf((float)cnt);
        float dd[4];
#pragma unroll
        for (int j = 0; j < 4; ++j) { s[j] += xn[15 + i][j]; dd[j] = s[j] * ic - xn[15 + i][j]; s[j] -= xn[15 + i - (W - 1)][j]; }
        u32x2 w; w.x = cvt_pk_bf16(dd[0], dd[1]); w.y = cvt_pk_bf16(dd[2], dd[3]);
        *(u32x2*)(d1 + (size_t)r * D + c4) = w;
        if (r >= SEQ - 15) *(f32x4*)(poolp + (size_t)(r - (SEQ - 15)) * D + c4) = (f32x4){xn[15 + i][0], xn[15 + i][1], xn[15 + i][2], xn[15 + i][3]};
    }
}
__device__ __forceinline__ void pool_tile(const KArgs& a, LAS unsigned char* lds, int pm, int gq, const float* part_in) {
    const int tid = otid(), lane = tid & 63, wave = __builtin_amdgcn_readfirstlane(tid >> 6);
    const bf16_t* h = (const bf16_t*)(a.ws + WS_R2 + 4096); bf16_t* d1 = (bf16_t*)(a.ws + WS_R1);
    LAS float* rsL = (LAS float*)(lds + 140288);
    __syncthreads();
    for (int p = wave; p < 136; p += 8) {
        const int sl = 2 * p + (lane >> 5); int r = 256 * pm - 15 + sl; if (r < 0) r = 0; if (r > SEQ - 1) r = SEQ - 1;
        __builtin_amdgcn_global_load_lds((const unsigned*)(h + (size_t)r * D + 256 * gq + 8 * (lane & 31)), (LAS unsigned*)(lds + p * 1024), 16, 0, 0);
    }
    if (tid < 271) { const int r = 256 * pm - 15 + tid; float rs = 0.f;
        if (r >= 0) { const f32x4 p0 = *(const f32x4*)(part_in + (long)r * 16), p1 = *(const f32x4*)(part_in + (long)r * 16 + 4), p2 = *(const f32x4*)(part_in + (long)r * 16 + 8), p3 = *(const f32x4*)(part_in + (long)r * 16 + 12);
            const float s = ((p0[0] + p0[1]) + (p0[2] + p0[3])) + ((p1[0] + p1[1]) + (p1[2] + p1[3])) + ((p2[0] + p2[1]) + (p2[2] + p2[3])) + ((p3[0] + p3[1]) + (p3[2] + p3[3]));
            rs = rsqrtf(s * (1.0f / D) + EPS); }
        rsL[tid] = rs; }
    asm volatile("s_waitcnt vmcnt(0) lgkmcnt(0)" ::: "memory");
    __syncthreads();
    const int cq = lane;
    const f32x4 gg = *(const f32x4*)(a.in[I_MNO] + 256 * gq + 4 * cq);
#pragma unroll 1
    for (int st = 0; st < 4; ++st) {
        const int rl0 = 32 * wave + 8 * st;
        if (gq == 0) pool_tile_core<2>(lds, rsL, gg, pm, rl0, cq, gq, d1, a.out + O_POOLP);
        else if (gq == 1) pool_tile_core<4>(lds, rsL, gg, pm, rl0, cq, gq, d1, a.out + O_POOLP);
        else if (gq == 2) pool_tile_core<8>(lds, rsL, gg, pm, rl0, cq, gq, d1, a.out + O_POOLP);
        else pool_tile_core<16>(lds, rsL, gg, pm, rl0, cq, gq, d1, a.out + O_POOLP);
    }
}
__device__ __forceinline__ void pool_sample_item(const KArgs& a, LAS unsigned char* lds, int b, const float* part_in) {
    const int tid = otid();
    const bf16_t* __restrict__ h = (const bf16_t*)(a.ws + WS_R2 + 4096) + (size_t)(SROW + b) * D; bf16_t* __restrict__ d1 = (bf16_t*)(a.ws + WS_R1);
    const float* __restrict__ st = a.in[I_SPOOL] + (size_t)b * 15 * D; float* __restrict__ so = a.out + O_POOLS + (size_t)b * 15 * D;
    const float rs = s_row_rs(part_in, b);
#pragma unroll
    for (int cc = 0; cc < 2; ++cc) {
        const int c = tid + cc * NTHREADS; const int w = 2 << (c >> 8);
        float sv[15];
#pragma unroll
        for (int j = 0; j < 15; ++j) sv[j] = st[(size_t)j * D + c];
        const float xn = bf2f(h[c]) * rs * a.in[I_MNO][c];
        float sum = xn;
#pragma unroll
        for (int j = 0; j < 15; ++j) sum += (j >= 16 - w) ? sv[j] : 0.f;
        const float dd = sum / (float)w - xn;
        d1[(size_t)(SROW + b) * D + c] = (bf16_t)(cvt_pk_bf16(dd, 0.f) & 0xffffu);
#pragma unroll
        for (int j = 0; j < 14; ++j) so[(size_t)j * D + c] = sv[j + 1];
        so[(size_t)14 * D + c] = xn;
    }
}

#define XB_TMO      128
#define XB_XCNT(j)  (256  + 64 * (j))
#define XB_XSUB(j)  (1280 + 64 * (j))
#define XB_XGEN(j)  (2304 + 64 * (j))
#define XB_TOP      3328
#define XB_TOPGEN   3392
#define XCD_BAR_WORDS 3456
#define XB_SPIN_CAP (1u << 18)
__device__ __forceinline__ unsigned xb_ld(unsigned* p)              { return __hip_atomic_load(p, __ATOMIC_RELAXED, __HIP_MEMORY_SCOPE_AGENT); }
__device__ __forceinline__ unsigned xb_add(unsigned* p, unsigned v) { return __hip_atomic_fetch_add(p, v, __ATOMIC_RELAXED, __HIP_MEMORY_SCOPE_AGENT); }
__device__ __forceinline__ unsigned xb_xcc_id() { return (unsigned)__builtin_amdgcn_s_getreg((3 << 11) | 20) & 0xFu; }
#define XB_SPIN(cond, bar) do { unsigned _sp = 0; while (cond) { __builtin_amdgcn_s_sleep(1); \
    if ((++_sp & 255u) == 0u) { if (xb_ld(&(bar)[XB_TMO])) break; if (_sp > XB_SPIN_CAP) { atomicAdd(&(bar)[XB_TMO], 1u); break; } } } } while (0)
struct XcdBarrier { unsigned* bar; unsigned x; volatile LAS unsigned* st; };
__device__ __forceinline__ XcdBarrier xcd_barrier_post(unsigned* bar, volatile LAS unsigned* st) {
    XcdBarrier b; b.bar = bar; b.x = xb_xcc_id(); b.st = st;
    if (threadIdx.x == 0) (void)xb_add(&bar[XB_XCNT(b.x)], 1u);
    return b;
}
__device__ __forceinline__ void xcd_barrier_complete(unsigned* bar, unsigned x, unsigned& nloc, unsigned& nx) {
    const unsigned G = gridDim.x * gridDim.y * gridDim.z;
    unsigned sum, cnt, mine, sp = 0u;
    for (;;) {
        sum = 0u; cnt = 0u; mine = 0u;
#pragma unroll
        for (unsigned j = 0; j < 16; ++j) { const unsigned c = xb_ld(&bar[XB_XCNT(j)]); sum += c; cnt += (c > 0u) ? 1u : 0u; mine = (j == x) ? c : mine; }
        if (sum == G) break;
        __builtin_amdgcn_s_sleep(1);
        if ((++sp & 255u) == 0u) { if (xb_ld(&bar[XB_TMO])) break; if (sp > XB_SPIN_CAP) { atomicAdd(&bar[XB_TMO], 1u); break; } }
    }
    nloc = mine > 0u ? mine : 1u; nx = cnt > 0u ? cnt : 1u;
}
__device__ __forceinline__ void xcd_barrier(const XcdBarrier& b) {
    asm volatile("s_waitcnt vmcnt(0)" ::: "memory");
    __syncthreads();
    if (threadIdx.x == 0) {
        unsigned* bar = b.bar;
        __builtin_amdgcn_s_waitcnt(0);
        unsigned nloc = b.st[0], nx = b.st[1];
        if (nloc == 0u) { xcd_barrier_complete(bar, b.x, nloc, nx); b.st[0] = nloc; b.st[1] = nx; }
        const unsigned old = xb_add(&bar[XB_XSUB(b.x)], 1u);
        const unsigned gen = old / nloc;
        if (old + 1u == (gen + 1u) * nloc) {
            __builtin_amdgcn_fence(__ATOMIC_RELEASE, "agent");
            asm volatile("s_waitcnt vmcnt(0)" ::: "memory");
            const unsigned og = xb_add(&bar[XB_TOP], 1u);
            const unsigned tg = og / nx;
            if (og + 1u == (tg + 1u) * nx) xb_add(&bar[XB_TOPGEN], 1u);
            else XB_SPIN(xb_ld(&bar[XB_TOPGEN]) == tg, bar);
            __builtin_amdgcn_fence(__ATOMIC_ACQUIRE, "agent");
            xb_add(&bar[XB_XGEN(b.x)], 1u);
            asm volatile("s_waitcnt vmcnt(0)" ::: "memory");
        } else {
            XB_SPIN(xb_ld(&bar[XB_XGEN(b.x)]) == gen, bar);
            __builtin_amdgcn_fence(__ATOMIC_ACQUIRE, "agent");
            asm volatile("s_waitcnt vmcnt(0)" ::: "memory");
        }
    }
    __syncthreads();
}

#ifndef DUPM
#define DUPM 0
#endif
#ifndef SYNCREP
#define SYNCREP 1
#endif
#if defined(PROBE_T)
#define TSTAMP() do { if (stamp_i == PROBE_T) t_a = __builtin_amdgcn_s_memrealtime(); if (stamp_i == PROBE_T + 1) t_b = __builtin_amdgcn_s_memrealtime(); ++stamp_i; } while (0)
#else
#define TSTAMP() do { } while (0)
#endif
#define GSYNC() do { _Pragma("unroll 1") for (int sr_ = 0; sr_ < SYNCREP; ++sr_) xcd_barrier(xbar); TSTAMP(); } while (0)
#define PH(k) _Pragma("unroll 1") for (int rep_ = 0; rep_ < (((DUPM) >> (k)) & 1) + 1; ++rep_)
__global__ void __launch_bounds__(NTHREADS, 2) mega_fwd(KArgs a) {
    extern __shared__ __attribute__((aligned(16))) unsigned char lds_raw[];
    LAS unsigned char* lds = (LAS unsigned char*)lds_raw;
    cg::grid_group grid = cg::this_grid();
    const int G = gridDim.x, bx = blockIdx.x;
    const int vcu = (G % 8 == 0) ? (bx % 8) * (G / 8) + bx / 8 : bx;
    unsigned char* ws = a.ws;
    if (ws == nullptr) grid.sync();
    volatile LAS unsigned* xst = (volatile LAS unsigned*)(lds + LDS_BYTES - 64);
    if (threadIdx.x < 16) xst[threadIdx.x] = 0u;
    __syncthreads();
    const XcdBarrier xbar = xcd_barrier_post((unsigned*)(ws + 16384), xst);
    bf16_t* R1 = (bf16_t*)(ws + WS_R1); bf16_t* R2 = (bf16_t*)(ws + WS_R2 + 4096);
    bf16_t* BIGB = (bf16_t*)(ws + WS_BIG);
    const bf16_t* pbf = (const bf16_t*)(ws + WS_PBF);

#if defined(PROBE_T)
    int stamp_i = 0; unsigned long long t_a = 0, t_b = 0;
    TSTAMP();
#endif
#if defined(PROBE_SUB) || defined(PROBE_P2) || defined(PROBE_P1) || defined(PROBE_E)
    unsigned long long sub_d = 0;
#endif
#ifndef NPASS
#define NPASS 1
#endif
#pragma unroll 1
    for (int pass_ = 0; pass_ < NPASS; ++pass_) {
    if (pass_ > 0) GSYNC();
    PH(0) p0_prologue(a, lds, vcu, G);
    GSYNC();
    PH(1) {
        pg8::Gemm g{R1, (const bf16_t*)(ws + WS_WIN0), 1024, 1024, 1024, 256, 0, 0};
        pg8::StaticOrder S; S.init(64, 10, G, bx);
        EpiProj E{BIGB, (float*)(ws + WS_BIG + BIG_LA), (const float*)(ws + WS_SSQ), a.in[I_BALPHA]};
#if defined(PROBE_P1)
        unsigned long long tq0 = __builtin_amdgcn_s_memrealtime();
#endif
        pg8::gemm_phase(lds, g, S, E);
#if defined(PROBE_P1)
        sub_d = __builtin_amdgcn_s_memrealtime() - tq0;
#endif
        if (bx >= (640 % G)) s_proj_units(a, lds, bx - (640 % G), G - (640 % G));
        if (bx >= (640 % G)) { const int wv = __builtin_amdgcn_readfirstlane(otid() >> 6); __syncthreads(); p3_convert(a, lds, (bx - (640 % G)) * 8 + wv, (G - (640 % G)) * 8, 0, CONV_SPLIT, false); }
#if defined(PROBE_P1)
        if (PROBE_P1 == 1) sub_d = __builtin_amdgcn_s_memrealtime() - tq0;
#endif
    }
    GSYNC();
#if defined(PROBE_P2)
    unsigned long long tp0 = __builtin_amdgcn_s_memrealtime();
#endif
    PH(2) for (int it = vcu; it < 256; it += G) gla_item_m<false>(a, lds, it);
#if defined(PROBE_P2)
    unsigned long long tp1 = __builtin_amdgcn_s_memrealtime();
#endif
    PH(3) for (int it = vcu; it < 512; it += G) swa_unit_m(a, lds, it);
#if defined(PROBE_P2)
    unsigned long long tp2 = __builtin_amdgcn_s_memrealtime();
#endif
    PH(4) { const int tid = otid(), lane = tid & 63, wave = __builtin_amdgcn_readfirstlane(tid >> 6); for (int it = vcu + G * wave; it < 512; it += G * 8) gla_decode_item(a, it, lane); }
    PH(5) { const int tid = otid(), lane = tid & 63, wave = __builtin_amdgcn_readfirstlane(tid >> 6); for (int it = vcu + G * ((wave + 6) & 7); it < 1024; it += G * 8) swa_decode_item(a, it, lane); }
#if defined(PROBE_P2)
    { unsigned long long tp3 = __builtin_amdgcn_s_memrealtime(); sub_d = (PROBE_P2 == 0) ? tp1 - tp0 : (PROBE_P2 == 1) ? tp2 - tp1 : tp3 - tp2; }
#endif
    GSYNC();
    PH(6) { gla_scan_m(a, vcu); const int wv = __builtin_amdgcn_readfirstlane(otid() >> 6); if (wv >= 2) p3_convert(a, lds, vcu * 6 + (wv - 2), G * 6, CONV_SPLIT, CONV_ITEMS, true); }
    GSYNC();
    PH(7) for (int it = vcu; it < 256; it += G) gla_item_m<true>(a, lds, it);
    GSYNC();
    PH(8) {
        pg8::Gemm g{R1, (const bf16_t*)(ws + WS_WOUT0), 1024, 1024, 1024, 256, 0, 0};
        pg8::StaticOrder S; S.init(64, 4, G, bx);
        EpiRes<0, true, true, false> E{a.out, a.in[I_XP], nullptr, R2, part_tab(ws, 0), nullptr, nullptr, nullptr};
        pg8::gemm_phase(lds, g, S, E);
        s_res_units<0, 1024, 1024>(a, lds, bx, G, R1, (const bf16_t*)(ws + WS_WOUT0), nullptr, R2, spart_tab(ws, 0));
    }
#if defined(PROBE_FFNK)
    {
        pg8::Gemm g{R2, (const bf16_t*)(ws + WS_WFFI), 1024, 1024, 1024, 254, -2, 0};
        pg8::StaticOrder S; S.init(65, 22, G, bx);
#if PROBE_FFNK == 1
        EpiNull E{};
#elif PROBE_FFNK == 2
        EpiStoreOnly<0> E{R1};
#else
        EpiStoreOnly<1> E{R1};
#endif
        pg8::gemm_phase(lds, g, S, E);
    }
#endif
#if defined(PROBE_KLOOP)
    {
        pg8::Gemm g{R1, (const bf16_t*)(ws + WS_WOUT0), 1024, 1024, 1024, 256, 0, 0};
        pg8::StaticOrder S; S.init(64, 4, G, bx);
#if PROBE_KVAR == 1
        EpiStoreOnly<0> E{R1};
#elif PROBE_KVAR == 2
        EpiRes<1, true, false, false> E{a.out, nullptr, R2, R1, nullptr, nullptr, nullptr, nullptr};
#else
        EpiNull E{};
#endif
        for (int rep = 0; rep < PROBE_KLOOP; ++rep) pg8::gemm_phase(lds, g, S, E);
    }
#endif
    GSYNC();
#pragma unroll 1
    for (int l = 0; l < 2; ++l) {
        bf16_t* G_ = BIGB;
        bf16_t* PPb = BIGB;
        PH(9) {
            pg8::Gemm g{R2, (const bf16_t*)(ws + WS_WFFI + l * WFFI_BYTES), 1024, 1024, 1024, 254, -2, 0};
            pg8::StaticOrder S; S.init(65, 22, G, bx);
            EpiFfn E{part_tab(ws, l == 0 ? 0 : 3), a.in[I_FCW] + (size_t)l * 3 * DFF, a.in[I_FCB] + (size_t)l * DFF, a.out + O_CONVP + (size_t)l * 2 * DFF, G_};
            pg8::gemm_phase(lds, g, S, E);
            if (bx >= (1430 % G)) s_ffn_units(a, lds, bx - (1430 % G), G - (1430 % G), l, R2, spart_tab(ws, l == 0 ? 0 : 3));
        }
        GSYNC();
        PH(10) {
            pg8::Gemm g{G_, (const bf16_t*)(ws + WS_WFFO + l * WFFO_BYTES), DFF, DFF, DFF, 256, 0, 0};
            pg8::StaticOrder S; S.init(64, 4, G, bx);
            EpiRes<1, true, true, false> E{a.out, nullptr, R2, R1, part_tab(ws, l == 0 ? 1 : 4), nullptr, nullptr, nullptr};
#if defined(PROBE_SUB)
            unsigned long long ts0 = __builtin_amdgcn_s_memrealtime();
#endif
            pg8::gemm_phase(lds, g, S, E);
#if defined(PROBE_SUB)
            unsigned long long ts1 = __builtin_amdgcn_s_memrealtime();
#endif
            s_res_units<1, DFF, DFF>(a, lds, bx, G, G_, (const bf16_t*)(ws + WS_WFFO + l * WFFO_BYTES), R2, R1, spart_tab(ws, l == 0 ? 1 : 4));
#if defined(PROBE_SUB)
            unsigned long long ts2 = __builtin_amdgcn_s_memrealtime();
            xcd_barrier(xbar);
            unsigned long long ts3 = __builtin_amdgcn_s_memrealtime();
            if (l == 0) { sub_d = (PROBE_SUB == 0) ? ts1 - ts0 : (PROBE_SUB == 1) ? ts2 - ts1 : ts3 - ts2; }
#endif
        }
#if !defined(PROBE_SUB)
        GSYNC();
#endif
        PH(11) {
            pg8::Gemm g{pbf + (size_t)l * MT * PLE, (const bf16_t*)(ws + WS_WPROJ + l * WPROJ_BYTES), PLE, PLE, PLE, 256, 0, 0};
            pg8::StaticOrder S; S.init(64, 4, G, bx);
            EpiPP E{PPb};
#if defined(PROBE_E)
            unsigned long long te0 = __builtin_amdgcn_s_memrealtime();
#endif
            pg8::gemm_phase(lds, g, S, E);
#if defined(PROBE_E)
            if (l == 0 && PROBE_E == 0) sub_d = __builtin_amdgcn_s_memrealtime() - te0;
#endif
        }
        PH(12) {
            pg8::Gemm g{R1, (const bf16_t*)(ws + WS_WGATE + l * WGATE_BYTES), 1024, 1024, 1024, 256, 0, 0};
            pg8::StaticOrder S; S.init(64, 4, G, bx);
#if defined(PROBE_E)
            unsigned long long te1 = __builtin_amdgcn_s_memrealtime();
#endif
            if (l == 0) { EpiRes<2, true, true, false> E{a.out, nullptr, R1, R2, part_tab(ws, 2), part_tab(ws, 1), PPb, nullptr}; pg8::gemm_phase(lds, g, S, E);
#if defined(PROBE_E)
                if (PROBE_E == 1) sub_d = __builtin_amdgcn_s_memrealtime() - te1;
                te1 = __builtin_amdgcn_s_memrealtime();
#endif
                s_ple_units<false>(a, lds, bx, G, pbf, (const bf16_t*)(ws + WS_WPROJ), R1, (const bf16_t*)(ws + WS_WGATE), spart_tab(ws, 1), spart_tab(ws, 2), R2);
#if defined(PROBE_E)
                if (PROBE_E == 2) sub_d = __builtin_amdgcn_s_memrealtime() - te1;
#endif
            }
            else { EpiRes<2, false, false, true> E{a.out, nullptr, R1, nullptr, nullptr, part_tab(ws, 4), PPb, nullptr}; pg8::gemm_phase(lds, g, S, E);
                s_ple_units<true>(a, lds, bx, G, pbf + (size_t)MT * PLE, (const bf16_t*)(ws + WS_WPROJ + WPROJ_BYTES), R1, (const bf16_t*)(ws + WS_WGATE + WGATE_BYTES), spart_tab(ws, 4), nullptr, nullptr); }
        }
        if (l == 0) {
            GSYNC();
            PH(13) { for (int it = vcu; it < NS; it += G) pool_sample_item(a, lds, it, spart_tab(ws, 2));
                     for (int it = vcu; it < 256; it += G) pool_tile(a, lds, it >> 2, it & 3, part_tab(ws, 2)); }
            GSYNC();
            PH(14) {
                pg8::Gemm g{R1, (const bf16_t*)(ws + WS_WPOOL), 1024, 256, 256, 256, 0, 256};
                pg8::StaticOrder S; S.init(64, 4, G, bx);
                EpiRes<3, true, true, false> E{a.out, nullptr, R2, R2, part_tab(ws, 3), nullptr, nullptr, a.in[I_POOLSC]};
                pg8::gemm_phase(lds, g, S, E);
                s_res_units<3, 256, 1024>(a, lds, bx, G, R1, (const bf16_t*)(ws + WS_WPOOL), R2, R2, spart_tab(ws, 3));
            }
            GSYNC();
        }
    }
    }
#if defined(PROBE_SUB) || defined(PROBE_P2) || defined(PROBE_P1) || defined(PROBE_E)
    if (blockIdx.x == PROBE_BLK && threadIdx.x == 0) { const unsigned long long t_end = __builtin_amdgcn_s_memrealtime() + sub_d; while (__builtin_amdgcn_s_memrealtime() < t_end) __builtin_amdgcn_s_sleep(8); }
#endif
#if defined(PROBE_T)
    TSTAMP();
    if (blockIdx.x == 0 && threadIdx.x == 0) { const unsigned long long t_end = __builtin_amdgcn_s_memrealtime() + (t_b - t_a); while (__builtin_amdgcn_s_memrealtime() < t_end) __builtin_amdgcn_s_sleep(8); }
#endif
}

extern "C" void kernel_launch(void* const* d_in, const int* in_sizes, int n_in, void* d_out, int out_size, void* d_ws, size_t ws_size, hipStream_t stream) {
    static int grid = 0;
    if (grid == 0) {
        int dev = 0, cus = 0, per_cu = 0;
        hipGetDevice(&dev);
        hipDeviceGetAttribute(&cus, hipDeviceAttributeMultiprocessorCount, dev);
        hipFuncSetAttribute((const void*)mega_fwd, hipFuncAttributeMaxDynamicSharedMemorySize, LDS_BYTES);
        hipOccupancyMaxActiveBlocksPerMultiprocessor(&per_cu, (const void*)mega_fwd, NTHREADS, LDS_BYTES);
        if (per_cu < 1) { fprintf(stderr, "kernel_launch: occupancy query reports %d blocks per CU\n", per_cu); per_cu = 1; }
        if (per_cu > 1) per_cu = 1;
        grid = cus * per_cu;
        (void)hipGetLastError();
    }
    (void)hipMemsetAsync(d_ws, 0, 65536, stream);
    KArgs a{};
    for (int i = 0; i < 29; ++i) a.in[i] = (const float*)d_in[i];
    a.out = (float*)d_out; a.ws = (unsigned char*)d_ws;
    void* args[] = {&a};
    hipError_t e = hipLaunchCooperativeKernel((const void*)mega_fwd, dim3(grid), dim3(NTHREADS), args, LDS_BYTES, stream);
#if defined(PROBE_TWICE)
    (void)hipMemsetAsync(d_ws, 0, 65536, stream);
    e = hipLaunchCooperativeKernel((const void*)mega_fwd, dim3(grid), dim3(NTHREADS), args, LDS_BYTES, stream);
#endif
    if (e != hipSuccess) fprintf(stderr, "cooperative launch failed: %s (grid %d)\n", hipGetErrorString(e), grid);
}
```

```cpp
#include <hip/hip_runtime.h>
#include <hip/hip_cooperative_groups.h>
#include <cstdio>
#include <cstdint>
namespace cg = cooperative_groups;

#define LAS __attribute__((address_space(3)))
typedef unsigned short bf16_t;
typedef short bf16x8 __attribute__((ext_vector_type(8)));
typedef float f32x4 __attribute__((ext_vector_type(4)));
typedef float f32x2 __attribute__((ext_vector_type(2)));
typedef unsigned u32x4 __attribute__((ext_vector_type(4)));
typedef unsigned u32x2 __attribute__((ext_vector_type(2)));
typedef float f32x16 __attribute__((ext_vector_type(16)));

constexpr int D = 1024, SEQ = 16384, NS = 128, DFF = 2816, PLE = 256;
constexpr int SROW = 16510;
constexpr int MT = 16640;
constexpr int MR = 16768;
constexpr int NPROJ = 2304;
constexpr int PQA = 0, PKA = 256, PVA = 512, PRA = 1024, PQB = 1536, PKB = 2048, PVB = 2176;
constexpr float EPS = 1e-6f;
constexpr int NTHREADS = 512;

constexpr size_t O_YP = 0, O_YS = 16777216, O_GLAP = 16908288, O_SKP = 16941056, O_SVP = 16957440, O_POOLP = 16973824, O_CONVP = 16989184,
                 O_GLAS = 17000448, O_SKS = 21194752, O_SVS = 23291904, O_POOLS = 25389056, O_CONVS = 27355136;

constexpr size_t MiB = 1u << 20;
constexpr size_t WS_WIN0 = 1 * MiB, WS_WOUT0 = 6 * MiB, WS_WFFI = 8 * MiB, WS_WFFO = 30 * MiB, WS_WGATE = 41 * MiB, WS_WPROJ = 45 * MiB, WS_WPOOL = 46 * MiB;
constexpr size_t WS_SSQ = 47 * MiB;
constexpr size_t WS_PBF = 55 * MiB, WS_R1 = 72 * MiB, WS_R2 = 105 * MiB, WS_BIG = 138 * MiB;
constexpr size_t PART_STRIDE = (size_t)(MR + 8) * 16 * 4;
constexpr size_t WFFI_BYTES = (size_t)5632 * 1024 * 2, WFFO_BYTES = (size_t)1024 * 2816 * 2, WGATE_BYTES = (size_t)1024 * 1024 * 2, WPROJ_BYTES = (size_t)1024 * 256 * 2;
constexpr size_t BIG_LA = (size_t)MT * NPROJ * 2;
constexpr int LDS_BYTES = 155648;

#ifndef NT_STORES
#define NT_STORES 0
#endif
typedef unsigned u32x4_fwd __attribute__((ext_vector_type(4)));
#if NT_STORES == 2
__device__ __forceinline__ void st16_sc1(void* p, u32x4_fwd v);
#define ST16(p, v) st16_sc1((void*)(p), (v))
#elif NT_STORES
#define ST16(p, v) __builtin_nontemporal_store((v), (p))
#else
#define ST16(p, v) (*(p) = (v))
#endif
#if NT_STORES == 2
__device__ __forceinline__ void st16_sc1(void* p, u32x4_fwd v) { asm volatile("global_store_dwordx4 %0, %1, off sc1\n\ts_nop 1" :: "v"(p), "v"(v) : "memory"); }
#endif
__device__ __forceinline__ unsigned cvt_pk_bf16(float lo, float hi) { unsigned r; asm volatile("v_cvt_pk_bf16_f32 %0, %1, %2" : "=v"(r) : "v"(lo), "v"(hi)); return r; }
__device__ __forceinline__ float bf_lo(unsigned w) { return __uint_as_float(w << 16); }
__device__ __forceinline__ float bf_hi(unsigned w) { return __uint_as_float(w & 0xffff0000u); }
__device__ __forceinline__ float bf2f(bf16_t v) { return __uint_as_float(((unsigned)v) << 16); }
__device__ __forceinline__ void unpack8(const u32x4 w, float* f) { f[0] = bf_lo(w.x); f[1] = bf_hi(w.x); f[2] = bf_lo(w.y); f[3] = bf_hi(w.y); f[4] = bf_lo(w.z); f[5] = bf_hi(w.z); f[6] = bf_lo(w.w); f[7] = bf_hi(w.w); }
__device__ __forceinline__ float wave_sum(float v) {
#pragma unroll
    for (int o = 1; o < 64; o <<= 1) v += __shfl_xor(v, o);
    return v;
}
__device__ __forceinline__ float wave_max(float v) {
#pragma unroll
    for (int o = 1; o < 64; o <<= 1) v = fmaxf(v, __shfl_xor(v, o));
    return v;
}
__device__ __forceinline__ int otid() { int t = threadIdx.x; asm volatile("" : "+v"(t)); return t; }
__device__ __forceinline__ bool row_valid(int row) { return row < SEQ || (row >= SROW && row < SROW + NS); }
__device__ __forceinline__ float* hrow_ptr(float* out, int row) { return row < SEQ ? out + O_YP + (size_t)row * D : out + O_YS + (size_t)(row - SROW) * D; }
__device__ __forceinline__ f32x2 gelu_pk(f32x2 v) {
    const f32x2 av = __builtin_elementwise_abs(v), d = av * 0.2316418882f + 1.0f;
    f32x2 t; t.x = __builtin_amdgcn_rcpf(d.x); t.y = __builtin_amdgcn_rcpf(d.y);
    f32x2 q = t * 0.5307027145f + (-0.7265760135f); q = q * t + 0.7107068705f; q = q * t + (-0.142248368f); q = q * t + 0.127414796f; q = q * t;
    const f32x2 s = (v * v) * (-0.72134752044f);
    f32x2 e; e.x = __builtin_amdgcn_exp2f(s.x); e.y = __builtin_amdgcn_exp2f(s.y);
    const f32x2 m = v * (q * e), r = v - m;
    f32x2 o; o.x = v.x < 0.f ? m.x : r.x; o.y = v.y < 0.f ? m.y : r.y; return o;
}

namespace pg8 {
constexpr int BM = 256, BK = 64, HALF = 128, HTB = HALF * BK * 2, STAGE_BYTES = 8 * HTB, NXCD = 8, WGM = 8;
__host__ __device__ __forceinline__ int lds_byte(int r, int c) { const int st = (r >> 4) * 2 + (c >> 5), rr = r & 15, cc = c & 31, ob = rr * 64 + cc * 2; return st * 1024 + (ob ^ (((ob >> 9) & 1) << 5)); }
__host__ __device__ __forceinline__ void stage_rc(int b, int& R, int& C) { const int st = b / 1024, sb = b % 1024, swz = sb ^ (((sb >> 9) & 1) << 5); R = (st >> 1) * 16 + swz / 64; C = (st & 1) * 32 + (swz % 64) / 2; }
__host__ __device__ __forceinline__ int perm32(int rho) { const int n = rho >> 4, i = rho & 15; return 8 * (i >> 2) + 4 * n + (i & 3); }

struct Unit { int pm, pn; };
struct Gemm { const bf16_t* A; const bf16_t* Bt; int lda, ldb, K, mstride, arow0, acolstep; };

struct StaticOrder {
    int nM, nN, nwg, G, c;
    __device__ void init(int nM_, int nN_, int G_, int c_) { nM = nM_; nN = nN_; nwg = nM * nN; G = G_; c = c_; }
    __device__ bool next(int i, Unit& u) const {
        const long L = (long)i * G + c; if (L >= nwg) return false;
        int wgid = (int)L; { const int q = nwg / NXCD, r = nwg % NXCD, xcd = wgid % NXCD, off = wgid / NXCD; wgid = (xcd < r ? xcd * (q + 1) : r * (q + 1) + (xcd - r) * q) + off; }
        const int nig = WGM * nN, gid = wgid / nig, fm = gid * WGM, gsz = (nM - fm) < WGM ? (nM - fm) : WGM;
        u.pm = fm + ((wgid % nig) % gsz); u.pn = (wgid % nig) / gsz; return true;
    }
};

template <class Epi>
__device__ __forceinline__ void gemm_phase(LAS unsigned char* lds, const Gemm g, const StaticOrder& S, const Epi& E) {
    const int tid = otid(), wid = __builtin_amdgcn_readfirstlane(tid >> 6), lane = tid & 63, wr = wid >> 2, wc = wid & 3, fr = lane & 15, fq = lane >> 4;
    const int K = g.K, nt = K / BK;
    unsigned voffA[2], voffB[2];
#pragma unroll
    for (int i = 0; i < 2; ++i) { int R, C; stage_rc(tid * 16 + i * 8192, R, C); const int Rb = (R & ~31) + perm32(R & 31);
        voffA[i] = (unsigned)(R * g.lda + C) * 2u; voffB[i] = (unsigned)(Rb * g.ldb + C) * 2u; }
    const size_t kstep = (size_t)(BK * 2);
    const size_t hstepA = (size_t)HALF * g.lda * 2, hstepB = (size_t)HALF * g.ldb * 2;
    const unsigned ldsw = (unsigned)wid * 1024u;
    const int aoff = lds_byte(wr * 64 + fr, fq * 8), boff = lds_byte(wc * 32 + fr, fq * 8);
#define PG8_SA(b, h) (((b) * 2 + (h)) * HTB)
#define PG8_SB(b, h) ((4 + (b) * 2 + (h)) * HTB)
#define PG8_STAGE(bufoff, gbase, voff) do { _Pragma("unroll") for (int _i = 0; _i < 2; ++_i) \
        __builtin_amdgcn_global_load_lds((const unsigned*)((const char*)(gbase) + (voff)[_i]), (LAS unsigned*)(lds + (bufoff) + ldsw + _i * 8192), 16, 0, 0); } while (0)
#define PG8_LDA(dst, b, h) do { _Pragma("unroll") for (int m = 0; m < 4; ++m) _Pragma("unroll") for (int k = 0; k < 2; ++k) dst[m][k] = *(const LAS bf16x8*)(lds + PG8_SA(b, h) + aoff + m * 2048 + k * 1024); } while (0)
#define PG8_LDB(dst, b, h) do { _Pragma("unroll") for (int n = 0; n < 2; ++n) _Pragma("unroll") for (int k = 0; k < 2; ++k) dst[n][k] = *(const LAS bf16x8*)(lds + PG8_SB(b, h) + boff + n * 2048 + k * 1024); } while (0)
#define PG8_MMA(ai, bj, At, Bt) do { __builtin_amdgcn_s_setprio(1); _Pragma("unroll") for (int m = 0; m < 4; ++m) _Pragma("unroll") for (int n = 0; n < 2; ++n) _Pragma("unroll") for (int k = 0; k < 2; ++k) \
        acc[ai][bj][m][n] = __builtin_amdgcn_mfma_f32_16x16x32_bf16(Bt[n][k], At[m][k], acc[ai][bj][m][n], 0, 0, 0); __builtin_amdgcn_s_setprio(0); } while (0)
#define PG8_WAIT_V(n) asm volatile("s_waitcnt vmcnt(" #n ")" ::: "memory")
#define PG8_WAIT_L(n) asm volatile("s_waitcnt lgkmcnt(" #n ")" ::: "memory")
#define PG8_BAR __builtin_amdgcn_s_barrier()
#define PG8_SCHED __builtin_amdgcn_sched_barrier(0)
#define PG8_ABASE(u) ((const char*)g.A + ((long)((long)(u).pm * g.mstride + g.arow0) * g.lda + (long)(u).pn * g.acolstep) * 2)
#define PG8_BBASE(u) ((const char*)g.Bt + (size_t)(u).pn * 256 * g.ldb * 2)
    Unit cur, nxt; int ui = 0;
    if (!S.next(0, cur)) return;
    f32x4 acc[2][2][4][2];
#pragma unroll
    for (int a = 0; a < 2; ++a)
#pragma unroll
        for (int b = 0; b < 2; ++b)
#pragma unroll
            for (int m = 0; m < 4; ++m)
#pragma unroll
                for (int n = 0; n < 2; ++n) acc[a][b][m][n] = (f32x4){0.f, 0.f, 0.f, 0.f};
    bf16x8 At[4][2], B0[2][2], B1[2][2];
    const char* cA = PG8_ABASE(cur); const char* cB = PG8_BBASE(cur);
    PG8_STAGE(PG8_SB(0, 0), cB, voffB); PG8_STAGE(PG8_SB(0, 1), cB + hstepB, voffB); PG8_STAGE(PG8_SA(0, 0), cA, voffA); PG8_STAGE(PG8_SA(0, 1), cA + hstepA, voffA);
    if (wr == 1) PG8_BAR;
    PG8_WAIT_V(2); PG8_BAR;
    PG8_STAGE(PG8_SB(1, 0), cB + kstep, voffB); PG8_STAGE(PG8_SA(1, 0), cA + kstep, voffA); PG8_STAGE(PG8_SB(1, 1), cB + hstepB + kstep, voffB);
    PG8_WAIT_V(6); PG8_BAR;
    for (;;) {
        const bool has_next = S.next(ui + 1, nxt);
        const char* nA = has_next ? PG8_ABASE(nxt) : cA; const char* nB = has_next ? PG8_BBASE(nxt) : cB;
#pragma unroll 1
        for (int t = 0; t < nt; t += 2) {
            const bool last = (t == nt - 2);
            const char* a1 = cA + (size_t)(t + 1) * kstep;
            const char* a2 = last ? nA : cA + (size_t)(t + 2) * kstep; const char* b2 = last ? nB : cB + (size_t)(t + 2) * kstep;
            const char* a3 = a2 + kstep; const char* b3 = b2 + kstep;
            PG8_LDB(B0, 0, 0); PG8_LDB(B1, 0, 1); PG8_SCHED; PG8_LDA(At, 0, 0); PG8_STAGE(PG8_SA(1, 1), a1 + hstepA, voffA);
            PG8_WAIT_V(8); PG8_WAIT_L(0); PG8_BAR; PG8_MMA(0, 0, At, B0); PG8_MMA(0, 1, At, B1); PG8_BAR; PG8_SCHED;
            PG8_LDA(At, 0, 1); PG8_STAGE(PG8_SB(0, 0), b2, voffB); PG8_STAGE(PG8_SB(0, 1), b2 + hstepB, voffB); PG8_STAGE(PG8_SA(0, 0), a2, voffA);
            PG8_WAIT_V(8); PG8_WAIT_L(0); PG8_BAR; PG8_MMA(1, 0, At, B0); PG8_MMA(1, 1, At, B1); PG8_BAR; PG8_SCHED;
            PG8_LDB(B0, 1, 0); PG8_LDB(B1, 1, 1); PG8_SCHED; PG8_LDA(At, 1, 0); PG8_STAGE(PG8_SA(0, 1), a2 + hstepA, voffA);
            PG8_WAIT_V(8); PG8_WAIT_L(0); PG8_BAR; PG8_MMA(0, 0, At, B0); PG8_MMA(0, 1, At, B1); PG8_BAR; PG8_SCHED;
            PG8_LDA(At, 1, 1); PG8_STAGE(PG8_SB(1, 0), b3, voffB); PG8_STAGE(PG8_SB(1, 1), b3 + hstepB, voffB); PG8_STAGE(PG8_SA(1, 0), a3, voffA);
            PG8_WAIT_V(8); PG8_WAIT_L(0); PG8_BAR; PG8_MMA(1, 0, At, B0); PG8_MMA(1, 1, At, B1); PG8_BAR; PG8_SCHED;
        }
        if (wr == 0) PG8_BAR;
        { int lane2 = lane; asm volatile("" : "+v"(lane2)); E(acc, cur, wr, wc, lane2 & 15, lane2 >> 4, lds + STAGE_BYTES); }
        if (!has_next) break;
#pragma unroll
        for (int a = 0; a < 2; ++a)
#pragma unroll
            for (int b = 0; b < 2; ++b)
#pragma unroll
                for (int m = 0; m < 4; ++m)
#pragma unroll
                    for (int n = 0; n < 2; ++n) acc[a][b][m][n] = (f32x4){0.f, 0.f, 0.f, 0.f};
        cur = nxt; cA = nA; cB = nB; ++ui;
        if (wr == 1) PG8_BAR;
    }
    PG8_WAIT_V(0);
    PG8_BAR;
#undef PG8_SA
#undef PG8_SB
#undef PG8_STAGE
#undef PG8_LDA
#undef PG8_LDB
#undef PG8_MMA
#undef PG8_WAIT_V
#undef PG8_WAIT_L
#undef PG8_BAR
#undef PG8_SCHED
#undef PG8_ABASE
#undef PG8_BBASE
}
}
using pg8::Unit;
typedef f32x4 AccT[2][2][4][2];

__device__ __forceinline__ float row_rs(const float* part, int row, int fq) {
    const f32x4 p = *(const f32x4*)(part + (long)row * 16 + fq * 4);
    float s = (p[0] + p[1]) + (p[2] + p[3]);
    s += __shfl_xor(s, 16); s += __shfl_xor(s, 32);
    return rsqrtf(s * (1.0f / D) + EPS);
}

struct EpiProj {
    bf16_t* proj; float* la; const float* ssq0; const float* b_alpha;
    __device__ __forceinline__ void operator()(const AccT& acc, const Unit& u, int wr, int wc, int fr, int fq, LAS unsigned char*) const {
        float rsv[2][4];
#pragma unroll
        for (int ai = 0; ai < 2; ++ai)
#pragma unroll
            for (int m = 0; m < 4; ++m) rsv[ai][m] = ssq0[u.pm * 256 + ai * 128 + wr * 64 + m * 16 + fr];
        f32x4 bb[2][2];
        if (u.pn >= 9) {
#pragma unroll
            for (int bj = 0; bj < 2; ++bj) { const int c = bj * 128 + wc * 32 + fq * 8; bb[bj][0] = *(const f32x4*)(b_alpha + c); bb[bj][1] = *(const f32x4*)(b_alpha + c + 4); }
        }
#pragma unroll
        for (int ai = 0; ai < 2; ++ai)
#pragma unroll
            for (int m = 0; m < 4; ++m) {
                const int row = u.pm * 256 + ai * 128 + wr * 64 + m * 16 + fr;
                const float rs = rsqrtf(rsv[ai][m] * (1.0f / D) + EPS);
#pragma unroll
                for (int bj = 0; bj < 2; ++bj) {
                    const int col = u.pn * 256 + bj * 128 + wc * 32 + fq * 8;
                    const f32x4 v0 = acc[ai][bj][m][0] * rs, v1 = acc[ai][bj][m][1] * rs;
                    if (u.pn < 9) {
                        u32x4 w; w.x = cvt_pk_bf16(v0[0], v0[1]); w.y = cvt_pk_bf16(v0[2], v0[3]); w.z = cvt_pk_bf16(v1[0], v1[1]); w.w = cvt_pk_bf16(v1[2], v1[3]);
                        ST16((u32x4*)(proj + (size_t)row * NPROJ + col), w);
                    } else {
                        const int c = col - NPROJ;
                        f32x4 o0, o1;
#pragma unroll
                        for (int j = 0; j < 4; ++j) {
                            const float z0 = v0[j] + bb[bj][0][j], z1 = v1[j] + bb[bj][1][j];
                            o0[j] = (fminf(z0, 0.f) - __logf(1.0f + __expf(-fabsf(z0)))) * 0.0625f;
                            o1[j] = (fminf(z1, 0.f) - __logf(1.0f + __expf(-fabsf(z1)))) * 0.0625f;
                        }
                        *(f32x4*)(la + (size_t)row * 256 + c) = o0; *(f32x4*)(la + (size_t)row * 256 + c + 4) = o1;
                    }
                }
            }
    }
};
struct EpiPP {
    bf16_t* pp;
    __device__ __forceinline__ void operator()(const AccT& acc, const Unit& u, int wr, int wc, int fr, int fq, LAS unsigned char*) const {
#pragma unroll
        for (int ai = 0; ai < 2; ++ai)
#pragma unroll
            for (int m = 0; m < 4; ++m) {
                const int row = u.pm * 256 + ai * 128 + wr * 64 + m * 16 + fr;
#pragma unroll
                for (int bj = 0; bj < 2; ++bj) {
                    const int col = u.pn * 256 + bj * 128 + wc * 32 + fq * 8;
                    const f32x4 v0 = acc[ai][bj][m][0], v1 = acc[ai][bj][m][1];
                    u32x4 w; w.x = cvt_pk_bf16(v0[0], v0[1]); w.y = cvt_pk_bf16(v0[2], v0[3]); w.z = cvt_pk_bf16(v1[0], v1[1]); w.w = cvt_pk_bf16(v1[2], v1[3]);
                    ST16((u32x4*)(pp + (size_t)row * D + col), w);
                }
            }
    }
};
template <int MODE, bool WRITE_HB, bool WRITE_PART, bool WRITE_F32>
struct EpiRes {
    float* out; const float* xp; const bf16_t* hbin; bf16_t* hb; float* part; const float* part_in; const bf16_t* pp; const float* scale;
    struct Q { f32x4 xb[2][2][2]; u32x4 hw[2][2]; u32x4 pw[2][2]; f32x4 pin[2]; };
    __device__ __forceinline__ void fetch(Q& q, const Unit& u, int aq, int wr, int wc, int fr, int fq) const {
        const int ai = aq >> 1, m0 = (aq & 1) * 2;
#pragma unroll
        for (int mm = 0; mm < 2; ++mm) {
            const int row = u.pm * 256 + ai * 128 + wr * 64 + (m0 + mm) * 16 + fr;
            if (MODE == 2) q.pin[mm] = *(const f32x4*)(part_in + (long)row * 16 + fq * 4);
#pragma unroll
            for (int bj = 0; bj < 2; ++bj) {
                const int col = u.pn * 256 + bj * 128 + wc * 32 + fq * 8;
                if (MODE == 0) { q.xb[mm][bj][0] = *(const f32x4*)(xp + (size_t)row * D + col); q.xb[mm][bj][1] = *(const f32x4*)(xp + (size_t)row * D + col + 4); }
                else q.hw[mm][bj] = *(const u32x4*)(hbin + (size_t)row * D + col);
                if (MODE == 2) q.pw[mm][bj] = *(const u32x4*)(pp + (size_t)row * D + col);
            }
        }
    }
    __device__ __forceinline__ void operator()(const AccT& acc, const Unit& u, int wr, int wc, int fr, int fq, LAS unsigned char*) const {
        f32x4 sc[2][2];
        if (MODE == 3) {
#pragma unroll
            for (int bj = 0; bj < 2; ++bj) { const int col = u.pn * 256 + bj * 128 + wc * 32 + fq * 8; sc[bj][0] = *(const f32x4*)(scale + col); sc[bj][1] = *(const f32x4*)(scale + col + 4); }
        }
        constexpr bool PIPE = (MODE == 1 || MODE == 3);
        Q qa, qb;
        fetch(qa, u, 0, wr, wc, fr, fq);
#pragma unroll
        for (int aq = 0; aq < 4; ++aq) {
            const int ai = aq >> 1, m0 = (aq & 1) * 2;
            Q& cur = (aq & 1) ? qb : qa; Q& nxt = (aq & 1) ? qa : qb;
            if (PIPE && aq < 3) fetch(nxt, u, aq + 1, wr, wc, fr, fq);
#pragma unroll
            for (int mm = 0; mm < 2; ++mm) {
                const int m = m0 + mm;
                const int row = u.pm * 256 + ai * 128 + wr * 64 + m * 16 + fr;
                float rs = 1.f;
                if (MODE == 2) { float s = (cur.pin[mm][0] + cur.pin[mm][1]) + (cur.pin[mm][2] + cur.pin[mm][3]); s += __shfl_xor(s, 16); s += __shfl_xor(s, 32); rs = rsqrtf(s * (1.0f / D) + EPS); }
                float sq = 0.f;
#pragma unroll
                for (int bj = 0; bj < 2; ++bj) {
                    const int col = u.pn * 256 + bj * 128 + wc * 32 + fq * 8;
                    f32x4 v0 = acc[ai][bj][m][0], v1 = acc[ai][bj][m][1];
                    if (MODE == 2) {
                        float pf[8]; unpack8(cur.pw[mm][bj], pf);
#pragma unroll
                        for (int j = 0; j < 4; ++j) {
                            v0[j] = pf[j] * __builtin_amdgcn_rcpf(1.f + __expf(-v0[j] * rs));
                            v1[j] = pf[4 + j] * __builtin_amdgcn_rcpf(1.f + __expf(-v1[j] * rs));
                        }
                    }
                    if (MODE == 3) { v0 = v0 * sc[bj][0]; v1 = v1 * sc[bj][1]; }
                    f32x4 b0, b1;
                    if (MODE == 0) { b0 = cur.xb[mm][bj][0]; b1 = cur.xb[mm][bj][1]; }
                    else { float bf[8]; unpack8(cur.hw[mm][bj], bf); b0 = (f32x4){bf[0], bf[1], bf[2], bf[3]}; b1 = (f32x4){bf[4], bf[5], bf[6], bf[7]}; }
                    const f32x4 h0 = b0 + v0, h1 = b1 + v1;
                    if (WRITE_F32) { float* hp = out + O_YP + (size_t)row * D; *(f32x4*)(hp + col) = h0; *(f32x4*)(hp + col + 4) = h1; }
                    if (WRITE_HB) { u32x4 w; w.x = cvt_pk_bf16(h0[0], h0[1]); w.y = cvt_pk_bf16(h0[2], h0[3]); w.z = cvt_pk_bf16(h1[0], h1[1]); w.w = cvt_pk_bf16(h1[2], h1[3]);
                        ST16((u32x4*)(hb + (size_t)row * D + col), w); }
                    sq += (h0[0] * h0[0] + h0[1] * h0[1]) + (h0[2] * h0[2] + h0[3] * h0[3]) + (h1[0] * h1[0] + h1[1] * h1[1]) + (h1[2] * h1[2] + h1[3] * h1[3]);
                }
                if (WRITE_PART) {
                    sq += __shfl_xor(sq, 16); sq += __shfl_xor(sq, 32);
                    if (fq == 0) part[(long)row * 16 + u.pn * 4 + wc] = sq;
                }
            }
            if (!PIPE && aq < 3) fetch(nxt, u, aq + 1, wr, wc, fr, fq);
        }
    }
};
struct EpiFfn {
    const float* part_in; const float* convw; const float* convb; float* convp_out; bf16_t* G;
    __device__ __forceinline__ void operator()(AccT& acc, const Unit& u, int wr, int wc, int fr, int fq, LAS unsigned char* ldsx) const {
        const int c0 = u.pn * 128 + wc * 32 + fq * 8;
        f32x4 w0[2], w1[2], w2[2], cb[2];
#pragma unroll
        for (int n = 0; n < 2; ++n) { const int cn = c0 + 4 * n;
            w0[n] = *(const f32x4*)(convw + cn); w1[n] = *(const f32x4*)(convw + DFF + cn); w2[n] = *(const f32x4*)(convw + 2 * DFF + cn); cb[n] = *(const f32x4*)(convb + cn); }
        f32x4 pin[2][4];
#pragma unroll
        for (int ai = 0; ai < 2; ++ai)
#pragma unroll
            for (int m = 0; m < 4; ++m) pin[ai][m] = *(const f32x4*)(part_in + (long)(u.pm * 254 - 2 + ai * 128 + wr * 64 + m * 16 + fr) * 16 + fq * 4);
#pragma unroll
        for (int ai = 0; ai < 2; ++ai)
#pragma unroll
            for (int m = 0; m < 4; ++m) {
                float s_ = (pin[ai][m][0] + pin[ai][m][1]) + (pin[ai][m][2] + pin[ai][m][3]); s_ += __shfl_xor(s_, 16); s_ += __shfl_xor(s_, 32);
                const float rs = rsqrtf(s_ * (1.0f / D) + EPS);
#pragma unroll
                for (int bj = 0; bj < 2; ++bj)
#pragma unroll
                    for (int n = 0; n < 2; ++n) acc[ai][bj][m][n] = acc[ai][bj][m][n] * rs;
            }
        LAS f32x4* xch = (LAS f32x4*)ldsx;
        if (fr >= 14) {
#pragma unroll
            for (int ai = 0; ai < 2; ++ai) {
                const int slot = ((((ai * 2 + wr) * 4 + wc) * 4 + fq) * 2 + (fr - 14)) * 2;
                xch[slot] = acc[ai][0][3][0]; xch[slot + 1] = acc[ai][0][3][1];
            }
        }
        asm volatile("s_waitcnt lgkmcnt(0)" ::: "memory"); __builtin_amdgcn_s_barrier(); asm volatile("" ::: "memory");
#pragma unroll
        for (int ai = 0; ai < 2; ++ai)
#pragma unroll
            for (int m = 0; m < 4; ++m) {
                const int tr = ai * 128 + wr * 64 + m * 16 + fr;
                const int grow = u.pm * 254 - 2 + tr;
                const bool store = (tr >= 2 && grow < SEQ);
                u32x4 w;
#pragma unroll
                for (int n = 0; n < 2; ++n) {
                    const f32x4 x = acc[ai][0][m][n];
                    f32x4 p;
                    if (m == 0) {
                        const int sa = (wr == 1) ? ai : 0, sw = (wr == 1) ? 0 : 1;
                        const bool has = (wr == 1) || (ai == 1);
                        const int slot = ((((sa * 2 + sw) * 4 + wc) * 4 + fq) * 2 + (fr >= 14 ? fr - 14 : 0)) * 2 + n;
                        p = xch[slot];
                        if (!has) p = (f32x4){0.f, 0.f, 0.f, 0.f};
                    } else p = acc[ai][0][m == 0 ? 0 : m - 1][n];
                    f32x4 p1, p2;
#pragma unroll
                    for (int j = 0; j < 4; ++j) {
                        const float xf = x[j], pf = p[j]; const int xi = __float_as_int(xf), pi = __float_as_int(pf);
                        const int r1 = __builtin_amdgcn_mov_dpp(pi, 0x121, 0xf, 0xf, true), r2 = __builtin_amdgcn_mov_dpp(pi, 0x122, 0xf, 0xf, true);
                        p1[j] = __int_as_float(__builtin_amdgcn_update_dpp(r1, xi, 0x111, 0xf, 0xf, false));
                        p2[j] = __int_as_float(__builtin_amdgcn_update_dpp(r2, xi, 0x112, 0xf, 0xf, false));
                    }
                    if (grow >= SEQ - 2 && grow < SEQ) *(f32x4*)(convp_out + (size_t)(grow - (SEQ - 2)) * DFF + c0 + 4 * n) = x;
                    const f32x4 ac = cb[n] + w0[n] * p2 + w1[n] * p1 + w2[n] * x;
                    const f32x4 v = acc[ai][1][m][n];
                    const f32x2 g0 = gelu_pk((f32x2){ac[0], ac[1]}), g1 = gelu_pk((f32x2){ac[2], ac[3]});
                    const unsigned lo = cvt_pk_bf16(g0.x * v[0], g0.y * v[1]), hi = cvt_pk_bf16(g1.x * v[2], g1.y * v[3]);
                    if (n == 0) { w.x = lo; w.y = hi; } else { w.z = lo; w.w = hi; }
                }
                if (store) ST16((u32x4*)(G + (size_t)grow * DFF + c0), w);
                asm volatile("" ::: "memory");
            }
    }
};

template <int NT>
struct EpiStoreOnly {
    bf16_t* dst;
    __device__ __forceinline__ void operator()(const AccT& acc, const Unit& u, int wr, int wc, int fr, int fq, LAS unsigned char*) const {
#pragma unroll
        for (int ai = 0; ai < 2; ++ai)
#pragma unroll
            for (int m = 0; m < 4; ++m) {
                const int row = u.pm * 254 + ai * 128 + wr * 64 + m * 16 + fr;
#pragma unroll
                for (int bj = 0; bj < 2; ++bj) {
                    const int col = (u.pn & 3) * 256 + bj * 128 + wc * 32 + fq * 8;
                    const f32x4 v0 = acc[ai][bj][m][0], v1 = acc[ai][bj][m][1];
                    u32x4 w; w.x = cvt_pk_bf16(v0[0], v0[1]); w.y = cvt_pk_bf16(v0[2], v0[3]); w.z = cvt_pk_bf16(v1[0], v1[1]); w.w = cvt_pk_bf16(v1[2], v1[3]);
                    if (NT) __builtin_nontemporal_store(w, (u32x4*)(dst + (size_t)row * D + col)); else *(u32x4*)(dst + (size_t)row * D + col) = w;
                }
            }
    }
};
struct EpiNull {
    __device__ __forceinline__ void operator()(const AccT& acc, const Unit& u, int wr, int wc, int fr, int fq, LAS unsigned char*) const {
#pragma unroll
        for (int ai = 0; ai < 2; ++ai)
#pragma unroll
            for (int bj = 0; bj < 2; ++bj)
#pragma unroll
                for (int m = 0; m < 4; ++m) { asm volatile("" :: "v"(acc[ai][bj][m][0]), "v"(acc[ai][bj][m][1])); }
    }
};
struct KArgs { const float* in[29]; float* out; unsigned char* ws; };
enum { I_XP = 0, I_XS, I_PP, I_PS, I_SGLA, I_CK, I_CV, I_SPOOL, I_SCONV, I_MNE, I_WIN, I_WALPHA, I_BALPHA, I_ONORM, I_QNORM, I_KNORM, I_SINKS, I_WOUT,
       I_MNO, I_POOLW, I_POOLSC, I_FNORM, I_FWIN, I_FCW, I_FCB, I_FWOUT, I_PNORM, I_PWPROJ, I_PWGATE };

__device__ __forceinline__ float* part_tab(unsigned char* ws, int i) { return (float*)(ws + WS_SSQ + 262144 + (size_t)i * PART_STRIDE) + 2 * 16; }

constexpr int SG_STAGE = 24576, SG_NST = 6, SPART_PITCH = 36;
constexpr size_t WS_SPART = WS_SSQ + 6750208;
__device__ __forceinline__ float* spart_tab(unsigned char* ws, int i) { return (float*)(ws + WS_SPART) + (size_t)i * 128 * 32; }
template <int K, int LDA, int LDB>
__device__ __forceinline__ void sgemm_tile(const bf16_t* __restrict__ A, const bf16_t* __restrict__ B0, const bf16_t* __restrict__ B1, LAS unsigned char* lds) {
    const int tid = otid(), lane = tid & 63, wave = __builtin_amdgcn_readfirstlane(tid >> 6);
    const int fr = lane & 15, fq = lane >> 4, mb = wave >> 1, nb = wave & 1;
    constexpr int NSTG = K / 128;
    static_assert(K % 128 == 0 && NSTG >= 2, "K must be a multiple of 128");
    const int prow = lane >> 4, ppc = lane & 15;
    const char* gsrc[3]; unsigned ldst[3];
#pragma unroll
    for (int j = 0; j < 3; ++j) {
        if (j < 2) { const int i = wave + 8 * j, row = 4 * i + prow; gsrc[j] = (const char*)(A + (size_t)row * LDA) + 16 * (ppc ^ (row & 15)); ldst[j] = (unsigned)i * 1024u; }
        else { const int row = 4 * wave + prow; const bf16_t* bp = row < 16 ? B0 + (size_t)row * LDB : B1 + (size_t)(row - 16) * LDB; gsrc[j] = (const char*)bp + 16 * (ppc ^ (row & 15)); ldst[j] = 16384u + (unsigned)wave * 1024u; }
    }
#define SG_DMA(c) do { const int st_ = ((c) % SG_NST) * SG_STAGE; _Pragma("unroll") for (int j_ = 0; j_ < 3; ++j_) \
        __builtin_amdgcn_global_load_lds((const unsigned*)(gsrc[j_] + (size_t)(c) * 256), (LAS unsigned*)(lds + st_ + ldst[j_]), 16, 0, 0); } while (0)
    f32x4 acc = (f32x4){0.f, 0.f, 0.f, 0.f};
    int aoff[4], boff[4];
#pragma unroll
    for (int s = 0; s < 4; ++s) { aoff[s] = (16 * mb + fr) * 256 + 16 * ((4 * s + fq) ^ fr); boff[s] = 16384 + (16 * nb + fr) * 256 + 16 * ((4 * s + fq) ^ fr); }
#pragma unroll
    for (int c = 0; c < (NSTG < 5 ? NSTG : 5); ++c) SG_DMA(c);
#pragma unroll 1
    for (int c = 0; c < NSTG; ++c) {
        if (c + 5 < NSTG) SG_DMA(c + 5);
        const int ahead = (NSTG - 1 - c) < 5 ? (NSTG - 1 - c) : 5;
        if (ahead == 5) asm volatile("s_waitcnt vmcnt(15)" ::: "memory");
        else if (ahead == 4) asm volatile("s_waitcnt vmcnt(12)" ::: "memory");
        else if (ahead == 3) asm volatile("s_waitcnt vmcnt(9)" ::: "memory");
        else if (ahead == 2) asm volatile("s_waitcnt vmcnt(6)" ::: "memory");
        else if (ahead == 1) asm volatile("s_waitcnt vmcnt(3)" ::: "memory");
        else asm volatile("s_waitcnt vmcnt(0)" ::: "memory");
        __builtin_amdgcn_s_barrier(); asm volatile("" ::: "memory");
        const LAS unsigned char* st = lds + (c % SG_NST) * SG_STAGE;
#pragma unroll
        for (int s = 0; s < 4; ++s) {
            const bf16x8 af = *(const LAS bf16x8*)(st + aoff[s]), bf = *(const LAS bf16x8*)(st + boff[s]);
            acc = __builtin_amdgcn_mfma_f32_16x16x32_bf16(bf, af, acc, 0, 0, 0);
        }
        asm volatile("s_waitcnt lgkmcnt(0)" ::: "memory"); __builtin_amdgcn_s_barrier(); asm volatile("" ::: "memory");
    }
#undef SG_DMA
    *(LAS f32x4*)((LAS float*)lds + (16 * mb + fr) * SPART_PITCH + 16 * nb + 4 * fq) = acc;
}
__device__ __forceinline__ f32x4 sread4(const LAS unsigned char* lds, int b, int col0) { return *(const LAS f32x4*)((const LAS float*)lds + b * SPART_PITCH + col0); }
__device__ __forceinline__ float s_row_rs(const float* spart, int sb) {
    const float* p = spart + (size_t)sb * 32; float s = 0.f;
#pragma unroll
    for (int i = 0; i < 32; i += 4) { const f32x4 v = *(const f32x4*)(p + i); s += (v[0] + v[1]) + (v[2] + v[3]); }
    return rsqrtf(s * (1.0f / D) + EPS);
}
template <int MODE, bool WRITE_HB, bool WRITE_PART, bool WRITE_F32>
__device__ __forceinline__ void s_res_epi(const KArgs& a, int sb, int q, int cu, const f32x4 v, const bf16_t* hbin, bf16_t* hb, float* spart, const f32x4 ppv, float rs_in, const float* scale) {
    const int row = SROW + sb, c0 = 32 * cu + 4 * q;
    f32x4 base;
    if (MODE == 0) base = *(const f32x4*)(a.in[I_XS] + (size_t)sb * D + c0);
    else { const u32x2 w = *(const u32x2*)(hbin + (size_t)row * D + c0); base = (f32x4){bf_lo(w.x), bf_hi(w.x), bf_lo(w.y), bf_hi(w.y)}; }
    f32x4 hn; float sq = 0.f;
#pragma unroll
    for (int j = 0; j < 4; ++j) {
        float nv = v[j];
        if (MODE == 2) nv = ppv[j] * __builtin_amdgcn_rcpf(1.f + __expf(-nv * rs_in));
        if (MODE == 3) nv = nv * scale[c0 + j];
        hn[j] = base[j] + nv; sq += hn[j] * hn[j];
    }
    if (WRITE_F32) *(f32x4*)(a.out + O_YS + (size_t)sb * D + c0) = hn;
    if (WRITE_HB) { u32x2 w; w.x = cvt_pk_bf16(hn[0], hn[1]); w.y = cvt_pk_bf16(hn[2], hn[3]); *(u32x2*)(hb + (size_t)row * D + c0) = w; }
    if (WRITE_PART) {
        sq += __shfl_xor(sq, 1); sq += __shfl_xor(sq, 2); sq += __shfl_xor(sq, 4);
        if (q == 0) spart[(size_t)sb * 32 + cu] = sq;
    }
}
__device__ __forceinline__ void s_proj_units(const KArgs& a, LAS unsigned char* lds, int u0, int ustep) {
    const bf16_t* xbf = (const bf16_t*)(a.ws + WS_R1) + (size_t)SROW * D; const bf16_t* W = (const bf16_t*)(a.ws + WS_WIN0);
    bf16_t* proj = (bf16_t*)(a.ws + WS_BIG); float* la = (float*)(a.ws + WS_BIG + BIG_LA); const float* ssq0 = (const float*)(a.ws + WS_SSQ);
    for (int u = u0; u < 160; u += ustep) {
        const int rh = u & 1, cu = u >> 1, n0 = cu * 32;
        sgemm_tile<1024, 1024, 1024>(xbf + (size_t)(64 * rh) * D, W + (size_t)n0 * 1024, W + (size_t)(n0 + 16) * 1024, lds);
        __syncthreads();
        const int tid = otid(), b = tid >> 3, q = tid & 7, sb = 64 * rh + b, c0 = n0 + 4 * q, row = SROW + sb;
        const f32x4 v = sread4(lds, b, 4 * q);
        const float rs = rsqrtf(ssq0[row] * (1.0f / D) + EPS);
        if (n0 < NPROJ) {
            u32x2 w; w.x = cvt_pk_bf16(v[0] * rs, v[1] * rs); w.y = cvt_pk_bf16(v[2] * rs, v[3] * rs);
            *(u32x2*)(proj + (size_t)row * NPROJ + c0) = w;
        } else {
            const int c = c0 - NPROJ; f32x4 o;
#pragma unroll
            for (int i = 0; i < 4; ++i) { const float z = v[i] * rs + a.in[I_BALPHA][c + i]; o[i] = (fminf(z, 0.f) - __logf(1.0f + __expf(-fabsf(z)))) * 0.0625f; }
            *(f32x4*)(la + (size_t)row * 256 + c) = o;
        }
        __syncthreads();
    }
}
template <int MODE, int K, int LDA>
__device__ __forceinline__ void s_res_units(const KArgs& a, LAS unsigned char* lds, int u0, int ustep, const bf16_t* A, const bf16_t* W, const bf16_t* hbin, bf16_t* hb, float* spart_out) {
    for (int u = u0; u < 64; u += ustep) {
        const int rh = u & 1, cu = u >> 1, n0 = cu * 32;
        const bf16_t* Au = A + (size_t)(SROW + 64 * rh) * LDA + (MODE == 3 ? (n0 >> 8) * 256 : 0);
        sgemm_tile<K, LDA, K>(Au, W + (size_t)n0 * K, W + (size_t)(n0 + 16) * K, lds);
        __syncthreads();
        const int tid = otid(), b = tid >> 3, q = tid & 7;
        const f32x4 v = sread4(lds, b, 4 * q);
        s_res_epi<MODE, true, true, false>(a, 64 * rh + b, q, cu, v, hbin, hb, spart_out, v, 1.f, a.in[I_POOLSC]);
        __syncthreads();
    }
}
template <bool LAST>
__device__ __forceinline__ void s_ple_units(const KArgs& a, LAS unsigned char* lds, int u0, int ustep, const bf16_t* pb, const bf16_t* Wp, const bf16_t* hbA, const bf16_t* Wg, const float* spart_in, float* spart_out, bf16_t* hbout) {
    for (int u = u0; u < 64; u += ustep) {
        const int rh = u & 1, cu = u >> 1, n0 = cu * 32;
        sgemm_tile<256, 256, 256>(pb + (size_t)(SROW + 64 * rh) * PLE, Wp + (size_t)n0 * PLE, Wp + (size_t)(n0 + 16) * PLE, lds);
        __syncthreads();
        const int tid = otid(), b = tid >> 3, q = tid & 7;
        const f32x4 ppv = sread4(lds, b, 4 * q);
        __syncthreads();
        sgemm_tile<1024, 1024, 1024>(hbA + (size_t)(SROW + 64 * rh) * D, Wg + (size_t)n0 * D, Wg + (size_t)(n0 + 16) * D, lds);
        __syncthreads();
        const f32x4 v = sread4(lds, b, 4 * q);
        const float rs = s_row_rs(spart_in, 64 * rh + b);
        s_res_epi<2, !LAST, !LAST, LAST>(a, 64 * rh + b, q, cu, v, hbA, hbout, spart_out, ppv, rs, nullptr);
        __syncthreads();
    }
}
__device__ __forceinline__ void s_ffn_units(const KArgs& a, LAS unsigned char* lds, int u0, int ustep, int l, const bf16_t* hbA, const float* spart_in) {
    const bf16_t* W = (const bf16_t*)(a.ws + WS_WFFI + l * WFFI_BYTES);
    bf16_t* Gb = (bf16_t*)(a.ws + WS_BIG);
    const float* convw = a.in[I_FCW] + (size_t)l * 3 * DFF; const float* convb = a.in[I_FCB] + (size_t)l * DFF;
    const float* cstate = a.in[I_SCONV] + (size_t)l * NS * 2 * DFF; float* convs = a.out + O_CONVS + (size_t)l * NS * 2 * DFF;
    for (int u = u0; u < 352; u += ustep) {
        const int rh = u & 1, cu = u >> 1, ca = cu * 16;
        const int nr = 256 * (ca >> 7) + (ca & 127);
        sgemm_tile<1024, 1024, 1024>(hbA + (size_t)(SROW + 64 * rh) * D, W + (size_t)nr * 1024, W + (size_t)(nr + 128) * 1024, lds);
        __syncthreads();
        const int tid = otid(), b = tid >> 3, q = tid & 7, sb = 64 * rh + b;
        if (q < 4) {
            const int c = ca + 4 * q;
            const f32x4 av = sread4(lds, b, 4 * q), vv = sread4(lds, b, 16 + 4 * q);
            const float rs = s_row_rs(spart_in, sb);
            const float* st = cstate + (size_t)sb * 2 * DFF + c; float* so = convs + (size_t)sb * 2 * DFF + c;
            const f32x4 p2 = *(const f32x4*)(st), p1 = *(const f32x4*)(st + DFF);
            const f32x4 w0 = *(const f32x4*)(convw + c), w1 = *(const f32x4*)(convw + DFF + c), w2 = *(const f32x4*)(convw + 2 * DFF + c), cb = *(const f32x4*)(convb + c);
            const f32x4 x = av * rs;
            *(f32x4*)(so) = p1; *(f32x4*)(so + DFF) = x;
            const f32x4 ac = cb + w0 * p2 + w1 * p1 + w2 * x;
            const f32x2 g0 = gelu_pk((f32x2){ac[0], ac[1]}), g1 = gelu_pk((f32x2){ac[2], ac[3]});
            u32x2 w; w.x = cvt_pk_bf16(g0.x * vv[0] * rs, g0.y * vv[1] * rs); w.y = cvt_pk_bf16(g1.x * vv[2] * rs, g1.y * vv[3] * rs);
            *(u32x2*)(Gb + (size_t)(SROW + sb) * DFF + c) = w;
        }
        __syncthreads();
    }
}

__device__ __forceinline__ void tr_item(const float* W, int ldsrc, int scol0, int k0, const float* gain, bf16_t* dst, int ldd, int drow0, LAS float* scr, int lane) {
    float wv[32];
#pragma unroll
    for (int i = 0; i < 32; ++i) { const int kk = 2 * i + (lane >> 5); wv[i] = __builtin_nontemporal_load(W + (size_t)(k0 + kk) * ldsrc + scol0 + (lane & 31)); }
#pragma unroll
    for (int i = 0; i < 32; ++i) { const int kk = 2 * i + (lane >> 5); const float gsc = gain ? gain[k0 + kk] : 1.f; scr[kk * 33 + (lane & 31)] = wv[i] * gsc; }
    asm volatile("s_waitcnt lgkmcnt(0)" ::: "memory");
    const int c = lane & 7;
#pragma unroll
    for (int j = 0; j < 4; ++j) { const int n = (lane >> 3) + 8 * j; const LAS float* s = scr + (8 * c) * 33 + n;
        u32x4 o; o.x = cvt_pk_bf16(s[0 * 33], s[1 * 33]); o.y = cvt_pk_bf16(s[2 * 33], s[3 * 33]); o.z = cvt_pk_bf16(s[4 * 33], s[5 * 33]); o.w = cvt_pk_bf16(s[6 * 33], s[7 * 33]);
        *(u32x4*)(dst + (size_t)(drow0 + n) * ldd + k0 + 8 * c) = o; }
    asm volatile("s_waitcnt lgkmcnt(0)" ::: "memory");
}
__device__ __forceinline__ void weff_item(const float* Win, const float* wal, int n0, int k0, const float* gain, bf16_t* dst, int drow0, LAS float* scr, int lane) {
#pragma unroll 2
    for (int i = 0; i < 32; ++i) { const int kk = 2 * i + (lane >> 5); const int k = k0 + kk; float s = 0.f;
#pragma unroll
        for (int r = 0; r < 16; ++r) s += Win[(size_t)k * 2320 + 1024 + r] * wal[r * 256 + n0 + (lane & 31)];
        scr[kk * 33 + (lane & 31)] = s * gain[k]; }
    asm volatile("s_waitcnt lgkmcnt(0)" ::: "memory");
    const int c = lane & 7;
#pragma unroll
    for (int j = 0; j < 4; ++j) { const int n = (lane >> 3) + 8 * j; const LAS float* s = scr + (8 * c) * 33 + n;
        u32x4 o; o.x = cvt_pk_bf16(s[0 * 33], s[1 * 33]); o.y = cvt_pk_bf16(s[2 * 33], s[3 * 33]); o.z = cvt_pk_bf16(s[4 * 33], s[5 * 33]); o.w = cvt_pk_bf16(s[6 * 33], s[7 * 33]);
        *(u32x4*)(dst + (size_t)(drow0 + n) * 1024 + k0 + 8 * c) = o; }
    asm volatile("s_waitcnt lgkmcnt(0)" ::: "memory");
}

__device__ __forceinline__ void p0_prologue(const KArgs& a, LAS unsigned char* lds, int vcu, int G) {
    const int tid = otid(), lane = tid & 63, wave = __builtin_amdgcn_readfirstlane(tid >> 6);
    LAS float* scr = (LAS float*)(lds + wave * 16384);
    const int gw = vcu * 8 + wave, NGW = G * 8;
    unsigned char* ws = a.ws;
    constexpr int I_A = 16 * 72, I_E = 16 * 8;
    for (int it = gw; it < I_A + I_E; it += NGW) {
        int r = it;
        if (r < I_A) { const int kb = r / 72, nb = r % 72, n0 = nb * 32; tr_item(a.in[I_WIN], 2320, n0 < 1024 ? n0 : n0 + 16, kb * 64, a.in[I_MNE], (bf16_t*)(ws + WS_WIN0), 1024, n0, scr, lane); continue; } r -= I_A;
        { const int kb = r / 8, nb = r % 8; weff_item(a.in[I_WIN], a.in[I_WALPHA], nb * 32, kb * 64, a.in[I_MNE], (bf16_t*)(ws + WS_WIN0), NPROJ + nb * 32, scr, lane); }
    }
    bf16_t* xbf = (bf16_t*)(ws + WS_R1);
    float* ssq0 = (float*)(ws + WS_SSQ);
    for (int row0 = gw * 2; row0 < MT; row0 += NGW * 2) {
        f32x4 v[2][4];
#pragma unroll
        for (int rr = 0; rr < 2; ++rr) { const int row = row0 + rr;
            const float* src = row < SEQ ? a.in[I_XP] + (size_t)row * D : ((row >= SROW && row < SROW + NS) ? a.in[I_XS] + (size_t)(row - SROW) * D : nullptr);
#pragma unroll
            for (int j = 0; j < 4; ++j) { v[rr][j] = (f32x4){0.f, 0.f, 0.f, 0.f}; if (src) v[rr][j] = __builtin_nontemporal_load((const f32x4*)(src + j * 256 + lane * 4)); } }
#pragma unroll
        for (int rr = 0; rr < 2; ++rr) { const int row = row0 + rr; float s = 0.f;
#pragma unroll
            for (int j = 0; j < 4; ++j) { const f32x4 x = v[rr][j]; s += (x[0] * x[0] + x[1] * x[1]) + (x[2] * x[2] + x[3] * x[3]);
                u32x2 w; w.x = cvt_pk_bf16(x[0], x[1]); w.y = cvt_pk_bf16(x[2], x[3]);
                *(u32x2*)(xbf + (size_t)row * D + j * 256 + lane * 4) = w; }
            s = wave_sum(s);
            if (lane == 0) ssq0[row] = s; }
    }
    if (vcu == 0) { for (int i = tid; i < 256; i += NTHREADS) ((u32x4*)(ws + WS_R2))[i] = (u32x4){0u, 0u, 0u, 0u}; }
    if (vcu == 1 && tid < 6 * 32) { float* pt = (float*)(ws + WS_SSQ + 262144 + (size_t)(tid >> 5) * PART_STRIDE); pt[tid & 31] = 0.f; }
}
constexpr int CONV_ITEMS = 16 * 32 + 2 * 16 * 176 + 2 * 44 * 32 + 2 * 16 * 32 + 2 * 4 * 32 + 4 * 32;
constexpr int CONV_SPLIT = 10368;
__device__ __forceinline__ void p3_convert(const KArgs& a, LAS unsigned char* lds, int gw, int NGW, int it_lo, int it_hi, bool do_p) {
    const int tid = otid(), lane = tid & 63, wave = __builtin_amdgcn_readfirstlane(tid >> 6);
    LAS float* scr = (LAS float*)(lds + wave * 16384);
    unsigned char* ws = a.ws;
    constexpr int I_O = 16 * 32, I_FI = 16 * 176, I_FO = 44 * 32, I_G = 16 * 32, I_P = 4 * 32, I_PL = 4 * 32;
    static_assert(CONV_ITEMS == I_O + 2 * I_FI + 2 * I_FO + 2 * I_G + 2 * I_P + I_PL, "item count");
    for (int it = it_lo + gw; it < it_hi; it += NGW) {
        int r = it;
        if (r < I_O) { const int kb = r / 32, nb = r % 32; tr_item(a.in[I_WOUT], 1024, nb * 32, kb * 64, nullptr, (bf16_t*)(ws + WS_WOUT0), 1024, nb * 32, scr, lane); continue; } r -= I_O;
        if (r < 2 * I_FI) { const int l = r / I_FI, q = r % I_FI, kb = q / 176, nb = q % 176, n0 = nb * 32;
            const int pn = n0 >> 8, rr = n0 & 255, bj = rr >> 7, ii = rr & 127;
            tr_item(a.in[I_FWIN] + (size_t)l * 1024 * 5632, 5632, bj * DFF + pn * 128 + ii, kb * 64, a.in[I_FNORM] + l * 1024, (bf16_t*)(ws + WS_WFFI + l * WFFI_BYTES), 1024, n0, scr, lane); continue; } r -= 2 * I_FI;
        if (r < 2 * I_FO) { const int l = r / I_FO, q = r % I_FO, kb = q / 32, nb = q % 32;
            tr_item(a.in[I_FWOUT] + (size_t)l * DFF * 1024, 1024, nb * 32, kb * 64, nullptr, (bf16_t*)(ws + WS_WFFO + l * WFFO_BYTES), DFF, nb * 32, scr, lane); continue; } r -= 2 * I_FO;
        if (r < 2 * I_G) { const int l = r / I_G, q = r % I_G, kb = q / 32, nb = q % 32;
            tr_item(a.in[I_PWGATE] + (size_t)l * 1024 * 1024, 1024, nb * 32, kb * 64, a.in[I_PNORM] + l * 1024, (bf16_t*)(ws + WS_WGATE + l * WGATE_BYTES), 1024, nb * 32, scr, lane); continue; } r -= 2 * I_G;
        if (r < 2 * I_P) { const int l = r / I_P, q = r % I_P, kb = q / 32, nb = q % 32;
            tr_item(a.in[I_PWPROJ] + (size_t)l * 256 * 1024, 1024, nb * 32, kb * 64, nullptr, (bf16_t*)(ws + WS_WPROJ + l * WPROJ_BYTES), 256, nb * 32, scr, lane); continue; } r -= 2 * I_P;
        { const int gq = r / 32, q = r % 32, kb = q / 8, nb = q % 8;
            tr_item(a.in[I_POOLW] + (size_t)gq * 65536, 256, nb * 32, kb * 64, nullptr, (bf16_t*)(ws + WS_WPOOL), 256, gq * 256 + nb * 32, scr, lane); }
    }
    bf16_t* pbf = (bf16_t*)(ws + WS_PBF);
    if (do_p)
    for (int it0 = gw * 4; it0 < 2 * MT; it0 += NGW * 4) {
        f32x4 v[4];
#pragma unroll
        for (int rr = 0; rr < 4; ++rr) { const int it = it0 + rr; const int l = it / MT, row = it % MT;
            const float* src = row < SEQ ? a.in[I_PP] + ((size_t)l * SEQ + row) * PLE : ((row >= SROW && row < SROW + NS) ? a.in[I_PS] + ((size_t)l * NS + (row - SROW)) * PLE : nullptr);
            v[rr] = (f32x4){0.f, 0.f, 0.f, 0.f}; if (src) v[rr] = __builtin_nontemporal_load((const f32x4*)(src + lane * 4)); }
#pragma unroll
        for (int rr = 0; rr < 4; ++rr) { u32x2 w; w.x = cvt_pk_bf16(v[rr][0], v[rr][1]); w.y = cvt_pk_bf16(v[rr][2], v[rr][3]);
            *(u32x2*)(pbf + (size_t)(it0 + rr) * PLE + lane * 4) = w; }
    }
}

__device__ __forceinline__ int crow(int i, int hh) { return (i & 3) + 8 * (i >> 2) + 4 * hh; }
template <bool OUT>
__device__ __forceinline__ void gla_item_m(const KArgs& a, LAS unsigned char* lds, int item) {
    const int tid = otid(), lane = tid & 63, wave = __builtin_amdgcn_readfirstlane(tid >> 6);
    const int sc = item >> 2, h = item & 3;
    const bf16_t* proj = (const bf16_t*)(a.ws + WS_BIG); const float* la = (const float*)(a.ws + WS_BIG + BIG_LA);
    bf16_t* mix = (bf16_t*)(a.ws + WS_R1);
    float* US = (float*)(a.ws + WS_R2 + 4096); float* DS = US + (size_t)64 * 4 * 64 * 128;
    LAS float* bL = (LAS float*)lds; LAS float* segS = (LAS float*)(lds + 16384);
    LAS bf16_t* Qn = (LAS bf16_t*)(lds + 18432); LAS bf16_t* Kn = (LAS bf16_t*)(lds + 27648); LAS bf16_t* KT = (LAS bf16_t*)(lds + 36864);
    LAS bf16_t* VT = (LAS bf16_t*)(lds + 46080); LAS bf16_t* ST = (LAS bf16_t*)(lds + 64512); LAS float* red = (LAS float*)(lds + 82944);
    const int r = lane & 31, hh = lane >> 5;
    const int dkt = wave & 1, dvt = wave >> 1, it = wave & 1;
    f32x16 S = {};
    float* usp = US + ((size_t)(sc * 4 + h) * 64 + 32 * dkt) * 128 + 32 * dvt + r;
    if (OUT) {
#pragma unroll
        for (int i = 0; i < 16; ++i) S[i] = usp[(size_t)crow(i, hh) * 128];
    }
    float bsum = 0.f;
    const int sdk = tid & 63, sseg = tid >> 6, st_t = tid >> 3, sd8 = (tid & 7) * 8;
    float nla[8]; u32x4 nkw, nqw, nvw[2]; u32x2 nrw[4];
#define GLA_FETCH(cc) do { const int T0n = sc * 256 + (cc) * 64; \
        _Pragma("unroll") for (int i = 0; i < 8; ++i) nla[i] = la[(size_t)(T0n + 8 * sseg + i) * 256 + h * 64 + sdk]; \
        const size_t prow_ = (size_t)(T0n + st_t) * NPROJ; \
        nkw = *(const u32x4*)(proj + prow_ + PKA + h * 64 + sd8); \
        if (OUT) nqw = *(const u32x4*)(proj + prow_ + PQA + h * 64 + sd8); \
        nvw[0] = *(const u32x4*)(proj + prow_ + PVA + h * 128 + sd8); nvw[1] = *(const u32x4*)(proj + prow_ + PVA + h * 128 + sd8 + 64); \
        if (OUT) { _Pragma("unroll") for (int q = 0; q < 4; ++q) nrw[q] = *(const u32x2*)(proj + (size_t)(T0n + 32 * it + r) * NPROJ + PRA + h * 128 + 32 * dvt + 8 * q + 4 * hh); } } while (0)
    GLA_FETCH(0);
#pragma unroll 1
    for (int c = 0; c < 4; ++c) {
        const int T0 = sc * 256 + c * 64;
        float v[8]; u32x4 kw_c = nkw, qw_c = nqw, vw_c0 = nvw[0], vw_c1 = nvw[1]; u32x2 rw_c[4];
#pragma unroll
        for (int i = 0; i < 8; ++i) v[i] = nla[i];
#pragma unroll
        for (int q = 0; q < 4; ++q) rw_c[q] = nrw[q];
        if (c < 3) GLA_FETCH(c + 1);
        if (OUT) {
#pragma unroll
            for (int q = 0; q < 4; ++q) { u32x2 w; w.x = cvt_pk_bf16(S[4 * q], S[4 * q + 1]); w.y = cvt_pk_bf16(S[4 * q + 2], S[4 * q + 3]);
                *(LAS u32x2*)(ST + (32 * dvt + r) * 72 + 32 * dkt + 8 * q + 4 * hh) = w; }
        }
        {
            const int dk = sdk, seg = sseg;
#pragma unroll
            for (int i = 1; i < 8; ++i) v[i] += v[i - 1];
            segS[seg * 64 + dk] = v[7];
            __syncthreads();
            float off = 0.f;
#pragma unroll
            for (int s = 0; s < 8; ++s) { const float x = segS[s * 64 + dk]; off += (s < seg) ? x : 0.f; }
#pragma unroll
            for (int i = 0; i < 8; ++i) bL[(8 * seg + i) * 64 + dk] = v[i] + off;
            __syncthreads();
        }
        {
            const int t = st_t, d8 = sd8;
            const f32x4 b0 = *(const LAS f32x4*)(bL + t * 64 + d8), b1 = *(const LAS f32x4*)(bL + t * 64 + d8 + 4);
            const f32x4 l0 = *(const LAS f32x4*)(bL + 63 * 64 + d8), l1 = *(const LAS f32x4*)(bL + 63 * 64 + d8 + 4);
            float bb[8] = {b0[0], b0[1], b0[2], b0[3], b1[0], b1[1], b1[2], b1[3]}, bl[8] = {l0[0], l0[1], l0[2], l0[3], l1[0], l1[1], l1[2], l1[3]};
            float kf[8]; unpack8(kw_c, kf);
#pragma unroll
            for (int j = 0; j < 8; ++j) KT[(d8 + j) * 72 + t] = (bf16_t)(cvt_pk_bf16(kf[j] * __expf(bl[j] - bb[j]), 0.f) & 0xffffu);
            if (OUT) {
                float qf[8]; unpack8(qw_c, qf);
                float qq[8], kk[8];
#pragma unroll
                for (int j = 0; j < 8; ++j) { const float e = __expf(bb[j]); qq[j] = qf[j] * 0.125f * e; kk[j] = kf[j] * __expf(-bb[j]); }
                u32x4 w; w.x = cvt_pk_bf16(qq[0], qq[1]); w.y = cvt_pk_bf16(qq[2], qq[3]); w.z = cvt_pk_bf16(qq[4], qq[5]); w.w = cvt_pk_bf16(qq[6], qq[7]);
                *(LAS u32x4*)(Qn + t * 72 + d8) = w;
                w.x = cvt_pk_bf16(kk[0], kk[1]); w.y = cvt_pk_bf16(kk[2], kk[3]); w.z = cvt_pk_bf16(kk[4], kk[5]); w.w = cvt_pk_bf16(kk[6], kk[7]);
                *(LAS u32x4*)(Kn + t * 72 + d8) = w;
            }
#pragma unroll
            for (int i = 0; i < 2; ++i) { const int dv8 = d8 + 64 * i;
                const u32x4 vw = (i == 0) ? vw_c0 : vw_c1;
                LAS bf16_t* vt = VT + dv8 * 72 + t;
                vt[0 * 72] = (bf16_t)(vw.x & 0xffffu); vt[1 * 72] = (bf16_t)(vw.x >> 16); vt[2 * 72] = (bf16_t)(vw.y & 0xffffu); vt[3 * 72] = (bf16_t)(vw.y >> 16);
                vt[4 * 72] = (bf16_t)(vw.z & 0xffffu); vt[5 * 72] = (bf16_t)(vw.z >> 16); vt[6 * 72] = (bf16_t)(vw.w & 0xffffu); vt[7 * 72] = (bf16_t)(vw.w >> 16); }
            if (tid < 64) bsum += bL[63 * 64 + tid];
        }
        __syncthreads();
        if (OUT) {
            bf16x8 qf[4];
#pragma unroll
            for (int s = 0; s < 4; ++s) qf[s] = *(const LAS bf16x8*)(Qn + (32 * it + r) * 72 + 16 * s + 8 * hh);
            f32x16 oacc = {};
#pragma unroll
            for (int jt = 0; jt < 2; ++jt) {
                if (jt <= it) {
                    f32x16 at = {};
#pragma unroll
                    for (int s = 0; s < 4; ++s) { const bf16x8 af = *(const LAS bf16x8*)(Kn + (32 * jt + r) * 72 + 16 * s + 8 * hh); at = __builtin_amdgcn_mfma_f32_32x32x16_bf16(af, qf[s], at, 0, 0, 0); }
                    if (jt == it) {
#pragma unroll
                        for (int i = 0; i < 16; ++i) if (crow(i, hh) > r) at[i] = 0.f;
                    }
#pragma unroll
                    for (int s2 = 0; s2 < 2; ++s2) {
                        u32x4 pw; pw.x = cvt_pk_bf16(at[8 * s2 + 0], at[8 * s2 + 1]); pw.y = cvt_pk_bf16(at[8 * s2 + 2], at[8 * s2 + 3]);
                        pw.z = cvt_pk_bf16(at[8 * s2 + 4], at[8 * s2 + 5]); pw.w = cvt_pk_bf16(at[8 * s2 + 6], at[8 * s2 + 7]);
                        const LAS bf16_t* vp = VT + (32 * dvt + r) * 72 + 32 * jt + 16 * s2 + 4 * hh;
                        const u32x2 v0 = *(const LAS u32x2*)vp, v1 = *(const LAS u32x2*)(vp + 8);
                        const u32x4 vv = (u32x4){v0.x, v0.y, v1.x, v1.y};
                        oacc = __builtin_amdgcn_mfma_f32_32x32x16_bf16(__builtin_bit_cast(bf16x8, vv), __builtin_bit_cast(bf16x8, pw), oacc, 0, 0, 0);
                    }
                }
            }
#pragma unroll
            for (int s = 0; s < 4; ++s) { const bf16x8 af = *(const LAS bf16x8*)(ST + (32 * dvt + r) * 72 + 16 * s + 8 * hh); oacc = __builtin_amdgcn_mfma_f32_32x32x16_bf16(af, qf[s], oacc, 0, 0, 0); }
            float ss = 0.f;
#pragma unroll
            for (int i = 0; i < 16; ++i) ss += oacc[i] * oacc[i];
            ss += __shfl_xor(ss, 32);
            if (hh == 0) red[wave * 32 + r] = ss;
            __syncthreads();
            const float tot = (red[it * 32 + r] + red[(it + 2) * 32 + r]) + (red[(it + 4) * 32 + r] + red[(it + 6) * 32 + r]);
            const float rstd = rsqrtf(tot * (1.0f / 128.f) + EPS);
            const int t = T0 + 32 * it + r;
#pragma unroll
            for (int q = 0; q < 4; ++q) {
                const int dv0 = 32 * dvt + 8 * q + 4 * hh;
                const u32x2 rw = rw_c[q];
                const f32x4 on = *(const f32x4*)(a.in[I_ONORM] + dv0);
                const float r0 = bf_lo(rw.x), r1 = bf_hi(rw.x), r2 = bf_lo(rw.y), r3 = bf_hi(rw.y);
                const float y0 = oacc[4 * q] * rstd * on[0] * (r0 * __builtin_amdgcn_rcpf(1.f + __expf(-r0))), y1 = oacc[4 * q + 1] * rstd * on[1] * (r1 * __builtin_amdgcn_rcpf(1.f + __expf(-r1)));
                const float y2 = oacc[4 * q + 2] * rstd * on[2] * (r2 * __builtin_amdgcn_rcpf(1.f + __expf(-r2))), y3 = oacc[4 * q + 3] * rstd * on[3] * (r3 * __builtin_amdgcn_rcpf(1.f + __expf(-r3)));
                u32x2 w; w.x = cvt_pk_bf16(y0, y1); w.y = cvt_pk_bf16(y2, y3);
                *(u32x2*)(mix + (size_t)t * D + h * 128 + dv0) = w;
            }
        }
#pragma unroll
        for (int i = 0; i < 16; ++i) S[i] *= __expf(bL[63 * 64 + 32 * dkt + crow(i, hh)]);
#pragma unroll
        for (int s = 0; s < 4; ++s) {
            const bf16x8 af = *(const LAS bf16x8*)(KT + (32 * dkt + r) * 72 + 16 * s + 8 * hh), bf = *(const LAS bf16x8*)(VT + (32 * dvt + r) * 72 + 16 * s + 8 * hh);
            S = __builtin_amdgcn_mfma_f32_32x32x16_bf16(af, bf, S, 0, 0, 0);
        }
        __syncthreads();
    }
#undef GLA_FETCH
    if (!OUT) {
#pragma unroll
        for (int i = 0; i < 16; ++i) usp[(size_t)crow(i, hh) * 128] = S[i];
        if (tid < 64) DS[(sc * 4 + h) * 64 + tid] = __expf(bsum);
    }
}
__device__ __forceinline__ void gla_scan_m(const KArgs& a, int vcu) {
    const int tid = otid(); if (tid >= 128) return;
    const int e = vcu * 128 + tid; if (e >= 32768) return;
    float* US = (float*)(a.ws + WS_R2 + 4096); const float* DS = US + (size_t)64 * 4 * 64 * 128;
    const int hd = e >> 7;
    float S = 0.f;
    for (int c0 = 0; c0 < 64; c0 += 8) {
        float u[8], d[8];
#pragma unroll
        for (int j = 0; j < 8; ++j) { u[j] = US[(size_t)(c0 + j) * 32768 + e]; d[j] = DS[(c0 + j) * 256 + hd]; }
#pragma unroll
        for (int j = 0; j < 8; ++j) { US[(size_t)(c0 + j) * 32768 + e] = S; S = d[j] * S + u[j]; }
    }
    a.out[O_GLAP + e] = S;
}
__device__ __forceinline__ void gla_decode_item(const KArgs& a, int item, int lane) {
    const int b = item >> 2, h = item & 3; const int row = SROW + b;
    const bf16_t* proj = (const bf16_t*)(a.ws + WS_BIG); const float* la = (const float*)(a.ws + WS_BIG + BIG_LA);
    bf16_t* mix = (bf16_t*)(a.ws + WS_R1);
    const float* S0 = a.in[I_SGLA] + ((size_t)b * 4 + h) * 8192;
    float* S1 = a.out + O_GLAS + ((size_t)b * 4 + h) * 8192;
    const float qv = bf2f(proj[(size_t)row * NPROJ + PQA + h * 64 + lane]) * 0.125f;
    const float kv = bf2f(proj[(size_t)row * NPROJ + PKA + h * 64 + lane]);
    const float av = __expf(la[(size_t)row * 256 + h * 64 + lane]);
    const unsigned vw = *(const unsigned*)(proj + (size_t)row * NPROJ + PVA + h * 128 + lane * 2);
    const float v0 = bf_lo(vw), v1 = bf_hi(vw);
    float o0 = 0.f, o1 = 0.f;
#pragma unroll 1
    for (int d0 = 0; d0 < 64; d0 += 16) {
        f32x2 sv[16];
#pragma unroll
        for (int j = 0; j < 16; ++j) sv[j] = __builtin_nontemporal_load((const f32x2*)(S0 + (d0 + j) * 128 + lane * 2));
#pragma unroll
        for (int j = 0; j < 16; ++j) {
            const int dk = d0 + j;
            const float q = __shfl(qv, dk), k = __shfl(kv, dk), al = __shfl(av, dk);
            const float n0 = al * sv[j].x + k * v0, n1 = al * sv[j].y + k * v1;
            __builtin_nontemporal_store((f32x2){n0, n1}, (f32x2*)(S1 + dk * 128 + lane * 2));
            o0 += q * n0; o1 += q * n1;
        }
    }
    const float ss = wave_sum(o0 * o0 + o1 * o1);
    const float rstd = rsqrtf(ss * (1.0f / 128.f) + EPS);
    const unsigned rw = *(const unsigned*)(proj + (size_t)row * NPROJ + PRA + h * 128 + lane * 2);
    const float r0 = bf_lo(rw), r1 = bf_hi(rw);
    const float y0 = o0 * rstd * a.in[I_ONORM][lane * 2] * (r0 / (1.f + __expf(-r0))), y1 = o1 * rstd * a.in[I_ONORM][lane * 2 + 1] * (r1 / (1.f + __expf(-r1)));
    *(unsigned*)(mix + (size_t)row * D + h * 128 + lane * 2) = cvt_pk_bf16(y0, y1);
}

__device__ __forceinline__ void swa_unit_m(const KArgs& a, LAS unsigned char* lds, int unit) {
    const int tid = otid(), lane = tid & 63, wave = __builtin_amdgcn_readfirstlane(tid >> 6);
    const int qb = unit >> 1, kvh = unit & 1; const int q0 = qb * 64, w0 = q0 - 128;
    const bf16_t* proj = (const bf16_t*)(a.ws + WS_BIG);
    bf16_t* mix = (bf16_t*)(a.ws + WS_R1);
    LAS bf16_t* Kl = (LAS bf16_t*)lds;
    LAS bf16_t* Vt = Kl + 192 * 72;
    const float* kn = a.in[I_KNORM];
    const int g = wave & 3, th = wave >> 2, hq = kvh * 4 + g;
    const int r = lane & 31, hh = lane >> 5;
    const int t = q0 + 32 * th + r;
    u32x4 kwv[3], vwv[3], qwv[4];
#pragma unroll
    for (int i = 0; i < 3; ++i) { const int c = tid + i * NTHREADS; const int kk = c >> 3, part = c & 7; const int tk = w0 + kk;
        kwv[i] = (u32x4){0u, 0u, 0u, 0u}; vwv[i] = (u32x4){0u, 0u, 0u, 0u};
        if (tk >= 0) { kwv[i] = *(const u32x4*)(proj + (size_t)tk * NPROJ + PKB + kvh * 64 + part * 8); vwv[i] = *(const u32x4*)(proj + (size_t)tk * NPROJ + PVB + kvh * 64 + part * 8); } }
#pragma unroll
    for (int s = 0; s < 4; ++s) qwv[s] = *(const u32x4*)(proj + (size_t)t * NPROJ + PQB + hq * 64 + 16 * s + 8 * hh);
#pragma unroll
    for (int i = 0; i < 3; ++i) {
        const int c = tid + i * NTHREADS; const int kk = c >> 3, part = c & 7;
        float kf[8]; unpack8(kwv[i], kf);
        const u32x4 vw = vwv[i];
        float ss = 0.f;
#pragma unroll
        for (int j = 0; j < 8; ++j) ss += kf[j] * kf[j];
        ss += __shfl_xor(ss, 1); ss += __shfl_xor(ss, 2); ss += __shfl_xor(ss, 4);
        const float rstd = rsqrtf(ss * (1.0f / 64.f) + EPS);
#pragma unroll
        for (int j = 0; j < 8; ++j) kf[j] = kf[j] * rstd * kn[part * 8 + j];
        u32x4 kw2; kw2.x = cvt_pk_bf16(kf[0], kf[1]); kw2.y = cvt_pk_bf16(kf[2], kf[3]); kw2.z = cvt_pk_bf16(kf[4], kf[5]); kw2.w = cvt_pk_bf16(kf[6], kf[7]);
        *(LAS u32x4*)(Kl + kk * 72 + part * 8) = kw2;
        LAS bf16_t* vt = Vt + (part * 8) * 196 + kk;
        vt[0 * 196] = (bf16_t)(vw.x & 0xffffu); vt[1 * 196] = (bf16_t)(vw.x >> 16); vt[2 * 196] = (bf16_t)(vw.y & 0xffffu); vt[3 * 196] = (bf16_t)(vw.y >> 16);
        vt[4 * 196] = (bf16_t)(vw.z & 0xffffu); vt[5 * 196] = (bf16_t)(vw.z >> 16); vt[6 * 196] = (bf16_t)(vw.w & 0xffffu); vt[7 * 196] = (bf16_t)(vw.w >> 16);
        if (qb == 255 && kk >= 64) {
            const int w = kk - 64;
            float vf[8]; unpack8(vw, vf);
            float* ko = a.out + O_SKP + ((size_t)w * 2 + kvh) * 64 + part * 8; float* vo = a.out + O_SVP + ((size_t)w * 2 + kvh) * 64 + part * 8;
            *(f32x4*)ko = (f32x4){kf[0], kf[1], kf[2], kf[3]}; *(f32x4*)(ko + 4) = (f32x4){kf[4], kf[5], kf[6], kf[7]};
            *(f32x4*)vo = (f32x4){vf[0], vf[1], vf[2], vf[3]}; *(f32x4*)(vo + 4) = (f32x4){vf[4], vf[5], vf[6], vf[7]};
        }
    }
    __syncthreads();
    constexpr float LOG2E = 1.4426950408889634f;
    bf16x8 qf[4];
    {
        float qv[4][8]; float ss = 0.f;
#pragma unroll
        for (int s = 0; s < 4; ++s) { unpack8(qwv[s], qv[s]);
#pragma unroll
            for (int j = 0; j < 8; ++j) ss += qv[s][j] * qv[s][j]; }
        ss += __shfl_xor(ss, 32);
        const float rstd = rsqrtf(ss * (1.0f / 64.f) + EPS) * (0.125f * LOG2E);
        const float* qn = a.in[I_QNORM];
#pragma unroll
        for (int s = 0; s < 4; ++s) {
            u32x4 w;
            w.x = cvt_pk_bf16(qv[s][0] * rstd * qn[16 * s + 8 * hh + 0], qv[s][1] * rstd * qn[16 * s + 8 * hh + 1]);
            w.y = cvt_pk_bf16(qv[s][2] * rstd * qn[16 * s + 8 * hh + 2], qv[s][3] * rstd * qn[16 * s + 8 * hh + 3]);
            w.z = cvt_pk_bf16(qv[s][4] * rstd * qn[16 * s + 8 * hh + 4], qv[s][5] * rstd * qn[16 * s + 8 * hh + 5]);
            w.w = cvt_pk_bf16(qv[s][6] * rstd * qn[16 * s + 8 * hh + 6], qv[s][7] * rstd * qn[16 * s + 8 * hh + 7]);
            qf[s] = __builtin_bit_cast(bf16x8, w);
        }
    }
    f32x16 sacc[5];
#pragma unroll
    for (int k5 = 0; k5 < 5; ++k5) {
        const int kt = th + k5;
        f32x16 acc = {};
#pragma unroll
        for (int s = 0; s < 4; ++s) { const bf16x8 af = *(const LAS bf16x8*)(Kl + (kt * 32 + r) * 72 + 16 * s + 8 * hh); acc = __builtin_amdgcn_mfma_f32_32x32x16_bf16(af, qf[s], acc, 0, 0, 0); }
        sacc[k5] = acc;
    }
    const float slope2 = exp2f(-(float)(hq + 1)) * LOG2E;
    const float sink2 = a.in[I_SINKS][hq] * LOG2E;
    float mx = sink2;
#pragma unroll
    for (int k5 = 0; k5 < 5; ++k5)
#pragma unroll
        for (int i = 0; i < 16; ++i) {
            const int row = (i & 3) + 8 * (i >> 2) + 4 * hh;
            const int dist = 128 - 32 * k5 + r - row;
            const int tk = w0 + 32 * (th + k5) + row;
            float s = sacc[k5][i] - slope2 * (float)dist;
            if (dist < 0 || dist >= 128 || tk < 0) s = -1e30f;
            sacc[k5][i] = s; mx = fmaxf(mx, s);
        }
    mx = fmaxf(mx, __shfl_xor(mx, 32));
    float l = 0.f;
#pragma unroll
    for (int k5 = 0; k5 < 5; ++k5)
#pragma unroll
        for (int i = 0; i < 16; ++i) { const float p = __builtin_amdgcn_exp2f(sacc[k5][i] - mx); sacc[k5][i] = p; l += p; }
    l += __shfl_xor(l, 32);
    l += exp2f(sink2 - mx);
    f32x16 oacc[2] = {{}, {}};
#pragma unroll
    for (int k5 = 0; k5 < 5; ++k5) {
        const int kt = th + k5;
#pragma unroll
        for (int s2 = 0; s2 < 2; ++s2) {
            u32x4 pw;
            pw.x = cvt_pk_bf16(sacc[k5][8 * s2 + 0], sacc[k5][8 * s2 + 1]); pw.y = cvt_pk_bf16(sacc[k5][8 * s2 + 2], sacc[k5][8 * s2 + 3]);
            pw.z = cvt_pk_bf16(sacc[k5][8 * s2 + 4], sacc[k5][8 * s2 + 5]); pw.w = cvt_pk_bf16(sacc[k5][8 * s2 + 6], sacc[k5][8 * s2 + 7]);
            const bf16x8 pf = __builtin_bit_cast(bf16x8, pw);
#pragma unroll
            for (int dt = 0; dt < 2; ++dt) {
                const LAS bf16_t* vp = Vt + (32 * dt + r) * 196 + kt * 32 + 16 * s2 + 4 * hh;
                const u32x2 v0 = *(const LAS u32x2*)vp, v1 = *(const LAS u32x2*)(vp + 8);
                const u32x4 vv = (u32x4){v0.x, v0.y, v1.x, v1.y};
                oacc[dt] = __builtin_amdgcn_mfma_f32_32x32x16_bf16(__builtin_bit_cast(bf16x8, vv), pf, oacc[dt], 0, 0, 0);
            }
        }
    }
    const float inv = 1.f / l;
#pragma unroll
    for (int dt = 0; dt < 2; ++dt)
#pragma unroll
        for (int q = 0; q < 4; ++q) {
            u32x2 w; w.x = cvt_pk_bf16(oacc[dt][4 * q] * inv, oacc[dt][4 * q + 1] * inv); w.y = cvt_pk_bf16(oacc[dt][4 * q + 2] * inv, oacc[dt][4 * q + 3] * inv);
            *(u32x2*)(mix + (size_t)t * D + 512 + hq * 64 + 32 * dt + 8 * q + 4 * hh) = w;
        }
    __syncthreads();
}
__device__ __forceinline__ void swa_decode_item(const KArgs& a, int item, int lane) {
    const int b = item >> 3, kvh = (item >> 2) & 1, g = item & 3, hq = kvh * 4 + g; const int row = SROW + b;
    const bf16_t* proj = (const bf16_t*)(a.ws + WS_BIG);
    bf16_t* mix = (bf16_t*)(a.ws + WS_R1);
    const float* ck = a.in[I_CK] + (size_t)b * 128 * 128 + kvh * 64;
    const float* cv = a.in[I_CV] + (size_t)b * 128 * 128 + kvh * 64;
    float qd = bf2f(proj[(size_t)row * NPROJ + PQB + hq * 64 + lane]);
    { const float ss = wave_sum(qd * qd); qd = qd * rsqrtf(ss * (1.0f / 64.f) + EPS) * a.in[I_QNORM][lane] * 0.125f; }
    float kd = bf2f(proj[(size_t)row * NPROJ + PKB + kvh * 64 + lane]);
    { const float ss = wave_sum(kd * kd); kd = kd * rsqrtf(ss * (1.0f / 64.f) + EPS) * a.in[I_KNORM][lane]; }
    const float vd = bf2f(proj[(size_t)row * NPROJ + PVB + kvh * 64 + lane]);
    const float slope = exp2f(-(float)(hq + 1));
    float s0 = 0.f, s1 = 0.f;
    {
        f32x4 k0[16], k1[16];
#pragma unroll
        for (int i = 0; i < 16; ++i) { k0[i] = *(const f32x4*)(ck + (size_t)lane * 128 + 4 * i); k1[i] = *(const f32x4*)(ck + (size_t)(lane + 64) * 128 + 4 * i); }
#pragma unroll
        for (int i = 0; i < 16; ++i) {
            const float q0 = __shfl(qd, 4 * i), q1 = __shfl(qd, 4 * i + 1), q2 = __shfl(qd, 4 * i + 2), q3 = __shfl(qd, 4 * i + 3);
            s0 += (q0 * k0[i][0] + q1 * k0[i][1]) + (q2 * k0[i][2] + q3 * k0[i][3]);
            s1 += (q0 * k1[i][0] + q1 * k1[i][1]) + (q2 * k1[i][2] + q3 * k1[i][3]);
        }
    }
    s0 -= slope * (float)(128 - lane); s1 -= slope * (float)(64 - lane);
    if (lane == 0) s0 = -1e30f;
    const float sn = wave_sum(qd * kd);
    const float sink = a.in[I_SINKS][hq];
    const float mx = fmaxf(fmaxf(wave_max(fmaxf(s0, s1)), sn), sink);
    const float p0 = __expf(s0 - mx), p1 = __expf(s1 - mx), pn = __expf(sn - mx);
    const float l = wave_sum(p0 + p1) + pn + __expf(sink - mx);
    float od = pn * vd;
#pragma unroll 1
    for (int w0 = 0; w0 < 64; w0 += 16) {
        float ca[16], cb[16];
#pragma unroll
        for (int j = 0; j < 16; ++j) { ca[j] = cv[(size_t)(w0 + j) * 128 + lane]; cb[j] = cv[(size_t)(w0 + j + 64) * 128 + lane]; }
#pragma unroll
        for (int j = 0; j < 16; ++j) { const float pa = __shfl(p0, w0 + j), pb = __shfl(p1, w0 + j); od += pa * ca[j] + pb * cb[j]; }
    }
    od /= l;
    const float oo = __shfl_down(od, 1);
    if ((lane & 1) == 0) *(unsigned*)(mix + (size_t)row * D + 512 + hq * 64 + lane) = cvt_pk_bf16(od, oo);
    {
        float* __restrict__ ko = a.out + O_SKS + (size_t)b * 128 * 128 + kvh * 64; float* __restrict__ vo = a.out + O_SVS + (size_t)b * 128 * 128 + kvh * 64;
        float ka[32], va[32];
#pragma unroll
        for (int j = 0; j < 32; ++j) { const int w = 32 * g + j + 1; ka[j] = (w < 128) ? ck[(size_t)w * 128 + lane] : kd; va[j] = (w < 128) ? cv[(size_t)w * 128 + lane] : vd; }
#pragma unroll
        for (int j = 0; j < 32; ++j) { ko[(size_t)(32 * g + j) * 128 + lane] = ka[j]; vo[(size_t)(32 * g + j) * 128 + lane] = va[j]; }
    }
}

template <int W>
__device__ __forceinline__ void pool_core(const bf16_t* __restrict__ h, const LAS float* rsL, const f32x4 gg, int r0, int half, int c4, bf16_t* __restrict__ d1, float* __restrict__ poolp) {
    const int rb = r0 + 8 * half;
    float xn[23][4];
#pragma unroll
    for (int i = 0; i < 23; ++i) { const int r = rb - 15 + i;
        u32x2 w = (u32x2){0u, 0u};
        if (i >= 16 - W && r >= 0) w = *(const u32x2*)(h + (size_t)r * D + c4);
        const float rs = rsL[8 * half + i];
        xn[i][0] = bf_lo(w.x) * rs * gg[0]; xn[i][1] = bf_hi(w.x) * rs * gg[1]; xn[i][2] = bf_lo(w.y) * rs * gg[2]; xn[i][3] = bf_hi(w.y) * rs * gg[3]; }
    float s[4] = {0.f, 0.f, 0.f, 0.f};
#pragma unroll
    for (int k = 1; k < W; ++k)
#pragma unroll
        for (int j = 0; j < 4; ++j) s[j] += xn[15 - k][j];
#pragma unroll
    for (int i = 0; i < 8; ++i) {
        const int r = rb + i;
        const int cnt = (r + 1 < W) ? r + 1 : W; const float ic = 1.0f / (float)cnt;
        float dd[4];
#pragma unroll
        for (int j = 0; j < 4; ++j) { s[j] += xn[15 + i][j]; dd[j] = s[j] * ic - xn[15 + i][j]; s[j] -= xn[15 + i - (W - 1)][j]; }
        u32x2 w; w.x = cvt_pk_bf16(dd[0], dd[1]); w.y = cvt_pk_bf16(dd[2], dd[3]);
        *(u32x2*)(d1 + (size_t)r * D + c4) = w;
        if (r >= SEQ - 15) *(f32x4*)(poolp + (size_t)(r - (SEQ - 15)) * D + c4) = (f32x4){xn[15 + i][0], xn[15 + i][1], xn[15 + i][2], xn[15 + i][3]};
    }
}
__device__ __forceinline__ void pool_item(const KArgs& a, LAS unsigned char* lds, int item, const float* part_in) {
    const int tid = otid();
    const bf16_t* h = (const bf16_t*)(a.ws + WS_R2 + 4096); bf16_t* d1 = (bf16_t*)(a.ws + WS_R1);
    LAS float* rsL = (LAS float*)lds;
    const int r0 = item * 16;
    __syncthreads();
    if (tid < 31) { const int r = r0 - 15 + tid; float rs = 0.f;
        if (r >= 0) { const f32x4 p0 = *(const f32x4*)(part_in + (long)r * 16), p1 = *(const f32x4*)(part_in + (long)r * 16 + 4), p2 = *(const f32x4*)(part_in + (long)r * 16 + 8), p3 = *(const f32x4*)(part_in + (long)r * 16 + 12);
            const float s = ((p0[0] + p0[1]) + (p0[2] + p0[3])) + ((p1[0] + p1[1]) + (p1[2] + p1[3])) + ((p2[0] + p2[1]) + (p2[2] + p2[3])) + ((p3[0] + p3[1]) + (p3[2] + p3[3]));
            rs = rsqrtf(s * (1.0f / D) + EPS); }
        rsL[tid] = rs; }
    __syncthreads();
    const int c4 = 4 * (tid & 255), half = tid >> 8; const int gq = __builtin_amdgcn_readfirstlane(c4 >> 8);
    const f32x4 gg = *(const f32x4*)(a.in[I_MNO] + c4);
    if (gq == 0) pool_core<2>(h, rsL, gg, r0, half, c4, d1, a.out + O_POOLP);
    else if (gq == 1) pool_core<4>(h, rsL, gg, r0, half, c4, d1, a.out + O_POOLP);
    else if (gq == 2) pool_core<8>(h, rsL, gg, r0, half, c4, d1, a.out + O_POOLP);
    else pool_core<16>(h, rsL, gg, r0, half, c4, d1, a.out + O_POOLP);
}
template <int W>
__device__ __forceinline__ void pool_tile_core(const LAS unsigned char* slab, const LAS float* rsL, const f32x4 gg, int pm, int rl0, int cq, int gq, bf16_t* __restrict__ d1, float* __restrict__ poolp) {
    float xn[23][4];
#pragma unroll
    for (int i = 0; i < 23; ++i) { const int sl = rl0 + i;
        u32x2 w = (u32x2){0u, 0u};
        if (i >= 16 - W) w = *(const LAS u32x2*)(slab + sl * 512 + cq * 8);
        const float rs = rsL[sl];
        xn[i][0] = bf_lo(w.x) * rs * gg[0]; xn[i][1] = bf_hi(w.x) * rs * gg[1]; xn[i][2] = bf_lo(w.y) * rs * gg[2]; xn[i][3] = bf_hi(w.y) * rs * gg[3]; }
    float s[4] = {0.f, 0.f, 0.f, 0.f};
#pragma unroll
    for (int k = 1; k < W; ++k)
#pragma unroll
        for (int j = 0; j < 4; ++j) s[j] += xn[15 - k][j];
    const int c4 = 256 * gq + 4 * cq;
#pragma unroll
    for (int i = 0; i < 8; ++i) {
        const int r = 256 * pm + rl0 + i;
        const int cnt = (r + 1 < W) ? r + 1 : W; const float ic = __builtin_amdgcn_rcpf((float)cnt);
        float dd[4];
#pragma unroll
        for (int j = 0; j < 4; ++j) { s[j] += xn[15 + i][j]; dd[j] = s[j] * ic - xn[15 + i][j]; s[j] -= xn[15 + i - (W - 1)][j]; }
        u32x2 w; w.x = cvt_pk_bf16(dd[0], dd[1]); w.y = cvt_pk_bf16(dd[2], dd[3]);
        *(u32x2*)(d1 + (size_t)r * D + c4) = w;
        if (r >= SEQ - 15) *(f32x4*)(poolp + (size_t)(r - (SEQ - 15)) * D + c4) = (f32x4){xn[15 + i][0], xn[15 + i][1], xn[15 + i][2], xn[15 + i][3]};
    }
}
__device__ __forceinline__ void pool_tile(const KArgs& a, LAS unsigned char* lds, int pm, int gq, const float* part_in) {
    const int tid = otid(), lane = tid & 63, wave = __builtin_amdgcn_readfirstlane(tid >> 6);
    const bf16_t* h = (const bf16_t*)(a.ws + WS_R2 + 4096); bf16_t* d1 = (bf16_t*)(a.ws + WS_R1);
    LAS float* rsL = (LAS float*)(lds + 140288);
    __syncthreads();
    for (int p = wave; p < 136; p += 8) {
        const int sl = 2 * p + (lane >> 5); int r = 256 * pm - 15 + sl; if (r < 0) r = 0; if (r > SEQ - 1) r = SEQ - 1;
        __builtin_amdgcn_global_load_lds((const unsigned*)(h + (size_t)r * D + 256 * gq + 8 * (lane & 31)), (LAS unsigned*)(lds + p * 1024), 16, 0, 0);
    }
    if (tid < 271) { const int r = 256 * pm - 15 + tid; float rs = 0.f;
        if (r >= 0) { const f32x4 p0 = *(const f32x4*)(part_in + (long)r * 16), p1 = *(const f32x4*)(part_in + (long)r * 16 + 4), p2 = *(const f32x4*)(part_in + (long)r * 16 + 8), p3 = *(const f32x4*)(part_in + (long)r * 16 + 12);
            const float s = ((p0[0] + p0[1]) + (p0[2] + p0[3])) + ((p1[0] + p1[1]) + (p1[2] + p1[3])) + ((p2[0] + p2[1]) + (p2[2] + p2[3])) + ((p3[0] + p3[1]) + (p3[2] + p3[3]));
            rs = rsqrtf(s * (1.0f / D) + EPS); }
        rsL[tid] = rs; }
    asm volatile("s_waitcnt vmcnt(0) lgkmcnt(0)" ::: "memory");
    __syncthreads();
    const int cq = lane;
    const f32x4 gg = *(const f32x4*)(a.in[I_MNO] + 256 * gq + 4 * cq);
#pragma unroll 1
    for (int st = 0; st < 4; ++st) {
        const int rl0 = 32 * wave + 8 * st;
        if (gq == 0) pool_tile_core<2>(lds, rsL, gg, pm, rl0, cq, gq, d1, a.out + O_POOLP);
        else if (gq == 1) pool_tile_core<4>(lds, rsL, gg, pm, rl0, cq, gq, d1, a.out + O_POOLP);
        else if (gq == 2) pool_tile_core<8>(lds, rsL, gg, pm, rl0, cq, gq, d1, a.out + O_POOLP);
        else pool_tile_core<16>(lds, rsL, gg, pm, rl0, cq, gq, d1, a.out + O_POOLP);
    }
}
__device__ __forceinline__ void pool_sample_item(const KArgs& a, LAS unsigned char* lds, int b, const float* part_in) {
    const int tid = otid();
    const bf16_t* __restrict__ h = (const bf16_t*)(a.ws + WS_R2 + 4096) + (size_t)(SROW + b) * D; bf16_t* __restrict__ d1 = (bf16_t*)(a.ws + WS_R1);
    const float* __restrict__ st = a.in[I_SPOOL] + (size_t)b * 15 * D; float* __restrict__ so = a.out + O_POOLS + (size_t)b * 15 * D;
    const float rs = s_row_rs(part_in, b);
#pragma unroll
    for (int cc = 0; cc < 2; ++cc) {
        const int c = tid + cc * NTHREADS; const int w = 2 << (c >> 8);
        float sv[15];
#pragma unroll
        for (int j = 0; j < 15; ++j) sv[j] = st[(size_t)j * D + c];
        const float xn = bf2f(h[c]) * rs * a.in[I_MNO][c];
        float sum = xn;
#pragma unroll
        for (int j = 0; j < 15; ++j) sum += (j >= 16 - w) ? sv[j] : 0.f;
        const float dd = sum / (float)w - xn;
        d1[(size_t)(SROW + b) * D + c] = (bf16_t)(cvt_pk_bf16(dd, 0.f) & 0xffffu);
#pragma unroll
        for (int j = 0; j < 14; ++j) so[(size_t)j * D + c] = sv[j + 1];
        so[(size_t)14 * D + c] = xn;
    }
}

#define XB_TMO      128
#define XB_XCNT(j)  (256  + 64 * (j))
#define XB_XSUB(j)  (1280 + 64 * (j))
#define XB_XGEN(j)  (2304 + 64 * (j))
#define XB_TOP      3328
#define XB_TOPGEN   3392
#define XCD_BAR_WORDS 3456
#define XB_SPIN_CAP (1u << 18)
__device__ __forceinline__ unsigned xb_ld(unsigned* p)              { return __hip_atomic_load(p, __ATOMIC_RELAXED, __HIP_MEMORY_SCOPE_AGENT); }
__device__ __forceinline__ unsigned xb_add(unsigned* p, unsigned v) { return __hip_atomic_fetch_add(p, v, __ATOMIC_RELAXED, __HIP_MEMORY_SCOPE_AGENT); }
__device__ __forceinline__ unsigned xb_xcc_id() { return (unsigned)__builtin_amdgcn_s_getreg((3 << 11) | 20) & 0xFu; }
#define XB_SPIN(cond, bar) do { unsigned _sp = 0; while (cond) { __builtin_amdgcn_s_sleep(1); \
    if ((++_sp & 255u) == 0u) { if (xb_ld(&(bar)[XB_TMO])) break; if (_sp > XB_SPIN_CAP) { atomicAdd(&(bar)[XB_TMO], 1u); break; } } } } while (0)
struct XcdBarrier { unsigned* bar; unsigned x; volatile LAS unsigned* st; };
__device__ __forceinline__ XcdBarrier xcd_barrier_post(unsigned* bar, volatile LAS unsigned* st) {
    XcdBarrier b; b.bar = bar; b.x = xb_xcc_id(); b.st = st;
    if (threadIdx.x == 0) (void)xb_add(&bar[XB_XCNT(b.x)], 1u);
    return b;
}
__device__ __forceinline__ void xcd_barrier_complete(unsigned* bar, unsigned x, unsigned& nloc, unsigned& nx) {
    const unsigned G = gridDim.x * gridDim.y * gridDim.z;
    unsigned sum, cnt, mine, sp = 0u;
    for (;;) {
        sum = 0u; cnt = 0u; mine = 0u;
#pragma unroll
        for (unsigned j = 0; j < 16; ++j) { const unsigned c = xb_ld(&bar[XB_XCNT(j)]); sum += c; cnt += (c > 0u) ? 1u : 0u; mine = (j == x) ? c : mine; }
        if (sum == G) break;
        __builtin_amdgcn_s_sleep(1);
        if ((++sp & 255u) == 0u) { if (xb_ld(&bar[XB_TMO])) break; if (sp > XB_SPIN_CAP) { atomicAdd(&bar[XB_TMO], 1u); break; } }
    }
    nloc = mine > 0u ? mine : 1u; nx = cnt > 0u ? cnt : 1u;
}
__device__ __forceinline__ void xcd_barrier(const XcdBarrier& b) {
    asm volatile("s_waitcnt vmcnt(0)" ::: "memory");
    __syncthreads();
    if (threadIdx.x == 0) {
        unsigned* bar = b.bar;
        __builtin_amdgcn_s_waitcnt(0);
        unsigned nloc = b.st[0], nx = b.st[1];
        if (nloc == 0u) { xcd_barrier_complete(bar, b.x, nloc, nx); b.st[0] = nloc; b.st[1] = nx; }
        const unsigned old = xb_add(&bar[XB_XSUB(b.x)], 1u);
        const unsigned gen = old / nloc;
        if (old + 1u == (gen + 1u) * nloc) {
            __builtin_amdgcn_fence(__ATOMIC_RELEASE, "agent");
            asm volatile("s_waitcnt vmcnt(0)" ::: "memory");
            const unsigned og = xb_add(&bar[XB_TOP], 1u);
            const unsigned tg = og / nx;
            if (og + 1u == (tg + 1u) * nx) xb_add(&bar[XB_TOPGEN], 1u);
            else XB_SPIN(xb_ld(&bar[XB_TOPGEN]) == tg, bar);
            __builtin_amdgcn_fence(__ATOMIC_ACQUIRE, "agent");
            xb_add(&bar[XB_XGEN(b.x)], 1u);
            asm volatile("s_waitcnt vmcnt(0)" ::: "memory");
        } else {
            XB_SPIN(xb_ld(&bar[XB_XGEN(b.x)]) == gen, bar);
            __builtin_amdgcn_fence(__ATOMIC_ACQUIRE, "agent");
            asm volatile("s_waitcnt vmcnt(0)" ::: "memory");
        }
    }
    __syncthreads();
}

#ifndef DUPM
#define DUPM 0
#endif
#ifndef SYNCREP
#define SYNCREP 1
#endif
#if defined(PROBE_T)
#define TSTAMP() do { if (stamp_i == PROBE_T) t_a = __builtin_amdgcn_s_memrealtime(); if (stamp_i == PROBE_T + 1) t_b = __builtin_amdgcn_s_memrealtime(); ++stamp_i; } while (0)
#else
#define TSTAMP() do { } while (0)
#endif
#define GSYNC() do { _Pragma("unroll 1") for (int sr_ = 0; sr_ < SYNCREP; ++sr_) xcd_barrier(xbar); TSTAMP(); } while (0)
#define PH(k) _Pragma("unroll 1") for (int rep_ = 0; rep_ < (((DUPM) >> (k)) & 1) + 1; ++rep_)
__global__ void __launch_bounds__(NTHREADS, 2) mega_fwd(KArgs a) {
    extern __shared__ __attribute__((aligned(16))) unsigned char lds_raw[];
    LAS unsigned char* lds = (LAS unsigned char*)lds_raw;
    cg::grid_group grid = cg::this_grid();
    const int G = gridDim.x, bx = blockIdx.x;
    const int vcu = (G % 8 == 0) ? (bx % 8) * (G / 8) + bx / 8 : bx;
    unsigned char* ws = a.ws;
    if (ws == nullptr) grid.sync();
    volatile LAS unsigned* xst = (volatile LAS unsigned*)(lds + LDS_BYTES - 64);
    if (threadIdx.x < 16) xst[threadIdx.x] = 0u;
    __syncthreads();
    const XcdBarrier xbar = xcd_barrier_post((unsigned*)(ws + 16384), xst);
    bf16_t* R1 = (bf16_t*)(ws + WS_R1); bf16_t* R2 = (bf16_t*)(ws + WS_R2 + 4096);
    bf16_t* BIGB = (bf16_t*)(ws + WS_BIG);
    const bf16_t* pbf = (const bf16_t*)(ws + WS_PBF);

#if defined(PROBE_T)
    int stamp_i = 0; unsigned long long t_a = 0, t_b = 0;
    TSTAMP();
#endif
#if defined(PROBE_SUB) || defined(PROBE_P2) || defined(PROBE_P1) || defined(PROBE_E)
    unsigned long long sub_d = 0;
#endif
#ifndef NPASS
#define NPASS 1
#endif
#pragma unroll 1
    for (int pass_ = 0; pass_ < NPASS; ++pass_) {
    if (pass_ > 0) GSYNC();
    PH(0) p0_prologue(a, lds, vcu, G);
    GSYNC();
    PH(1) {
        pg8::Gemm g{R1, (const bf16_t*)(ws + WS_WIN0), 1024, 1024, 1024, 256, 0, 0};
        pg8::StaticOrder S; S.init(64, 10, G, bx);
        EpiProj E{BIGB, (float*)(ws + WS_BIG + BIG_LA), (const float*)(ws + WS_SSQ), a.in[I_BALPHA]};
#if defined(PROBE_P1)
        unsigned long long tq0 = __builtin_amdgcn_s_memrealtime();
#endif
        pg8::gemm_phase(lds, g, S, E);
#if defined(PROBE_P1)
        sub_d = __builtin_amdgcn_s_memrealtime() - tq0;
#endif
        if (bx >= (640 % G)) s_proj_units(a, lds, bx - (640 % G), G - (640 % G));
        if (bx >= (640 % G)) { const int wv = __builtin_amdgcn_readfirstlane(otid() >> 6); __syncthreads(); p3_convert(a, lds, (bx - (640 % G)) * 8 + wv, (G - (640 % G)) * 8, 0, CONV_SPLIT, false); }
#if defined(PROBE_P1)
        if (PROBE_P1 == 1) sub_d = __builtin_amdgcn_s_memrealtime() - tq0;
#endif
    }
    GSYNC();
#if defined(PROBE_P2)
    unsigned long long tp0 = __builtin_amdgcn_s_memrealtime();
#endif
    PH(2) for (int it = vcu; it < 256; it += G) gla_item_m<false>(a, lds, it);
#if defined(PROBE_P2)
    unsigned long long tp1 = __builtin_amdgcn_s_memrealtime();
#endif
    PH(3) for (int it = vcu; it < 512; it += G) swa_unit_m(a, lds, it);
#if defined(PROBE_P2)
    unsigned long long tp2 = __builtin_amdgcn_s_memrealtime();
#endif
    PH(4) { const int tid = otid(), lane = tid & 63, wave = __builtin_amdgcn_readfirstlane(tid >> 6); for (int it = vcu + G * wave; it < 512; it += G * 8) gla_decode_item(a, it, lane); }
    PH(5) { const int tid = otid(), lane = tid & 63, wave = __builtin_amdgcn_readfirstlane(tid >> 6); for (int it = vcu + G * ((wave + 6) & 7); it < 1024; it += G * 8) swa_decode_item(a, it, lane); }
#if defined(PROBE_P2)
    { unsigned long long tp3 = __builtin_amdgcn_s_memrealtime(); sub_d = (PROBE_P2 == 0) ? tp1 - tp0 : (PROBE_P2 == 1) ? tp2 - tp1 : tp3 - tp2; }
#endif
    GSYNC();
    PH(6) { gla_scan_m(a, vcu); const int wv = __builtin_amdgcn_readfirstlane(otid() >> 6); if (wv >= 2) p3_convert(a, lds, vcu * 6 + (wv - 2), G * 6, CONV_SPLIT, CONV_ITEMS, true); }
    GSYNC();
    PH(7) for (int it = vcu; it < 256; it += G) gla_item_m<true>(a, lds, it);
    GSYNC();
    PH(8) {
        pg8::Gemm g{R1, (const bf16_t*)(ws + WS_WOUT0), 1024, 1024, 1024, 256, 0, 0};
        pg8::StaticOrder S; S.init(64, 4, G, bx);
        EpiRes<0, true, true, false> E{a.out, a.in[I_XP], nullptr, R2, part_tab(ws, 0), nullptr, nullptr, nullptr};
        pg8::gemm_phase(lds, g, S, E);
        s_res_units<0, 1024, 1024>(a, lds, bx, G, R1, (const bf16_t*)(ws + WS_WOUT0), nullptr, R2, spart_tab(ws, 0));
    }
#if defined(PROBE_FFNK)
    {
        pg8::Gemm g{R2, (const bf16_t*)(ws + WS_WFFI), 1024, 1024, 1024, 254, -2, 0};
        pg8::StaticOrder S; S.init(65, 22, G, bx);
#if PROBE_FFNK == 1
        EpiNull E{};
#elif PROBE_FFNK == 2
        EpiStoreOnly<0> E{R1};
#else
        EpiStoreOnly<1> E{R1};
#endif
        pg8::gemm_phase(lds, g, S, E);
    }
#endif
#if defined(PROBE_KLOOP)
    {
        pg8::Gemm g{R1, (const bf16_t*)(ws + WS_WOUT0), 1024, 1024, 1024, 256, 0, 0};
        pg8::StaticOrder S; S.init(64, 4, G, bx);
#if PROBE_KVAR == 1
        EpiStoreOnly<0> E{R1};
#elif PROBE_KVAR == 2
        EpiRes<1, true, false, false> E{a.out, nullptr, R2, R1, nullptr, nullptr, nullptr, nullptr};
#else
        EpiNull E{};
#endif
        for (int rep = 0; rep < PROBE_KLOOP; ++rep) pg8::gemm_phase(lds, g, S, E);
    }
#endif
    GSYNC();
#pragma unroll 1
    for (int l = 0; l < 2; ++l) {
        bf16_t* G_ = BIGB;
        bf16_t* PPb = BIGB;
        PH(9) {
            pg8::Gemm g{R2, (const bf16_t*)(ws + WS_WFFI + l * WFFI_BYTES), 1024, 1024, 1024, 254, -2, 0};
            pg8::StaticOrder S; S.init(65, 22, G, bx);
            EpiFfn E{part_tab(ws, l == 0 ? 0 : 3), a.in[I_FCW] + (size_t)l * 3 * DFF, a.in[I_FCB] + (size_t)l * DFF, a.out + O_CONVP + (size_t)l * 2 * DFF, G_};
            pg8::gemm_phase(lds, g, S, E);
            if (bx >= (1430 % G)) s_ffn_units(a, lds, bx - (1430 % G), G - (1430 % G), l, R2, spart_tab(ws, l == 0 ? 0 : 3));
        }
        GSYNC();
        PH(10) {
            pg8::Gemm g{G_, (const bf16_t*)(ws + WS_WFFO + l * WFFO_BYTES), DFF, DFF, DFF, 256, 0, 0};
            pg8::StaticOrder S; S.init(64, 4, G, bx);
            EpiRes<1, true, true, false> E{a.out, nullptr, R2, R1, part_tab(ws, l == 0 ? 1 : 4), nullptr, nullptr, nullptr};
#if defined(PROBE_SUB)
            unsigned long long ts0 = __builtin_amdgcn_s_memrealtime();
#endif
            pg8::gemm_phase(lds, g, S, E);
#if defined(PROBE_SUB)
            unsigned long long ts1 = __builtin_amdgcn_s_memrealtime();
#endif
            s_res_units<1, DFF, DFF>(a, lds, bx, G, G_, (const bf16_t*)(ws + WS_WFFO + l * WFFO_BYTES), R2, R1, spart_tab(ws, l == 0 ? 1 : 4));
#if defined(PROBE_SUB)
            unsigned long long ts2 = __builtin_amdgcn_s_memrealtime();
            xcd_barrier(xbar);
            unsigned long long ts3 = __builtin_amdgcn_s_memrealtime();
            if (l == 0) { sub_d = (PROBE_SUB == 0) ? ts1 - ts0 : (PROBE_SUB == 1) ? ts2 - ts1 : ts3 - ts2; }
#endif
        }
#if !defined(PROBE_SUB)
        GSYNC();
#endif
        PH(11) {
            pg8::Gemm g{pbf + (size_t)l * MT * PLE, (const bf16_t*)(ws + WS_WPROJ + l * WPROJ_BYTES), PLE, PLE, PLE, 256, 0, 0};
            pg8::StaticOrder S; S.init(64, 4, G, bx);
            EpiPP E{PPb};
#if defined(PROBE_E)
            unsigned long long te0 = __builtin_amdgcn_s_memrealtime();
#endif
            pg8::gemm_phase(lds, g, S, E);
#if defined(PROBE_E)
            if (l == 0 && PROBE_E == 0) sub_d = __builtin_amdgcn_s_memrealtime() - te0;
#endif
        }
        PH(12) {
            pg8::Gemm g{R1, (const bf16_t*)(ws + WS_WGATE + l * WGATE_BYTES), 1024, 1024, 1024, 256, 0, 0};
            pg8::StaticOrder S; S.init(64, 4, G, bx);
#if defined(PROBE_E)
            unsigned long long te1 = __builtin_amdgcn_s_memrealtime();
#endif
            if (l == 0) { EpiRes<2, true, true, false> E{a.out, nullptr, R1, R2, part_tab(ws, 2), part_tab(ws, 1), PPb, nullptr}; pg8::gemm_phase(lds, g, S, E);
#if defined(PROBE_E)
                if (PROBE_E == 1) sub_d = __builtin_amdgcn_s_memrealtime() - te1;
                te1 = __builtin_amdgcn_s_memrealtime();
#endif
                s_ple_units<false>(a, lds, bx, G, pbf, (const bf16_t*)(ws + WS_WPROJ), R1, (const bf16_t*)(ws + WS_WGATE), spart_tab(ws, 1), spart_tab(ws, 2), R2);
#if defined(PROBE_E)
                if (PROBE_E == 2) sub_d = __builtin_amdgcn_s_memrealtime() - te1;
#endif
            }
            else { EpiRes<2, false, false, true> E{a.out, nullptr, R1, nullptr, nullptr, part_tab(ws, 4), PPb, nullptr}; pg8::gemm_phase(lds, g, S, E);
                s_ple_units<true>(a, lds, bx, G, pbf + (size_t)MT * PLE, (const bf16_t*)(ws + WS_WPROJ + WPROJ_BYTES), R1, (const bf16_t*)(ws + WS_WGATE + WGATE_BYTES), spart_tab(ws, 4), nullptr, nullptr); }
        }
        if (l == 0) {
            GSYNC();
            PH(13) { for (int it = vcu; it < NS; it += G) pool_sample_item(a, lds, it, spart_tab(ws, 2));
                     for (int it = vcu; it < 256; it += G) pool_tile(a, lds, it >> 2, it & 3, part_tab(ws, 2)); }
            GSYNC();
            PH(14) {
                pg8::Gemm g{R1, (const bf16_t*)(ws + WS_WPOOL), 1024, 256, 256, 256, 0, 256};
                pg8::StaticOrder S; S.init(64, 4, G, bx);
                EpiRes<3, true, true, false> E{a.out, nullptr, R2, R2, part_tab(ws, 3), nullptr, nullptr, a.in[I_POOLSC]};
                pg8::gemm_phase(lds, g, S, E);
                s_res_units<3, 256, 1024>(a, lds, bx, G, R1, (const bf16_t*)(ws + WS_WPOOL), R2, R2, spart_tab(ws, 3));
            }
            GSYNC();
        }
    }
    }
#if defined(PROBE_SUB) || defined(PROBE_P2) || defined(PROBE_P1) || defined(PROBE_E)
    if (blockIdx.x == PROBE_BLK && threadIdx.x == 0) { const unsigned long long t_end = __builtin_amdgcn_s_memrealtime() + sub_d; while (__builtin_amdgcn_s_memrealtime() < t_end) __builtin_amdgcn_s_sleep(8); }
#endif
#if defined(PROBE_T)
    TSTAMP();
    if (blockIdx.x == 0 && threadIdx.x == 0) { const unsigned long long t_end = __builtin_amdgcn_s_memrealtime() + (t_b - t_a); while (__builtin_amdgcn_s_memrealtime() < t_end) __builtin_amdgcn_s_sleep(8); }
#endif
}

extern "C" void kernel_launch(void* const* d_in, const int* in_sizes, int n_in, void* d_out, int out_size, void* d_ws, size_t ws_size, hipStream_t stream) {
    static int grid = 0;
    if (grid == 0) {
        int dev = 0, cus = 0, per_cu = 0;
        hipGetDevice(&dev);
        hipDeviceGetAttribute(&cus, hipDeviceAttributeMultiprocessorCount, dev);
        hipFuncSetAttribute((const void*)mega_fwd, hipFuncAttributeMaxDynamicSharedMemorySize, LDS_BYTES);
        hipOccupancyMaxActiveBlocksPerMultiprocessor(&per_cu, (const void*)mega_fwd, NTHREADS, LDS_BYTES);
        if (per_cu < 1) { fprintf(stderr, "kernel_launch: occupancy query reports %d blocks per CU\n", per_cu); per_cu = 1; }
        if (per_cu > 1) per_cu = 1;
        grid = cus * per_cu;
        (void)hipGetLastError();
    }
    (void)hipMemsetAsync(d_ws, 0, 65536, stream);
    KArgs a{};
    for (int i = 0; i < 29; ++i) a.in[i] = (const float*)d_in[i];
    a.out = (float*)d_out; a.ws = (unsigned char*)d_ws;
    void* args[] = {&a};
    hipError_t e = hipLaunchCooperativeKernel((const void*)mega_fwd, dim3(grid), dim3(NTHREADS), args, LDS_BYTES, stream);
#if defined(PROBE_TWICE)
    (void)hipMemsetAsync(d_ws, 0, 65536, stream);
    e = hipLaunchCooperativeKernel((const void*)mega_fwd, dim3(grid), dim3(NTHREADS), args, LDS_BYTES, stream);
#endif
    if (e != hipSuccess) fprintf(stderr, "cooperative launch failed: %s (grid %d)\n", hipGetErrorString(e), grid);
}
```

```cpp
#include <hip/hip_runtime.h>
#include <hip/hip_cooperative_groups.h>
#include <cstdio>
#include <cstdint>
namespace cg = cooperative_groups;

#define LAS __attribute__((address_space(3)))
typedef unsigned short bf16_t;
typedef short bf16x8 __attribute__((ext_vector_type(8)));
typedef float f32x4 __attribute__((ext_vector_type(4)));
typedef float f32x2 __attribute__((ext_vector_type(2)));
typedef unsigned u32x4 __attribute__((ext_vector_type(4)));
typedef unsigned u32x2 __attribute__((ext_vector_type(2)));
typedef float f32x16 __attribute__((ext_vector_type(16)));

constexpr int D = 1024, SEQ = 16384, NS = 128, DFF = 2816, PLE = 256;
constexpr int SROW = 16510;
constexpr int MT = 16640;
constexpr int MR = 16768;
constexpr int NPROJ = 2304;
constexpr int PQA = 0, PKA = 256, PVA = 512, PRA = 1024, PQB = 1536, PKB = 2048, PVB = 2176;
constexpr float EPS = 1e-6f;
constexpr int NTHREADS = 512;

constexpr size_t O_YP = 0, O_YS = 16777216, O_GLAP = 16908288, O_SKP = 16941056, O_SVP = 16957440, O_POOLP = 16973824, O_CONVP = 16989184,
                 O_GLAS = 17000448, O_SKS = 21194752, O_SVS = 23291904, O_POOLS = 25389056, O_CONVS = 27355136;

constexpr size_t MiB = 1u << 20;
constexpr size_t WS_WIN0 = 1 * MiB, WS_WOUT0 = 6 * MiB, WS_WFFI = 8 * MiB, WS_WFFO = 30 * MiB, WS_WGATE = 41 * MiB, WS_WPROJ = 45 * MiB, WS_WPOOL = 46 * MiB;
constexpr size_t WS_SSQ = 47 * MiB;
constexpr size_t WS_PBF = 55 * MiB, WS_R1 = 72 * MiB, WS_R2 = 105 * MiB, WS_BIG = 138 * MiB;
constexpr size_t PART_STRIDE = (size_t)(MR + 8) * 16 * 4;
constexpr size_t WFFI_BYTES = (size_t)5632 * 1024 * 2, WFFO_BYTES = (size_t)1024 * 2816 * 2, WGATE_BYTES = (size_t)1024 * 1024 * 2, WPROJ_BYTES = (size_t)1024 * 256 * 2;
constexpr size_t BIG_LA = (size_t)MT * NPROJ * 2;
constexpr int LDS_BYTES = 155648;

#ifndef NT_STORES
#define NT_STORES 0
#endif
typedef unsigned u32x4_fwd __attribute__((ext_vector_type(4)));
#if NT_STORES == 2
__device__ __forceinline__ void st16_sc1(void* p, u32x4_fwd v);
#define ST16(p, v) st16_sc1((void*)(p), (v))
#elif NT_STORES
#define ST16(p, v) __builtin_nontemporal_store((v), (p))
#else
#define ST16(p, v) (*(p) = (v))
#endif
#if NT_STORES == 2
__device__ __forceinline__ void st16_sc1(void* p, u32x4_fwd v) { asm volatile("global_store_dwordx4 %0, %1, off sc1\n\ts_nop 1" :: "v"(p), "v"(v) : "memory"); }
#endif
#define LBAR() do { asm volatile("s_waitcnt lgkmcnt(0)" ::: "memory"); __builtin_amdgcn_s_barrier(); asm volatile("" ::: "memory"); } while (0)
__device__ __forceinline__ unsigned cvt_pk_bf16(float lo, float hi) { unsigned r; asm volatile("v_cvt_pk_bf16_f32 %0, %1, %2" : "=v"(r) : "v"(lo), "v"(hi)); return r; }
__device__ __forceinline__ float bf_lo(unsigned w) { return __uint_as_float(w << 16); }
__device__ __forceinline__ float bf_hi(unsigned w) { return __uint_as_float(w & 0xffff0000u); }
__device__ __forceinline__ float bf2f(bf16_t v) { return __uint_as_float(((unsigned)v) << 16); }
__device__ __forceinline__ void unpack8(const u32x4 w, float* f) { f[0] = bf_lo(w.x); f[1] = bf_hi(w.x); f[2] = bf_lo(w.y); f[3] = bf_hi(w.y); f[4] = bf_lo(w.z); f[5] = bf_hi(w.z); f[6] = bf_lo(w.w); f[7] = bf_hi(w.w); }
__device__ __forceinline__ float wave_sum(float v) {
#pragma unroll
    for (int o = 1; o < 64; o <<= 1) v += __shfl_xor(v, o);
    return v;
}
__device__ __forceinline__ float wave_max(float v) {
#pragma unroll
    for (int o = 1; o < 64; o <<= 1) v = fmaxf(v, __shfl_xor(v, o));
    return v;
}
__device__ __forceinline__ int otid() { int t = threadIdx.x; asm volatile("" : "+v"(t)); return t; }
__device__ __forceinline__ bool row_valid(int row) { return row < SEQ || (row >= SROW && row < SROW + NS); }
__device__ __forceinline__ float* hrow_ptr(float* out, int row) { return row < SEQ ? out + O_YP + (size_t)row * D : out + O_YS + (size_t)(row - SROW) * D; }
__device__ __forceinline__ f32x2 gelu_pk(f32x2 v) {
    const f32x2 av = __builtin_elementwise_abs(v), d = av * 0.2316418882f + 1.0f;
    f32x2 t; t.x = __builtin_amdgcn_rcpf(d.x); t.y = __builtin_amdgcn_rcpf(d.y);
    f32x2 q = t * 0.5307027145f + (-0.7265760135f); q = q * t + 0.7107068705f; q = q * t + (-0.142248368f); q = q * t + 0.127414796f; q = q * t;
    const f32x2 s = (v * v) * (-0.72134752044f);
    f32x2 e; e.x = __builtin_amdgcn_exp2f(s.x); e.y = __builtin_amdgcn_exp2f(s.y);
    const f32x2 m = v * (q * e), r = v - m;
    f32x2 o; o.x = v.x < 0.f ? m.x : r.x; o.y = v.y < 0.f ? m.y : r.y; return o;
}

namespace pg8 {
constexpr int BM = 256, BK = 64, HALF = 128, HTB = HALF * BK * 2, STAGE_BYTES = 8 * HTB, NXCD = 8, WGM = 8;
__host__ __device__ __forceinline__ int lds_byte(int r, int c) { const int st = (r >> 4) * 2 + (c >> 5), rr = r & 15, cc = c & 31, ob = rr * 64 + cc * 2; return st * 1024 + (ob ^ (((ob >> 9) & 1) << 5)); }
__host__ __device__ __forceinline__ void stage_rc(int b, int& R, int& C) { const int st = b / 1024, sb = b % 1024, swz = sb ^ (((sb >> 9) & 1) << 5); R = (st >> 1) * 16 + swz / 64; C = (st & 1) * 32 + (swz % 64) / 2; }
__host__ __device__ __forceinline__ int perm32(int rho) { const int n = rho >> 4, i = rho & 15; return 8 * (i >> 2) + 4 * n + (i & 3); }

struct Unit { int pm, pn; };
struct Gemm { const bf16_t* A; const bf16_t* Bt; int lda, ldb, K, mstride, arow0, acolstep; };

struct StaticOrder {
    int nM, nN, nwg, G, c;
    __device__ void init(int nM_, int nN_, int G_, int c_) { nM = nM_; nN = nN_; nwg = nM * nN; G = G_; c = c_; }
    __device__ bool next(int i, Unit& u) const {
        const long L = (long)i * G + c; if (L >= nwg) return false;
        int wgid = (int)L; { const int q = nwg / NXCD, r = nwg % NXCD, xcd = wgid % NXCD, off = wgid / NXCD; wgid = (xcd < r ? xcd * (q + 1) : r * (q + 1) + (xcd - r) * q) + off; }
        const int nig = WGM * nN, gid = wgid / nig, fm = gid * WGM, gsz = (nM - fm) < WGM ? (nM - fm) : WGM;
        u.pm = fm + ((wgid % nig) % gsz); u.pn = (wgid % nig) / gsz; return true;
    }
};

template <class Epi>
__device__ __forceinline__ void gemm_phase(LAS unsigned char* lds, const Gemm g, const StaticOrder& S, const Epi& E) {
    const int tid = otid(), wid = __builtin_amdgcn_readfirstlane(tid >> 6), lane = tid & 63, wr = wid >> 2, wc = wid & 3, fr = lane & 15, fq = lane >> 4;
    const int K = g.K, nt = K / BK;
    unsigned voffA[2], voffB[2];
#pragma unroll
    for (int i = 0; i < 2; ++i) { int R, C; stage_rc(tid * 16 + i * 8192, R, C); const int Rb = (R & ~31) + perm32(R & 31);
        voffA[i] = (unsigned)(R * g.lda + C) * 2u; voffB[i] = (unsigned)(Rb * g.ldb + C) * 2u; }
    const size_t kstep = (size_t)(BK * 2);
    const size_t hstepA = (size_t)HALF * g.lda * 2, hstepB = (size_t)HALF * g.ldb * 2;
    const unsigned ldsw = (unsigned)wid * 1024u;
    const int aoff = lds_byte(wr * 64 + fr, fq * 8), boff = lds_byte(wc * 32 + fr, fq * 8);
#define PG8_SA(b, h) (((b) * 2 + (h)) * HTB)
#define PG8_SB(b, h) ((4 + (b) * 2 + (h)) * HTB)
#define PG8_STAGE(bufoff, gbase, voff) do { _Pragma("unroll") for (int _i = 0; _i < 2; ++_i) \
        __builtin_amdgcn_global_load_lds((const unsigned*)((const char*)(gbase) + (voff)[_i]), (LAS unsigned*)(lds + (bufoff) + ldsw + _i * 8192), 16, 0, 0); } while (0)
#define PG8_LDA(dst, b, h) do { _Pragma("unroll") for (int m = 0; m < 4; ++m) _Pragma("unroll") for (int k = 0; k < 2; ++k) dst[m][k] = *(const LAS bf16x8*)(lds + PG8_SA(b, h) + aoff + m * 2048 + k * 1024); } while (0)
#define PG8_LDB(dst, b, h) do { _Pragma("unroll") for (int n = 0; n < 2; ++n) _Pragma("unroll") for (int k = 0; k < 2; ++k) dst[n][k] = *(const LAS bf16x8*)(lds + PG8_SB(b, h) + boff + n * 2048 + k * 1024); } while (0)
#define PG8_MMA(ai, bj, At, Bt) do { __builtin_amdgcn_s_setprio(1); _Pragma("unroll") for (int m = 0; m < 4; ++m) _Pragma("unroll") for (int n = 0; n < 2; ++n) _Pragma("unroll") for (int k = 0; k < 2; ++k) \
        acc[ai][bj][m][n] = __builtin_amdgcn_mfma_f32_16x16x32_bf16(Bt[n][k], At[m][k], acc[ai][bj][m][n], 0, 0, 0); __builtin_amdgcn_s_setprio(0); } while (0)
#define PG8_WAIT_V(n) asm volatile("s_waitcnt vmcnt(" #n ")" ::: "memory")
#define PG8_WAIT_L(n) asm volatile("s_waitcnt lgkmcnt(" #n ")" ::: "memory")
#define PG8_BAR __builtin_amdgcn_s_barrier()
#define PG8_SCHED __builtin_amdgcn_sched_barrier(0)
#define PG8_ABASE(u) ((const char*)g.A + ((long)((long)(u).pm * g.mstride + g.arow0) * g.lda + (long)(u).pn * g.acolstep) * 2)
#define PG8_BBASE(u) ((const char*)g.Bt + (size_t)(u).pn * 256 * g.ldb * 2)
    Unit cur, nxt; int ui = 0;
    if (!S.next(0, cur)) return;
    f32x4 acc[2][2][4][2];
#pragma unroll
    for (int a = 0; a < 2; ++a)
#pragma unroll
        for (int b = 0; b < 2; ++b)
#pragma unroll
            for (int m = 0; m < 4; ++m)
#pragma unroll
                for (int n = 0; n < 2; ++n) acc[a][b][m][n] = (f32x4){0.f, 0.f, 0.f, 0.f};
    bf16x8 At[4][2], B0[2][2], B1[2][2];
    const char* cA = PG8_ABASE(cur); const char* cB = PG8_BBASE(cur);
    PG8_STAGE(PG8_SB(0, 0), cB, voffB); PG8_STAGE(PG8_SB(0, 1), cB + hstepB, voffB); PG8_STAGE(PG8_SA(0, 0), cA, voffA); PG8_STAGE(PG8_SA(0, 1), cA + hstepA, voffA);
    if (wr == 1) PG8_BAR;
    PG8_WAIT_V(2); PG8_BAR;
    PG8_STAGE(PG8_SB(1, 0), cB + kstep, voffB); PG8_STAGE(PG8_SA(1, 0), cA + kstep, voffA); PG8_STAGE(PG8_SB(1, 1), cB + hstepB + kstep, voffB);
    PG8_WAIT_V(6); PG8_BAR;
    for (;;) {
        const bool has_next = S.next(ui + 1, nxt);
        const char* nA = has_next ? PG8_ABASE(nxt) : cA; const char* nB = has_next ? PG8_BBASE(nxt) : cB;
#pragma unroll 1
        for (int t = 0; t < nt; t += 2) {
            const bool last = (t == nt - 2);
            const char* a1 = cA + (size_t)(t + 1) * kstep;
            const char* a2 = last ? nA : cA + (size_t)(t + 2) * kstep; const char* b2 = last ? nB : cB + (size_t)(t + 2) * kstep;
            const char* a3 = a2 + kstep; const char* b3 = b2 + kstep;
            PG8_LDB(B0, 0, 0); PG8_LDB(B1, 0, 1); PG8_SCHED; PG8_LDA(At, 0, 0); PG8_STAGE(PG8_SA(1, 1), a1 + hstepA, voffA);
            PG8_WAIT_V(8); PG8_WAIT_L(0); PG8_BAR; PG8_MMA(0, 0, At, B0); PG8_MMA(0, 1, At, B1); PG8_BAR; PG8_SCHED;
            PG8_LDA(At, 0, 1); PG8_STAGE(PG8_SB(0, 0), b2, voffB); PG8_STAGE(PG8_SB(0, 1), b2 + hstepB, voffB); PG8_STAGE(PG8_SA(0, 0), a2, voffA);
            PG8_WAIT_V(8); PG8_WAIT_L(0); PG8_BAR; PG8_MMA(1, 0, At, B0); PG8_MMA(1, 1, At, B1); PG8_BAR; PG8_SCHED;
            PG8_LDB(B0, 1, 0); PG8_LDB(B1, 1, 1); PG8_SCHED; PG8_LDA(At, 1, 0); PG8_STAGE(PG8_SA(0, 1), a2 + hstepA, voffA);
            PG8_WAIT_V(8); PG8_WAIT_L(0); PG8_BAR; PG8_MMA(0, 0, At, B0); PG8_MMA(0, 1, At, B1); PG8_BAR; PG8_SCHED;
            PG8_LDA(At, 1, 1); PG8_STAGE(PG8_SB(1, 0), b3, voffB); PG8_STAGE(PG8_SB(1, 1), b3 + hstepB, voffB); PG8_STAGE(PG8_SA(1, 0), a3, voffA);
            PG8_WAIT_V(8); PG8_WAIT_L(0); PG8_BAR; PG8_MMA(1, 0, At, B0); PG8_MMA(1, 1, At, B1); PG8_BAR; PG8_SCHED;
        }
        if (wr == 0) PG8_BAR;
        { int lane2 = lane; asm volatile("" : "+v"(lane2)); E(acc, cur, wr, wc, lane2 & 15, lane2 >> 4, lds + STAGE_BYTES); }
        if (!has_next) break;
#pragma unroll
        for (int a = 0; a < 2; ++a)
#pragma unroll
            for (int b = 0; b < 2; ++b)
#pragma unroll
                for (int m = 0; m < 4; ++m)
#pragma unroll
                    for (int n = 0; n < 2; ++n) acc[a][b][m][n] = (f32x4){0.f, 0.f, 0.f, 0.f};
        cur = nxt; cA = nA; cB = nB; ++ui;
        if (wr == 1) PG8_BAR;
    }
    PG8_WAIT_V(0);
    PG8_BAR;
#undef PG8_SA
#undef PG8_SB
#undef PG8_STAGE
#undef PG8_LDA
#undef PG8_LDB
#undef PG8_MMA
#undef PG8_WAIT_V
#undef PG8_WAIT_L
#undef PG8_BAR
#undef PG8_SCHED
#undef PG8_ABASE
#undef PG8_BBASE
}
}
using pg8::Unit;
typedef f32x4 AccT[2][2][4][2];

__device__ __forceinline__ float row_rs(const float* part, int row, int fq) {
    const f32x4 p = *(const f32x4*)(part + (long)row * 16 + fq * 4);
    float s = (p[0] + p[1]) + (p[2] + p[3]);
    s += __shfl_xor(s, 16); s += __shfl_xor(s, 32);
    return rsqrtf(s * (1.0f / D) + EPS);
}

struct EpiProj {
    bf16_t* proj; float* la; const float* ssq0; const float* b_alpha;
    __device__ __forceinline__ void operator()(const AccT& acc, const Unit& u, int wr, int wc, int fr, int fq, LAS unsigned char*) const {
        float rsv[2][4];
#pragma unroll
        for (int ai = 0; ai < 2; ++ai)
#pragma unroll
            for (int m = 0; m < 4; ++m) rsv[ai][m] = ssq0[u.pm * 256 + ai * 128 + wr * 64 + m * 16 + fr];
        f32x4 bb[2][2];
        if (u.pn >= 9) {
#pragma unroll
            for (int bj = 0; bj < 2; ++bj) { const int c = bj * 128 + wc * 32 + fq * 8; bb[bj][0] = *(const f32x4*)(b_alpha + c); bb[bj][1] = *(const f32x4*)(b_alpha + c + 4); }
        }
#pragma unroll
        for (int ai = 0; ai < 2; ++ai)
#pragma unroll
            for (int m = 0; m < 4; ++m) {
                const int row = u.pm * 256 + ai * 128 + wr * 64 + m * 16 + fr;
                const float rs = rsqrtf(rsv[ai][m] * (1.0f / D) + EPS);
#pragma unroll
                for (int bj = 0; bj < 2; ++bj) {
                    const int col = u.pn * 256 + bj * 128 + wc * 32 + fq * 8;
                    const f32x4 v0 = acc[ai][bj][m][0] * rs, v1 = acc[ai][bj][m][1] * rs;
                    if (u.pn < 9) {
                        u32x4 w; w.x = cvt_pk_bf16(v0[0], v0[1]); w.y = cvt_pk_bf16(v0[2], v0[3]); w.z = cvt_pk_bf16(v1[0], v1[1]); w.w = cvt_pk_bf16(v1[2], v1[3]);
                        ST16((u32x4*)(proj + (size_t)row * NPROJ + col), w);
                    } else {
                        const int c = col - NPROJ;
                        f32x4 o0, o1;
#pragma unroll
                        for (int j = 0; j < 4; ++j) {
                            const float z0 = v0[j] + bb[bj][0][j], z1 = v1[j] + bb[bj][1][j];
                            o0[j] = (fminf(z0, 0.f) - __logf(1.0f + __expf(-fabsf(z0)))) * 0.0625f;
                            o1[j] = (fminf(z1, 0.f) - __logf(1.0f + __expf(-fabsf(z1)))) * 0.0625f;
                        }
                        *(f32x4*)(la + (size_t)row * 256 + c) = o0; *(f32x4*)(la + (size_t)row * 256 + c + 4) = o1;
                    }
                }
            }
    }
};
struct EpiPP {
    bf16_t* pp;
    __device__ __forceinline__ void operator()(const AccT& acc, const Unit& u, int wr, int wc, int fr, int fq, LAS unsigned char*) const {
#pragma unroll
        for (int ai = 0; ai < 2; ++ai)
#pragma unroll
            for (int m = 0; m < 4; ++m) {
                const int row = u.pm * 256 + ai * 128 + wr * 64 + m * 16 + fr;
#pragma unroll
                for (int bj = 0; bj < 2; ++bj) {
                    const int col = u.pn * 256 + bj * 128 + wc * 32 + fq * 8;
                    const f32x4 v0 = acc[ai][bj][m][0], v1 = acc[ai][bj][m][1];
                    u32x4 w; w.x = cvt_pk_bf16(v0[0], v0[1]); w.y = cvt_pk_bf16(v0[2], v0[3]); w.z = cvt_pk_bf16(v1[0], v1[1]); w.w = cvt_pk_bf16(v1[2], v1[3]);
                    ST16((u32x4*)(pp + (size_t)row * D + col), w);
                }
            }
    }
};
template <int MODE, bool WRITE_HB, bool WRITE_PART, bool WRITE_F32>
struct EpiRes {
    float* out; const float* xp; const bf16_t* hbin; bf16_t* hb; float* part; const float* part_in; const bf16_t* pp; const float* scale;
    struct Q { f32x4 xb[2][2][2]; u32x4 hw[2][2]; u32x4 pw[2][2]; f32x4 pin[2]; };
    __device__ __forceinline__ void fetch(Q& q, const Unit& u, int aq, int wr, int wc, int fr, int fq) const {
        const int ai = aq >> 1, m0 = (aq & 1) * 2;
#pragma unroll
        for (int mm = 0; mm < 2; ++mm) {
            const int row = u.pm * 256 + ai * 128 + wr * 64 + (m0 + mm) * 16 + fr;
            if (MODE == 2) q.pin[mm] = *(const f32x4*)(part_in + (long)row * 16 + fq * 4);
#pragma unroll
            for (int bj = 0; bj < 2; ++bj) {
                const int col = u.pn * 256 + bj * 128 + wc * 32 + fq * 8;
                if (MODE == 0) { q.xb[mm][bj][0] = *(const f32x4*)(xp + (size_t)row * D + col); q.xb[mm][bj][1] = *(const f32x4*)(xp + (size_t)row * D + col + 4); }
                else q.hw[mm][bj] = *(const u32x4*)(hbin + (size_t)row * D + col);
                if (MODE == 2) q.pw[mm][bj] = *(const u32x4*)(pp + (size_t)row * D + col);
            }
        }
    }
    __device__ __forceinline__ void operator()(const AccT& acc, const Unit& u, int wr, int wc, int fr, int fq, LAS unsigned char*) const {
        f32x4 sc[2][2];
        if (MODE == 3) {
#pragma unroll
            for (int bj = 0; bj < 2; ++bj) { const int col = u.pn * 256 + bj * 128 + wc * 32 + fq * 8; sc[bj][0] = *(const f32x4*)(scale + col); sc[bj][1] = *(const f32x4*)(scale + col + 4); }
        }
        constexpr bool PIPE = (MODE == 1 || MODE == 3);
        Q qa, qb;
        fetch(qa, u, 0, wr, wc, fr, fq);
#pragma unroll
        for (int aq = 0; aq < 4; ++aq) {
            const int ai = aq >> 1, m0 = (aq & 1) * 2;
            Q& cur = (aq & 1) ? qb : qa; Q& nxt = (aq & 1) ? qa : qb;
            if (PIPE && aq < 3) fetch(nxt, u, aq + 1, wr, wc, fr, fq);
#pragma unroll
            for (int mm = 0; mm < 2; ++mm) {
                const int m = m0 + mm;
                const int row = u.pm * 256 + ai * 128 + wr * 64 + m * 16 + fr;
                float rs = 1.f;
                if (MODE == 2) { float s = (cur.pin[mm][0] + cur.pin[mm][1]) + (cur.pin[mm][2] + cur.pin[mm][3]); s += __shfl_xor(s, 16); s += __shfl_xor(s, 32); rs = rsqrtf(s * (1.0f / D) + EPS); }
                float sq = 0.f;
#pragma unroll
                for (int bj = 0; bj < 2; ++bj) {
                    const int col = u.pn * 256 + bj * 128 + wc * 32 + fq * 8;
                    f32x4 v0 = acc[ai][bj][m][0], v1 = acc[ai][bj][m][1];
                    if (MODE == 2) {
                        float pf[8]; unpack8(cur.pw[mm][bj], pf);
#pragma unroll
                        for (int j = 0; j < 4; ++j) {
                            v0[j] = pf[j] * __builtin_amdgcn_rcpf(1.f + __expf(-v0[j] * rs));
                            v1[j] = pf[4 + j] * __builtin_amdgcn_rcpf(1.f + __expf(-v1[j] * rs));
                        }
                    }
                    if (MODE == 3) { v0 = v0 * sc[bj][0]; v1 = v1 * sc[bj][1]; }
                    f32x4 b0, b1;
                    if (MODE == 0) { b0 = cur.xb[mm][bj][0]; b1 = cur.xb[mm][bj][1]; }
                    else { float bf[8]; unpack8(cur.hw[mm][bj], bf); b0 = (f32x4){bf[0], bf[1], bf[2], bf[3]}; b1 = (f32x4){bf[4], bf[5], bf[6], bf[7]}; }
                    const f32x4 h0 = b0 + v0, h1 = b1 + v1;
                    if (WRITE_F32) { float* hp = out + O_YP + (size_t)row * D; *(f32x4*)(hp + col) = h0; *(f32x4*)(hp + col + 4) = h1; }
                    if (WRITE_HB) { u32x4 w; w.x = cvt_pk_bf16(h0[0], h0[1]); w.y = cvt_pk_bf16(h0[2], h0[3]); w.z = cvt_pk_bf16(h1[0], h1[1]); w.w = cvt_pk_bf16(h1[2], h1[3]);
                        ST16((u32x4*)(hb + (size_t)row * D + col), w); }
                    sq += (h0[0] * h0[0] + h0[1] * h0[1]) + (h0[2] * h0[2] + h0[3] * h0[3]) + (h1[0] * h1[0] + h1[1] * h1[1]) + (h1[2] * h1[2] + h1[3] * h1[3]);
                }
                if (WRITE_PART) {
                    sq += __shfl_xor(sq, 16); sq += __shfl_xor(sq, 32);
                    if (fq == 0) part[(long)row * 16 + u.pn * 4 + wc] = sq;
                }
            }
            if (!PIPE && aq < 3) fetch(nxt, u, aq + 1, wr, wc, fr, fq);
        }
    }
};
struct EpiFfn {
    const float* part_in; const float* convw; const float* convb; float* convp_out; bf16_t* G;
    __device__ __forceinline__ void operator()(AccT& acc, const Unit& u, int wr, int wc, int fr, int fq, LAS unsigned char* ldsx) const {
        const int c0 = u.pn * 128 + wc * 32 + fq * 8;
        f32x4 w0[2], w1[2], w2[2], cb[2];
#pragma unroll
        for (int n = 0; n < 2; ++n) { const int cn = c0 + 4 * n;
            w0[n] = *(const f32x4*)(convw + cn); w1[n] = *(const f32x4*)(convw + DFF + cn); w2[n] = *(const f32x4*)(convw + 2 * DFF + cn); cb[n] = *(const f32x4*)(convb + cn); }
        f32x4 pin[2][4];
#pragma unroll
        for (int ai = 0; ai < 2; ++ai)
#pragma unroll
            for (int m = 0; m < 4; ++m) pin[ai][m] = *(const f32x4*)(part_in + (long)(u.pm * 254 - 2 + ai * 128 + wr * 64 + m * 16 + fr) * 16 + fq * 4);
#pragma unroll
        for (int ai = 0; ai < 2; ++ai)
#pragma unroll
            for (int m = 0; m < 4; ++m) {
                float s_ = (pin[ai][m][0] + pin[ai][m][1]) + (pin[ai][m][2] + pin[ai][m][3]); s_ += __shfl_xor(s_, 16); s_ += __shfl_xor(s_, 32);
                const float rs = rsqrtf(s_ * (1.0f / D) + EPS);
#pragma unroll
                for (int bj = 0; bj < 2; ++bj)
#pragma unroll
                    for (int n = 0; n < 2; ++n) acc[ai][bj][m][n] = acc[ai][bj][m][n] * rs;
            }
        LAS f32x4* xch = (LAS f32x4*)ldsx;
        if (fr >= 14) {
#pragma unroll
            for (int ai = 0; ai < 2; ++ai) {
                const int slot = ((((ai * 2 + wr) * 4 + wc) * 4 + fq) * 2 + (fr - 14)) * 2;
                xch[slot] = acc[ai][0][3][0]; xch[slot + 1] = acc[ai][0][3][1];
            }
        }
        asm volatile("s_waitcnt lgkmcnt(0)" ::: "memory"); __builtin_amdgcn_s_barrier(); asm volatile("" ::: "memory");
#pragma unroll
        for (int ai = 0; ai < 2; ++ai)
#pragma unroll
            for (int m = 0; m < 4; ++m) {
                const int tr = ai * 128 + wr * 64 + m * 16 + fr;
                const int grow = u.pm * 254 - 2 + tr;
                const bool store = (tr >= 2 && grow < SEQ);
                u32x4 w;
#pragma unroll
                for (int n = 0; n < 2; ++n) {
                    const f32x4 x = acc[ai][0][m][n];
                    f32x4 p;
                    if (m == 0) {
                        const int sa = (wr == 1) ? ai : 0, sw = (wr == 1) ? 0 : 1;
                        const bool has = (wr == 1) || (ai == 1);
                        const int slot = ((((sa * 2 + sw) * 4 + wc) * 4 + fq) * 2 + (fr >= 14 ? fr - 14 : 0)) * 2 + n;
                        p = xch[slot];
                        if (!has) p = (f32x4){0.f, 0.f, 0.f, 0.f};
                    } else p = acc[ai][0][m == 0 ? 0 : m - 1][n];
                    f32x4 p1, p2;
#pragma unroll
                    for (int j = 0; j < 4; ++j) {
                        const float xf = x[j], pf = p[j]; const int xi = __float_as_int(xf), pi = __float_as_int(pf);
                        const int r1 = __builtin_amdgcn_mov_dpp(pi, 0x121, 0xf, 0xf, true), r2 = __builtin_amdgcn_mov_dpp(pi, 0x122, 0xf, 0xf, true);
                        p1[j] = __int_as_float(__builtin_amdgcn_update_dpp(r1, xi, 0x111, 0xf, 0xf, false));
                        p2[j] = __int_as_float(__builtin_amdgcn_update_dpp(r2, xi, 0x112, 0xf, 0xf, false));
                    }
                    if (grow >= SEQ - 2 && grow < SEQ) *(f32x4*)(convp_out + (size_t)(grow - (SEQ - 2)) * DFF + c0 + 4 * n) = x;
                    const f32x4 ac = cb[n] + w0[n] * p2 + w1[n] * p1 + w2[n] * x;
                    const f32x4 v = acc[ai][1][m][n];
                    const f32x2 g0 = gelu_pk((f32x2){ac[0], ac[1]}), g1 = gelu_pk((f32x2){ac[2], ac[3]});
                    const unsigned lo = cvt_pk_bf16(g0.x * v[0], g0.y * v[1]), hi = cvt_pk_bf16(g1.x * v[2], g1.y * v[3]);
                    if (n == 0) { w.x = lo; w.y = hi; } else { w.z = lo; w.w = hi; }
                }
                if (store) ST16((u32x4*)(G + (size_t)grow * DFF + c0), w);
                asm volatile("" ::: "memory");
            }
    }
};

template <int NT>
struct EpiStoreOnly {
    bf16_t* dst;
    __device__ __forceinline__ void operator()(const AccT& acc, const Unit& u, int wr, int wc, int fr, int fq, LAS unsigned char*) const {
#pragma unroll
        for (int ai = 0; ai < 2; ++ai)
#pragma unroll
            for (int m = 0; m < 4; ++m) {
                const int row = u.pm * 254 + ai * 128 + wr * 64 + m * 16 + fr;
#pragma unroll
                for (int bj = 0; bj < 2; ++bj) {
                    const int col = (u.pn & 3) * 256 + bj * 128 + wc * 32 + fq * 8;
                    const f32x4 v0 = acc[ai][bj][m][0], v1 = acc[ai][bj][m][1];
                    u32x4 w; w.x = cvt_pk_bf16(v0[0], v0[1]); w.y = cvt_pk_bf16(v0[2], v0[3]); w.z = cvt_pk_bf16(v1[0], v1[1]); w.w = cvt_pk_bf16(v1[2], v1[3]);
                    if (NT) __builtin_nontemporal_store(w, (u32x4*)(dst + (size_t)row * D + col)); else *(u32x4*)(dst + (size_t)row * D + col) = w;
                }
            }
    }
};
struct EpiNull {
    __device__ __forceinline__ void operator()(const AccT& acc, const Unit& u, int wr, int wc, int fr, int fq, LAS unsigned char*) const {
#pragma unroll
        for (int ai = 0; ai < 2; ++ai)
#pragma unroll
            for (int bj = 0; bj < 2; ++bj)
#pragma unroll
                for (int m = 0; m < 4; ++m) { asm volatile("" :: "v"(acc[ai][bj][m][0]), "v"(acc[ai][bj][m][1])); }
    }
};
struct KArgs { const float* in[29]; float* out; unsigned char* ws; };
enum { I_XP = 0, I_XS, I_PP, I_PS, I_SGLA, I_CK, I_CV, I_SPOOL, I_SCONV, I_MNE, I_WIN, I_WALPHA, I_BALPHA, I_ONORM, I_QNORM, I_KNORM, I_SINKS, I_WOUT,
       I_MNO, I_POOLW, I_POOLSC, I_FNORM, I_FWIN, I_FCW, I_FCB, I_FWOUT, I_PNORM, I_PWPROJ, I_PWGATE };

__device__ __forceinline__ float* part_tab(unsigned char* ws, int i) { return (float*)(ws + WS_SSQ + 262144 + (size_t)i * PART_STRIDE) + 2 * 16; }

constexpr int SG_STAGE = 24576, SG_NST = 6, SPART_PITCH = 36;
constexpr size_t WS_SPART = WS_SSQ + 6750208;
__device__ __forceinline__ float* spart_tab(unsigned char* ws, int i) { return (float*)(ws + WS_SPART) + (size_t)i * 128 * 32; }
template <int K, int LDA, int LDB>
__device__ __forceinline__ void sgemm_tile(const bf16_t* __restrict__ A, const bf16_t* __restrict__ B0, const bf16_t* __restrict__ B1, LAS unsigned char* lds) {
    const int tid = otid(), lane = tid & 63, wave = __builtin_amdgcn_readfirstlane(tid >> 6);
    const int fr = lane & 15, fq = lane >> 4, mb = wave >> 1, nb = wave & 1;
    constexpr int NSTG = K / 128;
    static_assert(K % 128 == 0 && NSTG >= 2, "K must be a multiple of 128");
    const int prow = lane >> 4, ppc = lane & 15;
    const char* gsrc[3]; unsigned ldst[3];
#pragma unroll
    for (int j = 0; j < 3; ++j) {
        if (j < 2) { const int i = wave + 8 * j, row = 4 * i + prow; gsrc[j] = (const char*)(A + (size_t)row * LDA) + 16 * (ppc ^ (row & 15)); ldst[j] = (unsigned)i * 1024u; }
        else { const int row = 4 * wave + prow; const bf16_t* bp = row < 16 ? B0 + (size_t)row * LDB : B1 + (size_t)(row - 16) * LDB; gsrc[j] = (const char*)bp + 16 * (ppc ^ (row & 15)); ldst[j] = 16384u + (unsigned)wave * 1024u; }
    }
#define SG_DMA(c) do { const int st_ = ((c) % SG_NST) * SG_STAGE; _Pragma("unroll") for (int j_ = 0; j_ < 3; ++j_) \
        __builtin_amdgcn_global_load_lds((const unsigned*)(gsrc[j_] + (size_t)(c) * 256), (LAS unsigned*)(lds + st_ + ldst[j_]), 16, 0, 0); } while (0)
    f32x4 acc = (f32x4){0.f, 0.f, 0.f, 0.f};
    int aoff[4], boff[4];
#pragma unroll
    for (int s = 0; s < 4; ++s) { aoff[s] = (16 * mb + fr) * 256 + 16 * ((4 * s + fq) ^ fr); boff[s] = 16384 + (16 * nb + fr) * 256 + 16 * ((4 * s + fq) ^ fr); }
#pragma unroll
    for (int c = 0; c < (NSTG < 5 ? NSTG : 5); ++c) SG_DMA(c);
#pragma unroll 1
    for (int c = 0; c < NSTG; ++c) {
        if (c + 5 < NSTG) SG_DMA(c + 5);
        const int ahead = (NSTG - 1 - c) < 5 ? (NSTG - 1 - c) : 5;
        if (ahead == 5) asm volatile("s_waitcnt vmcnt(15)" ::: "memory");
        else if (ahead == 4) asm volatile("s_waitcnt vmcnt(12)" ::: "memory");
        else if (ahead == 3) asm volatile("s_waitcnt vmcnt(9)" ::: "memory");
        else if (ahead == 2) asm volatile("s_waitcnt vmcnt(6)" ::: "memory");
        else if (ahead == 1) asm volatile("s_waitcnt vmcnt(3)" ::: "memory");
        else asm volatile("s_waitcnt vmcnt(0)" ::: "memory");
        __builtin_amdgcn_s_barrier(); asm volatile("" ::: "memory");
        const LAS unsigned char* st = lds + (c % SG_NST) * SG_STAGE;
#pragma unroll
        for (int s = 0; s < 4; ++s) {
            const bf16x8 af = *(const LAS bf16x8*)(st + aoff[s]), bf = *(const LAS bf16x8*)(st + boff[s]);
            acc = __builtin_amdgcn_mfma_f32_16x16x32_bf16(bf, af, acc, 0, 0, 0);
        }
        asm volatile("s_waitcnt lgkmcnt(0)" ::: "memory"); __builtin_amdgcn_s_barrier(); asm volatile("" ::: "memory");
    }
#undef SG_DMA
    *(LAS f32x4*)((LAS float*)lds + (16 * mb + fr) * SPART_PITCH + 16 * nb + 4 * fq) = acc;
}
__device__ __forceinline__ f32x4 sread4(const LAS unsigned char* lds, int b, int col0) { return *(const LAS f32x4*)((const LAS float*)lds + b * SPART_PITCH + col0); }
__device__ __forceinline__ float s_row_rs(const float* spart, int sb) {
    const float* p = spart + (size_t)sb * 32; float s = 0.f;
#pragma unroll
    for (int i = 0; i < 32; i += 4) { const f32x4 v = *(const f32x4*)(p + i); s += (v[0] + v[1]) + (v[2] + v[3]); }
    return rsqrtf(s * (1.0f / D) + EPS);
}
template <int MODE, bool WRITE_HB, bool WRITE_PART, bool WRITE_F32>
__device__ __forceinline__ void s_res_epi(const KArgs& a, int sb, int q, int cu, const f32x4 v, const bf16_t* hbin, bf16_t* hb, float* spart, const f32x4 ppv, float rs_in, const float* scale) {
    const int row = SROW + sb, c0 = 32 * cu + 4 * q;
    f32x4 base;
    if (MODE == 0) base = *(const f32x4*)(a.in[I_XS] + (size_t)sb * D + c0);
    else { const u32x2 w = *(const u32x2*)(hbin + (size_t)row * D + c0); base = (f32x4){bf_lo(w.x), bf_hi(w.x), bf_lo(w.y), bf_hi(w.y)}; }
    f32x4 hn; float sq = 0.f;
#pragma unroll
    for (int j = 0; j < 4; ++j) {
        float nv = v[j];
        if (MODE == 2) nv = ppv[j] * __builtin_amdgcn_rcpf(1.f + __expf(-nv * rs_in));
        if (MODE == 3) nv = nv * scale[c0 + j];
        hn[j] = base[j] + nv; sq += hn[j] * hn[j];
    }
    if (WRITE_F32) *(f32x4*)(a.out + O_YS + (size_t)sb * D + c0) = hn;
    if (WRITE_HB) { u32x2 w; w.x = cvt_pk_bf16(hn[0], hn[1]); w.y = cvt_pk_bf16(hn[2], hn[3]); *(u32x2*)(hb + (size_t)row * D + c0) = w; }
    if (WRITE_PART) {
        sq += __shfl_xor(sq, 1); sq += __shfl_xor(sq, 2); sq += __shfl_xor(sq, 4);
        if (q == 0) spart[(size_t)sb * 32 + cu] = sq;
    }
}
__device__ __forceinline__ void s_proj_units(const KArgs& a, LAS unsigned char* lds, int u0, int ustep) {
    const bf16_t* xbf = (const bf16_t*)(a.ws + WS_R1) + (size_t)SROW * D; const bf16_t* W = (const bf16_t*)(a.ws + WS_WIN0);
    bf16_t* proj = (bf16_t*)(a.ws + WS_BIG); float* la = (float*)(a.ws + WS_BIG + BIG_LA); const float* ssq0 = (const float*)(a.ws + WS_SSQ);
    for (int u = u0; u < 160; u += ustep) {
        const int rh = u & 1, cu = u >> 1, n0 = cu * 32;
        sgemm_tile<1024, 1024, 1024>(xbf + (size_t)(64 * rh) * D, W + (size_t)n0 * 1024, W + (size_t)(n0 + 16) * 1024, lds);
        __syncthreads();
        const int tid = otid(), b = tid >> 3, q = tid & 7, sb = 64 * rh + b, c0 = n0 + 4 * q, row = SROW + sb;
        const f32x4 v = sread4(lds, b, 4 * q);
        const float rs = rsqrtf(ssq0[row] * (1.0f / D) + EPS);
        if (n0 < NPROJ) {
            u32x2 w; w.x = cvt_pk_bf16(v[0] * rs, v[1] * rs); w.y = cvt_pk_bf16(v[2] * rs, v[3] * rs);
            *(u32x2*)(proj + (size_t)row * NPROJ + c0) = w;
        } else {
            const int c = c0 - NPROJ; f32x4 o;
#pragma unroll
            for (int i = 0; i < 4; ++i) { const float z = v[i] * rs + a.in[I_BALPHA][c + i]; o[i] = (fminf(z, 0.f) - __logf(1.0f + __expf(-fabsf(z)))) * 0.0625f; }
            *(f32x4*)(la + (size_t)row * 256 + c) = o;
        }
        __syncthreads();
    }
}
template <int MODE, int K, int LDA>
__device__ __forceinline__ void s_res_units(const KArgs& a, LAS unsigned char* lds, int u0, int ustep, const bf16_t* A, const bf16_t* W, const bf16_t* hbin, bf16_t* hb, float* spart_out) {
    for (int u = u0; u < 64; u += ustep) {
        const int rh = u & 1, cu = u >> 1, n0 = cu * 32;
        const bf16_t* Au = A + (size_t)(SROW + 64 * rh) * LDA + (MODE == 3 ? (n0 >> 8) * 256 : 0);
        sgemm_tile<K, LDA, K>(Au, W + (size_t)n0 * K, W + (size_t)(n0 + 16) * K, lds);
        __syncthreads();
        const int tid = otid(), b = tid >> 3, q = tid & 7;
        const f32x4 v = sread4(lds, b, 4 * q);
        s_res_epi<MODE, true, true, false>(a, 64 * rh + b, q, cu, v, hbin, hb, spart_out, v, 1.f, a.in[I_POOLSC]);
        __syncthreads();
    }
}
template <bool LAST>
__device__ __forceinline__ void s_ple_units(const KArgs& a, LAS unsigned char* lds, int u0, int ustep, const bf16_t* pb, const bf16_t* Wp, const bf16_t* hbA, const bf16_t* Wg, const float* spart_in, float* spart_out, bf16_t* hbout) {
    for (int u = u0; u < 64; u += ustep) {
        const int rh = u & 1, cu = u >> 1, n0 = cu * 32;
        sgemm_tile<256, 256, 256>(pb + (size_t)(SROW + 64 * rh) * PLE, Wp + (size_t)n0 * PLE, Wp + (size_t)(n0 + 16) * PLE, lds);
        __syncthreads();
        const int tid = otid(), b = tid >> 3, q = tid & 7;
        const f32x4 ppv = sread4(lds, b, 4 * q);
        __syncthreads();
        sgemm_tile<1024, 1024, 1024>(hbA + (size_t)(SROW + 64 * rh) * D, Wg + (size_t)n0 * D, Wg + (size_t)(n0 + 16) * D, lds);
        __syncthreads();
        const f32x4 v = sread4(lds, b, 4 * q);
        const float rs = s_row_rs(spart_in, 64 * rh + b);
        s_res_epi<2, !LAST, !LAST, LAST>(a, 64 * rh + b, q, cu, v, hbA, hbout, spart_out, ppv, rs, nullptr);
        __syncthreads();
    }
}
__device__ __forceinline__ void s_ffn_units(const KArgs& a, LAS unsigned char* lds, int u0, int ustep, int l, const bf16_t* hbA, const float* spart_in) {
    const bf16_t* W = (const bf16_t*)(a.ws + WS_WFFI + l * WFFI_BYTES);
    bf16_t* Gb = (bf16_t*)(a.ws + WS_BIG);
    const float* convw = a.in[I_FCW] + (size_t)l * 3 * DFF; const float* convb = a.in[I_FCB] + (size_t)l * DFF;
    const float* cstate = a.in[I_SCONV] + (size_t)l * NS * 2 * DFF; float* convs = a.out + O_CONVS + (size_t)l * NS * 2 * DFF;
    for (int u = u0; u < 352; u += ustep) {
        const int rh = u & 1, cu = u >> 1, ca = cu * 16;
        const int nr = 256 * (ca >> 7) + (ca & 127);
        sgemm_tile<1024, 1024, 1024>(hbA + (size_t)(SROW + 64 * rh) * D, W + (size_t)nr * 1024, W + (size_t)(nr + 128) * 1024, lds);
        __syncthreads();
        const int tid = otid(), b = tid >> 3, q = tid & 7, sb = 64 * rh + b;
        if (q < 4) {
            const int c = ca + 4 * q;
            const f32x4 av = sread4(lds, b, 4 * q), vv = sread4(lds, b, 16 + 4 * q);
            const float rs = s_row_rs(spart_in, sb);
            const float* st = cstate + (size_t)sb * 2 * DFF + c; float* so = convs + (size_t)sb * 2 * DFF + c;
            const f32x4 p2 = *(const f32x4*)(st), p1 = *(const f32x4*)(st + DFF);
            const f32x4 w0 = *(const f32x4*)(convw + c), w1 = *(const f32x4*)(convw + DFF + c), w2 = *(const f32x4*)(convw + 2 * DFF + c), cb = *(const f32x4*)(convb + c);
            const f32x4 x = av * rs;
            *(f32x4*)(so) = p1; *(f32x4*)(so + DFF) = x;
            const f32x4 ac = cb + w0 * p2 + w1 * p1 + w2 * x;
            const f32x2 g0 = gelu_pk((f32x2){ac[0], ac[1]}), g1 = gelu_pk((f32x2){ac[2], ac[3]});
            u32x2 w; w.x = cvt_pk_bf16(g0.x * vv[0] * rs, g0.y * vv[1] * rs); w.y = cvt_pk_bf16(g1.x * vv[2] * rs, g1.y * vv[3] * rs);
            *(u32x2*)(Gb + (size_t)(SROW + sb) * DFF + c) = w;
        }
        __syncthreads();
    }
}

__device__ __forceinline__ void tr_item(const float* W, int ldsrc, int scol0, int k0, const float* gain, bf16_t* dst, int ldd, int drow0, LAS float* scr, int lane) {
    float wv[32];
#pragma unroll
    for (int i = 0; i < 32; ++i) { const int kk = 2 * i + (lane >> 5); wv[i] = __builtin_nontemporal_load(W + (size_t)(k0 + kk) * ldsrc + scol0 + (lane & 31)); }
#pragma unroll
    for (int i = 0; i < 32; ++i) { const int kk = 2 * i + (lane >> 5); const float gsc = gain ? gain[k0 + kk] : 1.f; scr[kk * 33 + (lane & 31)] = wv[i] * gsc; }
    asm volatile("s_waitcnt lgkmcnt(0)" ::: "memory");
    const int c = lane & 7;
#pragma unroll
    for (int j = 0; j < 4; ++j) { const int n = (lane >> 3) + 8 * j; const LAS float* s = scr + (8 * c) * 33 + n;
        u32x4 o; o.x = cvt_pk_bf16(s[0 * 33], s[1 * 33]); o.y = cvt_pk_bf16(s[2 * 33], s[3 * 33]); o.z = cvt_pk_bf16(s[4 * 33], s[5 * 33]); o.w = cvt_pk_bf16(s[6 * 33], s[7 * 33]);
        *(u32x4*)(dst + (size_t)(drow0 + n) * ldd + k0 + 8 * c) = o; }
    asm volatile("s_waitcnt lgkmcnt(0)" ::: "memory");
}
__device__ __forceinline__ void weff_item(const float* Win, const float* wal, int n0, int k0, const float* gain, bf16_t* dst, int drow0, LAS float* scr, int lane) {
#pragma unroll 2
    for (int i = 0; i < 32; ++i) { const int kk = 2 * i + (lane >> 5); const int k = k0 + kk; float s = 0.f;
#pragma unroll
        for (int r = 0; r < 16; ++r) s += Win[(size_t)k * 2320 + 1024 + r] * wal[r * 256 + n0 + (lane & 31)];
        scr[kk * 33 + (lane & 31)] = s * gain[k]; }
    asm volatile("s_waitcnt lgkmcnt(0)" ::: "memory");
    const int c = lane & 7;
#pragma unroll
    for (int j = 0; j < 4; ++j) { const int n = (lane >> 3) + 8 * j; const LAS float* s = scr + (8 * c) * 33 + n;
        u32x4 o; o.x = cvt_pk_bf16(s[0 * 33], s[1 * 33]); o.y = cvt_pk_bf16(s[2 * 33], s[3 * 33]); o.z = cvt_pk_bf16(s[4 * 33], s[5 * 33]); o.w = cvt_pk_bf16(s[6 * 33], s[7 * 33]);
        *(u32x4*)(dst + (size_t)(drow0 + n) * 1024 + k0 + 8 * c) = o; }
    asm volatile("s_waitcnt lgkmcnt(0)" ::: "memory");
}

__device__ __forceinline__ void p0_prologue(const KArgs& a, LAS unsigned char* lds, int vcu, int G) {
    const int tid = otid(), lane = tid & 63, wave = __builtin_amdgcn_readfirstlane(tid >> 6);
    LAS float* scr = (LAS float*)(lds + wave * 16384);
    const int gw = vcu * 8 + wave, NGW = G * 8;
    unsigned char* ws = a.ws;
    constexpr int I_A = 16 * 72, I_E = 16 * 8;
    for (int it = gw; it < I_A + I_E; it += NGW) {
        int r = it;
        if (r < I_A) { const int kb = r / 72, nb = r % 72, n0 = nb * 32; tr_item(a.in[I_WIN], 2320, n0 < 1024 ? n0 : n0 + 16, kb * 64, a.in[I_MNE], (bf16_t*)(ws + WS_WIN0), 1024, n0, scr, lane); continue; } r -= I_A;
        { const int kb = r / 8, nb = r % 8; weff_item(a.in[I_WIN], a.in[I_WALPHA], nb * 32, kb * 64, a.in[I_MNE], (bf16_t*)(ws + WS_WIN0), NPROJ + nb * 32, scr, lane); }
    }
    bf16_t* xbf = (bf16_t*)(ws + WS_R1);
    float* ssq0 = (float*)(ws + WS_SSQ);
    for (int row0 = gw * 2; row0 < MT; row0 += NGW * 2) {
        f32x4 v[2][4];
#pragma unroll
        for (int rr = 0; rr < 2; ++rr) { const int row = row0 + rr;
            const float* src = row < SEQ ? a.in[I_XP] + (size_t)row * D : ((row >= SROW && row < SROW + NS) ? a.in[I_XS] + (size_t)(row - SROW) * D : nullptr);
#pragma unroll
            for (int j = 0; j < 4; ++j) { v[rr][j] = (f32x4){0.f, 0.f, 0.f, 0.f}; if (src) v[rr][j] = __builtin_nontemporal_load((const f32x4*)(src + j * 256 + lane * 4)); } }
#pragma unroll
        for (int rr = 0; rr < 2; ++rr) { const int row = row0 + rr; float s = 0.f;
#pragma unroll
            for (int j = 0; j < 4; ++j) { const f32x4 x = v[rr][j]; s += (x[0] * x[0] + x[1] * x[1]) + (x[2] * x[2] + x[3] * x[3]);
                u32x2 w; w.x = cvt_pk_bf16(x[0], x[1]); w.y = cvt_pk_bf16(x[2], x[3]);
                *(u32x2*)(xbf + (size_t)row * D + j * 256 + lane * 4) = w; }
            s = wave_sum(s);
            if (lane == 0) ssq0[row] = s; }
    }
    if (vcu == 0) { for (int i = tid; i < 256; i += NTHREADS) ((u32x4*)(ws + WS_R2))[i] = (u32x4){0u, 0u, 0u, 0u}; }
    if (vcu == 1 && tid < 6 * 32) { float* pt = (float*)(ws + WS_SSQ + 262144 + (size_t)(tid >> 5) * PART_STRIDE); pt[tid & 31] = 0.f; }
}
constexpr int CONV_ITEMS = 16 * 32 + 2 * 16 * 176 + 2 * 44 * 32 + 2 * 16 * 32 + 2 * 4 * 32 + 4 * 32;
constexpr int CONV_SPLIT = 10368;
__device__ __forceinline__ void p3_convert(const KArgs& a, LAS unsigned char* lds, int gw, int NGW, int it_lo, int it_hi, bool do_p) {
    const int tid = otid(), lane = tid & 63, wave = __builtin_amdgcn_readfirstlane(tid >> 6);
    LAS float* scr = (LAS float*)(lds + wave * 16384);
    unsigned char* ws = a.ws;
    constexpr int I_O = 16 * 32, I_FI = 16 * 176, I_FO = 44 * 32, I_G = 16 * 32, I_P = 4 * 32, I_PL = 4 * 32;
    static_assert(CONV_ITEMS == I_O + 2 * I_FI + 2 * I_FO + 2 * I_G + 2 * I_P + I_PL, "item count");
    for (int it = it_lo + gw; it < it_hi; it += NGW) {
        int r = it;
        if (r < I_O) { const int kb = r / 32, nb = r % 32; tr_item(a.in[I_WOUT], 1024, nb * 32, kb * 64, nullptr, (bf16_t*)(ws + WS_WOUT0), 1024, nb * 32, scr, lane); continue; } r -= I_O;
        if (r < 2 * I_FI) { const int l = r / I_FI, q = r % I_FI, kb = q / 176, nb = q % 176, n0 = nb * 32;
            const int pn = n0 >> 8, rr = n0 & 255, bj = rr >> 7, ii = rr & 127;
            tr_item(a.in[I_FWIN] + (size_t)l * 1024 * 5632, 5632, bj * DFF + pn * 128 + ii, kb * 64, a.in[I_FNORM] + l * 1024, (bf16_t*)(ws + WS_WFFI + l * WFFI_BYTES), 1024, n0, scr, lane); continue; } r -= 2 * I_FI;
        if (r < 2 * I_FO) { const int l = r / I_FO, q = r % I_FO, kb = q / 32, nb = q % 32;
            tr_item(a.in[I_FWOUT] + (size_t)l * DFF * 1024, 1024, nb * 32, kb * 64, nullptr, (bf16_t*)(ws + WS_WFFO + l * WFFO_BYTES), DFF, nb * 32, scr, lane); continue; } r -= 2 * I_FO;
        if (r < 2 * I_G) { const int l = r / I_G, q = r % I_G, kb = q / 32, nb = q % 32;
            tr_item(a.in[I_PWGATE] + (size_t)l * 1024 * 1024, 1024, nb * 32, kb * 64, a.in[I_PNORM] + l * 1024, (bf16_t*)(ws + WS_WGATE + l * WGATE_BYTES), 1024, nb * 32, scr, lane); continue; } r -= 2 * I_G;
        if (r < 2 * I_P) { const int l = r / I_P, q = r % I_P, kb = q / 32, nb = q % 32;
            tr_item(a.in[I_PWPROJ] + (size_t)l * 256 * 1024, 1024, nb * 32, kb * 64, nullptr, (bf16_t*)(ws + WS_WPROJ + l * WPROJ_BYTES), 256, nb * 32, scr, lane); continue; } r -= 2 * I_P;
        { const int gq = r / 32, q = r % 32, kb = q / 8, nb = q % 8;
            tr_item(a.in[I_POOLW] + (size_t)gq * 65536, 256, nb * 32, kb * 64, nullptr, (bf16_t*)(ws + WS_WPOOL), 256, gq * 256 + nb * 32, scr, lane); }
    }
    bf16_t* pbf = (bf16_t*)(ws + WS_PBF);
    if (do_p)
    for (int it0 = gw * 4; it0 < 2 * MT; it0 += NGW * 4) {
        f32x4 v[4];
#pragma unroll
        for (int rr = 0; rr < 4; ++rr) { const int it = it0 + rr; const int l = it / MT, row = it % MT;
            const float* src = row < SEQ ? a.in[I_PP] + ((size_t)l * SEQ + row) * PLE : ((row >= SROW && row < SROW + NS) ? a.in[I_PS] + ((size_t)l * NS + (row - SROW)) * PLE : nullptr);
            v[rr] = (f32x4){0.f, 0.f, 0.f, 0.f}; if (src) v[rr] = __builtin_nontemporal_load((const f32x4*)(src + lane * 4)); }
#pragma unroll
        for (int rr = 0; rr < 4; ++rr) { u32x2 w; w.x = cvt_pk_bf16(v[rr][0], v[rr][1]); w.y = cvt_pk_bf16(v[rr][2], v[rr][3]);
            *(u32x2*)(pbf + (size_t)(it0 + rr) * PLE + lane * 4) = w; }
    }
}

__device__ __forceinline__ int crow(int i, int hh) { return (i & 3) + 8 * (i >> 2) + 4 * hh; }
template <bool OUT>
__device__ __forceinline__ void gla_item_m(const KArgs& a, LAS unsigned char* lds, int item) {
    const int tid = otid(), lane = tid & 63, wave = __builtin_amdgcn_readfirstlane(tid >> 6);
    const int sc = item >> 2, h = item & 3;
    const bf16_t* proj = (const bf16_t*)(a.ws + WS_BIG); const float* la = (const float*)(a.ws + WS_BIG + BIG_LA);
    bf16_t* mix = (bf16_t*)(a.ws + WS_R1);
    float* US = (float*)(a.ws + WS_R2 + 4096); float* DS = US + (size_t)64 * 4 * 64 * 128;
    LAS float* bL = (LAS float*)lds; LAS float* segS = (LAS float*)(lds + 16384);
    LAS bf16_t* Qn = (LAS bf16_t*)(lds + 18432); LAS bf16_t* Kn = (LAS bf16_t*)(lds + 27648); LAS bf16_t* KT = (LAS bf16_t*)(lds + 36864);
    LAS bf16_t* VT = (LAS bf16_t*)(lds + 46080); LAS bf16_t* ST = (LAS bf16_t*)(lds + 64512); LAS float* red = (LAS float*)(lds + 82944);
    const int r = lane & 31, hh = lane >> 5;
    const int dkt = wave & 1, dvt = wave >> 1, it = wave & 1;
    f32x16 S = {};
    float* usp = US + ((size_t)(sc * 4 + h) * 64 + 32 * dkt) * 128 + 32 * dvt + r;
    if (OUT) {
#pragma unroll
        for (int i = 0; i < 16; ++i) S[i] = usp[(size_t)crow(i, hh) * 128];
    }
    float bsum = 0.f;
    const int sdk = tid & 63, sseg = tid >> 6, st_t = tid >> 3, sd8 = (tid & 7) * 8;
    float nla[8]; u32x4 nkw, nqw, nvw[2]; u32x2 nrw[4];
#define GLA_FETCH(cc) do { const int T0n = sc * 256 + (cc) * 64; \
        _Pragma("unroll") for (int i = 0; i < 8; ++i) nla[i] = la[(size_t)(T0n + 8 * sseg + i) * 256 + h * 64 + sdk]; \
        const size_t prow_ = (size_t)(T0n + st_t) * NPROJ; \
        nkw = *(const u32x4*)(proj + prow_ + PKA + h * 64 + sd8); \
        if (OUT) nqw = *(const u32x4*)(proj + prow_ + PQA + h * 64 + sd8); \
        nvw[0] = *(const u32x4*)(proj + prow_ + PVA + h * 128 + sd8); nvw[1] = *(const u32x4*)(proj + prow_ + PVA + h * 128 + sd8 + 64); \
        if (OUT) { _Pragma("unroll") for (int q = 0; q < 4; ++q) nrw[q] = *(const u32x2*)(proj + (size_t)(T0n + 32 * it + r) * NPROJ + PRA + h * 128 + 32 * dvt + 8 * q + 4 * hh); } } while (0)
    f32x4 onv[4];
    if (OUT) {
#pragma unroll
        for (int q = 0; q < 4; ++q) onv[q] = *(const f32x4*)(a.in[I_ONORM] + 32 * dvt + 8 * q + 4 * hh);
    }
    GLA_FETCH(0);
#pragma unroll 1
    for (int c = 0; c < 4; ++c) {
        const int T0 = sc * 256 + c * 64;
        float v[8]; u32x4 kw_c = nkw, qw_c = nqw, vw_c0 = nvw[0], vw_c1 = nvw[1]; u32x2 rw_c[4];
#pragma unroll
        for (int i = 0; i < 8; ++i) v[i] = nla[i];
#pragma unroll
        for (int q = 0; q < 4; ++q) rw_c[q] = nrw[q];
        if (c < 3) GLA_FETCH(c + 1);
        if (OUT) {
#pragma unroll
            for (int q = 0; q < 4; ++q) { u32x2 w; w.x = cvt_pk_bf16(S[4 * q], S[4 * q + 1]); w.y = cvt_pk_bf16(S[4 * q + 2], S[4 * q + 3]);
                *(LAS u32x2*)(ST + (32 * dvt + r) * 72 + 32 * dkt + 8 * q + 4 * hh) = w; }
        }
        {
            const int dk = sdk, seg = sseg;
#pragma unroll
            for (int i = 1; i < 8; ++i) v[i] += v[i - 1];
            segS[seg * 64 + dk] = v[7];
            LBAR();
            float off = 0.f;
#pragma unroll
            for (int s = 0; s < 8; ++s) { const float x = segS[s * 64 + dk]; off += (s < seg) ? x : 0.f; }
#pragma unroll
            for (int i = 0; i < 8; ++i) bL[(8 * seg + i) * 64 + dk] = v[i] + off;
            LBAR();
        }
        {
            const int t = st_t, d8 = sd8;
            const f32x4 b0 = *(const LAS f32x4*)(bL + t * 64 + d8), b1 = *(const LAS f32x4*)(bL + t * 64 + d8 + 4);
            const f32x4 l0 = *(const LAS f32x4*)(bL + 63 * 64 + d8), l1 = *(const LAS f32x4*)(bL + 63 * 64 + d8 + 4);
            float bb[8] = {b0[0], b0[1], b0[2], b0[3], b1[0], b1[1], b1[2], b1[3]}, bl[8] = {l0[0], l0[1], l0[2], l0[3], l1[0], l1[1], l1[2], l1[3]};
            float kf[8]; unpack8(kw_c, kf);
#pragma unroll
            for (int j = 0; j < 8; ++j) KT[(d8 + j) * 72 + t] = (bf16_t)(cvt_pk_bf16(kf[j] * __expf(bl[j] - bb[j]), 0.f) & 0xffffu);
            if (OUT) {
                float qf[8]; unpack8(qw_c, qf);
                float qq[8], kk[8];
#pragma unroll
                for (int j = 0; j < 8; ++j) { const float e = __expf(bb[j]); qq[j] = qf[j] * 0.125f * e; kk[j] = kf[j] * __expf(-bb[j]); }
                u32x4 w; w.x = cvt_pk_bf16(qq[0], qq[1]); w.y = cvt_pk_bf16(qq[2], qq[3]); w.z = cvt_pk_bf16(qq[4], qq[5]); w.w = cvt_pk_bf16(qq[6], qq[7]);
                *(LAS u32x4*)(Qn + t * 72 + d8) = w;
                w.x = cvt_pk_bf16(kk[0], kk[1]); w.y = cvt_pk_bf16(kk[2], kk[3]); w.z = cvt_pk_bf16(kk[4], kk[5]); w.w = cvt_pk_bf16(kk[6], kk[7]);
                *(LAS u32x4*)(Kn + t * 72 + d8) = w;
            }
#pragma unroll
            for (int i = 0; i < 2; ++i) { const int dv8 = d8 + 64 * i;
                const u32x4 vw = (i == 0) ? vw_c0 : vw_c1;
                LAS bf16_t* vt = VT + dv8 * 72 + t;
                vt[0 * 72] = (bf16_t)(vw.x & 0xffffu); vt[1 * 72] = (bf16_t)(vw.x >> 16); vt[2 * 72] = (bf16_t)(vw.y & 0xffffu); vt[3 * 72] = (bf16_t)(vw.y >> 16);
                vt[4 * 72] = (bf16_t)(vw.z & 0xffffu); vt[5 * 72] = (bf16_t)(vw.z >> 16); vt[6 * 72] = (bf16_t)(vw.w & 0xffffu); vt[7 * 72] = (bf16_t)(vw.w >> 16); }
            if (tid < 64) bsum += bL[63 * 64 + tid];
        }
        LBAR();
        if (OUT) {
            bf16x8 qf[4];
#pragma unroll
            for (int s = 0; s < 4; ++s) qf[s] = *(const LAS bf16x8*)(Qn + (32 * it + r) * 72 + 16 * s + 8 * hh);
            f32x16 oacc = {};
#pragma unroll
            for (int jt = 0; jt < 2; ++jt) {
                if (jt <= it) {
                    f32x16 at = {};
#pragma unroll
                    for (int s = 0; s < 4; ++s) { const bf16x8 af = *(const LAS bf16x8*)(Kn + (32 * jt + r) * 72 + 16 * s + 8 * hh); at = __builtin_amdgcn_mfma_f32_32x32x16_bf16(af, qf[s], at, 0, 0, 0); }
                    if (jt == it) {
#pragma unroll
                        for (int i = 0; i < 16; ++i) if (crow(i, hh) > r) at[i] = 0.f;
                    }
#pragma unroll
                    for (int s2 = 0; s2 < 2; ++s2) {
                        u32x4 pw; pw.x = cvt_pk_bf16(at[8 * s2 + 0], at[8 * s2 + 1]); pw.y = cvt_pk_bf16(at[8 * s2 + 2], at[8 * s2 + 3]);
                        pw.z = cvt_pk_bf16(at[8 * s2 + 4], at[8 * s2 + 5]); pw.w = cvt_pk_bf16(at[8 * s2 + 6], at[8 * s2 + 7]);
                        const LAS bf16_t* vp = VT + (32 * dvt + r) * 72 + 32 * jt + 16 * s2 + 4 * hh;
                        const u32x2 v0 = *(const LAS u32x2*)vp, v1 = *(const LAS u32x2*)(vp + 8);
                        const u32x4 vv = (u32x4){v0.x, v0.y, v1.x, v1.y};
                        oacc = __builtin_amdgcn_mfma_f32_32x32x16_bf16(__builtin_bit_cast(bf16x8, vv), __builtin_bit_cast(bf16x8, pw), oacc, 0, 0, 0);
                    }
                }
            }
#pragma unroll
            for (int s = 0; s < 4; ++s) { const bf16x8 af = *(const LAS bf16x8*)(ST + (32 * dvt + r) * 72 + 16 * s + 8 * hh); oacc = __builtin_amdgcn_mfma_f32_32x32x16_bf16(af, qf[s], oacc, 0, 0, 0); }
            float ss = 0.f;
#pragma unroll
            for (int i = 0; i < 16; ++i) ss += oacc[i] * oacc[i];
            ss += __shfl_xor(ss, 32);
            if (hh == 0) red[wave * 32 + r] = ss;
            LBAR();
            const float tot = (red[it * 32 + r] + red[(it + 2) * 32 + r]) + (red[(it + 4) * 32 + r] + red[(it + 6) * 32 + r]);
            const float rstd = rsqrtf(tot * (1.0f / 128.f) + EPS);
            const int t = T0 + 32 * it + r;
#pragma unroll
            for (int q = 0; q < 4; ++q) {
                const int dv0 = 32 * dvt + 8 * q + 4 * hh;
                const u32x2 rw = rw_c[q];
                const f32x4 on = onv[q];
                const float r0 = bf_lo(rw.x), r1 = bf_hi(rw.x), r2 = bf_lo(rw.y), r3 = bf_hi(rw.y);
                const float y0 = oacc[4 * q] * rstd * on[0] * (r0 * __builtin_amdgcn_rcpf(1.f + __expf(-r0))), y1 = oacc[4 * q + 1] * rstd * on[1] * (r1 * __builtin_amdgcn_rcpf(1.f + __expf(-r1)));
                const float y2 = oacc[4 * q + 2] * rstd * on[2] * (r2 * __builtin_amdgcn_rcpf(1.f + __expf(-r2))), y3 = oacc[4 * q + 3] * rstd * on[3] * (r3 * __builtin_amdgcn_rcpf(1.f + __expf(-r3)));
                u32x2 w; w.x = cvt_pk_bf16(y0, y1); w.y = cvt_pk_bf16(y2, y3);
                *(u32x2*)(mix + (size_t)t * D + h * 128 + dv0) = w;
            }
        }
#pragma unroll
        for (int i = 0; i < 16; ++i) S[i] *= __expf(bL[63 * 64 + 32 * dkt + crow(i, hh)]);
#pragma unroll
        for (int s = 0; s < 4; ++s) {
            const bf16x8 af = *(const LAS bf16x8*)(KT + (32 * dkt + r) * 72 + 16 * s + 8 * hh), bf = *(const LAS bf16x8*)(VT + (32 * dvt + r) * 72 + 16 * s + 8 * hh);
            S = __builtin_amdgcn_mfma_f32_32x32x16_bf16(af, bf, S, 0, 0, 0);
        }
        LBAR();
    }
#undef GLA_FETCH
    if (!OUT) {
#pragma unroll
        for (int i = 0; i < 16; ++i) usp[(size_t)crow(i, hh) * 128] = S[i];
        if (tid < 64) DS[(sc * 4 + h) * 64 + tid] = __expf(bsum);
    }
}
__device__ __forceinline__ void gla_scan_m(const KArgs& a, int vcu) {
    const int tid = otid(); if (tid >= 128) return;
    const int e = vcu * 128 + tid; if (e >= 32768) return;
    float* US = (float*)(a.ws + WS_R2 + 4096); const float* DS = US + (size_t)64 * 4 * 64 * 128;
    const int hd = e >> 7;
    float S = 0.f;
    for (int c0 = 0; c0 < 64; c0 += 8) {
        float u[8], d[8];
#pragma unroll
        for (int j = 0; j < 8; ++j) { u[j] = US[(size_t)(c0 + j) * 32768 + e]; d[j] = DS[(c0 + j) * 256 + hd]; }
#pragma unroll
        for (int j = 0; j < 8; ++j) { US[(size_t)(c0 + j) * 32768 + e] = S; S = d[j] * S + u[j]; }
    }
    a.out[O_GLAP + e] = S;
}
__device__ __forceinline__ void gla_decode_item(const KArgs& a, int item, int lane) {
    const int b = item >> 2, h = item & 3; const int row = SROW + b;
    const bf16_t* proj = (const bf16_t*)(a.ws + WS_BIG); const float* la = (const float*)(a.ws + WS_BIG + BIG_LA);
    bf16_t* mix = (bf16_t*)(a.ws + WS_R1);
    const float* S0 = a.in[I_SGLA] + ((size_t)b * 4 + h) * 8192;
    float* S1 = a.out + O_GLAS + ((size_t)b * 4 + h) * 8192;
    const float qv = bf2f(proj[(size_t)row * NPROJ + PQA + h * 64 + lane]) * 0.125f;
    const float kv = bf2f(proj[(size_t)row * NPROJ + PKA + h * 64 + lane]);
    const float av = __expf(la[(size_t)row * 256 + h * 64 + lane]);
    const unsigned vw = *(const unsigned*)(proj + (size_t)row * NPROJ + PVA + h * 128 + lane * 2);
    const float v0 = bf_lo(vw), v1 = bf_hi(vw);
    float o0 = 0.f, o1 = 0.f;
#pragma unroll 1
    for (int d0 = 0; d0 < 64; d0 += 16) {
        f32x2 sv[16];
#pragma unroll
        for (int j = 0; j < 16; ++j) sv[j] = __builtin_nontemporal_load((const f32x2*)(S0 + (d0 + j) * 128 + lane * 2));
#pragma unroll
        for (int j = 0; j < 16; ++j) {
            const int dk = d0 + j;
            const float q = __shfl(qv, dk), k = __shfl(kv, dk), al = __shfl(av, dk);
            const float n0 = al * sv[j].x + k * v0, n1 = al * sv[j].y + k * v1;
            __builtin_nontemporal_store((f32x2){n0, n1}, (f32x2*)(S1 + dk * 128 + lane * 2));
            o0 += q * n0; o1 += q * n1;
        }
    }
    const float ss = wave_sum(o0 * o0 + o1 * o1);
    const float rstd = rsqrtf(ss * (1.0f / 128.f) + EPS);
    const unsigned rw = *(const unsigned*)(proj + (size_t)row * NPROJ + PRA + h * 128 + lane * 2);
    const float r0 = bf_lo(rw), r1 = bf_hi(rw);
    const float y0 = o0 * rstd * a.in[I_ONORM][lane * 2] * (r0 / (1.f + __expf(-r0))), y1 = o1 * rstd * a.in[I_ONORM][lane * 2 + 1] * (r1 / (1.f + __expf(-r1)));
    *(unsigned*)(mix + (size_t)row * D + h * 128 + lane * 2) = cvt_pk_bf16(y0, y1);
}

__device__ __forceinline__ void swa_unit_m(const KArgs& a, LAS unsigned char* lds, int unit) {
    const int tid = otid(), lane = tid & 63, wave = __builtin_amdgcn_readfirstlane(tid >> 6);
    const int qb = unit >> 1, kvh = unit & 1; const int q0 = qb * 64, w0 = q0 - 128;
    const bf16_t* proj = (const bf16_t*)(a.ws + WS_BIG);
    bf16_t* mix = (bf16_t*)(a.ws + WS_R1);
    LAS bf16_t* Kl = (LAS bf16_t*)lds;
    LAS bf16_t* Vt = Kl + 192 * 72;
    const float* kn = a.in[I_KNORM];
    const int g = wave & 3, th = wave >> 2, hq = kvh * 4 + g;
    const int r = lane & 31, hh = lane >> 5;
    const int t = q0 + 32 * th + r;
    u32x4 kwv[3], vwv[3], qwv[4];
#pragma unroll
    for (int i = 0; i < 3; ++i) { const int c = tid + i * NTHREADS; const int kk = c >> 3, part = c & 7; const int tk = w0 + kk;
        kwv[i] = (u32x4){0u, 0u, 0u, 0u}; vwv[i] = (u32x4){0u, 0u, 0u, 0u};
        if (tk >= 0) { kwv[i] = *(const u32x4*)(proj + (size_t)tk * NPROJ + PKB + kvh * 64 + part * 8); vwv[i] = *(const u32x4*)(proj + (size_t)tk * NPROJ + PVB + kvh * 64 + part * 8); } }
#pragma unroll
    for (int s = 0; s < 4; ++s) qwv[s] = *(const u32x4*)(proj + (size_t)t * NPROJ + PQB + hq * 64 + 16 * s + 8 * hh);
#pragma unroll
    for (int i = 0; i < 3; ++i) {
        const int c = tid + i * NTHREADS; const int kk = c >> 3, part = c & 7;
        float kf[8]; unpack8(kwv[i], kf);
        const u32x4 vw = vwv[i];
        float ss = 0.f;
#pragma unroll
        for (int j = 0; j < 8; ++j) ss += kf[j] * kf[j];
        ss += __shfl_xor(ss, 1); ss += __shfl_xor(ss, 2); ss += __shfl_xor(ss, 4);
        const float rstd = rsqrtf(ss * (1.0f / 64.f) + EPS);
#pragma unroll
        for (int j = 0; j < 8; ++j) kf[j] = kf[j] * rstd * kn[part * 8 + j];
        u32x4 kw2; kw2.x = cvt_pk_bf16(kf[0], kf[1]); kw2.y = cvt_pk_bf16(kf[2], kf[3]); kw2.z = cvt_pk_bf16(kf[4], kf[5]); kw2.w = cvt_pk_bf16(kf[6], kf[7]);
        *(LAS u32x4*)(Kl + kk * 72 + part * 8) = kw2;
        LAS bf16_t* vt = Vt + (part * 8) * 196 + kk;
        vt[0 * 196] = (bf16_t)(vw.x & 0xffffu); vt[1 * 196] = (bf16_t)(vw.x >> 16); vt[2 * 196] = (bf16_t)(vw.y & 0xffffu); vt[3 * 196] = (bf16_t)(vw.y >> 16);
        vt[4 * 196] = (bf16_t)(vw.z & 0xffffu); vt[5 * 196] = (bf16_t)(vw.z >> 16); vt[6 * 196] = (bf16_t)(vw.w & 0xffffu); vt[7 * 196] = (bf16_t)(vw.w >> 16);
        if (qb == 255 && kk >= 64) {
            const int w = kk - 64;
            float vf[8]; unpack8(vw, vf);
            float* ko = a.out + O_SKP + ((size_t)w * 2 + kvh) * 64 + part * 8; float* vo = a.out + O_SVP + ((size_t)w * 2 + kvh) * 64 + part * 8;
            *(f32x4*)ko = (f32x4){kf[0], kf[1], kf[2], kf[3]}; *(f32x4*)(ko + 4) = (f32x4){kf[4], kf[5], kf[6], kf[7]};
            *(f32x4*)vo = (f32x4){vf[0], vf[1], vf[2], vf[3]}; *(f32x4*)(vo + 4) = (f32x4){vf[4], vf[5], vf[6], vf[7]};
        }
    }
    LBAR();
    constexpr float LOG2E = 1.4426950408889634f;
    bf16x8 qf[4];
    {
        float qv[4][8]; float ss = 0.f;
#pragma unroll
        for (int s = 0; s < 4; ++s) { unpack8(qwv[s], qv[s]);
#pragma unroll
            for (int j = 0; j < 8; ++j) ss += qv[s][j] * qv[s][j]; }
        ss += __shfl_xor(ss, 32);
        const float rstd = rsqrtf(ss * (1.0f / 64.f) + EPS) * (0.125f * LOG2E);
        const float* qn = a.in[I_QNORM];
#pragma unroll
        for (int s = 0; s < 4; ++s) {
            u32x4 w;
            w.x = cvt_pk_bf16(qv[s][0] * rstd * qn[16 * s + 8 * hh + 0], qv[s][1] * rstd * qn[16 * s + 8 * hh + 1]);
            w.y = cvt_pk_bf16(qv[s][2] * rstd * qn[16 * s + 8 * hh + 2], qv[s][3] * rstd * qn[16 * s + 8 * hh + 3]);
            w.z = cvt_pk_bf16(qv[s][4] * rstd * qn[16 * s + 8 * hh + 4], qv[s][5] * rstd * qn[16 * s + 8 * hh + 5]);
            w.w = cvt_pk_bf16(qv[s][6] * rstd * qn[16 * s + 8 * hh + 6], qv[s][7] * rstd * qn[16 * s + 8 * hh + 7]);
            qf[s] = __builtin_bit_cast(bf16x8, w);
        }
    }
    f32x16 sacc[5];
#pragma unroll
    for (int k5 = 0; k5 < 5; ++k5) {
        const int kt = th + k5;
        f32x16 acc = {};
#pragma unroll
        for (int s = 0; s < 4; ++s) { const bf16x8 af = *(const LAS bf16x8*)(Kl + (kt * 32 + r) * 72 + 16 * s + 8 * hh); acc = __builtin_amdgcn_mfma_f32_32x32x16_bf16(af, qf[s], acc, 0, 0, 0); }
        sacc[k5] = acc;
    }
    const float slope2 = exp2f(-(float)(hq + 1)) * LOG2E;
    const float sink2 = a.in[I_SINKS][hq] * LOG2E;
    float mx = sink2;
#pragma unroll
    for (int k5 = 0; k5 < 5; ++k5)
#pragma unroll
        for (int i = 0; i < 16; ++i) {
            const int row = (i & 3) + 8 * (i >> 2) + 4 * hh;
            const int dist = 128 - 32 * k5 + r - row;
            const int tk = w0 + 32 * (th + k5) + row;
            float s = sacc[k5][i] - slope2 * (float)dist;
            if (dist < 0 || dist >= 128 || tk < 0) s = -1e30f;
            sacc[k5][i] = s; mx = fmaxf(mx, s);
        }
    mx = fmaxf(mx, __shfl_xor(mx, 32));
    float l = 0.f;
#pragma unroll
    for (int k5 = 0; k5 < 5; ++k5)
#pragma unroll
        for (int i = 0; i < 16; ++i) { const float p = __builtin_amdgcn_exp2f(sacc[k5][i] - mx); sacc[k5][i] = p; l += p; }
    l += __shfl_xor(l, 32);
    l += exp2f(sink2 - mx);
    f32x16 oacc[2] = {{}, {}};
#pragma unroll
    for (int k5 = 0; k5 < 5; ++k5) {
        const int kt = th + k5;
#pragma unroll
        for (int s2 = 0; s2 < 2; ++s2) {
            u32x4 pw;
            pw.x = cvt_pk_bf16(sacc[k5][8 * s2 + 0], sacc[k5][8 * s2 + 1]); pw.y = cvt_pk_bf16(sacc[k5][8 * s2 + 2], sacc[k5][8 * s2 + 3]);
            pw.z = cvt_pk_bf16(sacc[k5][8 * s2 + 4], sacc[k5][8 * s2 + 5]); pw.w = cvt_pk_bf16(sacc[k5][8 * s2 + 6], sacc[k5][8 * s2 + 7]);
            const bf16x8 pf = __builtin_bit_cast(bf16x8, pw);
#pragma unroll
            for (int dt = 0; dt < 2; ++dt) {
                const LAS bf16_t* vp = Vt + (32 * dt + r) * 196 + kt * 32 + 16 * s2 + 4 * hh;
                const u32x2 v0 = *(const LAS u32x2*)vp, v1 = *(const LAS u32x2*)(vp + 8);
                const u32x4 vv = (u32x4){v0.x, v0.y, v1.x, v1.y};
                oacc[dt] = __builtin_amdgcn_mfma_f32_32x32x16_bf16(__builtin_bit_cast(bf16x8, vv), pf, oacc[dt], 0, 0, 0);
            }
        }
    }
    const float inv = 1.f / l;
#pragma unroll
    for (int dt = 0; dt < 2; ++dt)
#pragma unroll
        for (int q = 0; q < 4; ++q) {
            u32x2 w; w.x = cvt_pk_bf16(oacc[dt][4 * q] * inv, oacc[dt][4 * q + 1] * inv); w.y = cvt_pk_bf16(oacc[dt][4 * q + 2] * inv, oacc[dt][4 * q + 3] * inv);
            *(u32x2*)(mix + (size_t)t * D + 512 + hq * 64 + 32 * dt + 8 * q + 4 * hh) = w;
        }
    LBAR();
}
__device__ __forceinline__ void swa_decode_item(const KArgs& a, int item, int lane) {
    const int b = item >> 3, kvh = (item >> 2) & 1, g = item & 3, hq = kvh * 4 + g; const int row = SROW + b;
    const bf16_t* proj = (const bf16_t*)(a.ws + WS_BIG);
    bf16_t* mix = (bf16_t*)(a.ws + WS_R1);
    const float* ck = a.in[I_CK] + (size_t)b * 128 * 128 + kvh * 64;
    const float* cv = a.in[I_CV] + (size_t)b * 128 * 128 + kvh * 64;
    float qd = bf2f(proj[(size_t)row * NPROJ + PQB + hq * 64 + lane]);
    { const float ss = wave_sum(qd * qd); qd = qd * rsqrtf(ss * (1.0f / 64.f) + EPS) * a.in[I_QNORM][lane] * 0.125f; }
    float kd = bf2f(proj[(size_t)row * NPROJ + PKB + kvh * 64 + lane]);
    { const float ss = wave_sum(kd * kd); kd = kd * rsqrtf(ss * (1.0f / 64.f) + EPS) * a.in[I_KNORM][lane]; }
    const float vd = bf2f(proj[(size_t)row * NPROJ + PVB + kvh * 64 + lane]);
    const float slope = exp2f(-(float)(hq + 1));
    float s0 = 0.f, s1 = 0.f;
    {
        f32x4 k0[16], k1[16];
#pragma unroll
        for (int i = 0; i < 16; ++i) { k0[i] = *(const f32x4*)(ck + (size_t)lane * 128 + 4 * i); k1[i] = *(const f32x4*)(ck + (size_t)(lane + 64) * 128 + 4 * i); }
#pragma unroll
        for (int i = 0; i < 16; ++i) {
            const float q0 = __shfl(qd, 4 * i), q1 = __shfl(qd, 4 * i + 1), q2 = __shfl(qd, 4 * i + 2), q3 = __shfl(qd, 4 * i + 3);
            s0 += (q0 * k0[i][0] + q1 * k0[i][1]) + (q2 * k0[i][2] + q3 * k0[i][3]);
            s1 += (q0 * k1[i][0] + q1 * k1[i][1]) + (q2 * k1[i][2] + q3 * k1[i][3]);
        }
    }
    s0 -= slope * (float)(128 - lane); s1 -= slope * (float)(64 - lane);
    if (lane == 0) s0 = -1e30f;
    const float sn = wave_sum(qd * kd);
    const float sink = a.in[I_SINKS][hq];
    const float mx = fmaxf(fmaxf(wave_max(fmaxf(s0, s1)), sn), sink);
    const float p0 = __expf(s0 - mx), p1 = __expf(s1 - mx), pn = __expf(sn - mx);
    const float l = wave_sum(p0 + p1) + pn + __expf(sink - mx);
    float od = pn * vd;
#pragma unroll 1
    for (int w0 = 0; w0 < 64; w0 += 16) {
        float ca[16], cb[16];
#pragma unroll
        for (int j = 0; j < 16; ++j) { ca[j] = cv[(size_t)(w0 + j) * 128 + lane]; cb[j] = cv[(size_t)(w0 + j + 64) * 128 + lane]; }
#pragma unroll
        for (int j = 0; j < 16; ++j) { const float pa = __shfl(p0, w0 + j), pb = __shfl(p1, w0 + j); od += pa * ca[j] + pb * cb[j]; }
    }
    od /= l;
    const float oo = __shfl_down(od, 1);
    if ((lane & 1) == 0) *(unsigned*)(mix + (size_t)row * D + 512 + hq * 64 + lane) = cvt_pk_bf16(od, oo);
    {
        float* __restrict__ ko = a.out + O_SKS + (size_t)b * 128 * 128 + kvh * 64; float* __restrict__ vo = a.out + O_SVS + (size_t)b * 128 * 128 + kvh * 64;
        float ka[32], va[32];
#pragma unroll
        for (int j = 0; j < 32; ++j) { const int w = 32 * g + j + 1; ka[j] = (w < 128) ? ck[(size_t)w * 128 + lane] : kd; va[j] = (w < 128) ? cv[(size_t)w * 128 + lane] : vd; }
#pragma unroll
        for (int j = 0; j < 32; ++j) { ko[(size_t)(32 * g + j) * 128 + lane] = ka[j]; vo[(size_t)(32 * g + j) * 128 + lane] = va[j]; }
    }
}

template <int W>
__device__ __forceinline__ void pool_core(const bf16_t* __restrict__ h, const LAS float* rsL, const f32x4 gg, int r0, int half, int c4, bf16_t* __restrict__ d1, float* __restrict__ poolp) {
    const int rb = r0 + 8 * half;
    float xn[23][4];
#pragma unroll
    for (int i = 0; i < 23; ++i) { const int r = rb - 15 + i;
        u32x2 w = (u32x2){0u, 0u};
        if (i >= 16 - W && r >= 0) w = *(const u32x2*)(h + (size_t)r * D + c4);
        const float rs = rsL[8 * half + i];
        xn[i][0] = bf_lo(w.x) * rs * gg[0]; xn[i][1] = bf_hi(w.x) * rs * gg[1]; xn[i][2] = bf_lo(w.y) * rs * gg[2]; xn[i][3] = bf_hi(w.y) * rs * gg[3]; }
    float s[4] = {0.f, 0.f, 0.f, 0.f};
#pragma unroll
    for (int k = 1; k < W; ++k)
#pragma unroll
        for (int j = 0; j < 4; ++j) s[j] += xn[15 - k][j];
#pragma unroll
    for (int i = 0; i < 8; ++i) {
        const int r = rb + i;
        const int cnt = (r + 1 < W) ? r + 1 : W; const float ic = 1.0f / (float)cnt;
        float dd[4];
#pragma unroll
        for (int j = 0; j < 4; ++j) { s[j] += xn[15 + i][j]; dd[j] = s[j] * ic - xn[15 + i][j]; s[j] -= xn[15 + i - (W - 1)][j]; }
        u32x2 w; w.x = cvt_pk_bf16(dd[0], dd[1]); w.y = cvt_pk_bf16(dd[2], dd[3]);
        *(u32x2*)(d1 + (size_t)r * D + c4) = w;
        if (r >= SEQ - 15) *(f32x4*)(poolp + (size_t)(r - (SEQ - 15)) * D + c4) = (f32x4){xn[15 + i][0], xn[15 + i][1], xn[15 + i][2], xn[15 + i][3]};
    }
}
__device__ __forceinline__ void pool_item(const KArgs& a, LAS unsigned char* lds, int item, const float* part_in) {
    const int tid = otid();
    const bf16_t* h = (const bf16_t*)(a.ws + WS_R2 + 4096); bf16_t* d1 = (bf16_t*)(a.ws + WS_R1);
    LAS float* rsL = (LAS float*)lds;
    const int r0 = item * 16;
    __syncthreads();
    if (tid < 31) { const int r = r0 - 15 + tid; float rs = 0.f;
        if (r >= 0) { const f32x4 p0 = *(const f32x4*)(part_in + (long)r * 16), p1 = *(const f32x4*)(part_in + (long)r * 16 + 4), p2 = *(const f32x4*)(part_in + (long)r * 16 + 8), p3 = *(const f32x4*)(part_in + (long)r * 16 + 12);
            const float s = ((p0[0] + p0[1]) + (p0[2] + p0[3])) + ((p1[0] + p1[1]) + (p1[2] + p1[3])) + ((p2[0] + p2[1]) + (p2[2] + p2[3])) + ((p3[0] + p3[1]) + (p3[2] + p3[3]));
            rs = rsqrtf(s * (1.0f / D) + EPS); }
        rsL[tid] = rs; }
    __syncthreads();
    const int c4 = 4 * (tid & 255), half = tid >> 8; const int gq = __builtin_amdgcn_readfirstlane(c4 >> 8);
    const f32x4 gg = *(const f32x4*)(a.in[I_MNO] + c4);
    if (gq == 0) pool_core<2>(h, rsL, gg, r0, half, c4, d1, a.out + O_POOLP);
    else if (gq == 1) pool_core<4>(h, rsL, gg, r0, half, c4, d1, a.out + O_POOLP);
    else if (gq == 2) pool_core<8>(h, rsL, gg, r0, half, c4, d1, a.out + O_POOLP);
    else pool_core<16>(h, rsL, gg, r0, half, c4, d1, a.out + O_POOLP);
}
template <int W>
__device__ __forceinline__ void pool_tile_core(const LAS unsigned char* slab, const LAS float* rsL, const f32x4 gg, int pm, int rl0, int cq, int gq, bf16_t* __restrict__ d1, float* __restrict__ poolp) {
    float xn[23][4];
#pragma unroll
    for (int i = 0; i < 23; ++i) { const int sl = rl0 + i;
        u32x2 w = (u32x2){0u, 0u};
        if (i >= 16 - W) w = *(const LAS u32x2*)(slab + sl * 512 + cq * 8);
        const float rs = rsL[sl];
        xn[i][0] = bf_lo(w.x) * rs * gg[0]; xn[i][1] = bf_hi(w.x) * rs * gg[1]; xn[i][2] = bf_lo(w.y) * rs * gg[2]; xn[i][3] = bf_hi(w.y) * rs * gg[3]; }
    float s[4] = {0.f, 0.f, 0.f, 0.f};
#pragma unroll
    for (int k = 1; k < W; ++k)
#pragma unroll
        for (int j = 0; j < 4; ++j) s[j] += xn[15 - k][j];
    const int c4 = 256 * gq + 4 * cq;
#pragma unroll
    for (int i = 0; i < 8; ++i) {
        const int r = 256 * pm + rl0 + i;
        const int cnt = (r + 1 < W) ? r + 1 : W; const float ic = __builtin_amdgcn_rcpf((float)cnt);
        float dd[4];
#pragma unroll
        for (int j = 0; j < 4; ++j) { s[j] += xn[15 + i][j]; dd[j] = s[j] * ic - xn[15 + i][j]; s[j] -= xn[15 + i - (W - 1)][j]; }
        u32x2 w; w.x = cvt_pk_bf16(dd[0], dd[1]); w.y = cvt_pk_bf16(dd[2], dd[3]);
        *(u32x2*)(d1 + (size_t)r * D + c4) = w;
        if (r >= SEQ - 15) *(f32x4*)(poolp + (size_t)(r - (SEQ - 15)) * D + c4) = (f32x4){xn[15 + i][0], xn[15 + i][1], xn[15 + i][2], xn[15 + i][3]};
    }
}
__device__ __forceinline__ void pool_tile(const KArgs& a, LAS unsigned char* lds, int pm, int gq, const float* part_in) {
    const int tid = otid(), lane = tid & 63, wave = __builtin_amdgcn_readfirstlane(tid >> 6);
    const bf16_t* h = (const bf16_t*)(a.ws + WS_R2 + 4096); bf16_t* d1 = (bf16_t*)(a.ws + WS_R1);
    LAS float* rsL = (LAS float*)(lds + 140288);
    __syncthreads();
    for (int p = wave; p < 136; p += 8) {
        const int sl = 2 * p + (lane >> 5); int r = 256 * pm - 15 + sl; if (r < 0) r = 0; if (r > SEQ - 1) r = SEQ - 1;
        __builtin_amdgcn_global_load_lds((const unsigned*)(h + (size_t)r * D + 256 * gq + 8 * (lane & 31)), (LAS unsigned*)(lds + p * 1024), 16, 0, 0);
    }
    if (tid < 271) { const int r = 256 * pm - 15 + tid; float rs = 0.f;
        if (r >= 0) { const f32x4 p0 = *(const f32x4*)(part_in + (long)r * 16), p1 = *(const f32x4*)(part_in + (long)r * 16 + 4), p2 = *(const f32x4*)(part_in + (long)r * 16 + 8), p3 = *(const f32x4*)(part_in + (long)r * 16 + 12);
            const float s = ((p0[0] + p0[1]) + (p0[2] + p0[3])) + ((p1[0] + p1[1]) + (p1[2] + p1[3])) + ((p2[0] + p2[1]) + (p2[2] + p2[3])) + ((p3[0] + p3[1]) + (p3[2] + p3[3]));
            rs = rsqrtf(s * (1.0f / D) + EPS); }
        rsL[tid] = rs; }
    asm volatile("s_waitcnt vmcnt(0) lgkmcnt(0)" ::: "memory");
    __syncthreads();
    const int cq = lane;
    const f32x4 gg = *(const f32x4*)(a.in[I_MNO] + 256 * gq + 4 * cq);
#pragma unroll 1
    for (int st = 0; st < 4; ++st) {
        const int rl0 = 32 * wave + 8 * st;
        if (gq == 0) pool_tile_core<2>(lds, rsL, gg, pm, rl0, cq, gq, d1, a.out + O_POOLP);
        else if (gq == 1) pool_tile_core<4>(lds, rsL, gg, pm, rl0, cq, gq, d1, a.out + O_POOLP);
        else if (gq == 2) pool_tile_core<8>(lds, rsL, gg, pm, rl0, cq, gq, d1, a.out + O_POOLP);
        else pool_tile_core<16>(lds, rsL, gg, pm, rl0, cq, gq, d1, a.out + O_POOLP);
    }
}
__device__ __forceinline__ void pool_sample_item(const KArgs& a, LAS unsigned char* lds, int b, const float* part_in) {
    const int tid = otid();
    const bf16_t* __restrict__ h = (const bf16_t*)(a.ws + WS_R2 + 4096) + (size_t)(SROW + b) * D; bf16_t* __restrict__ d1 = (bf16_t*)(a.ws + WS_R1);
    const float* __restrict__ st = a.in[I_SPOOL] + (size_t)b * 15 * D; float* __restrict__ so = a.out + O_POOLS + (size_t)b * 15 * D;
    const float rs = s_row_rs(part_in, b);
#pragma unroll
    for (int cc = 0; cc < 2; ++cc) {
        const int c = tid + cc * NTHREADS; const int w = 2 << (c >> 8);
        float sv[15];
#pragma unroll
        for (int j = 0; j < 15; ++j) sv[j] = st[(size_t)j * D + c];
        const float xn = bf2f(h[c]) * rs * a.in[I_MNO][c];
        float sum = xn;
#pragma unroll
        for (int j = 0; j < 15; ++j) sum += (j >= 16 - w) ? sv[j] : 0.f;
        const float dd = sum / (float)w - xn;
        d1[(size_t)(SROW + b) * D + c] = (bf16_t)(cvt_pk_bf16(dd, 0.f) & 0xffffu);
#pragma unroll
        for (int j = 0; j < 14; ++j) so[(size_t)j * D + c] = sv[j + 1];
        so[(size_t)14 * D + c] = xn;
    }
}

#define XB_TMO      128
#define XB_XCNT(j)  (256  + 64 * (j))
#define XB_XSUB(j)  (1280 + 64 * (j))
#define XB_XGEN(j)  (2304 + 64 * (j))
#define XB_TOP      3328
#define XB_TOPGEN   3392
#define XCD_BAR_WORDS 3456
#define XB_SPIN_CAP (1u << 18)
__device__ __forceinline__ unsigned xb_ld(unsigned* p)              { return __hip_atomic_load(p, __ATOMIC_RELAXED, __HIP_MEMORY_SCOPE_AGENT); }
__device__ __forceinline__ unsigned xb_add(unsigned* p, unsigned v) { return __hip_atomic_fetch_add(p, v, __ATOMIC_RELAXED, __HIP_MEMORY_SCOPE_AGENT); }
__device__ __forceinline__ unsigned xb_xcc_id() { return (unsigned)__builtin_amdgcn_s_getreg((3 << 11) | 20) & 0xFu; }
#define XB_SPIN(cond, bar) do { unsigned _sp = 0; while (cond) { __builtin_amdgcn_s_sleep(1); \
    if ((++_sp & 255u) == 0u) { if (xb_ld(&(bar)[XB_TMO])) break; if (_sp > XB_SPIN_CAP) { atomicAdd(&(bar)[XB_TMO], 1u); break; } } } } while (0)
struct XcdBarrier { unsigned* bar; unsigned x; volatile LAS unsigned* st; };
__device__ __forceinline__ XcdBarrier xcd_barrier_post(unsigned* bar, volatile LAS unsigned* st) {
    XcdBarrier b; b.bar = bar; b.x = xb_xcc_id(); b.st = st;
    if (threadIdx.x == 0) (void)xb_add(&bar[XB_XCNT(b.x)], 1u);
    return b;
}
__device__ __forceinline__ void xcd_barrier_complete(unsigned* bar, unsigned x, unsigned& nloc, unsigned& nx) {
    const unsigned G = gridDim.x * gridDim.y * gridDim.z;
    unsigned sum, cnt, mine, sp = 0u;
    for (;;) {
        sum = 0u; cnt = 0u; mine = 0u;
#pragma unroll
        for (unsigned j = 0; j < 16; ++j) { const unsigned c = xb_ld(&bar[XB_XCNT(j)]); sum += c; cnt += (c > 0u) ? 1u : 0u; mine = (j == x) ? c : mine; }
        if (sum == G) break;
        __builtin_amdgcn_s_sleep(1);
        if ((++sp & 255u) == 0u) { if (xb_ld(&bar[XB_TMO])) break; if (sp > XB_SPIN_CAP) { atomicAdd(&bar[XB_TMO], 1u); break; } }
    }
    nloc = mine > 0u ? mine : 1u; nx = cnt > 0u ? cnt : 1u;
}
__device__ __forceinline__ void xcd_barrier(const XcdBarrier& b) {
    asm volatile("s_waitcnt vmcnt(0)" ::: "memory");
    __syncthreads();
    if (threadIdx.x == 0) {
        unsigned* bar = b.bar;
        __builtin_amdgcn_s_waitcnt(0);
        unsigned nloc = b.st[0], nx = b.st[1];
        if (nloc == 0u) { xcd_barrier_complete(bar, b.x, nloc, nx); b.st[0] = nloc; b.st[1] = nx; }
        const unsigned old = xb_add(&bar[XB_XSUB(b.x)], 1u);
        const unsigned gen = old / nloc;
        if (old + 1u == (gen + 1u) * nloc) {
            __builtin_amdgcn_fence(__ATOMIC_RELEASE, "agent");
            asm volatile("s_waitcnt vmcnt(0)" ::: "memory");
            const unsigned og = xb_add(&bar[XB_TOP], 1u);
            const unsigned tg = og / nx;
            if (og + 1u == (tg + 1u) * nx) xb_add(&bar[XB_TOPGEN], 1u);
            else XB_SPIN(xb_ld(&bar[XB_TOPGEN]) == tg, bar);
            __builtin_amdgcn_fence(__ATOMIC_ACQUIRE, "agent");
            xb_add(&bar[XB_XGEN(b.x)], 1u);
            asm volatile("s_waitcnt vmcnt(0)" ::: "memory");
        } else {
            XB_SPIN(xb_ld(&bar[XB_XGEN(b.x)]) == gen, bar);
            __builtin_amdgcn_fence(__ATOMIC_ACQUIRE, "agent");
            asm volatile("s_waitcnt vmcnt(0)" ::: "memory");
        }
    }
    __syncthreads();
}

#ifndef DUPM
#define DUPM 0
#endif
#ifndef SYNCREP
#define SYNCREP 1
#endif
#if defined(PROBE_T)
#define TSTAMP() do { if (stamp_i == PROBE_T) t_a = __builtin_amdgcn_s_memrealtime(); if (stamp_i == PROBE_T + 1) t_b = __builtin_amdgcn_s_memrealtime(); ++stamp_i; } while (0)
#else
#define TSTAMP() do { } while (0)
#endif
#if defined(PROBE_BAR)
#define GSYNC() do { const unsigned long long tb_ = __builtin_amdgcn_s_memrealtime(); xcd_barrier(xbar); sub_d += __builtin_amdgcn_s_memrealtime() - tb_; } while (0)
#else
#define GSYNC() do { _Pragma("unroll 1") for (int sr_ = 0; sr_ < SYNCREP; ++sr_) xcd_barrier(xbar); TSTAMP(); } while (0)
#endif
#define PH(k) _Pragma("unroll 1") for (int rep_ = 0; rep_ < (((DUPM) >> (k)) & 1) + 1; ++rep_)
__global__ void __launch_bounds__(NTHREADS, 2) mega_fwd(KArgs a) {
    extern __shared__ __attribute__((aligned(16))) unsigned char lds_raw[];
    LAS unsigned char* lds = (LAS unsigned char*)lds_raw;
    cg::grid_group grid = cg::this_grid();
    const int G = gridDim.x, bx = blockIdx.x;
    const int vcu = (G % 8 == 0) ? (bx % 8) * (G / 8) + bx / 8 : bx;
    unsigned char* ws = a.ws;
    if (ws == nullptr) grid.sync();
    volatile LAS unsigned* xst = (volatile LAS unsigned*)(lds + LDS_BYTES - 64);
    if (threadIdx.x < 16) xst[threadIdx.x] = 0u;
    __syncthreads();
    const XcdBarrier xbar = xcd_barrier_post((unsigned*)(ws + 16384), xst);
    bf16_t* R1 = (bf16_t*)(ws + WS_R1); bf16_t* R2 = (bf16_t*)(ws + WS_R2 + 4096);
    bf16_t* BIGB = (bf16_t*)(ws + WS_BIG);
    const bf16_t* pbf = (const bf16_t*)(ws + WS_PBF);

#if defined(PROBE_T)
    int stamp_i = 0; unsigned long long t_a = 0, t_b = 0;
    TSTAMP();
#endif
#if defined(PROBE_SUB) || defined(PROBE_P2) || defined(PROBE_P1) || defined(PROBE_E) || defined(PROBE_BAR)
    unsigned long long sub_d = 0;
#endif
#ifndef NPASS
#define NPASS 1
#endif
#pragma unroll 1
    for (int pass_ = 0; pass_ < NPASS; ++pass_) {
    if (pass_ > 0) GSYNC();
    PH(0) p0_prologue(a, lds, vcu, G);
    GSYNC();
    PH(1) {
        pg8::Gemm g{R1, (const bf16_t*)(ws + WS_WIN0), 1024, 1024, 1024, 256, 0, 0};
        pg8::StaticOrder S; S.init(64, 10, G, bx);
        EpiProj E{BIGB, (float*)(ws + WS_BIG + BIG_LA), (const float*)(ws + WS_SSQ), a.in[I_BALPHA]};
#if defined(PROBE_P1)
        unsigned long long tq0 = __builtin_amdgcn_s_memrealtime();
#endif
        pg8::gemm_phase(lds, g, S, E);
#if defined(PROBE_P1)
        sub_d = __builtin_amdgcn_s_memrealtime() - tq0;
#endif
        if (bx >= (640 % G)) s_proj_units(a, lds, bx - (640 % G), G - (640 % G));
        if (bx >= (640 % G)) { const int wv = __builtin_amdgcn_readfirstlane(otid() >> 6); __syncthreads(); p3_convert(a, lds, (bx - (640 % G)) * 8 + wv, (G - (640 % G)) * 8, 0, CONV_SPLIT, false); }
#if defined(PROBE_P1)
        if (PROBE_P1 == 1) sub_d = __builtin_amdgcn_s_memrealtime() - tq0;
#endif
    }
    GSYNC();
#if defined(PROBE_P2)
    unsigned long long tp0 = __builtin_amdgcn_s_memrealtime();
#endif
    PH(2) for (int it = vcu; it < 256; it += G) gla_item_m<false>(a, lds, it);
#if defined(PROBE_P2)
    unsigned long long tp1 = __builtin_amdgcn_s_memrealtime();
#endif
    PH(3) for (int it = vcu; it < 512; it += G) swa_unit_m(a, lds, it);
#if defined(PROBE_P2)
    unsigned long long tp2 = __builtin_amdgcn_s_memrealtime();
#endif
    PH(4) { const int tid = otid(), lane = tid & 63, wave = __builtin_amdgcn_readfirstlane(tid >> 6); for (int it = vcu + G * wave; it < 512; it += G * 8) gla_decode_item(a, it, lane); }
    PH(5) { const int tid = otid(), lane = tid & 63, wave = __builtin_amdgcn_readfirstlane(tid >> 6); for (int it = vcu + G * ((wave + 6) & 7); it < 1024; it += G * 8) swa_decode_item(a, it, lane); }
#if defined(PROBE_P2)
    { unsigned long long tp3 = __builtin_amdgcn_s_memrealtime(); sub_d = (PROBE_P2 == 0) ? tp1 - tp0 : (PROBE_P2 == 1) ? tp2 - tp1 : tp3 - tp2; }
#endif
    GSYNC();
    PH(6) { gla_scan_m(a, vcu); const int wv = __builtin_amdgcn_readfirstlane(otid() >> 6); if (wv >= 2) p3_convert(a, lds, vcu * 6 + (wv - 2), G * 6, CONV_SPLIT, CONV_ITEMS, true); }
    GSYNC();
    PH(7) for (int it = vcu; it < 256; it += G) gla_item_m<true>(a, lds, it);
    GSYNC();
    PH(8) {
        pg8::Gemm g{R1, (const bf16_t*)(ws + WS_WOUT0), 1024, 1024, 1024, 256, 0, 0};
        pg8::StaticOrder S; S.init(64, 4, G, bx);
        EpiRes<0, true, true, false> E{a.out, a.in[I_XP], nullptr, R2, part_tab(ws, 0), nullptr, nullptr, nullptr};
        pg8::gemm_phase(lds, g, S, E);
        s_res_units<0, 1024, 1024>(a, lds, bx, G, R1, (const bf16_t*)(ws + WS_WOUT0), nullptr, R2, spart_tab(ws, 0));
    }
#if defined(PROBE_FFNK)
    {
        pg8::Gemm g{R2, (const bf16_t*)(ws + WS_WFFI), 1024, 1024, 1024, 254, -2, 0};
        pg8::StaticOrder S; S.init(65, 22, G, bx);
#if PROBE_FFNK == 1
        EpiNull E{};
#elif PROBE_FFNK == 2
        EpiStoreOnly<0> E{R1};
#else
        EpiStoreOnly<1> E{R1};
#endif
        pg8::gemm_phase(lds, g, S, E);
    }
#endif
#if defined(PROBE_KLOOP)
    {
        pg8::Gemm g{R1, (const bf16_t*)(ws + WS_WOUT0), 1024, 1024, 1024, 256, 0, 0};
        pg8::StaticOrder S; S.init(64, 4, G, bx);
#if PROBE_KVAR == 1
        EpiStoreOnly<0> E{R1};
#elif PROBE_KVAR == 2
        EpiRes<1, true, false, false> E{a.out, nullptr, R2, R1, nullptr, nullptr, nullptr, nullptr};
#else
        EpiNull E{};
#endif
        for (int rep = 0; rep < PROBE_KLOOP; ++rep) pg8::gemm_phase(lds, g, S, E);
    }
#endif
    GSYNC();
#pragma unroll 1
    for (int l = 0; l < 2; ++l) {
        bf16_t* G_ = BIGB;
        bf16_t* PPb = BIGB;
        PH(9) {
            pg8::Gemm g{R2, (const bf16_t*)(ws + WS_WFFI + l * WFFI_BYTES), 1024, 1024, 1024, 254, -2, 0};
            pg8::StaticOrder S; S.init(65, 22, G, bx);
            EpiFfn E{part_tab(ws, l == 0 ? 0 : 3), a.in[I_FCW] + (size_t)l * 3 * DFF, a.in[I_FCB] + (size_t)l * DFF, a.out + O_CONVP + (size_t)l * 2 * DFF, G_};
            pg8::gemm_phase(lds, g, S, E);
            if (bx >= (1430 % G)) s_ffn_units(a, lds, bx - (1430 % G), G - (1430 % G), l, R2, spart_tab(ws, l == 0 ? 0 : 3));
        }
        GSYNC();
        PH(10) {
            pg8::Gemm g{G_, (const bf16_t*)(ws + WS_WFFO + l * WFFO_BYTES), DFF, DFF, DFF, 256, 0, 0};
            pg8::StaticOrder S; S.init(64, 4, G, bx);
            EpiRes<1, true, true, false> E{a.out, nullptr, R2, R1, part_tab(ws, l == 0 ? 1 : 4), nullptr, nullptr, nullptr};
#if defined(PROBE_SUB)
            unsigned long long ts0 = __builtin_amdgcn_s_memrealtime();
#endif
            pg8::gemm_phase(lds, g, S, E);
#if defined(PROBE_SUB)
            unsigned long long ts1 = __builtin_amdgcn_s_memrealtime();
#endif
            s_res_units<1, DFF, DFF>(a, lds, bx, G, G_, (const bf16_t*)(ws + WS_WFFO + l * WFFO_BYTES), R2, R1, spart_tab(ws, l == 0 ? 1 : 4));
#if defined(PROBE_SUB)
            unsigned long long ts2 = __builtin_amdgcn_s_memrealtime();
            xcd_barrier(xbar);
            unsigned long long ts3 = __builtin_amdgcn_s_memrealtime();
            if (l == 0) { sub_d = (PROBE_SUB == 0) ? ts1 - ts0 : (PROBE_SUB == 1) ? ts2 - ts1 : ts3 - ts2; }
#endif
        }
#if !defined(PROBE_SUB)
        GSYNC();
#endif
        PH(11) {
            pg8::Gemm g{pbf + (size_t)l * MT * PLE, (const bf16_t*)(ws + WS_WPROJ + l * WPROJ_BYTES), PLE, PLE, PLE, 256, 0, 0};
            pg8::StaticOrder S; S.init(64, 4, G, bx);
            EpiPP E{PPb};
#if defined(PROBE_E)
            unsigned long long te0 = __builtin_amdgcn_s_memrealtime();
#endif
            pg8::gemm_phase(lds, g, S, E);
#if defined(PROBE_E)
            if (l == 0 && PROBE_E == 0) sub_d = __builtin_amdgcn_s_memrealtime() - te0;
#endif
        }
        PH(12) {
            pg8::Gemm g{R1, (const bf16_t*)(ws + WS_WGATE + l * WGATE_BYTES), 1024, 1024, 1024, 256, 0, 0};
            pg8::StaticOrder S; S.init(64, 4, G, bx);
#if defined(PROBE_E)
            unsigned long long te1 = __builtin_amdgcn_s_memrealtime();
#endif
            if (l == 0) { EpiRes<2, true, true, false> E{a.out, nullptr, R1, R2, part_tab(ws, 2), part_tab(ws, 1), PPb, nullptr}; pg8::gemm_phase(lds, g, S, E);
#if defined(PROBE_E)
                if (PROBE_E == 1) sub_d = __builtin_amdgcn_s_memrealtime() - te1;
                te1 = __builtin_amdgcn_s_memrealtime();
#endif
                s_ple_units<false>(a, lds, bx, G, pbf, (const bf16_t*)(ws + WS_WPROJ), R1, (const bf16_t*)(ws + WS_WGATE), spart_tab(ws, 1), spart_tab(ws, 2), R2);
#if defined(PROBE_E)
                if (PROBE_E == 2) sub_d = __builtin_amdgcn_s_memrealtime() - te1;
#endif
            }
            else { EpiRes<2, false, false, true> E{a.out, nullptr, R1, nullptr, nullptr, part_tab(ws, 4), PPb, nullptr}; pg8::gemm_phase(lds, g, S, E);
                s_ple_units<true>(a, lds, bx, G, pbf + (size_t)MT * PLE, (const bf16_t*)(ws + WS_WPROJ + WPROJ_BYTES), R1, (const bf16_t*)(ws + WS_WGATE + WGATE_BYTES), spart_tab(ws, 4), nullptr, nullptr); }
        }
        if (l == 0) {
            GSYNC();
            PH(13) { for (int it = vcu; it < NS; it += G) pool_sample_item(a, lds, it, spart_tab(ws, 2));
                     for (int it = vcu; it < 256; it += G) pool_tile(a, lds, it >> 2, it & 3, part_tab(ws, 2)); }
            GSYNC();
            PH(14) {
                pg8::Gemm g{R1, (const bf16_t*)(ws + WS_WPOOL), 1024, 256, 256, 256, 0, 256};
                pg8::StaticOrder S; S.init(64, 4, G, bx);
                EpiRes<3, true, true, false> E{a.out, nullptr, R2, R2, part_tab(ws, 3), nullptr, nullptr, a.in[I_POOLSC]};
                pg8::gemm_phase(lds, g, S, E);
                s_res_units<3, 256, 1024>(a, lds, bx, G, R1, (const bf16_t*)(ws + WS_WPOOL), R2, R2, spart_tab(ws, 3));
            }
            GSYNC();
        }
    }
    }
#if defined(PROBE_SUB) || defined(PROBE_P2) || defined(PROBE_P1) || defined(PROBE_E) || defined(PROBE_BAR)
    if (blockIdx.x == PROBE_BLK && threadIdx.x == 0) { const unsigned long long t_end = __builtin_amdgcn_s_memrealtime() + sub_d; while (__builtin_amdgcn_s_memrealtime() < t_end) __builtin_amdgcn_s_sleep(8); }
#endif
#if defined(PROBE_T)
    TSTAMP();
    if (blockIdx.x == 0 && threadIdx.x == 0) { const unsigned long long t_end = __builtin_amdgcn_s_memrealtime() + (t_b - t_a); while (__builtin_amdgcn_s_memrealtime() < t_end) __builtin_amdgcn_s_sleep(8); }
#endif
}

extern "C" void kernel_launch(void* const* d_in, const int* in_sizes, int n_in, void* d_out, int out_size, void* d_ws, size_t ws_size, hipStream_t stream) {
    static int grid = 0;
    if (grid == 0) {
        int dev = 0, cus = 0, per_cu = 0;
        hipGetDevice(&dev);
        hipDeviceGetAttribute(&cus, hipDeviceAttributeMultiprocessorCount, dev);
        hipFuncSetAttribute((const void*)mega_fwd, hipFuncAttributeMaxDynamicSharedMemorySize, LDS_BYTES);
        hipOccupancyMaxActiveBlocksPerMultiprocessor(&per_cu, (const void*)mega_fwd, NTHREADS, LDS_BYTES);
        if (per_cu < 1) { fprintf(stderr, "kernel_launch: occupancy query reports %d blocks per CU\n", per_cu); per_cu = 1; }
        if (per_cu > 1) per_cu = 1;
        grid = cus * per_cu;
        (void)hipGetLastError();
    }
    (void)hipMemsetAsync(d_ws, 0, 65536, stream);
    KArgs a{};
    for (int i = 0; i < 29; ++i) a.in[i] = (const float*)d_in[i];
    a.out = (float*)d_out; a.ws = (unsigned char*)d_ws;
    void* args[] = {&a};
    hipError_t e = hipLaunchCooperativeKernel((const void*)mega_fwd, dim3(grid), dim3(NTHREADS), args, LDS_BYTES, stream);
#if defined(PROBE_TWICE)
    (void)hipMemsetAsync(d_ws, 0, 65536, stream);
    e = hipLaunchCooperativeKernel((const void*)mega_fwd, dim3(grid), dim3(NTHREADS), args, LDS_BYTES, stream);
#endif
    if (e != hipSuccess) fprintf(stderr, "cooperative launch failed: %s (grid %d)\n", hipGetErrorString(e), grid);
}
```

```cpp
#include <hip/hip_runtime.h>
#include <hip/hip_cooperative_groups.h>
#include <cstdio>
#include <cstdint>
namespace cg = cooperative_groups;

#define LAS __attribute__((address_space(3)))
typedef unsigned short bf16_t;
typedef short bf16x8 __attribute__((ext_vector_type(8)));
typedef float f32x4 __attribute__((ext_vector_type(4)));
typedef float f32x2 __attribute__((ext_vector_type(2)));
typedef unsigned u32x4 __attribute__((ext_vector_type(4)));
typedef unsigned u32x2 __attribute__((ext_vector_type(2)));
typedef float f32x16 __attribute__((ext_vector_type(16)));

constexpr int D = 1024, SEQ = 16384, NS = 128, DFF = 2816, PLE = 256;
constexpr int SROW = 16510;
constexpr int MT = 16640;
constexpr int MR = 16768;
constexpr int NPROJ = 2304;
constexpr int PQA = 0, PKA = 256, PVA = 512, PRA = 1024, PQB = 1536, PKB = 2048, PVB = 2176;
constexpr float EPS = 1e-6f;
constexpr int NTHREADS = 512;

constexpr size_t O_YP = 0, O_YS = 16777216, O_GLAP = 16908288, O_SKP = 16941056, O_SVP = 16957440, O_POOLP = 16973824, O_CONVP = 16989184,
                 O_GLAS = 17000448, O_SKS = 21194752, O_SVS = 23291904, O_POOLS = 25389056, O_CONVS = 27355136;

constexpr size_t MiB = 1u << 20;
constexpr size_t WS_WIN0 = 1 * MiB, WS_WOUT0 = 6 * MiB, WS_WFFI = 8 * MiB, WS_WFFO = 30 * MiB, WS_WGATE = 41 * MiB, WS_WPROJ = 45 * MiB, WS_WPOOL = 46 * MiB;
constexpr size_t WS_SSQ = 47 * MiB;
constexpr size_t WS_PBF = 55 * MiB, WS_R1 = 72 * MiB, WS_R2 = 105 * MiB, WS_BIG = 138 * MiB;
constexpr size_t PART_STRIDE = (size_t)(MR + 8) * 16 * 4;
constexpr size_t WFFI_BYTES = (size_t)5632 * 1024 * 2, WFFO_BYTES = (size_t)1024 * 2816 * 2, WGATE_BYTES = (size_t)1024 * 1024 * 2, WPROJ_BYTES = (size_t)1024 * 256 * 2;
constexpr size_t BIG_LA = (size_t)MT * NPROJ * 2;
constexpr int LDS_BYTES = 155648;

#ifndef NT_STORES
#define NT_STORES 0
#endif
#ifndef WARM
#define WARM 0
#endif
typedef unsigned u32x4_fwd __attribute__((ext_vector_type(4)));
#if NT_STORES == 2
__device__ __forceinline__ void st16_sc1(void* p, u32x4_fwd v);
#define ST16(p, v) st16_sc1((void*)(p), (v))
#elif NT_STORES
#define ST16(p, v) __builtin_nontemporal_store((v), (p))
#else
#define ST16(p, v) (*(p) = (v))
#endif
#if NT_STORES == 2
__device__ __forceinline__ void st16_sc1(void* p, u32x4_fwd v) { asm volatile("global_store_dwordx4 %0, %1, off sc1\n\ts_nop 1" :: "v"(p), "v"(v) : "memory"); }
#endif
#define LBAR() do { asm volatile("s_waitcnt lgkmcnt(0)" ::: "memory"); __builtin_amdgcn_s_barrier(); asm volatile("" ::: "memory"); } while (0)
__device__ __forceinline__ unsigned cvt_pk_bf16(float lo, float hi) { unsigned r; asm volatile("v_cvt_pk_bf16_f32 %0, %1, %2" : "=v"(r) : "v"(lo), "v"(hi)); return r; }
__device__ __forceinline__ float bf_lo(unsigned w) { return __uint_as_float(w << 16); }
__device__ __forceinline__ float bf_hi(unsigned w) { return __uint_as_float(w & 0xffff0000u); }
__device__ __forceinline__ float bf2f(bf16_t v) { return __uint_as_float(((unsigned)v) << 16); }
__device__ __forceinline__ void unpack8(const u32x4 w, float* f) { f[0] = bf_lo(w.x); f[1] = bf_hi(w.x); f[2] = bf_lo(w.y); f[3] = bf_hi(w.y); f[4] = bf_lo(w.z); f[5] = bf_hi(w.z); f[6] = bf_lo(w.w); f[7] = bf_hi(w.w); }
__device__ __forceinline__ float wave_sum(float v) {
#pragma unroll
    for (int o = 1; o < 64; o <<= 1) v += __shfl_xor(v, o);
    return v;
}
__device__ __forceinline__ float wave_max(float v) {
#pragma unroll
    for (int o = 1; o < 64; o <<= 1) v = fmaxf(v, __shfl_xor(v, o));
    return v;
}
__device__ __forceinline__ int otid() { int t = threadIdx.x; asm volatile("" : "+v"(t)); return t; }
__device__ __forceinline__ bool row_valid(int row) { return row < SEQ || (row >= SROW && row < SROW + NS); }
__device__ __forceinline__ float* hrow_ptr(float* out, int row) { return row < SEQ ? out + O_YP + (size_t)row * D : out + O_YS + (size_t)(row - SROW) * D; }
__device__ __forceinline__ f32x2 gelu_pk(f32x2 v) {
    const f32x2 av = __builtin_elementwise_abs(v), d = av * 0.2316418882f + 1.0f;
    f32x2 t; t.x = __builtin_amdgcn_rcpf(d.x); t.y = __builtin_amdgcn_rcpf(d.y);
    f32x2 q = t * 0.5307027145f + (-0.7265760135f); q = q * t + 0.7107068705f; q = q * t + (-0.142248368f); q = q * t + 0.127414796f; q = q * t;
    const f32x2 s = (v * v) * (-0.72134752044f);
    f32x2 e; e.x = __builtin_amdgcn_exp2f(s.x); e.y = __builtin_amdgcn_exp2f(s.y);
    const f32x2 m = v * (q * e), r = v - m;
    f32x2 o; o.x = v.x < 0.f ? m.x : r.x; o.y = v.y < 0.f ? m.y : r.y; return o;
}

namespace pg8 {
constexpr int BM = 256, BK = 64, HALF = 128, HTB = HALF * BK * 2, STAGE_BYTES = 8 * HTB, NXCD = 8, WGM = 8;
__host__ __device__ __forceinline__ int lds_byte(int r, int c) { const int st = (r >> 4) * 2 + (c >> 5), rr = r & 15, cc = c & 31, ob = rr * 64 + cc * 2; return st * 1024 + (ob ^ (((ob >> 9) & 1) << 5)); }
__host__ __device__ __forceinline__ void stage_rc(int b, int& R, int& C) { const int st = b / 1024, sb = b % 1024, swz = sb ^ (((sb >> 9) & 1) << 5); R = (st >> 1) * 16 + swz / 64; C = (st & 1) * 32 + (swz % 64) / 2; }
__host__ __device__ __forceinline__ int perm32(int rho) { const int n = rho >> 4, i = rho & 15; return 8 * (i >> 2) + 4 * n + (i & 3); }

struct Unit { int pm, pn; };
struct Gemm { const bf16_t* A; const bf16_t* Bt; int lda, ldb, K, mstride, arow0, acolstep; };

struct StaticOrder {
    int nM, nN, nwg, G, c;
    __device__ void init(int nM_, int nN_, int G_, int c_) { nM = nM_; nN = nN_; nwg = nM * nN; G = G_; c = c_; }
    __device__ bool next(int i, Unit& u) const {
        const long L = (long)i * G + c; if (L >= nwg) return false;
        int wgid = (int)L; { const int q = nwg / NXCD, r = nwg % NXCD, xcd = wgid % NXCD, off = wgid / NXCD; wgid = (xcd < r ? xcd * (q + 1) : r * (q + 1) + (xcd - r) * q) + off; }
        const int nig = WGM * nN, gid = wgid / nig, fm = gid * WGM, gsz = (nM - fm) < WGM ? (nM - fm) : WGM;
        u.pm = fm + ((wgid % nig) % gsz); u.pn = (wgid % nig) / gsz; return true;
    }
};

template <class Epi, int WARM_BYTES = 0>
__device__ __forceinline__ void gemm_phase(LAS unsigned char* lds, const Gemm g, const StaticOrder& S, const Epi& E, unsigned long long* tacc = nullptr) {
    const int tid = otid(), wid = __builtin_amdgcn_readfirstlane(tid >> 6), lane = tid & 63, wr = wid >> 2, wc = wid & 3, fr = lane & 15, fq = lane >> 4;
    const int K = g.K, nt = K / BK;
    unsigned voffA[2], voffB[2];
#pragma unroll
    for (int i = 0; i < 2; ++i) { int R, C; stage_rc(tid * 16 + i * 8192, R, C); const int Rb = (R & ~31) + perm32(R & 31);
        voffA[i] = (unsigned)(R * g.lda + C) * 2u; voffB[i] = (unsigned)(Rb * g.ldb + C) * 2u; }
    const size_t kstep = (size_t)(BK * 2);
    const size_t hstepA = (size_t)HALF * g.lda * 2, hstepB = (size_t)HALF * g.ldb * 2;
    const unsigned ldsw = (unsigned)wid * 1024u;
    const int aoff = lds_byte(wr * 64 + fr, fq * 8), boff = lds_byte(wc * 32 + fr, fq * 8);
#define PG8_SA(b, h) (((b) * 2 + (h)) * HTB)
#define PG8_SB(b, h) ((4 + (b) * 2 + (h)) * HTB)
#define PG8_STAGE(bufoff, gbase, voff) do { _Pragma("unroll") for (int _i = 0; _i < 2; ++_i) \
        __builtin_amdgcn_global_load_lds((const unsigned*)((const char*)(gbase) + (voff)[_i]), (LAS unsigned*)(lds + (bufoff) + ldsw + _i * 8192), 16, 0, 0); } while (0)
#define PG8_LDA(dst, b, h) do { _Pragma("unroll") for (int m = 0; m < 4; ++m) _Pragma("unroll") for (int k = 0; k < 2; ++k) dst[m][k] = *(const LAS bf16x8*)(lds + PG8_SA(b, h) + aoff + m * 2048 + k * 1024); } while (0)
#define PG8_LDB(dst, b, h) do { _Pragma("unroll") for (int n = 0; n < 2; ++n) _Pragma("unroll") for (int k = 0; k < 2; ++k) dst[n][k] = *(const LAS bf16x8*)(lds + PG8_SB(b, h) + boff + n * 2048 + k * 1024); } while (0)
#define PG8_MMA(ai, bj, At, Bt) do { __builtin_amdgcn_s_setprio(1); _Pragma("unroll") for (int m = 0; m < 4; ++m) _Pragma("unroll") for (int n = 0; n < 2; ++n) _Pragma("unroll") for (int k = 0; k < 2; ++k) \
        acc[ai][bj][m][n] = __builtin_amdgcn_mfma_f32_16x16x32_bf16(Bt[n][k], At[m][k], acc[ai][bj][m][n], 0, 0, 0); __builtin_amdgcn_s_setprio(0); } while (0)
#define PG8_WAIT_V(n) asm volatile("s_waitcnt vmcnt(" #n ")" ::: "memory")
#define PG8_WAIT_L(n) asm volatile("s_waitcnt lgkmcnt(" #n ")" ::: "memory")
#define PG8_BAR __builtin_amdgcn_s_barrier()
#define PG8_SCHED __builtin_amdgcn_sched_barrier(0)
#define PG8_ABASE(u) ((const char*)g.A + ((long)((long)(u).pm * g.mstride + g.arow0) * g.lda + (long)(u).pn * g.acolstep) * 2)
#define PG8_BBASE(u) ((const char*)g.Bt + (size_t)(u).pn * 256 * g.ldb * 2)
    Unit cur, nxt; int ui = 0;
    if (!S.next(0, cur)) return;
    f32x4 acc[2][2][4][2];
#pragma unroll
    for (int a = 0; a < 2; ++a)
#pragma unroll
        for (int b = 0; b < 2; ++b)
#pragma unroll
            for (int m = 0; m < 4; ++m)
#pragma unroll
                for (int n = 0; n < 2; ++n) acc[a][b][m][n] = (f32x4){0.f, 0.f, 0.f, 0.f};
    bf16x8 At[4][2], B0[2][2], B1[2][2];
    const char* cA = PG8_ABASE(cur); const char* cB = PG8_BBASE(cur);
    if (WARM_BYTES > 0) {
        LAS unsigned* wdst = (LAS unsigned*)(lds + STAGE_BYTES + 4096 + wid * 1024);
#pragma unroll 1
        for (int r = wid; r < 256; r += 8) {
            const char* rp = cA + (size_t)r * g.lda * 2 + 16 * lane;
#pragma unroll
            for (int i = 0; i < WARM_BYTES / 1024; ++i) __builtin_amdgcn_global_load_lds((const unsigned*)(rp + i * 1024), wdst, 16, 0, 0);
        }
    }
#if defined(PROBE_GP)
    unsigned long long tg0_ = tacc ? __builtin_amdgcn_s_memrealtime() : 0;
#endif
    PG8_STAGE(PG8_SB(0, 0), cB, voffB); PG8_STAGE(PG8_SB(0, 1), cB + hstepB, voffB); PG8_STAGE(PG8_SA(0, 0), cA, voffA); PG8_STAGE(PG8_SA(0, 1), cA + hstepA, voffA);
    if (wr == 1) PG8_BAR;
    PG8_WAIT_V(2); PG8_BAR;
    PG8_STAGE(PG8_SB(1, 0), cB + kstep, voffB); PG8_STAGE(PG8_SA(1, 0), cA + kstep, voffA); PG8_STAGE(PG8_SB(1, 1), cB + hstepB + kstep, voffB);
    PG8_WAIT_V(6); PG8_BAR;
#if defined(PROBE_GP)
    unsigned long long tg1_ = tacc ? __builtin_amdgcn_s_memrealtime() : 0;
    if (tacc && PROBE_GP == 1) *tacc += tg1_ - tg0_;
#endif
    for (;;) {
        const bool has_next = S.next(ui + 1, nxt);
        const char* nA = has_next ? PG8_ABASE(nxt) : cA; const char* nB = has_next ? PG8_BBASE(nxt) : cB;
#pragma unroll 1
        for (int t = 0; t < nt; t += 2) {
            const bool last = (t == nt - 2);
            const char* a1 = cA + (size_t)(t + 1) * kstep;
            const char* a2 = last ? nA : cA + (size_t)(t + 2) * kstep; const char* b2 = last ? nB : cB + (size_t)(t + 2) * kstep;
            const char* a3 = a2 + kstep; const char* b3 = b2 + kstep;
            PG8_LDB(B0, 0, 0); PG8_LDB(B1, 0, 1); PG8_SCHED; PG8_LDA(At, 0, 0); PG8_STAGE(PG8_SA(1, 1), a1 + hstepA, voffA);
            PG8_WAIT_V(8); PG8_WAIT_L(0); PG8_BAR; PG8_MMA(0, 0, At, B0); PG8_MMA(0, 1, At, B1); PG8_BAR; PG8_SCHED;
            PG8_LDA(At, 0, 1); PG8_STAGE(PG8_SB(0, 0), b2, voffB); PG8_STAGE(PG8_SB(0, 1), b2 + hstepB, voffB); PG8_STAGE(PG8_SA(0, 0), a2, voffA);
            PG8_WAIT_V(8); PG8_WAIT_L(0); PG8_BAR; PG8_MMA(1, 0, At, B0); PG8_MMA(1, 1, At, B1); PG8_BAR; PG8_SCHED;
            PG8_LDB(B0, 1, 0); PG8_LDB(B1, 1, 1); PG8_SCHED; PG8_LDA(At, 1, 0); PG8_STAGE(PG8_SA(0, 1), a2 + hstepA, voffA);
            PG8_WAIT_V(8); PG8_WAIT_L(0); PG8_BAR; PG8_MMA(0, 0, At, B0); PG8_MMA(0, 1, At, B1); PG8_BAR; PG8_SCHED;
            PG8_LDA(At, 1, 1); PG8_STAGE(PG8_SB(1, 0), b3, voffB); PG8_STAGE(PG8_SB(1, 1), b3 + hstepB, voffB); PG8_STAGE(PG8_SA(1, 0), a3, voffA);
            PG8_WAIT_V(8); PG8_WAIT_L(0); PG8_BAR; PG8_MMA(1, 0, At, B0); PG8_MMA(1, 1, At, B1); PG8_BAR; PG8_SCHED;
        }
        if (wr == 0) PG8_BAR;
#if defined(PROBE_GP)
        if (tacc && PROBE_GP == 2) *tacc += __builtin_amdgcn_s_memrealtime() - tg1_;
#endif
        { unsigned long long te_ = 0; if (tacc) te_ = __builtin_amdgcn_s_memrealtime(); int lane2 = lane; asm volatile("" : "+v"(lane2)); E(acc, cur, wr, wc, lane2 & 15, lane2 >> 4, lds + STAGE_BYTES); if (tacc) { asm volatile("s_waitcnt vmcnt(0)" ::: "memory");
#if defined(PROBE_GP)
            if (PROBE_GP == 0)
#endif
            *tacc += __builtin_amdgcn_s_memrealtime() - te_; } }
        if (!has_next) break;
#pragma unroll
        for (int a = 0; a < 2; ++a)
#pragma unroll
            for (int b = 0; b < 2; ++b)
#pragma unroll
                for (int m = 0; m < 4; ++m)
#pragma unroll
                    for (int n = 0; n < 2; ++n) acc[a][b][m][n] = (f32x4){0.f, 0.f, 0.f, 0.f};
        cur = nxt; cA = nA; cB = nB; ++ui;
        if (wr == 1) PG8_BAR;
    }
    PG8_WAIT_V(0);
    PG8_BAR;
#undef PG8_SA
#undef PG8_SB
#undef PG8_STAGE
#undef PG8_LDA
#undef PG8_LDB
#undef PG8_MMA
#undef PG8_WAIT_V
#undef PG8_WAIT_L
#undef PG8_BAR
#undef PG8_SCHED
#undef PG8_ABASE
#undef PG8_BBASE
}
}

using pg8::Unit;
typedef f32x4 AccT[2][2][4][2];

__device__ __forceinline__ float row_rs(const float* part, int row, int fq) {
    const f32x4 p = *(const f32x4*)(part + (long)row * 16 + fq * 4);
    float s = (p[0] + p[1]) + (p[2] + p[3]);
    s += __shfl_xor(s, 16); s += __shfl_xor(s, 32);
    return rsqrtf(s * (1.0f / D) + EPS);
}

struct EpiProj {
    bf16_t* proj; float* la; const float* ssq0; const float* b_alpha;
    __device__ __forceinline__ void operator()(const AccT& acc, const Unit& u, int wr, int wc, int fr, int fq, LAS unsigned char*) const {
        float rsv[2][4];
#pragma unroll
        for (int ai = 0; ai < 2; ++ai)
#pragma unroll
            for (int m = 0; m < 4; ++m) rsv[ai][m] = ssq0[u.pm * 256 + ai * 128 + wr * 64 + m * 16 + fr];
        f32x4 bb[2][2];
        if (u.pn >= 9) {
#pragma unroll
            for (int bj = 0; bj < 2; ++bj) { const int c = bj * 128 + wc * 32 + fq * 8; bb[bj][0] = *(const f32x4*)(b_alpha + c); bb[bj][1] = *(const f32x4*)(b_alpha + c + 4); }
        }
#pragma unroll
        for (int ai = 0; ai < 2; ++ai)
#pragma unroll
            for (int m = 0; m < 4; ++m) {
                const int row = u.pm * 256 + ai * 128 + wr * 64 + m * 16 + fr;
                const float rs = rsqrtf(rsv[ai][m] * (1.0f / D) + EPS);
#pragma unroll
                for (int bj = 0; bj < 2; ++bj) {
                    const int col = u.pn * 256 + bj * 128 + wc * 32 + fq * 8;
                    const f32x4 v0 = acc[ai][bj][m][0] * rs, v1 = acc[ai][bj][m][1] * rs;
                    if (u.pn < 9) {
                        u32x4 w; w.x = cvt_pk_bf16(v0[0], v0[1]); w.y = cvt_pk_bf16(v0[2], v0[3]); w.z = cvt_pk_bf16(v1[0], v1[1]); w.w = cvt_pk_bf16(v1[2], v1[3]);
                        ST16((u32x4*)(proj + (size_t)row * NPROJ + col), w);
                    } else {
                        const int c = col - NPROJ;
                        f32x4 o0, o1;
#pragma unroll
                        for (int j = 0; j < 4; ++j) {
                            const float z0 = v0[j] + bb[bj][0][j], z1 = v1[j] + bb[bj][1][j];
                            o0[j] = (fminf(z0, 0.f) - __logf(1.0f + __expf(-fabsf(z0)))) * 0.0625f;
                            o1[j] = (fminf(z1, 0.f) - __logf(1.0f + __expf(-fabsf(z1)))) * 0.0625f;
                        }
                        *(f32x4*)(la + (size_t)row * 256 + c) = o0; *(f32x4*)(la + (size_t)row * 256 + c + 4) = o1;
                    }
                }
            }
    }
};
struct EpiPP {
    bf16_t* pp;
    __device__ __forceinline__ void operator()(const AccT& acc, const Unit& u, int wr, int wc, int fr, int fq, LAS unsigned char*) const {
#pragma unroll
        for (int ai = 0; ai < 2; ++ai)
#pragma unroll
            for (int m = 0; m < 4; ++m) {
                const int row = u.pm * 256 + ai * 128 + wr * 64 + m * 16 + fr;
#pragma unroll
                for (int bj = 0; bj < 2; ++bj) {
                    const int col = u.pn * 256 + bj * 128 + wc * 32 + fq * 8;
                    const f32x4 v0 = acc[ai][bj][m][0], v1 = acc[ai][bj][m][1];
                    u32x4 w; w.x = cvt_pk_bf16(v0[0], v0[1]); w.y = cvt_pk_bf16(v0[2], v0[3]); w.z = cvt_pk_bf16(v1[0], v1[1]); w.w = cvt_pk_bf16(v1[2], v1[3]);
                    ST16((u32x4*)(pp + (size_t)row * D + col), w);
                }
            }
    }
};
template <int MODE, bool WRITE_HB, bool WRITE_PART, bool WRITE_F32>
struct EpiRes {
    float* out; const float* xp; const bf16_t* hbin; bf16_t* hb; float* part; const float* part_in; const bf16_t* pp; const float* scale;
    struct Q { f32x4 xb[2][2]; u32x4 hw[2]; u32x4 pw[2]; f32x4 pin; };
    __device__ __forceinline__ void fetch(Q& q, const Unit& u, int st, int wr, int wc, int fr, int fq) const {
        const int row = u.pm * 256 + (st >> 2) * 128 + wr * 64 + (st & 3) * 16 + fr;
        if (MODE == 2) q.pin = *(const f32x4*)(part_in + (long)row * 16 + fq * 4);
#pragma unroll
        for (int bj = 0; bj < 2; ++bj) {
            const int col = u.pn * 256 + bj * 128 + wc * 32 + fq * 8;
            if (MODE == 0) { q.xb[bj][0] = *(const f32x4*)(xp + (size_t)row * D + col); q.xb[bj][1] = *(const f32x4*)(xp + (size_t)row * D + col + 4); }
            else q.hw[bj] = *(const u32x4*)(hbin + (size_t)row * D + col);
            if (MODE == 2) q.pw[bj] = *(const u32x4*)(pp + (size_t)row * D + col);
        }
    }
    __device__ __forceinline__ void operator()(const AccT& acc, const Unit& u, int wr, int wc, int fr, int fq, LAS unsigned char*) const {
        f32x4 sc[2][2];
        if (MODE == 3) {
#pragma unroll
            for (int bj = 0; bj < 2; ++bj) { const int col = u.pn * 256 + bj * 128 + wc * 32 + fq * 8; sc[bj][0] = *(const f32x4*)(scale + col); sc[bj][1] = *(const f32x4*)(scale + col + 4); }
        }
        Q qa, qb;
        fetch(qa, u, 0, wr, wc, fr, fq);
#pragma unroll
        for (int st = 0; st < 8; ++st) {
            const int ai = st >> 2, m = st & 3;
            Q& cur = (st & 1) ? qb : qa; Q& nxt = (st & 1) ? qa : qb;
            if (st < 7) fetch(nxt, u, st + 1, wr, wc, fr, fq);
            const int row = u.pm * 256 + ai * 128 + wr * 64 + m * 16 + fr;
            float rs = 1.f;
            if (MODE == 2) { float s = (cur.pin[0] + cur.pin[1]) + (cur.pin[2] + cur.pin[3]); s += __shfl_xor(s, 16); s += __shfl_xor(s, 32); rs = rsqrtf(s * (1.0f / D) + EPS); }
            float sq = 0.f;
#pragma unroll
            for (int bj = 0; bj < 2; ++bj) {
                const int col = u.pn * 256 + bj * 128 + wc * 32 + fq * 8;
                f32x4 v0 = acc[ai][bj][m][0], v1 = acc[ai][bj][m][1];
                if (MODE == 2) {
                    float pf[8]; unpack8(cur.pw[bj], pf);
#pragma unroll
                    for (int j = 0; j < 4; ++j) {
                        v0[j] = pf[j] * __builtin_amdgcn_rcpf(1.f + __expf(-v0[j] * rs));
                        v1[j] = pf[4 + j] * __builtin_amdgcn_rcpf(1.f + __expf(-v1[j] * rs));
                    }
                }
                if (MODE == 3) { v0 = v0 * sc[bj][0]; v1 = v1 * sc[bj][1]; }
                f32x4 b0, b1;
                if (MODE == 0) { b0 = cur.xb[bj][0]; b1 = cur.xb[bj][1]; }
                else { float bf[8]; unpack8(cur.hw[bj], bf); b0 = (f32x4){bf[0], bf[1], bf[2], bf[3]}; b1 = (f32x4){bf[4], bf[5], bf[6], bf[7]}; }
                const f32x4 h0 = b0 + v0, h1 = b1 + v1;
                if (WRITE_F32) { float* hp = out + O_YP + (size_t)row * D; *(f32x4*)(hp + col) = h0; *(f32x4*)(hp + col + 4) = h1; }
                if (WRITE_HB) { u32x4 w; w.x = cvt_pk_bf16(h0[0], h0[1]); w.y = cvt_pk_bf16(h0[2], h0[3]); w.z = cvt_pk_bf16(h1[0], h1[1]); w.w = cvt_pk_bf16(h1[2], h1[3]);
                    ST16((u32x4*)(hb + (size_t)row * D + col), w); }
                sq += (h0[0] * h0[0] + h0[1] * h0[1]) + (h0[2] * h0[2] + h0[3] * h0[3]) + (h1[0] * h1[0] + h1[1] * h1[1]) + (h1[2] * h1[2] + h1[3] * h1[3]);
            }
            if (WRITE_PART) {
                sq += __shfl_xor(sq, 16); sq += __shfl_xor(sq, 32);
                if (fq == 0) part[(long)row * 16 + u.pn * 4 + wc] = sq;
            }
        }
    }
};
struct EpiFfn {
    const float* part_in; const float* convw; const float* convb; float* convp_out; bf16_t* G;
    __device__ __forceinline__ void operator()(AccT& acc, const Unit& u, int wr, int wc, int fr, int fq, LAS unsigned char* ldsx) const {
        const int c0 = u.pn * 128 + wc * 32 + fq * 8;
        f32x4 w0[2], w1[2], w2[2], cb[2];
#pragma unroll
        for (int n = 0; n < 2; ++n) { const int cn = c0 + 4 * n;
            w0[n] = *(const f32x4*)(convw + cn); w1[n] = *(const f32x4*)(convw + DFF + cn); w2[n] = *(const f32x4*)(convw + 2 * DFF + cn); cb[n] = *(const f32x4*)(convb + cn); }
        f32x4 pin[2][4];
#pragma unroll
        for (int ai = 0; ai < 2; ++ai)
#pragma unroll
            for (int m = 0; m < 4; ++m) pin[ai][m] = *(const f32x4*)(part_in + (long)(u.pm * 254 - 2 + ai * 128 + wr * 64 + m * 16 + fr) * 16 + fq * 4);
#pragma unroll
        for (int ai = 0; ai < 2; ++ai)
#pragma unroll
            for (int m = 0; m < 4; ++m) {
                float s_ = (pin[ai][m][0] + pin[ai][m][1]) + (pin[ai][m][2] + pin[ai][m][3]); s_ += __shfl_xor(s_, 16); s_ += __shfl_xor(s_, 32);
                const float rs = rsqrtf(s_ * (1.0f / D) + EPS);
#pragma unroll
                for (int bj = 0; bj < 2; ++bj)
#pragma unroll
                    for (int n = 0; n < 2; ++n) acc[ai][bj][m][n] = acc[ai][bj][m][n] * rs;
            }
        LAS f32x4* xch = (LAS f32x4*)ldsx;
        if (fr >= 14) {
#pragma unroll
            for (int ai = 0; ai < 2; ++ai) {
                const int slot = ((((ai * 2 + wr) * 4 + wc) * 4 + fq) * 2 + (fr - 14)) * 2;
                xch[slot] = acc[ai][0][3][0]; xch[slot + 1] = acc[ai][0][3][1];
            }
        }
        asm volatile("s_waitcnt lgkmcnt(0)" ::: "memory"); __builtin_amdgcn_s_barrier(); asm volatile("" ::: "memory");
#pragma unroll
        for (int ai = 0; ai < 2; ++ai)
#pragma unroll
            for (int m = 0; m < 4; ++m) {
                const int tr = ai * 128 + wr * 64 + m * 16 + fr;
                const int grow = u.pm * 254 - 2 + tr;
                const bool store = (tr >= 2 && grow < SEQ);
                u32x4 w;
#pragma unroll
                for (int n = 0; n < 2; ++n) {
                    const f32x4 x = acc[ai][0][m][n];
                    f32x4 p;
                    if (m == 0) {
                        const int sa = (wr == 1) ? ai : 0, sw = (wr == 1) ? 0 : 1;
                        const bool has = (wr == 1) || (ai == 1);
                        const int slot = ((((sa * 2 + sw) * 4 + wc) * 4 + fq) * 2 + (fr >= 14 ? fr - 14 : 0)) * 2 + n;
                        p = xch[slot];
                        if (!has) p = (f32x4){0.f, 0.f, 0.f, 0.f};
                    } else p = acc[ai][0][m == 0 ? 0 : m - 1][n];
                    f32x4 p1, p2;
#pragma unroll
                    for (int j = 0; j < 4; ++j) {
                        const float xf = x[j], pf = p[j]; const int xi = __float_as_int(xf), pi = __float_as_int(pf);
                        const int r1 = __builtin_amdgcn_mov_dpp(pi, 0x121, 0xf, 0xf, true), r2 = __builtin_amdgcn_mov_dpp(pi, 0x122, 0xf, 0xf, true);
                        p1[j] = __int_as_float(__builtin_amdgcn_update_dpp(r1, xi, 0x111, 0xf, 0xf, false));
                        p2[j] = __int_as_float(__builtin_amdgcn_update_dpp(r2, xi, 0x112, 0xf, 0xf, false));
                    }
                    if (grow >= SEQ - 2 && grow < SEQ) *(f32x4*)(convp_out + (size_t)(grow - (SEQ - 2)) * DFF + c0 + 4 * n) = x;
                    const f32x4 ac = cb[n] + w0[n] * p2 + w1[n] * p1 + w2[n] * x;
                    const f32x4 v = acc[ai][1][m][n];
                    const f32x2 g0 = gelu_pk((f32x2){ac[0], ac[1]}), g1 = gelu_pk((f32x2){ac[2], ac[3]});
                    const unsigned lo = cvt_pk_bf16(g0.x * v[0], g0.y * v[1]), hi = cvt_pk_bf16(g1.x * v[2], g1.y * v[3]);
                    if (n == 0) { w.x = lo; w.y = hi; } else { w.z = lo; w.w = hi; }
                }
                if (store) ST16((u32x4*)(G + (size_t)grow * DFF + c0), w);
                asm volatile("" ::: "memory");
            }
    }
};

template <int NT>
struct EpiStoreOnly {
    bf16_t* dst;
    __device__ __forceinline__ void operator()(const AccT& acc, const Unit& u, int wr, int wc, int fr, int fq, LAS unsigned char*) const {
#pragma unroll
        for (int ai = 0; ai < 2; ++ai)
#pragma unroll
            for (int m = 0; m < 4; ++m) {
                const int row = u.pm * 254 + ai * 128 + wr * 64 + m * 16 + fr;
#pragma unroll
                for (int bj = 0; bj < 2; ++bj) {
                    const int col = (u.pn & 3) * 256 + bj * 128 + wc * 32 + fq * 8;
                    const f32x4 v0 = acc[ai][bj][m][0], v1 = acc[ai][bj][m][1];
                    u32x4 w; w.x = cvt_pk_bf16(v0[0], v0[1]); w.y = cvt_pk_bf16(v0[2], v0[3]); w.z = cvt_pk_bf16(v1[0], v1[1]); w.w = cvt_pk_bf16(v1[2], v1[3]);
                    if (NT) __builtin_nontemporal_store(w, (u32x4*)(dst + (size_t)row * D + col)); else *(u32x4*)(dst + (size_t)row * D + col) = w;
                }
            }
    }
};
struct EpiNull {
    __device__ __forceinline__ void operator()(const AccT& acc, const Unit& u, int wr, int wc, int fr, int fq, LAS unsigned char*) const {
#pragma unroll
        for (int ai = 0; ai < 2; ++ai)
#pragma unroll
            for (int bj = 0; bj < 2; ++bj)
#pragma unroll
                for (int m = 0; m < 4; ++m) { asm volatile("" :: "v"(acc[ai][bj][m][0]), "v"(acc[ai][bj][m][1])); }
    }
};
struct KArgs { const float* in[29]; float* out; unsigned char* ws; };
enum { I_XP = 0, I_XS, I_PP, I_PS, I_SGLA, I_CK, I_CV, I_SPOOL, I_SCONV, I_MNE, I_WIN, I_WALPHA, I_BALPHA, I_ONORM, I_QNORM, I_KNORM, I_SINKS, I_WOUT,
       I_MNO, I_POOLW, I_POOLSC, I_FNORM, I_FWIN, I_FCW, I_FCB, I_FWOUT, I_PNORM, I_PWPROJ, I_PWGATE };

__device__ __forceinline__ float* part_tab(unsigned char* ws, int i) { return (float*)(ws + WS_SSQ + 262144 + (size_t)i * PART_STRIDE) + 2 * 16; }

constexpr int SG_STAGE = 24576, SG_NST = 6, SPART_PITCH = 36;
constexpr size_t WS_SPART = WS_SSQ + 6750208;
__device__ __forceinline__ float* spart_tab(unsigned char* ws, int i) { return (float*)(ws + WS_SPART) + (size_t)i * 128 * 32; }
template <int K, int LDA, int LDB>
__device__ __forceinline__ void sgemm_tile(const bf16_t* __restrict__ A, const bf16_t* __restrict__ B0, const bf16_t* __restrict__ B1, LAS unsigned char* lds) {
    const int tid = otid(), lane = tid & 63, wave = __builtin_amdgcn_readfirstlane(tid >> 6);
    const int fr = lane & 15, fq = lane >> 4, mb = wave >> 1, nb = wave & 1;
    constexpr int NSTG = K / 128;
    static_assert(K % 128 == 0 && NSTG >= 2, "K must be a multiple of 128");
    const int prow = lane >> 4, ppc = lane & 15;
    const char* gsrc[3]; unsigned ldst[3];
#pragma unroll
    for (int j = 0; j < 3; ++j) {
        if (j < 2) { const int i = wave + 8 * j, row = 4 * i + prow; gsrc[j] = (const char*)(A + (size_t)row * LDA) + 16 * (ppc ^ (row & 15)); ldst[j] = (unsigned)i * 1024u; }
        else { const int row = 4 * wave + prow; const bf16_t* bp = row < 16 ? B0 + (size_t)row * LDB : B1 + (size_t)(row - 16) * LDB; gsrc[j] = (const char*)bp + 16 * (ppc ^ (row & 15)); ldst[j] = 16384u + (unsigned)wave * 1024u; }
    }
#define SG_DMA(c) do { const int st_ = ((c) % SG_NST) * SG_STAGE; _Pragma("unroll") for (int j_ = 0; j_ < 3; ++j_) \
        __builtin_amdgcn_global_load_lds((const unsigned*)(gsrc[j_] + (size_t)(c) * 256), (LAS unsigned*)(lds + st_ + ldst[j_]), 16, 0, 0); } while (0)
    f32x4 acc = (f32x4){0.f, 0.f, 0.f, 0.f};
    int aoff[4], boff[4];
#pragma unroll
    for (int s = 0; s < 4; ++s) { aoff[s] = (16 * mb + fr) * 256 + 16 * ((4 * s + fq) ^ fr); boff[s] = 16384 + (16 * nb + fr) * 256 + 16 * ((4 * s + fq) ^ fr); }
#pragma unroll
    for (int c = 0; c < (NSTG < 5 ? NSTG : 5); ++c) SG_DMA(c);
#pragma unroll 1
    for (int c = 0; c < NSTG; ++c) {
        if (c + 5 < NSTG) SG_DMA(c + 5);
        const int ahead = (NSTG - 1 - c) < 5 ? (NSTG - 1 - c) : 5;
        if (ahead == 5) asm volatile("s_waitcnt vmcnt(15)" ::: "memory");
        else if (ahead == 4) asm volatile("s_waitcnt vmcnt(12)" ::: "memory");
        else if (ahead == 3) asm volatile("s_waitcnt vmcnt(9)" ::: "memory");
        else if (ahead == 2) asm volatile("s_waitcnt vmcnt(6)" ::: "memory");
        else if (ahead == 1) asm volatile("s_waitcnt vmcnt(3)" ::: "memory");
        else asm volatile("s_waitcnt vmcnt(0)" ::: "memory");
        __builtin_amdgcn_s_barrier(); asm volatile("" ::: "memory");
        const LAS unsigned char* st = lds + (c % SG_NST) * SG_STAGE;
#pragma unroll
        for (int s = 0; s < 4; ++s) {
            const bf16x8 af = *(const LAS bf16x8*)(st + aoff[s]), bf = *(const LAS bf16x8*)(st + boff[s]);
            acc = __builtin_amdgcn_mfma_f32_16x16x32_bf16(bf, af, acc, 0, 0, 0);
        }
        asm volatile("s_waitcnt lgkmcnt(0)" ::: "memory"); __builtin_amdgcn_s_barrier(); asm volatile("" ::: "memory");
    }
#undef SG_DMA
    *(LAS f32x4*)((LAS float*)lds + (16 * mb + fr) * SPART_PITCH + 16 * nb + 4 * fq) = acc;
}
__device__ __forceinline__ f32x4 sread4(const LAS unsigned char* lds, int b, int col0) { return *(const LAS f32x4*)((const LAS float*)lds + b * SPART_PITCH + col0); }
__device__ __forceinline__ float s_row_rs(const float* spart, int sb) {
    const float* p = spart + (size_t)sb * 32; float s = 0.f;
#pragma unroll
    for (int i = 0; i < 32; i += 4) { const f32x4 v = *(const f32x4*)(p + i); s += (v[0] + v[1]) + (v[2] + v[3]); }
    return rsqrtf(s * (1.0f / D) + EPS);
}
template <int MODE, bool WRITE_HB, bool WRITE_PART, bool WRITE_F32>
__device__ __forceinline__ void s_res_epi(const KArgs& a, int sb, int q, int cu, const f32x4 v, const bf16_t* hbin, bf16_t* hb, float* spart, const f32x4 ppv, float rs_in, const float* scale) {
    const int row = SROW + sb, c0 = 32 * cu + 4 * q;
    f32x4 base;
    if (MODE == 0) base = *(const f32x4*)(a.in[I_XS] + (size_t)sb * D + c0);
    else { const u32x2 w = *(const u32x2*)(hbin + (size_t)row * D + c0); base = (f32x4){bf_lo(w.x), bf_hi(w.x), bf_lo(w.y), bf_hi(w.y)}; }
    f32x4 hn; float sq = 0.f;
#pragma unroll
    for (int j = 0; j < 4; ++j) {
        float nv = v[j];
        if (MODE == 2) nv = ppv[j] * __builtin_amdgcn_rcpf(1.f + __expf(-nv * rs_in));
        if (MODE == 3) nv = nv * scale[c0 + j];
        hn[j] = base[j] + nv; sq += hn[j] * hn[j];
    }
    if (WRITE_F32) *(f32x4*)(a.out + O_YS + (size_t)sb * D + c0) = hn;
    if (WRITE_HB) { u32x2 w; w.x = cvt_pk_bf16(hn[0], hn[1]); w.y = cvt_pk_bf16(hn[2], hn[3]); *(u32x2*)(hb + (size_t)row * D + c0) = w; }
    if (WRITE_PART) {
        sq += __shfl_xor(sq, 1); sq += __shfl_xor(sq, 2); sq += __shfl_xor(sq, 4);
        if (q == 0) spart[(size_t)sb * 32 + cu] = sq;
    }
}
__device__ __forceinline__ void s_proj_units(const KArgs& a, LAS unsigned char* lds, int u0, int ustep) {
    const bf16_t* xbf = (const bf16_t*)(a.ws + WS_R1) + (size_t)SROW * D; const bf16_t* W = (const bf16_t*)(a.ws + WS_WIN0);
    bf16_t* proj = (bf16_t*)(a.ws + WS_BIG); float* la = (float*)(a.ws + WS_BIG + BIG_LA); const float* ssq0 = (const float*)(a.ws + WS_SSQ);
    for (int u = u0; u < 160; u += ustep) {
        const int rh = u & 1, cu = u >> 1, n0 = cu * 32;
        sgemm_tile<1024, 1024, 1024>(xbf + (size_t)(64 * rh) * D, W + (size_t)n0 * 1024, W + (size_t)(n0 + 16) * 1024, lds);
        __syncthreads();
        const int tid = otid(), b = tid >> 3, q = tid & 7, sb = 64 * rh + b, c0 = n0 + 4 * q, row = SROW + sb;
        const f32x4 v = sread4(lds, b, 4 * q);
        const float rs = rsqrtf(ssq0[row] * (1.0f / D) + EPS);
        if (n0 < NPROJ) {
            u32x2 w; w.x = cvt_pk_bf16(v[0] * rs, v[1] * rs); w.y = cvt_pk_bf16(v[2] * rs, v[3] * rs);
            *(u32x2*)(proj + (size_t)row * NPROJ + c0) = w;
        } else {
            const int c = c0 - NPROJ; f32x4 o;
#pragma unroll
            for (int i = 0; i < 4; ++i) { const float z = v[i] * rs + a.in[I_BALPHA][c + i]; o[i] = (fminf(z, 0.f) - __logf(1.0f + __expf(-fabsf(z)))) * 0.0625f; }
            *(f32x4*)(la + (size_t)row * 256 + c) = o;
        }
        __syncthreads();
    }
}
template <int MODE, int K, int LDA>
__device__ __forceinline__ void s_res_units(const KArgs& a, LAS unsigned char* lds, int u0, int ustep, const bf16_t* A, const bf16_t* W, const bf16_t* hbin, bf16_t* hb, float* spart_out) {
    for (int u = u0; u < 64; u += ustep) {
        const int rh = u & 1, cu = u >> 1, n0 = cu * 32;
        const bf16_t* Au = A + (size_t)(SROW + 64 * rh) * LDA + (MODE == 3 ? (n0 >> 8) * 256 : 0);
        sgemm_tile<K, LDA, K>(Au, W + (size_t)n0 * K, W + (size_t)(n0 + 16) * K, lds);
        __syncthreads();
        const int tid = otid(), b = tid >> 3, q = tid & 7;
        const f32x4 v = sread4(lds, b, 4 * q);
        s_res_epi<MODE, true, true, false>(a, 64 * rh + b, q, cu, v, hbin, hb, spart_out, v, 1.f, a.in[I_POOLSC]);
        __syncthreads();
    }
}
template <bool LAST>
__device__ __forceinline__ void s_ple_units(const KArgs& a, LAS unsigned char* lds, int u0, int ustep, const bf16_t* pb, const bf16_t* Wp, const bf16_t* hbA, const bf16_t* Wg, const float* spart_in, float* spart_out, bf16_t* hbout) {
    for (int u = u0; u < 64; u += ustep) {
        const int rh = u & 1, cu = u >> 1, n0 = cu * 32;
        sgemm_tile<256, 256, 256>(pb + (size_t)(SROW + 64 * rh) * PLE, Wp + (size_t)n0 * PLE, Wp + (size_t)(n0 + 16) * PLE, lds);
        __syncthreads();
        const int tid = otid(), b = tid >> 3, q = tid & 7;
        const f32x4 ppv = sread4(lds, b, 4 * q);
        __syncthreads();
        sgemm_tile<1024, 1024, 1024>(hbA + (size_t)(SROW + 64 * rh) * D, Wg + (size_t)n0 * D, Wg + (size_t)(n0 + 16) * D, lds);
        __syncthreads();
        const f32x4 v = sread4(lds, b, 4 * q);
        const float rs = s_row_rs(spart_in, 64 * rh + b);
        s_res_epi<2, !LAST, !LAST, LAST>(a, 64 * rh + b, q, cu, v, hbA, hbout, spart_out, ppv, rs, nullptr);
        __syncthreads();
    }
}
__device__ __forceinline__ void s_ffn_units(const KArgs& a, LAS unsigned char* lds, int u0, int ustep, int l, const bf16_t* hbA, const float* spart_in) {
    const bf16_t* W = (const bf16_t*)(a.ws + WS_WFFI + l * WFFI_BYTES);
    bf16_t* Gb = (bf16_t*)(a.ws + WS_BIG);
    const float* convw = a.in[I_FCW] + (size_t)l * 3 * DFF; const float* convb = a.in[I_FCB] + (size_t)l * DFF;
    const float* cstate = a.in[I_SCONV] + (size_t)l * NS * 2 * DFF; float* convs = a.out + O_CONVS + (size_t)l * NS * 2 * DFF;
    for (int u = u0; u < 352; u += ustep) {
        const int rh = u & 1, cu = u >> 1, ca = cu * 16;
        const int nr = 256 * (ca >> 7) + (ca & 127);
        sgemm_tile<1024, 1024, 1024>(hbA + (size_t)(SROW + 64 * rh) * D, W + (size_t)nr * 1024, W + (size_t)(nr + 128) * 1024, lds);
        __syncthreads();
        const int tid = otid(), b = tid >> 3, q = tid & 7, sb = 64 * rh + b;
        if (q < 4) {
            const int c = ca + 4 * q;
            const f32x4 av = sread4(lds, b, 4 * q), vv = sread4(lds, b, 16 + 4 * q);
            const float rs = s_row_rs(spart_in, sb);
            const float* st = cstate + (size_t)sb * 2 * DFF + c; float* so = convs + (size_t)sb * 2 * DFF + c;
            const f32x4 p2 = *(const f32x4*)(st), p1 = *(const f32x4*)(st + DFF);
            const f32x4 w0 = *(const f32x4*)(convw + c), w1 = *(const f32x4*)(convw + DFF + c), w2 = *(const f32x4*)(convw + 2 * DFF + c), cb = *(const f32x4*)(convb + c);
            const f32x4 x = av * rs;
            *(f32x4*)(so) = p1; *(f32x4*)(so + DFF) = x;
            const f32x4 ac = cb + w0 * p2 + w1 * p1 + w2 * x;
            const f32x2 g0 = gelu_pk((f32x2){ac[0], ac[1]}), g1 = gelu_pk((f32x2){ac[2], ac[3]});
            u32x2 w; w.x = cvt_pk_bf16(g0.x * vv[0] * rs, g0.y * vv[1] * rs); w.y = cvt_pk_bf16(g1.x * vv[2] * rs, g1.y * vv[3] * rs);
            *(u32x2*)(Gb + (size_t)(SROW + sb) * DFF + c) = w;
        }
        __syncthreads();
    }
}

__device__ __forceinline__ void tr_item(const float* W, int ldsrc, int scol0, int k0, const float* gain, bf16_t* dst, int ldd, int drow0, LAS float* scr, int lane) {
    float wv[32];
#pragma unroll
    for (int i = 0; i < 32; ++i) { const int kk = 2 * i + (lane >> 5); wv[i] = __builtin_nontemporal_load(W + (size_t)(k0 + kk) * ldsrc + scol0 + (lane & 31)); }
#pragma unroll
    for (int i = 0; i < 32; ++i) { const int kk = 2 * i + (lane >> 5); const float gsc = gain ? gain[k0 + kk] : 1.f; scr[kk * 33 + (lane & 31)] = wv[i] * gsc; }
    asm volatile("s_waitcnt lgkmcnt(0)" ::: "memory");
    const int c = lane & 7;
#pragma unroll
    for (int j = 0; j < 4; ++j) { const int n = (lane >> 3) + 8 * j; const LAS float* s = scr + (8 * c) * 33 + n;
        u32x4 o; o.x = cvt_pk_bf16(s[0 * 33], s[1 * 33]); o.y = cvt_pk_bf16(s[2 * 33], s[3 * 33]); o.z = cvt_pk_bf16(s[4 * 33], s[5 * 33]); o.w = cvt_pk_bf16(s[6 * 33], s[7 * 33]);
        *(u32x4*)(dst + (size_t)(drow0 + n) * ldd + k0 + 8 * c) = o; }
    asm volatile("s_waitcnt lgkmcnt(0)" ::: "memory");
}
__device__ __forceinline__ void tr_item64(const float* W, int ldsrc, int scol0, int k0, const float* gain, bf16_t* dst, int ldd, int drow0, LAS float* scr, int lane) {
    f32x4 wv[16];
#pragma unroll
    for (int i = 0; i < 16; ++i) { const int kk = 4 * i + (lane >> 4); wv[i] = __builtin_nontemporal_load((const f32x4*)(W + (size_t)(k0 + kk) * ldsrc + scol0 + 4 * (lane & 15))); }
#pragma unroll
    for (int i = 0; i < 16; ++i) { const int kk = 4 * i + (lane >> 4); const float gsc = gain ? gain[k0 + kk] : 1.f;
        *(LAS f32x4*)(scr + kk * 68 + ((4 * (lane & 15)) ^ (((kk >> 3) & 7) << 2))) = wv[i] * gsc; }
    asm volatile("s_waitcnt lgkmcnt(0)" ::: "memory");
    const int c = lane & 7;
#pragma unroll
    for (int j = 0; j < 8; ++j) { const int n = (lane >> 3) + 8 * j; const LAS float* s = scr + (8 * c) * 68 + (n ^ (c << 2));
        u32x4 o; o.x = cvt_pk_bf16(s[0 * 68], s[1 * 68]); o.y = cvt_pk_bf16(s[2 * 68], s[3 * 68]); o.z = cvt_pk_bf16(s[4 * 68], s[5 * 68]); o.w = cvt_pk_bf16(s[6 * 68], s[7 * 68]);
        *(u32x4*)(dst + (size_t)(drow0 + n) * ldd + k0 + 8 * c) = o; }
    asm volatile("s_waitcnt lgkmcnt(0)" ::: "memory");
}
__device__ __forceinline__ void weff_item(const float* Win, const float* wal, int n0, int k0, const float* gain, bf16_t* dst, int drow0, LAS float* scr, int lane) {
#pragma unroll 2
    for (int i = 0; i < 32; ++i) { const int kk = 2 * i + (lane >> 5); const int k = k0 + kk; float s = 0.f;
#pragma unroll
        for (int r = 0; r < 16; ++r) s += Win[(size_t)k * 2320 + 1024 + r] * wal[r * 256 + n0 + (lane & 31)];
        scr[kk * 33 + (lane & 31)] = s * gain[k]; }
    asm volatile("s_waitcnt lgkmcnt(0)" ::: "memory");
    const int c = lane & 7;
#pragma unroll
    for (int j = 0; j < 4; ++j) { const int n = (lane >> 3) + 8 * j; const LAS float* s = scr + (8 * c) * 33 + n;
        u32x4 o; o.x = cvt_pk_bf16(s[0 * 33], s[1 * 33]); o.y = cvt_pk_bf16(s[2 * 33], s[3 * 33]); o.z = cvt_pk_bf16(s[4 * 33], s[5 * 33]); o.w = cvt_pk_bf16(s[6 * 33], s[7 * 33]);
        *(u32x4*)(dst + (size_t)(drow0 + n) * 1024 + k0 + 8 * c) = o; }
    asm volatile("s_waitcnt lgkmcnt(0)" ::: "memory");
}

__device__ __forceinline__ void p0_prologue(const KArgs& a, LAS unsigned char* lds, int vcu, int G) {
    const int tid = otid(), lane = tid & 63, wave = __builtin_amdgcn_readfirstlane(tid >> 6);
    LAS float* scr = (LAS float*)(lds + wave * 17408);
    const int gw = vcu * 8 + wave, NGW = G * 8;
    unsigned char* ws = a.ws;
    constexpr int I_A = 16 * 36, I_E = 16 * 8;
    for (int it = gw; it < I_A + I_E; it += NGW) {
        int r = it;
        if (r < I_A) { const int kb = r / 36, nb = r % 36, n0 = nb * 64; tr_item64(a.in[I_WIN], 2320, n0 < 1024 ? n0 : n0 + 16, kb * 64, a.in[I_MNE], (bf16_t*)(ws + WS_WIN0), 1024, n0, scr, lane); continue; } r -= I_A;
        { const int kb = r / 8, nb = r % 8; weff_item(a.in[I_WIN], a.in[I_WALPHA], nb * 32, kb * 64, a.in[I_MNE], (bf16_t*)(ws + WS_WIN0), NPROJ + nb * 32, scr, lane); }
    }
    bf16_t* xbf = (bf16_t*)(ws + WS_R1);
    float* ssq0 = (float*)(ws + WS_SSQ);
    for (int row0 = gw * 4; row0 < MT; row0 += NGW * 4) {
        f32x4 v[4][4];
#pragma unroll
        for (int rr = 0; rr < 4; ++rr) { const int row = row0 + rr;
            const float* src = row < SEQ ? a.in[I_XP] + (size_t)row * D : ((row >= SROW && row < SROW + NS) ? a.in[I_XS] + (size_t)(row - SROW) * D : nullptr);
#pragma unroll
            for (int j = 0; j < 4; ++j) { v[rr][j] = (f32x4){0.f, 0.f, 0.f, 0.f}; if (src) v[rr][j] = __builtin_nontemporal_load((const f32x4*)(src + j * 256 + lane * 4)); } }
#pragma unroll
        for (int rr = 0; rr < 4; ++rr) { const int row = row0 + rr; float s = 0.f;
#pragma unroll
            for (int j = 0; j < 4; ++j) { const f32x4 x = v[rr][j]; s += (x[0] * x[0] + x[1] * x[1]) + (x[2] * x[2] + x[3] * x[3]);
                u32x2 w; w.x = cvt_pk_bf16(x[0], x[1]); w.y = cvt_pk_bf16(x[2], x[3]);
                *(u32x2*)(xbf + (size_t)row * D + j * 256 + lane * 4) = w; }
            s = wave_sum(s);
            if (lane == 0) ssq0[row] = s; }
    }
    if (vcu == 0) { for (int i = tid; i < 256; i += NTHREADS) ((u32x4*)(ws + WS_R2))[i] = (u32x4){0u, 0u, 0u, 0u}; }
    if (vcu == 1 && tid < 6 * 32) { float* pt = (float*)(ws + WS_SSQ + 262144 + (size_t)(tid >> 5) * PART_STRIDE); pt[tid & 31] = 0.f; }
}
constexpr int CONV_ITEMS = 16 * 16 + 2 * 16 * 88 + 2 * 44 * 16 + 2 * 16 * 16 + 2 * 4 * 16 + 4 * 16;
constexpr int CONV_SPLIT = CONV_ITEMS;
__device__ __forceinline__ void p3_convert(const KArgs& a, LAS unsigned char* lds, int gw, int NGW, int it_lo, int it_hi, bool do_p) {
    const int tid = otid(), lane = tid & 63, wave = __builtin_amdgcn_readfirstlane(tid >> 6);
    LAS float* scr = (LAS float*)(lds + wave * 17408);
    unsigned char* ws = a.ws;
    constexpr int I_O = 16 * 16, I_FI = 16 * 88, I_FO = 44 * 16, I_G = 16 * 16, I_P = 4 * 16, I_PL = 4 * 16;
    static_assert(CONV_ITEMS == I_O + 2 * I_FI + 2 * I_FO + 2 * I_G + 2 * I_P + I_PL, "item count");
    for (int it = it_lo + gw; it < it_hi; it += NGW) {
        int r = it;
        if (r < I_O) { const int kb = r / 16, nb = r % 16; tr_item64(a.in[I_WOUT], 1024, nb * 64, kb * 64, nullptr, (bf16_t*)(ws + WS_WOUT0), 1024, nb * 64, scr, lane); continue; } r -= I_O;
        if (r < 2 * I_FI) { const int l = r / I_FI, q = r % I_FI, kb = q / 88, nb = q % 88, n0 = nb * 64;
            const int pn = n0 >> 8, rr = n0 & 255, bj = rr >> 7, ii = rr & 127;
            tr_item64(a.in[I_FWIN] + (size_t)l * 1024 * 5632, 5632, bj * DFF + pn * 128 + ii, kb * 64, a.in[I_FNORM] + l * 1024, (bf16_t*)(ws + WS_WFFI + l * WFFI_BYTES), 1024, n0, scr, lane); continue; } r -= 2 * I_FI;
        if (r < 2 * I_FO) { const int l = r / I_FO, q = r % I_FO, kb = q / 16, nb = q % 16;
            tr_item64(a.in[I_FWOUT] + (size_t)l * DFF * 1024, 1024, nb * 64, kb * 64, nullptr, (bf16_t*)(ws + WS_WFFO + l * WFFO_BYTES), DFF, nb * 64, scr, lane); continue; } r -= 2 * I_FO;
        if (r < 2 * I_G) { const int l = r / I_G, q = r % I_G, kb = q / 16, nb = q % 16;
            tr_item64(a.in[I_PWGATE] + (size_t)l * 1024 * 1024, 1024, nb * 64, kb * 64, a.in[I_PNORM] + l * 1024, (bf16_t*)(ws + WS_WGATE + l * WGATE_BYTES), 1024, nb * 64, scr, lane); continue; } r -= 2 * I_G;
        if (r < 2 * I_P) { const int l = r / I_P, q = r % I_P, kb = q / 16, nb = q % 16;
            tr_item64(a.in[I_PWPROJ] + (size_t)l * 256 * 1024, 1024, nb * 64, kb * 64, nullptr, (bf16_t*)(ws + WS_WPROJ + l * WPROJ_BYTES), 256, nb * 64, scr, lane); continue; } r -= 2 * I_P;
        { const int gq = r / 16, q = r % 16, kb = q / 4, nb = q % 4;
            tr_item64(a.in[I_POOLW] + (size_t)gq * 65536, 256, nb * 64, kb * 64, nullptr, (bf16_t*)(ws + WS_WPOOL), 256, gq * 256 + nb * 64, scr, lane); }
    }
    bf16_t* pbf = (bf16_t*)(ws + WS_PBF);
    if (do_p)
    for (int it0 = gw * 4; it0 < 2 * MT; it0 += NGW * 4) {
        f32x4 v[4];
#pragma unroll
        for (int rr = 0; rr < 4; ++rr) { const int it = it0 + rr; const int l = it / MT, row = it % MT;
            const float* src = row < SEQ ? a.in[I_PP] + ((size_t)l * SEQ + row) * PLE : ((row >= SROW && row < SROW + NS) ? a.in[I_PS] + ((size_t)l * NS + (row - SROW)) * PLE : nullptr);
            v[rr] = (f32x4){0.f, 0.f, 0.f, 0.f}; if (src) v[rr] = __builtin_nontemporal_load((const f32x4*)(src + lane * 4)); }
#pragma unroll
        for (int rr = 0; rr < 4; ++rr) { u32x2 w; w.x = cvt_pk_bf16(v[rr][0], v[rr][1]); w.y = cvt_pk_bf16(v[rr][2], v[rr][3]);
            *(u32x2*)(pbf + (size_t)(it0 + rr) * PLE + lane * 4) = w; }
    }
}

__device__ __forceinline__ int crow(int i, int hh) { return (i & 3) + 8 * (i >> 2) + 4 * hh; }
template <bool OUT>
__device__ __forceinline__ void gla_item_m(const KArgs& a, LAS unsigned char* lds, int item) {
    const int tid = otid(), lane = tid & 63, wave = __builtin_amdgcn_readfirstlane(tid >> 6);
    const int sc = item >> 2, h = item & 3;
    const bf16_t* proj = (const bf16_t*)(a.ws + WS_BIG); const float* la = (const float*)(a.ws + WS_BIG + BIG_LA);
    bf16_t* mix = (bf16_t*)(a.ws + WS_R1);
    float* US = (float*)(a.ws + WS_R2 + 4096); float* DS = US + (size_t)64 * 4 * 64 * 128;
    LAS float* bL = (LAS float*)lds; LAS float* segS = (LAS float*)(lds + 16384);
    LAS bf16_t* Qn = (LAS bf16_t*)(lds + 18432); LAS bf16_t* Kn = (LAS bf16_t*)(lds + 27648); LAS bf16_t* KT = (LAS bf16_t*)(lds + 36864);
    LAS bf16_t* VT = (LAS bf16_t*)(lds + 46080); LAS bf16_t* ST = (LAS bf16_t*)(lds + 64512); LAS float* red = (LAS float*)(lds + 82944);
    const int r = lane & 31, hh = lane >> 5;
    const int dkt = wave & 1, dvt = wave >> 1, it = wave & 1;
    f32x16 S = {};
    float* usp = US + ((size_t)(sc * 4 + h) * 64 + 32 * dkt) * 128 + 32 * dvt + r;
    if (OUT) {
#pragma unroll
        for (int i = 0; i < 16; ++i) S[i] = usp[(size_t)crow(i, hh) * 128];
    }
    float bsum = 0.f;
    const int sdk = tid & 63, sseg = tid >> 6, st_t = tid >> 3, sd8 = (tid & 7) * 8;
    float nla[8]; u32x4 nkw, nqw, nvw[2]; u32x2 nrw[4];
#define GLA_FETCH(cc) do { const int T0n = sc * 256 + (cc) * 64; \
        _Pragma("unroll") for (int i = 0; i < 8; ++i) nla[i] = la[(size_t)(T0n + 8 * sseg + i) * 256 + h * 64 + sdk]; \
        const size_t prow_ = (size_t)(T0n + st_t) * NPROJ; \
        nkw = *(const u32x4*)(proj + prow_ + PKA + h * 64 + sd8); \
        if (OUT) nqw = *(const u32x4*)(proj + prow_ + PQA + h * 64 + sd8); \
        nvw[0] = *(const u32x4*)(proj + prow_ + PVA + h * 128 + sd8); nvw[1] = *(const u32x4*)(proj + prow_ + PVA + h * 128 + sd8 + 64); \
        if (OUT) { _Pragma("unroll") for (int q = 0; q < 4; ++q) nrw[q] = *(const u32x2*)(proj + (size_t)(T0n + 32 * it + r) * NPROJ + PRA + h * 128 + 32 * dvt + 8 * q + 4 * hh); } } while (0)
    f32x4 onv[4];
    if (OUT) {
#pragma unroll
        for (int q = 0; q < 4; ++q) onv[q] = *(const f32x4*)(a.in[I_ONORM] + 32 * dvt + 8 * q + 4 * hh);
    }
    GLA_FETCH(0);
#pragma unroll 1
    for (int c = 0; c < 4; ++c) {
        const int T0 = sc * 256 + c * 64;
        float v[8]; u32x4 kw_c = nkw, qw_c = nqw, vw_c0 = nvw[0], vw_c1 = nvw[1]; u32x2 rw_c[4];
#pragma unroll
        for (int i = 0; i < 8; ++i) v[i] = nla[i];
#pragma unroll
        for (int q = 0; q < 4; ++q) rw_c[q] = nrw[q];
        if (c < 3) GLA_FETCH(c + 1);
        if (OUT) {
#pragma unroll
            for (int q = 0; q < 4; ++q) { u32x2 w; w.x = cvt_pk_bf16(S[4 * q], S[4 * q + 1]); w.y = cvt_pk_bf16(S[4 * q + 2], S[4 * q + 3]);
                *(LAS u32x2*)(ST + (32 * dvt + r) * 72 + 32 * dkt + 8 * q + 4 * hh) = w; }
        }
        {
            const int dk = sdk, seg = sseg;
#pragma unroll
            for (int i = 1; i < 8; ++i) v[i] += v[i - 1];
            segS[seg * 64 + dk] = v[7];
            LBAR();
            float off = 0.f;
#pragma unroll
            for (int s = 0; s < 8; ++s) { const float x = segS[s * 64 + dk]; off += (s < seg) ? x : 0.f; }
#pragma unroll
            for (int i = 0; i < 8; ++i) bL[(8 * seg + i) * 64 + dk] = v[i] + off;
            LBAR();
        }
        {
            const int t = st_t, d8 = sd8;
            const f32x4 b0 = *(const LAS f32x4*)(bL + t * 64 + d8), b1 = *(const LAS f32x4*)(bL + t * 64 + d8 + 4);
            const f32x4 l0 = *(const LAS f32x4*)(bL + 63 * 64 + d8), l1 = *(const LAS f32x4*)(bL + 63 * 64 + d8 + 4);
            float bb[8] = {b0[0], b0[1], b0[2], b0[3], b1[0], b1[1], b1[2], b1[3]}, bl[8] = {l0[0], l0[1], l0[2], l0[3], l1[0], l1[1], l1[2], l1[3]};
            float kf[8]; unpack8(kw_c, kf);
#pragma unroll
            for (int j = 0; j < 8; ++j) KT[(d8 + j) * 72 + t] = (bf16_t)(cvt_pk_bf16(kf[j] * __expf(bl[j] - bb[j]), 0.f) & 0xffffu);
            if (OUT) {
                float qf[8]; unpack8(qw_c, qf);
                float qq[8], kk[8];
#pragma unroll
                for (int j = 0; j < 8; ++j) { const float e = __expf(bb[j]); qq[j] = qf[j] * 0.125f * e; kk[j] = kf[j] * __expf(-bb[j]); }
                u32x4 w; w.x = cvt_pk_bf16(qq[0], qq[1]); w.y = cvt_pk_bf16(qq[2], qq[3]); w.z = cvt_pk_bf16(qq[4], qq[5]); w.w = cvt_pk_bf16(qq[6], qq[7]);
                *(LAS u32x4*)(Qn + t * 72 + d8) = w;
                w.x = cvt_pk_bf16(kk[0], kk[1]); w.y = cvt_pk_bf16(kk[2], kk[3]); w.z = cvt_pk_bf16(kk[4], kk[5]); w.w = cvt_pk_bf16(kk[6], kk[7]);
                *(LAS u32x4*)(Kn + t * 72 + d8) = w;
            }
#pragma unroll
            for (int i = 0; i < 2; ++i) { const int dv8 = d8 + 64 * i;
                const u32x4 vw = (i == 0) ? vw_c0 : vw_c1;
                LAS bf16_t* vt = VT + dv8 * 72 + t;
                vt[0 * 72] = (bf16_t)(vw.x & 0xffffu); vt[1 * 72] = (bf16_t)(vw.x >> 16); vt[2 * 72] = (bf16_t)(vw.y & 0xffffu); vt[3 * 72] = (bf16_t)(vw.y >> 16);
                vt[4 * 72] = (bf16_t)(vw.z & 0xffffu); vt[5 * 72] = (bf16_t)(vw.z >> 16); vt[6 * 72] = (bf16_t)(vw.w & 0xffffu); vt[7 * 72] = (bf16_t)(vw.w >> 16); }
            if (tid < 64) bsum += bL[63 * 64 + tid];
        }
        LBAR();
        if (OUT) {
            bf16x8 qf[4];
#pragma unroll
            for (int s = 0; s < 4; ++s) qf[s] = *(const LAS bf16x8*)(Qn + (32 * it + r) * 72 + 16 * s + 8 * hh);
            f32x16 oacc = {};
#pragma unroll
            for (int jt = 0; jt < 2; ++jt) {
                if (jt <= it) {
                    f32x16 at = {};
#pragma unroll
                    for (int s = 0; s < 4; ++s) { const bf16x8 af = *(const LAS bf16x8*)(Kn + (32 * jt + r) * 72 + 16 * s + 8 * hh); at = __builtin_amdgcn_mfma_f32_32x32x16_bf16(af, qf[s], at, 0, 0, 0); }
                    if (jt == it) {
#pragma unroll
                        for (int i = 0; i < 16; ++i) if (crow(i, hh) > r) at[i] = 0.f;
                    }
#pragma unroll
                    for (int s2 = 0; s2 < 2; ++s2) {
                        u32x4 pw; pw.x = cvt_pk_bf16(at[8 * s2 + 0], at[8 * s2 + 1]); pw.y = cvt_pk_bf16(at[8 * s2 + 2], at[8 * s2 + 3]);
                        pw.z = cvt_pk_bf16(at[8 * s2 + 4], at[8 * s2 + 5]); pw.w = cvt_pk_bf16(at[8 * s2 + 6], at[8 * s2 + 7]);
                        const LAS bf16_t* vp = VT + (32 * dvt + r) * 72 + 32 * jt + 16 * s2 + 4 * hh;
                        const u32x2 v0 = *(const LAS u32x2*)vp, v1 = *(const LAS u32x2*)(vp + 8);
                        const u32x4 vv = (u32x4){v0.x, v0.y, v1.x, v1.y};
                        oacc = __builtin_amdgcn_mfma_f32_32x32x16_bf16(__builtin_bit_cast(bf16x8, vv), __builtin_bit_cast(bf16x8, pw), oacc, 0, 0, 0);
                    }
                }
            }
#pragma unroll
            for (int s = 0; s < 4; ++s) { const bf16x8 af = *(const LAS bf16x8*)(ST + (32 * dvt + r) * 72 + 16 * s + 8 * hh); oacc = __builtin_amdgcn_mfma_f32_32x32x16_bf16(af, qf[s], oacc, 0, 0, 0); }
            float ss = 0.f;
#pragma unroll
            for (int i = 0; i < 16; ++i) ss += oacc[i] * oacc[i];
            ss += __shfl_xor(ss, 32);
            if (hh == 0) red[wave * 32 + r] = ss;
            LBAR();
            const float tot = (red[it * 32 + r] + red[(it + 2) * 32 + r]) + (red[(it + 4) * 32 + r] + red[(it + 6) * 32 + r]);
            const float rstd = rsqrtf(tot * (1.0f / 128.f) + EPS);
            const int t = T0 + 32 * it + r;
#pragma unroll
            for (int q = 0; q < 4; ++q) {
                const int dv0 = 32 * dvt + 8 * q + 4 * hh;
                const u32x2 rw = rw_c[q];
                const f32x4 on = onv[q];
                const float r0 = bf_lo(rw.x), r1 = bf_hi(rw.x), r2 = bf_lo(rw.y), r3 = bf_hi(rw.y);
                const float y0 = oacc[4 * q] * rstd * on[0] * (r0 * __builtin_amdgcn_rcpf(1.f + __expf(-r0))), y1 = oacc[4 * q + 1] * rstd * on[1] * (r1 * __builtin_amdgcn_rcpf(1.f + __expf(-r1)));
                const float y2 = oacc[4 * q + 2] * rstd * on[2] * (r2 * __builtin_amdgcn_rcpf(1.f + __expf(-r2))), y3 = oacc[4 * q + 3] * rstd * on[3] * (r3 * __builtin_amdgcn_rcpf(1.f + __expf(-r3)));
                u32x2 w; w.x = cvt_pk_bf16(y0, y1); w.y = cvt_pk_bf16(y2, y3);
                *(u32x2*)(mix + (size_t)t * D + h * 128 + dv0) = w;
            }
        }
#pragma unroll
        for (int i = 0; i < 16; ++i) S[i] *= __expf(bL[63 * 64 + 32 * dkt + crow(i, hh)]);
#pragma unroll
        for (int s = 0; s < 4; ++s) {
            const bf16x8 af = *(const LAS bf16x8*)(KT + (32 * dkt + r) * 72 + 16 * s + 8 * hh), bf = *(const LAS bf16x8*)(VT + (32 * dvt + r) * 72 + 16 * s + 8 * hh);
            S = __builtin_amdgcn_mfma_f32_32x32x16_bf16(af, bf, S, 0, 0, 0);
        }
        LBAR();
    }
#undef GLA_FETCH
    if (!OUT) {
#pragma unroll
        for (int i = 0; i < 16; ++i) usp[(size_t)crow(i, hh) * 128] = S[i];
        if (tid < 64) DS[(sc * 4 + h) * 64 + tid] = __expf(bsum);
    }
}
__device__ __forceinline__ void gla_scan_m(const KArgs& a, int vcu) {
    const int tid = otid(); if (tid >= 128) return;
    const int e = vcu * 128 + tid; if (e >= 32768) return;
    float* US = (float*)(a.ws + WS_R2 + 4096); const float* DS = US + (size_t)64 * 4 * 64 * 128;
    const int hd = e >> 7;
    float S = 0.f;
    for (int c0 = 0; c0 < 64; c0 += 8) {
        float u[8], d[8];
#pragma unroll
        for (int j = 0; j < 8; ++j) { u[j] = US[(size_t)(c0 + j) * 32768 + e]; d[j] = DS[(c0 + j) * 256 + hd]; }
#pragma unroll
        for (int j = 0; j < 8; ++j) { US[(size_t)(c0 + j) * 32768 + e] = S; S = d[j] * S + u[j]; }
    }
    a.out[O_GLAP + e] = S;
}
__device__ __forceinline__ void gla_decode_item(const KArgs& a, int item, int lane) {
    const int b = item >> 2, h = item & 3; const int row = SROW + b;
    const bf16_t* proj = (const bf16_t*)(a.ws + WS_BIG); const float* la = (const float*)(a.ws + WS_BIG + BIG_LA);
    bf16_t* mix = (bf16_t*)(a.ws + WS_R1);
    const float* S0 = a.in[I_SGLA] + ((size_t)b * 4 + h) * 8192;
    float* S1 = a.out + O_GLAS + ((size_t)b * 4 + h) * 8192;
    const float qv = bf2f(proj[(size_t)row * NPROJ + PQA + h * 64 + lane]) * 0.125f;
    const float kv = bf2f(proj[(size_t)row * NPROJ + PKA + h * 64 + lane]);
    const float av = __expf(la[(size_t)row * 256 + h * 64 + lane]);
    const unsigned vw = *(const unsigned*)(proj + (size_t)row * NPROJ + PVA + h * 128 + lane * 2);
    const float v0 = bf_lo(vw), v1 = bf_hi(vw);
    float o0 = 0.f, o1 = 0.f;
#pragma unroll 1
    for (int d0 = 0; d0 < 64; d0 += 16) {
        f32x2 sv[16];
#pragma unroll
        for (int j = 0; j < 16; ++j) sv[j] = __builtin_nontemporal_load((const f32x2*)(S0 + (d0 + j) * 128 + lane * 2));
#pragma unroll
        for (int j = 0; j < 16; ++j) {
            const int dk = d0 + j;
            const float q = __shfl(qv, dk), k = __shfl(kv, dk), al = __shfl(av, dk);
            const float n0 = al * sv[j].x + k * v0, n1 = al * sv[j].y + k * v1;
            __builtin_nontemporal_store((f32x2){n0, n1}, (f32x2*)(S1 + dk * 128 + lane * 2));
            o0 += q * n0; o1 += q * n1;
        }
    }
    const float ss = wave_sum(o0 * o0 + o1 * o1);
    const float rstd = rsqrtf(ss * (1.0f / 128.f) + EPS);
    const unsigned rw = *(const unsigned*)(proj + (size_t)row * NPROJ + PRA + h * 128 + lane * 2);
    const float r0 = bf_lo(rw), r1 = bf_hi(rw);
    const float y0 = o0 * rstd * a.in[I_ONORM][lane * 2] * (r0 / (1.f + __expf(-r0))), y1 = o1 * rstd * a.in[I_ONORM][lane * 2 + 1] * (r1 / (1.f + __expf(-r1)));
    *(unsigned*)(mix + (size_t)row * D + h * 128 + lane * 2) = cvt_pk_bf16(y0, y1);
}

__device__ __forceinline__ void swa_unit_m(const KArgs& a, LAS unsigned char* lds, int unit) {
    const int tid = otid(), lane = tid & 63, wave = __builtin_amdgcn_readfirstlane(tid >> 6);
    const int qb = unit >> 1, kvh = unit & 1; const int q0 = qb * 64, w0 = q0 - 128;
    const bf16_t* proj = (const bf16_t*)(a.ws + WS_BIG);
    bf16_t* mix = (bf16_t*)(a.ws + WS_R1);
    LAS bf16_t* Kl = (LAS bf16_t*)lds;
    LAS bf16_t* Vt = Kl + 192 * 72;
    const float* kn = a.in[I_KNORM];
    const int g = wave & 3, th = wave >> 2, hq = kvh * 4 + g;
    const int r = lane & 31, hh = lane >> 5;
    const int t = q0 + 32 * th + r;
    u32x4 kwv[3], vwv[3], qwv[4];
#pragma unroll
    for (int i = 0; i < 3; ++i) { const int c = tid + i * NTHREADS; const int kk = c >> 3, part = c & 7; const int tk = w0 + kk;
        kwv[i] = (u32x4){0u, 0u, 0u, 0u}; vwv[i] = (u32x4){0u, 0u, 0u, 0u};
        if (tk >= 0) { kwv[i] = *(const u32x4*)(proj + (size_t)tk * NPROJ + PKB + kvh * 64 + part * 8); vwv[i] = *(const u32x4*)(proj + (size_t)tk * NPROJ + PVB + kvh * 64 + part * 8); } }
#pragma unroll
    for (int s = 0; s < 4; ++s) qwv[s] = *(const u32x4*)(proj + (size_t)t * NPROJ + PQB + hq * 64 + 16 * s + 8 * hh);
#pragma unroll
    for (int i = 0; i < 3; ++i) {
        const int c = tid + i * NTHREADS; const int kk = c >> 3, part = c & 7;
        float kf[8]; unpack8(kwv[i], kf);
        const u32x4 vw = vwv[i];
        float ss = 0.f;
#pragma unroll
        for (int j = 0; j < 8; ++j) ss += kf[j] * kf[j];
        ss += __shfl_xor(ss, 1); ss += __shfl_xor(ss, 2); ss += __shfl_xor(ss, 4);
        const float rstd = rsqrtf(ss * (1.0f / 64.f) + EPS);
#pragma unroll
        for (int j = 0; j < 8; ++j) kf[j] = kf[j] * rstd * kn[part * 8 + j];
        u32x4 kw2; kw2.x = cvt_pk_bf16(kf[0], kf[1]); kw2.y = cvt_pk_bf16(kf[2], kf[3]); kw2.z = cvt_pk_bf16(kf[4], kf[5]); kw2.w = cvt_pk_bf16(kf[6], kf[7]);
        *(LAS u32x4*)(Kl + kk * 72 + part * 8) = kw2;
        LAS bf16_t* vt = Vt + (part * 8) * 196 + kk;
        vt[0 * 196] = (bf16_t)(vw.x & 0xffffu); vt[1 * 196] = (bf16_t)(vw.x >> 16); vt[2 * 196] = (bf16_t)(vw.y & 0xffffu); vt[3 * 196] = (bf16_t)(vw.y >> 16);
        vt[4 * 196] = (bf16_t)(vw.z & 0xffffu); vt[5 * 196] = (bf16_t)(vw.z >> 16); vt[6 * 196] = (bf16_t)(vw.w & 0xffffu); vt[7 * 196] = (bf16_t)(vw.w >> 16);
        if (qb == 255 && kk >= 64) {
            const int w = kk - 64;
            float vf[8]; unpack8(vw, vf);
            float* ko = a.out + O_SKP + ((size_t)w * 2 + kvh) * 64 + part * 8; float* vo = a.out + O_SVP + ((size_t)w * 2 + kvh) * 64 + part * 8;
            *(f32x4*)ko = (f32x4){kf[0], kf[1], kf[2], kf[3]}; *(f32x4*)(ko + 4) = (f32x4){kf[4], kf[5], kf[6], kf[7]};
            *(f32x4*)vo = (f32x4){vf[0], vf[1], vf[2], vf[3]}; *(f32x4*)(vo + 4) = (f32x4){vf[4], vf[5], vf[6], vf[7]};
        }
    }
    LBAR();
    constexpr float LOG2E = 1.4426950408889634f;
    bf16x8 qf[4];
    {
        float qv[4][8]; float ss = 0.f;
#pragma unroll
        for (int s = 0; s < 4; ++s) { unpack8(qwv[s], qv[s]);
#pragma unroll
            for (int j = 0; j < 8; ++j) ss += qv[s][j] * qv[s][j]; }
        ss += __shfl_xor(ss, 32);
        const float rstd = rsqrtf(ss * (1.0f / 64.f) + EPS) * (0.125f * LOG2E);
        const float* qn = a.in[I_QNORM];
#pragma unroll
        for (int s = 0; s < 4; ++s) {
            u32x4 w;
            w.x = cvt_pk_bf16(qv[s][0] * rstd * qn[16 * s + 8 * hh + 0], qv[s][1] * rstd * qn[16 * s + 8 * hh + 1]);
            w.y = cvt_pk_bf16(qv[s][2] * rstd * qn[16 * s + 8 * hh + 2], qv[s][3] * rstd * qn[16 * s + 8 * hh + 3]);
            w.z = cvt_pk_bf16(qv[s][4] * rstd * qn[16 * s + 8 * hh + 4], qv[s][5] * rstd * qn[16 * s + 8 * hh + 5]);
            w.w = cvt_pk_bf16(qv[s][6] * rstd * qn[16 * s + 8 * hh + 6], qv[s][7] * rstd * qn[16 * s + 8 * hh + 7]);
            qf[s] = __builtin_bit_cast(bf16x8, w);
        }
    }
    f32x16 sacc[5];
#pragma unroll
    for (int k5 = 0; k5 < 5; ++k5) {
        const int kt = th + k5;
        f32x16 acc = {};
#pragma unroll
        for (int s = 0; s < 4; ++s) { const bf16x8 af = *(const LAS bf16x8*)(Kl + (kt * 32 + r) * 72 + 16 * s + 8 * hh); acc = __builtin_amdgcn_mfma_f32_32x32x16_bf16(af, qf[s], acc, 0, 0, 0); }
        sacc[k5] = acc;
    }
    const float slope2 = exp2f(-(float)(hq + 1)) * LOG2E;
    const float sink2 = a.in[I_SINKS][hq] * LOG2E;
    float mx = sink2;
#pragma unroll
    for (int k5 = 0; k5 < 5; ++k5)
#pragma unroll
        for (int i = 0; i < 16; ++i) {
            const int row = (i & 3) + 8 * (i >> 2) + 4 * hh;
            const int dist = 128 - 32 * k5 + r - row;
            const int tk = w0 + 32 * (th + k5) + row;
            float s = sacc[k5][i] - slope2 * (float)dist;
            if (dist < 0 || dist >= 128 || tk < 0) s = -1e30f;
            sacc[k5][i] = s; mx = fmaxf(mx, s);
        }
    mx = fmaxf(mx, __shfl_xor(mx, 32));
    float l = 0.f;
#pragma unroll
    for (int k5 = 0; k5 < 5; ++k5)
#pragma unroll
        for (int i = 0; i < 16; ++i) { const float p = __builtin_amdgcn_exp2f(sacc[k5][i] - mx); sacc[k5][i] = p; l += p; }
    l += __shfl_xor(l, 32);
    l += exp2f(sink2 - mx);
    f32x16 oacc[2] = {{}, {}};
#pragma unroll
    for (int k5 = 0; k5 < 5; ++k5) {
        const int kt = th + k5;
#pragma unroll
        for (int s2 = 0; s2 < 2; ++s2) {
            u32x4 pw;
            pw.x = cvt_pk_bf16(sacc[k5][8 * s2 + 0], sacc[k5][8 * s2 + 1]); pw.y = cvt_pk_bf16(sacc[k5][8 * s2 + 2], sacc[k5][8 * s2 + 3]);
            pw.z = cvt_pk_bf16(sacc[k5][8 * s2 + 4], sacc[k5][8 * s2 + 5]); pw.w = cvt_pk_bf16(sacc[k5][8 * s2 + 6], sacc[k5][8 * s2 + 7]);
            const bf16x8 pf = __builtin_bit_cast(bf16x8, pw);
#pragma unroll
            for (int dt = 0; dt < 2; ++dt) {
                const LAS bf16_t* vp = Vt + (32 * dt + r) * 196 + kt * 32 + 16 * s2 + 4 * hh;
                const u32x2 v0 = *(const LAS u32x2*)vp, v1 = *(const LAS u32x2*)(vp + 8);
                const u32x4 vv = (u32x4){v0.x, v0.y, v1.x, v1.y};
                oacc[dt] = __builtin_amdgcn_mfma_f32_32x32x16_bf16(__builtin_bit_cast(bf16x8, vv), pf, oacc[dt], 0, 0, 0);
            }
        }
    }
    const float inv = 1.f / l;
#pragma unroll
    for (int dt = 0; dt < 2; ++dt)
#pragma unroll
        for (int q = 0; q < 4; ++q) {
            u32x2 w; w.x = cvt_pk_bf16(oacc[dt][4 * q] * inv, oacc[dt][4 * q + 1] * inv); w.y = cvt_pk_bf16(oacc[dt][4 * q + 2] * inv, oacc[dt][4 * q + 3] * inv);
            *(u32x2*)(mix + (size_t)t * D + 512 + hq * 64 + 32 * dt + 8 * q + 4 * hh) = w;
        }
    LBAR();
}
__device__ __forceinline__ void swa_decode_item(const KArgs& a, int item, int lane) {
    const int b = item >> 3, kvh = (item >> 2) & 1, g = item & 3, hq = kvh * 4 + g; const int row = SROW + b;
    const bf16_t* proj = (const bf16_t*)(a.ws + WS_BIG);
    bf16_t* mix = (bf16_t*)(a.ws + WS_R1);
    const float* ck = a.in[I_CK] + (size_t)b * 128 * 128 + kvh * 64;
    const float* cv = a.in[I_CV] + (size_t)b * 128 * 128 + kvh * 64;
    float qd = bf2f(proj[(size_t)row * NPROJ + PQB + hq * 64 + lane]);
    { const float ss = wave_sum(qd * qd); qd = qd * rsqrtf(ss * (1.0f / 64.f) + EPS) * a.in[I_QNORM][lane] * 0.125f; }
    float kd = bf2f(proj[(size_t)row * NPROJ + PKB + kvh * 64 + lane]);
    { const float ss = wave_sum(kd * kd); kd = kd * rsqrtf(ss * (1.0f / 64.f) + EPS) * a.in[I_KNORM][lane]; }
    const float vd = bf2f(proj[(size_t)row * NPROJ + PVB + kvh * 64 + lane]);
    const float slope = exp2f(-(float)(hq + 1));
    float s0 = 0.f, s1 = 0.f;
    {
        f32x4 k0[16], k1[16];
#pragma unroll
        for (int i = 0; i < 16; ++i) { k0[i] = *(const f32x4*)(ck + (size_t)lane * 128 + 4 * i); k1[i] = *(const f32x4*)(ck + (size_t)(lane + 64) * 128 + 4 * i); }
#pragma unroll
        for (int i = 0; i < 16; ++i) {
            const float q0 = __shfl(qd, 4 * i), q1 = __shfl(qd, 4 * i + 1), q2 = __shfl(qd, 4 * i + 2), q3 = __shfl(qd, 4 * i + 3);
            s0 += (q0 * k0[i][0] + q1 * k0[i][1]) + (q2 * k0[i][2] + q3 * k0[i][3]);
            s1 += (q0 * k1[i][0] + q1 * k1[i][1]) + (q2 * k1[i][2] + q3 * k1[i][3]);
        }
    }
    s0 -= slope * (float)(128 - lane); s1 -= slope * (float)(64 - lane);
    if (lane == 0) s0 = -1e30f;
    const float sn = wave_sum(qd * kd);
    const float sink = a.in[I_SINKS][hq];
    const float mx = fmaxf(fmaxf(wave_max(fmaxf(s0, s1)), sn), sink);
    const float p0 = __expf(s0 - mx), p1 = __expf(s1 - mx), pn = __expf(sn - mx);
    const float l = wave_sum(p0 + p1) + pn + __expf(sink - mx);
    float od = pn * vd;
#pragma unroll 1
    for (int w0 = 0; w0 < 64; w0 += 16) {
        float ca[16], cb[16];
#pragma unroll
        for (int j = 0; j < 16; ++j) { ca[j] = cv[(size_t)(w0 + j) * 128 + lane]; cb[j] = cv[(size_t)(w0 + j + 64) * 128 + lane]; }
#pragma unroll
        for (int j = 0; j < 16; ++j) { const float pa = __shfl(p0, w0 + j), pb = __shfl(p1, w0 + j); od += pa * ca[j] + pb * cb[j]; }
    }
    od /= l;
    const float oo = __shfl_down(od, 1);
    if ((lane & 1) == 0) *(unsigned*)(mix + (size_t)row * D + 512 + hq * 64 + lane) = cvt_pk_bf16(od, oo);
    {
        float* __restrict__ ko = a.out + O_SKS + (size_t)b * 128 * 128 + kvh * 64; float* __restrict__ vo = a.out + O_SVS + (size_t)b * 128 * 128 + kvh * 64;
        float ka[32], va[32];
#pragma unroll
        for (int j = 0; j < 32; ++j) { const int w = 32 * g + j + 1; ka[j] = (w < 128) ? ck[(size_t)w * 128 + lane] : kd; va[j] = (w < 128) ? cv[(size_t)w * 128 + lane] : vd; }
#pragma unroll
        for (int j = 0; j < 32; ++j) { ko[(size_t)(32 * g + j) * 128 + lane] = ka[j]; vo[(size_t)(32 * g + j) * 128 + lane] = va[j]; }
    }
}

template <int W>
__device__ __forceinline__ void pool_core(const bf16_t* __restrict__ h, const LAS float* rsL, const f32x4 gg, int r0, int half, int c4, bf16_t* __restrict__ d1, float* __restrict__ poolp) {
    const int rb = r0 + 8 * half;
    float xn[23][4];
#pragma unroll
    for (int i = 0; i < 23; ++i) { const int r = rb - 15 + i;
        u32x2 w = (u32x2){0u, 0u};
        if (i >= 16 - W && r >= 0) w = *(const u32x2*)(h + (size_t)r * D + c4);
        const float rs = rsL[8 * half + i];
        xn[i][0] = bf_lo(w.x) * rs * gg[0]; xn[i][1] = bf_hi(w.x) * rs * gg[1]; xn[i][2] = bf_lo(w.y) * rs * gg[2]; xn[i][3] = bf_hi(w.y) * rs * gg[3]; }
    float s[4] = {0.f, 0.f, 0.f, 0.f};
#pragma unroll
    for (int k = 1; k < W; ++k)
#pragma unroll
        for (int j = 0; j < 4; ++j) s[j] += xn[15 - k][j];
#pragma unroll
    for (int i = 0; i < 8; ++i) {
        const int r = rb + i;
        const int cnt = (r + 1 < W) ? r + 1 : W; const float ic = 1.0f / (float)cnt;
        float dd[4];
#pragma unroll
        for (int j = 0; j < 4; ++j) { s[j] += xn[15 + i][j]; dd[j] = s[j] * ic - xn[15 + i][j]; s[j] -= xn[15 + i - (W - 1)][j]; }
        u32x2 w; w.x = cvt_pk_bf16(dd[0], dd[1]); w.y = cvt_pk_bf16(dd[2], dd[3]);
        *(u32x2*)(d1 + (size_t)r * D + c4) = w;
        if (r >= SEQ - 15) *(f32x4*)(poolp + (size_t)(r - (SEQ - 15)) * D + c4) = (f32x4){xn[15 + i][0], xn[15 + i][1], xn[15 + i][2], xn[15 + i][3]};
    }
}
__device__ __forceinline__ void pool_item(const KArgs& a, LAS unsigned char* lds, int item, const float* part_in) {
    const int tid = otid();
    const bf16_t* h = (const bf16_t*)(a.ws + WS_R2 + 4096); bf16_t* d1 = (bf16_t*)(a.ws + WS_R1);
    LAS float* rsL = (LAS float*)lds;
    const int r0 = item * 16;
    __syncthreads();
    if (tid < 31) { const int r = r0 - 15 + tid; float rs = 0.f;
        if (r >= 0) { const f32x4 p0 = *(const f32x4*)(part_in + (long)r * 16), p1 = *(const f32x4*)(part_in + (long)r * 16 + 4), p2 = *(const f32x4*)(part_in + (long)r * 16 + 8), p3 = *(const f32x4*)(part_in + (long)r * 16 + 12);
            const float s = ((p0[0] + p0[1]) + (p0[2] + p0[3])) + ((p1[0] + p1[1]) + (p1[2] + p1[3])) + ((p2[0] + p2[1]) + (p2[2] + p2[3])) + ((p3[0] + p3[1]) + (p3[2] + p3[3]));
            rs = rsqrtf(s * (1.0f / D) + EPS); }
        rsL[tid] = rs; }
    __syncthreads();
    const int c4 = 4 * (tid & 255), half = tid >> 8; const int gq = __builtin_amdgcn_readfirstlane(c4 >> 8);
    const f32x4 gg = *(const f32x4*)(a.in[I_MNO] + c4);
    if (gq == 0) pool_core<2>(h, rsL, gg, r0, half, c4, d1, a.out + O_POOLP);
    else if (gq == 1) pool_core<4>(h, rsL, gg, r0, half, c4, d1, a.out + O_POOLP);
    else if (gq == 2) pool_core<8>(h, rsL, gg, r0, half, c4, d1, a.out + O_POOLP);
    else pool_core<16>(h, rsL, gg, r0, half, c4, d1, a.out + O_POOLP);
}
template <int W>
__device__ __forceinline__ void pool_tile_core(const LAS unsigned char* slab, const LAS float* rsL, const f32x4 gg, int pm, int rl0, int cq, int gq, bf16_t* __restrict__ d1, float* __restrict__ poolp) {
    float xn[23][4];
#pragma unroll
    for (int i = 0; i < 23; ++i) { const int sl = rl0 + i;
        u32x2 w = (u32x2){0u, 0u};
        if (i >= 16 - W) w = *(const LAS u32x2*)(slab + sl * 512 + cq * 8);
        const float rs = rsL[sl];
        xn[i][0] = bf_lo(w.x) * rs * gg[0]; xn[i][1] = bf_hi(w.x) * rs * gg[1]; xn[i][2] = bf_lo(w.y) * rs * gg[2]; xn[i][3] = bf_hi(w.y) * rs * gg[3]; }
    float s[4] = {0.f, 0.f, 0.f, 0.f};
#pragma unroll
    for (int k = 1; k < W; ++k)
#pragma unroll
        for (int j = 0; j < 4; ++j) s[j] += xn[15 - k][j];
    const int c4 = 256 * gq + 4 * cq;
#pragma unroll
    for (int i = 0; i < 8; ++i) {
        const int r = 256 * pm + rl0 + i;
        const int cnt = (r + 1 < W) ? r + 1 : W; const float ic = __builtin_amdgcn_rcpf((float)cnt);
        float dd[4];
#pragma unroll
        for (int j = 0; j < 4; ++j) { s[j] += xn[15 + i][j]; dd[j] = s[j] * ic - xn[15 + i][j]; s[j] -= xn[15 + i - (W - 1)][j]; }
        u32x2 w; w.x = cvt_pk_bf16(dd[0], dd[1]); w.y = cvt_pk_bf16(dd[2], dd[3]);
        *(u32x2*)(d1 + (size_t)r * D + c4) = w;
        if (r >= SEQ - 15) *(f32x4*)(poolp + (size_t)(r - (SEQ - 15)) * D + c4) = (f32x4){xn[15 + i][0], xn[15 + i][1], xn[15 + i][2], xn[15 + i][3]};
    }
}
__device__ __forceinline__ void pool_tile(const KArgs& a, LAS unsigned char* lds, int pm, int gq, const float* part_in) {
    const int tid = otid(), lane = tid & 63, wave = __builtin_amdgcn_readfirstlane(tid >> 6);
    const bf16_t* h = (const bf16_t*)(a.ws + WS_R2 + 4096); bf16_t* d1 = (bf16_t*)(a.ws + WS_R1);
    LAS float* rsL = (LAS float*)(lds + 140288);
    __syncthreads();
    for (int p = wave; p < 136; p += 8) {
        const int sl = 2 * p + (lane >> 5); int r = 256 * pm - 15 + sl; if (r < 0) r = 0; if (r > SEQ - 1) r = SEQ - 1;
        __builtin_amdgcn_global_load_lds((const unsigned*)(h + (size_t)r * D + 256 * gq + 8 * (lane & 31)), (LAS unsigned*)(lds + p * 1024), 16, 0, 0);
    }
    if (tid < 271) { const int r = 256 * pm - 15 + tid; float rs = 0.f;
        if (r >= 0) { const f32x4 p0 = *(const f32x4*)(part_in + (long)r * 16), p1 = *(const f32x4*)(part_in + (long)r * 16 + 4), p2 = *(const f32x4*)(part_in + (long)r * 16 + 8), p3 = *(const f32x4*)(part_in + (long)r * 16 + 12);
            const float s = ((p0[0] + p0[1]) + (p0[2] + p0[3])) + ((p1[0] + p1[1]) + (p1[2] + p1[3])) + ((p2[0] + p2[1]) + (p2[2] + p2[3])) + ((p3[0] + p3[1]) + (p3[2] + p3[3]));
            rs = rsqrtf(s * (1.0f / D) + EPS); }
        rsL[tid] = rs; }
    asm volatile("s_waitcnt vmcnt(0) lgkmcnt(0)" ::: "memory");
    __syncthreads();
    const int cq = lane;
    const f32x4 gg = *(const f32x4*)(a.in[I_MNO] + 256 * gq + 4 * cq);
#pragma unroll 1
    for (int st = 0; st < 4; ++st) {
        const int rl0 = 32 * wave + 8 * st;
        if (gq == 0) pool_tile_core<2>(lds, rsL, gg, pm, rl0, cq, gq, d1, a.out + O_POOLP);
        else if (gq == 1) pool_tile_core<4>(lds, rsL, gg, pm, rl0, cq, gq, d1, a.out + O_POOLP);
        else if (gq == 2) pool_tile_core<8>(lds, rsL, gg, pm, rl0, cq, gq, d1, a.out + O_POOLP);
        else pool_tile_core<16>(lds, rsL, gg, pm, rl0, cq, gq, d1, a.out + O_POOLP);
    }
}
__device__ __forceinline__ void pool_sample_item(const KArgs& a, LAS unsigned char* lds, int b, const float* part_in) {
    const int tid = otid();
    const bf16_t* __restrict__ h = (const bf16_t*)(a.ws + WS_R2 + 4096) + (size_t)(SROW + b) * D; bf16_t* __restrict__ d1 = (bf16_t*)(a.ws + WS_R1);
    const float* __restrict__ st = a.in[I_SPOOL] + (size_t)b * 15 * D; float* __restrict__ so = a.out + O_POOLS + (size_t)b * 15 * D;
    const float rs = s_row_rs(part_in, b);
#pragma unroll
    for (int cc = 0; cc < 2; ++cc) {
        const int c = tid + cc * NTHREADS; const int w = 2 << (c >> 8);
        float sv[15];
#pragma unroll
        for (int j = 0; j < 15; ++j) sv[j] = st[(size_t)j * D + c];
        const float xn = bf2f(h[c]) * rs * a.in[I_MNO][c];
        float sum = xn;
#pragma unroll
        for (int j = 0; j < 15; ++j) sum += (j >= 16 - w) ? sv[j] : 0.f;
        const float dd = sum / (float)w - xn;
        d1[(size_t)(SROW + b) * D + c] = (bf16_t)(cvt_pk_bf16(dd, 0.f) & 0xffffu);
#pragma unroll
        for (int j = 0; j < 14; ++j) so[(size_t)j * D + c] = sv[j + 1];
        so[(size_t)14 * D + c] = xn;
    }
}

#define XB_TMO      128
#define XB_XCNT(j)  (256  + 64 * (j))
#define XB_XSUB(j)  (1280 + 64 * (j))
#define XB_XGEN(j)  (2304 + 64 * (j))
#define XB_TOP      3328
#define XB_TOPGEN   3392
#define XCD_BAR_WORDS 3456
#define XB_SPIN_CAP (1u << 18)
__device__ __forceinline__ unsigned xb_ld(unsigned* p)              { return __hip_atomic_load(p, __ATOMIC_RELAXED, __HIP_MEMORY_SCOPE_AGENT); }
__device__ __forceinline__ unsigned xb_add(unsigned* p, unsigned v) { return __hip_atomic_fetch_add(p, v, __ATOMIC_RELAXED, __HIP_MEMORY_SCOPE_AGENT); }
__device__ __forceinline__ unsigned xb_xcc_id() { return (unsigned)__builtin_amdgcn_s_getreg((3 << 11) | 20) & 0xFu; }
#define XB_SPIN(cond, bar) do { unsigned _sp = 0; while (cond) { __builtin_amdgcn_s_sleep(1); \
    if ((++_sp & 255u) == 0u) { if (xb_ld(&(bar)[XB_TMO])) break; if (_sp > XB_SPIN_CAP) { atomicAdd(&(bar)[XB_TMO], 1u); break; } } } } while (0)
struct XcdBarrier { unsigned* bar; unsigned x; volatile LAS unsigned* st; };
__device__ __forceinline__ XcdBarrier xcd_barrier_post(unsigned* bar, volatile LAS unsigned* st) {
    XcdBarrier b; b.bar = bar; b.x = xb_xcc_id(); b.st = st;
    if (threadIdx.x == 0) (void)xb_add(&bar[XB_XCNT(b.x)], 1u);
    return b;
}
__device__ __forceinline__ void xcd_barrier_complete(unsigned* bar, unsigned x, unsigned& nloc, unsigned& nx) {
    const unsigned G = gridDim.x * gridDim.y * gridDim.z;
    unsigned sum, cnt, mine, sp = 0u;
    for (;;) {
        sum = 0u; cnt = 0u; mine = 0u;
#pragma unroll
        for (unsigned j = 0; j < 16; ++j) { const unsigned c = xb_ld(&bar[XB_XCNT(j)]); sum += c; cnt += (c > 0u) ? 1u : 0u; mine = (j == x) ? c : mine; }
        if (sum == G) break;
        __builtin_amdgcn_s_sleep(1);
        if ((++sp & 255u) == 0u) { if (xb_ld(&bar[XB_TMO])) break; if (sp > XB_SPIN_CAP) { atomicAdd(&bar[XB_TMO], 1u); break; } }
    }
    nloc = mine > 0u ? mine : 1u; nx = cnt > 0u ? cnt : 1u;
}
__device__ __forceinline__ void xcd_barrier(const XcdBarrier& b) {
    asm volatile("s_waitcnt vmcnt(0)" ::: "memory");
    __syncthreads();
    if (threadIdx.x == 0) {
        unsigned* bar = b.bar;
        __builtin_amdgcn_s_waitcnt(0);
        unsigned nloc = b.st[0], nx = b.st[1];
        if (nloc == 0u) { xcd_barrier_complete(bar, b.x, nloc, nx); b.st[0] = nloc; b.st[1] = nx; }
        const unsigned old = xb_add(&bar[XB_XSUB(b.x)], 1u);
        const unsigned gen = old / nloc;
        if (old + 1u == (gen + 1u) * nloc) {
            __builtin_amdgcn_fence(__ATOMIC_RELEASE, "agent");
            asm volatile("s_waitcnt vmcnt(0)" ::: "memory");
            const unsigned og = xb_add(&bar[XB_TOP], 1u);
            const unsigned tg = og / nx;
            if (og + 1u == (tg + 1u) * nx) xb_add(&bar[XB_TOPGEN], 1u);
            else XB_SPIN(xb_ld(&bar[XB_TOPGEN]) == tg, bar);
            __builtin_amdgcn_fence(__ATOMIC_ACQUIRE, "agent");
            xb_add(&bar[XB_XGEN(b.x)], 1u);
            asm volatile("s_waitcnt vmcnt(0)" ::: "memory");
        } else {
            XB_SPIN(xb_ld(&bar[XB_XGEN(b.x)]) == gen, bar);
            __builtin_amdgcn_fence(__ATOMIC_ACQUIRE, "agent");
            asm volatile("s_waitcnt vmcnt(0)" ::: "memory");
        }
    }
    __syncthreads();
}

#ifndef DUPM
#define DUPM 0
#endif
#ifndef SYNCREP
#define SYNCREP 1
#endif
#if defined(PROBE_T)
#define TSTAMP() do { if (stamp_i == PROBE_T) t_a = __builtin_amdgcn_s_memrealtime(); if (stamp_i == PROBE_T + 1) t_b = __builtin_amdgcn_s_memrealtime(); ++stamp_i; } while (0)
#else
#define TSTAMP() do { } while (0)
#endif
#if defined(PROBE_BAR)
#define GSYNC() do { const unsigned long long tb_ = __builtin_amdgcn_s_memrealtime(); xcd_barrier(xbar); sub_d += __builtin_amdgcn_s_memrealtime() - tb_; } while (0)
#else
#define GSYNC() do { _Pragma("unroll 1") for (int sr_ = 0; sr_ < SYNCREP; ++sr_) xcd_barrier(xbar); TSTAMP(); } while (0)
#endif
#define PH(k) _Pragma("unroll 1") for (int rep_ = 0; rep_ < (((DUPM) >> (k)) & 1) + 1; ++rep_)
__global__ void __launch_bounds__(NTHREADS, 2) mega_fwd(KArgs a) {
    extern __shared__ __attribute__((aligned(16))) unsigned char lds_raw[];
    LAS unsigned char* lds = (LAS unsigned char*)lds_raw;
    cg::grid_group grid = cg::this_grid();
    const int G = gridDim.x, bx = blockIdx.x;
    const int vcu = (G % 8 == 0) ? (bx % 8) * (G / 8) + bx / 8 : bx;
    unsigned char* ws = a.ws;
    if (ws == nullptr) grid.sync();
    volatile LAS unsigned* xst = (volatile LAS unsigned*)(lds + LDS_BYTES - 64);
    if (threadIdx.x < 16) xst[threadIdx.x] = 0u;
    __syncthreads();
    const XcdBarrier xbar = xcd_barrier_post((unsigned*)(ws + 16384), xst);
    bf16_t* R1 = (bf16_t*)(ws + WS_R1); bf16_t* R2 = (bf16_t*)(ws + WS_R2 + 4096);
    bf16_t* BIGB = (bf16_t*)(ws + WS_BIG);
    const bf16_t* pbf = (const bf16_t*)(ws + WS_PBF);

#if defined(PROBE_T)
    int stamp_i = 0; unsigned long long t_a = 0, t_b = 0;
    TSTAMP();
#endif
#if defined(PROBE_SUB) || defined(PROBE_P2) || defined(PROBE_P1) || defined(PROBE_E) || defined(PROBE_BAR)
    unsigned long long sub_d = 0;
#endif
#ifndef NPASS
#define NPASS 1
#endif
#pragma unroll 1
    for (int pass_ = 0; pass_ < NPASS; ++pass_) {
    if (pass_ > 0) GSYNC();
    PH(0) p0_prologue(a, lds, vcu, G);
    GSYNC();
    PH(1) {
        pg8::Gemm g{R1, (const bf16_t*)(ws + WS_WIN0), 1024, 1024, 1024, 256, 0, 0};
        pg8::StaticOrder S; S.init(64, 10, G, bx);
        EpiProj E{BIGB, (float*)(ws + WS_BIG + BIG_LA), (const float*)(ws + WS_SSQ), a.in[I_BALPHA]};
#if defined(PROBE_P1)
        unsigned long long tq0 = __builtin_amdgcn_s_memrealtime();
#endif
        pg8::gemm_phase(lds, g, S, E);
#if defined(PROBE_P1)
        sub_d = __builtin_amdgcn_s_memrealtime() - tq0;
#endif
        if (bx >= (640 % G)) s_proj_units(a, lds, bx - (640 % G), G - (640 % G));
        if (bx >= (640 % G)) { const int wv = __builtin_amdgcn_readfirstlane(otid() >> 6); __syncthreads(); p3_convert(a, lds, (bx - (640 % G)) * 8 + wv, (G - (640 % G)) * 8, 0, CONV_SPLIT, false); }
#if defined(PROBE_P1)
        if (PROBE_P1 == 1) sub_d = __builtin_amdgcn_s_memrealtime() - tq0;
#endif
    }
    GSYNC();
#if defined(PROBE_P2)
    unsigned long long tp0 = __builtin_amdgcn_s_memrealtime();
#endif
    PH(2) for (int it = vcu; it < 256; it += G) gla_item_m<false>(a, lds, it);
#if defined(PROBE_P2)
    unsigned long long tp1 = __builtin_amdgcn_s_memrealtime();
#endif
    PH(3) for (int it = vcu; it < 512; it += G) swa_unit_m(a, lds, it);
#if defined(PROBE_P2)
    unsigned long long tp2 = __builtin_amdgcn_s_memrealtime();
#endif
    PH(4) { const int tid = otid(), lane = tid & 63, wave = __builtin_amdgcn_readfirstlane(tid >> 6); for (int it = vcu + G * wave; it < 512; it += G * 8) gla_decode_item(a, it, lane); }
    PH(5) { const int tid = otid(), lane = tid & 63, wave = __builtin_amdgcn_readfirstlane(tid >> 6); for (int it = vcu + G * ((wave + 6) & 7); it < 1024; it += G * 8) swa_decode_item(a, it, lane); }
#if defined(PROBE_P2)
    { unsigned long long tp3 = __builtin_amdgcn_s_memrealtime(); sub_d = (PROBE_P2 == 0) ? tp1 - tp0 : (PROBE_P2 == 1) ? tp2 - tp1 : tp3 - tp2; }
#endif
    GSYNC();
    PH(6) { gla_scan_m(a, vcu); const int wv = __builtin_amdgcn_readfirstlane(otid() >> 6); if (wv >= 2) p3_convert(a, lds, vcu * 6 + (wv - 2), G * 6, CONV_SPLIT, CONV_ITEMS, true); }
    GSYNC();
    PH(7) for (int it = vcu; it < 256; it += G) gla_item_m<true>(a, lds, it);
    GSYNC();
    PH(8) {
        pg8::Gemm g{R1, (const bf16_t*)(ws + WS_WOUT0), 1024, 1024, 1024, 256, 0, 0};
        pg8::StaticOrder S; S.init(64, 4, G, bx);
        EpiRes<0, true, true, false> E{a.out, a.in[I_XP], nullptr, R2, part_tab(ws, 0), nullptr, nullptr, nullptr};
        pg8::gemm_phase<EpiRes<0, true, true, false>, WARM * 2048>(lds, g, S, E);
        s_res_units<0, 1024, 1024>(a, lds, bx, G, R1, (const bf16_t*)(ws + WS_WOUT0), nullptr, R2, spart_tab(ws, 0));
    }
#if defined(PROBE_FFNK)
    {
        pg8::Gemm g{R2, (const bf16_t*)(ws + WS_WFFI), 1024, 1024, 1024, 254, -2, 0};
        pg8::StaticOrder S; S.init(65, 22, G, bx);
#if PROBE_FFNK == 1
        EpiNull E{};
#elif PROBE_FFNK == 2
        EpiStoreOnly<0> E{R1};
#else
        EpiStoreOnly<1> E{R1};
#endif
        pg8::gemm_phase(lds, g, S, E);
    }
#endif
#if defined(PROBE_KLOOP)
    {
        pg8::Gemm g{R1, (const bf16_t*)(ws + WS_WOUT0), 1024, 1024, 1024, 256, 0, 0};
        pg8::StaticOrder S; S.init(64, 4, G, bx);
#if PROBE_KVAR == 1
        EpiStoreOnly<0> E{R1};
#elif PROBE_KVAR == 2
        EpiRes<1, true, false, false> E{a.out, nullptr, R2, R1, nullptr, nullptr, nullptr, nullptr};
#else
        EpiNull E{};
#endif
        for (int rep = 0; rep < PROBE_KLOOP; ++rep) pg8::gemm_phase(lds, g, S, E);
    }
#endif
    GSYNC();
#pragma unroll 1
    for (int l = 0; l < 2; ++l) {
        bf16_t* G_ = BIGB;
        bf16_t* PPb = BIGB;
        PH(9) {
            pg8::Gemm g{R2, (const bf16_t*)(ws + WS_WFFI + l * WFFI_BYTES), 1024, 1024, 1024, 254, -2, 0};
            pg8::StaticOrder S; S.init(65, 22, G, bx);
            EpiFfn E{part_tab(ws, l == 0 ? 0 : 3), a.in[I_FCW] + (size_t)l * 3 * DFF, a.in[I_FCB] + (size_t)l * DFF, a.out + O_CONVP + (size_t)l * 2 * DFF, G_};
            pg8::gemm_phase(lds, g, S, E);
            if (bx >= (1430 % G)) s_ffn_units(a, lds, bx - (1430 % G), G - (1430 % G), l, R2, spart_tab(ws, l == 0 ? 0 : 3));
        }
        GSYNC();
        PH(10) {
            pg8::Gemm g{G_, (const bf16_t*)(ws + WS_WFFO + l * WFFO_BYTES), DFF, DFF, DFF, 256, 0, 0};
            pg8::StaticOrder S; S.init(64, 4, G, bx);
            EpiRes<1, true, true, false> E{a.out, nullptr, R2, R1, part_tab(ws, l == 0 ? 1 : 4), nullptr, nullptr, nullptr};
#if defined(PROBE_SUB)
            unsigned long long ts0 = __builtin_amdgcn_s_memrealtime();
#endif
            pg8::gemm_phase(lds, g, S, E);
#if defined(PROBE_SUB)
            unsigned long long ts1 = __builtin_amdgcn_s_memrealtime();
#endif
            s_res_units<1, DFF, DFF>(a, lds, bx, G, G_, (const bf16_t*)(ws + WS_WFFO + l * WFFO_BYTES), R2, R1, spart_tab(ws, l == 0 ? 1 : 4));
#if defined(PROBE_SUB)
            unsigned long long ts2 = __builtin_amdgcn_s_memrealtime();
            xcd_barrier(xbar);
            unsigned long long ts3 = __builtin_amdgcn_s_memrealtime();
            if (l == 0) { sub_d = (PROBE_SUB == 0) ? ts1 - ts0 : (PROBE_SUB == 1) ? ts2 - ts1 : ts3 - ts2; }
#endif
        }
#if !defined(PROBE_SUB)
        GSYNC();
#endif
        PH(11) {
            pg8::Gemm g{pbf + (size_t)l * MT * PLE, (const bf16_t*)(ws + WS_WPROJ + l * WPROJ_BYTES), PLE, PLE, PLE, 256, 0, 0};
            pg8::StaticOrder S; S.init(64, 4, G, bx);
            EpiPP E{PPb};
#if defined(PROBE_E)
            unsigned long long te0 = __builtin_amdgcn_s_memrealtime();
#endif
            pg8::gemm_phase(lds, g, S, E);
#if defined(PROBE_E)
            if (l == 0 && PROBE_E == 0) sub_d = __builtin_amdgcn_s_memrealtime() - te0;
#endif
        }
        PH(12) {
            pg8::Gemm g{R1, (const bf16_t*)(ws + WS_WGATE + l * WGATE_BYTES), 1024, 1024, 1024, 256, 0, 0};
            pg8::StaticOrder S; S.init(64, 4, G, bx);
#if defined(PROBE_E)
            unsigned long long te1 = __builtin_amdgcn_s_memrealtime();
#endif
#if defined(PROBE_E)
#define PE_TACC (PROBE_E == 3 ? &sub_d : nullptr)
#else
#define PE_TACC nullptr
#endif
            if (l == 0) { EpiRes<2, true, true, false> E{a.out, nullptr, R1, R2, part_tab(ws, 2), part_tab(ws, 1), PPb, nullptr}; pg8::gemm_phase<EpiRes<2, true, true, false>, WARM * 2048>(lds, g, S, E, PE_TACC);
#if defined(PROBE_E)
                if (PROBE_E == 1) sub_d = __builtin_amdgcn_s_memrealtime() - te1;
                te1 = __builtin_amdgcn_s_memrealtime();
#endif
                s_ple_units<false>(a, lds, bx, G, pbf, (const bf16_t*)(ws + WS_WPROJ), R1, (const bf16_t*)(ws + WS_WGATE), spart_tab(ws, 1), spart_tab(ws, 2), R2);
#if defined(PROBE_E)
                if (PROBE_E == 2) sub_d = __builtin_amdgcn_s_memrealtime() - te1;
#endif
            }
            else { EpiRes<2, false, false, true> E{a.out, nullptr, R1, nullptr, nullptr, part_tab(ws, 4), PPb, nullptr}; pg8::gemm_phase<EpiRes<2, false, false, true>, WARM * 2048>(lds, g, S, E);
                s_ple_units<true>(a, lds, bx, G, pbf + (size_t)MT * PLE, (const bf16_t*)(ws + WS_WPROJ + WPROJ_BYTES), R1, (const bf16_t*)(ws + WS_WGATE + WGATE_BYTES), spart_tab(ws, 4), nullptr, nullptr); }
        }
        if (l == 0) {
            GSYNC();
            PH(13) { for (int it = vcu; it < NS; it += G) pool_sample_item(a, lds, it, spart_tab(ws, 2));
                     for (int it = vcu; it < 256; it += G) pool_tile(a, lds, it >> 2, it & 3, part_tab(ws, 2)); }
            GSYNC();
            PH(14) {
                pg8::Gemm g{R1, (const bf16_t*)(ws + WS_WPOOL), 1024, 256, 256, 256, 0, 256};
                pg8::StaticOrder S; S.init(64, 4, G, bx);
                EpiRes<3, true, true, false> E{a.out, nullptr, R2, R2, part_tab(ws, 3), nullptr, nullptr, a.in[I_POOLSC]};
                pg8::gemm_phase(lds, g, S, E);
                s_res_units<3, 256, 1024>(a, lds, bx, G, R1, (const bf16_t*)(ws + WS_WPOOL), R2, R2, spart_tab(ws, 3));
            }
            GSYNC();
        }
    }
    }
#if defined(PROBE_SUB) || defined(PROBE_P2) || defined(PROBE_P1) || defined(PROBE_E) || defined(PROBE_BAR)
    if (blockIdx.x == PROBE_BLK && threadIdx.x == 0) { const unsigned long long t_end = __builtin_amdgcn_s_memrealtime() + sub_d; while (__builtin_amdgcn_s_memrealtime() < t_end) __builtin_amdgcn_s_sleep(8); }
#endif
#if defined(PROBE_T)
    TSTAMP();
    if (blockIdx.x == 0 && threadIdx.x == 0) { const unsigned long long t_end = __builtin_amdgcn_s_memrealtime() + (t_b - t_a); while (__builtin_amdgcn_s_memrealtime() < t_end) __builtin_amdgcn_s_sleep(8); }
#endif
}

extern "C" void kernel_launch(void* const* d_in, const int* in_sizes, int n_in, void* d_out, int out_size, void* d_ws, size_t ws_size, hipStream_t stream) {
    static int grid = 0;
    if (grid == 0) {
        int dev = 0, cus = 0, per_cu = 0;
        hipGetDevice(&dev);
        hipDeviceGetAttribute(&cus, hipDeviceAttributeMultiprocessorCount, dev);
        hipFuncSetAttribute((const void*)mega_fwd, hipFuncAttributeMaxDynamicSharedMemorySize, LDS_BYTES);
        hipOccupancyMaxActiveBlocksPerMultiprocessor(&per_cu, (const void*)mega_fwd, NTHREADS, LDS_BYTES);
        if (per_cu < 1) { fprintf(stderr, "kernel_launch: occupancy query reports %d blocks per CU\n", per_cu); per_cu = 1; }
        if (per_cu > 1) per_cu = 1;
        grid = cus * per_cu;
        (void)hipGetLastError();
    }
    (void)hipMemsetAsync(d_ws, 0, 65536, stream);
    KArgs a{};
    for (int i = 0; i < 29; ++i) a.in[i] = (const float*)d_in[i];
    a.out = (float*)d_out; a.ws = (unsigned char*)d_ws;
    void* args[] = {&a};
    hipError_t e = hipLaunchCooperativeKernel((const void*)mega_fwd, dim3(grid), dim3(NTHREADS), args, LDS_BYTES, stream);
#if defined(PROBE_TWICE)
    (void)hipMemsetAsync(d_ws, 0, 65536, stream);
    e = hipLaunchCooperativeKernel((const void*)mega_fwd, dim3(grid), dim3(NTHREADS), args, LDS_BYTES, stream);
#endif
    if (e != hipSuccess) fprintf(stderr, "cooperative launch failed: %s (grid %d)\n", hipGetErrorString(e), grid);
}
```

```cpp
#define HOOKS 0
#include <hip/hip_runtime.h>
#include <hip/hip_cooperative_groups.h>
#include <cstdio>
#include <cstdint>
namespace cg = cooperative_groups;

#define LAS __attribute__((address_space(3)))
typedef unsigned short bf16_t;
typedef short bf16x8 __attribute__((ext_vector_type(8)));
typedef float f32x4 __attribute__((ext_vector_type(4)));
typedef float f32x2 __attribute__((ext_vector_type(2)));
typedef unsigned u32x4 __attribute__((ext_vector_type(4)));
typedef unsigned u32x2 __attribute__((ext_vector_type(2)));
typedef float f32x16 __attribute__((ext_vector_type(16)));

constexpr int D = 1024, SEQ = 16384, NS = 128, DFF = 2816, PLE = 256;
constexpr int SROW = 16510;
constexpr int MT = 16640;
constexpr int MR = 16768;
constexpr int NPROJ = 2304;
constexpr int PQA = 0, PKA = 256, PVA = 512, PRA = 1024, PQB = 1536, PKB = 2048, PVB = 2176;
constexpr float EPS = 1e-6f;
constexpr int NTHREADS = 512;

constexpr size_t O_YP = 0, O_YS = 16777216, O_GLAP = 16908288, O_SKP = 16941056, O_SVP = 16957440, O_POOLP = 16973824, O_CONVP = 16989184,
                 O_GLAS = 17000448, O_SKS = 21194752, O_SVS = 23291904, O_POOLS = 25389056, O_CONVS = 27355136;

constexpr size_t MiB = 1u << 20;
constexpr size_t WS_WIN0 = 1 * MiB, WS_WOUT0 = 6 * MiB, WS_WFFI = 8 * MiB, WS_WFFO = 30 * MiB, WS_WGATE = 41 * MiB, WS_WPROJ = 45 * MiB, WS_WPOOL = 46 * MiB;
constexpr size_t WS_SSQ = 47 * MiB;
constexpr size_t WS_PBF = 55 * MiB, WS_R1 = 72 * MiB, WS_R2 = 105 * MiB, WS_BIG = 138 * MiB;
constexpr size_t PART_STRIDE = (size_t)(MR + 8) * 16 * 4;
constexpr size_t WFFI_BYTES = (size_t)5632 * 1024 * 2, WFFO_BYTES = (size_t)1024 * 2816 * 2, WGATE_BYTES = (size_t)1024 * 1024 * 2, WPROJ_BYTES = (size_t)1024 * 256 * 2;
constexpr size_t BIG_LA = (size_t)MT * NPROJ * 2;
constexpr int LDS_BYTES = 155648;

#ifndef NT_STORES
#define NT_STORES 2
#endif
#ifndef WARM
#define WARM 0
#endif
typedef unsigned u32x4_fwd __attribute__((ext_vector_type(4)));
#if NT_STORES == 2
__device__ __forceinline__ void st16_sc1(void* p, u32x4_fwd v);
#define ST16(p, v) st16_sc1((void*)(p), (v))
#elif NT_STORES
#define ST16(p, v) __builtin_nontemporal_store((v), (p))
#else
#define ST16(p, v) (*(p) = (v))
#endif
#if NT_STORES == 2
__device__ __forceinline__ void st16_sc1(void* p, u32x4_fwd v) { asm volatile("global_store_dwordx4 %0, %1, off sc1\n\ts_nop 1" :: "v"(p), "v"(v) : "memory"); }
#endif
#define LBAR() do { asm volatile("s_waitcnt lgkmcnt(0)" ::: "memory"); __builtin_amdgcn_s_barrier(); asm volatile("" ::: "memory"); } while (0)
__device__ __forceinline__ unsigned cvt_pk_bf16(float lo, float hi) { unsigned r; asm volatile("v_cvt_pk_bf16_f32 %0, %1, %2" : "=v"(r) : "v"(lo), "v"(hi)); return r; }
__device__ __forceinline__ float bf_lo(unsigned w) { return __uint_as_float(w << 16); }
__device__ __forceinline__ float bf_hi(unsigned w) { return __uint_as_float(w & 0xffff0000u); }
__device__ __forceinline__ float bf2f(bf16_t v) { return __uint_as_float(((unsigned)v) << 16); }
__device__ __forceinline__ void unpack8(const u32x4 w, float* f) { f[0] = bf_lo(w.x); f[1] = bf_hi(w.x); f[2] = bf_lo(w.y); f[3] = bf_hi(w.y); f[4] = bf_lo(w.z); f[5] = bf_hi(w.z); f[6] = bf_lo(w.w); f[7] = bf_hi(w.w); }
__device__ __forceinline__ float wave_sum(float v) {
#pragma unroll
    for (int o = 1; o < 64; o <<= 1) v += __shfl_xor(v, o);
    return v;
}
__device__ __forceinline__ float wave_max(float v) {
#pragma unroll
    for (int o = 1; o < 64; o <<= 1) v = fmaxf(v, __shfl_xor(v, o));
    return v;
}
__device__ __forceinline__ int otid() { int t = threadIdx.x; asm volatile("" : "+v"(t)); return t; }
__device__ __forceinline__ bool row_valid(int row) { return row < SEQ || (row >= SROW && row < SROW + NS); }
__device__ __forceinline__ float* hrow_ptr(float* out, int row) { return row < SEQ ? out + O_YP + (size_t)row * D : out + O_YS + (size_t)(row - SROW) * D; }
__device__ __forceinline__ f32x2 gelu_pk(f32x2 v) {
    const f32x2 av = __builtin_elementwise_min(__builtin_elementwise_abs(v), (f32x2){6.0f, 6.0f});
    f32x2 p = av * (-4.733090910e-04f) + 7.084554422e-03f;
    p = p * av + (-5.182737214e-02f); p = p * av + (-4.599924556e-01f); p = p * av + (-1.150787842e+00f); p = p * av + (-1.000037624e+00f);
    f32x2 o; o.x = __builtin_fmaf(-__builtin_fabsf(v.x), __builtin_amdgcn_exp2f(p.x), __builtin_fmaxf(v.x, 0.f)); o.y = __builtin_fmaf(-__builtin_fabsf(v.y), __builtin_amdgcn_exp2f(p.y), __builtin_fmaxf(v.y, 0.f)); return o;
}

#ifndef SDUP
#define SDUP 1
#endif
#define SREP _Pragma("unroll 1") for (int sr_ = 0; sr_ < SDUP; ++sr_)
#ifndef HOOKS
#define HOOKS 1
#endif
#ifndef PAIR
#define PAIR 1
#endif
namespace pg8 {
constexpr int BM = 256, BK = 64, HALF = 128, HTB = HALF * BK * 2, STAGE_BYTES = 8 * HTB, NXCD = 8, WGM = 8;
__host__ __device__ __forceinline__ int lds_byte(int r, int c) { const int st = (r >> 4) * 2 + (c >> 5), rr = r & 15, cc = c & 31, ob = rr * 64 + cc * 2; return st * 1024 + (ob ^ (((ob >> 9) & 1) << 5)); }
__host__ __device__ __forceinline__ void stage_rc(int b, int& R, int& C) { const int st = b / 1024, sb = b % 1024, swz = sb ^ (((sb >> 9) & 1) << 5); R = (st >> 1) * 16 + swz / 64; C = (st & 1) * 32 + (swz % 64) / 2; }
__host__ __device__ __forceinline__ int perm32(int rho) { const int n = rho >> 4, i = rho & 15; return 8 * (i >> 2) + 4 * n + (i & 3); }

struct Unit { int pm, pn; };
struct NoPre { static constexpr bool active = false; __device__ __forceinline__ void operator()(LAS unsigned char*) const {} };
struct Gemm { const bf16_t* A; const bf16_t* Bt; int lda, ldb, K, mstride, arow0, acolstep; };

struct StaticOrder {
    int nM, nN, nwg, G, c;
    __device__ void init(int nM_, int nN_, int G_, int c_) { nM = nM_; nN = nN_; nwg = nM * nN; G = G_; c = c_; }
    __device__ bool next(int i, Unit& u) const {
        const long L = (long)i * G + c; if (L >= nwg) return false;
        int wgid = (int)L; { const int q = nwg / NXCD, r = nwg % NXCD, xcd = wgid % NXCD, off = wgid / NXCD; wgid = (xcd < r ? xcd * (q + 1) : r * (q + 1) + (xcd - r) * q) + off; }
        const int nig = WGM * nN, gid = wgid / nig, fm = gid * WGM, gsz = (nM - fm) < WGM ? (nM - fm) : WGM;
        u.pm = fm + ((wgid % nig) % gsz); u.pn = (wgid % nig) / gsz; return true;
    }
};

template <class Epi, int WARM_BYTES = 0, class Pre = NoPre>
__device__ __forceinline__ void gemm_phase(LAS unsigned char* lds, const Gemm g, const StaticOrder& S, const Epi& E, unsigned long long* tacc = nullptr, const Pre& P = Pre()) {
    const int tid = otid(), wid = __builtin_amdgcn_readfirstlane(tid >> 6), lane = tid & 63, wr = wid >> 2, wc = wid & 3, fr = lane & 15, fq = lane >> 4;
    const int K = g.K, nt = K / BK;
    unsigned voffA[2], voffB[2];
#pragma unroll
    for (int i = 0; i < 2; ++i) { int R, C; stage_rc(tid * 16 + i * 8192, R, C); const int Rb = (R & ~31) + perm32(R & 31);
        voffA[i] = (unsigned)(R * g.lda + C) * 2u; voffB[i] = (unsigned)(Rb * g.ldb + C) * 2u; }
    const size_t kstep = (size_t)(BK * 2);
    const size_t hstepA = (size_t)HALF * g.lda * 2, hstepB = (size_t)HALF * g.ldb * 2;
    const unsigned ldsw = (unsigned)wid * 1024u;
    const int aoff = lds_byte(wr * 64 + fr, fq * 8), boff = lds_byte(wc * 32 + fr, fq * 8);
#define PG8_SA(b, h) (((b) * 2 + (h)) * HTB)
#define PG8_SB(b, h) ((4 + (b) * 2 + (h)) * HTB)
#define PG8_STAGE(bufoff, gbase, voff) do { _Pragma("unroll") for (int _i = 0; _i < 2; ++_i) \
        __builtin_amdgcn_global_load_lds((const unsigned*)((const char*)(gbase) + (voff)[_i]), (LAS unsigned*)(lds + (bufoff) + ldsw + _i * 8192), 16, 0, 0); } while (0)
#define PG8_LDA(dst, b, h) do { _Pragma("unroll") for (int m = 0; m < 4; ++m) _Pragma("unroll") for (int k = 0; k < 2; ++k) dst[m][k] = *(const LAS bf16x8*)(lds + PG8_SA(b, h) + aoff + m * 2048 + k * 1024); } while (0)
#define PG8_LDB(dst, b, h) do { _Pragma("unroll") for (int n = 0; n < 2; ++n) _Pragma("unroll") for (int k = 0; k < 2; ++k) dst[n][k] = *(const LAS bf16x8*)(lds + PG8_SB(b, h) + boff + n * 2048 + k * 1024); } while (0)
#define PG8_MMA(ai, bj, At, Bt) do { __builtin_amdgcn_s_setprio(1); _Pragma("unroll") for (int m = 0; m < 4; ++m) _Pragma("unroll") for (int n = 0; n < 2; ++n) _Pragma("unroll") for (int k = 0; k < 2; ++k) \
        acc[ai][bj][m][n] = __builtin_amdgcn_mfma_f32_16x16x32_bf16(Bt[n][k], At[m][k], acc[ai][bj][m][n], 0, 0, 0); __builtin_amdgcn_s_setprio(0); } while (0)
#define PG8_WAIT_V(n) asm volatile("s_waitcnt vmcnt(" #n ")" ::: "memory")
#define PG8_WAIT_L(n) asm volatile("s_waitcnt lgkmcnt(" #n ")" ::: "memory")
#define PG8_BAR __builtin_amdgcn_s_barrier()
#define PG8_SCHED __builtin_amdgcn_sched_barrier(0)
#define PG8_ABASE(u) ((const char*)g.A + ((long)((long)(u).pm * g.mstride + g.arow0) * g.lda + (long)(u).pn * g.acolstep) * 2)
#define PG8_BBASE(u) ((const char*)g.Bt + (size_t)(u).pn * 256 * g.ldb * 2)
    Unit cur, nxt; int ui = 0;
    if (!S.next(0, cur)) return;
    f32x4 acc[2][2][4][2];
#pragma unroll
    for (int a = 0; a < 2; ++a)
#pragma unroll
        for (int b = 0; b < 2; ++b)
#pragma unroll
            for (int m = 0; m < 4; ++m)
#pragma unroll
                for (int n = 0; n < 2; ++n) acc[a][b][m][n] = (f32x4){0.f, 0.f, 0.f, 0.f};
    bf16x8 At[4][2], B0[2][2], B1[2][2];
    const char* cA = PG8_ABASE(cur); const char* cB = PG8_BBASE(cur);
    if (WARM_BYTES > 0) {
        LAS unsigned* wdst = (LAS unsigned*)(lds + STAGE_BYTES + 4096 + wid * 1024);
#pragma unroll 1
        for (int r = wid; r < 256; r += 8) {
            const char* rp = cA + (size_t)r * g.lda * 2 + 16 * lane;
#pragma unroll
            for (int i = 0; i < WARM_BYTES / 1024; ++i) __builtin_amdgcn_global_load_lds((const unsigned*)(rp + i * 1024), wdst, 16, 0, 0);
        }
    }
#if defined(PROBE_GP)
    unsigned long long tg0_ = tacc ? __builtin_amdgcn_s_memrealtime() : 0;
#endif
    PG8_STAGE(PG8_SB(0, 0), cB, voffB); PG8_STAGE(PG8_SB(0, 1), cB + hstepB, voffB); PG8_STAGE(PG8_SA(0, 0), cA, voffA); PG8_STAGE(PG8_SA(0, 1), cA + hstepA, voffA);
    if (wr == 1) PG8_BAR;
    PG8_WAIT_V(2); PG8_BAR;
    PG8_STAGE(PG8_SB(1, 0), cB + kstep, voffB); PG8_STAGE(PG8_SA(1, 0), cA + kstep, voffA); PG8_STAGE(PG8_SB(1, 1), cB + hstepB + kstep, voffB);
    PG8_WAIT_V(6); PG8_BAR;
#if defined(PROBE_GP)
    unsigned long long tg1_ = tacc ? __builtin_amdgcn_s_memrealtime() : 0;
    if (tacc && PROBE_GP == 1) *tacc += tg1_ - tg0_;
#endif
    for (;;) {
        const bool has_next = S.next(ui + 1, nxt);
        const char* nA = has_next ? PG8_ABASE(nxt) : cA; const char* nB = has_next ? PG8_BBASE(nxt) : cB;
#pragma unroll 1
        for (int t = 0; t < nt; t += 2) {
            const bool last = (t == nt - 2);
            const char* a1 = cA + (size_t)(t + 1) * kstep;
            const char* a2 = last ? nA : cA + (size_t)(t + 2) * kstep; const char* b2 = last ? nB : cB + (size_t)(t + 2) * kstep;
            const char* a3 = a2 + kstep; const char* b3 = b2 + kstep;
            PG8_LDB(B0, 0, 0); PG8_LDB(B1, 0, 1); PG8_SCHED; PG8_LDA(At, 0, 0); PG8_STAGE(PG8_SA(1, 1), a1 + hstepA, voffA);
            PG8_WAIT_V(8); PG8_WAIT_L(0); PG8_BAR; PG8_MMA(0, 0, At, B0); PG8_MMA(0, 1, At, B1); PG8_BAR; PG8_SCHED;
            PG8_LDA(At, 0, 1); PG8_STAGE(PG8_SB(0, 0), b2, voffB); PG8_STAGE(PG8_SB(0, 1), b2 + hstepB, voffB); PG8_STAGE(PG8_SA(0, 0), a2, voffA);
            PG8_WAIT_V(8); PG8_WAIT_L(0); PG8_BAR; PG8_MMA(1, 0, At, B0); PG8_MMA(1, 1, At, B1); PG8_BAR; PG8_SCHED;
            PG8_LDB(B0, 1, 0); PG8_LDB(B1, 1, 1); PG8_SCHED; PG8_LDA(At, 1, 0); PG8_STAGE(PG8_SA(0, 1), a2 + hstepA, voffA);
            PG8_WAIT_V(8); PG8_WAIT_L(0); PG8_BAR; PG8_MMA(0, 0, At, B0); PG8_MMA(0, 1, At, B1); PG8_BAR; PG8_SCHED;
            PG8_LDA(At, 1, 1); PG8_STAGE(PG8_SB(1, 0), b3, voffB); PG8_STAGE(PG8_SB(1, 1), b3 + hstepB, voffB); PG8_STAGE(PG8_SA(1, 0), a3, voffA);
            PG8_WAIT_V(8); PG8_WAIT_L(0); PG8_BAR; PG8_MMA(1, 0, At, B0); PG8_MMA(1, 1, At, B1); PG8_BAR; PG8_SCHED;
        }
        if (wr == 0) PG8_BAR;
#if defined(PROBE_GP)
        if (tacc && PROBE_GP == 2) *tacc += __builtin_amdgcn_s_memrealtime() - tg1_;
#endif
        if (Pre::active && !has_next) { PG8_WAIT_V(0); PG8_BAR; P(lds); }
        { unsigned long long te_ = 0; if (tacc) te_ = __builtin_amdgcn_s_memrealtime(); int lane2 = lane; asm volatile("" : "+v"(lane2)); E(acc, cur, wr, wc, lane2 & 15, lane2 >> 4, lds + STAGE_BYTES); if (tacc) { asm volatile("s_waitcnt vmcnt(0)" ::: "memory");
#if defined(PROBE_GP)
            if (PROBE_GP == 0)
#endif
            *tacc += __builtin_amdgcn_s_memrealtime() - te_; } }
        if (!has_next) break;
#pragma unroll
        for (int a = 0; a < 2; ++a)
#pragma unroll
            for (int b = 0; b < 2; ++b)
#pragma unroll
                for (int m = 0; m < 4; ++m)
#pragma unroll
                    for (int n = 0; n < 2; ++n) acc[a][b][m][n] = (f32x4){0.f, 0.f, 0.f, 0.f};
        cur = nxt; cA = nA; cB = nB; ++ui;
        if (wr == 1) PG8_BAR;
    }
    PG8_WAIT_V(0);
    PG8_BAR;
#undef PG8_SA
#undef PG8_SB
#undef PG8_STAGE
#undef PG8_LDA
#undef PG8_LDB
#undef PG8_MMA
#undef PG8_WAIT_V
#undef PG8_WAIT_L
#undef PG8_BAR
#undef PG8_SCHED
#undef PG8_ABASE
#undef PG8_BBASE
}

template <class EpiA, class EpiB, class Pre = NoPre>
__device__ __forceinline__ void gemm_pair(LAS unsigned char* lds, const Gemm gA, const Gemm gB, const StaticOrder& S, const EpiA& EA, const EpiB& EB, const Pre& P = Pre()) {
    const int tid = otid(), wid = __builtin_amdgcn_readfirstlane(tid >> 6), lane = tid & 63, wr = wid >> 2, wc = wid & 3, fr = lane & 15, fq = lane >> 4;
    Unit cur;
    if (!S.next(0, cur)) return;
    unsigned voffA[2], voffB[2], nvoffA[2], nvoffB[2];
#pragma unroll
    for (int i = 0; i < 2; ++i) { int R, C; stage_rc(tid * 16 + i * 8192, R, C); const int Rb = (R & ~31) + perm32(R & 31);
        voffA[i] = (unsigned)(R * gA.lda + C) * 2u; voffB[i] = (unsigned)(Rb * gA.ldb + C) * 2u;
        nvoffA[i] = (unsigned)(R * gB.lda + C) * 2u; nvoffB[i] = (unsigned)(Rb * gB.ldb + C) * 2u; }
    const size_t kstep = (size_t)(BK * 2);
    size_t hstepA = (size_t)HALF * gA.lda * 2, hstepB = (size_t)HALF * gA.ldb * 2;
    const size_t nhstepA = (size_t)HALF * gB.lda * 2, nhstepB = (size_t)HALF * gB.ldb * 2;
    const unsigned ldsw = (unsigned)wid * 1024u;
    const int aoff = lds_byte(wr * 64 + fr, fq * 8), boff = lds_byte(wc * 32 + fr, fq * 8);
#define PG8_SA(b, h) (((b) * 2 + (h)) * HTB)
#define PG8_SB(b, h) ((4 + (b) * 2 + (h)) * HTB)
#define PG8_STAGE(bufoff, gbase, voff) do { _Pragma("unroll") for (int _i = 0; _i < 2; ++_i) \
        __builtin_amdgcn_global_load_lds((const unsigned*)((const char*)(gbase) + (voff)[_i]), (LAS unsigned*)(lds + (bufoff) + ldsw + _i * 8192), 16, 0, 0); } while (0)
#define PG8_LDA(dst, b, h) do { _Pragma("unroll") for (int m = 0; m < 4; ++m) _Pragma("unroll") for (int k = 0; k < 2; ++k) dst[m][k] = *(const LAS bf16x8*)(lds + PG8_SA(b, h) + aoff + m * 2048 + k * 1024); } while (0)
#define PG8_LDB(dst, b, h) do { _Pragma("unroll") for (int n = 0; n < 2; ++n) _Pragma("unroll") for (int k = 0; k < 2; ++k) dst[n][k] = *(const LAS bf16x8*)(lds + PG8_SB(b, h) + boff + n * 2048 + k * 1024); } while (0)
#define PG8_MMA(ai, bj, At, Bt) do { __builtin_amdgcn_s_setprio(1); _Pragma("unroll") for (int m = 0; m < 4; ++m) _Pragma("unroll") for (int n = 0; n < 2; ++n) _Pragma("unroll") for (int k = 0; k < 2; ++k) \
        acc[ai][bj][m][n] = __builtin_amdgcn_mfma_f32_16x16x32_bf16(Bt[n][k], At[m][k], acc[ai][bj][m][n], 0, 0, 0); __builtin_amdgcn_s_setprio(0); } while (0)
#define PG8_WAIT_V(n) asm volatile("s_waitcnt vmcnt(" #n ")" ::: "memory")
#define PG8_WAIT_L(n) asm volatile("s_waitcnt lgkmcnt(" #n ")" ::: "memory")
#define PG8_BAR __builtin_amdgcn_s_barrier()
#define PG8_SCHED __builtin_amdgcn_sched_barrier(0)
#define PG8_ABASE2(g_, u) ((const char*)(g_).A + ((long)((long)(u).pm * (g_).mstride + (g_).arow0) * (g_).lda + (long)(u).pn * (g_).acolstep) * 2)
#define PG8_BBASE2(g_, u) ((const char*)(g_).Bt + (size_t)(u).pn * 256 * (g_).ldb * 2)
    f32x4 acc[2][2][4][2];
#pragma unroll
    for (int a = 0; a < 2; ++a)
#pragma unroll
        for (int b = 0; b < 2; ++b)
#pragma unroll
            for (int m = 0; m < 4; ++m)
#pragma unroll
                for (int n = 0; n < 2; ++n) acc[a][b][m][n] = (f32x4){0.f, 0.f, 0.f, 0.f};
    bf16x8 At[4][2], B0[2][2], B1[2][2];
    const char* cA = PG8_ABASE2(gA, cur); const char* cB = PG8_BBASE2(gA, cur);
    const char* sA = PG8_ABASE2(gB, cur); const char* sB = PG8_BBASE2(gB, cur);
    PG8_STAGE(PG8_SB(0, 0), cB, voffB); PG8_STAGE(PG8_SB(0, 1), cB + hstepB, voffB); PG8_STAGE(PG8_SA(0, 0), cA, voffA); PG8_STAGE(PG8_SA(0, 1), cA + hstepA, voffA);
    if (wr == 1) PG8_BAR;
    PG8_WAIT_V(2); PG8_BAR;
    PG8_STAGE(PG8_SB(1, 0), cB + kstep, voffB); PG8_STAGE(PG8_SA(1, 0), cA + kstep, voffA); PG8_STAGE(PG8_SB(1, 1), cB + hstepB + kstep, voffB);
    PG8_WAIT_V(6); PG8_BAR;
#pragma unroll 1
    for (int sub = 0; sub < 2; ++sub) {
        const bool has_next = (sub == 0);
        const int nt = (sub == 0 ? gA.K : gB.K) / BK;
        const char* nA = has_next ? sA : cA; const char* nB = has_next ? sB : cB;
#pragma unroll 1
        for (int t = 0; t < nt; t += 2) {
            const bool last = (t == nt - 2);
            const bool sw = last && has_next;
            const char* a1 = cA + (size_t)(t + 1) * kstep;
            const char* a2 = last ? nA : cA + (size_t)(t + 2) * kstep; const char* b2 = last ? nB : cB + (size_t)(t + 2) * kstep;
            const char* a3 = a2 + kstep; const char* b3 = b2 + kstep;
            const unsigned vA2[2] = {sw ? nvoffA[0] : voffA[0], sw ? nvoffA[1] : voffA[1]}, vB2[2] = {sw ? nvoffB[0] : voffB[0], sw ? nvoffB[1] : voffB[1]};
            const size_t hA2 = sw ? nhstepA : hstepA, hB2 = sw ? nhstepB : hstepB;
            PG8_LDB(B0, 0, 0); PG8_LDB(B1, 0, 1); PG8_SCHED; PG8_LDA(At, 0, 0); PG8_STAGE(PG8_SA(1, 1), a1 + hstepA, voffA);
            PG8_WAIT_V(8); PG8_WAIT_L(0); PG8_BAR; PG8_MMA(0, 0, At, B0); PG8_MMA(0, 1, At, B1); PG8_BAR; PG8_SCHED;
            PG8_LDA(At, 0, 1); PG8_STAGE(PG8_SB(0, 0), b2, vB2); PG8_STAGE(PG8_SB(0, 1), b2 + hB2, vB2); PG8_STAGE(PG8_SA(0, 0), a2, vA2);
            PG8_WAIT_V(8); PG8_WAIT_L(0); PG8_BAR; PG8_MMA(1, 0, At, B0); PG8_MMA(1, 1, At, B1); PG8_BAR; PG8_SCHED;
            PG8_LDB(B0, 1, 0); PG8_LDB(B1, 1, 1); PG8_SCHED; PG8_LDA(At, 1, 0); PG8_STAGE(PG8_SA(0, 1), a2 + hA2, vA2);
            PG8_WAIT_V(8); PG8_WAIT_L(0); PG8_BAR; PG8_MMA(0, 0, At, B0); PG8_MMA(0, 1, At, B1); PG8_BAR; PG8_SCHED;
            PG8_LDA(At, 1, 1); PG8_STAGE(PG8_SB(1, 0), b3, vB2); PG8_STAGE(PG8_SB(1, 1), b3 + hB2, vB2); PG8_STAGE(PG8_SA(1, 0), a3, vA2);
            PG8_WAIT_V(8); PG8_WAIT_L(0); PG8_BAR; PG8_MMA(1, 0, At, B0); PG8_MMA(1, 1, At, B1); PG8_BAR; PG8_SCHED;
        }
        if (wr == 0) PG8_BAR;
        if (Pre::active && !has_next) { PG8_WAIT_V(0); PG8_BAR; P(lds); }
        { int lane2 = lane; asm volatile("" : "+v"(lane2)); if (sub == 0) EA(acc, cur, wr, wc, lane2 & 15, lane2 >> 4, lds + STAGE_BYTES); else EB(acc, cur, wr, wc, lane2 & 15, lane2 >> 4, lds + STAGE_BYTES); }
        if (!has_next) break;
#pragma unroll
        for (int a = 0; a < 2; ++a)
#pragma unroll
            for (int b = 0; b < 2; ++b)
#pragma unroll
                for (int m = 0; m < 4; ++m)
#pragma unroll
                    for (int n = 0; n < 2; ++n) acc[a][b][m][n] = (f32x4){0.f, 0.f, 0.f, 0.f};
        cA = nA; cB = nB; hstepA = nhstepA; hstepB = nhstepB;
#pragma unroll
        for (int i = 0; i < 2; ++i) { voffA[i] = nvoffA[i]; voffB[i] = nvoffB[i]; }
        if (wr == 1) PG8_BAR;
    }
    PG8_WAIT_V(0);
    PG8_BAR;
#undef PG8_SA
#undef PG8_SB
#undef PG8_STAGE
#undef PG8_LDA
#undef PG8_LDB
#undef PG8_MMA
#undef PG8_WAIT_V
#undef PG8_WAIT_L
#undef PG8_BAR
#undef PG8_SCHED
#undef PG8_ABASE2
#undef PG8_BBASE2
}
}

using pg8::Unit;
typedef f32x4 AccT[2][2][4][2];

__device__ __forceinline__ float row_rs(const float* part, int row, int fq) {
    const f32x4 p = *(const f32x4*)(part + (long)row * 16 + fq * 4);
    float s = (p[0] + p[1]) + (p[2] + p[3]);
    s += __shfl_xor(s, 16); s += __shfl_xor(s, 32);
    return rsqrtf(s * (1.0f / D) + EPS);
}

struct EpiProj {
    bf16_t* proj; float* la; const float* ssq0; const float* b_alpha;
    __device__ __forceinline__ void operator()(const AccT& acc, const Unit& u, int wr, int wc, int fr, int fq, LAS unsigned char*) const {
        float rsv[2][4];
#pragma unroll
        for (int ai = 0; ai < 2; ++ai)
#pragma unroll
            for (int m = 0; m < 4; ++m) rsv[ai][m] = ssq0[u.pm * 256 + ai * 128 + wr * 64 + m * 16 + fr];
        f32x4 bb[2][2];
        if (u.pn >= 9) {
#pragma unroll
            for (int bj = 0; bj < 2; ++bj) { const int c = bj * 128 + wc * 32 + fq * 8; bb[bj][0] = *(const f32x4*)(b_alpha + c); bb[bj][1] = *(const f32x4*)(b_alpha + c + 4); }
        }
#pragma unroll
        for (int ai = 0; ai < 2; ++ai)
#pragma unroll
            for (int m = 0; m < 4; ++m) {
                const int row = u.pm * 256 + ai * 128 + wr * 64 + m * 16 + fr;
                const float rs = rsqrtf(rsv[ai][m] * (1.0f / D) + EPS);
#pragma unroll
                for (int bj = 0; bj < 2; ++bj) {
                    const int col = u.pn * 256 + bj * 128 + wc * 32 + fq * 8;
                    const f32x4 v0 = acc[ai][bj][m][0] * rs, v1 = acc[ai][bj][m][1] * rs;
                    if (u.pn < 9) {
                        u32x4 w; w.x = cvt_pk_bf16(v0[0], v0[1]); w.y = cvt_pk_bf16(v0[2], v0[3]); w.z = cvt_pk_bf16(v1[0], v1[1]); w.w = cvt_pk_bf16(v1[2], v1[3]);
                        ST16((u32x4*)(proj + (size_t)row * NPROJ + col), w);
                    } else {
                        const int c = col - NPROJ;
                        f32x4 o0, o1;
#pragma unroll
                        for (int j = 0; j < 4; ++j) {
                            const float z0 = v0[j] + bb[bj][0][j], z1 = v1[j] + bb[bj][1][j];
                            o0[j] = (fminf(z0, 0.f) - __logf(1.0f + __expf(-fabsf(z0)))) * 0.0625f;
                            o1[j] = (fminf(z1, 0.f) - __logf(1.0f + __expf(-fabsf(z1)))) * 0.0625f;
                        }
                        *(f32x4*)(la + (size_t)row * 256 + c) = o0; *(f32x4*)(la + (size_t)row * 256 + c + 4) = o1;
                    }
                }
            }
    }
};
struct EpiPP {
    bf16_t* pp;
    __device__ __forceinline__ void operator()(const AccT& acc, const Unit& u, int wr, int wc, int fr, int fq, LAS unsigned char*) const {
#pragma unroll
        for (int ai = 0; ai < 2; ++ai)
#pragma unroll
            for (int m = 0; m < 4; ++m) {
                const int row = u.pm * 256 + ai * 128 + wr * 64 + m * 16 + fr;
#pragma unroll
                for (int bj = 0; bj < 2; ++bj) {
                    const int col = u.pn * 256 + bj * 128 + wc * 32 + fq * 8;
                    const f32x4 v0 = acc[ai][bj][m][0], v1 = acc[ai][bj][m][1];
                    u32x4 w; w.x = cvt_pk_bf16(v0[0], v0[1]); w.y = cvt_pk_bf16(v0[2], v0[3]); w.z = cvt_pk_bf16(v1[0], v1[1]); w.w = cvt_pk_bf16(v1[2], v1[3]);
                    *(u32x4*)(pp + (size_t)row * D + col) = w;
                }
            }
    }
};
template <int MODE, bool WRITE_HB, bool WRITE_PART, bool WRITE_F32>
struct EpiRes {
    float* out; const float* xp; const bf16_t* hbin; bf16_t* hb; float* part; const float* part_in; const bf16_t* pp; const float* scale;
    struct Q { f32x4 xb[2][2]; u32x4 hw[2]; u32x4 pw[2]; f32x4 pin; };
    __device__ __forceinline__ void fetch(Q& q, const Unit& u, int st, int wr, int wc, int fr, int fq) const {
        const int row = u.pm * 256 + (st >> 2) * 128 + wr * 64 + (st & 3) * 16 + fr;
        if (MODE == 2) q.pin = *(const f32x4*)(part_in + (long)row * 16 + fq * 4);
#pragma unroll
        for (int bj = 0; bj < 2; ++bj) {
            const int col = u.pn * 256 + bj * 128 + wc * 32 + fq * 8;
            if (MODE == 0) { q.xb[bj][0] = *(const f32x4*)(xp + (size_t)row * D + col); q.xb[bj][1] = *(const f32x4*)(xp + (size_t)row * D + col + 4); }
            else q.hw[bj] = *(const u32x4*)(hbin + (size_t)row * D + col);
            if (MODE == 2) q.pw[bj] = *(const u32x4*)(pp + (size_t)row * D + col);
        }
    }
    __device__ __forceinline__ void operator()(const AccT& acc, const Unit& u, int wr, int wc, int fr, int fq, LAS unsigned char*) const {
        f32x4 sc[2][2];
        if (MODE == 3) {
#pragma unroll
            for (int bj = 0; bj < 2; ++bj) { const int col = u.pn * 256 + bj * 128 + wc * 32 + fq * 8; sc[bj][0] = *(const f32x4*)(scale + col); sc[bj][1] = *(const f32x4*)(scale + col + 4); }
        }
        Q qa, qb;
        fetch(qa, u, 0, wr, wc, fr, fq);
#pragma unroll
        for (int st = 0; st < 8; ++st) {
            const int ai = st >> 2, m = st & 3;
            Q& cur = (st & 1) ? qb : qa; Q& nxt = (st & 1) ? qa : qb;
            if (st < 7) fetch(nxt, u, st + 1, wr, wc, fr, fq);
            const int row = u.pm * 256 + ai * 128 + wr * 64 + m * 16 + fr;
            float rs = 1.f;
            if (MODE == 2) { float s = (cur.pin[0] + cur.pin[1]) + (cur.pin[2] + cur.pin[3]); s += __shfl_xor(s, 16); s += __shfl_xor(s, 32); rs = rsqrtf(s * (1.0f / D) + EPS); }
            float sq = 0.f;
#pragma unroll
            for (int bj = 0; bj < 2; ++bj) {
                const int col = u.pn * 256 + bj * 128 + wc * 32 + fq * 8;
                f32x4 v0 = acc[ai][bj][m][0], v1 = acc[ai][bj][m][1];
                if (MODE == 2) {
                    float pf[8]; unpack8(cur.pw[bj], pf);
#pragma unroll
                    for (int j = 0; j < 4; ++j) {
                        v0[j] = pf[j] * __builtin_amdgcn_rcpf(1.f + __expf(-v0[j] * rs));
                        v1[j] = pf[4 + j] * __builtin_amdgcn_rcpf(1.f + __expf(-v1[j] * rs));
                    }
                }
                if (MODE == 3) { v0 = v0 * sc[bj][0]; v1 = v1 * sc[bj][1]; }
                f32x4 b0, b1;
                if (MODE == 0) { b0 = cur.xb[bj][0]; b1 = cur.xb[bj][1]; }
                else { float bf[8]; unpack8(cur.hw[bj], bf); b0 = (f32x4){bf[0], bf[1], bf[2], bf[3]}; b1 = (f32x4){bf[4], bf[5], bf[6], bf[7]}; }
                const f32x4 h0 = b0 + v0, h1 = b1 + v1;
                if (WRITE_F32) { float* hp = out + O_YP + (size_t)row * D; *(f32x4*)(hp + col) = h0; *(f32x4*)(hp + col + 4) = h1; }
                if (WRITE_HB) { u32x4 w; w.x = cvt_pk_bf16(h0[0], h0[1]); w.y = cvt_pk_bf16(h0[2], h0[3]); w.z = cvt_pk_bf16(h1[0], h1[1]); w.w = cvt_pk_bf16(h1[2], h1[3]);
                    *(u32x4*)(hb + (size_t)row * D + col) = w; }
                sq += (h0[0] * h0[0] + h0[1] * h0[1]) + (h0[2] * h0[2] + h0[3] * h0[3]) + (h1[0] * h1[0] + h1[1] * h1[1]) + (h1[2] * h1[2] + h1[3] * h1[3]);
            }
            if (WRITE_PART) {
                sq += __shfl_xor(sq, 16); sq += __shfl_xor(sq, 32);
                if (fq == 0) part[(long)row * 16 + u.pn * 4 + wc] = sq;
            }
        }
    }
};
struct EpiFfn {
    const float* part_in; const float* convw; const float* convb; float* convp_out; bf16_t* G;
    __device__ __forceinline__ void operator()(AccT& acc, const Unit& u, int wr, int wc, int fr, int fq, LAS unsigned char* ldsx) const {
        const int c0 = u.pn * 128 + wc * 32 + fq * 8;
        f32x4 w0[2], w1[2], w2[2], cb[2];
#pragma unroll
        for (int n = 0; n < 2; ++n) { const int cn = c0 + 4 * n;
            w0[n] = *(const f32x4*)(convw + cn); w1[n] = *(const f32x4*)(convw + DFF + cn); w2[n] = *(const f32x4*)(convw + 2 * DFF + cn); cb[n] = *(const f32x4*)(convb + cn); }
        f32x4 pin[2][4];
#pragma unroll
        for (int ai = 0; ai < 2; ++ai)
#pragma unroll
            for (int m = 0; m < 4; ++m) pin[ai][m] = *(const f32x4*)(part_in + (long)(u.pm * 254 - 2 + ai * 128 + wr * 64 + m * 16 + fr) * 16 + fq * 4);
#pragma unroll
        for (int ai = 0; ai < 2; ++ai)
#pragma unroll
            for (int m = 0; m < 4; ++m) {
                float s_ = (pin[ai][m][0] + pin[ai][m][1]) + (pin[ai][m][2] + pin[ai][m][3]); s_ += __shfl_xor(s_, 16); s_ += __shfl_xor(s_, 32);
                const float rs = rsqrtf(s_ * (1.0f / D) + EPS);
#pragma unroll
                for (int bj = 0; bj < 2; ++bj)
#pragma unroll
                    for (int n = 0; n < 2; ++n) acc[ai][bj][m][n] = acc[ai][bj][m][n] * rs;
            }
        LAS f32x4* xch = (LAS f32x4*)ldsx;
        if (fr >= 14) {
#pragma unroll
            for (int ai = 0; ai < 2; ++ai) {
                const int slot = ((((ai * 2 + wr) * 4 + wc) * 4 + fq) * 2 + (fr - 14)) * 2;
                xch[slot] = acc[ai][0][3][0]; xch[slot + 1] = acc[ai][0][3][1];
            }
        }
        asm volatile("s_waitcnt lgkmcnt(0)" ::: "memory"); __builtin_amdgcn_s_barrier(); asm volatile("" ::: "memory");
#pragma unroll
        for (int ai = 0; ai < 2; ++ai)
#pragma unroll
            for (int m = 0; m < 4; ++m) {
                const int tr = ai * 128 + wr * 64 + m * 16 + fr;
                const int grow = u.pm * 254 - 2 + tr;
                const bool store = (tr >= 2 && grow < SEQ);
                u32x4 w;
#pragma unroll
                for (int n = 0; n < 2; ++n) {
                    const f32x4 x = acc[ai][0][m][n];
                    f32x4 p;
                    if (m == 0) {
                        const int sa = (wr == 1) ? ai : 0, sw = (wr == 1) ? 0 : 1;
                        const bool has = (wr == 1) || (ai == 1);
                        const int slot = ((((sa * 2 + sw) * 4 + wc) * 4 + fq) * 2 + (fr >= 14 ? fr - 14 : 0)) * 2 + n;
                        p = xch[slot];
                        if (!has) p = (f32x4){0.f, 0.f, 0.f, 0.f};
                    } else p = acc[ai][0][m == 0 ? 0 : m - 1][n];
                    f32x4 p1, p2;
#pragma unroll
                    for (int j = 0; j < 4; ++j) {
                        const float xf = x[j], pf = p[j]; const int xi = __float_as_int(xf), pi = __float_as_int(pf);
                        const int r1 = __builtin_amdgcn_mov_dpp(pi, 0x121, 0xf, 0xf, true), r2 = __builtin_amdgcn_mov_dpp(pi, 0x122, 0xf, 0xf, true);
                        p1[j] = __int_as_float(__builtin_amdgcn_update_dpp(r1, xi, 0x111, 0xf, 0xf, false));
                        p2[j] = __int_as_float(__builtin_amdgcn_update_dpp(r2, xi, 0x112, 0xf, 0xf, false));
                    }
                    if (grow >= SEQ - 2 && grow < SEQ) *(f32x4*)(convp_out + (size_t)(grow - (SEQ - 2)) * DFF + c0 + 4 * n) = x;
                    const f32x4 ac = cb[n] + w0[n] * p2 + w1[n] * p1 + w2[n] * x;
                    const f32x4 v = acc[ai][1][m][n];
                    const f32x2 g0 = gelu_pk((f32x2){ac[0], ac[1]}), g1 = gelu_pk((f32x2){ac[2], ac[3]});
                    const unsigned lo = cvt_pk_bf16(g0.x * v[0], g0.y * v[1]), hi = cvt_pk_bf16(g1.x * v[2], g1.y * v[3]);
                    if (n == 0) { w.x = lo; w.y = hi; } else { w.z = lo; w.w = hi; }
                }
                if (store) ST16((u32x4*)(G + (size_t)grow * DFF + c0), w);
                asm volatile("" ::: "memory");
            }
    }
};

template <int NT>
struct EpiStoreOnly {
    bf16_t* dst;
    __device__ __forceinline__ void operator()(const AccT& acc, const Unit& u, int wr, int wc, int fr, int fq, LAS unsigned char*) const {
#pragma unroll
        for (int ai = 0; ai < 2; ++ai)
#pragma unroll
            for (int m = 0; m < 4; ++m) {
                const int row = u.pm * 254 + ai * 128 + wr * 64 + m * 16 + fr;
#pragma unroll
                for (int bj = 0; bj < 2; ++bj) {
                    const int col = (u.pn & 3) * 256 + bj * 128 + wc * 32 + fq * 8;
                    const f32x4 v0 = acc[ai][bj][m][0], v1 = acc[ai][bj][m][1];
                    u32x4 w; w.x = cvt_pk_bf16(v0[0], v0[1]); w.y = cvt_pk_bf16(v0[2], v0[3]); w.z = cvt_pk_bf16(v1[0], v1[1]); w.w = cvt_pk_bf16(v1[2], v1[3]);
                    if (NT) __builtin_nontemporal_store(w, (u32x4*)(dst + (size_t)row * D + col)); else *(u32x4*)(dst + (size_t)row * D + col) = w;
                }
            }
    }
};
struct EpiNull {
    __device__ __forceinline__ void operator()(const AccT& acc, const Unit& u, int wr, int wc, int fr, int fq, LAS unsigned char*) const {
#pragma unroll
        for (int ai = 0; ai < 2; ++ai)
#pragma unroll
            for (int bj = 0; bj < 2; ++bj)
#pragma unroll
                for (int m = 0; m < 4; ++m) { asm volatile("" :: "v"(acc[ai][bj][m][0]), "v"(acc[ai][bj][m][1])); }
    }
};
struct KArgs { const float* in[29]; float* out; unsigned char* ws; };
enum { I_XP = 0, I_XS, I_PP, I_PS, I_SGLA, I_CK, I_CV, I_SPOOL, I_SCONV, I_MNE, I_WIN, I_WALPHA, I_BALPHA, I_ONORM, I_QNORM, I_KNORM, I_SINKS, I_WOUT,
       I_MNO, I_POOLW, I_POOLSC, I_FNORM, I_FWIN, I_FCW, I_FCB, I_FWOUT, I_PNORM, I_PWPROJ, I_PWGATE };

__device__ __forceinline__ float* part_tab(unsigned char* ws, int i) { return (float*)(ws + WS_SSQ + 262144 + (size_t)i * PART_STRIDE) + 2 * 16; }

constexpr int SG_STAGE = 49152, SG_NST = 3, SPART_PITCH = 36;
constexpr size_t WS_SPART = WS_SSQ + 6750208;
__device__ __forceinline__ float* spart_tab(unsigned char* ws, int i) { return (float*)(ws + WS_SPART) + (size_t)i * 128 * 32; }
template <int K, int LDA, int LDB>
__device__ __forceinline__ void sgemm_tile(const bf16_t* __restrict__ A, const bf16_t* __restrict__ B0, const bf16_t* __restrict__ B1, LAS unsigned char* lds) {
    const int tid = otid(), lane = tid & 63, wave = __builtin_amdgcn_readfirstlane(tid >> 6);
    const int fr = lane & 15, fq = lane >> 4, mb = wave >> 1, nb = wave & 1;
    constexpr int NSTG = K / 256;
    static_assert(K % 256 == 0 && NSTG >= 1, "K must be a multiple of 256");
    const int prow = lane >> 5, ppc = lane & 31;
    const char* gsrc[6]; unsigned ldst[6];
#pragma unroll
    for (int j = 0; j < 6; ++j) {
        if (j < 4) { const int i = wave + 8 * j, row = 2 * i + prow; gsrc[j] = (const char*)(A + (size_t)row * LDA) + 16 * (ppc ^ (row & 15)); ldst[j] = (unsigned)i * 1024u; }
        else { const int i = wave + 8 * (j - 4), row = 2 * i + prow; const bf16_t* bp = row < 16 ? B0 + (size_t)row * LDB : B1 + (size_t)(row - 16) * LDB; gsrc[j] = (const char*)bp + 16 * (ppc ^ (row & 15)); ldst[j] = 32768u + (unsigned)i * 1024u; }
    }
#define SG_DMA(c) do { const int st_ = ((c) % SG_NST) * SG_STAGE; _Pragma("unroll") for (int j_ = 0; j_ < 6; ++j_) \
        __builtin_amdgcn_global_load_lds((const unsigned*)(gsrc[j_] + (size_t)(c) * 512), (LAS unsigned*)(lds + st_ + ldst[j_]), 16, 0, 0); } while (0)
    f32x4 acc = (f32x4){0.f, 0.f, 0.f, 0.f};
    const int abase = (16 * mb + fr) * 512, bbase = 32768 + (16 * nb + fr) * 512;
#pragma unroll
    for (int c = 0; c < (NSTG < 2 ? NSTG : 2); ++c) SG_DMA(c);
#pragma unroll 1
    for (int c = 0; c < NSTG; ++c) {
        if (c + 2 < NSTG) SG_DMA(c + 2);
        const int ahead = (NSTG - 1 - c) < 2 ? (NSTG - 1 - c) : 2;
        if (ahead == 2) asm volatile("s_waitcnt vmcnt(12)" ::: "memory");
        else if (ahead == 1) asm volatile("s_waitcnt vmcnt(6)" ::: "memory");
        else asm volatile("s_waitcnt vmcnt(0)" ::: "memory");
        __builtin_amdgcn_s_barrier(); asm volatile("" ::: "memory");
        const LAS unsigned char* st = lds + (c % SG_NST) * SG_STAGE;
#pragma unroll
        for (int s = 0; s < 8; ++s) {
            const bf16x8 af = *(const LAS bf16x8*)(st + abase + 16 * ((4 * s + fq) ^ fr)), bf = *(const LAS bf16x8*)(st + bbase + 16 * ((4 * s + fq) ^ fr));
            acc = __builtin_amdgcn_mfma_f32_16x16x32_bf16(bf, af, acc, 0, 0, 0);
        }
        asm volatile("s_waitcnt lgkmcnt(0)" ::: "memory"); __builtin_amdgcn_s_barrier(); asm volatile("" ::: "memory");
    }
#undef SG_DMA
    *(LAS f32x4*)((LAS float*)lds + (16 * mb + fr) * SPART_PITCH + 16 * nb + 4 * fq) = acc;
}
__device__ __forceinline__ f32x4 sread4(const LAS unsigned char* lds, int b, int col0) { return *(const LAS f32x4*)((const LAS float*)lds + b * SPART_PITCH + col0); }
constexpr int SQ_STAGE = 24576, SQ_NST = 5, SQ_PD = 3, SQ_PART = SQ_NST * SQ_STAGE, SQ_KG = 16 * SPART_PITCH;
template <int K> struct SqPre { static constexpr int NSTG = K / 256, N = NSTG <= SQ_NST ? NSTG : SQ_PD; };
#define SQ_SETUP() \
    const int tid = otid(), lane = tid & 63, wave = __builtin_amdgcn_readfirstlane(tid >> 6); \
    const int prow = lane >> 5, ppc = lane & 31, row = 2 * wave + prow;               \
    const char* g0 = (const char*)(A + (size_t)row * LDA) + 16 * (ppc ^ row); \
    const char* g1 = (const char*)(B0 + (size_t)row * LDB) + 16 * (ppc ^ row); \
    const char* g2 = (const char*)(B1 + (size_t)row * LDB) + 16 * (ppc ^ row); \
    const unsigned d0 = (unsigned)wave * 1024u, d1 = 8192u + (unsigned)wave * 1024u, d2 = 16384u + (unsigned)wave * 1024u
#define SQ_DMA(c) do { const int st_ = (((c) + SLOT0) % SQ_NST) * SQ_STAGE; \
        __builtin_amdgcn_global_load_lds((const unsigned*)(g0 + (size_t)(c) * 512), (LAS unsigned*)(lds + st_ + d0), 16, 0, 0); \
        __builtin_amdgcn_global_load_lds((const unsigned*)(g1 + (size_t)(c) * 512), (LAS unsigned*)(lds + st_ + d1), 16, 0, 0); \
        __builtin_amdgcn_global_load_lds((const unsigned*)(g2 + (size_t)(c) * 512), (LAS unsigned*)(lds + st_ + d2), 16, 0, 0); } while (0)
template <int K, int LDA, int LDB, int SLOT0>
__device__ __forceinline__ void sgemm_q_issue(const bf16_t* __restrict__ A, const bf16_t* __restrict__ B0, const bf16_t* __restrict__ B1, LAS unsigned char* lds) {
    SQ_SETUP();
#pragma unroll
    for (int c = 0; c < SqPre<K>::N; ++c) SQ_DMA(c);
}
template <int K, int LDA, int LDB, int SLOT0 = 0>
__device__ __forceinline__ void sgemm_q(const bf16_t* __restrict__ A, const bf16_t* __restrict__ B0, const bf16_t* __restrict__ B1, LAS unsigned char* lds, bool pre = false) {
    SQ_SETUP();
    const int fr = lane & 15, fq = lane >> 4, nb = wave & 1, kg = wave >> 1;
    constexpr int NSTG = K / 256, PRE = SqPre<K>::N;
    static_assert(K % 256 == 0 && NSTG >= 1, "K must be a multiple of 256");
    f32x4 acc = (f32x4){0.f, 0.f, 0.f, 0.f};
    const int abase = fr * 512, bbase = 8192 + (16 * nb + fr) * 512;
    if (!pre) {
#pragma unroll
        for (int c = 0; c < PRE; ++c) SQ_DMA(c);
    }
    if (NSTG <= SQ_NST) {
        asm volatile("s_waitcnt vmcnt(0)" ::: "memory");
        __builtin_amdgcn_s_barrier(); asm volatile("" ::: "memory");
#pragma unroll
        for (int c = 0; c < (NSTG <= SQ_NST ? NSTG : 1); ++c) {
            const LAS unsigned char* st = lds + ((c + SLOT0) % SQ_NST) * SQ_STAGE;
#pragma unroll
            for (int s2 = 0; s2 < 2; ++s2) {
                const int s = 2 * kg + s2;
                const bf16x8 af = *(const LAS bf16x8*)(st + abase + 16 * ((4 * s + fq) ^ fr)), bf = *(const LAS bf16x8*)(st + bbase + 16 * ((4 * s + fq) ^ fr));
                acc = __builtin_amdgcn_mfma_f32_16x16x32_bf16(bf, af, acc, 0, 0, 0);
            }
        }
        asm volatile("s_waitcnt lgkmcnt(0)" ::: "memory");
    } else
#pragma unroll 1
    for (int c = 0; c < NSTG; ++c) {
        const int nx = c + SQ_PD;
        if (nx >= PRE && nx < NSTG) SQ_DMA(nx);
        const int nxc = nx < NSTG - 1 ? nx : NSTG - 1, lastI = nxc > PRE - 1 ? nxc : PRE - 1, ahead = lastI - c;
        if (ahead >= 4) asm volatile("s_waitcnt vmcnt(12)" ::: "memory");
        else if (ahead == 3) asm volatile("s_waitcnt vmcnt(9)" ::: "memory");
        else if (ahead == 2) asm volatile("s_waitcnt vmcnt(6)" ::: "memory");
        else if (ahead == 1) asm volatile("s_waitcnt vmcnt(3)" ::: "memory");
        else asm volatile("s_waitcnt vmcnt(0)" ::: "memory");
        __builtin_amdgcn_s_barrier(); asm volatile("" ::: "memory");
        const LAS unsigned char* st = lds + ((c + SLOT0) % SQ_NST) * SQ_STAGE;
#pragma unroll
        for (int s2 = 0; s2 < 2; ++s2) {
            const int s = 2 * kg + s2;
            const bf16x8 af = *(const LAS bf16x8*)(st + abase + 16 * ((4 * s + fq) ^ fr)), bf = *(const LAS bf16x8*)(st + bbase + 16 * ((4 * s + fq) ^ fr));
            acc = __builtin_amdgcn_mfma_f32_16x16x32_bf16(bf, af, acc, 0, 0, 0);
        }
        asm volatile("s_waitcnt lgkmcnt(0)" ::: "memory");
    }
    *(LAS f32x4*)((LAS float*)(lds + SQ_PART) + kg * SQ_KG + fr * SPART_PITCH + 16 * nb + 4 * fq) = acc;
}
#undef SQ_DMA
#undef SQ_SETUP
__device__ __forceinline__ f32x4 sq_read4(const LAS unsigned char* lds, int b, int col0) {
    const LAS float* p = (const LAS float*)(lds + SQ_PART) + b * SPART_PITCH + col0;
    return (*(const LAS f32x4*)p + *(const LAS f32x4*)(p + SQ_KG)) + (*(const LAS f32x4*)(p + 2 * SQ_KG) + *(const LAS f32x4*)(p + 3 * SQ_KG));
}
__device__ __forceinline__ float s_row_rs(const float* spart, int sb) {
    const float* p = spart + (size_t)sb * 32; float s = 0.f;
#pragma unroll
    for (int i = 0; i < 32; i += 4) { const f32x4 v = *(const f32x4*)(p + i); s += (v[0] + v[1]) + (v[2] + v[3]); }
    return rsqrtf(s * (1.0f / D) + EPS);
}
template <int MODE, bool WRITE_HB, bool WRITE_PART, bool WRITE_F32>
__device__ __forceinline__ void s_res_epi(const KArgs& a, int sb, int q, int cu, const f32x4 v, const bf16_t* hbin, bf16_t* hb, float* spart, const f32x4 ppv, float rs_in, const float* scale) {
    const int row = SROW + sb, c0 = 32 * cu + 4 * q;
    f32x4 base;
    if (MODE == 0) base = *(const f32x4*)(a.in[I_XS] + (size_t)sb * D + c0);
    else { const u32x2 w = *(const u32x2*)(hbin + (size_t)row * D + c0); base = (f32x4){bf_lo(w.x), bf_hi(w.x), bf_lo(w.y), bf_hi(w.y)}; }
    f32x4 hn; float sq = 0.f;
#pragma unroll
    for (int j = 0; j < 4; ++j) {
        float nv = v[j];
        if (MODE == 2) nv = ppv[j] * __builtin_amdgcn_rcpf(1.f + __expf(-nv * rs_in));
        if (MODE == 3) nv = nv * scale[c0 + j];
        hn[j] = base[j] + nv; sq += hn[j] * hn[j];
    }
    if (WRITE_F32) *(f32x4*)(a.out + O_YS + (size_t)sb * D + c0) = hn;
    if (WRITE_HB) { u32x2 w; w.x = cvt_pk_bf16(hn[0], hn[1]); w.y = cvt_pk_bf16(hn[2], hn[3]); *(u32x2*)(hb + (size_t)row * D + c0) = w; }
    if (WRITE_PART) {
        sq += __shfl_xor(sq, 1); sq += __shfl_xor(sq, 2); sq += __shfl_xor(sq, 4);
        if (q == 0) spart[(size_t)sb * 32 + cu] = sq;
    }
}
__device__ __forceinline__ void s_proj_units(const KArgs& a, LAS unsigned char* lds, int u0, int ustep) {
    const bf16_t* xbf = (const bf16_t*)(a.out + O_YP) + (size_t)SROW * D; const bf16_t* W = (const bf16_t*)(a.ws + WS_WIN0);
    bf16_t* proj = (bf16_t*)(a.ws + WS_BIG); float* la = (float*)(a.ws + WS_BIG + BIG_LA); const float* ssq0 = (const float*)(a.ws + WS_SSQ);
    for (int u = u0; u < 160; u += ustep) {
        const int rh = u & 1, cu = u >> 1, n0 = cu * 32;
        sgemm_tile<1024, 1024, 1024>(xbf + (size_t)(64 * rh) * D, W + (size_t)n0 * 1024, W + (size_t)(n0 + 16) * 1024, lds);
        __syncthreads();
        const int tid = otid(), b = tid >> 3, q = tid & 7, sb = 64 * rh + b, c0 = n0 + 4 * q, row = SROW + sb;
        const f32x4 v = sread4(lds, b, 4 * q);
        const float rs = rsqrtf(ssq0[row] * (1.0f / D) + EPS);
        if (n0 < NPROJ) {
            u32x2 w; w.x = cvt_pk_bf16(v[0] * rs, v[1] * rs); w.y = cvt_pk_bf16(v[2] * rs, v[3] * rs);
            *(u32x2*)(proj + (size_t)row * NPROJ + c0) = w;
        } else {
            const int c = c0 - NPROJ; f32x4 o;
#pragma unroll
            for (int i = 0; i < 4; ++i) { const float z = v[i] * rs + a.in[I_BALPHA][c + i]; o[i] = (fminf(z, 0.f) - __logf(1.0f + __expf(-fabsf(z)))) * 0.0625f; }
            *(f32x4*)(la + (size_t)row * 256 + c) = o;
        }
        __syncthreads();
    }
}
template <int MODE, int K, int LDA>
__device__ __forceinline__ void s_res_units(const KArgs& a, LAS unsigned char* lds, int u0, int ustep, const bf16_t* A, const bf16_t* W, const bf16_t* hbin, bf16_t* hb, float* spart_out) {
    for (int u = u0; u < 64; u += ustep) {
        const int rh = u & 1, cu = u >> 1, n0 = cu * 32;
        const bf16_t* Au = A + (size_t)(SROW + 64 * rh) * LDA + (MODE == 3 ? (n0 >> 8) * 256 : 0);
        sgemm_tile<K, LDA, K>(Au, W + (size_t)n0 * K, W + (size_t)(n0 + 16) * K, lds);
        __syncthreads();
        const int tid = otid(), b = tid >> 3, q = tid & 7;
        const f32x4 v = sread4(lds, b, 4 * q);
        s_res_epi<MODE, true, true, false>(a, 64 * rh + b, q, cu, v, hbin, hb, spart_out, v, 1.f, a.in[I_POOLSC]);
        __syncthreads();
    }
}
template <bool LAST>
__device__ __forceinline__ void s_ple_units(const KArgs& a, LAS unsigned char* lds, int u0, int ustep, const bf16_t* pb, const bf16_t* Wp, const bf16_t* hbA, const bf16_t* Wg, const float* spart_in, float* spart_out, bf16_t* hbout) {
    for (int u = u0; u < 64; u += ustep) {
        const int rh = u & 1, cu = u >> 1, n0 = cu * 32;
        sgemm_tile<256, 256, 256>(pb + (size_t)(SROW + 64 * rh) * PLE, Wp + (size_t)n0 * PLE, Wp + (size_t)(n0 + 16) * PLE, lds);
        __syncthreads();
        const int tid = otid(), b = tid >> 3, q = tid & 7;
        const f32x4 ppv = sread4(lds, b, 4 * q);
        __syncthreads();
        sgemm_tile<1024, 1024, 1024>(hbA + (size_t)(SROW + 64 * rh) * D, Wg + (size_t)n0 * D, Wg + (size_t)(n0 + 16) * D, lds);
        __syncthreads();
        const f32x4 v = sread4(lds, b, 4 * q);
        const float rs = s_row_rs(spart_in, 64 * rh + b);
        s_res_epi<2, !LAST, !LAST, LAST>(a, 64 * rh + b, q, cu, v, hbA, hbout, spart_out, ppv, rs, nullptr);
        __syncthreads();
    }
}
template <int MODE, int K, int LDA>
__device__ __forceinline__ void s_res_units_q(const KArgs& a, LAS unsigned char* lds, int u0, int ustep, const bf16_t* A, const bf16_t* W, const bf16_t* hbin, bf16_t* hb, float* spart_out, bool pre0 = false) {
    for (int u = u0; u < 256; u += ustep) {
        const int cu = u & 31, rb = u >> 5, n0 = cu * 32;
        const bf16_t* Au = A + (size_t)(SROW + 16 * rb) * LDA + (MODE == 3 ? (n0 >> 8) * 256 : 0);
        sgemm_q<K, LDA, K>(Au, W + (size_t)n0 * K, W + (size_t)(n0 + 16) * K, lds, pre0 && u == u0);
        __syncthreads();
        const int tid = otid(), b = tid >> 3, q = tid & 7;
        if (tid < 128) {
            const f32x4 v = sq_read4(lds, b, 4 * q);
            s_res_epi<MODE, true, true, false>(a, 16 * rb + b, q, cu, v, hbin, hb, spart_out, v, 1.f, a.in[I_POOLSC]);
        }
        __syncthreads();
    }
}
template <bool LAST>
__device__ __forceinline__ void s_ple_units_q(const KArgs& a, LAS unsigned char* lds, int u0, int ustep, const bf16_t* pb, const bf16_t* Wp, const bf16_t* hbA, const bf16_t* Wg, const float* spart_in, float* spart_out, bf16_t* hbout, bool pre0 = false) {
    for (int u = u0; u < 256; u += ustep) {
        const int cu = u & 31, rb = u >> 5, n0 = cu * 32;
        if (!(pre0 && u == u0)) {
            sgemm_q_issue<256, 256, 256, 4>(pb + (size_t)(SROW + 16 * rb) * PLE, Wp + (size_t)n0 * PLE, Wp + (size_t)(n0 + 16) * PLE, lds);
            sgemm_q_issue<1024, 1024, 1024, 0>(hbA + (size_t)(SROW + 16 * rb) * D, Wg + (size_t)n0 * D, Wg + (size_t)(n0 + 16) * D, lds);
        }
        const bool pre = true;
        sgemm_q<256, 256, 256, 4>(pb + (size_t)(SROW + 16 * rb) * PLE, Wp + (size_t)n0 * PLE, Wp + (size_t)(n0 + 16) * PLE, lds, pre);
        __syncthreads();
        const int tid = otid(), b = (tid >> 3) & 15, q = tid & 7;
        const f32x4 ppv = sq_read4(lds, b, 4 * q);
        __syncthreads();
        sgemm_q<1024, 1024, 1024, 0>(hbA + (size_t)(SROW + 16 * rb) * D, Wg + (size_t)n0 * D, Wg + (size_t)(n0 + 16) * D, lds, pre);
        __syncthreads();
        if (tid < 128) {
            const f32x4 v = sq_read4(lds, b, 4 * q);
            const float rs = s_row_rs(spart_in, 16 * rb + b);
            s_res_epi<2, !LAST, !LAST, LAST>(a, 16 * rb + b, q, cu, v, hbA, hbout, spart_out, ppv, rs, nullptr);
        }
        __syncthreads();
    }
}
template <int MODE, int K, int LDA>
struct PreRes { static constexpr bool active = (HOOKS != 0); const bf16_t* A; const bf16_t* W; int u;
    __device__ __forceinline__ void operator()(LAS unsigned char* lds) const {
        if (u >= 256) return;
        const int cu = u & 31, rb = u >> 5, n0 = cu * 32;
        sgemm_q_issue<K, LDA, K, 0>(A + (size_t)(SROW + 16 * rb) * LDA + (MODE == 3 ? (n0 >> 8) * 256 : 0), W + (size_t)n0 * K, W + (size_t)(n0 + 16) * K, lds);
    } };
struct PrePle { static constexpr bool active = (HOOKS != 0); const bf16_t* pb; const bf16_t* Wp; const bf16_t* hbA; const bf16_t* Wg; int u;
    __device__ __forceinline__ void operator()(LAS unsigned char* lds) const {
        if (u >= 256) return;
        const int cu = u & 31, rb = u >> 5, n0 = cu * 32;
        sgemm_q_issue<256, 256, 256, 4>(pb + (size_t)(SROW + 16 * rb) * PLE, Wp + (size_t)n0 * PLE, Wp + (size_t)(n0 + 16) * PLE, lds);
        sgemm_q_issue<1024, 1024, 1024, 0>(hbA + (size_t)(SROW + 16 * rb) * D, Wg + (size_t)n0 * D, Wg + (size_t)(n0 + 16) * D, lds);
    } };
__device__ __forceinline__ void s_ffn_units(const KArgs& a, LAS unsigned char* lds, int u0, int ustep, int l, const bf16_t* hbA, const float* spart_in) {
    const bf16_t* W = (const bf16_t*)(a.ws + WS_WFFI + l * WFFI_BYTES);
    bf16_t* Gb = (bf16_t*)(a.ws + WS_BIG);
    const float* convw = a.in[I_FCW] + (size_t)l * 3 * DFF; const float* convb = a.in[I_FCB] + (size_t)l * DFF;
    const float* cstate = a.in[I_SCONV] + (size_t)l * NS * 2 * DFF; float* convs = a.out + O_CONVS + (size_t)l * NS * 2 * DFF;
    for (int u = u0; u < 352; u += ustep) {
        const int rh = u & 1, cu = u >> 1, ca = cu * 16;
        const int nr = 256 * (ca >> 7) + (ca & 127);
        sgemm_tile<1024, 1024, 1024>(hbA + (size_t)(SROW + 64 * rh) * D, W + (size_t)nr * 1024, W + (size_t)(nr + 128) * 1024, lds);
        __syncthreads();
        const int tid = otid(), b = tid >> 3, q = tid & 7, sb = 64 * rh + b;
        if (q < 4) {
            const int c = ca + 4 * q;
            const f32x4 av = sread4(lds, b, 4 * q), vv = sread4(lds, b, 16 + 4 * q);
            const float rs = s_row_rs(spart_in, sb);
            const float* st = cstate + (size_t)sb * 2 * DFF + c; float* so = convs + (size_t)sb * 2 * DFF + c;
            const f32x4 p2 = *(const f32x4*)(st), p1 = *(const f32x4*)(st + DFF);
            const f32x4 w0 = *(const f32x4*)(convw + c), w1 = *(const f32x4*)(convw + DFF + c), w2 = *(const f32x4*)(convw + 2 * DFF + c), cb = *(const f32x4*)(convb + c);
            const f32x4 x = av * rs;
            *(f32x4*)(so) = p1; *(f32x4*)(so + DFF) = x;
            const f32x4 ac = cb + w0 * p2 + w1 * p1 + w2 * x;
            const f32x2 g0 = gelu_pk((f32x2){ac[0], ac[1]}), g1 = gelu_pk((f32x2){ac[2], ac[3]});
            u32x2 w; w.x = cvt_pk_bf16(g0.x * vv[0] * rs, g0.y * vv[1] * rs); w.y = cvt_pk_bf16(g1.x * vv[2] * rs, g1.y * vv[3] * rs);
            *(u32x2*)(Gb + (size_t)(SROW + sb) * DFF + c) = w;
        }
        __syncthreads();
    }
}

__device__ __forceinline__ void tr_item(const float* W, int ldsrc, int scol0, int k0, const float* gain, bf16_t* dst, int ldd, int drow0, LAS float* scr, int lane) {
    float wv[32];
#pragma unroll
    for (int i = 0; i < 32; ++i) { const int kk = 2 * i + (lane >> 5); wv[i] = __builtin_nontemporal_load(W + (size_t)(k0 + kk) * ldsrc + scol0 + (lane & 31)); }
#pragma unroll
    for (int i = 0; i < 32; ++i) { const int kk = 2 * i + (lane >> 5); const float gsc = gain ? gain[k0 + kk] : 1.f; scr[kk * 33 + (lane & 31)] = wv[i] * gsc; }
    asm volatile("s_waitcnt lgkmcnt(0)" ::: "memory");
    const int c = lane & 7;
#pragma unroll
    for (int j = 0; j < 4; ++j) { const int n = (lane >> 3) + 8 * j; const LAS float* s = scr + (8 * c) * 33 + n;
        u32x4 o; o.x = cvt_pk_bf16(s[0 * 33], s[1 * 33]); o.y = cvt_pk_bf16(s[2 * 33], s[3 * 33]); o.z = cvt_pk_bf16(s[4 * 33], s[5 * 33]); o.w = cvt_pk_bf16(s[6 * 33], s[7 * 33]);
        *(u32x4*)(dst + (size_t)(drow0 + n) * ldd + k0 + 8 * c) = o; }
    asm volatile("s_waitcnt lgkmcnt(0)" ::: "memory");
}
__device__ __forceinline__ void tr_item64(const float* W, int ldsrc, int scol0, int k0, const float* gain, bf16_t* dst, int ldd, int drow0, LAS float* scr, int lane) {
    f32x4 wv[16];
#pragma unroll
    for (int i = 0; i < 16; ++i) { const int kk = 4 * i + (lane >> 4); wv[i] = __builtin_nontemporal_load((const f32x4*)(W + (size_t)(k0 + kk) * ldsrc + scol0 + 4 * (lane & 15))); }
#pragma unroll
    for (int i = 0; i < 16; ++i) { const int kk = 4 * i + (lane >> 4); const float gsc = gain ? gain[k0 + kk] : 1.f;
        *(LAS f32x4*)(scr + kk * 68 + ((4 * (lane & 15)) ^ (((kk >> 3) & 7) << 2))) = wv[i] * gsc; }
    asm volatile("s_waitcnt lgkmcnt(0)" ::: "memory");
    const int c = lane & 7;
#pragma unroll
    for (int j = 0; j < 8; ++j) { const int n = (lane >> 3) + 8 * j; const LAS float* s = scr + (8 * c) * 68 + (n ^ (c << 2));
        u32x4 o; o.x = cvt_pk_bf16(s[0 * 68], s[1 * 68]); o.y = cvt_pk_bf16(s[2 * 68], s[3 * 68]); o.z = cvt_pk_bf16(s[4 * 68], s[5 * 68]); o.w = cvt_pk_bf16(s[6 * 68], s[7 * 68]);
        *(u32x4*)(dst + (size_t)(drow0 + n) * ldd + k0 + 8 * c) = o; }
    asm volatile("s_waitcnt lgkmcnt(0)" ::: "memory");
}
__device__ __forceinline__ void weff_item(const float* __restrict__ Win, const float* __restrict__ wal, int n0, int k0, const float* __restrict__ gain, bf16_t* dst, int drow0, LAS float* scr, int lane) {
    LAS float* wl = scr + 64 * 33;
#pragma unroll
    for (int j = 0; j < 8; ++j) { const int idx = lane + 64 * j; wl[idx] = wal[(idx >> 5) * 256 + n0 + (idx & 31)]; }
    const int k = k0 + lane;
    f32x4 w4[4];
#pragma unroll
    for (int q = 0; q < 4; ++q) w4[q] = *(const f32x4*)(Win + (size_t)k * 2320 + 1024 + 4 * q);
    const float g = gain[k];
    asm volatile("s_waitcnt lgkmcnt(0)" ::: "memory");
#pragma unroll 2
    for (int n4 = 0; n4 < 32; n4 += 4) {
        f32x4 s = (f32x4){0.f, 0.f, 0.f, 0.f};
#pragma unroll
        for (int r = 0; r < 16; ++r) s += *(const LAS f32x4*)(wl + r * 32 + n4) * w4[r >> 2][r & 3];
#pragma unroll
        for (int i = 0; i < 4; ++i) scr[lane * 33 + n4 + i] = s[i] * g;
    }
    asm volatile("s_waitcnt lgkmcnt(0)" ::: "memory");
    const int c = lane & 7;
#pragma unroll
    for (int j = 0; j < 4; ++j) { const int n = (lane >> 3) + 8 * j; const LAS float* s = scr + (8 * c) * 33 + n;
        u32x4 o; o.x = cvt_pk_bf16(s[0 * 33], s[1 * 33]); o.y = cvt_pk_bf16(s[2 * 33], s[3 * 33]); o.z = cvt_pk_bf16(s[4 * 33], s[5 * 33]); o.w = cvt_pk_bf16(s[6 * 33], s[7 * 33]);
        *(u32x4*)(dst + (size_t)(drow0 + n) * 1024 + k0 + 8 * c) = o; }
    asm volatile("s_waitcnt lgkmcnt(0)" ::: "memory");
}

__device__ __forceinline__ void p0_prologue(const KArgs& a, LAS unsigned char* lds, int vcu, int G) {
    const int tid = otid(), lane = tid & 63, wave = __builtin_amdgcn_readfirstlane(tid >> 6);
    LAS float* scr = (LAS float*)(lds + wave * 17408);
    const int gw = vcu * 8 + wave, NGW = G * 8;
    unsigned char* ws = a.ws;
    constexpr int I_A = 16 * 36, I_E = 16 * 8;
    for (int it = gw; it < I_A + I_E; it += NGW) {
        int r = it;
        if (r < I_A) { const int kb = r / 36, nb = r % 36, n0 = nb * 64; tr_item64(a.in[I_WIN], 2320, n0 < 1024 ? n0 : n0 + 16, kb * 64, a.in[I_MNE], (bf16_t*)(ws + WS_WIN0), 1024, n0, scr, lane); continue; } r -= I_A;
        { const int kb = r / 8, nb = r % 8; weff_item(a.in[I_WIN], a.in[I_WALPHA], nb * 32, kb * 64, a.in[I_MNE], (bf16_t*)(ws + WS_WIN0), NPROJ + nb * 32, scr, lane); }
    }
    bf16_t* xbf = (bf16_t*)(a.out + O_YP);
    float* ssq0 = (float*)(ws + WS_SSQ);
    for (int row0 = gw * 4; row0 < MT; row0 += NGW * 4) {
        f32x4 v[4][4];
#pragma unroll
        for (int rr = 0; rr < 4; ++rr) { const int row = row0 + rr;
            const float* src = row < SEQ ? a.in[I_XP] + (size_t)row * D : ((row >= SROW && row < SROW + NS) ? a.in[I_XS] + (size_t)(row - SROW) * D : nullptr);
#pragma unroll
            for (int j = 0; j < 4; ++j) { v[rr][j] = (f32x4){0.f, 0.f, 0.f, 0.f}; if (src) v[rr][j] = __builtin_nontemporal_load((const f32x4*)(src + j * 256 + lane * 4)); } }
#pragma unroll
        for (int rr = 0; rr < 4; ++rr) { const int row = row0 + rr; float s = 0.f;
#pragma unroll
            for (int j = 0; j < 4; ++j) { const f32x4 x = v[rr][j]; s += (x[0] * x[0] + x[1] * x[1]) + (x[2] * x[2] + x[3] * x[3]);
                u32x2 w; w.x = cvt_pk_bf16(x[0], x[1]); w.y = cvt_pk_bf16(x[2], x[3]);
                *(u32x2*)(xbf + (size_t)row * D + j * 256 + lane * 4) = w; }
            s = wave_sum(s);
            if (lane == 0) ssq0[row] = s; }
    }
    if (vcu == 0) { for (int i = tid; i < 256; i += NTHREADS) ((u32x4*)(ws + WS_R2))[i] = (u32x4){0u, 0u, 0u, 0u}; }
    if (vcu == 1 && tid < 6 * 32) { float* pt = (float*)(ws + WS_SSQ + 262144 + (size_t)(tid >> 5) * PART_STRIDE); pt[tid & 31] = 0.f; }
}
constexpr int CONV_ITEMS = 16 * 16 + 2 * 16 * 88 + 2 * 44 * 16 + 2 * 16 * 16 + 2 * 4 * 16 + 4 * 16;
constexpr int CONV_SPLIT = CONV_ITEMS;
__device__ __forceinline__ void p3_convert(const KArgs& a, LAS unsigned char* lds, int gw, int NGW, int it_lo, int it_hi, bool do_p) {
    const int tid = otid(), lane = tid & 63, wave = __builtin_amdgcn_readfirstlane(tid >> 6);
    LAS float* scr = (LAS float*)(lds + wave * 17408);
    unsigned char* ws = a.ws;
    constexpr int I_O = 16 * 16, I_FI = 16 * 88, I_FO = 44 * 16, I_G = 16 * 16, I_P = 4 * 16, I_PL = 4 * 16;
    static_assert(CONV_ITEMS == I_O + 2 * I_FI + 2 * I_FO + 2 * I_G + 2 * I_P + I_PL, "item count");
    for (int it = it_lo + gw; it < it_hi; it += NGW) {
        int r = it;
        if (r < I_O) { const int kb = r / 16, nb = r % 16; tr_item64(a.in[I_WOUT], 1024, nb * 64, kb * 64, nullptr, (bf16_t*)(ws + WS_WOUT0), 1024, nb * 64, scr, lane); continue; } r -= I_O;
        if (r < 2 * I_FI) { const int l = r / I_FI, q = r % I_FI, kb = q / 88, nb = q % 88, n0 = nb * 64;
            const int pn = n0 >> 8, rr = n0 & 255, bj = rr >> 7, ii = rr & 127;
            tr_item64(a.in[I_FWIN] + (size_t)l * 1024 * 5632, 5632, bj * DFF + pn * 128 + ii, kb * 64, a.in[I_FNORM] + l * 1024, (bf16_t*)(ws + WS_WFFI + l * WFFI_BYTES), 1024, n0, scr, lane); continue; } r -= 2 * I_FI;
        if (r < 2 * I_FO) { const int l = r / I_FO, q = r % I_FO, kb = q / 16, nb = q % 16;
            tr_item64(a.in[I_FWOUT] + (size_t)l * DFF * 1024, 1024, nb * 64, kb * 64, nullptr, (bf16_t*)(ws + WS_WFFO + l * WFFO_BYTES), DFF, nb * 64, scr, lane); continue; } r -= 2 * I_FO;
        if (r < 2 * I_G) { const int l = r / I_G, q = r % I_G, kb = q / 16, nb = q % 16;
            tr_item64(a.in[I_PWGATE] + (size_t)l * 1024 * 1024, 1024, nb * 64, kb * 64, a.in[I_PNORM] + l * 1024, (bf16_t*)(ws + WS_WGATE + l * WGATE_BYTES), 1024, nb * 64, scr, lane); continue; } r -= 2 * I_G;
        if (r < 2 * I_P) { const int l = r / I_P, q = r % I_P, kb = q / 16, nb = q % 16;
            tr_item64(a.in[I_PWPROJ] + (size_t)l * 256 * 1024, 1024, nb * 64, kb * 64, nullptr, (bf16_t*)(ws + WS_WPROJ + l * WPROJ_BYTES), 256, nb * 64, scr, lane); continue; } r -= 2 * I_P;
        { const int gq = r / 16, q = r % 16, kb = q / 4, nb = q % 4;
            tr_item64(a.in[I_POOLW] + (size_t)gq * 65536, 256, nb * 64, kb * 64, nullptr, (bf16_t*)(ws + WS_WPOOL), 256, gq * 256 + nb * 64, scr, lane); }
    }
    bf16_t* pbf = (bf16_t*)(ws + WS_PBF);
    if (do_p)
    for (int it0 = gw * 4; it0 < 2 * MT; it0 += NGW * 4) {
        f32x4 v[4];
#pragma unroll
        for (int rr = 0; rr < 4; ++rr) { const int it = it0 + rr; const int l = it / MT, row = it % MT;
            const float* src = row < SEQ ? a.in[I_PP] + ((size_t)l * SEQ + row) * PLE : ((row >= SROW && row < SROW + NS) ? a.in[I_PS] + ((size_t)l * NS + (row - SROW)) * PLE : nullptr);
            v[rr] = (f32x4){0.f, 0.f, 0.f, 0.f}; if (src) v[rr] = __builtin_nontemporal_load((const f32x4*)(src + lane * 4)); }
#pragma unroll
        for (int rr = 0; rr < 4; ++rr) { u32x2 w; w.x = cvt_pk_bf16(v[rr][0], v[rr][1]); w.y = cvt_pk_bf16(v[rr][2], v[rr][3]);
            *(u32x2*)(pbf + (size_t)(it0 + rr) * PLE + lane * 4) = w; }
    }
}

__device__ __forceinline__ int crow(int i, int hh) { return (i & 3) + 8 * (i >> 2) + 4 * hh; }
__device__ __forceinline__ void gla_agg_item(const KArgs& a, LAS unsigned char* lds, int item) {
    const int tid = otid(), lane = tid & 63, wave = __builtin_amdgcn_readfirstlane(tid >> 6);
    const int sc = item >> 2, h = item & 3, T0 = sc * 256;
    const bf16_t* proj = (const bf16_t*)(a.ws + WS_BIG); const float* la = (const float*)(a.ws + WS_BIG + BIG_LA);
    float* US = (float*)(a.ws + WS_R2 + 4096); float* DS = US + (size_t)64 * 4 * 64 * 128;
    constexpr int PT = 264;
    LAS bf16_t* KT = (LAS bf16_t*)lds;
    constexpr int VP = 160;
    LAS bf16_t* Vr = KT + 64 * PT;
    LAS float* segS = (LAS float*)(lds + 64 * PT * 2 + 256 * VP * 2);
    const int dk = tid & 63, seg = tid >> 6;
    float v[32]; unsigned short kr[32];
#pragma unroll
    for (int i = 0; i < 32; ++i) { const size_t t = (size_t)(T0 + 32 * seg + i); v[i] = la[t * 256 + h * 64 + dk]; kr[i] = proj[t * NPROJ + PKA + h * 64 + dk]; }
    const int st_t = tid >> 3, sd8 = (tid & 7) * 8;
    u32x4 vw[4][2];
#pragma unroll
    for (int p = 0; p < 4; ++p) { const size_t prow = (size_t)(T0 + 64 * p + st_t) * NPROJ + PVA + h * 128 + sd8; vw[p][0] = *(const u32x4*)(proj + prow); vw[p][1] = *(const u32x4*)(proj + prow + 64); }
#pragma unroll
    for (int i = 1; i < 32; ++i) v[i] += v[i - 1];
    segS[seg * 64 + dk] = v[31];
    LBAR();
    float off = 0.f, tot = 0.f;
#pragma unroll
    for (int s = 0; s < 8; ++s) { const float x = segS[s * 64 + dk]; off += (s < seg) ? x : 0.f; tot += x; }
    const float rem = tot - off;
#pragma unroll
    for (int q = 0; q < 4; ++q) {
        u32x4 w;
        float kk[8];
#pragma unroll
        for (int j = 0; j < 8; ++j) kk[j] = bf2f(kr[8 * q + j]) * __expf(rem - v[8 * q + j]);
        w.x = cvt_pk_bf16(kk[0], kk[1]); w.y = cvt_pk_bf16(kk[2], kk[3]); w.z = cvt_pk_bf16(kk[4], kk[5]); w.w = cvt_pk_bf16(kk[6], kk[7]);
        *(LAS u32x4*)(KT + dk * PT + 32 * seg + 8 * q) = w;
    }
    if (seg == 0) DS[(sc * 4 + h) * 64 + dk] = __expf(tot);
#pragma unroll
    for (int p = 0; p < 4; ++p)
#pragma unroll
        for (int i = 0; i < 2; ++i) *(LAS u32x4*)(Vr + (64 * p + st_t) * VP + sd8 + 64 * i) = vw[p][i];
    LBAR();
    const int r = lane & 31, hh = lane >> 5, dkt = wave & 1, dvt = wave >> 1;
    f32x16 S = {};
    const unsigned trb = (unsigned)(size_t)(Vr + (8 * hh + ((lane & 15) >> 2)) * VP + 32 * dvt + 16 * ((lane >> 4) & 1) + 4 * (lane & 3));
#pragma unroll
    for (int s4 = 0; s4 < 4; ++s4) {
        u32x2 b[4][2];
        const unsigned ad = trb + (unsigned)(64 * s4 * VP * 2);
        asm volatile("ds_read_b64_tr_b16 %0, %8\n\tds_read_b64_tr_b16 %1, %8 offset:%9\n\tds_read_b64_tr_b16 %2, %8 offset:%10\n\tds_read_b64_tr_b16 %3, %8 offset:%11\n\t"
                     "ds_read_b64_tr_b16 %4, %8 offset:%12\n\tds_read_b64_tr_b16 %5, %8 offset:%13\n\tds_read_b64_tr_b16 %6, %8 offset:%14\n\tds_read_b64_tr_b16 %7, %8 offset:%15\n\ts_waitcnt lgkmcnt(0)"
                     : "=&v"(b[0][0]), "=&v"(b[0][1]), "=&v"(b[1][0]), "=&v"(b[1][1]), "=&v"(b[2][0]), "=&v"(b[2][1]), "=&v"(b[3][0]), "=&v"(b[3][1])
                     : "v"(ad), "i"(4 * VP * 2), "i"(16 * VP * 2), "i"(20 * VP * 2), "i"(32 * VP * 2), "i"(36 * VP * 2), "i"(48 * VP * 2), "i"(52 * VP * 2) : "memory");
#pragma unroll
        for (int s1 = 0; s1 < 4; ++s1) {
            const int s = 4 * s4 + s1;
            const bf16x8 af = *(const LAS bf16x8*)(KT + (32 * dkt + r) * PT + 16 * s + 8 * hh);
            const u32x4 bw = (u32x4){b[s1][0].x, b[s1][0].y, b[s1][1].x, b[s1][1].y};
            S = __builtin_amdgcn_mfma_f32_32x32x16_bf16(af, __builtin_bit_cast(bf16x8, bw), S, 0, 0, 0);
        }
    }
    float* usp = US + ((size_t)(sc * 4 + h) * 64 + 32 * dkt) * 128 + 32 * dvt + r;
#pragma unroll
    for (int i = 0; i < 16; ++i) usp[(size_t)crow(i, hh) * 128] = S[i];
    LBAR();
}
template <bool OUT>
__device__ __forceinline__ void gla_item_m(const KArgs& a, LAS unsigned char* lds, int item) {
    const int tid = otid(), lane = tid & 63, wave = __builtin_amdgcn_readfirstlane(tid >> 6);
    const int sc = item >> 2, h = item & 3;
    const bf16_t* proj = (const bf16_t*)(a.ws + WS_BIG); const float* la = (const float*)(a.ws + WS_BIG + BIG_LA);
    bf16_t* mix = (bf16_t*)(a.ws + WS_R1);
    float* US = (float*)(a.ws + WS_R2 + 4096); float* DS = US + (size_t)64 * 4 * 64 * 128;
    LAS float* bL = (LAS float*)lds; LAS float* segS = (LAS float*)(lds + 16384);
    LAS bf16_t* Qn = (LAS bf16_t*)(lds + 18432); LAS bf16_t* Kn = (LAS bf16_t*)(lds + 27648); LAS bf16_t* KT = (LAS bf16_t*)(lds + 36864);
    LAS bf16_t* VT = (LAS bf16_t*)(lds + 46080); LAS bf16_t* ST = (LAS bf16_t*)(lds + 64512); LAS float* red = (LAS float*)(lds + 82944);
    const int r = lane & 31, hh = lane >> 5;
    const int dkt = wave & 1, dvt = wave >> 1, it = wave & 1;
    LAS bf16_t* Kr = (LAS bf16_t*)(lds + 86016);
    LAS bf16_t* Vr = (LAS bf16_t*)(lds + 98304);
    const int trq = (lane & 15) >> 2, trc = 16 * ((lane >> 4) & 1) + 4 * (lane & 3);
    const unsigned trbP = (unsigned)(size_t)(Vr + (4 * hh + trq) * 160 + 32 * dvt + trc);
    const unsigned trbV = (unsigned)(size_t)(Vr + (8 * hh + trq) * 160 + 32 * dvt + trc);
    const unsigned trbK = (unsigned)(size_t)(Kr + (8 * hh + trq) * 96 + 32 * dkt + trc);
    f32x16 S = {};
    float* usp = US + ((size_t)(sc * 4 + h) * 64 + 32 * dkt) * 128 + 32 * dvt + r;
    if (OUT) {
#pragma unroll
        for (int i = 0; i < 16; ++i) S[i] = usp[(size_t)crow(i, hh) * 128];
    }
    float bsum = 0.f;
    const int sdk = tid & 63, sseg = tid >> 6, st_t = tid >> 3, sd8 = (tid & 7) * 8;
    float nla[8]; u32x4 nkw, nqw, nvw[2]; u32x2 nrw[4];
#define GLA_FETCH(cc) do { const int T0n = sc * 256 + (cc) * 64; \
        _Pragma("unroll") for (int i = 0; i < 8; ++i) nla[i] = la[(size_t)(T0n + 8 * sseg + i) * 256 + h * 64 + sdk]; \
        const size_t prow_ = (size_t)(T0n + st_t) * NPROJ; \
        nkw = *(const u32x4*)(proj + prow_ + PKA + h * 64 + sd8); \
        if (OUT) nqw = *(const u32x4*)(proj + prow_ + PQA + h * 64 + sd8); \
        nvw[0] = *(const u32x4*)(proj + prow_ + PVA + h * 128 + sd8); nvw[1] = *(const u32x4*)(proj + prow_ + PVA + h * 128 + sd8 + 64); \
        if (OUT) { _Pragma("unroll") for (int q = 0; q < 4; ++q) nrw[q] = *(const u32x2*)(proj + (size_t)(T0n + 32 * it + r) * NPROJ + PRA + h * 128 + 32 * dvt + 8 * q + 4 * hh); } } while (0)
    f32x4 onv[4];
    if (OUT) {
#pragma unroll
        for (int q = 0; q < 4; ++q) onv[q] = *(const f32x4*)(a.in[I_ONORM] + 32 * dvt + 8 * q + 4 * hh);
    }
    GLA_FETCH(0);
#pragma unroll 1
    for (int c = 0; c < 4; ++c) {
        const int T0 = sc * 256 + c * 64;
        float v[8]; u32x4 kw_c = nkw, qw_c = nqw, vw_c0 = nvw[0], vw_c1 = nvw[1]; u32x2 rw_c[4];
#pragma unroll
        for (int i = 0; i < 8; ++i) v[i] = nla[i];
#pragma unroll
        for (int q = 0; q < 4; ++q) rw_c[q] = nrw[q];
        if (c < 3) GLA_FETCH(c + 1);
        if (OUT) {
#pragma unroll
            for (int q = 0; q < 4; ++q) { u32x2 w; w.x = cvt_pk_bf16(S[4 * q], S[4 * q + 1]); w.y = cvt_pk_bf16(S[4 * q + 2], S[4 * q + 3]);
                *(LAS u32x2*)(ST + (32 * dvt + r) * 72 + 32 * dkt + 8 * q + 4 * hh) = w; }
        }
        {
            const int dk = sdk, seg = sseg;
#pragma unroll
            for (int i = 1; i < 8; ++i) v[i] += v[i - 1];
            segS[seg * 64 + dk] = v[7];
            LBAR();
            float off = 0.f;
#pragma unroll
            for (int s = 0; s < 8; ++s) { const float x = segS[s * 64 + dk]; off += (s < seg) ? x : 0.f; }
#pragma unroll
            for (int i = 0; i < 8; ++i) bL[(8 * seg + i) * 64 + dk] = v[i] + off;
            LBAR();
        }
        {
            const int t = st_t, d8 = sd8;
            const f32x4 b0 = *(const LAS f32x4*)(bL + t * 64 + d8), b1 = *(const LAS f32x4*)(bL + t * 64 + d8 + 4);
            const f32x4 l0 = *(const LAS f32x4*)(bL + 63 * 64 + d8), l1 = *(const LAS f32x4*)(bL + 63 * 64 + d8 + 4);
            float bb[8] = {b0[0], b0[1], b0[2], b0[3], b1[0], b1[1], b1[2], b1[3]}, bl[8] = {l0[0], l0[1], l0[2], l0[3], l1[0], l1[1], l1[2], l1[3]};
            float kf[8]; unpack8(kw_c, kf);
#pragma unroll
            for (int j = 0; j < 8; ++j) bl[j] = kf[j] * __expf(bl[j] - bb[j]);
            { u32x4 w; w.x = cvt_pk_bf16(bl[0], bl[1]); w.y = cvt_pk_bf16(bl[2], bl[3]); w.z = cvt_pk_bf16(bl[4], bl[5]); w.w = cvt_pk_bf16(bl[6], bl[7]); *(LAS u32x4*)(Kr + t * 96 + d8) = w; }
            if (OUT) {
                float qf[8]; unpack8(qw_c, qf);
                float qq[8], kk[8];
#pragma unroll
                for (int j = 0; j < 8; ++j) { const float e = __expf(bb[j]); qq[j] = qf[j] * 0.125f * e; kk[j] = kf[j] * __expf(-bb[j]); }
                u32x4 w; w.x = cvt_pk_bf16(qq[0], qq[1]); w.y = cvt_pk_bf16(qq[2], qq[3]); w.z = cvt_pk_bf16(qq[4], qq[5]); w.w = cvt_pk_bf16(qq[6], qq[7]);
                *(LAS u32x4*)(Qn + t * 72 + d8) = w;
                w.x = cvt_pk_bf16(kk[0], kk[1]); w.y = cvt_pk_bf16(kk[2], kk[3]); w.z = cvt_pk_bf16(kk[4], kk[5]); w.w = cvt_pk_bf16(kk[6], kk[7]);
                *(LAS u32x4*)(Kn + t * 72 + d8) = w;
            }
#pragma unroll
            for (int i = 0; i < 2; ++i) *(LAS u32x4*)(Vr + t * 160 + d8 + 64 * i) = (i == 0) ? vw_c0 : vw_c1;
            if (tid < 64) bsum += bL[63 * 64 + tid];
        }
        LBAR();
        if (OUT) {
            bf16x8 qf[4];
#pragma unroll
            for (int s = 0; s < 4; ++s) qf[s] = *(const LAS bf16x8*)(Qn + (32 * it + r) * 72 + 16 * s + 8 * hh);
            f32x16 oacc = {};
#pragma unroll
            for (int jt = 0; jt < 2; ++jt) {
                if (jt <= it) {
                    u32x2 vb[2][2];
                    asm volatile("ds_read_b64_tr_b16 %0, %4\n\tds_read_b64_tr_b16 %1, %4 offset:2560\n\tds_read_b64_tr_b16 %2, %4 offset:5120\n\tds_read_b64_tr_b16 %3, %4 offset:7680\n\ts_waitcnt lgkmcnt(0)"
                                 : "=&v"(vb[0][0]), "=&v"(vb[0][1]), "=&v"(vb[1][0]), "=&v"(vb[1][1]) : "v"(trbP + (unsigned)(32 * jt * 320)) : "memory");
                    f32x16 at = {};
#pragma unroll
                    for (int s = 0; s < 4; ++s) { const bf16x8 af = *(const LAS bf16x8*)(Kn + (32 * jt + r) * 72 + 16 * s + 8 * hh); at = __builtin_amdgcn_mfma_f32_32x32x16_bf16(af, qf[s], at, 0, 0, 0); }
                    if (jt == it) {
#pragma unroll
                        for (int i = 0; i < 16; ++i) if (crow(i, hh) > r) at[i] = 0.f;
                    }
#pragma unroll
                    for (int s2 = 0; s2 < 2; ++s2) {
                        u32x4 pw; pw.x = cvt_pk_bf16(at[8 * s2 + 0], at[8 * s2 + 1]); pw.y = cvt_pk_bf16(at[8 * s2 + 2], at[8 * s2 + 3]);
                        pw.z = cvt_pk_bf16(at[8 * s2 + 4], at[8 * s2 + 5]); pw.w = cvt_pk_bf16(at[8 * s2 + 6], at[8 * s2 + 7]);
                        const u32x4 vv = (u32x4){vb[s2][0].x, vb[s2][0].y, vb[s2][1].x, vb[s2][1].y};
                        oacc = __builtin_amdgcn_mfma_f32_32x32x16_bf16(__builtin_bit_cast(bf16x8, vv), __builtin_bit_cast(bf16x8, pw), oacc, 0, 0, 0);
                    }
                }
            }
#pragma unroll
            for (int s = 0; s < 4; ++s) { const bf16x8 af = *(const LAS bf16x8*)(ST + (32 * dvt + r) * 72 + 16 * s + 8 * hh); oacc = __builtin_amdgcn_mfma_f32_32x32x16_bf16(af, qf[s], oacc, 0, 0, 0); }
            float ss = 0.f;
#pragma unroll
            for (int i = 0; i < 16; ++i) ss += oacc[i] * oacc[i];
            ss += __shfl_xor(ss, 32);
            if (hh == 0) red[wave * 32 + r] = ss;
            LBAR();
            const float tot = (red[it * 32 + r] + red[(it + 2) * 32 + r]) + (red[(it + 4) * 32 + r] + red[(it + 6) * 32 + r]);
            const float rstd = rsqrtf(tot * (1.0f / 128.f) + EPS);
            const int t = T0 + 32 * it + r;
#pragma unroll
            for (int q = 0; q < 4; ++q) {
                const int dv0 = 32 * dvt + 8 * q + 4 * hh;
                const u32x2 rw = rw_c[q];
                const f32x4 on = onv[q];
                const float r0 = bf_lo(rw.x), r1 = bf_hi(rw.x), r2 = bf_lo(rw.y), r3 = bf_hi(rw.y);
                const float y0 = oacc[4 * q] * rstd * on[0] * (r0 * __builtin_amdgcn_rcpf(1.f + __expf(-r0))), y1 = oacc[4 * q + 1] * rstd * on[1] * (r1 * __builtin_amdgcn_rcpf(1.f + __expf(-r1)));
                const float y2 = oacc[4 * q + 2] * rstd * on[2] * (r2 * __builtin_amdgcn_rcpf(1.f + __expf(-r2))), y3 = oacc[4 * q + 3] * rstd * on[3] * (r3 * __builtin_amdgcn_rcpf(1.f + __expf(-r3)));
                u32x2 w; w.x = cvt_pk_bf16(y0, y1); w.y = cvt_pk_bf16(y2, y3);
                *(u32x2*)(mix + (size_t)t * D + h * 128 + dv0) = w;
            }
        }
#pragma unroll
        for (int i = 0; i < 16; ++i) S[i] *= __expf(bL[63 * 64 + 32 * dkt + crow(i, hh)]);
#pragma unroll
        for (int s = 0; s < 0; ++s) { }
        {
            u32x2 ka[4][2], va[4][2];
            asm volatile("ds_read_b64_tr_b16 %0, %16\n\tds_read_b64_tr_b16 %1, %16 offset:768\n\tds_read_b64_tr_b16 %2, %16 offset:3072\n\tds_read_b64_tr_b16 %3, %16 offset:3840\n\t"
                         "ds_read_b64_tr_b16 %4, %16 offset:6144\n\tds_read_b64_tr_b16 %5, %16 offset:6912\n\tds_read_b64_tr_b16 %6, %16 offset:9216\n\tds_read_b64_tr_b16 %7, %16 offset:9984\n\t"
                         "ds_read_b64_tr_b16 %8, %17\n\tds_read_b64_tr_b16 %9, %17 offset:1280\n\tds_read_b64_tr_b16 %10, %17 offset:5120\n\tds_read_b64_tr_b16 %11, %17 offset:6400\n\t"
                         "ds_read_b64_tr_b16 %12, %17 offset:10240\n\tds_read_b64_tr_b16 %13, %17 offset:11520\n\tds_read_b64_tr_b16 %14, %17 offset:15360\n\tds_read_b64_tr_b16 %15, %17 offset:16640\n\ts_waitcnt lgkmcnt(0)"
                         : "=&v"(ka[0][0]), "=&v"(ka[0][1]), "=&v"(ka[1][0]), "=&v"(ka[1][1]), "=&v"(ka[2][0]), "=&v"(ka[2][1]), "=&v"(ka[3][0]), "=&v"(ka[3][1]),
                           "=&v"(va[0][0]), "=&v"(va[0][1]), "=&v"(va[1][0]), "=&v"(va[1][1]), "=&v"(va[2][0]), "=&v"(va[2][1]), "=&v"(va[3][0]), "=&v"(va[3][1])
                         : "v"(trbK), "v"(trbV) : "memory");
#pragma unroll
            for (int s = 0; s < 4; ++s) {
                const u32x4 aw = (u32x4){ka[s][0].x, ka[s][0].y, ka[s][1].x, ka[s][1].y}, bw = (u32x4){va[s][0].x, va[s][0].y, va[s][1].x, va[s][1].y};
                S = __builtin_amdgcn_mfma_f32_32x32x16_bf16(__builtin_bit_cast(bf16x8, aw), __builtin_bit_cast(bf16x8, bw), S, 0, 0, 0);
            }
        }
        LBAR();
    }
#undef GLA_FETCH
    if (!OUT) {
#pragma unroll
        for (int i = 0; i < 16; ++i) usp[(size_t)crow(i, hh) * 128] = S[i];
        if (tid < 64) DS[(sc * 4 + h) * 64 + tid] = __expf(bsum);
    }
}
__device__ __forceinline__ void gla_scan_m(const KArgs& a, int vcu) {
    const int tid = otid(); if (tid >= 128) return;
    const int e = vcu * 128 + tid; if (e >= 32768) return;
    float* US = (float*)(a.ws + WS_R2 + 4096); const float* DS = US + (size_t)64 * 4 * 64 * 128;
    const int hd = e >> 7;
    float S = 0.f;
    for (int c0 = 0; c0 < 64; c0 += 8) {
        float u[8], d[8];
#pragma unroll
        for (int j = 0; j < 8; ++j) { u[j] = US[(size_t)(c0 + j) * 32768 + e]; d[j] = DS[(c0 + j) * 256 + hd]; }
#pragma unroll
        for (int j = 0; j < 8; ++j) { US[(size_t)(c0 + j) * 32768 + e] = S; S = d[j] * S + u[j]; }
    }
    a.out[O_GLAP + e] = S;
}
__device__ __forceinline__ void gla_decode_item(const KArgs& a, int item, int lane) {
    const int b = item >> 2, h = item & 3; const int row = SROW + b;
    const bf16_t* proj = (const bf16_t*)(a.ws + WS_BIG); const float* la = (const float*)(a.ws + WS_BIG + BIG_LA);
    bf16_t* mix = (bf16_t*)(a.ws + WS_R1);
    const float* S0 = a.in[I_SGLA] + ((size_t)b * 4 + h) * 8192;
    float* S1 = a.out + O_GLAS + ((size_t)b * 4 + h) * 8192;
    const float qv = bf2f(proj[(size_t)row * NPROJ + PQA + h * 64 + lane]) * 0.125f;
    const float kv = bf2f(proj[(size_t)row * NPROJ + PKA + h * 64 + lane]);
    const float av = __expf(la[(size_t)row * 256 + h * 64 + lane]);
    const unsigned vw = *(const unsigned*)(proj + (size_t)row * NPROJ + PVA + h * 128 + lane * 2);
    const float v0 = bf_lo(vw), v1 = bf_hi(vw);
    float o0 = 0.f, o1 = 0.f;
#pragma unroll 1
    for (int d0 = 0; d0 < 64; d0 += 16) {
        f32x2 sv[16];
#pragma unroll
        for (int j = 0; j < 16; ++j) sv[j] = __builtin_nontemporal_load((const f32x2*)(S0 + (d0 + j) * 128 + lane * 2));
#pragma unroll
        for (int j = 0; j < 16; ++j) {
            const int dk = d0 + j;
            const float q = __shfl(qv, dk), k = __shfl(kv, dk), al = __shfl(av, dk);
            const float n0 = al * sv[j].x + k * v0, n1 = al * sv[j].y + k * v1;
            __builtin_nontemporal_store((f32x2){n0, n1}, (f32x2*)(S1 + dk * 128 + lane * 2));
            o0 += q * n0; o1 += q * n1;
        }
    }
    const float ss = wave_sum(o0 * o0 + o1 * o1);
    const float rstd = rsqrtf(ss * (1.0f / 128.f) + EPS);
    const unsigned rw = *(const unsigned*)(proj + (size_t)row * NPROJ + PRA + h * 128 + lane * 2);
    const float r0 = bf_lo(rw), r1 = bf_hi(rw);
    const float y0 = o0 * rstd * a.in[I_ONORM][lane * 2] * (r0 / (1.f + __expf(-r0))), y1 = o1 * rstd * a.in[I_ONORM][lane * 2 + 1] * (r1 / (1.f + __expf(-r1)));
    *(unsigned*)(mix + (size_t)row * D + h * 128 + lane * 2) = cvt_pk_bf16(y0, y1);
}

__device__ __forceinline__ void swa_unit_m(const KArgs& a, LAS unsigned char* lds, int unit) {
    const int tid = otid(), lane = tid & 63, wave = __builtin_amdgcn_readfirstlane(tid >> 6);
    const int qb = unit >> 1, kvh = unit & 1; const int q0 = qb * 64, w0 = q0 - 128;
    const bf16_t* proj = (const bf16_t*)(a.ws + WS_BIG);
    bf16_t* mix = (bf16_t*)(a.ws + WS_R1);
    LAS bf16_t* Kl = (LAS bf16_t*)lds;
    LAS bf16_t* Vr = Kl + 192 * 72;
    const float* kn = a.in[I_KNORM];
    const int g = wave & 3, th = wave >> 2, hq = kvh * 4 + g;
    const int r = lane & 31, hh = lane >> 5;
    const int t = q0 + 32 * th + r;
    u32x4 kwv[3], vwv[3], qwv[4];
#pragma unroll
    for (int i = 0; i < 3; ++i) { const int c = tid + i * NTHREADS; const int kk = c >> 3, part = c & 7; const int tk = w0 + kk;
        kwv[i] = (u32x4){0u, 0u, 0u, 0u}; vwv[i] = (u32x4){0u, 0u, 0u, 0u};
        if (tk >= 0) { kwv[i] = *(const u32x4*)(proj + (size_t)tk * NPROJ + PKB + kvh * 64 + part * 8); vwv[i] = *(const u32x4*)(proj + (size_t)tk * NPROJ + PVB + kvh * 64 + part * 8); } }
#pragma unroll
    for (int s = 0; s < 4; ++s) qwv[s] = *(const u32x4*)(proj + (size_t)t * NPROJ + PQB + hq * 64 + 16 * s + 8 * hh);
#pragma unroll
    for (int i = 0; i < 3; ++i) {
        const int c = tid + i * NTHREADS; const int kk = c >> 3, part = c & 7;
        float kf[8]; unpack8(kwv[i], kf);
        const u32x4 vw = vwv[i];
        float ss = 0.f;
#pragma unroll
        for (int j = 0; j < 8; ++j) ss += kf[j] * kf[j];
        ss += __shfl_xor(ss, 1); ss += __shfl_xor(ss, 2); ss += __shfl_xor(ss, 4);
        const float rstd = rsqrtf(ss * (1.0f / 64.f) + EPS);
#pragma unroll
        for (int j = 0; j < 8; ++j) kf[j] = kf[j] * rstd * kn[part * 8 + j];
        u32x4 kw2; kw2.x = cvt_pk_bf16(kf[0], kf[1]); kw2.y = cvt_pk_bf16(kf[2], kf[3]); kw2.z = cvt_pk_bf16(kf[4], kf[5]); kw2.w = cvt_pk_bf16(kf[6], kf[7]);
        *(LAS u32x4*)(Kl + kk * 72 + part * 8) = kw2;
        *(LAS u32x4*)(Vr + kk * 96 + part * 8) = vw;
        if (qb == 255 && kk >= 64) {
            const int w = kk - 64;
            float vf[8]; unpack8(vw, vf);
            float* ko = a.out + O_SKP + ((size_t)w * 2 + kvh) * 64 + part * 8; float* vo = a.out + O_SVP + ((size_t)w * 2 + kvh) * 64 + part * 8;
            *(f32x4*)ko = (f32x4){kf[0], kf[1], kf[2], kf[3]}; *(f32x4*)(ko + 4) = (f32x4){kf[4], kf[5], kf[6], kf[7]};
            *(f32x4*)vo = (f32x4){vf[0], vf[1], vf[2], vf[3]}; *(f32x4*)(vo + 4) = (f32x4){vf[4], vf[5], vf[6], vf[7]};
        }
    }
    LBAR();
    constexpr float LOG2E = 1.4426950408889634f;
    bf16x8 qf[4];
    {
        float qv[4][8]; float ss = 0.f;
#pragma unroll
        for (int s = 0; s < 4; ++s) { unpack8(qwv[s], qv[s]);
#pragma unroll
            for (int j = 0; j < 8; ++j) ss += qv[s][j] * qv[s][j]; }
        ss += __shfl_xor(ss, 32);
        const float rstd = rsqrtf(ss * (1.0f / 64.f) + EPS) * (0.125f * LOG2E);
        const float* qn = a.in[I_QNORM];
#pragma unroll
        for (int s = 0; s < 4; ++s) {
            u32x4 w;
            w.x = cvt_pk_bf16(qv[s][0] * rstd * qn[16 * s + 8 * hh + 0], qv[s][1] * rstd * qn[16 * s + 8 * hh + 1]);
            w.y = cvt_pk_bf16(qv[s][2] * rstd * qn[16 * s + 8 * hh + 2], qv[s][3] * rstd * qn[16 * s + 8 * hh + 3]);
            w.z = cvt_pk_bf16(qv[s][4] * rstd * qn[16 * s + 8 * hh + 4], qv[s][5] * rstd * qn[16 * s + 8 * hh + 5]);
            w.w = cvt_pk_bf16(qv[s][6] * rstd * qn[16 * s + 8 * hh + 6], qv[s][7] * rstd * qn[16 * s + 8 * hh + 7]);
            qf[s] = __builtin_bit_cast(bf16x8, w);
        }
    }
    f32x16 sacc[5];
#pragma unroll
    for (int k5 = 0; k5 < 5; ++k5) {
        const int kt = th + k5;
        f32x16 acc = {};
#pragma unroll
        for (int s = 0; s < 4; ++s) { const bf16x8 af = *(const LAS bf16x8*)(Kl + (kt * 32 + r) * 72 + 16 * s + 8 * hh); acc = __builtin_amdgcn_mfma_f32_32x32x16_bf16(af, qf[s], acc, 0, 0, 0); }
        sacc[k5] = acc;
    }
    const float slope2 = exp2f(-(float)(hq + 1)) * LOG2E;
    const float sink2 = a.in[I_SINKS][hq] * LOG2E;
    float mx = sink2;
#pragma unroll
    for (int k5 = 0; k5 < 5; ++k5)
#pragma unroll
        for (int i = 0; i < 16; ++i) {
            const int row = (i & 3) + 8 * (i >> 2) + 4 * hh;
            const int dist = 128 - 32 * k5 + r - row;
            const int tk = w0 + 32 * (th + k5) + row;
            float s = sacc[k5][i] - slope2 * (float)dist;
            if (dist < 0 || dist >= 128 || tk < 0) s = -1e30f;
            sacc[k5][i] = s; mx = fmaxf(mx, s);
        }
    mx = fmaxf(mx, __shfl_xor(mx, 32));
    float l = 0.f;
#pragma unroll
    for (int k5 = 0; k5 < 5; ++k5)
#pragma unroll
        for (int i = 0; i < 16; ++i) { const float p = __builtin_amdgcn_exp2f(sacc[k5][i] - mx); sacc[k5][i] = p; l += p; }
    l += __shfl_xor(l, 32);
    l += exp2f(sink2 - mx);
    f32x16 oacc[2] = {{}, {}};
    const unsigned trb = (unsigned)(size_t)(Vr + (32 * th + 4 * hh + ((lane & 15) >> 2)) * 96 + 16 * ((lane >> 4) & 1) + 4 * (lane & 3));
#pragma unroll
    for (int k5 = 0; k5 < 5; ++k5) {
        u32x2 vb[2][2][2];
        const unsigned ad = trb + (unsigned)(32 * k5 * 96 * 2);
        asm volatile("ds_read_b64_tr_b16 %0, %8\n\tds_read_b64_tr_b16 %1, %8 offset:%9\n\tds_read_b64_tr_b16 %2, %8 offset:%10\n\tds_read_b64_tr_b16 %3, %8 offset:%11\n\t"
                     "ds_read_b64_tr_b16 %4, %8 offset:%12\n\tds_read_b64_tr_b16 %5, %8 offset:%13\n\tds_read_b64_tr_b16 %6, %8 offset:%14\n\tds_read_b64_tr_b16 %7, %8 offset:%15\n\ts_waitcnt lgkmcnt(0)"
                     : "=&v"(vb[0][0][0]), "=&v"(vb[0][0][1]), "=&v"(vb[0][1][0]), "=&v"(vb[0][1][1]), "=&v"(vb[1][0][0]), "=&v"(vb[1][0][1]), "=&v"(vb[1][1][0]), "=&v"(vb[1][1][1])
                     : "v"(ad), "i"(8 * 96 * 2), "i"(64), "i"(8 * 96 * 2 + 64), "i"(16 * 96 * 2), "i"(24 * 96 * 2), "i"(16 * 96 * 2 + 64), "i"(24 * 96 * 2 + 64) : "memory");
#pragma unroll
        for (int s2 = 0; s2 < 2; ++s2) {
            u32x4 pw;
            pw.x = cvt_pk_bf16(sacc[k5][8 * s2 + 0], sacc[k5][8 * s2 + 1]); pw.y = cvt_pk_bf16(sacc[k5][8 * s2 + 2], sacc[k5][8 * s2 + 3]);
            pw.z = cvt_pk_bf16(sacc[k5][8 * s2 + 4], sacc[k5][8 * s2 + 5]); pw.w = cvt_pk_bf16(sacc[k5][8 * s2 + 6], sacc[k5][8 * s2 + 7]);
            const bf16x8 pf = __builtin_bit_cast(bf16x8, pw);
#pragma unroll
            for (int dt = 0; dt < 2; ++dt) {
                const u32x4 vv = (u32x4){vb[s2][dt][0].x, vb[s2][dt][0].y, vb[s2][dt][1].x, vb[s2][dt][1].y};
                oacc[dt] = __builtin_amdgcn_mfma_f32_32x32x16_bf16(__builtin_bit_cast(bf16x8, vv), pf, oacc[dt], 0, 0, 0);
            }
        }
    }
    const float inv = 1.f / l;
#pragma unroll
    for (int dt = 0; dt < 2; ++dt)
#pragma unroll
        for (int q = 0; q < 4; ++q) {
            u32x2 w; w.x = cvt_pk_bf16(oacc[dt][4 * q] * inv, oacc[dt][4 * q + 1] * inv); w.y = cvt_pk_bf16(oacc[dt][4 * q + 2] * inv, oacc[dt][4 * q + 3] * inv);
            *(u32x2*)(mix + (size_t)t * D + 512 + hq * 64 + 32 * dt + 8 * q + 4 * hh) = w;
        }
    LBAR();
}
__device__ __forceinline__ void swa_decode_item(const KArgs& a, int item, int lane) {
    const int b = item >> 3, kvh = (item >> 2) & 1, g = item & 3, hq = kvh * 4 + g; const int row = SROW + b;
    const bf16_t* proj = (const bf16_t*)(a.ws + WS_BIG);
    bf16_t* mix = (bf16_t*)(a.ws + WS_R1);
    const float* ck = a.in[I_CK] + (size_t)b * 128 * 128 + kvh * 64;
    const float* cv = a.in[I_CV] + (size_t)b * 128 * 128 + kvh * 64;
    float qd = bf2f(proj[(size_t)row * NPROJ + PQB + hq * 64 + lane]);
    { const float ss = wave_sum(qd * qd); qd = qd * rsqrtf(ss * (1.0f / 64.f) + EPS) * a.in[I_QNORM][lane] * 0.125f; }
    float kd = bf2f(proj[(size_t)row * NPROJ + PKB + kvh * 64 + lane]);
    { const float ss = wave_sum(kd * kd); kd = kd * rsqrtf(ss * (1.0f / 64.f) + EPS) * a.in[I_KNORM][lane]; }
    const float vd = bf2f(proj[(size_t)row * NPROJ + PVB + kvh * 64 + lane]);
    const float slope = exp2f(-(float)(hq + 1));
    float s0 = 0.f, s1 = 0.f;
    {
        f32x4 k0[16], k1[16];
#pragma unroll
        for (int i = 0; i < 16; ++i) { k0[i] = *(const f32x4*)(ck + (size_t)lane * 128 + 4 * i); k1[i] = *(const f32x4*)(ck + (size_t)(lane + 64) * 128 + 4 * i); }
#pragma unroll
        for (int i = 0; i < 16; ++i) {
            const float q0 = __shfl(qd, 4 * i), q1 = __shfl(qd, 4 * i + 1), q2 = __shfl(qd, 4 * i + 2), q3 = __shfl(qd, 4 * i + 3);
            s0 += (q0 * k0[i][0] + q1 * k0[i][1]) + (q2 * k0[i][2] + q3 * k0[i][3]);
            s1 += (q0 * k1[i][0] + q1 * k1[i][1]) + (q2 * k1[i][2] + q3 * k1[i][3]);
        }
    }
    s0 -= slope * (float)(128 - lane); s1 -= slope * (float)(64 - lane);
    if (lane == 0) s0 = -1e30f;
    const float sn = wave_sum(qd * kd);
    const float sink = a.in[I_SINKS][hq];
    const float mx = fmaxf(fmaxf(wave_max(fmaxf(s0, s1)), sn), sink);
    const float p0 = __expf(s0 - mx), p1 = __expf(s1 - mx), pn = __expf(sn - mx);
    const float l = wave_sum(p0 + p1) + pn + __expf(sink - mx);
    float od = pn * vd;
#pragma unroll 1
    for (int w0 = 0; w0 < 64; w0 += 16) {
        float ca[16], cb[16];
#pragma unroll
        for (int j = 0; j < 16; ++j) { ca[j] = cv[(size_t)(w0 + j) * 128 + lane]; cb[j] = cv[(size_t)(w0 + j + 64) * 128 + lane]; }
#pragma unroll
        for (int j = 0; j < 16; ++j) { const float pa = __shfl(p0, w0 + j), pb = __shfl(p1, w0 + j); od += pa * ca[j] + pb * cb[j]; }
    }
    od /= l;
    const float oo = __shfl_down(od, 1);
    if ((lane & 1) == 0) *(unsigned*)(mix + (size_t)row * D + 512 + hq * 64 + lane) = cvt_pk_bf16(od, oo);
    {
        float* __restrict__ ko = a.out + O_SKS + (size_t)b * 128 * 128 + kvh * 64; float* __restrict__ vo = a.out + O_SVS + (size_t)b * 128 * 128 + kvh * 64;
        float ka[32], va[32];
#pragma unroll
        for (int j = 0; j < 32; ++j) { const int w = 32 * g + j + 1; ka[j] = (w < 128) ? ck[(size_t)w * 128 + lane] : kd; va[j] = (w < 128) ? cv[(size_t)w * 128 + lane] : vd; }
#pragma unroll
        for (int j = 0; j < 32; ++j) { ko[(size_t)(32 * g + j) * 128 + lane] = ka[j]; vo[(size_t)(32 * g + j) * 128 + lane] = va[j]; }
    }
}

template <int W>
__device__ __forceinline__ void pool_core(const bf16_t* __restrict__ h, const LAS float* rsL, const f32x4 gg, int r0, int half, int c4, bf16_t* __restrict__ d1, float* __restrict__ poolp) {
    const int rb = r0 + 8 * half;
    float xn[23][4];
#pragma unroll
    for (int i = 0; i < 23; ++i) { const int r = rb - 15 + i;
        u32x2 w = (u32x2){0u, 0u};
        if (i >= 16 - W && r >= 0) w = *(const u32x2*)(h + (size_t)r * D + c4);
        const float rs = rsL[8 * half + i];
        xn[i][0] = bf_lo(w.x) * rs * gg[0]; xn[i][1] = bf_hi(w.x) * rs * gg[1]; xn[i][2] = bf_lo(w.y) * rs * gg[2]; xn[i][3] = bf_hi(w.y) * rs * gg[3]; }
    float s[4] = {0.f, 0.f, 0.f, 0.f};
#pragma unroll
    for (int k = 1; k < W; ++k)
#pragma unroll
        for (int j = 0; j < 4; ++j) s[j] += xn[15 - k][j];
#pragma unroll
    for (int i = 0; i < 8; ++i) {
        const int r = rb + i;
        const int cnt = (r + 1 < W) ? r + 1 : W; const float ic = 1.0f / (float)cnt;
        float dd[4];
#pragma unroll
        for (int j = 0; j < 4; ++j) { s[j] += xn[15 + i][j]; dd[j] = s[j] * ic - xn[15 + i][j]; s[j] -= xn[15 + i - (W - 1)][j]; }
        u32x2 w; w.x = cvt_pk_bf16(dd[0], dd[1]); w.y = cvt_pk_bf16(dd[2], dd[3]);
        *(u32x2*)(d1 + (size_t)r * D + c4) = w;
        if (r >= SEQ - 15) *(f32x4*)(poolp + (size_t)(r - (SEQ - 15)) * D + c4) = (f32x4){xn[15 + i][0], xn[15 + i][1], xn[15 + i][2], xn[15 + i][3]};
    }
}
__device__ __forceinline__ void pool_item(const KArgs& a, LAS unsigned char* lds, int item, const float* part_in) {
    const int tid = otid();
    const bf16_t* h = (const bf16_t*)(a.ws + WS_R2 + 4096); bf16_t* d1 = (bf16_t*)(a.ws + WS_R1);
    LAS float* rsL = (LAS float*)lds;
    const int r0 = item * 16;
    __syncthreads();
    if (tid < 31) { const int r = r0 - 15 + tid; float rs = 0.f;
        if (r >= 0) { const f32x4 p0 = *(const f32x4*)(part_in + (long)r * 16), p1 = *(const f32x4*)(part_in + (long)r * 16 + 4), p2 = *(const f32x4*)(part_in + (long)r * 16 + 8), p3 = *(const f32x4*)(part_in + (long)r * 16 + 12);
            const float s = ((p0[0] + p0[1]) + (p0[2] + p0[3])) + ((p1[0] + p1[1]) + (p1[2] + p1[3])) + ((p2[0] + p2[1]) + (p2[2] + p2[3])) + ((p3[0] + p3[1]) + (p3[2] + p3[3]));
            rs = rsqrtf(s * (1.0f / D) + EPS); }
        rsL[tid] = rs; }
    __syncthreads();
    const int c4 = 4 * (tid & 255), half = tid >> 8; const int gq = __builtin_amdgcn_readfirstlane(c4 >> 8);
    const f32x4 gg = *(const f32x4*)(a.in[I_MNO] + c4);
    if (gq == 0) pool_core<2>(h, rsL, gg, r0, half, c4, d1, a.out + O_POOLP);
    else if (gq == 1) pool_core<4>(h, rsL, gg, r0, half, c4, d1, a.out + O_POOLP);
    else if (gq == 2) pool_core<8>(h, rsL, gg, r0, half, c4, d1, a.out + O_POOLP);
    else pool_core<16>(h, rsL, gg, r0, half, c4, d1, a.out + O_POOLP);
}
template <int W>
__device__ __forceinline__ void pool_tile_core(const LAS unsigned char* slab, const LAS float* rsL, const f32x4 gg, int pm, int rl0, int cq, int gq, bf16_t* __restrict__ d1, float* __restrict__ poolp) {
    float xn[23][4];
#pragma unroll
    for (int i = 0; i < 23; ++i) { const int sl = rl0 + i;
        u32x2 w = (u32x2){0u, 0u};
        if (i >= 16 - W) w = *(const LAS u32x2*)(slab + sl * 512 + cq * 8);
        const float rs = rsL[sl];
        xn[i][0] = bf_lo(w.x) * rs * gg[0]; xn[i][1] = bf_hi(w.x) * rs * gg[1]; xn[i][2] = bf_lo(w.y) * rs * gg[2]; xn[i][3] = bf_hi(w.y) * rs * gg[3]; }
    float s[4] = {0.f, 0.f, 0.f, 0.f};
#pragma unroll
    for (int k = 1; k < W; ++k)
#pragma unroll
        for (int j = 0; j < 4; ++j) s[j] += xn[15 - k][j];
    const int c4 = 256 * gq + 4 * cq;
#pragma unroll
    for (int i = 0; i < 8; ++i) {
        const int r = 256 * pm + rl0 + i;
        const int cnt = (r + 1 < W) ? r + 1 : W; const float ic = __builtin_amdgcn_rcpf((float)cnt);
        float dd[4];
#pragma unroll
        for (int j = 0; j < 4; ++j) { s[j] += xn[15 + i][j]; dd[j] = s[j] * ic - xn[15 + i][j]; s[j] -= xn[15 + i - (W - 1)][j]; }
        u32x2 w; w.x = cvt_pk_bf16(dd[0], dd[1]); w.y = cvt_pk_bf16(dd[2], dd[3]);
        *(u32x2*)(d1 + (size_t)r * D + c4) = w;
        if (r >= SEQ - 15) *(f32x4*)(poolp + (size_t)(r - (SEQ - 15)) * D + c4) = (f32x4){xn[15 + i][0], xn[15 + i][1], xn[15 + i][2], xn[15 + i][3]};
    }
}
__device__ __forceinline__ void pool_tile(const KArgs& a, LAS unsigned char* lds, int pm, int gq, const float* part_in) {
    const int tid = otid(), lane = tid & 63, wave = __builtin_amdgcn_readfirstlane(tid >> 6);
    const bf16_t* h = (const bf16_t*)(a.ws + WS_R2 + 4096); bf16_t* d1 = (bf16_t*)(a.ws + WS_R1);
    LAS float* rsL = (LAS float*)(lds + 140288);
    __syncthreads();
    for (int p = wave; p < 136; p += 8) {
        const int sl = 2 * p + (lane >> 5); int r = 256 * pm - 15 + sl; if (r < 0) r = 0; if (r > SEQ - 1) r = SEQ - 1;
        __builtin_amdgcn_global_load_lds((const unsigned*)(h + (size_t)r * D + 256 * gq + 8 * (lane & 31)), (LAS unsigned*)(lds + p * 1024), 16, 0, 0);
    }
    if (tid < 271) { const int r = 256 * pm - 15 + tid; float rs = 0.f;
        if (r >= 0) { const f32x4 p0 = *(const f32x4*)(part_in + (long)r * 16), p1 = *(const f32x4*)(part_in + (long)r * 16 + 4), p2 = *(const f32x4*)(part_in + (long)r * 16 + 8), p3 = *(const f32x4*)(part_in + (long)r * 16 + 12);
            const float s = ((p0[0] + p0[1]) + (p0[2] + p0[3])) + ((p1[0] + p1[1]) + (p1[2] + p1[3])) + ((p2[0] + p2[1]) + (p2[2] + p2[3])) + ((p3[0] + p3[1]) + (p3[2] + p3[3]));
            rs = rsqrtf(s * (1.0f / D) + EPS); }
        rsL[tid] = rs; }
    asm volatile("s_waitcnt vmcnt(0) lgkmcnt(0)" ::: "memory");
    __syncthreads();
    const int cq = lane;
    const f32x4 gg = *(const f32x4*)(a.in[I_MNO] + 256 * gq + 4 * cq);
#pragma unroll 1
    for (int st = 0; st < 4; ++st) {
        const int rl0 = 32 * wave + 8 * st;
        if (gq == 0) pool_tile_core<2>(lds, rsL, gg, pm, rl0, cq, gq, d1, a.out + O_POOLP);
        else if (gq == 1) pool_tile_core<4>(lds, rsL, gg, pm, rl0, cq, gq, d1, a.out + O_POOLP);
        else if (gq == 2) pool_tile_core<8>(lds, rsL, gg, pm, rl0, cq, gq, d1, a.out + O_POOLP);
        else pool_tile_core<16>(lds, rsL, gg, pm, rl0, cq, gq, d1, a.out + O_POOLP);
    }
}
__device__ __forceinline__ void pool_sample_item(const KArgs& a, LAS unsigned char* lds, int b, const float* part_in) {
    const int tid = otid();
    const bf16_t* __restrict__ h = (const bf16_t*)(a.ws + WS_R2 + 4096) + (size_t)(SROW + b) * D; bf16_t* __restrict__ d1 = (bf16_t*)(a.ws + WS_R1);
    const float* __restrict__ st = a.in[I_SPOOL] + (size_t)b * 15 * D; float* __restrict__ so = a.out + O_POOLS + (size_t)b * 15 * D;
    const float rs = s_row_rs(part_in, b);
#pragma unroll
    for (int cc = 0; cc < 2; ++cc) {
        const int c = tid + cc * NTHREADS; const int w = 2 << (c >> 8);
        float sv[15];
#pragma unroll
        for (int j = 0; j < 15; ++j) sv[j] = st[(size_t)j * D + c];
        const float xn = bf2f(h[c]) * rs * a.in[I_MNO][c];
        float sum = xn;
#pragma unroll
        for (int j = 0; j < 15; ++j) sum += (j >= 16 - w) ? sv[j] : 0.f;
        const float dd = sum / (float)w - xn;
        d1[(size_t)(SROW + b) * D + c] = (bf16_t)(cvt_pk_bf16(dd, 0.f) & 0xffffu);
#pragma unroll
        for (int j = 0; j < 14; ++j) so[(size_t)j * D + c] = sv[j + 1];
        so[(size_t)14 * D + c] = xn;
    }
}

#define XB_TMO      128
#define XB_XCNT(j)  (256  + 64 * (j))
#define XB_XSUB(j)  (1280 + 64 * (j))
#define XB_XGEN(j)  (2304 + 64 * (j))
#define XB_TOP      3328
#define XB_TOPGEN   3392
#define XCD_BAR_WORDS 3456
#define XB_SPIN_CAP (1u << 18)
__device__ __forceinline__ unsigned xb_ld(unsigned* p)              { return __hip_atomic_load(p, __ATOMIC_RELAXED, __HIP_MEMORY_SCOPE_AGENT); }
__device__ __forceinline__ unsigned xb_add(unsigned* p, unsigned v) { return __hip_atomic_fetch_add(p, v, __ATOMIC_RELAXED, __HIP_MEMORY_SCOPE_AGENT); }
__device__ __forceinline__ unsigned xb_xcc_id() { return (unsigned)__builtin_amdgcn_s_getreg((3 << 11) | 20) & 0xFu; }
#define XB_SPIN(cond, bar) do { unsigned _sp = 0; while (cond) { __builtin_amdgcn_s_sleep(1); \
    if ((++_sp & 255u) == 0u) { if (xb_ld(&(bar)[XB_TMO])) break; if (_sp > XB_SPIN_CAP) { atomicAdd(&(bar)[XB_TMO], 1u); break; } } } } while (0)
struct XcdBarrier { unsigned* bar; unsigned x; volatile LAS unsigned* st; };
__device__ __forceinline__ XcdBarrier xcd_barrier_post(unsigned* bar, volatile LAS unsigned* st) {
    XcdBarrier b; b.bar = bar; b.x = xb_xcc_id(); b.st = st;
    if (threadIdx.x == 0) (void)xb_add(&bar[XB_XCNT(b.x)], 1u);
    return b;
}
__device__ __forceinline__ void xcd_barrier_complete(unsigned* bar, unsigned x, unsigned& nloc, unsigned& nx, unsigned& mask) {
    const unsigned G = gridDim.x * gridDim.y * gridDim.z;
    unsigned sum, cnt, mine, sp = 0u;
    for (;;) {
        sum = 0u; cnt = 0u; mine = 0u; mask = 0u;
#pragma unroll
        for (unsigned j = 0; j < 16; ++j) { const unsigned c = xb_ld(&bar[XB_XCNT(j)]); sum += c; cnt += (c > 0u) ? 1u : 0u; mask |= (c > 0u) ? (1u << j) : 0u; mine = (j == x) ? c : mine; }
        if (sum == G) break;
        __builtin_amdgcn_s_sleep(1);
        if ((++sp & 255u) == 0u) { if (xb_ld(&bar[XB_TMO])) break; if (sp > XB_SPIN_CAP) { atomicAdd(&bar[XB_TMO], 1u); break; } }
    }
    nloc = mine > 0u ? mine : 1u; nx = cnt > 0u ? cnt : 1u;
}
#ifndef XB_FLAT
#define XB_FLAT 2
#endif
__device__ __forceinline__ void xcd_barrier(const XcdBarrier& b) {
    asm volatile("s_waitcnt vmcnt(0)" ::: "memory");
    __syncthreads();
    if (threadIdx.x == 0) {
        unsigned* bar = b.bar;
        __builtin_amdgcn_s_waitcnt(0);
        unsigned nloc = b.st[0], nx = b.st[1], mask = b.st[2];
        if (nloc == 0u) { xcd_barrier_complete(bar, b.x, nloc, nx, mask); b.st[0] = nloc; b.st[1] = nx; b.st[2] = mask; }
#if XB_FLAT == 2
        const unsigned g1 = b.st[3] + 1u; b.st[3] = g1;
        const unsigned old = xb_add(&bar[XB_XSUB(b.x)], 1u);
        if (old + 1u == g1 * nloc) {
            __builtin_amdgcn_fence(__ATOMIC_RELEASE, "agent");
            asm volatile("s_waitcnt vmcnt(0)" ::: "memory");
            const unsigned og = xb_add(&bar[XB_TOP], 1u);
            if (og + 1u == g1 * nx) xb_add(&bar[XB_TOPGEN], 1u);
        }
        XB_SPIN(xb_ld(&bar[XB_TOPGEN]) < g1, bar);
        __builtin_amdgcn_fence(__ATOMIC_ACQUIRE, "agent");
        asm volatile("s_waitcnt vmcnt(0)" ::: "memory");
#elif XB_FLAT
        const unsigned g1 = b.st[3] + 1u; b.st[3] = g1;
        const unsigned old = xb_add(&bar[XB_XSUB(b.x)], 1u);
        if (old + 1u == g1 * nloc) {
            __builtin_amdgcn_fence(__ATOMIC_RELEASE, "agent");
            asm volatile("s_waitcnt vmcnt(0)" ::: "memory");
            xb_add(&bar[XB_XGEN(b.x)], 1u);
        }
        {
            unsigned sp_ = 0u;
            for (;;) {
                unsigned ok = 1u;
#pragma unroll
                for (unsigned j = 0; j < 16; ++j) { if (mask & (1u << j)) { const unsigned v = xb_ld(&bar[XB_XGEN(j)]); ok &= (v >= g1) ? 1u : 0u; } }
                if (ok) break;
                __builtin_amdgcn_s_sleep(1);
                if ((++sp_ & 255u) == 0u) { if (xb_ld(&bar[XB_TMO])) break; if (sp_ > XB_SPIN_CAP) { atomicAdd(&bar[XB_TMO], 1u); break; } }
            }
        }
        __builtin_amdgcn_fence(__ATOMIC_ACQUIRE, "agent");
        asm volatile("s_waitcnt vmcnt(0)" ::: "memory");
#else
        const unsigned old = xb_add(&bar[XB_XSUB(b.x)], 1u);
        const unsigned gen = old / nloc;
        if (old + 1u == (gen + 1u) * nloc) {
            __builtin_amdgcn_fence(__ATOMIC_RELEASE, "agent");
            asm volatile("s_waitcnt vmcnt(0)" ::: "memory");
            const unsigned og = xb_add(&bar[XB_TOP], 1u);
            const unsigned tg = og / nx;
            if (og + 1u == (tg + 1u) * nx) xb_add(&bar[XB_TOPGEN], 1u);
            else XB_SPIN(xb_ld(&bar[XB_TOPGEN]) == tg, bar);
            __builtin_amdgcn_fence(__ATOMIC_ACQUIRE, "agent");
            xb_add(&bar[XB_XGEN(b.x)], 1u);
            asm volatile("s_waitcnt vmcnt(0)" ::: "memory");
        } else {
            XB_SPIN(xb_ld(&bar[XB_XGEN(b.x)]) == gen, bar);
            __builtin_amdgcn_fence(__ATOMIC_ACQUIRE, "agent");
            asm volatile("s_waitcnt vmcnt(0)" ::: "memory");
        }
#endif
    }
    __syncthreads();
}

#ifndef DUPM
#define DUPM 0
#endif
#ifndef SYNCREP
#define SYNCREP 1
#endif
#if defined(PROBE_T)
#define TSTAMP() do { if (stamp_i == PROBE_T) t_a = __builtin_amdgcn_s_memrealtime(); if (stamp_i == PROBE_T + 1) t_b = __builtin_amdgcn_s_memrealtime(); ++stamp_i; } while (0)
#else
#define TSTAMP() do { } while (0)
#endif
#if defined(PROBE_BAR)
#define GSYNC() do { const unsigned long long tb_ = __builtin_amdgcn_s_memrealtime(); xcd_barrier(xbar); sub_d += __builtin_amdgcn_s_memrealtime() - tb_; } while (0)
#else
#define GSYNC() do { _Pragma("unroll 1") for (int sr_ = 0; sr_ < SYNCREP; ++sr_) xcd_barrier(xbar); TSTAMP(); } while (0)
#endif
#define PH(k) _Pragma("unroll 1") for (int rep_ = 0; rep_ < (((DUPM) >> (k)) & 1) + 1; ++rep_)
__global__ void __launch_bounds__(NTHREADS, 2) mega_fwd(KArgs a) {
    extern __shared__ __attribute__((aligned(16))) unsigned char lds_raw[];
    LAS unsigned char* lds = (LAS unsigned char*)lds_raw;
    cg::grid_group grid = cg::this_grid();
    const int G = gridDim.x, bx = blockIdx.x;
    const int vcu = (G % 8 == 0) ? (bx % 8) * (G / 8) + bx / 8 : bx;
    unsigned char* ws = a.ws;
    if (ws == nullptr) grid.sync();
    volatile LAS unsigned* xst = (volatile LAS unsigned*)(lds + LDS_BYTES - 64);
    if (threadIdx.x < 16) xst[threadIdx.x] = 0u;
    __syncthreads();
    const XcdBarrier xbar = xcd_barrier_post((unsigned*)(ws + 16384), xst);
    bf16_t* R1 = (bf16_t*)(ws + WS_R1); bf16_t* R2 = (bf16_t*)(ws + WS_R2 + 4096);
    bf16_t* BIGB = (bf16_t*)(ws + WS_BIG);
    const bf16_t* pbf = (const bf16_t*)(ws + WS_PBF);

#if defined(PROBE_T)
    int stamp_i = 0; unsigned long long t_a = 0, t_b = 0;
    TSTAMP();
#endif
#if defined(PROBE_SUB) || defined(PROBE_P2) || defined(PROBE_P1) || defined(PROBE_E) || defined(PROBE_BAR)
    unsigned long long sub_d = 0;
#endif
#ifndef NPASS
#define NPASS 1
#endif
#pragma unroll 1
    for (int pass_ = 0; pass_ < NPASS; ++pass_) {
    if (pass_ > 0) GSYNC();
    PH(0) p0_prologue(a, lds, vcu, G);
    GSYNC();
    PH(1) {
        pg8::Gemm g{(const bf16_t*)(a.out + O_YP), (const bf16_t*)(ws + WS_WIN0), 1024, 1024, 1024, 256, 0, 0};
        pg8::StaticOrder S; S.init(64, 10, G, bx);
        EpiProj E{BIGB, (float*)(ws + WS_BIG + BIG_LA), (const float*)(ws + WS_SSQ), a.in[I_BALPHA]};
#if defined(PROBE_P1)
        unsigned long long tq0 = __builtin_amdgcn_s_memrealtime();
#endif
        pg8::gemm_phase(lds, g, S, E);
#if defined(PROBE_P1)
        sub_d = __builtin_amdgcn_s_memrealtime() - tq0;
#endif
        if (bx >= (640 % G)) s_proj_units(a, lds, bx - (640 % G), G - (640 % G));
        if (G == 256 && CONV_SPLIT == CONV_ITEMS) {
            const int wv = __builtin_amdgcn_readfirstlane(otid() >> 6); __syncthreads();
            if (bx >= 128) { p3_convert(a, lds, (bx - 128) * 8 + wv, 1024, 0, 4096, false); if (bx >= 160 && bx < 168) p3_convert(a, lds, (bx - 160) * 8 + wv, 64, 5120, CONV_ITEMS, false); }
            else p3_convert(a, lds, bx * 8 + wv, 1024, 4096, 5120, false);
        } else
        if (bx >= (640 % G)) { const int wv = __builtin_amdgcn_readfirstlane(otid() >> 6); __syncthreads(); p3_convert(a, lds, (bx - (640 % G)) * 8 + wv, (G - (640 % G)) * 8, 0, CONV_SPLIT, false); }
#if defined(PROBE_P1)
        if (PROBE_P1 == 1) sub_d = __builtin_amdgcn_s_memrealtime() - tq0;
#endif
    }
    GSYNC();
#if defined(PROBE_P2)
    unsigned long long tp0 = __builtin_amdgcn_s_memrealtime();
#endif
    PH(2) for (int it = vcu; it < 256; it += G) gla_agg_item(a, lds, it);
#if defined(PROBE_P2)
    unsigned long long tp1 = __builtin_amdgcn_s_memrealtime();
#endif
    PH(3) for (int it = vcu; it < 512; it += G) swa_unit_m(a, lds, it);
#if defined(PROBE_P2)
    unsigned long long tp2 = __builtin_amdgcn_s_memrealtime();
#endif
    PH(4) { const int tid = otid(), lane = tid & 63, wave = __builtin_amdgcn_readfirstlane(tid >> 6); for (int it = vcu + G * wave; it < 512; it += G * 8) gla_decode_item(a, it, lane); }
    PH(5) { const int tid = otid(), lane = tid & 63, wave = __builtin_amdgcn_readfirstlane(tid >> 6); for (int it = vcu + G * ((wave + 6) & 7); it < 1024; it += G * 8) swa_decode_item(a, it, lane); }
#if defined(PROBE_P2)
    { unsigned long long tp3 = __builtin_amdgcn_s_memrealtime(); sub_d = (PROBE_P2 == 0) ? tp1 - tp0 : (PROBE_P2 == 1) ? tp2 - tp1 : tp3 - tp2; }
#endif
    GSYNC();
    PH(6) { gla_scan_m(a, vcu); const int wv = __builtin_amdgcn_readfirstlane(otid() >> 6); if (wv >= 2) p3_convert(a, lds, vcu * 6 + (wv - 2), G * 6, CONV_SPLIT, CONV_ITEMS, true); }
    GSYNC();
    PH(7) for (int it = vcu; it < 256; it += G) gla_item_m<true>(a, lds, it);
    GSYNC();
    PH(8) {
        pg8::Gemm g{R1, (const bf16_t*)(ws + WS_WOUT0), 1024, 1024, 1024, 256, 0, 0};
        pg8::StaticOrder S; S.init(64, 4, G, bx);
        EpiRes<1, true, true, false> E{a.out, nullptr, (const bf16_t*)(a.out + O_YP), R2, part_tab(ws, 0), nullptr, nullptr, nullptr};
        PreRes<1, 1024, 1024> P{R1, (const bf16_t*)(ws + WS_WOUT0), bx};
        pg8::gemm_phase<EpiRes<1, true, true, false>, 0, PreRes<1, 1024, 1024>>(lds, g, S, E, nullptr, P);
        s_res_units_q<1, 1024, 1024>(a, lds, bx, G, R1, (const bf16_t*)(ws + WS_WOUT0), (const bf16_t*)(a.out + O_YP), R2, spart_tab(ws, 0), (HOOKS != 0) && bx < 256);
    }
#if defined(PROBE_FFNK)
    {
        pg8::Gemm g{R2, (const bf16_t*)(ws + WS_WFFI), 1024, 1024, 1024, 254, -2, 0};
        pg8::StaticOrder S; S.init(65, 22, G, bx);
#if PROBE_FFNK == 1
        EpiNull E{};
#elif PROBE_FFNK == 2
        EpiStoreOnly<0> E{R1};
#else
        EpiStoreOnly<1> E{R1};
#endif
        pg8::gemm_phase(lds, g, S, E);
    }
#endif
#if defined(PROBE_KLOOP)
    {
        pg8::Gemm g{R1, (const bf16_t*)(ws + WS_WOUT0), 1024, 1024, 1024, 256, 0, 0};
        pg8::StaticOrder S; S.init(64, 4, G, bx);
#if PROBE_KVAR == 1
        EpiStoreOnly<0> E{R1};
#elif PROBE_KVAR == 2
        EpiRes<1, true, false, false> E{a.out, nullptr, R2, R1, nullptr, nullptr, nullptr, nullptr};
#else
        EpiNull E{};
#endif
        for (int rep = 0; rep < PROBE_KLOOP; ++rep) pg8::gemm_phase(lds, g, S, E);
    }
#endif
    GSYNC();
#pragma unroll 1
    for (int l = 0; l < 2; ++l) {
        bf16_t* G_ = BIGB;
        bf16_t* PPb = BIGB;
        PH(9) {
            pg8::Gemm g{R2, (const bf16_t*)(ws + WS_WFFI + l * WFFI_BYTES), 1024, 1024, 1024, 254, -2, 0};
            pg8::StaticOrder S; S.init(65, 22, G, bx);
            EpiFfn E{part_tab(ws, l == 0 ? 0 : 3), a.in[I_FCW] + (size_t)l * 3 * DFF, a.in[I_FCB] + (size_t)l * DFF, a.out + O_CONVP + (size_t)l * 2 * DFF, G_};
            pg8::gemm_phase(lds, g, S, E);
            if (bx >= (1430 % G)) s_ffn_units(a, lds, bx - (1430 % G), G - (1430 % G), l, R2, spart_tab(ws, l == 0 ? 0 : 3));
        }
        GSYNC();
        PH(10) {
            pg8::Gemm g{G_, (const bf16_t*)(ws + WS_WFFO + l * WFFO_BYTES), DFF, DFF, DFF, 256, 0, 0};
            pg8::StaticOrder S; S.init(64, 4, G, bx);
            EpiRes<1, true, true, false> E{a.out, nullptr, R2, R1, part_tab(ws, l == 0 ? 1 : 4), nullptr, nullptr, nullptr};
#if defined(PROBE_SUB)
            unsigned long long ts0 = __builtin_amdgcn_s_memrealtime();
#endif
            PreRes<1, DFF, DFF> P{G_, (const bf16_t*)(ws + WS_WFFO + l * WFFO_BYTES), bx};
            pg8::gemm_phase<EpiRes<1, true, true, false>, 0, PreRes<1, DFF, DFF>>(lds, g, S, E, nullptr, P);
#if defined(PROBE_SUB)
            unsigned long long ts1 = __builtin_amdgcn_s_memrealtime();
#endif
            s_res_units_q<1, DFF, DFF>(a, lds, bx, G, G_, (const bf16_t*)(ws + WS_WFFO + l * WFFO_BYTES), R2, R1, spart_tab(ws, l == 0 ? 1 : 4), (HOOKS != 0) && bx < 256);
#if defined(PROBE_SUB)
            unsigned long long ts2 = __builtin_amdgcn_s_memrealtime();
            xcd_barrier(xbar);
            unsigned long long ts3 = __builtin_amdgcn_s_memrealtime();
            if (l == 0) { sub_d = (PROBE_SUB == 0) ? ts1 - ts0 : (PROBE_SUB == 1) ? ts2 - ts1 : ts3 - ts2; }
#endif
        }
#if !defined(PROBE_SUB)
        GSYNC();
#endif
#if PAIR
        PH(11) {
            pg8::Gemm gp{pbf + (size_t)l * MT * PLE, (const bf16_t*)(ws + WS_WPROJ + l * WPROJ_BYTES), PLE, PLE, PLE, 256, 0, 0};
            pg8::Gemm gg{R1, (const bf16_t*)(ws + WS_WGATE + l * WGATE_BYTES), 1024, 1024, 1024, 256, 0, 0};
            pg8::StaticOrder S; S.init(64, 4, G, bx);
            EpiPP EP{PPb};
            if (l == 0) { EpiRes<2, true, true, false> E{a.out, nullptr, R1, R2, part_tab(ws, 2), part_tab(ws, 1), PPb, nullptr}; PrePle P{pbf, (const bf16_t*)(ws + WS_WPROJ), R1, (const bf16_t*)(ws + WS_WGATE), bx}; pg8::gemm_pair(lds, gp, gg, S, EP, E, P);
                s_ple_units_q<false>(a, lds, bx, G, pbf, (const bf16_t*)(ws + WS_WPROJ), R1, (const bf16_t*)(ws + WS_WGATE), spart_tab(ws, 1), spart_tab(ws, 2), R2, (HOOKS != 0) && bx < 256); }
            else { EpiRes<2, false, false, true> E{a.out, nullptr, R1, nullptr, nullptr, part_tab(ws, 4), PPb, nullptr}; PrePle P{pbf + (size_t)MT * PLE, (const bf16_t*)(ws + WS_WPROJ + WPROJ_BYTES), R1, (const bf16_t*)(ws + WS_WGATE + WGATE_BYTES), bx}; pg8::gemm_pair(lds, gp, gg, S, EP, E, P);
                s_ple_units_q<true>(a, lds, bx, G, pbf + (size_t)MT * PLE, (const bf16_t*)(ws + WS_WPROJ + WPROJ_BYTES), R1, (const bf16_t*)(ws + WS_WGATE + WGATE_BYTES), spart_tab(ws, 4), nullptr, nullptr, (HOOKS != 0) && bx < 256); }
        }
#else
        PH(11) {
            pg8::Gemm g{pbf + (size_t)l * MT * PLE, (const bf16_t*)(ws + WS_WPROJ + l * WPROJ_BYTES), PLE, PLE, PLE, 256, 0, 0};
            pg8::StaticOrder S; S.init(64, 4, G, bx);
            EpiPP E{PPb};
#if defined(PROBE_E)
            unsigned long long te0 = __builtin_amdgcn_s_memrealtime();
#endif
            pg8::gemm_phase(lds, g, S, E);
#if defined(PROBE_E)
            if (l == 0 && PROBE_E == 0) sub_d = __builtin_amdgcn_s_memrealtime() - te0;
#endif
        }
        PH(12) {
            pg8::Gemm g{R1, (const bf16_t*)(ws + WS_WGATE + l * WGATE_BYTES), 1024, 1024, 1024, 256, 0, 0};
            pg8::StaticOrder S; S.init(64, 4, G, bx);
#if defined(PROBE_E)
            unsigned long long te1 = __builtin_amdgcn_s_memrealtime();
#endif
#if defined(PROBE_E)
#define PE_TACC (PROBE_E == 3 ? &sub_d : nullptr)
#else
#define PE_TACC nullptr
#endif
            if (l == 0) { EpiRes<2, true, true, false> E{a.out, nullptr, R1, R2, part_tab(ws, 2), part_tab(ws, 1), PPb, nullptr}; pg8::gemm_phase<EpiRes<2, true, true, false>, WARM * 2048>(lds, g, S, E, PE_TACC);
#if defined(PROBE_E)
                if (PROBE_E == 1) sub_d = __builtin_amdgcn_s_memrealtime() - te1;
                te1 = __builtin_amdgcn_s_memrealtime();
#endif
                s_ple_units<false>(a, lds, bx, G, pbf, (const bf16_t*)(ws + WS_WPROJ), R1, (const bf16_t*)(ws + WS_WGATE), spart_tab(ws, 1), spart_tab(ws, 2), R2);
#if defined(PROBE_E)
                if (PROBE_E == 2) sub_d = __builtin_amdgcn_s_memrealtime() - te1;
#endif
            }
            else { EpiRes<2, false, false, true> E{a.out, nullptr, R1, nullptr, nullptr, part_tab(ws, 4), PPb, nullptr}; pg8::gemm_phase<EpiRes<2, false, false, true>, WARM * 2048>(lds, g, S, E);
                s_ple_units<true>(a, lds, bx, G, pbf + (size_t)MT * PLE, (const bf16_t*)(ws + WS_WPROJ + WPROJ_BYTES), R1, (const bf16_t*)(ws + WS_WGATE + WGATE_BYTES), spart_tab(ws, 4), nullptr, nullptr); }
        }
#endif
        if (l == 0) {
            GSYNC();
            PH(13) { for (int it = vcu; it < NS; it += G) pool_sample_item(a, lds, it, spart_tab(ws, 2));
                     for (int it = vcu; it < 256; it += G) pool_tile(a, lds, it >> 2, it & 3, part_tab(ws, 2)); }
            GSYNC();
            PH(14) {
                pg8::Gemm g{R1, (const bf16_t*)(ws + WS_WPOOL), 1024, 256, 256, 256, 0, 256};
                pg8::StaticOrder S; S.init(64, 4, G, bx);
                EpiRes<3, true, true, false> E{a.out, nullptr, R2, R2, part_tab(ws, 3), nullptr, nullptr, a.in[I_POOLSC]};
                PreRes<3, 256, 1024> P{R1, (const bf16_t*)(ws + WS_WPOOL), bx};
                pg8::gemm_phase<EpiRes<3, true, true, false>, 0, PreRes<3, 256, 1024>>(lds, g, S, E, nullptr, P);
                s_res_units_q<3, 256, 1024>(a, lds, bx, G, R1, (const bf16_t*)(ws + WS_WPOOL), R2, R2, spart_tab(ws, 3), (HOOKS != 0) && bx < 256);
            }
            GSYNC();
        }
    }
    }
#if defined(PROBE_SUB) || defined(PROBE_P2) || defined(PROBE_P1) || defined(PROBE_E) || defined(PROBE_BAR)
    if (blockIdx.x == PROBE_BLK && threadIdx.x == 0) { const unsigned long long t_end = __builtin_amdgcn_s_memrealtime() + sub_d; while (__builtin_amdgcn_s_memrealtime() < t_end) __builtin_amdgcn_s_sleep(8); }
#endif
#if defined(PROBE_T)
    TSTAMP();
    if (blockIdx.x == 0 && threadIdx.x == 0) { const unsigned long long t_end = __builtin_amdgcn_s_memrealtime() + (t_b - t_a); while (__builtin_amdgcn_s_memrealtime() < t_end) __builtin_amdgcn_s_sleep(8); }
#endif
}

extern "C" void kernel_launch(void* const* d_in, const int* in_sizes, int n_in, void* d_out, int out_size, void* d_ws, size_t ws_size, hipStream_t stream) {
    static int grid = 0;
    if (grid == 0) {
        int dev = 0, cus = 0, per_cu = 0;
        hipGetDevice(&dev);
        hipDeviceGetAttribute(&cus, hipDeviceAttributeMultiprocessorCount, dev);
        hipFuncSetAttribute((const void*)mega_fwd, hipFuncAttributeMaxDynamicSharedMemorySize, LDS_BYTES);
        hipOccupancyMaxActiveBlocksPerMultiprocessor(&per_cu, (const void*)mega_fwd, NTHREADS, LDS_BYTES);
        if (per_cu < 1) { fprintf(stderr, "kernel_launch: occupancy query reports %d blocks per CU\n", per_cu); per_cu = 1; }
        if (per_cu > 1) per_cu = 1;
        grid = cus * per_cu;
        (void)hipGetLastError();
    }
    (void)hipMemsetAsync(d_ws, 0, 65536, stream);
    KArgs a{};
    for (int i = 0; i < 29; ++i) a.in[i] = (const float*)d_in[i];
    a.out = (float*)d_out; a.ws = (unsigned char*)d_ws;
    void* args[] = {&a};
    hipError_t e = hipLaunchCooperativeKernel((const void*)mega_fwd, dim3(grid), dim3(NTHREADS), args, LDS_BYTES, stream);
#if defined(PROBE_TWICE)
    (void)hipMemsetAsync(d_ws, 0, 65536, stream);
    e = hipLaunchCooperativeKernel((const void*)mega_fwd, dim3(grid), dim3(NTHREADS), args, LDS_BYTES, stream);
#endif
    if (e != hipSuccess) fprintf(stderr, "cooperative launch failed: %s (grid %d)\n", hipGetErrorString(e), grid);
}
```
